# Optimizing an MI355X kernel written in HIP

```python
import jax, jax.numpy as jnp
from jax import lax
import numpy as np

D_MODEL = 2048
BATCH = 16
SEQ = 2048
DEPTH = 4
DEC_BATCH = 8
DEC_SEQ = 2048
PAST_LEN = 128

GRID_W = 64
HEAD_DIM = 128
A_Q = D_MODEL // 2
A_HEADS = A_Q // HEAD_DIM
A_KV_HEADS = A_HEADS // 4
A_GROUP = A_HEADS // A_KV_HEADS
A_KV = A_KV_HEADS * HEAD_DIM
ROPE_THETA = 10000.0
Q_BLOCK = 128
B_W = D_MODEL // 4
B_HEADS = B_W // HEAD_DIM
NA_ROWS = 8
NA_COLS = 16
C_V = D_MODEL // 4
C_HEADS = 4
C_DV = C_V // C_HEADS
C_DK = C_DV // 2
C_K = C_HEADS * C_DK
C_RANK = 16
C_TAU = 16.0
C_CHUNK = 64
D_FF = 5632
EPS = 1e-6
N_BRANCH = 3

SPLITS = (A_Q, A_KV, A_KV,
          B_W, B_W, B_W,
          C_K, C_K, C_V, C_V,
          C_RANK, C_RANK,
          D_MODEL, D_MODEL, D_MODEL)
N_IN = sum(SPLITS)
SPLIT_IDX = tuple(int(i) for i in np.cumsum(SPLITS)[:-1])

kernel_name = "hybrid_gqa_natten_gla_macaron_encoder"


def rms_norm(x, gain):
    x32 = x.astype(jnp.float32)
    y = x32 * lax.rsqrt(jnp.mean(x32 * x32, axis=-1, keepdims=True) + EPS)
    return (y * gain.astype(jnp.float32)).astype(x.dtype)


def swiglu(x, w_in, w_out):
    g, u = jnp.split(x @ w_in, 2, axis=-1)
    return (jax.nn.silu(g) * u) @ w_out


def axial_rope(n_tok):
    t = jnp.arange(n_tok)
    pos_r = (t // GRID_W).astype(jnp.float32)
    pos_c = (t % GRID_W).astype(jnp.float32)
    half = HEAD_DIM // 2
    inv = ROPE_THETA ** (-jnp.arange(0, half, 2, dtype=jnp.float32) / half)
    ang = jnp.concatenate([pos_r[:, None] * inv, pos_c[:, None] * inv], axis=-1)
    return jnp.cos(ang), jnp.sin(ang)


def apply_rope(x, cos, sin):
    xp = x.astype(jnp.float32).reshape(*x.shape[:-1], HEAD_DIM // 2, 2)
    x1, x2 = xp[..., 0], xp[..., 1]
    c = cos[None, :, None, :]
    s = sin[None, :, None, :]
    out = jnp.stack([x1 * c - x2 * s, x1 * s + x2 * c], axis=-1)
    return out.reshape(x.shape).astype(x.dtype)


def mixer_a(q, k, v, qk_gain, cos, sin):
    bsz, n_tok, _ = q.shape
    q = q.reshape(bsz, n_tok, A_HEADS, HEAD_DIM)
    k = k.reshape(bsz, n_tok, A_KV_HEADS, HEAD_DIM)
    v = v.reshape(bsz, n_tok, A_KV_HEADS, HEAD_DIM)
    q = apply_rope(rms_norm(q, qk_gain[0]), cos, sin)
    k = apply_rope(rms_norm(k, qk_gain[1]), cos, sin)
    n_blk = n_tok // Q_BLOCK
    qb_all = q.reshape(bsz, n_blk, Q_BLOCK, A_KV_HEADS, A_GROUP, HEAD_DIM).transpose(1, 0, 2, 3, 4, 5)
    scale = HEAD_DIM ** -0.5

    def block(qb):
        s = jnp.einsum('bqkgd,bskd->bkgqs', qb, k, preferred_element_type=jnp.float32) * scale
        p = jax.nn.softmax(s, axis=-1).astype(v.dtype)
        return jnp.einsum('bkgqs,bskd->bqkgd', p, v)

    o = lax.map(block, qb_all)
    return o.transpose(1, 0, 2, 3, 4, 5).reshape(bsz, n_tok, A_Q)


def mixer_b(q, k, v, rpb):
    bsz, n_tok, _ = q.shape
    rows = n_tok // GRID_W
    wr = min(NA_ROWS, rows)
    q = q.reshape(bsz, rows, GRID_W, B_HEADS, HEAD_DIM) * (HEAD_DIM ** -0.5)
    k = k.reshape(bsz, rows, GRID_W, B_HEADS, HEAD_DIM)
    v = v.reshape(bsz, rows, GRID_W, B_HEADS, HEAD_DIM)
    cols = jnp.arange(GRID_W)
    col_start = jnp.clip(cols - NA_COLS // 2, 0, GRID_W - NA_COLS)
    col_idx = col_start[:, None] + jnp.arange(NA_COLS)[None, :]
    dc = col_idx - cols[:, None] + (NA_COLS - 1)

    def row_block(r):
        rs = jnp.clip(r - wr // 2, 0, rows - wr)
        kb = lax.dynamic_slice_in_dim(k, rs, wr, axis=1)
        vb = lax.dynamic_slice_in_dim(v, rs, wr, axis=1)
        kw = kb[:, :, col_idx]
        vw = vb[:, :, col_idx]
        dr = rs + jnp.arange(wr) - r + (NA_ROWS - 1)
        bias = rpb[:, dr[:, None, None], dc[None, :, :]]
        qr = lax.dynamic_index_in_dim(q, r, axis=1, keepdims=False)
        s = jnp.einsum('bqhd,bwqjhd->bhqwj', qr, kw, preferred_element_type=jnp.float32)
        s = s + bias.transpose(0, 2, 1, 3)[None].astype(jnp.float32)
        p = jax.nn.softmax(s.reshape(bsz, B_HEADS, GRID_W, wr * NA_COLS), axis=-1)
        p = p.reshape(bsz, B_HEADS, GRID_W, wr, NA_COLS).astype(v.dtype)
        return jnp.einsum('bhqwj,bwqjhd->bqhd', p, vw)

    o = lax.map(row_block, jnp.arange(rows))
    return o.transpose(1, 0, 2, 3, 4).reshape(bsz, n_tok, B_W)


def gla_scan(q, k, v, g):
    bsz, n_tok, n_h, dk = q.shape
    dv = v.shape[-1]
    n_ch = n_tok // C_CHUNK

    def to_chunks(t):
        return t.reshape(bsz, n_ch, C_CHUNK, n_h, t.shape[-1]).transpose(1, 0, 3, 2, 4)

    mask = jnp.tril(jnp.ones((C_CHUNK, C_CHUNK), dtype=bool))

    def step(state, inp):
        qi, ki, vi, gi = inp
        b = jnp.cumsum(gi, axis=-2)
        diff = b[:, :, :, None, :] - b[:, :, None, :, :]
        decay = jnp.exp(jnp.where(mask[:, :, None], diff, -jnp.inf))
        attn = jnp.einsum('bhid,bhjd,bhijd->bhij', qi, ki, decay)
        o = jnp.einsum('bhij,bhjv->bhiv', attn, vi) + jnp.einsum('bhid,bhdv->bhiv', qi * jnp.exp(b), state)
        b_last = b[:, :, -1:, :]
        state = jnp.exp(b_last[:, :, 0, :, None]) * state + jnp.einsum('bhjd,bhjv->bhdv', ki * jnp.exp(b_last - b), vi)
        return state, o

    state0 = jnp.zeros((bsz, n_h, dk, dv), jnp.float32)
    _, o = lax.scan(step, state0, (to_chunks(q), to_chunks(k), to_chunks(v), to_chunks(g)))
    return o.transpose(1, 0, 3, 2, 4).reshape(bsz, n_tok, n_h, dv)


def mixer_c(xq, xk, xv, xog, lr_f, lr_b, w_decay, b_decay, onorm):
    bsz, n_tok, _ = xq.shape
    f32 = jnp.float32
    q = xq.astype(f32).reshape(bsz, n_tok, C_HEADS, C_DK) * (C_DK ** -0.5)
    k = xk.astype(f32).reshape(bsz, n_tok, C_HEADS, C_DK)
    v = xv.astype(f32).reshape(bsz, n_tok, C_HEADS, C_DV)

    def log_decay(lr, w2, b2):
        z = lr.astype(f32) @ w2.astype(f32) + b2.astype(f32)
        return (jax.nn.log_sigmoid(z) / C_TAU).reshape(bsz, n_tok, C_HEADS, C_DK)

    g_f = log_decay(lr_f, w_decay[0], b_decay[0])
    g_b = log_decay(lr_b, w_decay[1], b_decay[1])
    flip = lambda t: jnp.flip(t, axis=1)
    o_f = gla_scan(q, k, v, g_f)
    o_b = flip(gla_scan(flip(q), flip(k), flip(v), flip(g_b)))
    o = rms_norm(o_f + o_b, onorm).reshape(bsz, n_tok, C_V)
    o = o * jax.nn.silu(xog.astype(f32))
    return o.astype(xq.dtype)


def token_mixing(u, w_in, gate_bias, qk_norm_a, rpb_b, w_decay_c, b_decay_c, onorm_c,
                 w_br_a, w_br_b, w_br_c, w_out, cos, sin):
    proj = u @ w_in
    (aq, ak, av, bq, bk, bv, cq, ck, cv, cog, clf, clb, ga, gb, gc) = jnp.split(proj, SPLIT_IDX, axis=-1)
    ya = mixer_a(aq, ak, av, qk_norm_a, cos, sin) @ w_br_a
    yb = mixer_b(bq, bk, bv, rpb_b) @ w_br_b
    yc = mixer_c(cq, ck, cv, cog, clf, clb, w_decay_c, b_decay_c, onorm_c) @ w_br_c
    merged = (jax.nn.sigmoid(ga + gate_bias[0]) * ya
              + jax.nn.sigmoid(gb + gate_bias[1]) * yb
              + jax.nn.sigmoid(gc + gate_bias[2]) * yc)
    return merged @ w_out


def trunk(x, norm_gains, w_in, gate_bias, qk_norm_a, rpb_b, w_decay_c, b_decay_c, onorm_c,
          w_br_a, w_br_b, w_br_c, w_out, w_ffn1_in, w_ffn1_out, w_ffn2_in, w_ffn2_out):
    cos, sin = axial_rope(x.shape[1])
    for l in range(DEPTH):
        ng = norm_gains[l]
        x = x + 0.5 * rms_norm(swiglu(rms_norm(x, ng[0]), w_ffn1_in[l], w_ffn1_out[l]), ng[1])
        mix = token_mixing(rms_norm(x, ng[2]), w_in[l], gate_bias[l], qk_norm_a[l], rpb_b[l],
                           w_decay_c[l], b_decay_c[l], onorm_c[l], w_br_a[l], w_br_b[l], w_br_c[l],
                           w_out[l], cos, sin)
        x = x + rms_norm(mix, ng[3])
        x = x + 0.5 * rms_norm(swiglu(rms_norm(x, ng[4]), w_ffn2_in[l], w_ffn2_out[l]), ng[5])
    return x


def setup_inputs(seed: int = 0) -> dict:
    key = jax.random.key(seed)
    ks = jax.random.split(key, 20)
    f32 = jnp.float32

    def dense(k, shape, fan_in):
        return jax.random.normal(k, shape, f32) * (fan_in ** -0.5)

    return {
        "x_prompt": jax.random.normal(ks[0], (BATCH, SEQ, D_MODEL), f32),
        "x_sample": jax.random.normal(ks[1], (DEC_BATCH, DEC_SEQ, D_MODEL), f32),
        "norm_gains": 1.0 + 0.02 * jax.random.normal(ks[2], (DEPTH, 6, D_MODEL), f32),
        "w_in": dense(ks[3], (DEPTH, D_MODEL, N_IN), D_MODEL),
        "gate_bias": 0.02 * jax.random.normal(ks[4], (DEPTH, N_BRANCH, D_MODEL), f32),
        "qk_norm_a": 1.0 + 0.02 * jax.random.normal(ks[5], (DEPTH, 2, HEAD_DIM), f32),
        "rpb_b": 0.1 * jax.random.normal(ks[6], (DEPTH, B_HEADS, 2 * NA_ROWS - 1, 2 * NA_COLS - 1), f32),
        "w_decay_c": dense(ks[7], (DEPTH, 2, C_RANK, C_K), C_RANK),
        "b_decay_c": 0.1 * jax.random.normal(ks[8], (DEPTH, 2, C_K), f32),
        "onorm_c": 1.0 + 0.02 * jax.random.normal(ks[9], (DEPTH, C_DV), f32),
        "w_br_a": dense(ks[10], (DEPTH, A_Q, D_MODEL), A_Q),
        "w_br_b": dense(ks[11], (DEPTH, B_W, D_MODEL), B_W),
        "w_br_c": dense(ks[12], (DEPTH, C_V, D_MODEL), C_V),
        "w_out": dense(ks[13], (DEPTH, D_MODEL, D_MODEL), D_MODEL),
        "w_ffn1_in": dense(ks[14], (DEPTH, D_MODEL, 2 * D_FF), D_MODEL),
        "w_ffn1_out": dense(ks[15], (DEPTH, D_FF, D_MODEL), D_FF),
        "w_ffn2_in": dense(ks[16], (DEPTH, D_MODEL, 2 * D_FF), D_MODEL),
        "w_ffn2_out": dense(ks[17], (DEPTH, D_FF, D_MODEL), D_FF),
    }


def reference(x_prompt, x_sample, norm_gains, w_in, gate_bias, qk_norm_a, rpb_b, w_decay_c, b_decay_c,
              onorm_c, w_br_a, w_br_b, w_br_c, w_out, w_ffn1_in, w_ffn1_out, w_ffn2_in, w_ffn2_out):
    y_prompt = trunk(x_prompt, norm_gains, w_in, gate_bias, qk_norm_a, rpb_b, w_decay_c, b_decay_c, onorm_c,
                     w_br_a, w_br_b, w_br_c, w_out, w_ffn1_in, w_ffn1_out, w_ffn2_in, w_ffn2_out)
    y_sample = trunk(x_sample, norm_gains, w_in, gate_bias, qk_norm_a, rpb_b, w_decay_c, b_decay_c, onorm_c,
                     w_br_a, w_br_b, w_br_c, w_out, w_ffn1_in, w_ffn1_out, w_ffn2_in, w_ffn2_out)
    return (y_prompt, y_sample)
```

```cpp
#include <hip/hip_runtime.h>
#include <cstdio>
#include <cstdint>

#ifndef ONE_LAUNCH
#define ONE_LAUNCH 1
#endif
#ifndef WGM_FI
#define WGM_FI 4
#endif
#ifndef WGM_FO
#define WGM_FO 2
#endif
#ifndef WGM_M1
#define WGM_M1 4
#endif
#ifndef WGM_M45
#define WGM_M45 4
#endif
#ifndef ATT_DUP
#define ATT_DUP 0
#endif
#ifndef DUP_MASK
#define DUP_MASK 0u
#endif
#ifndef PHASE_MASK
#define PHASE_MASK 0xFFFFFFFFu
#endif

#define GAS __attribute__((address_space(1)))
#define LAS __attribute__((address_space(3)))
typedef unsigned short bf16_t;
typedef short bf16x8 __attribute__((ext_vector_type(8)));
typedef short s16x4 __attribute__((ext_vector_type(4)));
typedef float f32x4 __attribute__((ext_vector_type(4)));
typedef float f32x2 __attribute__((ext_vector_type(2)));
typedef float f32x16 __attribute__((ext_vector_type(16)));
typedef unsigned u32x4 __attribute__((ext_vector_type(4)));
typedef unsigned u32x2 __attribute__((ext_vector_type(2)));

constexpr int M = 49152;
constexpr int SEQ = 2048, NSEQ = 24;
constexpr int D = 2048, FF = 5632, DEPTH = 4;
constexpr int NPROJ = 4608;
constexpr int NGATE = 6144;
constexpr int NIN = 10784, NIN_PAD = 11008;
constexpr int C_AQ = 0, C_AK = 1024, C_AV = 1280, C_BQ = 1536, C_BK = 2048, C_BV = 2560, C_CQ = 3072, C_CK = 3328, C_CV = 3584, C_OG = 4096;
constexpr int C_OC = 3072;
constexpr float EPS = 1e-6f;

constexpr size_t MiB = 1u << 20;
constexpr size_t WS_CTL = 0, CTL_BYTES = 1 * MiB;
constexpr size_t WS_WIN = 2 * MiB;
constexpr size_t WS_WF1I = 45 * MiB;
constexpr size_t WS_WF1O = 89 * MiB;
constexpr size_t WS_WF2I = 111 * MiB;
constexpr size_t WS_WF2O = 155 * MiB;
constexpr size_t WS_WBRA = 177 * MiB;
constexpr size_t WS_WBRB = 181 * MiB;
constexpr size_t WS_WBRC = 183 * MiB;
constexpr size_t WS_WOUT = 185 * MiB;
constexpr size_t WS_XN = 193 * MiB;
constexpr size_t WS_BIG = 385 * MiB;
constexpr size_t WS_PROJ = WS_BIG;
constexpr size_t WS_GATES = WS_BIG + 432 * MiB;
constexpr size_t WS_LR = WS_BIG + 1008 * MiB;
constexpr size_t WS_H = WS_BIG;
constexpr size_t WS_Y = WS_BIG + 528 * MiB;
constexpr size_t WS_OFB = WS_BIG + 1014 * MiB;
constexpr size_t WS_OC = WS_OFB + 48 * MiB;
constexpr size_t WS_MG = WS_OFB + 96 * MiB;
constexpr size_t WS_RSTD = WS_MG + 192 * MiB;
constexpr size_t WS_OA = WS_RSTD + 1 * MiB;
constexpr size_t WS_END = WS_OA + 96 * MiB;
constexpr int CW_Q = 32768;
static_assert(WS_Y + (size_t)M * D * 4 <= WS_LR, "Y inside GATES region");
constexpr int CW_BAR = 4096;

__device__ __forceinline__ unsigned cvt_pk_bf16(float lo, float hi) { unsigned r; asm volatile("v_cvt_pk_bf16_f32 %0, %1, %2" : "=v"(r) : "v"(lo), "v"(hi)); return r; }
__device__ __forceinline__ float bflo(unsigned w) { return __uint_as_float(w << 16); }
__device__ __forceinline__ float bfhi(unsigned w) { return __uint_as_float(w & 0xffff0000u); }
__device__ __forceinline__ float bf2f(bf16_t v) { return __uint_as_float(((unsigned)v) << 16); }
__device__ __forceinline__ bf16_t f2bf(float f) { unsigned u = __float_as_uint(f); return (bf16_t)((u + 0x7fffu + ((u >> 16) & 1u)) >> 16); }
__device__ __forceinline__ float wave_sum(float v) {
#pragma unroll
    for (int o = 1; o < 64; o <<= 1) v += __shfl_xor(v, o);
    return v;
}
__device__ __forceinline__ float wave_max(float v) {
#pragma unroll
    for (int o = 1; o < 64; o <<= 1) v = fmaxf(v, __shfl_xor(v, o));
    return v;
}
__device__ __forceinline__ int opaque_tid() { int t = threadIdx.x; asm volatile("" : "+v"(t)); return t; }
__device__ __forceinline__ unsigned char* opq(unsigned char* p) { asm volatile("" : "+s"(p)); return p; }
__device__ __forceinline__ const float* lds_ptr(volatile LAS unsigned long long* tab, int i) { const unsigned long long v = tab[i];
    const unsigned lo = __builtin_amdgcn_readfirstlane((unsigned)v), hi = __builtin_amdgcn_readfirstlane((unsigned)(v >> 32)); return (const float*)(((unsigned long long)hi << 32) | lo); }
#define LDS_WAIT() asm volatile("s_waitcnt lgkmcnt(0)" ::: "memory")
#define VM_WAIT() asm volatile("s_waitcnt vmcnt(0)" ::: "memory")

namespace pg8 {
constexpr int BM = 256, BK = 64, HALF = 128, HTB = HALF * BK * 2, STAGE_BYTES = 8 * HTB, NXCD = 8;
__host__ __device__ __forceinline__ int lds_byte(int r, int c) { const int st = (r >> 4) * 2 + (c >> 5), rr = r & 15, cc = c & 31, ob = rr * 64 + cc * 2; return st * 1024 + (ob ^ (((ob >> 9) & 1) << 5)); }
__host__ __device__ __forceinline__ void stage_rc(int b, int& R, int& C) { const int st = b / 1024, sb = b % 1024, swz = sb ^ (((sb >> 9) & 1) << 5); R = (st >> 1) * 16 + swz / 64; C = (st & 1) * 32 + (swz % 64) / 2; }
__host__ __device__ __forceinline__ int perm32(int rho) { const int n = rho >> 4, i = rho & 15; return 8 * (i >> 2) + 4 * n + (i & 3); }

struct Unit { int pm, pn; };
struct Gemm { const bf16_t* A; const bf16_t* Bt; int M, N, K, lda; };

struct StaticOrder {
    int nM, nN, nwg, G, c, WGM;
    __host__ __device__ void init(int M_, int N_, int G_, int c_, int wgm_ = 4) { nM = M_ / BM; nN = N_ / BM; nwg = nM * nN; G = G_; c = c_; WGM = wgm_; }
    __host__ __device__ bool next(int i, Unit& u) const {
        const long L = (long)i * G + c; if (L >= nwg) return false;
        int wgid = (int)L; { const int q = nwg / NXCD, r = nwg % NXCD, xcd = wgid % NXCD, off = wgid / NXCD; wgid = (xcd < r ? xcd * (q + 1) : r * (q + 1) + (xcd - r) * q) + off; }
        const int nig = WGM * nN, gid = wgid / nig, fm = gid * WGM, gsz = (nM - fm) < WGM ? (nM - fm) : WGM;
        u.pm = fm + ((wgid % nig) % gsz); u.pn = (wgid % nig) / gsz; return true;
    }
    __device__ __forceinline__ void a_ready(const Unit&) const {}
    __device__ __forceinline__ void done(const Unit&) const {}
};

struct EpiF32 {
    static constexpr bool PERM = false, AFTER_DRAIN = false;
    float* C; int ldc;
    __device__ __forceinline__ void operator()(const f32x4 (&acc)[2][2][4][2], const Unit& u, int wr, int wc, int fr, int fq) const {
        const int row0 = u.pm * BM + wr * 64 + fr, col0 = u.pn * BM + wc * 32 + 4 * fq;
#pragma unroll
        for (int ai = 0; ai < 2; ++ai)
#pragma unroll
            for (int m = 0; m < 4; ++m) { float* rowp = C + (size_t)(row0 + ai * HALF + m * 16) * ldc + col0;
#pragma unroll
                for (int bj = 0; bj < 2; ++bj)
#pragma unroll
                    for (int n = 0; n < 2; ++n) *(f32x4*)(rowp + bj * HALF + n * 16) = acc[ai][bj][m][n]; }
    }
};
struct EpiBf16Plain {
    static constexpr bool PERM = true, AFTER_DRAIN = false;
    bf16_t* C; int ldc;
    __device__ __forceinline__ void operator()(const f32x4 (&acc)[2][2][4][2], const Unit& u, int wr, int wc, int fr, int fq) const {
        const int row0 = u.pm * BM + wr * 64 + fr, col0 = u.pn * BM + wc * 32 + 8 * fq;
#pragma unroll
        for (int ai = 0; ai < 2; ++ai)
#pragma unroll
            for (int m = 0; m < 4; ++m) { bf16_t* p = C + (size_t)(row0 + ai * HALF + m * 16) * ldc + col0;
#pragma unroll
                for (int bj = 0; bj < 2; ++bj) { const f32x4 v0 = acc[ai][bj][m][0], v1 = acc[ai][bj][m][1];
                    u32x4 w; w.x = cvt_pk_bf16(v0[0], v0[1]); w.y = cvt_pk_bf16(v0[2], v0[3]); w.z = cvt_pk_bf16(v1[0], v1[1]); w.w = cvt_pk_bf16(v1[2], v1[3]);
                    *(u32x4*)(p + bj * HALF) = w; } }
    }
};
__device__ __forceinline__ float silu_f(float g) { return g * __builtin_amdgcn_rcpf(1.0f + __builtin_amdgcn_exp2f(-1.4426950408889634f * g)); }
__device__ __forceinline__ float sigmoid_f(float g) { return __builtin_amdgcn_rcpf(1.0f + __builtin_amdgcn_exp2f(-1.4426950408889634f * g)); }
struct EpiSwiGLU {
    static constexpr bool PERM = true, AFTER_DRAIN = false;
    bf16_t* H; const float* rstd;
    __device__ __forceinline__ void operator()(const f32x4 (&acc)[2][2][4][2], const Unit& u, int wr, int wc, int fr, int fq) const {
        const int row0 = u.pm * BM + wr * 64 + fr, col0 = u.pn * HALF + wc * 32 + 8 * fq;
#pragma unroll
        for (int ai = 0; ai < 2; ++ai)
#pragma unroll
            for (int m = 0; m < 4; ++m) { bf16_t* p = H + (size_t)(row0 + ai * HALF + m * 16) * FF + col0; const float rs = rstd[row0 + ai * HALF + m * 16];
                const f32x4 g0 = acc[ai][0][m][0] * rs, g1 = acc[ai][0][m][1] * rs, u0 = acc[ai][1][m][0] * rs, u1 = acc[ai][1][m][1] * rs;
                u32x4 w; w.x = cvt_pk_bf16(silu_f(g0[0]) * u0[0], silu_f(g0[1]) * u0[1]); w.y = cvt_pk_bf16(silu_f(g0[2]) * u0[2], silu_f(g0[3]) * u0[3]);
                w.z = cvt_pk_bf16(silu_f(g1[0]) * u1[0], silu_f(g1[1]) * u1[1]); w.w = cvt_pk_bf16(silu_f(g1[2]) * u1[2], silu_f(g1[3]) * u1[3]);
                *(u32x4*)p = w; }
    }
};
struct EpiProj {
    static constexpr bool PERM = true, AFTER_DRAIN = false;
    bf16_t* PROJ; bf16_t* GATES; float* LR; const float* gbias; const float* rstd;
    __device__ __forceinline__ void operator()(const f32x4 (&acc)[2][2][4][2], const Unit& u, int wr, int wc, int fr, int fq) const {
        const int row0 = u.pm * BM + wr * 64 + fr;
        if (u.pn < 18) {
            const int col0 = u.pn * BM + wc * 32 + 8 * fq;
#pragma unroll
            for (int ai = 0; ai < 2; ++ai)
#pragma unroll
                for (int m = 0; m < 4; ++m) { bf16_t* p = PROJ + (size_t)(row0 + ai * HALF + m * 16) * NPROJ + col0; const float rs = rstd[row0 + ai * HALF + m * 16];
#pragma unroll
                    for (int bj = 0; bj < 2; ++bj) { const f32x4 v0 = acc[ai][bj][m][0] * rs, v1 = acc[ai][bj][m][1] * rs;
                        u32x4 w; w.x = cvt_pk_bf16(v0[0], v0[1]); w.y = cvt_pk_bf16(v0[2], v0[3]); w.z = cvt_pk_bf16(v1[0], v1[1]); w.w = cvt_pk_bf16(v1[2], v1[3]);
                        *(u32x4*)(p + bj * HALF) = w; } }
        } else if (u.pn < 42) {
            const int col0 = (u.pn - 18) * BM + wc * 32 + 8 * fq;
#pragma unroll
            for (int bj = 0; bj < 2; ++bj) {
                const f32x4 b0 = *(const f32x4*)(gbias + col0 + bj * HALF), b1 = *(const f32x4*)(gbias + col0 + bj * HALF + 4);
#pragma unroll
                for (int ai = 0; ai < 2; ++ai)
#pragma unroll
                    for (int m = 0; m < 4; ++m) { bf16_t* p = GATES + (size_t)(row0 + ai * HALF + m * 16) * NGATE + col0 + bj * HALF; const float rs = rstd[row0 + ai * HALF + m * 16];
                        const f32x4 v0 = acc[ai][bj][m][0] * rs + b0, v1 = acc[ai][bj][m][1] * rs + b1;
                        u32x4 w; w.x = cvt_pk_bf16(sigmoid_f(v0[0]), sigmoid_f(v0[1])); w.y = cvt_pk_bf16(sigmoid_f(v0[2]), sigmoid_f(v0[3]));
                        w.z = cvt_pk_bf16(sigmoid_f(v1[0]), sigmoid_f(v1[1])); w.w = cvt_pk_bf16(sigmoid_f(v1[2]), sigmoid_f(v1[3]));
                        *(u32x4*)p = w; }
                asm volatile("" ::: "memory"); }
        } else {
            if (wc == 0) {
#pragma unroll
                for (int ai = 0; ai < 2; ++ai)
#pragma unroll
                    for (int m = 0; m < 4; ++m) { float* p = LR + (size_t)(row0 + ai * HALF + m * 16) * 32 + 8 * fq; const float rs = rstd[row0 + ai * HALF + m * 16];
                        *(f32x4*)p = acc[ai][0][m][0] * rs; *(f32x4*)(p + 4) = acc[ai][0][m][1] * rs; }
            }
        }
    }
};
template <bool FIRST> struct EpiMerge {
    static constexpr bool PERM = true, AFTER_DRAIN = false;
    const bf16_t* G; bf16_t* MG;
    __device__ __forceinline__ void operator()(const f32x4 (&acc)[2][2][4][2], const Unit& u, int wr, int wc, int fr, int fq) const {
        const int row0 = u.pm * BM + wr * 64 + fr, col0 = u.pn * BM + wc * 32 + 8 * fq;
#pragma unroll
        for (int ai = 0; ai < 2; ++ai)
#pragma unroll
            for (int m = 0; m < 4; ++m) { const size_t r = (size_t)(row0 + ai * HALF + m * 16);
#pragma unroll
                for (int bj = 0; bj < 2; ++bj) { const u32x4 g = *(const u32x4*)(G + r * NGATE + col0 + bj * HALF);
                    const f32x4 v0 = acc[ai][bj][m][0], v1 = acc[ai][bj][m][1];
                    float o[8] = { bflo(g.x) * v0[0], bfhi(g.x) * v0[1], bflo(g.y) * v0[2], bfhi(g.y) * v0[3], bflo(g.z) * v1[0], bfhi(g.z) * v1[1], bflo(g.w) * v1[2], bfhi(g.w) * v1[3] };
                    bf16_t* p = MG + r * D + col0 + bj * HALF;
                    if (!FIRST) { const u32x4 old = *(const u32x4*)p;
                        o[0] += bflo(old.x); o[1] += bfhi(old.x); o[2] += bflo(old.y); o[3] += bfhi(old.y); o[4] += bflo(old.z); o[5] += bfhi(old.z); o[6] += bflo(old.w); o[7] += bfhi(old.w); }
                    u32x4 w; w.x = cvt_pk_bf16(o[0], o[1]); w.y = cvt_pk_bf16(o[2], o[3]); w.z = cvt_pk_bf16(o[4], o[5]); w.w = cvt_pk_bf16(o[6], o[7]);
                    *(u32x4*)p = w; }
                asm volatile("" ::: "memory"); }
    }
};

template <class Epi, class Sched, bool ALIGN_EPI = false, bool SP2 = false>
__device__ __forceinline__ void gemm_phase(LAS unsigned char* lds, const Gemm g, const Sched& S, const Epi& E) {
    const int tid = opaque_tid(), wid = __builtin_amdgcn_readfirstlane(tid >> 6), lane = tid & 63, wr = wid >> 2, wc = wid & 3, fr = lane & 15, fq = lane >> 4;
    const int K = g.K, nt = K / BK, lda = g.lda;
    unsigned voffA[2], voffB[2];
#pragma unroll
    for (int i = 0; i < 2; ++i) { int R, C; stage_rc(tid * 16 + i * 8192, R, C); const int Rb = Epi::PERM ? ((R & ~31) + perm32(R & 31)) : R;
        voffA[i] = (unsigned)(R * lda + C) * 2u; voffB[i] = (unsigned)(Rb * K + C) * 2u; }
    const unsigned kstep = (unsigned)(BK * 2);
    const unsigned hstepA = (unsigned)HALF * (unsigned)lda * 2u, hstepB = (unsigned)HALF * (unsigned)K * 2u;
    const unsigned tstepA = 2u * hstepA, tstepB = 2u * hstepB;
    const unsigned ldsw = (unsigned)wid * 1024u;
    const int aoff = lds_byte(wr * 64 + fr, fq * 8), boff = lds_byte(wc * 32 + fr, fq * 8);
    const char* const baseA = (const char*)g.A; const char* const baseB = (const char*)g.Bt;
#define PG8_SA(b, h) (((b) * 2 + (h)) * HTB)
#define PG8_SB(b, h) ((4 + (b) * 2 + (h)) * HTB)
#define PG8_STAGE(bufoff, gbase, goff, voff) do { _Pragma("unroll") for (int _i = 0; _i < 2; ++_i) \
        __builtin_amdgcn_global_load_lds((const unsigned*)((gbase) + (size_t)(unsigned)((goff) + (voff)[_i])), (LAS unsigned*)(lds + (bufoff) + ldsw + _i * 8192), 16, 0, 0); } while (0)
#define PG8_LDA(dst, b, h) do { _Pragma("unroll") for (int m = 0; m < 4; ++m) _Pragma("unroll") for (int k = 0; k < 2; ++k) dst[m][k] = *(const LAS bf16x8*)(lds + PG8_SA(b, h) + aoff + m * 2048 + k * 1024); } while (0)
#define PG8_LDB(dst, b, h) do { _Pragma("unroll") for (int n = 0; n < 2; ++n) _Pragma("unroll") for (int k = 0; k < 2; ++k) dst[n][k] = *(const LAS bf16x8*)(lds + PG8_SB(b, h) + boff + n * 2048 + k * 1024); } while (0)
#define PG8_MMA(ai, bj, At, Bt) do { __builtin_amdgcn_s_setprio(1); _Pragma("unroll") for (int m = 0; m < 4; ++m) _Pragma("unroll") for (int n = 0; n < 2; ++n) _Pragma("unroll") for (int k = 0; k < 2; ++k) \
        acc[ai][bj][m][n] = __builtin_amdgcn_mfma_f32_16x16x32_bf16(Bt[n][k], At[m][k], acc[ai][bj][m][n], 0, 0, 0); __builtin_amdgcn_s_setprio(0); } while (0)
#define PG8_WAIT_V(n) asm volatile("s_waitcnt vmcnt(" #n ")" ::: "memory")
#define PG8_WAIT_L(n) asm volatile("s_waitcnt lgkmcnt(" #n ")" ::: "memory")
#define PG8_BAR __builtin_amdgcn_s_barrier()
#define PG8_SCHED __builtin_amdgcn_sched_barrier(0)
    Unit cur, nxt; int ui = 0;
    if (!S.next(0, cur)) return;
    f32x4 acc[2][2][4][2];
#pragma unroll
    for (int a = 0; a < 2; ++a)
#pragma unroll
        for (int b = 0; b < 2; ++b)
#pragma unroll
            for (int m = 0; m < 4; ++m)
#pragma unroll
                for (int n = 0; n < 2; ++n) acc[a][b][m][n] = (f32x4){0.f, 0.f, 0.f, 0.f};
    bf16x8 At[4][2], B0[2][2], B1[2][2];
    unsigned cA = (unsigned)cur.pm * tstepA, cB = (unsigned)cur.pn * tstepB;
    S.a_ready(cur);
    if constexpr (SP2) {
        PG8_STAGE(PG8_SB(0, 0), baseB, cB, voffB); PG8_STAGE(PG8_SB(0, 1), baseB, cB + hstepB, voffB); PG8_STAGE(PG8_SA(0, 0), baseA, cA, voffA); PG8_STAGE(PG8_SA(0, 1), baseA, cA + hstepA, voffA);
        if (wr == 1) PG8_BAR;
        PG8_WAIT_V(2); PG8_BAR;
        PG8_STAGE(PG8_SB(1, 0), baseB, cB + kstep, voffB); PG8_STAGE(PG8_SA(1, 0), baseA, cA + kstep, voffA); PG8_STAGE(PG8_SB(1, 1), baseB, cB + hstepB + kstep, voffB);
        PG8_WAIT_V(6); PG8_BAR;
    } else {
        PG8_STAGE(PG8_SB(0, 0), baseB, cB, voffB); PG8_STAGE(PG8_SA(0, 0), baseA, cA, voffA); PG8_STAGE(PG8_SB(0, 1), baseB, cB + hstepB, voffB); PG8_STAGE(PG8_SA(0, 1), baseA, cA + hstepA, voffA);
        if (wr == 1) PG8_BAR;
        PG8_WAIT_V(4); PG8_BAR;
        PG8_STAGE(PG8_SB(1, 0), baseB, cB + kstep, voffB); PG8_STAGE(PG8_SA(1, 0), baseA, cA + kstep, voffA); PG8_STAGE(PG8_SB(1, 1), baseB, cB + hstepB + kstep, voffB);
        PG8_WAIT_V(6); PG8_BAR;
    }
    for (;;) {
        const bool has_next = S.next(ui + 1, nxt);
        const unsigned nA = has_next ? (unsigned)nxt.pm * tstepA : cA, nB = has_next ? (unsigned)nxt.pn * tstepB : cB;
        for (int t = 0; t < nt; t += 2) {
            const bool last = (t == nt - 2);
            const unsigned a1 = cA + (unsigned)(t + 1) * kstep;
            const unsigned a2 = last ? nA : cA + (unsigned)(t + 2) * kstep, b2 = last ? nB : cB + (unsigned)(t + 2) * kstep;
            const unsigned a3 = a2 + kstep, b3 = b2 + kstep;
            if (last && has_next) S.a_ready(nxt);
            if constexpr (SP2) {
            PG8_LDB(B0, 0, 0); PG8_LDB(B1, 0, 1); PG8_SCHED; PG8_LDA(At, 0, 0); PG8_STAGE(PG8_SA(1, 1), baseA, a1 + hstepA, voffA);
            PG8_WAIT_V(8); PG8_WAIT_L(0); PG8_BAR; PG8_MMA(0, 0, At, B0); PG8_MMA(0, 1, At, B1); PG8_BAR; PG8_SCHED;
            PG8_LDA(At, 0, 1); PG8_STAGE(PG8_SB(0, 0), baseB, b2, voffB); PG8_STAGE(PG8_SB(0, 1), baseB, b2 + hstepB, voffB); PG8_STAGE(PG8_SA(0, 0), baseA, a2, voffA);
            PG8_WAIT_V(8); PG8_WAIT_L(0); PG8_BAR; PG8_MMA(1, 0, At, B0); PG8_MMA(1, 1, At, B1); PG8_BAR; PG8_SCHED;
            PG8_LDB(B0, 1, 0); PG8_LDB(B1, 1, 1); PG8_SCHED; PG8_LDA(At, 1, 0); PG8_STAGE(PG8_SA(0, 1), baseA, a2 + hstepA, voffA);
            PG8_WAIT_V(8); PG8_WAIT_L(0); PG8_BAR; PG8_MMA(0, 0, At, B0); PG8_MMA(0, 1, At, B1); PG8_BAR; PG8_SCHED;
            PG8_LDA(At, 1, 1); PG8_STAGE(PG8_SB(1, 0), baseB, b3, voffB); PG8_STAGE(PG8_SB(1, 1), baseB, b3 + hstepB, voffB); PG8_STAGE(PG8_SA(1, 0), baseA, a3, voffA);
            PG8_WAIT_V(8); PG8_WAIT_L(0); PG8_BAR; PG8_MMA(1, 0, At, B0); PG8_MMA(1, 1, At, B1); PG8_BAR; PG8_SCHED;
            } else {
            PG8_LDB(B0, 0, 0); PG8_SCHED; PG8_LDA(At, 0, 0); PG8_STAGE(PG8_SA(1, 1), baseA, a1 + hstepA, voffA);
            PG8_WAIT_L(8); PG8_BAR; PG8_WAIT_L(0); PG8_MMA(0, 0, At, B0); PG8_BAR; PG8_SCHED;
            PG8_LDB(B1, 0, 1); PG8_STAGE(PG8_SB(0, 0), baseB, b2, voffB);
            PG8_BAR; PG8_WAIT_L(0); PG8_MMA(0, 1, At, B1); PG8_BAR;
            PG8_LDA(At, 0, 1); PG8_STAGE(PG8_SA(0, 0), baseA, a2, voffA);
            PG8_BAR; PG8_WAIT_L(0); PG8_MMA(1, 0, At, B0); PG8_BAR; PG8_SCHED;
            PG8_STAGE(PG8_SB(0, 1), baseB, b2 + hstepB, voffB);
            PG8_WAIT_V(6); PG8_BAR; PG8_MMA(1, 1, At, B1); PG8_BAR;
            PG8_LDB(B0, 1, 0); PG8_SCHED; PG8_LDA(At, 1, 0); PG8_STAGE(PG8_SA(0, 1), baseA, a2 + hstepA, voffA);
            PG8_WAIT_L(8); PG8_BAR; PG8_WAIT_L(0); PG8_MMA(0, 0, At, B0); PG8_BAR; PG8_SCHED;
            PG8_LDB(B1, 1, 1); PG8_STAGE(PG8_SB(1, 0), baseB, b3, voffB);
            PG8_BAR; PG8_WAIT_L(0); PG8_MMA(0, 1, At, B1); PG8_BAR;
            PG8_LDA(At, 1, 1); PG8_STAGE(PG8_SA(1, 0), baseA, a3, voffA);
            PG8_BAR; PG8_WAIT_L(0); PG8_MMA(1, 0, At, B0); PG8_BAR; PG8_SCHED;
            PG8_STAGE(PG8_SB(1, 1), baseB, b3 + hstepB, voffB);
            PG8_WAIT_V(6); PG8_BAR; PG8_MMA(1, 1, At, B1); PG8_BAR;
            }
        }
        if constexpr (ALIGN_EPI) { if (wr == 0) PG8_BAR; }
        if constexpr (!Epi::AFTER_DRAIN) { E(acc, cur, wr, wc, fr, fq); S.done(cur); }
        if (!has_next) break;
#pragma unroll
        for (int a = 0; a < 2; ++a)
#pragma unroll
            for (int b = 0; b < 2; ++b)
#pragma unroll
                for (int m = 0; m < 4; ++m)
#pragma unroll
                    for (int n = 0; n < 2; ++n) acc[a][b][m][n] = (f32x4){0.f, 0.f, 0.f, 0.f};
        cur = nxt; cA = nA; cB = nB; ++ui;
        if constexpr (ALIGN_EPI) { if (wr == 1) PG8_BAR; }
    }
    PG8_WAIT_V(0);
    if constexpr (!ALIGN_EPI) { if (wr == 0) PG8_BAR; }
    PG8_BAR;
#undef PG8_SA
#undef PG8_SB
#undef PG8_STAGE
#undef PG8_LDA
#undef PG8_LDB
#undef PG8_MMA
#undef PG8_WAIT_V
#undef PG8_WAIT_L
#undef PG8_BAR
#undef PG8_SCHED
}
}

namespace att {
constexpr int DH = 128, NW = 8, QBLK = 32, KVBLK = 64;
constexpr float SCALE = 0.088388347648318440f;
constexpr float THR = 8.f;
constexpr int LD = NPROJ, LDO = 1024;
constexpr size_t SHM_V = KVBLK * DH * 2, SHM_K = KVBLK * DH * 2, SHM_ATTN = 2 * SHM_V + 2 * SHM_K + NW * 64 * 4;
#define KSWZ(row, colB) ((row) * 256 + ((colB) ^ (((row) & 7) << 4)))
#define SBAR() __builtin_amdgcn_sched_barrier(0)
__device__ __forceinline__ int crow(int r, int hi) { return (r & 3) + 8 * (r >> 2) + 4 * hi; }
__device__ __forceinline__ void partialSM(f32x16& p0, f32x16& p1, float& m_reg, float& mn, float& alpha) {
  constexpr float C = SCALE * 1.4426950408889634f;
  float pmax = p0[0];
#pragma unroll
  for (int r = 1; r < 16; ++r) pmax = fmaxf(pmax, p0[r]);
#pragma unroll
  for (int r = 0; r < 16; ++r) pmax = fmaxf(pmax, p1[r]);
  { auto rr = __builtin_amdgcn_permlane32_swap(__float_as_uint(pmax), __float_as_uint(pmax), false, false);
    pmax = fmaxf(__uint_as_float(rr[0]), __uint_as_float(rr[1])); }
  if (__builtin_expect(__all(pmax - m_reg <= THR / SCALE), 1)) { mn = m_reg; alpha = 1.f; }
  else { mn = fmaxf(m_reg, pmax); alpha = __builtin_amdgcn_exp2f((m_reg - mn) * C); m_reg = mn; }
  float mnC = -mn * C;
#pragma unroll
  for (int r = 0; r < 16; ++r) p0[r] = fmaf(p0[r], C, mnC);
#pragma unroll
  for (int r = 0; r < 16; ++r) p1[r] = fmaf(p1[r], C, mnC);
#pragma unroll
  for (int r = 0; r < 16; ++r) p0[r] = __builtin_amdgcn_exp2f(p0[r]);
}
__device__ __forceinline__ void finishSM(f32x16& p0, f32x16& p1, float alpha, float& l_reg, bf16x8& pa0, bf16x8& pa1, bf16x8& pa2, bf16x8& pa3) {
#pragma unroll
  for (int r = 0; r < 16; ++r) p1[r] = __builtin_amdgcn_exp2f(p1[r]);
  float ps = 0;
#pragma unroll
  for (int r = 0; r < 16; ++r) ps += p0[r];
#pragma unroll
  for (int r = 0; r < 16; ++r) ps += p1[r];
  { auto rr = __builtin_amdgcn_permlane32_swap(__float_as_uint(ps), __float_as_uint(ps), false, false);
    ps = __uint_as_float(rr[0]) + __uint_as_float(rr[1]); }
  l_reg = l_reg * alpha + ps;
#define PK4(P, BASE, OUT) do { unsigned a0 = cvt_pk_bf16(P[BASE + 0], P[BASE + 1]), a1 = cvt_pk_bf16(P[BASE + 2], P[BASE + 3]);   \
    unsigned b0 = cvt_pk_bf16(P[BASE + 4], P[BASE + 5]), b1 = cvt_pk_bf16(P[BASE + 6], P[BASE + 7]);                              \
    auto r0 = __builtin_amdgcn_permlane32_swap(a0, b0, false, false); auto r1 = __builtin_amdgcn_permlane32_swap(a1, b1, false, false); \
    u32x4 w = {r0[0], r1[0], r0[1], r1[1]}; OUT = *reinterpret_cast<bf16x8*>(&w); } while (0)
  PK4(p0, 0, pa0); PK4(p0, 8, pa1); PK4(p1, 0, pa2); PK4(p1, 8, pa3);
#undef PK4
}
__device__ __forceinline__ void qkt(f32x16& p0, f32x16& p1, const bf16_t* Ks, const bf16x8* qr, int r32, int hi) {
  p0 = f32x16{}; p1 = f32x16{};
#pragma unroll
  for (int d0 = 0; d0 < 8; ++d0) { int cb = (d0 * 16 + hi * 8) * 2;
    bf16x8 b0 = *reinterpret_cast<const bf16x8*>((const char*)Ks + KSWZ(r32, cb));
    bf16x8 b1 = *reinterpret_cast<const bf16x8*>((const char*)Ks + KSWZ(32 + r32, cb));
    p0 = __builtin_amdgcn_mfma_f32_32x32x16_bf16(b0, qr[d0], p0, 0, 0, 0);
    p1 = __builtin_amdgcn_mfma_f32_32x32x16_bf16(b1, qr[d0], p1, 0, 0, 0); }
}
__device__ __forceinline__ int v_st(int k, int c) { const int kk = (k & ~0xC) | ((k & 4) << 1) | ((k & 8) >> 1); return ((kk >> 3) * 4 + (c >> 5)) * 512 + ((kk & 7) * 32 + (c & 31)) * 2; }
__device__ __forceinline__ int v_rd_base(int lane) { return ((lane & 3) << 3) | (((lane >> 2) & 3) << 6) | (((lane >> 4) & 1) << 5) | (((lane >> 5) & 1) << 8); }
constexpr int v_rd_off(int d0, int ks, int half) { return d0 * 512 + ks * 4096 + half * 2048; }
template <int OFF> __device__ __forceinline__ s16x4 tr_read(int vb) {
  s16x4 r; asm volatile("ds_read_b64_tr_b16 %0, %1 offset:%2" : "=&v"(r) : "v"(vb), "i"(OFF) : "memory"); return r;
}
template <int D0> __device__ __forceinline__ void pv_one(f32x16& od, int vb, bf16x8 pa0, bf16x8 pa1, bf16x8 pa2, bf16x8 pa3) {
  const s16x4 l0 = tr_read<v_rd_off(D0, 0, 0)>(vb), h0 = tr_read<v_rd_off(D0, 0, 1)>(vb), l1 = tr_read<v_rd_off(D0, 1, 0)>(vb), h1 = tr_read<v_rd_off(D0, 1, 1)>(vb);
  const s16x4 l2 = tr_read<v_rd_off(D0, 2, 0)>(vb), h2 = tr_read<v_rd_off(D0, 2, 1)>(vb), l3 = tr_read<v_rd_off(D0, 3, 0)>(vb), h3 = tr_read<v_rd_off(D0, 3, 1)>(vb);
  asm volatile("s_waitcnt lgkmcnt(0)" ::: "memory"); SBAR();
#define PK(L, H) (bf16x8){L[0], L[1], L[2], L[3], H[0], H[1], H[2], H[3]}
  od = __builtin_amdgcn_mfma_f32_32x32x16_bf16(pa0, PK(l0, h0), od, 0, 0, 0);
  od = __builtin_amdgcn_mfma_f32_32x32x16_bf16(pa1, PK(l1, h1), od, 0, 0, 0);
  od = __builtin_amdgcn_mfma_f32_32x32x16_bf16(pa2, PK(l2, h2), od, 0, 0, 0);
  od = __builtin_amdgcn_mfma_f32_32x32x16_bf16(pa3, PK(l3, h3), od, 0, 0, 0);
#undef PK
}
__device__ __forceinline__ void pv_d0(f32x16* o, int vb, bf16x8 pa0, bf16x8 pa1, bf16x8 pa2, bf16x8 pa3) {
  pv_one<0>(o[0], vb, pa0, pa1, pa2, pa3); pv_one<1>(o[1], vb, pa0, pa1, pa2, pa3); pv_one<2>(o[2], vb, pa0, pa1, pa2, pa3); pv_one<3>(o[3], vb, pa0, pa1, pa2, pa3);
}
__device__ __forceinline__ void attn_dense_body(const bf16_t* Qb, const bf16_t* __restrict__ Kh, const bf16_t* __restrict__ Vh, bf16_t* Ob, int seq, char* lds) {
  const int tid = opaque_tid(), wid = tid >> 6, lane = tid & 63, r32 = lane & 31, hi = lane >> 5;
  bf16_t* V_lds = (bf16_t*)lds; bf16_t* K_lds = (bf16_t*)(lds + 2 * SHM_V);
  float* ws = (float*)(lds + 2 * SHM_V + 2 * SHM_K) + wid * 64; float* li_l = ws; float* al_l = ws + 32;
  float m_reg = -1e30f, l_reg = 0; f32x16 o[4] = {}; bf16x8 qr[8];
  const bf16_t* Qw = Qb + (long)(wid * QBLK + r32) * LD + hi * 8;
#pragma unroll
  for (int d0 = 0; d0 < 8; ++d0) qr[d0] = *reinterpret_cast<const bf16x8*>(Qw + d0 * 16);
  const int sr = tid >> 4, sc = (tid & 15) * 8, vst0 = v_st(sr, sc), vst1 = v_st(32 + sr, sc);
  const int vb0 = (int)(uintptr_t)V_lds + v_rd_base(lane);
  struct { bf16x8 vs0, vs1, ks0, ks1; } sr_[1];
#define SLOAD(i, k0) do { sr_[i].vs0 = *reinterpret_cast<const bf16x8*>(&Vh[(long)((k0) + sr) * LD + sc]); sr_[i].vs1 = *reinterpret_cast<const bf16x8*>(&Vh[(long)((k0) + 32 + sr) * LD + sc]); \
    sr_[i].ks0 = *reinterpret_cast<const bf16x8*>(&Kh[(long)((k0) + sr) * LD + sc]); sr_[i].ks1 = *reinterpret_cast<const bf16x8*>(&Kh[(long)((k0) + 32 + sr) * LD + sc]); } while (0)
#define SWRITE(b, i) do { *(bf16x8*)((char*)V_lds + (b) * SHM_V + vst0) = sr_[i].vs0;          \
    *(bf16x8*)((char*)V_lds + (b) * SHM_V + vst1) = sr_[i].vs1; int kc = sc * 2;               \
    *(bf16x8*)((char*)K_lds + (b) * SHM_K + KSWZ(sr, kc)) = sr_[i].ks0;                       \
    *(bf16x8*)((char*)K_lds + (b) * SHM_K + KSWZ(32 + sr, kc)) = sr_[i].ks1; } while (0)
#define SWAIT() asm volatile("s_waitcnt vmcnt(0)" ::: "memory")
#define RESC(a) do { if (__any((a) < 1.f)) { if (hi == 0) al_l[r32] = (a); asm volatile("s_waitcnt lgkmcnt(0)" ::: "memory"); \
    _Pragma("unroll") for (int d = 0; d < 4; ++d) _Pragma("unroll") for (int r = 0; r < 16; ++r) o[d][r] *= al_l[crow(r, hi)]; } } while (0)
  f32x16 pA0, pA1, pB0, pB1; float mnA, mnB, alA, alB; bf16x8 pa0, pa1, pa2, pa3; const int NT = seq / KVBLK;
  constexpr int SE = 0, SO = 0;
  SLOAD(SE, 0); asm volatile("s_waitcnt vmcnt(0)" ::: "memory"); SWRITE(0, SE); __syncthreads();
  qkt(pA0, pA1, K_lds, qr, r32, hi); partialSM(pA0, pA1, m_reg, mnA, alA);
  SLOAD(SO, KVBLK);
  SWAIT(); SWRITE(1, SO); __syncthreads();
  for (int j = 1; j + 1 < NT; j += 2) {
    SBAR(); qkt(pB0, pB1, (bf16_t*)((char*)K_lds + SHM_K), qr, r32, hi);
    finishSM(pA0, pA1, alA, l_reg, pa0, pa1, pa2, pa3); SBAR();
    SLOAD(SO, (j + 1) * KVBLK); SBAR();
    pv_d0(o, vb0, pa0, pa1, pa2, pa3); partialSM(pB0, pB1, m_reg, mnB, alB);
    __syncthreads(); SWAIT(); SWRITE(0, SE);
    RESC(alB); __syncthreads();
    SBAR(); qkt(pA0, pA1, K_lds, qr, r32, hi);
    finishSM(pB0, pB1, alB, l_reg, pa0, pa1, pa2, pa3); SBAR();
    SLOAD(SE, (j + 2) * KVBLK); SBAR();
    pv_d0(o, vb0 + (int)SHM_V, pa0, pa1, pa2, pa3); partialSM(pA0, pA1, m_reg, mnA, alA);
    __syncthreads(); SWAIT(); SWRITE(1, SO);
    RESC(alA); __syncthreads();
  }
  SBAR(); qkt(pB0, pB1, (bf16_t*)((char*)K_lds + SHM_K), qr, r32, hi);
  finishSM(pA0, pA1, alA, l_reg, pa0, pa1, pa2, pa3); SBAR();
  pv_d0(o, vb0, pa0, pa1, pa2, pa3); partialSM(pB0, pB1, m_reg, mnB, alB);
  __syncthreads(); RESC(alB);
  finishSM(pB0, pB1, alB, l_reg, pa0, pa1, pa2, pa3); SBAR();
  pv_d0(o, vb0 + (int)SHM_V, pa0, pa1, pa2, pa3);
  if (hi == 0) li_l[r32] = l_reg; asm volatile("s_waitcnt lgkmcnt(0)" ::: "memory");
  float rli[16];
#pragma unroll
  for (int r = 0; r < 16; ++r) rli[r] = __builtin_amdgcn_rcpf(li_l[crow(r, hi)]);
  bf16_t* Ow = Ob + (long)(wid * QBLK) * LDO;
#pragma unroll
  for (int r = 0; r < 16; ++r) { int orow = crow(r, hi);
#pragma unroll
    for (int d0 = 0; d0 < 4; ++d0) Ow[(long)orow * LDO + d0 * 32 + r32] = f2bf(o[d0][r] * rli[r]); }
  __syncthreads();
#undef SLOAD
#undef SWRITE
#undef SWAIT
#undef RESC
}
}

constexpr int RING_BYTES = 131072;
constexpr int LDSCTL_OFF = RING_BYTES, MISC_OFF = LDSCTL_OFF + 320, PTAB_OFF = LDSCTL_OFF + 1024;
constexpr int LDS_BYTES = 147456;

#define XB_TMO      128
#define XB_XCNT(j)  (256  + 64 * (j))
#define XB_XSUB(j)  (1280 + 64 * (j))
#define XB_XGEN(j)  (2304 + 64 * (j))
#define XB_TOP      3328
#define XB_TOPGEN   3392
#define XCD_BAR_WORDS 3456
#define XB_SPIN_CAP (1u << 22)
__device__ __forceinline__ unsigned xb_ld(unsigned* p)              { return __hip_atomic_load(p, __ATOMIC_RELAXED, __HIP_MEMORY_SCOPE_AGENT); }
__device__ __forceinline__ unsigned xb_add(unsigned* p, unsigned v) { return __hip_atomic_fetch_add(p, v, __ATOMIC_RELAXED, __HIP_MEMORY_SCOPE_AGENT); }
__device__ __forceinline__ unsigned xb_xcc_id() { return (unsigned)__builtin_amdgcn_s_getreg((3 << 11) | 20) & 0xFu; }
#define XB_SPIN(cond, bar) do { unsigned _sp = 0; while (cond) { __builtin_amdgcn_s_sleep(1); \
    if ((++_sp & 255u) == 0u) { if (xb_ld(&(bar)[XB_TMO])) break; if (_sp > XB_SPIN_CAP) { atomicAdd(&(bar)[XB_TMO], 1u); break; } } } } while (0)
struct XcdBarrier { unsigned* bar; unsigned x; volatile LAS unsigned* st; };
__device__ __forceinline__ XcdBarrier xcd_barrier_post(unsigned* bar, volatile LAS unsigned* st) {
    XcdBarrier b; b.bar = bar; b.x = xb_xcc_id(); b.st = st;
    if (threadIdx.x == 0) (void)xb_add(&bar[XB_XCNT(b.x)], 1u);
    return b;
}
__device__ __forceinline__ void xcd_barrier_complete(unsigned* bar, unsigned x, unsigned& nloc, unsigned& nx) {
    const unsigned G = gridDim.x * gridDim.y * gridDim.z;
    unsigned sum, cnt, mine, sp = 0u;
    for (;;) {
        sum = 0u; cnt = 0u;
        for (unsigned j = 0; j < 16; ++j) { const unsigned c = xb_ld(&bar[XB_XCNT(j)]); sum += c; cnt += (c > 0u) ? 1u : 0u; }
        mine = xb_ld(&bar[XB_XCNT(x)]);
        if (sum == G) break;
        __builtin_amdgcn_s_sleep(1);
        if ((++sp & 255u) == 0u) { if (xb_ld(&bar[XB_TMO])) break; if (sp > XB_SPIN_CAP) { atomicAdd(&bar[XB_TMO], 1u); break; } }
    }
    nloc = mine > 0u ? mine : 1u; nx = cnt > 0u ? cnt : 1u;
}
__device__ __forceinline__ XcdBarrier xcd_barrier_setup(unsigned* bar, volatile LAS unsigned* st) {
    XcdBarrier b = xcd_barrier_post(bar, st);
    if (threadIdx.x == 0) { unsigned nloc, nx; xcd_barrier_complete(bar, b.x, nloc, nx); st[0] = nloc; st[1] = nx; }
    __syncthreads();
    return b;
}
__device__ __forceinline__ void xcd_barrier(const XcdBarrier& b) {
    asm volatile("s_waitcnt vmcnt(0)" ::: "memory");
    __syncthreads();
    if (threadIdx.x == 0) {
        unsigned* bar = b.bar; unsigned bx = b.x;
        asm volatile("" : "+s"(bar), "+s"(bx));
        __builtin_amdgcn_s_waitcnt(0);
        const unsigned nloc = b.st[0], nx = b.st[1];
        const unsigned old = xb_add(&bar[XB_XSUB(bx)], 1u);
        const unsigned gen = old / nloc;
        if (old + 1u == (gen + 1u) * nloc) {
            __builtin_amdgcn_fence(__ATOMIC_RELEASE, "agent");
            asm volatile("s_waitcnt vmcnt(0)" ::: "memory");
            const unsigned og = xb_add(&bar[XB_TOP], 1u);
            const unsigned tg = og / nx;
            if (og + 1u == (tg + 1u) * nx) xb_add(&bar[XB_TOPGEN], 1u);
            else XB_SPIN(xb_ld(&bar[XB_TOPGEN]) == tg, bar);
            __builtin_amdgcn_fence(__ATOMIC_ACQUIRE, "agent");
            xb_add(&bar[XB_XGEN(bx)], 1u);
            asm volatile("s_waitcnt vmcnt(0)" ::: "memory");
        } else {
            XB_SPIN(xb_ld(&bar[XB_XGEN(bx)]) == gen, bar);
            __builtin_amdgcn_fence(__ATOMIC_ACQUIRE, "agent");
            asm volatile("s_waitcnt vmcnt(0)" ::: "memory");
        }
    }
    __syncthreads();
}

__device__ __forceinline__ void transpose_item(const float* W, int ldw, int K, int k0, int srccol0, bf16_t* WT, int dstrow0, LAS float* scr, int lane, const float* kgain = nullptr) {
    constexpr int P = 36;
    const int n4 = (lane & 7) * 4, kr = lane >> 3;
    f32x4 v[8];
    if (srccol0 >= 0) {
#pragma unroll
        for (int i = 0; i < 8; ++i) v[i] = *(const f32x4*)(W + (size_t)(k0 + 8 * i + kr) * ldw + srccol0 + n4);
        if (kgain) {
#pragma unroll
            for (int i = 0; i < 8; ++i) v[i] = v[i] * kgain[k0 + 8 * i + kr];
        }
    } else {
#pragma unroll
        for (int i = 0; i < 8; ++i) v[i] = (f32x4){0.f, 0.f, 0.f, 0.f};
    }
#pragma unroll
    for (int i = 0; i < 8; ++i) *(LAS f32x4*)(scr + (8 * i + kr) * P + n4) = v[i];
    LDS_WAIT(); asm volatile("" ::: "memory");
    const int c = lane & 7;
#pragma unroll
    for (int j = 0; j < 4; ++j) { const int n = (lane >> 3) + 8 * j; const LAS float* s = scr + (8 * c) * P + n;
        u32x4 o; o.x = cvt_pk_bf16(s[0 * P], s[1 * P]); o.y = cvt_pk_bf16(s[2 * P], s[3 * P]); o.z = cvt_pk_bf16(s[4 * P], s[5 * P]); o.w = cvt_pk_bf16(s[6 * P], s[7 * P]);
        *(u32x4*)(WT + (size_t)(dstrow0 + n) * K + k0 + 8 * c) = o; }
    LDS_WAIT(); asm volatile("" ::: "memory");
}
struct LayerW { const float *w_in, *w_bra, *w_brb, *w_brc, *w_out, *f1i, *f1o, *f2i, *f2o, *ng; };
__device__ __forceinline__ void phase_weights(const LayerW& w, unsigned char* ws, LAS unsigned char* lds, int gw, int NGW, int wave, int lane) {
    LAS float* scr = (LAS float*)(lds + wave * 16384);
    constexpr int I_IN = (NIN_PAD / 32) * (D / 64);
    constexpr int I_FI = (2 * FF / 32) * (D / 64);
    constexpr int I_FO = (D / 32) * (FF / 64);
    constexpr int I_BA = (D / 32) * (1024 / 64);
    constexpr int I_BB = (D / 32) * (512 / 64);
    constexpr int I_WO = (D / 32) * (D / 64);
    constexpr int NITEMS = I_IN + 2 * I_FI + 2 * I_FO + I_BA + 2 * I_BB + I_WO;
    for (int it = gw; it < NITEMS; it += NGW) {
        int r = it;
        if (r < I_IN) { const int nb = r % (NIN_PAD / 32), kb = r / (NIN_PAD / 32); const int d0 = nb * 32;
            const int src = d0 < 4608 ? d0 : (d0 < 10752 ? d0 + 32 : (d0 < 10784 ? 4608 + (d0 - 10752) : -1));
            transpose_item(w.w_in, NIN, D, kb * 64, src, (bf16_t*)(ws + WS_WIN), d0, scr, lane, w.ng + 2 * D); continue; } r -= I_IN;
        if (r < 2 * I_FI) { const int which = r / I_FI; r -= which * I_FI; const int nb = r % (2 * FF / 32), kb = r / (2 * FF / 32); const int d0 = nb * 32;
            const int t = d0 >> 8, within = d0 & 255; const int src = within < 128 ? 128 * t + within : FF + 128 * t + (within - 128);
            transpose_item(which ? w.f2i : w.f1i, 2 * FF, D, kb * 64, src, (bf16_t*)(ws + (which ? WS_WF2I : WS_WF1I)), d0, scr, lane, w.ng + (which ? 4 * D : 0)); continue; } r -= 2 * I_FI;
        if (r < 2 * I_FO) { const int which = r / I_FO; r -= which * I_FO; const int nb = r % (D / 32), kb = r / (D / 32);
            transpose_item(which ? w.f2o : w.f1o, D, FF, kb * 64, nb * 32, (bf16_t*)(ws + (which ? WS_WF2O : WS_WF1O)), nb * 32, scr, lane); continue; } r -= 2 * I_FO;
        if (r < I_BA) { const int nb = r % (D / 32), kb = r / (D / 32);
            transpose_item(w.w_bra, D, 1024, kb * 64, nb * 32, (bf16_t*)(ws + WS_WBRA), nb * 32, scr, lane); continue; } r -= I_BA;
        if (r < 2 * I_BB) { const int which = r / I_BB; r -= which * I_BB; const int nb = r % (D / 32), kb = r / (D / 32);
            transpose_item(which ? w.w_brc : w.w_brb, D, 512, kb * 64, nb * 32, (bf16_t*)(ws + (which ? WS_WBRC : WS_WBRB)), nb * 32, scr, lane); continue; } r -= 2 * I_BB;
        { const int nb = r % (D / 32), kb = r / (D / 32);
            transpose_item(w.w_out, D, D, kb * 64, nb * 32, (bf16_t*)(ws + WS_WOUT), nb * 32, scr, lane); }
    }
}
__device__ __forceinline__ void phase_norm(bf16_t* XB, const bf16_t* Y, float* RSTD, float* OUT, const float* gpost, float coef, int gw, int NGW, int lane) {
    for (int m = gw; m < M; m += NGW) {
        const u32x2* xr = (const u32x2*)(XB + (size_t)m * D) + lane; const u32x2* yr = (const u32x2*)(Y + (size_t)m * D) + lane;
        f32x4 x[8], y[8]; float s = 0.f;
#pragma unroll
        for (int j = 0; j < 8; ++j) { const u32x2 t = yr[64 * j], q = xr[64 * j]; y[j] = (f32x4){bflo(t.x), bfhi(t.x), bflo(t.y), bfhi(t.y)}; x[j] = (f32x4){bflo(q.x), bfhi(q.x), bflo(q.y), bfhi(q.y)};
            s += (y[j].x * y[j].x + y[j].y * y[j].y) + (y[j].z * y[j].z + y[j].w * y[j].w); }
        const float rstd = coef * (1.0f / sqrtf(wave_sum(s) * (1.0f / D) + EPS));
        float s2 = 0.f;
#pragma unroll
        for (int j = 0; j < 8; ++j) { const f32x4 g = ((const f32x4*)gpost)[lane + 64 * j]; x[j] = x[j] + y[j] * g * rstd; s2 += (x[j].x * x[j].x + x[j].y * x[j].y) + (x[j].z * x[j].z + x[j].w * x[j].w); }
        if (OUT) { f32x4* xo = (f32x4*)(OUT + (size_t)m * D) + lane;
#pragma unroll
            for (int j = 0; j < 8; ++j) xo[64 * j] = x[j];
        } else {
            u32x2* o8 = (u32x2*)(XB + (size_t)m * D) + lane;
#pragma unroll
            for (int j = 0; j < 8; ++j) { u32x2 w; w.x = cvt_pk_bf16(x[j].x, x[j].y); w.y = cvt_pk_bf16(x[j].z, x[j].w); o8[64 * j] = w; }
            const float r2 = 1.0f / sqrtf(wave_sum(s2) * (1.0f / D) + EPS);
            if (lane == 0) RSTD[m] = r2;
        }
    }
}
__device__ __forceinline__ void phase_prep(bf16_t* PROJ, const float* qk_gain  , LAS unsigned char* lds, int gw, int NGW, int tid, int lane) {
    LAS f32x2* cs = (LAS f32x2*)lds;
    for (int i = tid; i < 2048; i += 512) { const int pos = i >> 5, mi = i & 31; const float inv = powf(10000.0f, -(float)mi / 32.0f); float s, c; sincosf((float)pos * inv, &s, &c); cs[i] = (f32x2){c, s}; }
    __syncthreads();
    const float gq0 = qk_gain[2 * lane], gq1 = qk_gain[2 * lane + 1], gk0 = qk_gain[128 + 2 * lane], gk1 = qk_gain[128 + 2 * lane + 1];
    for (int m = gw; m < M; m += NGW) {
        const int t = m & (SEQ - 1), pr = t >> 6, pc = t & 63;
        const f32x2 c_s = cs[((lane < 32) ? pr : pc) * 32 + (lane & 31)];
        unsigned* row = (unsigned*)(PROJ + (size_t)m * NPROJ);
        unsigned v[10];
#pragma unroll
        for (int h = 0; h < 10; ++h) v[h] = row[h * 64 + lane];
#pragma unroll
        for (int h = 0; h < 10; ++h) {
            const float x1 = bflo(v[h]), x2 = bfhi(v[h]);
            const float rstd = 1.0f / sqrtf(wave_sum(x1 * x1 + x2 * x2) * (1.0f / 128.0f) + EPS);
            const float n1 = x1 * rstd * (h < 8 ? gq0 : gk0), n2 = x2 * rstd * (h < 8 ? gq1 : gk1);
            row[h * 64 + lane] = cvt_pk_bf16(n1 * c_s.x - n2 * c_s.y, n1 * c_s.y + n2 * c_s.x);
        }
    }
    __syncthreads();
}
__device__ __forceinline__ void tr_pair(unsigned base, int pitch, int row0, int col0, int lane, s16x4& lo, s16x4& hi) {
    const int g = lane >> 4, i = lane & 15;
    const unsigned addr = base + (unsigned)((row0 + 4 * g + (i >> 2)) * pitch + (col0 + 4 * (i & 3)) * 2);
    asm volatile("ds_read_b64_tr_b16 %0, %1" : "=&v"(lo) : "v"(addr) : "memory");
    asm volatile("ds_read_b64_tr_b16 %0, %1" : "=&v"(hi) : "v"(addr + (unsigned)(16 * pitch)) : "memory");
}
#define TR_JOIN(L, H) ((bf16x8){L[0], L[1], L[2], L[3], H[0], H[1], H[2], H[3]})
__device__ __forceinline__ bf16x8 pack8(const float* x) { u32x4 w; w.x = cvt_pk_bf16(x[0], x[1]); w.y = cvt_pk_bf16(x[2], x[3]); w.z = cvt_pk_bf16(x[4], x[5]); w.w = cvt_pk_bf16(x[6], x[7]); return *reinterpret_cast<bf16x8*>(&w); }
__device__ __forceinline__ void na_unit(bf16_t* PROJ, LAS unsigned char* lds, int u) {
    const int tid = opaque_tid(), lane = tid & 63, w = __builtin_amdgcn_readfirstlane(tid >> 6);
    constexpr int PV = 272, O_V = 0, O_RPB = 2 * 64 * PV;
    LAS float* rpbs = (LAS float*)(lds + O_RPB);
    const unsigned lbase = (unsigned)(uintptr_t)lds;
    const int ib = w & 3, vh = w >> 2;
    {
        int lane_o = lane; asm volatile("" : "+v"(lane_o));
        const int g = lane_o >> 4, li = lane_o & 15;
        const int r = u & 31, h = (u >> 5) & 3, b = u >> 7;
        const int rs = min(max(r - 4, 0), 24);
        const int c = 16 * ib + li, cs0 = min(max(c - 8, 0), 48);
        const size_t tq = (size_t)b * SEQ + r * 64 + c;
        bf16x8 qf[4];
#pragma unroll
        for (int ks = 0; ks < 4; ++ks) qf[ks] = *(const bf16x8*)(PROJ + tq * NPROJ + C_BQ + h * 128 + 32 * ks + 8 * g);
        int jbv[4], dcv[4];
#pragma unroll
        for (int rr = 0; rr < 4; ++rr) { const int km = 4 * g + rr; jbv[rr] = (cs0 + 15 - km) >> 4; dcv[rr] = 16 * jbv[rr] + km - c + 15; }
        f32x4 o[4];
#pragma unroll
        for (int vt = 0; vt < 4; ++vt) o[vt] = (f32x4){0.f, 0.f, 0.f, 0.f};
        float m_run = -1e30f, l_run = 0.f;
        const int sr = tid >> 4, sc = (tid & 15) * 8;
        const int jlo = ib > 1 ? ib - 1 : 0, jhi = ib < 2 ? ib + 1 : 3;
        bf16x8 kf[4][4], vr0, vr1;
#define NA_LOADK(kr_) do { const size_t kt_ = (size_t)b * SEQ + (size_t)(rs + (kr_)) * 64; \
            _Pragma("unroll") for (int jb = 0; jb < 4; ++jb) if (jb >= jlo && jb <= jhi) { const bf16_t* kp = PROJ + (kt_ + 16 * jb + li) * NPROJ + C_BK + h * 128 + 8 * g; \
                _Pragma("unroll") for (int ks = 0; ks < 4; ++ks) kf[jb][ks] = *(const bf16x8*)(kp + 32 * ks); } } while (0)
#define NA_LOADV(kr_) do { const size_t kt_ = (size_t)b * SEQ + (size_t)(rs + (kr_)) * 64; \
            vr0 = *(const bf16x8*)(PROJ + (kt_ + sr) * NPROJ + C_BV + h * 128 + sc); vr1 = *(const bf16x8*)(PROJ + (kt_ + sr + 32) * NPROJ + C_BV + h * 128 + sc); } while (0)
        NA_LOADV(0); NA_LOADK(0);
        for (int kr = 0; kr < 8; ++kr) {
            *(LAS bf16x8*)(lds + O_V + (kr & 1) * 64 * PV + sr * PV + sc * 2) = vr0; *(LAS bf16x8*)(lds + O_V + (kr & 1) * 64 * PV + (sr + 32) * PV + sc * 2) = vr1;
            if (kr + 1 < 8) NA_LOADV(kr + 1);
            f32x4 s[4];
#pragma unroll
            for (int jb = 0; jb < 4; ++jb) { s[jb] = (f32x4){0.f, 0.f, 0.f, 0.f};
                if (jb >= jlo && jb <= jhi) {
#pragma unroll
                    for (int ks = 0; ks < 4; ++ks) s[jb] = __builtin_amdgcn_mfma_f32_16x16x32_bf16(kf[jb][ks], qf[ks], s[jb], 0, 0, 0); } }
            if (kr + 1 < 8) NA_LOADK(kr + 1);
            const int dr = rs + kr - r + 7;
            float mx = -1e30f;
#pragma unroll
            for (int rr = 0; rr < 4; ++rr) { const float bias = rpbs[(h * 15 + dr) * 31 + dcv[rr]];
#pragma unroll
                for (int jb = 0; jb < 4; ++jb) { const float v = (jb == jbv[rr]) ? s[jb][rr] * 0.088388347648318440f + bias : -1e30f; s[jb][rr] = v; mx = fmaxf(mx, v); } }
            mx = fmaxf(mx, __shfl_xor(mx, 16)); mx = fmaxf(mx, __shfl_xor(mx, 32));
            const float m_new = fmaxf(m_run, mx), alpha = __expf(m_run - m_new);
            m_run = m_new;
            float ps = 0.f;
#pragma unroll
            for (int jb = 0; jb < 4; ++jb)
#pragma unroll
                for (int rr = 0; rr < 4; ++rr) { const float p = (jb == jbv[rr]) ? __expf(s[jb][rr] - m_new) : 0.f; s[jb][rr] = p; ps += p; }
            l_run = l_run * alpha + ps;
            bf16x8 pfr[2];
#pragma unroll
            for (int ss = 0; ss < 2; ++ss) { const float t[8] = {s[2 * ss][0], s[2 * ss][1], s[2 * ss][2], s[2 * ss][3], s[2 * ss + 1][0], s[2 * ss + 1][1], s[2 * ss + 1][2], s[2 * ss + 1][3]}; pfr[ss] = pack8(t); }
            __syncthreads();
            s16x4 vl[4][2], vhh[4][2];
            {
                const unsigned vbase = lbase + O_V + (unsigned)((kr & 1) * 64 * PV + (4 * g + (li >> 2)) * PV + (64 * vh + 4 * (li & 3)) * 2);
                asm volatile("ds_read_b64_tr_b16 %0, %16 offset:0\n\t"
                         "ds_read_b64_tr_b16 %1, %16 offset:4352\n\t"
                         "ds_read_b64_tr_b16 %2, %16 offset:8704\n\t"
                         "ds_read_b64_tr_b16 %3, %16 offset:13056\n\t"
                         "ds_read_b64_tr_b16 %4, %16 offset:32\n\t"
                         "ds_read_b64_tr_b16 %5, %16 offset:4384\n\t"
                         "ds_read_b64_tr_b16 %6, %16 offset:8736\n\t"
                         "ds_read_b64_tr_b16 %7, %16 offset:13088\n\t"
                         "ds_read_b64_tr_b16 %8, %16 offset:64\n\t"
                         "ds_read_b64_tr_b16 %9, %16 offset:4416\n\t"
                         "ds_read_b64_tr_b16 %10, %16 offset:8768\n\t"
                         "ds_read_b64_tr_b16 %11, %16 offset:13120\n\t"
                         "ds_read_b64_tr_b16 %12, %16 offset:96\n\t"
                         "ds_read_b64_tr_b16 %13, %16 offset:4448\n\t"
                         "ds_read_b64_tr_b16 %14, %16 offset:8800\n\t"
                         "ds_read_b64_tr_b16 %15, %16 offset:13152\n\t"
                         "s_waitcnt lgkmcnt(0)"
                         : "=&v"(vl[0][0]), "=&v"(vhh[0][0]), "=&v"(vl[0][1]), "=&v"(vhh[0][1]), "=&v"(vl[1][0]), "=&v"(vhh[1][0]), "=&v"(vl[1][1]), "=&v"(vhh[1][1]), "=&v"(vl[2][0]), "=&v"(vhh[2][0]), "=&v"(vl[2][1]), "=&v"(vhh[2][1]), "=&v"(vl[3][0]), "=&v"(vhh[3][0]), "=&v"(vl[3][1]), "=&v"(vhh[3][1])
                         : "v"(vbase) : "memory");
            }
            __builtin_amdgcn_sched_barrier(0);
#pragma unroll
            for (int vt = 0; vt < 4; ++vt) { o[vt] = o[vt] * alpha;
#pragma unroll
                for (int ss = 0; ss < 2; ++ss) o[vt] = __builtin_amdgcn_mfma_f32_16x16x32_bf16(TR_JOIN(vl[vt][ss], vhh[vt][ss]), pfr[ss], o[vt], 0, 0, 0); }
        }
#undef NA_LOADK
#undef NA_LOADV
        l_run += __shfl_xor(l_run, 16); l_run += __shfl_xor(l_run, 32);
        const float inv = 1.0f / l_run;
#pragma unroll
        for (int vt = 0; vt < 4; ++vt) { u32x2 ov; ov.x = cvt_pk_bf16(o[vt].x * inv, o[vt].y * inv); ov.y = cvt_pk_bf16(o[vt].z * inv, o[vt].w * inv);
            *(u32x2*)(PROJ + tq * NPROJ + C_BQ + h * 128 + 64 * vh + 16 * vt + 4 * g) = ov; }
        __syncthreads();
    }
}
__device__ __forceinline__ void na_load_bias(const float* rpb, LAS unsigned char* lds) {
    const int tid = opaque_tid(); LAS float* rpbs = (LAS float*)(lds + 2 * 64 * 272);
    __syncthreads();
    for (int i = tid; i < 4 * 15 * 31; i += 512) rpbs[i] = rpb[i];
    __syncthreads();
}
__device__ __forceinline__ float logsig16(float z) { return (fminf(z, 0.f) - log1pf(expf(-fabsf(z)))) * (1.0f / 16.0f); }
__device__ __forceinline__ void gla_seq_unit(const bf16_t* PROJ, const float* LR, const float* w_decay  , const float* b_decay  , bf16_t* OFB, bf16_t* OC, const float* onorm,
                                             LAS unsigned char* lds, int b, int h) {
    const int tid = opaque_tid(), lane = tid & 63, w = __builtin_amdgcn_readfirstlane(tid >> 6);
    constexpr int P64 = 144, PV = 272;
    constexpr int O_Q = 0, O_K = 9216, O_KH = 18432, O_V = 27648, O_S = 45056, O_DEC = 63488, O_W2 = 63744;
    const unsigned lbase = (unsigned)(uintptr_t)lds;
    const int ib = w & 3, vh = w >> 2, g = lane >> 4, li = lane & 15;
    LAS float* w2s = (LAS float*)(lds + O_W2);
    LAS float* red = (LAS float*)(lds + 68096);
  for (int dir = 0; dir < 2; ++dir) {
    __syncthreads();
    for (int i = tid; i < 16 * 64; i += 512) w2s[i] = w_decay[dir * 4096 + (i >> 6) * 256 + h * 64 + (i & 63)];
    if (tid < 64) w2s[1024 + tid] = b_decay[dir * 256 + h * 64 + tid];
    for (int i = tid; i < 128 * 72 / 2; i += 512) ((LAS unsigned*)(lds + O_S))[i] = 0u;
    f32x4 S[4];
#pragma unroll
    for (int vt = 0; vt < 4; ++vt) S[vt] = (f32x4){0.f, 0.f, 0.f, 0.f};
    const int dcol = 8 * w;
    const int sr = tid >> 4, sc = (tid & 15) * 8;
    f32x4 lr4[4]; u32x4 qraw, kraw; bf16x8 vst0, vst1;
#define GLA_LOAD(cc_) do { const int c_ = dir ? 31 - (cc_) : (cc_); const size_t m0_ = (size_t)b * SEQ + c_ * 64, m_ = m0_ + lane; \
        _Pragma("unroll") for (int j = 0; j < 4; ++j) lr4[j] = ((const f32x4*)(LR + m_ * 32 + dir * 16))[j]; \
        qraw = *(const u32x4*)(PROJ + m_ * NPROJ + C_CQ + h * 64 + dcol); kraw = *(const u32x4*)(PROJ + m_ * NPROJ + C_CK + h * 64 + dcol); \
        vst0 = *(const bf16x8*)(PROJ + (m0_ + sr) * NPROJ + C_CV + h * 128 + sc); vst1 = *(const bf16x8*)(PROJ + (m0_ + sr + 32) * NPROJ + C_CV + h * 128 + sc); } while (0)
    GLA_LOAD(0);
    __syncthreads();
    for (int cc = 0; cc < 32; ++cc) {
        const int c = dir ? 31 - cc : cc; const size_t m0 = (size_t)b * SEQ + c * 64;
        {
            f32x4 z0 = *(const LAS f32x4*)(w2s + 1024 + dcol), z1 = *(const LAS f32x4*)(w2s + 1024 + dcol + 4);
#pragma unroll
            for (int j = 0; j < 4; ++j)
#pragma unroll
                for (int rr = 0; rr < 4; ++rr) { const int r = 4 * j + rr; z0 = z0 + *(const LAS f32x4*)(w2s + r * 64 + dcol) * lr4[j][rr]; z1 = z1 + *(const LAS f32x4*)(w2s + r * 64 + dcol + 4) * lr4[j][rr]; }
            float bs[8];
#pragma unroll
            for (int e = 0; e < 4; ++e) { bs[e] = logsig16(z0[e]); bs[4 + e] = logsig16(z1[e]); }
            if (dir == 0) {
#pragma unroll
                for (int off = 1; off < 64; off <<= 1)
#pragma unroll
                    for (int e = 0; e < 8; ++e) { const float t = __shfl_up(bs[e], off); if (lane >= off) bs[e] += t; }
            } else {
#pragma unroll
                for (int off = 1; off < 64; off <<= 1)
#pragma unroll
                    for (int e = 0; e < 8; ++e) { const float t = __shfl_down(bs[e], off); if (lane + off < 64) bs[e] += t; }
            }
            const float q[8] = {bflo(qraw.x), bfhi(qraw.x), bflo(qraw.y), bfhi(qraw.y), bflo(qraw.z), bfhi(qraw.z), bflo(qraw.w), bfhi(qraw.w)};
            const float k[8] = {bflo(kraw.x), bfhi(kraw.x), bflo(kraw.y), bfhi(kraw.y), bflo(kraw.z), bfhi(kraw.z), bflo(kraw.w), bfhi(kraw.w)};
            float qt[8], kt[8], kh[8], dc[8];
#pragma unroll
            for (int e = 0; e < 8; ++e) { const float be = __shfl(bs[e], dir ? 0 : 63);
                qt[e] = q[e] * 0.125f * __expf(bs[e]); kt[e] = k[e] * __expf(-bs[e]); kh[e] = k[e] * __expf(be - bs[e]); dc[e] = __expf(be); }
            *(LAS bf16x8*)(lds + O_Q + lane * P64 + 16 * w) = pack8(qt); *(LAS bf16x8*)(lds + O_K + lane * P64 + 16 * w) = pack8(kt); *(LAS bf16x8*)(lds + O_KH + lane * P64 + 16 * w) = pack8(kh);
            if (lane == 0) { *(LAS f32x4*)(lds + O_DEC + 4 * dcol) = (f32x4){dc[0], dc[1], dc[2], dc[3]}; *(LAS f32x4*)(lds + O_DEC + 4 * dcol + 16) = (f32x4){dc[4], dc[5], dc[6], dc[7]}; }
            *(LAS bf16x8*)(lds + O_V + sr * PV + sc * 2) = vst0; *(LAS bf16x8*)(lds + O_V + (sr + 32) * PV + sc * 2) = vst1;
        }
        __syncthreads();
        if (cc + 1 < 32) GLA_LOAD(cc + 1);
        const size_t mi = m0 + 16 * ib + li; f32x4 oo[4]; float ss = 0.f;
        {
            bf16x8 qF[2];
#pragma unroll
            for (int ks = 0; ks < 2; ++ks) qF[ks] = *(const LAS bf16x8*)(lds + O_Q + (16 * ib + li) * P64 + (32 * ks + 8 * g) * 2);
            f32x4 P[4];
#pragma unroll
            for (int jb = 0; jb < 4; ++jb) {
                f32x4 a = {0.f, 0.f, 0.f, 0.f};
                const bool need = dir ? (jb >= ib) : (jb <= ib);
                if (need) {
#pragma unroll
                    for (int ks = 0; ks < 2; ++ks) a = __builtin_amdgcn_mfma_f32_16x16x32_bf16(*(const LAS bf16x8*)(lds + O_K + (16 * jb + li) * P64 + (32 * ks + 8 * g) * 2), qF[ks], a, 0, 0, 0); }
#pragma unroll
                for (int r = 0; r < 4; ++r) { const int jl = 4 * g + r;
                    const bool keep = (jb == ib) ? (dir ? (jl >= li) : (jl <= li)) : need;
                    P[jb][r] = keep ? a[r] : 0.f; }
            }
            bf16x8 pfr[2];
#pragma unroll
            for (int s = 0; s < 2; ++s) { const float t[8] = {P[2 * s][0], P[2 * s][1], P[2 * s][2], P[2 * s][3], P[2 * s + 1][0], P[2 * s + 1][1], P[2 * s + 1][2], P[2 * s + 1][3]}; pfr[s] = pack8(t); }
            s16x4 vl[4][2], vhh[4][2], kl[2], kh2[2];
            {
                const unsigned vbase = lbase + O_V + (unsigned)((4 * g + (li >> 2)) * PV + (64 * vh + 4 * (li & 3)) * 2);
                const unsigned kbase = lbase + O_KH + (unsigned)((4 * g + (li >> 2)) * P64 + (16 * ib + 4 * (li & 3)) * 2);
                asm volatile("ds_read_b64_tr_b16 %0, %20 offset:0\n\t"
                         "ds_read_b64_tr_b16 %1, %20 offset:4352\n\t"
                         "ds_read_b64_tr_b16 %2, %20 offset:8704\n\t"
                         "ds_read_b64_tr_b16 %3, %20 offset:13056\n\t"
                         "ds_read_b64_tr_b16 %4, %20 offset:32\n\t"
                         "ds_read_b64_tr_b16 %5, %20 offset:4384\n\t"
                         "ds_read_b64_tr_b16 %6, %20 offset:8736\n\t"
                         "ds_read_b64_tr_b16 %7, %20 offset:13088\n\t"
                         "ds_read_b64_tr_b16 %8, %20 offset:64\n\t"
                         "ds_read_b64_tr_b16 %9, %20 offset:4416\n\t"
                         "ds_read_b64_tr_b16 %10, %20 offset:8768\n\t"
                         "ds_read_b64_tr_b16 %11, %20 offset:13120\n\t"
                         "ds_read_b64_tr_b16 %12, %20 offset:96\n\t"
                         "ds_read_b64_tr_b16 %13, %20 offset:4448\n\t"
                         "ds_read_b64_tr_b16 %14, %20 offset:8800\n\t"
                         "ds_read_b64_tr_b16 %15, %20 offset:13152\n\t"
                         "ds_read_b64_tr_b16 %16, %21 offset:0\n\t"
                         "ds_read_b64_tr_b16 %17, %21 offset:2304\n\t"
                         "ds_read_b64_tr_b16 %18, %21 offset:4608\n\t"
                         "ds_read_b64_tr_b16 %19, %21 offset:6912\n\t"
                         "s_waitcnt lgkmcnt(0)"
                         : "=&v"(vl[0][0]), "=&v"(vhh[0][0]), "=&v"(vl[0][1]), "=&v"(vhh[0][1]), "=&v"(vl[1][0]), "=&v"(vhh[1][0]), "=&v"(vl[1][1]), "=&v"(vhh[1][1]), "=&v"(vl[2][0]), "=&v"(vhh[2][0]), "=&v"(vl[2][1]), "=&v"(vhh[2][1]), "=&v"(vl[3][0]), "=&v"(vhh[3][0]), "=&v"(vl[3][1]), "=&v"(vhh[3][1]), "=&v"(kl[0]), "=&v"(kh2[0]), "=&v"(kl[1]), "=&v"(kh2[1])
                         : "v"(vbase), "v"(kbase) : "memory");
            }
            bf16x8 sfr[4][2];
#pragma unroll
            for (int vt = 0; vt < 4; ++vt)
#pragma unroll
                for (int ks = 0; ks < 2; ++ks) sfr[vt][ks] = *(const LAS bf16x8*)(lds + O_S + (64 * vh + 16 * vt + li) * P64 + (32 * ks + 8 * g) * 2);
            const float dec = *(const LAS float*)(lds + O_DEC + 4 * (16 * ib + li));
            __builtin_amdgcn_sched_barrier(0);
#pragma unroll
            for (int vt = 0; vt < 4; ++vt) {
                const int v0 = 64 * vh + 16 * vt;
                f32x4 o = {0.f, 0.f, 0.f, 0.f};
#pragma unroll
                for (int s = 0; s < 2; ++s) o = __builtin_amdgcn_mfma_f32_16x16x32_bf16(TR_JOIN(vl[vt][s], vhh[vt][s]), pfr[s], o, 0, 0, 0);
#pragma unroll
                for (int ks = 0; ks < 2; ++ks) o = __builtin_amdgcn_mfma_f32_16x16x32_bf16(sfr[vt][ks], qF[ks], o, 0, 0, 0);
                if (dir == 0) { u32x2 ov; ov.x = (unsigned)f2bf(o.x) | ((unsigned)f2bf(o.y) << 16); ov.y = (unsigned)f2bf(o.z) | ((unsigned)f2bf(o.w) << 16);
                    *(u32x2*)(OFB + mi * 512 + h * 128 + v0 + 4 * g) = ov; }
                else { const u32x2 f = *(const u32x2*)(OFB + mi * 512 + h * 128 + v0 + 4 * g);
                    o.x += bflo(f.x); o.y += bfhi(f.x); o.z += bflo(f.y); o.w += bfhi(f.y); oo[vt] = o; ss += (o.x * o.x + o.y * o.y) + (o.z * o.z + o.w * o.w); }
                f32x4 sn = S[vt] * dec;
#pragma unroll
                for (int s = 0; s < 2; ++s) sn = __builtin_amdgcn_mfma_f32_16x16x32_bf16(TR_JOIN(vl[vt][s], vhh[vt][s]), TR_JOIN(kl[s], kh2[s]), sn, 0, 0, 0);
                S[vt] = sn;
            }
        }
        if (dir) { ss += __shfl_xor(ss, 16); ss += __shfl_xor(ss, 32); if (g == 0) red[vh * 64 + 16 * ib + li] = ss; }
        __syncthreads();
        if (dir) {
            const float rstd = 1.0f / sqrtf((red[16 * ib + li] + red[64 + 16 * ib + li]) * (1.0f / 128.0f) + EPS);
#pragma unroll
            for (int vt = 0; vt < 4; ++vt) { const int v0 = 64 * vh + 16 * vt;
                const u32x2 og = *(const u32x2*)(PROJ + mi * NPROJ + C_OG + h * 128 + v0 + 4 * g); const f32x4 gn = *(const f32x4*)(onorm + v0 + 4 * g);
                u32x2 ov; ov.x = cvt_pk_bf16(oo[vt].x * rstd * gn.x * pg8::silu_f(bflo(og.x)), oo[vt].y * rstd * gn.y * pg8::silu_f(bfhi(og.x)));
                ov.y = cvt_pk_bf16(oo[vt].z * rstd * gn.z * pg8::silu_f(bflo(og.y)), oo[vt].w * rstd * gn.w * pg8::silu_f(bfhi(og.y)));
                *(u32x2*)(OC + mi * 512 + h * 128 + v0 + 4 * g) = ov; }
        }
#pragma unroll
        for (int vt = 0; vt < 4; ++vt)
#pragma unroll
            for (int r = 0; r < 4; ++r) *(LAS bf16_t*)(lds + O_S + (64 * vh + 16 * vt + 4 * g + r) * P64 + (16 * ib + li) * 2) = f2bf(S[vt][r]);
    }
    __syncthreads();
  }
#undef GLA_LOAD
}
constexpr int NPH = 15;
enum { P_F1A = 0, P_F1B, P_N1, P_M1, P_PREP, P_ATT, P_NA, P_GLA, P_GLC, P_M4, P_M5, P_N2, P_F2A, P_F2B, P_N3 };
constexpr int NGP = 1 + DEPTH * NPH;
struct Args { const float* in[18]; float* out; unsigned char* ws; int gp_lo, gp_hi; };

typedef decltype(__builtin_amdgcn_kernarg_segment_ptr()) kargp_t;
__device__ __forceinline__ unsigned long long karg_q(int byte_off) { kargp_t p_ = __builtin_amdgcn_kernarg_segment_ptr(); asm volatile("" : "+s"(p_));
    return *(const unsigned long long __attribute__((address_space(4)))*)((const char __attribute__((address_space(4)))*)p_ + byte_off); }
__global__ void __launch_bounds__(512, 2) fwd(Args args) {
    extern __shared__ __attribute__((aligned(16))) unsigned char lds_raw[];
    LAS unsigned char* const lds0 = (LAS unsigned char*)lds_raw;
    const int G0 = gridDim.x, wg0 = blockIdx.x;
#define PENV LAS unsigned char* lds = lds0; int G = G0, wg = wg0; asm volatile("" : "+s"(lds), "+s"(G), "+s"(wg)); const int NGW = G * 8; (void)NGW; (void)lds; (void)wg
    volatile LAS unsigned* MISC = (volatile LAS unsigned*)(lds0 + MISC_OFF);
    volatile LAS unsigned long long* PT = (volatile LAS unsigned long long*)(lds0 + PTAB_OFF);
    { const int t0 = threadIdx.x;
      for (int u = t0; u < (LDS_BYTES - LDSCTL_OFF) / 4; u += 512) ((LAS unsigned*)(lds0 + LDSCTL_OFF))[u] = 0u;
      __syncthreads();
      __syncthreads(); }
#if ONE_LAUNCH
    constexpr int lo = 0, hi = NGP;
#else
    const int lo = args.gp_lo, hi = args.gp_hi;
#endif
    XcdBarrier bar; bar.bar = (unsigned*)(args.ws + WS_CTL) + CW_BAR; bar.x = 0; bar.st = nullptr;
    if (hi - lo > 1) bar = xcd_barrier_setup((unsigned*)(args.ws + WS_CTL) + CW_BAR, MISC + 8);
#define SEAM(gp) do { if ((gp) + 1 < hi) xcd_barrier(bar); } while (0)
#define INP(i) ((const float*)(const GAS float*)karg_q(8 * (i)))
#define WSP() ((unsigned char*)(GAS unsigned char*)karg_q(8 * 19))
#define XP() ((float*)(GAS float*)karg_q(8 * 18))
#define TIDS() PENV; const int tid = opaque_tid(), lane = tid & 63, wave = __builtin_amdgcn_readfirstlane(tid >> 6), gw = wg * 8 + wave; (void)tid; (void)lane; (void)wave; (void)gw

    if (((PHASE_MASK >> 31) & 1u) && lo <= 0 && 0 < hi) {
        TIDS(); unsigned char* ws = WSP(); bf16_t* XB = (bf16_t*)(ws + WS_XN); float* RSTD = (float*)(ws + WS_RSTD);
        LayerW w; w.w_in = INP(3); w.w_bra = INP(10); w.w_brb = INP(11); w.w_brc = INP(12); w.w_out = INP(13); w.f1i = INP(14); w.f1o = INP(15); w.f2i = INP(16); w.f2o = INP(17); w.ng = INP(2);
        phase_weights(w, ws, lds, gw, NGW, wave, lane);
        const float* xp = INP(0); const float* xs = INP(1);
        for (int m = gw; m < M; m += NGW) {
            const float* src = m < 16 * SEQ ? xp + (size_t)m * D : xs + (size_t)(m - 16 * SEQ) * D;
            const f32x4* xr = (const f32x4*)src + lane; f32x4 x[8]; float s = 0.f;
#pragma unroll
            for (int j = 0; j < 8; ++j) { x[j] = xr[64 * j]; s += (x[j].x * x[j].x + x[j].y * x[j].y) + (x[j].z * x[j].z + x[j].w * x[j].w); }
            u32x2* o8 = (u32x2*)(XB + (size_t)m * D) + lane;
#pragma unroll
            for (int j = 0; j < 8; ++j) { u32x2 wv; wv.x = cvt_pk_bf16(x[j].x, x[j].y); wv.y = cvt_pk_bf16(x[j].z, x[j].w); o8[64 * j] = wv; }
            const float rstd = 1.0f / sqrtf(wave_sum(s) * (1.0f / D) + EPS);
            if (lane == 0) RSTD[m] = rstd;
        }
        SEAM(0);
    }
    for (int l = 0; l < DEPTH; ++l) {
        const int gp0 = 1 + l * NPH;
        if (gp0 + NPH <= lo || gp0 >= hi) continue;
#define IN(p) (((PHASE_MASK >> (p)) & 1u) && lo <= gp0 + (p) && gp0 + (p) < hi)
#define FFN_PAIR(ff, pa, pb) do { \
        if (IN(pa)) { PENV; unsigned char* ws = WSP(); pg8::Gemm g{(const bf16_t*)(ws + WS_XN), (const bf16_t*)(ws + ((ff) ? WS_WF2I : WS_WF1I)), M, 2 * FF, D, D}; pg8::StaticOrder S; S.init(M, 2 * FF, G, wg, WGM_FI); \
            pg8::EpiSwiGLU E{(bf16_t*)(ws + WS_H), (const float*)(ws + WS_RSTD)}; pg8::gemm_phase<pg8::EpiSwiGLU, pg8::StaticOrder, true, true>(lds, g, S, E); if ((DUP_MASK >> (pa)) & 1u) pg8::gemm_phase<pg8::EpiSwiGLU, pg8::StaticOrder, true, true>(lds, g, S, E); SEAM(gp0 + (pa)); } \
        if (IN(pb)) { PENV; unsigned char* ws = WSP(); pg8::Gemm g{(const bf16_t*)(ws + WS_H), (const bf16_t*)(ws + ((ff) ? WS_WF2O : WS_WF1O)), M, D, FF, FF}; pg8::StaticOrder S; S.init(M, D, G, wg, WGM_FO); \
            pg8::EpiBf16Plain E{(bf16_t*)(ws + WS_Y), D}; pg8::gemm_phase<pg8::EpiBf16Plain, pg8::StaticOrder, true, true>(lds, g, S, E); if ((DUP_MASK >> (pb)) & 1u) pg8::gemm_phase<pg8::EpiBf16Plain, pg8::StaticOrder, true, true>(lds, g, S, E); SEAM(gp0 + (pb)); } } while (0)
#define NORM_PHASE(p, ipost, coef, last) do { if (IN(p)) { TIDS(); unsigned char* ws = WSP(); const float* ng = INP(2) + (size_t)l * 6 * D; \
            phase_norm((bf16_t*)(ws + WS_XN), (const bf16_t*)(ws + WS_Y), (float*)(ws + WS_RSTD), (last) ? XP() : nullptr, ng + (ipost) * D, (coef), gw, NGW, lane);

        FFN_PAIR(0, P_F1A, P_F1B);
        NORM_PHASE(P_N1, 1, 0.5f, false) SEAM(gp0 + P_N1); } } while (0);
        if (IN(P_M1)) { PENV;
            unsigned char* ws = WSP();
            pg8::Gemm g{(const bf16_t*)(ws + WS_XN), (const bf16_t*)(ws + WS_WIN), M, NIN_PAD, D, D}; pg8::StaticOrder S; S.init(M, NIN_PAD, G, wg, WGM_M1);
            pg8::EpiProj E{(bf16_t*)(ws + WS_PROJ), (bf16_t*)(ws + WS_GATES), (float*)(ws + WS_LR), INP(4) + (size_t)l * 3 * D, (const float*)(ws + WS_RSTD)};
            pg8::gemm_phase<pg8::EpiProj, pg8::StaticOrder, true, true>(lds, g, S, E);
            if ((DUP_MASK >> P_M1) & 1u) pg8::gemm_phase<pg8::EpiProj, pg8::StaticOrder, true, true>(lds, g, S, E);
            SEAM(gp0 + P_M1);
        }
        if (IN(P_PREP)) {
            { TIDS(); unsigned char* ws = WSP(); phase_prep((bf16_t*)(ws + WS_PROJ), INP(5) + (size_t)l * 256, lds, gw, NGW, tid, lane); }
            SEAM(gp0 + P_PREP);
        }
        if (IN(P_ATT)) { PENV;
            unsigned char* ws = WSP(); bf16_t* PROJ = (bf16_t*)(ws + WS_PROJ);
            const int ngrp = (G % 8 == 0) ? 8 : 1, xg = wg % ngrp, slot = wg / ngrp, per = G / ngrp;
            for (int gu = slot; gu < 96 / ngrp; gu += per) { const int U = xg * (96 / ngrp) + gu;
                gla_seq_unit(PROJ, (const float*)(ws + WS_LR), INP(7) + (size_t)l * 2 * 16 * 256, INP(8) + (size_t)l * 512, (bf16_t*)(ws + WS_OFB), (bf16_t*)(ws + WS_OC), INP(9) + (size_t)l * 128, lds, U >> 2, U & 3); }
            na_load_bias(INP(6) + (size_t)l * 4 * 15 * 31, lds);
            unsigned* head = (unsigned*)(ws + WS_CTL) + CW_Q + (l * 8 + xg) * 64;
            const int n_att = 1536 / ngrp, n_na = 3072 / ngrp;
            LAS unsigned* qslot = (LAS unsigned*)(lds + MISC_OFF + 64);
            for (;;) {
                __syncthreads();
                if (threadIdx.x == 0) *qslot = __hip_atomic_fetch_add(head, 1u, __ATOMIC_RELAXED, __HIP_MEMORY_SCOPE_AGENT);
                __syncthreads();
                const int idx = __builtin_amdgcn_readfirstlane((int)*(volatile LAS unsigned*)qslot);
                if (idx >= n_att * (1 + ATT_DUP) + n_na) break;
                if (idx < n_att * (1 + ATT_DUP)) { const int idx0 = idx; const int idx = idx0 % n_att;
                    const int rnd = idx >> 5, mem = idx & 31, grp = (ngrp == 8) ? rnd * 8 + xg : rnd;
                    const int b = grp >> 1, kvh = grp & 1, h = kvh * 4 + (mem >> 3), qb = mem & 7;
                    const size_t rowq = (size_t)b * SEQ + qb * 256, rowk = (size_t)b * SEQ;
                    bf16_t* Qp = PROJ + rowq * NPROJ + C_AQ + h * 128;
                    att::attn_dense_body(Qp, PROJ + rowk * NPROJ + C_AK + kvh * 128, PROJ + rowk * NPROJ + C_AV + kvh * 128, (bf16_t*)(ws + WS_OA) + rowq * 1024 + h * 128, SEQ, (char*)lds_raw + 49152);
                } else {
                    na_unit(PROJ, lds, xg * n_na + (idx - n_att * (1 + ATT_DUP)));
                }
            }
            SEAM(gp0 + P_GLA);
        }
        if (IN(P_M4)) { PENV;
            { unsigned char* ws = WSP(); pg8::Gemm g{(const bf16_t*)(ws + WS_OA), (const bf16_t*)(ws + WS_WBRA), M, D, 1024, 1024}; pg8::StaticOrder S; S.init(M, D, G, wg, WGM_M45);
              pg8::EpiMerge<true> E{(const bf16_t*)(ws + WS_GATES), (bf16_t*)(ws + WS_MG)}; pg8::gemm_phase<pg8::EpiMerge<true>, pg8::StaticOrder, true, true>(lds, g, S, E); }
            { unsigned char* ws = WSP(); pg8::Gemm g{(const bf16_t*)(ws + WS_PROJ) + C_BQ, (const bf16_t*)(ws + WS_WBRB), M, D, 512, NPROJ}; pg8::StaticOrder S; S.init(M, D, G, wg, WGM_M45);
              pg8::EpiMerge<false> E{(const bf16_t*)(ws + WS_GATES) + D, (bf16_t*)(ws + WS_MG)}; pg8::gemm_phase<pg8::EpiMerge<false>, pg8::StaticOrder, true, true>(lds, g, S, E); }
            { unsigned char* ws = WSP(); pg8::Gemm g{(const bf16_t*)(ws + WS_OC), (const bf16_t*)(ws + WS_WBRC), M, D, 512, 512}; pg8::StaticOrder S; S.init(M, D, G, wg, WGM_M45);
              pg8::EpiMerge<false> E{(const bf16_t*)(ws + WS_GATES) + 2 * D, (bf16_t*)(ws + WS_MG)}; pg8::gemm_phase<pg8::EpiMerge<false>, pg8::StaticOrder, true, true>(lds, g, S, E); }
            if ((DUP_MASK >> P_M4) & 1u) {
            { unsigned char* ws = WSP(); pg8::Gemm g{(const bf16_t*)(ws + WS_OA), (const bf16_t*)(ws + WS_WBRA), M, D, 1024, 1024}; pg8::StaticOrder S; S.init(M, D, G, wg, WGM_M45);
              pg8::EpiMerge<true> E{(const bf16_t*)(ws + WS_GATES), (bf16_t*)(ws + WS_MG)}; pg8::gemm_phase<pg8::EpiMerge<true>, pg8::StaticOrder, true, true>(lds, g, S, E); }
            { unsigned char* ws = WSP(); pg8::Gemm g{(const bf16_t*)(ws + WS_PROJ) + C_BQ, (const bf16_t*)(ws + WS_WBRB), M, D, 512, NPROJ}; pg8::StaticOrder S; S.init(M, D, G, wg, WGM_M45);
              pg8::EpiMerge<false> E{(const bf16_t*)(ws + WS_GATES) + D, (bf16_t*)(ws + WS_MG)}; pg8::gemm_phase<pg8::EpiMerge<false>, pg8::StaticOrder, true, true>(lds, g, S, E); }
            { unsigned char* ws = WSP(); pg8::Gemm g{(const bf16_t*)(ws + WS_OC), (const bf16_t*)(ws + WS_WBRC), M, D, 512, 512}; pg8::StaticOrder S; S.init(M, D, G, wg, WGM_M45);
              pg8::EpiMerge<false> E{(const bf16_t*)(ws + WS_GATES) + 2 * D, (bf16_t*)(ws + WS_MG)}; pg8::gemm_phase<pg8::EpiMerge<false>, pg8::StaticOrder, true, true>(lds, g, S, E); }
            }
            SEAM(gp0 + P_M4);
        }
        if (IN(P_M5)) { PENV;
            unsigned char* ws = WSP();
            pg8::Gemm g{(const bf16_t*)(ws + WS_MG), (const bf16_t*)(ws + WS_WOUT), M, D, D, D}; pg8::StaticOrder S; S.init(M, D, G, wg, WGM_M45);
            pg8::EpiBf16Plain E{(bf16_t*)(ws + WS_Y), D};
            pg8::gemm_phase<pg8::EpiBf16Plain, pg8::StaticOrder, true, true>(lds, g, S, E);
            if ((DUP_MASK >> P_M5) & 1u) pg8::gemm_phase<pg8::EpiBf16Plain, pg8::StaticOrder, true, true>(lds, g, S, E);
            SEAM(gp0 + P_M5);
        }
        NORM_PHASE(P_N2, 3, 1.0f, false) SEAM(gp0 + P_N2); } } while (0);
        FFN_PAIR(1, P_F2A, P_F2B);
        NORM_PHASE(P_N3, 5, 0.5f, (l + 1 == DEPTH))
            if (l + 1 < DEPTH) { LayerW w; w.w_in = INP(3) + (size_t)(l + 1) * D * NIN; w.w_bra = INP(10) + (size_t)(l + 1) * 1024 * D; w.w_brb = INP(11) + (size_t)(l + 1) * 512 * D; w.w_brc = INP(12) + (size_t)(l + 1) * 512 * D;
                w.w_out = INP(13) + (size_t)(l + 1) * D * D; w.f1i = INP(14) + (size_t)(l + 1) * D * 2 * FF; w.f1o = INP(15) + (size_t)(l + 1) * FF * D; w.f2i = INP(16) + (size_t)(l + 1) * D * 2 * FF; w.f2o = INP(17) + (size_t)(l + 1) * FF * D; w.ng = INP(2) + (size_t)(l + 1) * 6 * D;
                phase_weights(w, ws, lds, gw, NGW, wave, lane); if ((DUP_MASK >> 20) & 1u) phase_weights(w, ws, lds, gw, NGW, wave, lane); }
            SEAM(gp0 + P_N3); } } while (0);
#undef FFN_PAIR
#undef NORM_PHASE
#undef IN
    }
#undef SEAM
}

extern "C" void kernel_launch(void* const* d_in, const int* in_sizes, int n_in, void* d_out, int out_size, void* d_ws, size_t ws_size, hipStream_t stream) {
    static int grid = 0;
    if (grid == 0) {
        if (n_in != 18 || out_size != M * D || ws_size < WS_END) { fprintf(stderr, "kernel_launch: unexpected shapes: n_in %d out %d ws %zu (need %zu)\n", n_in, out_size, ws_size, (size_t)WS_END); grid = -1; return; }
        int dev = 0, cus = 0, per_cu = 0;
        if (hipGetDevice(&dev) != hipSuccess || hipDeviceGetAttribute(&cus, hipDeviceAttributeMultiprocessorCount, dev) != hipSuccess) { grid = -1; return; }
        if (hipFuncSetAttribute((const void*)fwd, hipFuncAttributeMaxDynamicSharedMemorySize, LDS_BYTES) != hipSuccess) { fprintf(stderr, "kernel_launch: hipFuncSetAttribute failed\n"); grid = -1; return; }
        if (hipOccupancyMaxActiveBlocksPerMultiprocessor(&per_cu, (const void*)fwd, 512, LDS_BYTES) != hipSuccess || per_cu < 1) fprintf(stderr, "kernel_launch: occupancy query says %d\n", per_cu);
        (void)hipGetLastError();
        grid = cus;
    }
    if (grid < 0) return;
    (void)hipMemsetAsync((char*)d_ws + WS_CTL, 0, CTL_BYTES, stream);
    Args a{};
    for (int i = 0; i < 18; ++i) a.in[i] = (const float*)d_in[i];
    a.out = (float*)d_out; a.ws = (unsigned char*)d_ws;
#if ONE_LAUNCH
    a.gp_lo = 0; a.gp_hi = NGP;
    hipLaunchKernelGGL(fwd, dim3(grid), dim3(512), LDS_BYTES, stream, a);
#else
    for (int gp = 0; gp < NGP; ++gp) { a.gp_lo = gp; a.gp_hi = gp + 1; hipLaunchKernelGGL(fwd, dim3(grid), dim3(512), LDS_BYTES, stream, a); }
#endif
    const hipError_t le = hipPeekAtLastError();
    if (le != hipSuccess) fprintf(stderr, "kernel_launch: launch failed: %s\n", hipGetErrorName(le));
}
```

```cpp
#include <hip/hip_runtime.h>
#include <cstdio>
#include <cstdint>

#ifndef ONE_LAUNCH
#define ONE_LAUNCH 1
#endif
#ifndef WGM_FI
#define WGM_FI 4
#endif
#ifndef WGM_FO
#define WGM_FO 2
#endif
#ifndef WGM_M1
#define WGM_M1 4
#endif
#ifndef WGM_M45
#define WGM_M45 4
#endif
#ifndef ATT_DUP
#define ATT_DUP 0
#endif
#ifndef DUP_MASK
#define DUP_MASK 0u
#endif
#ifndef PHASE_MASK
#define PHASE_MASK 0xFFFFFFFFu
#endif

#define GAS __attribute__((address_space(1)))
#define LAS __attribute__((address_space(3)))
typedef unsigned short bf16_t;
typedef short bf16x8 __attribute__((ext_vector_type(8)));
typedef short s16x4 __attribute__((ext_vector_type(4)));
typedef float f32x4 __attribute__((ext_vector_type(4)));
typedef float f32x2 __attribute__((ext_vector_type(2)));
typedef float f32x16 __attribute__((ext_vector_type(16)));
typedef unsigned u32x4 __attribute__((ext_vector_type(4)));
typedef unsigned u32x2 __attribute__((ext_vector_type(2)));

constexpr int M = 49152;
constexpr int SEQ = 2048, NSEQ = 24;
constexpr int D = 2048, FF = 5632, DEPTH = 4;
constexpr int NPROJ = 4608;
constexpr int NGATE = 6144;
constexpr int NIN = 10784, NIN_PAD = 11008;
constexpr int C_AQ = 0, C_AK = 1024, C_AV = 1280, C_BQ = 1536, C_BK = 2048, C_BV = 2560, C_CQ = 3072, C_CK = 3328, C_CV = 3584, C_OG = 4096;
constexpr int C_OC = 3072;
constexpr float EPS = 1e-6f;

constexpr size_t MiB = 1u << 20;
constexpr size_t WS_CTL = 0, CTL_BYTES = 1 * MiB;
constexpr size_t WS_WIN = 2 * MiB;
constexpr size_t WS_WF1I = 45 * MiB;
constexpr size_t WS_WF1O = 89 * MiB;
constexpr size_t WS_WF2I = 111 * MiB;
constexpr size_t WS_WF2O = 155 * MiB;
constexpr size_t WS_WBRA = 177 * MiB;
constexpr size_t WS_WBRB = 181 * MiB;
constexpr size_t WS_WBRC = 183 * MiB;
constexpr size_t WS_WOUT = 185 * MiB;
constexpr size_t WS_XN = 193 * MiB;
constexpr size_t WS_BIG = 385 * MiB;
constexpr size_t WS_PROJ = WS_BIG;
constexpr size_t WS_GATES = WS_BIG + 432 * MiB;
constexpr size_t WS_LR = WS_BIG + 1008 * MiB;
constexpr size_t WS_H = WS_BIG;
constexpr size_t WS_Y = WS_BIG + 528 * MiB;
constexpr size_t WS_OFB = WS_BIG + 1014 * MiB;
constexpr size_t WS_OC = WS_OFB + 48 * MiB;
constexpr size_t WS_MG = WS_OFB + 96 * MiB;
constexpr size_t WS_RSTD = WS_MG + 192 * MiB;
constexpr size_t WS_OA = WS_RSTD + 1 * MiB;
constexpr size_t WS_END = WS_OA + 96 * MiB;
constexpr int CW_Q = 32768;
static_assert(WS_Y + (size_t)M * D * 4 <= WS_LR, "Y inside GATES region");
constexpr int CW_BAR = 4096;

__device__ __forceinline__ unsigned cvt_pk_bf16(float lo, float hi) { unsigned r; asm volatile("v_cvt_pk_bf16_f32 %0, %1, %2" : "=v"(r) : "v"(lo), "v"(hi)); return r; }
__device__ __forceinline__ float bflo(unsigned w) { return __uint_as_float(w << 16); }
__device__ __forceinline__ float bfhi(unsigned w) { return __uint_as_float(w & 0xffff0000u); }
__device__ __forceinline__ float bf2f(bf16_t v) { return __uint_as_float(((unsigned)v) << 16); }
__device__ __forceinline__ bf16_t f2bf(float f) { unsigned u = __float_as_uint(f); return (bf16_t)((u + 0x7fffu + ((u >> 16) & 1u)) >> 16); }
__device__ __forceinline__ float wave_sum(float v) {
#pragma unroll
    for (int o = 1; o < 64; o <<= 1) v += __shfl_xor(v, o);
    return v;
}
__device__ __forceinline__ float wave_max(float v) {
#pragma unroll
    for (int o = 1; o < 64; o <<= 1) v = fmaxf(v, __shfl_xor(v, o));
    return v;
}
__device__ __forceinline__ int opaque_tid() { int t = threadIdx.x; asm volatile("" : "+v"(t)); return t; }
__device__ __forceinline__ unsigned char* opq(unsigned char* p) { asm volatile("" : "+s"(p)); return p; }
__device__ __forceinline__ const float* lds_ptr(volatile LAS unsigned long long* tab, int i) { const unsigned long long v = tab[i];
    const unsigned lo = __builtin_amdgcn_readfirstlane((unsigned)v), hi = __builtin_amdgcn_readfirstlane((unsigned)(v >> 32)); return (const float*)(((unsigned long long)hi << 32) | lo); }
#define LDS_WAIT() asm volatile("s_waitcnt lgkmcnt(0)" ::: "memory")
#define VM_WAIT() asm volatile("s_waitcnt vmcnt(0)" ::: "memory")

namespace pg8 {
constexpr int BM = 256, BK = 64, HALF = 128, HTB = HALF * BK * 2, STAGE_BYTES = 8 * HTB, NXCD = 8;
__host__ __device__ __forceinline__ int lds_byte(int r, int c) { const int st = (r >> 4) * 2 + (c >> 5), rr = r & 15, cc = c & 31, ob = rr * 64 + cc * 2; return st * 1024 + (ob ^ (((ob >> 9) & 1) << 5)); }
__host__ __device__ __forceinline__ void stage_rc(int b, int& R, int& C) { const int st = b / 1024, sb = b % 1024, swz = sb ^ (((sb >> 9) & 1) << 5); R = (st >> 1) * 16 + swz / 64; C = (st & 1) * 32 + (swz % 64) / 2; }
__host__ __device__ __forceinline__ int perm32(int rho) { const int n = rho >> 4, i = rho & 15; return 8 * (i >> 2) + 4 * n + (i & 3); }

struct Unit { int pm, pn; };
struct Gemm { const bf16_t* A; const bf16_t* Bt; int M, N, K, lda; };

struct StaticOrder {
    int nM, nN, nwg, G, c, WGM;
    __host__ __device__ void init(int M_, int N_, int G_, int c_, int wgm_ = 4) { nM = M_ / BM; nN = N_ / BM; nwg = nM * nN; G = G_; c = c_; WGM = wgm_; }
    __host__ __device__ bool next(int i, Unit& u) const {
        const long L = (long)i * G + c; if (L >= nwg) return false;
        int wgid = (int)L; { const int q = nwg / NXCD, r = nwg % NXCD, xcd = wgid % NXCD, off = wgid / NXCD; wgid = (xcd < r ? xcd * (q + 1) : r * (q + 1) + (xcd - r) * q) + off; }
        const int nig = WGM * nN, gid = wgid / nig, fm = gid * WGM, gsz = (nM - fm) < WGM ? (nM - fm) : WGM;
        u.pm = fm + ((wgid % nig) % gsz); u.pn = (wgid % nig) / gsz; return true;
    }
    __device__ __forceinline__ void a_ready(const Unit&) const {}
    __device__ __forceinline__ void done(const Unit&) const {}
};

struct EpiF32 {
    static constexpr bool PERM = false, AFTER_DRAIN = false;
    float* C; int ldc;
    __device__ __forceinline__ void operator()(const f32x4 (&acc)[2][2][4][2], const Unit& u, int wr, int wc, int fr, int fq) const {
        const int row0 = u.pm * BM + wr * 64 + fr, col0 = u.pn * BM + wc * 32 + 4 * fq;
#pragma unroll
        for (int ai = 0; ai < 2; ++ai)
#pragma unroll
            for (int m = 0; m < 4; ++m) { float* rowp = C + (size_t)(row0 + ai * HALF + m * 16) * ldc + col0;
#pragma unroll
                for (int bj = 0; bj < 2; ++bj)
#pragma unroll
                    for (int n = 0; n < 2; ++n) *(f32x4*)(rowp + bj * HALF + n * 16) = acc[ai][bj][m][n]; }
    }
};
struct EpiBf16Plain {
    static constexpr bool PERM = true, AFTER_DRAIN = false;
    bf16_t* C; int ldc;
    __device__ __forceinline__ void operator()(const f32x4 (&acc)[2][2][4][2], const Unit& u, int wr, int wc, int fr, int fq) const {
        const int row0 = u.pm * BM + wr * 64 + fr, col0 = u.pn * BM + wc * 32 + 8 * fq;
#pragma unroll
        for (int ai = 0; ai < 2; ++ai)
#pragma unroll
            for (int m = 0; m < 4; ++m) { bf16_t* p = C + (size_t)(row0 + ai * HALF + m * 16) * ldc + col0;
#pragma unroll
                for (int bj = 0; bj < 2; ++bj) { const f32x4 v0 = acc[ai][bj][m][0], v1 = acc[ai][bj][m][1];
                    u32x4 w; w.x = cvt_pk_bf16(v0[0], v0[1]); w.y = cvt_pk_bf16(v0[2], v0[3]); w.z = cvt_pk_bf16(v1[0], v1[1]); w.w = cvt_pk_bf16(v1[2], v1[3]);
                    *(u32x4*)(p + bj * HALF) = w; } }
    }
};
__device__ __forceinline__ float silu_f(float g) { return g * __builtin_amdgcn_rcpf(1.0f + __builtin_amdgcn_exp2f(-1.4426950408889634f * g)); }
__device__ __forceinline__ float sigmoid_f(float g) { return __builtin_amdgcn_rcpf(1.0f + __builtin_amdgcn_exp2f(-1.4426950408889634f * g)); }
struct EpiSwiGLU {
    static constexpr bool PERM = true, AFTER_DRAIN = false;
    bf16_t* H; const float* rstd;
    __device__ __forceinline__ void operator()(const f32x4 (&acc)[2][2][4][2], const Unit& u, int wr, int wc, int fr, int fq) const {
        const int row0 = u.pm * BM + wr * 64 + fr, col0 = u.pn * HALF + wc * 32 + 8 * fq;
#pragma unroll
        for (int ai = 0; ai < 2; ++ai)
#pragma unroll
            for (int m = 0; m < 4; ++m) { bf16_t* p = H + (size_t)(row0 + ai * HALF + m * 16) * FF + col0; const float rs = rstd[row0 + ai * HALF + m * 16];
                const f32x4 g0 = acc[ai][0][m][0] * rs, g1 = acc[ai][0][m][1] * rs, u0 = acc[ai][1][m][0] * rs, u1 = acc[ai][1][m][1] * rs;
                u32x4 w; w.x = cvt_pk_bf16(silu_f(g0[0]) * u0[0], silu_f(g0[1]) * u0[1]); w.y = cvt_pk_bf16(silu_f(g0[2]) * u0[2], silu_f(g0[3]) * u0[3]);
                w.z = cvt_pk_bf16(silu_f(g1[0]) * u1[0], silu_f(g1[1]) * u1[1]); w.w = cvt_pk_bf16(silu_f(g1[2]) * u1[2], silu_f(g1[3]) * u1[3]);
                *(u32x4*)p = w; }
    }
};
struct EpiProj {
    static constexpr bool PERM = true, AFTER_DRAIN = false;
    bf16_t* PROJ; bf16_t* GATES; float* LR; const float* gbias; const float* rstd;
    __device__ __forceinline__ void operator()(const f32x4 (&acc)[2][2][4][2], const Unit& u, int wr, int wc, int fr, int fq) const {
        const int row0 = u.pm * BM + wr * 64 + fr;
        if (u.pn < 18) {
            const int col0 = u.pn * BM + wc * 32 + 8 * fq;
#pragma unroll
            for (int ai = 0; ai < 2; ++ai)
#pragma unroll
                for (int m = 0; m < 4; ++m) { bf16_t* p = PROJ + (size_t)(row0 + ai * HALF + m * 16) * NPROJ + col0; const float rs = rstd[row0 + ai * HALF + m * 16];
#pragma unroll
                    for (int bj = 0; bj < 2; ++bj) { const f32x4 v0 = acc[ai][bj][m][0] * rs, v1 = acc[ai][bj][m][1] * rs;
                        u32x4 w; w.x = cvt_pk_bf16(v0[0], v0[1]); w.y = cvt_pk_bf16(v0[2], v0[3]); w.z = cvt_pk_bf16(v1[0], v1[1]); w.w = cvt_pk_bf16(v1[2], v1[3]);
                        *(u32x4*)(p + bj * HALF) = w; } }
        } else if (u.pn < 42) {
            const int col0 = (u.pn - 18) * BM + wc * 32 + 8 * fq;
#pragma unroll
            for (int bj = 0; bj < 2; ++bj) {
                const f32x4 b0 = *(const f32x4*)(gbias + col0 + bj * HALF), b1 = *(const f32x4*)(gbias + col0 + bj * HALF + 4);
#pragma unroll
                for (int ai = 0; ai < 2; ++ai)
#pragma unroll
                    for (int m = 0; m < 4; ++m) { bf16_t* p = GATES + (size_t)(row0 + ai * HALF + m * 16) * NGATE + col0 + bj * HALF; const float rs = rstd[row0 + ai * HALF + m * 16];
                        const f32x4 v0 = acc[ai][bj][m][0] * rs + b0, v1 = acc[ai][bj][m][1] * rs + b1;
                        u32x4 w; w.x = cvt_pk_bf16(sigmoid_f(v0[0]), sigmoid_f(v0[1])); w.y = cvt_pk_bf16(sigmoid_f(v0[2]), sigmoid_f(v0[3]));
                        w.z = cvt_pk_bf16(sigmoid_f(v1[0]), sigmoid_f(v1[1])); w.w = cvt_pk_bf16(sigmoid_f(v1[2]), sigmoid_f(v1[3]));
                        *(u32x4*)p = w; }
                asm volatile("" ::: "memory"); }
        } else {
            if (wc == 0) {
#pragma unroll
                for (int ai = 0; ai < 2; ++ai)
#pragma unroll
                    for (int m = 0; m < 4; ++m) { float* p = LR + (size_t)(row0 + ai * HALF + m * 16) * 32 + 8 * fq; const float rs = rstd[row0 + ai * HALF + m * 16];
                        *(f32x4*)p = acc[ai][0][m][0] * rs; *(f32x4*)(p + 4) = acc[ai][0][m][1] * rs; }
            }
        }
    }
};
template <bool FIRST> struct EpiMerge {
    static constexpr bool PERM = true, AFTER_DRAIN = false;
    const bf16_t* G; bf16_t* MG;
    __device__ __forceinline__ void operator()(const f32x4 (&acc)[2][2][4][2], const Unit& u, int wr, int wc, int fr, int fq) const {
        const int row0 = u.pm * BM + wr * 64 + fr, col0 = u.pn * BM + wc * 32 + 8 * fq;
#pragma unroll
        for (int ai = 0; ai < 2; ++ai)
#pragma unroll
            for (int m = 0; m < 4; ++m) { const size_t r = (size_t)(row0 + ai * HALF + m * 16);
#pragma unroll
                for (int bj = 0; bj < 2; ++bj) { const u32x4 g = *(const u32x4*)(G + r * NGATE + col0 + bj * HALF);
                    const f32x4 v0 = acc[ai][bj][m][0], v1 = acc[ai][bj][m][1];
                    float o[8] = { bflo(g.x) * v0[0], bfhi(g.x) * v0[1], bflo(g.y) * v0[2], bfhi(g.y) * v0[3], bflo(g.z) * v1[0], bfhi(g.z) * v1[1], bflo(g.w) * v1[2], bfhi(g.w) * v1[3] };
                    bf16_t* p = MG + r * D + col0 + bj * HALF;
                    if (!FIRST) { const u32x4 old = *(const u32x4*)p;
                        o[0] += bflo(old.x); o[1] += bfhi(old.x); o[2] += bflo(old.y); o[3] += bfhi(old.y); o[4] += bflo(old.z); o[5] += bfhi(old.z); o[6] += bflo(old.w); o[7] += bfhi(old.w); }
                    u32x4 w; w.x = cvt_pk_bf16(o[0], o[1]); w.y = cvt_pk_bf16(o[2], o[3]); w.z = cvt_pk_bf16(o[4], o[5]); w.w = cvt_pk_bf16(o[6], o[7]);
                    *(u32x4*)p = w; }
                asm volatile("" ::: "memory"); }
    }
};

template <class Epi, class Sched, bool ALIGN_EPI = false, bool SP2 = false>
__device__ __forceinline__ void gemm_phase(LAS unsigned char* lds, const Gemm g, const Sched& S, const Epi& E) {
    const int tid = opaque_tid(), wid = __builtin_amdgcn_readfirstlane(tid >> 6), lane = tid & 63, wr = wid >> 2, wc = wid & 3, fr = lane & 15, fq = lane >> 4;
    const int K = g.K, nt = K / BK, lda = g.lda;
    unsigned voffA[2], voffB[2];
#pragma unroll
    for (int i = 0; i < 2; ++i) { int R, C; stage_rc(tid * 16 + i * 8192, R, C); const int Rb = Epi::PERM ? ((R & ~31) + perm32(R & 31)) : R;
        voffA[i] = (unsigned)(R * lda + C) * 2u; voffB[i] = (unsigned)(Rb * K + C) * 2u; }
    const unsigned kstep = (unsigned)(BK * 2);
    const unsigned hstepA = (unsigned)HALF * (unsigned)lda * 2u, hstepB = (unsigned)HALF * (unsigned)K * 2u;
    const unsigned tstepA = 2u * hstepA, tstepB = 2u * hstepB;
    const unsigned ldsw = (unsigned)wid * 1024u;
    const int aoff = lds_byte(wr * 64 + fr, fq * 8), boff = lds_byte(wc * 32 + fr, fq * 8);
    const char* const baseA = (const char*)g.A; const char* const baseB = (const char*)g.Bt;
#define PG8_SA(b, h) (((b) * 2 + (h)) * HTB)
#define PG8_SB(b, h) ((4 + (b) * 2 + (h)) * HTB)
#define PG8_STAGE(bufoff, gbase, goff, voff) do { _Pragma("unroll") for (int _i = 0; _i < 2; ++_i) \
        __builtin_amdgcn_global_load_lds((const unsigned*)((gbase) + (size_t)(unsigned)((goff) + (voff)[_i])), (LAS unsigned*)(lds + (bufoff) + ldsw + _i * 8192), 16, 0, 0); } while (0)
#define PG8_LDA(dst, b, h) do { _Pragma("unroll") for (int m = 0; m < 4; ++m) _Pragma("unroll") for (int k = 0; k < 2; ++k) dst[m][k] = *(const LAS bf16x8*)(lds + PG8_SA(b, h) + aoff + m * 2048 + k * 1024); } while (0)
#define PG8_LDB(dst, b, h) do { _Pragma("unroll") for (int n = 0; n < 2; ++n) _Pragma("unroll") for (int k = 0; k < 2; ++k) dst[n][k] = *(const LAS bf16x8*)(lds + PG8_SB(b, h) + boff + n * 2048 + k * 1024); } while (0)
#define PG8_MMA(ai, bj, At, Bt) do { __builtin_amdgcn_s_setprio(1); _Pragma("unroll") for (int m = 0; m < 4; ++m) _Pragma("unroll") for (int n = 0; n < 2; ++n) _Pragma("unroll") for (int k = 0; k < 2; ++k) \
        acc[ai][bj][m][n] = __builtin_amdgcn_mfma_f32_16x16x32_bf16(Bt[n][k], At[m][k], acc[ai][bj][m][n], 0, 0, 0); __builtin_amdgcn_s_setprio(0); } while (0)
#define PG8_WAIT_V(n) asm volatile("s_waitcnt vmcnt(" #n ")" ::: "memory")
#define PG8_WAIT_L(n) asm volatile("s_waitcnt lgkmcnt(" #n ")" ::: "memory")
#define PG8_BAR __builtin_amdgcn_s_barrier()
#define PG8_SCHED __builtin_amdgcn_sched_barrier(0)
    Unit cur, nxt; int ui = 0;
    if (!S.next(0, cur)) return;
    f32x4 acc[2][2][4][2];
#pragma unroll
    for (int a = 0; a < 2; ++a)
#pragma unroll
        for (int b = 0; b < 2; ++b)
#pragma unroll
            for (int m = 0; m < 4; ++m)
#pragma unroll
                for (int n = 0; n < 2; ++n) acc[a][b][m][n] = (f32x4){0.f, 0.f, 0.f, 0.f};
    bf16x8 At[4][2], B0[2][2], B1[2][2];
    unsigned cA = (unsigned)cur.pm * tstepA, cB = (unsigned)cur.pn * tstepB;
    S.a_ready(cur);
    if constexpr (SP2) {
        PG8_STAGE(PG8_SB(0, 0), baseB, cB, voffB); PG8_STAGE(PG8_SB(0, 1), baseB, cB + hstepB, voffB); PG8_STAGE(PG8_SA(0, 0), baseA, cA, voffA); PG8_STAGE(PG8_SA(0, 1), baseA, cA + hstepA, voffA);
        if (wr == 1) PG8_BAR;
        PG8_WAIT_V(2); PG8_BAR;
        PG8_STAGE(PG8_SB(1, 0), baseB, cB + kstep, voffB); PG8_STAGE(PG8_SA(1, 0), baseA, cA + kstep, voffA); PG8_STAGE(PG8_SB(1, 1), baseB, cB + hstepB + kstep, voffB);
        PG8_WAIT_V(6); PG8_BAR;
    } else {
        PG8_STAGE(PG8_SB(0, 0), baseB, cB, voffB); PG8_STAGE(PG8_SA(0, 0), baseA, cA, voffA); PG8_STAGE(PG8_SB(0, 1), baseB, cB + hstepB, voffB); PG8_STAGE(PG8_SA(0, 1), baseA, cA + hstepA, voffA);
        if (wr == 1) PG8_BAR;
        PG8_WAIT_V(4); PG8_BAR;
        PG8_STAGE(PG8_SB(1, 0), baseB, cB + kstep, voffB); PG8_STAGE(PG8_SA(1, 0), baseA, cA + kstep, voffA); PG8_STAGE(PG8_SB(1, 1), baseB, cB + hstepB + kstep, voffB);
        PG8_WAIT_V(6); PG8_BAR;
    }
    for (;;) {
        const bool has_next = S.next(ui + 1, nxt);
        const unsigned nA = has_next ? (unsigned)nxt.pm * tstepA : cA, nB = has_next ? (unsigned)nxt.pn * tstepB : cB;
        for (int t = 0; t < nt; t += 2) {
            const bool last = (t == nt - 2);
            const unsigned a1 = cA + (unsigned)(t + 1) * kstep;
            const unsigned a2 = last ? nA : cA + (unsigned)(t + 2) * kstep, b2 = last ? nB : cB + (unsigned)(t + 2) * kstep;
            const unsigned a3 = a2 + kstep, b3 = b2 + kstep;
            if (last && has_next) S.a_ready(nxt);
            if constexpr (SP2) {
            PG8_LDB(B0, 0, 0); PG8_LDB(B1, 0, 1); PG8_SCHED; PG8_LDA(At, 0, 0); PG8_STAGE(PG8_SA(1, 1), baseA, a1 + hstepA, voffA);
            PG8_WAIT_V(8); PG8_WAIT_L(0); PG8_BAR; PG8_MMA(0, 0, At, B0); PG8_MMA(0, 1, At, B1); PG8_BAR; PG8_SCHED;
            PG8_LDA(At, 0, 1); PG8_STAGE(PG8_SB(0, 0), baseB, b2, voffB); PG8_STAGE(PG8_SB(0, 1), baseB, b2 + hstepB, voffB); PG8_STAGE(PG8_SA(0, 0), baseA, a2, voffA);
            PG8_WAIT_V(8); PG8_WAIT_L(0); PG8_BAR; PG8_MMA(1, 0, At, B0); PG8_MMA(1, 1, At, B1); PG8_BAR; PG8_SCHED;
            PG8_LDB(B0, 1, 0); PG8_LDB(B1, 1, 1); PG8_SCHED; PG8_LDA(At, 1, 0); PG8_STAGE(PG8_SA(0, 1), baseA, a2 + hstepA, voffA);
            PG8_WAIT_V(8); PG8_WAIT_L(0); PG8_BAR; PG8_MMA(0, 0, At, B0); PG8_MMA(0, 1, At, B1); PG8_BAR; PG8_SCHED;
            PG8_LDA(At, 1, 1); PG8_STAGE(PG8_SB(1, 0), baseB, b3, voffB); PG8_STAGE(PG8_SB(1, 1), baseB, b3 + hstepB, voffB); PG8_STAGE(PG8_SA(1, 0), baseA, a3, voffA);
            PG8_WAIT_V(8); PG8_WAIT_L(0); PG8_BAR; PG8_MMA(1, 0, At, B0); PG8_MMA(1, 1, At, B1); PG8_BAR; PG8_SCHED;
            } else {
            PG8_LDB(B0, 0, 0); PG8_SCHED; PG8_LDA(At, 0, 0); PG8_STAGE(PG8_SA(1, 1), baseA, a1 + hstepA, voffA);
            PG8_WAIT_L(8); PG8_BAR; PG8_WAIT_L(0); PG8_MMA(0, 0, At, B0); PG8_BAR; PG8_SCHED;
            PG8_LDB(B1, 0, 1); PG8_STAGE(PG8_SB(0, 0), baseB, b2, voffB);
            PG8_BAR; PG8_WAIT_L(0); PG8_MMA(0, 1, At, B1); PG8_BAR;
            PG8_LDA(At, 0, 1); PG8_STAGE(PG8_SA(0, 0), baseA, a2, voffA);
            PG8_BAR; PG8_WAIT_L(0); PG8_MMA(1, 0, At, B0); PG8_BAR; PG8_SCHED;
            PG8_STAGE(PG8_SB(0, 1), baseB, b2 + hstepB, voffB);
            PG8_WAIT_V(6); PG8_BAR; PG8_MMA(1, 1, At, B1); PG8_BAR;
            PG8_LDB(B0, 1, 0); PG8_SCHED; PG8_LDA(At, 1, 0); PG8_STAGE(PG8_SA(0, 1), baseA, a2 + hstepA, voffA);
            PG8_WAIT_L(8); PG8_BAR; PG8_WAIT_L(0); PG8_MMA(0, 0, At, B0); PG8_BAR; PG8_SCHED;
            PG8_LDB(B1, 1, 1); PG8_STAGE(PG8_SB(1, 0), baseB, b3, voffB);
            PG8_BAR; PG8_WAIT_L(0); PG8_MMA(0, 1, At, B1); PG8_BAR;
            PG8_LDA(At, 1, 1); PG8_STAGE(PG8_SA(1, 0), baseA, a3, voffA);
            PG8_BAR; PG8_WAIT_L(0); PG8_MMA(1, 0, At, B0); PG8_BAR; PG8_SCHED;
            PG8_STAGE(PG8_SB(1, 1), baseB, b3 + hstepB, voffB);
            PG8_WAIT_V(6); PG8_BAR; PG8_MMA(1, 1, At, B1); PG8_BAR;
            }
        }
        if constexpr (ALIGN_EPI) { if (wr == 0) PG8_BAR; }
        if constexpr (!Epi::AFTER_DRAIN) { E(acc, cur, wr, wc, fr, fq); S.done(cur); }
        if (!has_next) break;
#pragma unroll
        for (int a = 0; a < 2; ++a)
#pragma unroll
            for (int b = 0; b < 2; ++b)
#pragma unroll
                for (int m = 0; m < 4; ++m)
#pragma unroll
                    for (int n = 0; n < 2; ++n) acc[a][b][m][n] = (f32x4){0.f, 0.f, 0.f, 0.f};
        cur = nxt; cA = nA; cB = nB; ++ui;
        if constexpr (ALIGN_EPI) { if (wr == 1) PG8_BAR; }
    }
    PG8_WAIT_V(0);
    if constexpr (!ALIGN_EPI) { if (wr == 0) PG8_BAR; }
    PG8_BAR;
#undef PG8_SA
#undef PG8_SB
#undef PG8_STAGE
#undef PG8_LDA
#undef PG8_LDB
#undef PG8_MMA
#undef PG8_WAIT_V
#undef PG8_WAIT_L
#undef PG8_BAR
#undef PG8_SCHED
}
}

namespace att {
constexpr int DH = 128, NW = 8, QBLK = 32, KVBLK = 64;
constexpr float SCALE = 0.088388347648318440f;
constexpr float THR = 8.f;
constexpr int LD = NPROJ, LDO = 1024;
constexpr size_t SHM_V = KVBLK * DH * 2, SHM_K = KVBLK * DH * 2, SHM_ATTN = 2 * SHM_V + 2 * SHM_K + NW * 64 * 4;
#define KSWZ(row, colB) ((row) * 256 + ((colB) ^ (((row) & 7) << 4)))
#define SBAR() __builtin_amdgcn_sched_barrier(0)
__device__ __forceinline__ int crow(int r, int hi) { return (r & 3) + 8 * (r >> 2) + 4 * hi; }
__device__ __forceinline__ void partialSM(f32x16& p0, f32x16& p1, float& m_reg, float& mn, float& alpha) {
  constexpr float C = SCALE * 1.4426950408889634f;
  float pmax = p0[0];
#pragma unroll
  for (int r = 1; r < 16; ++r) pmax = fmaxf(pmax, p0[r]);
#pragma unroll
  for (int r = 0; r < 16; ++r) pmax = fmaxf(pmax, p1[r]);
  { auto rr = __builtin_amdgcn_permlane32_swap(__float_as_uint(pmax), __float_as_uint(pmax), false, false);
    pmax = fmaxf(__uint_as_float(rr[0]), __uint_as_float(rr[1])); }
  if (__builtin_expect(__all(pmax - m_reg <= THR / SCALE), 1)) { mn = m_reg; alpha = 1.f; }
  else { mn = fmaxf(m_reg, pmax); alpha = __builtin_amdgcn_exp2f((m_reg - mn) * C); m_reg = mn; }
  float mnC = -mn * C;
#pragma unroll
  for (int r = 0; r < 16; ++r) p0[r] = fmaf(p0[r], C, mnC);
#pragma unroll
  for (int r = 0; r < 16; ++r) p1[r] = fmaf(p1[r], C, mnC);
#pragma unroll
  for (int r = 0; r < 16; ++r) p0[r] = __builtin_amdgcn_exp2f(p0[r]);
}
__device__ __forceinline__ void finishSM(f32x16& p0, f32x16& p1, float alpha, float& l_reg, bf16x8& pa0, bf16x8& pa1, bf16x8& pa2, bf16x8& pa3) {
#pragma unroll
  for (int r = 0; r < 16; ++r) p1[r] = __builtin_amdgcn_exp2f(p1[r]);
  float ps = 0;
#pragma unroll
  for (int r = 0; r < 16; ++r) ps += p0[r];
#pragma unroll
  for (int r = 0; r < 16; ++r) ps += p1[r];
  { auto rr = __builtin_amdgcn_permlane32_swap(__float_as_uint(ps), __float_as_uint(ps), false, false);
    ps = __uint_as_float(rr[0]) + __uint_as_float(rr[1]); }
  l_reg = l_reg * alpha + ps;
#define PK4(P, BASE, OUT) do { unsigned a0 = cvt_pk_bf16(P[BASE + 0], P[BASE + 1]), a1 = cvt_pk_bf16(P[BASE + 2], P[BASE + 3]);   \
    unsigned b0 = cvt_pk_bf16(P[BASE + 4], P[BASE + 5]), b1 = cvt_pk_bf16(P[BASE + 6], P[BASE + 7]);                              \
    auto r0 = __builtin_amdgcn_permlane32_swap(a0, b0, false, false); auto r1 = __builtin_amdgcn_permlane32_swap(a1, b1, false, false); \
    u32x4 w = {r0[0], r1[0], r0[1], r1[1]}; OUT = *reinterpret_cast<bf16x8*>(&w); } while (0)
  PK4(p0, 0, pa0); PK4(p0, 8, pa1); PK4(p1, 0, pa2); PK4(p1, 8, pa3);
#undef PK4
}
__device__ __forceinline__ void qkt(f32x16& p0, f32x16& p1, const bf16_t* Ks, const bf16x8* qr, int r32, int hi) {
  p0 = f32x16{}; p1 = f32x16{};
#pragma unroll
  for (int d0 = 0; d0 < 8; ++d0) { int cb = (d0 * 16 + hi * 8) * 2;
    bf16x8 b0 = *reinterpret_cast<const bf16x8*>((const char*)Ks + KSWZ(r32, cb));
    bf16x8 b1 = *reinterpret_cast<const bf16x8*>((const char*)Ks + KSWZ(32 + r32, cb));
    p0 = __builtin_amdgcn_mfma_f32_32x32x16_bf16(b0, qr[d0], p0, 0, 0, 0);
    p1 = __builtin_amdgcn_mfma_f32_32x32x16_bf16(b1, qr[d0], p1, 0, 0, 0); }
}
__device__ __forceinline__ int v_st(int k, int c) { const int kk = (k & ~0xC) | ((k & 4) << 1) | ((k & 8) >> 1); return ((kk >> 3) * 4 + (c >> 5)) * 512 + ((kk & 7) * 32 + (c & 31)) * 2; }
__device__ __forceinline__ int v_rd_base(int lane) { return ((lane & 3) << 3) | (((lane >> 2) & 3) << 6) | (((lane >> 4) & 1) << 5) | (((lane >> 5) & 1) << 8); }
constexpr int v_rd_off(int d0, int ks, int half) { return d0 * 512 + ks * 4096 + half * 2048; }
template <int OFF> __device__ __forceinline__ s16x4 tr_read(int vb) {
  s16x4 r; asm volatile("ds_read_b64_tr_b16 %0, %1 offset:%2" : "=&v"(r) : "v"(vb), "i"(OFF) : "memory"); return r;
}
template <int D0> __device__ __forceinline__ void pv_one(f32x16& od, int vb, bf16x8 pa0, bf16x8 pa1, bf16x8 pa2, bf16x8 pa3) {
  const s16x4 l0 = tr_read<v_rd_off(D0, 0, 0)>(vb), h0 = tr_read<v_rd_off(D0, 0, 1)>(vb), l1 = tr_read<v_rd_off(D0, 1, 0)>(vb), h1 = tr_read<v_rd_off(D0, 1, 1)>(vb);
  const s16x4 l2 = tr_read<v_rd_off(D0, 2, 0)>(vb), h2 = tr_read<v_rd_off(D0, 2, 1)>(vb), l3 = tr_read<v_rd_off(D0, 3, 0)>(vb), h3 = tr_read<v_rd_off(D0, 3, 1)>(vb);
  asm volatile("s_waitcnt lgkmcnt(0)" ::: "memory"); SBAR();
#define PK(L, H) (bf16x8){L[0], L[1], L[2], L[3], H[0], H[1], H[2], H[3]}
  od = __builtin_amdgcn_mfma_f32_32x32x16_bf16(pa0, PK(l0, h0), od, 0, 0, 0);
  od = __builtin_amdgcn_mfma_f32_32x32x16_bf16(pa1, PK(l1, h1), od, 0, 0, 0);
  od = __builtin_amdgcn_mfma_f32_32x32x16_bf16(pa2, PK(l2, h2), od, 0, 0, 0);
  od = __builtin_amdgcn_mfma_f32_32x32x16_bf16(pa3, PK(l3, h3), od, 0, 0, 0);
#undef PK
}
__device__ __forceinline__ void pv_d0(f32x16* o, int vb, bf16x8 pa0, bf16x8 pa1, bf16x8 pa2, bf16x8 pa3) {
  pv_one<0>(o[0], vb, pa0, pa1, pa2, pa3); pv_one<1>(o[1], vb, pa0, pa1, pa2, pa3); pv_one<2>(o[2], vb, pa0, pa1, pa2, pa3); pv_one<3>(o[3], vb, pa0, pa1, pa2, pa3);
}
__device__ __forceinline__ void attn_dense_body(const bf16_t* Qb, const bf16_t* __restrict__ Kh, const bf16_t* __restrict__ Vh, bf16_t* Ob, int seq, char* lds) {
  const int tid = opaque_tid(), wid = tid >> 6, lane = tid & 63, r32 = lane & 31, hi = lane >> 5;
  bf16_t* V_lds = (bf16_t*)lds; bf16_t* K_lds = (bf16_t*)(lds + 2 * SHM_V);
  float* ws = (float*)(lds + 2 * SHM_V + 2 * SHM_K) + wid * 64; float* li_l = ws; float* al_l = ws + 32;
  float m_reg = -1e30f, l_reg = 0; f32x16 o[4] = {}; bf16x8 qr[8];
  const bf16_t* Qw = Qb + (long)(wid * QBLK + r32) * LD + hi * 8;
#pragma unroll
  for (int d0 = 0; d0 < 8; ++d0) qr[d0] = *reinterpret_cast<const bf16x8*>(Qw + d0 * 16);
  const int sr = tid >> 4, sc = (tid & 15) * 8, vst0 = v_st(sr, sc), vst1 = v_st(32 + sr, sc);
  const int vb0 = (int)(uintptr_t)V_lds + v_rd_base(lane);
  struct { bf16x8 vs0, vs1, ks0, ks1; } sr_[1];
#define SLOAD(i, k0) do { sr_[i].vs0 = *reinterpret_cast<const bf16x8*>(&Vh[(long)((k0) + sr) * LD + sc]); sr_[i].vs1 = *reinterpret_cast<const bf16x8*>(&Vh[(long)((k0) + 32 + sr) * LD + sc]); \
    sr_[i].ks0 = *reinterpret_cast<const bf16x8*>(&Kh[(long)((k0) + sr) * LD + sc]); sr_[i].ks1 = *reinterpret_cast<const bf16x8*>(&Kh[(long)((k0) + 32 + sr) * LD + sc]); } while (0)
#define SWRITE(b, i) do { *(bf16x8*)((char*)V_lds + (b) * SHM_V + vst0) = sr_[i].vs0;          \
    *(bf16x8*)((char*)V_lds + (b) * SHM_V + vst1) = sr_[i].vs1; int kc = sc * 2;               \
    *(bf16x8*)((char*)K_lds + (b) * SHM_K + KSWZ(sr, kc)) = sr_[i].ks0;                       \
    *(bf16x8*)((char*)K_lds + (b) * SHM_K + KSWZ(32 + sr, kc)) = sr_[i].ks1; } while (0)
#define SWAIT() asm volatile("s_waitcnt vmcnt(0)" ::: "memory")
#define RESC(a) do { if (__any((a) < 1.f)) { if (hi == 0) al_l[r32] = (a); asm volatile("s_waitcnt lgkmcnt(0)" ::: "memory"); \
    _Pragma("unroll") for (int d = 0; d < 4; ++d) _Pragma("unroll") for (int r = 0; r < 16; ++r) o[d][r] *= al_l[crow(r, hi)]; } } while (0)
  f32x16 pA0, pA1, pB0, pB1; float mnA, mnB, alA, alB; bf16x8 pa0, pa1, pa2, pa3; const int NT = seq / KVBLK;
  constexpr int SE = 0, SO = 0;
  SLOAD(SE, 0); asm volatile("s_waitcnt vmcnt(0)" ::: "memory"); SWRITE(0, SE); __syncthreads();
  qkt(pA0, pA1, K_lds, qr, r32, hi); partialSM(pA0, pA1, m_reg, mnA, alA);
  SLOAD(SO, KVBLK);
  SWAIT(); SWRITE(1, SO); __syncthreads();
  for (int j = 1; j + 1 < NT; j += 2) {
    SBAR(); qkt(pB0, pB1, (bf16_t*)((char*)K_lds + SHM_K), qr, r32, hi);
    finishSM(pA0, pA1, alA, l_reg, pa0, pa1, pa2, pa3); SBAR();
    SLOAD(SO, (j + 1) * KVBLK); SBAR();
    pv_d0(o, vb0, pa0, pa1, pa2, pa3); partialSM(pB0, pB1, m_reg, mnB, alB);
    __syncthreads(); SWAIT(); SWRITE(0, SE);
    RESC(alB); __syncthreads();
    SBAR(); qkt(pA0, pA1, K_lds, qr, r32, hi);
    finishSM(pB0, pB1, alB, l_reg, pa0, pa1, pa2, pa3); SBAR();
    SLOAD(SE, (j + 2) * KVBLK); SBAR();
    pv_d0(o, vb0 + (int)SHM_V, pa0, pa1, pa2, pa3); partialSM(pA0, pA1, m_reg, mnA, alA);
    __syncthreads(); SWAIT(); SWRITE(1, SO);
    RESC(alA); __syncthreads();
  }
  SBAR(); qkt(pB0, pB1, (bf16_t*)((char*)K_lds + SHM_K), qr, r32, hi);
  finishSM(pA0, pA1, alA, l_reg, pa0, pa1, pa2, pa3); SBAR();
  pv_d0(o, vb0, pa0, pa1, pa2, pa3); partialSM(pB0, pB1, m_reg, mnB, alB);
  __syncthreads(); RESC(alB);
  finishSM(pB0, pB1, alB, l_reg, pa0, pa1, pa2, pa3); SBAR();
  pv_d0(o, vb0 + (int)SHM_V, pa0, pa1, pa2, pa3);
  if (hi == 0) li_l[r32] = l_reg; asm volatile("s_waitcnt lgkmcnt(0)" ::: "memory");
  float rli[16];
#pragma unroll
  for (int r = 0; r < 16; ++r) rli[r] = __builtin_amdgcn_rcpf(li_l[crow(r, hi)]);
  bf16_t* Ow = Ob + (long)(wid * QBLK) * LDO;
#pragma unroll
  for (int r = 0; r < 16; ++r) { int orow = crow(r, hi);
#pragma unroll
    for (int d0 = 0; d0 < 4; ++d0) Ow[(long)orow * LDO + d0 * 32 + r32] = f2bf(o[d0][r] * rli[r]); }
  __syncthreads();
#undef SLOAD
#undef SWRITE
#undef SWAIT
#undef RESC
}
}

constexpr int RING_BYTES = 131072;
constexpr int LDSCTL_OFF = RING_BYTES, MISC_OFF = LDSCTL_OFF + 320, PTAB_OFF = LDSCTL_OFF + 1024;
constexpr int LDS_BYTES = 147456;

#define XB_TMO      128
#define XB_XCNT(j)  (256  + 64 * (j))
#define XB_XSUB(j)  (1280 + 64 * (j))
#define XB_XGEN(j)  (2304 + 64 * (j))
#define XB_TOP      3328
#define XB_TOPGEN   3392
#define XCD_BAR_WORDS 3456
#define XB_SPIN_CAP (1u << 22)
__device__ __forceinline__ unsigned xb_ld(unsigned* p)              { return __hip_atomic_load(p, __ATOMIC_RELAXED, __HIP_MEMORY_SCOPE_AGENT); }
__device__ __forceinline__ unsigned xb_add(unsigned* p, unsigned v) { return __hip_atomic_fetch_add(p, v, __ATOMIC_RELAXED, __HIP_MEMORY_SCOPE_AGENT); }
__device__ __forceinline__ unsigned xb_xcc_id() { return (unsigned)__builtin_amdgcn_s_getreg((3 << 11) | 20) & 0xFu; }
#define XB_SPIN(cond, bar) do { unsigned _sp = 0; while (cond) { __builtin_amdgcn_s_sleep(1); \
    if ((++_sp & 255u) == 0u) { if (xb_ld(&(bar)[XB_TMO])) break; if (_sp > XB_SPIN_CAP) { atomicAdd(&(bar)[XB_TMO], 1u); break; } } } } while (0)
struct XcdBarrier { unsigned* bar; unsigned x; volatile LAS unsigned* st; };
__device__ __forceinline__ XcdBarrier xcd_barrier_post(unsigned* bar, volatile LAS unsigned* st) {
    XcdBarrier b; b.bar = bar; b.x = xb_xcc_id(); b.st = st;
    if (threadIdx.x == 0) (void)xb_add(&bar[XB_XCNT(b.x)], 1u);
    return b;
}
__device__ __forceinline__ void xcd_barrier_complete(unsigned* bar, unsigned x, unsigned& nloc, unsigned& nx) {
    const unsigned G = gridDim.x * gridDim.y * gridDim.z;
    unsigned sum, cnt, mine, sp = 0u;
    for (;;) {
        sum = 0u; cnt = 0u;
        for (unsigned j = 0; j < 16; ++j) { const unsigned c = xb_ld(&bar[XB_XCNT(j)]); sum += c; cnt += (c > 0u) ? 1u : 0u; }
        mine = xb_ld(&bar[XB_XCNT(x)]);
        if (sum == G) break;
        __builtin_amdgcn_s_sleep(1);
        if ((++sp & 255u) == 0u) { if (xb_ld(&bar[XB_TMO])) break; if (sp > XB_SPIN_CAP) { atomicAdd(&bar[XB_TMO], 1u); break; } }
    }
    nloc = mine > 0u ? mine : 1u; nx = cnt > 0u ? cnt : 1u;
}
__device__ __forceinline__ XcdBarrier xcd_barrier_setup(unsigned* bar, volatile LAS unsigned* st) {
    XcdBarrier b = xcd_barrier_post(bar, st);
    if (threadIdx.x == 0) { unsigned nloc, nx; xcd_barrier_complete(bar, b.x, nloc, nx); st[0] = nloc; st[1] = nx; }
    __syncthreads();
    return b;
}
__device__ __forceinline__ void xcd_barrier(const XcdBarrier& b) {
    asm volatile("s_waitcnt vmcnt(0)" ::: "memory");
    __syncthreads();
    if (threadIdx.x == 0) {
        unsigned* bar = b.bar; unsigned bx = b.x;
        asm volatile("" : "+s"(bar), "+s"(bx));
        __builtin_amdgcn_s_waitcnt(0);
        const unsigned nloc = b.st[0], nx = b.st[1];
        const unsigned old = xb_add(&bar[XB_XSUB(bx)], 1u);
        const unsigned gen = old / nloc;
        if (old + 1u == (gen + 1u) * nloc) {
            __builtin_amdgcn_fence(__ATOMIC_RELEASE, "agent");
            asm volatile("s_waitcnt vmcnt(0)" ::: "memory");
            const unsigned og = xb_add(&bar[XB_TOP], 1u);
            const unsigned tg = og / nx;
            if (og + 1u == (tg + 1u) * nx) xb_add(&bar[XB_TOPGEN], 1u);
            else XB_SPIN(xb_ld(&bar[XB_TOPGEN]) == tg, bar);
            __builtin_amdgcn_fence(__ATOMIC_ACQUIRE, "agent");
            xb_add(&bar[XB_XGEN(bx)], 1u);
            asm volatile("s_waitcnt vmcnt(0)" ::: "memory");
        } else {
            XB_SPIN(xb_ld(&bar[XB_XGEN(bx)]) == gen, bar);
            __builtin_amdgcn_fence(__ATOMIC_ACQUIRE, "agent");
            asm volatile("s_waitcnt vmcnt(0)" ::: "memory");
        }
    }
    __syncthreads();
}

__device__ __forceinline__ void transpose_item(const float* W, int ldw, int K, int k0, int srccol0, bf16_t* WT, int dstrow0, LAS float* scr, int lane, const float* kgain = nullptr) {
    constexpr int P = 36;
    const int n4 = (lane & 7) * 4, kr = lane >> 3;
    f32x4 v[8];
    if (srccol0 >= 0) {
#pragma unroll
        for (int i = 0; i < 8; ++i) v[i] = *(const f32x4*)(W + (size_t)(k0 + 8 * i + kr) * ldw + srccol0 + n4);
        if (kgain) {
#pragma unroll
            for (int i = 0; i < 8; ++i) v[i] = v[i] * kgain[k0 + 8 * i + kr];
        }
    } else {
#pragma unroll
        for (int i = 0; i < 8; ++i) v[i] = (f32x4){0.f, 0.f, 0.f, 0.f};
    }
#pragma unroll
    for (int i = 0; i < 8; ++i) *(LAS f32x4*)(scr + (8 * i + kr) * P + n4) = v[i];
    LDS_WAIT(); asm volatile("" ::: "memory");
    const int c = lane & 7;
#pragma unroll
    for (int j = 0; j < 4; ++j) { const int n = (lane >> 3) + 8 * j; const LAS float* s = scr + (8 * c) * P + n;
        u32x4 o; o.x = cvt_pk_bf16(s[0 * P], s[1 * P]); o.y = cvt_pk_bf16(s[2 * P], s[3 * P]); o.z = cvt_pk_bf16(s[4 * P], s[5 * P]); o.w = cvt_pk_bf16(s[6 * P], s[7 * P]);
        *(u32x4*)(WT + (size_t)(dstrow0 + n) * K + k0 + 8 * c) = o; }
    LDS_WAIT(); asm volatile("" ::: "memory");
}
struct LayerW { const float *w_in, *w_bra, *w_brb, *w_brc, *w_out, *f1i, *f1o, *f2i, *f2o, *ng; };
__device__ __forceinline__ void phase_weights(const LayerW& w, unsigned char* ws, LAS unsigned char* lds, int gw, int NGW, int wave, int lane) {
    LAS float* scr = (LAS float*)(lds + wave * 16384);
    constexpr int I_IN = (NIN_PAD / 32) * (D / 64);
    constexpr int I_FI = (2 * FF / 32) * (D / 64);
    constexpr int I_FO = (D / 32) * (FF / 64);
    constexpr int I_BA = (D / 32) * (1024 / 64);
    constexpr int I_BB = (D / 32) * (512 / 64);
    constexpr int I_WO = (D / 32) * (D / 64);
    constexpr int NITEMS = I_IN + 2 * I_FI + 2 * I_FO + I_BA + 2 * I_BB + I_WO;
    for (int it = gw; it < NITEMS; it += NGW) {
        int r = it;
        if (r < I_IN) { const int nb = r % (NIN_PAD / 32), kb = r / (NIN_PAD / 32); const int d0 = nb * 32;
            const int src = d0 < 4608 ? d0 : (d0 < 10752 ? d0 + 32 : (d0 < 10784 ? 4608 + (d0 - 10752) : -1));
            transpose_item(w.w_in, NIN, D, kb * 64, src, (bf16_t*)(ws + WS_WIN), d0, scr, lane, w.ng + 2 * D); continue; } r -= I_IN;
        if (r < 2 * I_FI) { const int which = r / I_FI; r -= which * I_FI; const int nb = r % (2 * FF / 32), kb = r / (2 * FF / 32); const int d0 = nb * 32;
            const int t = d0 >> 8, within = d0 & 255; const int src = within < 128 ? 128 * t + within : FF + 128 * t + (within - 128);
            transpose_item(which ? w.f2i : w.f1i, 2 * FF, D, kb * 64, src, (bf16_t*)(ws + (which ? WS_WF2I : WS_WF1I)), d0, scr, lane, w.ng + (which ? 4 * D : 0)); continue; } r -= 2 * I_FI;
        if (r < 2 * I_FO) { const int which = r / I_FO; r -= which * I_FO; const int nb = r % (D / 32), kb = r / (D / 32);
            transpose_item(which ? w.f2o : w.f1o, D, FF, kb * 64, nb * 32, (bf16_t*)(ws + (which ? WS_WF2O : WS_WF1O)), nb * 32, scr, lane); continue; } r -= 2 * I_FO;
        if (r < I_BA) { const int nb = r % (D / 32), kb = r / (D / 32);
            transpose_item(w.w_bra, D, 1024, kb * 64, nb * 32, (bf16_t*)(ws + WS_WBRA), nb * 32, scr, lane); continue; } r -= I_BA;
        if (r < 2 * I_BB) { const int which = r / I_BB; r -= which * I_BB; const int nb = r % (D / 32), kb = r / (D / 32);
            transpose_item(which ? w.w_brc : w.w_brb, D, 512, kb * 64, nb * 32, (bf16_t*)(ws + (which ? WS_WBRC : WS_WBRB)), nb * 32, scr, lane); continue; } r -= 2 * I_BB;
        { const int nb = r % (D / 32), kb = r / (D / 32);
            transpose_item(w.w_out, D, D, kb * 64, nb * 32, (bf16_t*)(ws + WS_WOUT), nb * 32, scr, lane); }
    }
}
__device__ __forceinline__ void phase_norm(bf16_t* XB, const bf16_t* Y, float* RSTD, float* OUT, const float* gpost, float coef, int gw, int NGW, int lane) {
    for (int m = gw; m < M; m += NGW) {
        const u32x2* xr = (const u32x2*)(XB + (size_t)m * D) + lane; const u32x2* yr = (const u32x2*)(Y + (size_t)m * D) + lane;
        f32x4 x[8], y[8]; float s = 0.f;
#pragma unroll
        for (int j = 0; j < 8; ++j) { const u32x2 t = yr[64 * j], q = xr[64 * j]; y[j] = (f32x4){bflo(t.x), bfhi(t.x), bflo(t.y), bfhi(t.y)}; x[j] = (f32x4){bflo(q.x), bfhi(q.x), bflo(q.y), bfhi(q.y)};
            s += (y[j].x * y[j].x + y[j].y * y[j].y) + (y[j].z * y[j].z + y[j].w * y[j].w); }
        const float rstd = coef * (1.0f / sqrtf(wave_sum(s) * (1.0f / D) + EPS));
        float s2 = 0.f;
#pragma unroll
        for (int j = 0; j < 8; ++j) { const f32x4 g = ((const f32x4*)gpost)[lane + 64 * j]; x[j] = x[j] + y[j] * g * rstd; s2 += (x[j].x * x[j].x + x[j].y * x[j].y) + (x[j].z * x[j].z + x[j].w * x[j].w); }
        if (OUT) { f32x4* xo = (f32x4*)(OUT + (size_t)m * D) + lane;
#pragma unroll
            for (int j = 0; j < 8; ++j) xo[64 * j] = x[j];
        } else {
            u32x2* o8 = (u32x2*)(XB + (size_t)m * D) + lane;
#pragma unroll
            for (int j = 0; j < 8; ++j) { u32x2 w; w.x = cvt_pk_bf16(x[j].x, x[j].y); w.y = cvt_pk_bf16(x[j].z, x[j].w); o8[64 * j] = w; }
            const float r2 = 1.0f / sqrtf(wave_sum(s2) * (1.0f / D) + EPS);
            if (lane == 0) RSTD[m] = r2;
        }
    }
}
__device__ __forceinline__ void phase_prep(bf16_t* PROJ, const float* qk_gain  , LAS unsigned char* lds, int gw, int NGW, int tid, int lane) {
    LAS f32x2* cs = (LAS f32x2*)lds;
    for (int i = tid; i < 2048; i += 512) { const int pos = i >> 5, mi = i & 31; const float inv = powf(10000.0f, -(float)mi / 32.0f); float s, c; sincosf((float)pos * inv, &s, &c); cs[i] = (f32x2){c, s}; }
    __syncthreads();
    const float gq0 = qk_gain[2 * lane], gq1 = qk_gain[2 * lane + 1], gk0 = qk_gain[128 + 2 * lane], gk1 = qk_gain[128 + 2 * lane + 1];
    for (int m = gw; m < M; m += NGW) {
        const int t = m & (SEQ - 1), pr = t >> 6, pc = t & 63;
        const f32x2 c_s = cs[((lane < 32) ? pr : pc) * 32 + (lane & 31)];
        unsigned* row = (unsigned*)(PROJ + (size_t)m * NPROJ);
        unsigned v[10];
#pragma unroll
        for (int h = 0; h < 10; ++h) v[h] = row[h * 64 + lane];
#pragma unroll
        for (int h = 0; h < 10; ++h) {
            const float x1 = bflo(v[h]), x2 = bfhi(v[h]);
            const float rstd = 1.0f / sqrtf(wave_sum(x1 * x1 + x2 * x2) * (1.0f / 128.0f) + EPS);
            const float n1 = x1 * rstd * (h < 8 ? gq0 : gk0), n2 = x2 * rstd * (h < 8 ? gq1 : gk1);
            row[h * 64 + lane] = cvt_pk_bf16(n1 * c_s.x - n2 * c_s.y, n1 * c_s.y + n2 * c_s.x);
        }
    }
    __syncthreads();
}
__device__ __forceinline__ void tr_pair(unsigned base, int pitch, int row0, int col0, int lane, s16x4& lo, s16x4& hi) {
    const int g = lane >> 4, i = lane & 15;
    const unsigned addr = base + (unsigned)((row0 + 4 * g + (i >> 2)) * pitch + (col0 + 4 * (i & 3)) * 2);
    asm volatile("ds_read_b64_tr_b16 %0, %1" : "=&v"(lo) : "v"(addr) : "memory");
    asm volatile("ds_read_b64_tr_b16 %0, %1" : "=&v"(hi) : "v"(addr + (unsigned)(16 * pitch)) : "memory");
}
#define TR_JOIN(L, H) ((bf16x8){L[0], L[1], L[2], L[3], H[0], H[1], H[2], H[3]})
__device__ __forceinline__ bf16x8 pack8(const float* x) { u32x4 w; w.x = cvt_pk_bf16(x[0], x[1]); w.y = cvt_pk_bf16(x[2], x[3]); w.z = cvt_pk_bf16(x[4], x[5]); w.w = cvt_pk_bf16(x[6], x[7]); return *reinterpret_cast<bf16x8*>(&w); }
__device__ __forceinline__ void na_unit(bf16_t* PROJ, LAS unsigned char* lds, int u) {
    const int tid = opaque_tid(), lane = tid & 63, w = __builtin_amdgcn_readfirstlane(tid >> 6);
    constexpr int PV = 272, O_V = 0, O_RPB = 2 * 64 * PV;
    LAS float* rpbs = (LAS float*)(lds + O_RPB);
    const unsigned lbase = (unsigned)(uintptr_t)lds;
    const int ib = w & 3, vh = w >> 2;
    {
        int lane_o = lane; asm volatile("" : "+v"(lane_o));
        const int g = lane_o >> 4, li = lane_o & 15;
        const int r = u & 31, h = (u >> 5) & 3, b = u >> 7;
        const int rs = min(max(r - 4, 0), 24);
        const int c = 16 * ib + li, cs0 = min(max(c - 8, 0), 48);
        const size_t tq = (size_t)b * SEQ + r * 64 + c;
        bf16x8 qf[4];
#pragma unroll
        for (int ks = 0; ks < 4; ++ks) qf[ks] = *(const bf16x8*)(PROJ + tq * NPROJ + C_BQ + h * 128 + 32 * ks + 8 * g);
        int jbv[4], dcv[4];
#pragma unroll
        for (int rr = 0; rr < 4; ++rr) { const int km = 4 * g + rr; jbv[rr] = (cs0 + 15 - km) >> 4; dcv[rr] = 16 * jbv[rr] + km - c + 15; }
        f32x4 o[4];
#pragma unroll
        for (int vt = 0; vt < 4; ++vt) o[vt] = (f32x4){0.f, 0.f, 0.f, 0.f};
        float m_run = -1e30f, l_run = 0.f;
        const int sr = tid >> 4, sc = (tid & 15) * 8;
        const int jlo = ib > 1 ? ib - 1 : 0, jhi = ib < 2 ? ib + 1 : 3;
        bf16x8 kf[4][4], vr0, vr1;
#define NA_LOADK(kr_) do { const size_t kt_ = (size_t)b * SEQ + (size_t)(rs + (kr_)) * 64; \
            _Pragma("unroll") for (int jb = 0; jb < 4; ++jb) if (jb >= jlo && jb <= jhi) { const bf16_t* kp = PROJ + (kt_ + 16 * jb + li) * NPROJ + C_BK + h * 128 + 8 * g; \
                _Pragma("unroll") for (int ks = 0; ks < 4; ++ks) kf[jb][ks] = *(const bf16x8*)(kp + 32 * ks); } } while (0)
#define NA_LOADV(kr_) do { const size_t kt_ = (size_t)b * SEQ + (size_t)(rs + (kr_)) * 64; \
            vr0 = *(const bf16x8*)(PROJ + (kt_ + sr) * NPROJ + C_BV + h * 128 + sc); vr1 = *(const bf16x8*)(PROJ + (kt_ + sr + 32) * NPROJ + C_BV + h * 128 + sc); } while (0)
        NA_LOADV(0); NA_LOADK(0);
        for (int kr = 0; kr < 8; ++kr) {
            *(LAS bf16x8*)(lds + O_V + (kr & 1) * 64 * PV + sr * PV + sc * 2) = vr0; *(LAS bf16x8*)(lds + O_V + (kr & 1) * 64 * PV + (sr + 32) * PV + sc * 2) = vr1;
            if (kr + 1 < 8) NA_LOADV(kr + 1);
            f32x4 s[4];
#pragma unroll
            for (int jb = 0; jb < 4; ++jb) { s[jb] = (f32x4){0.f, 0.f, 0.f, 0.f};
                if (jb >= jlo && jb <= jhi) {
#pragma unroll
                    for (int ks = 0; ks < 4; ++ks) s[jb] = __builtin_amdgcn_mfma_f32_16x16x32_bf16(kf[jb][ks], qf[ks], s[jb], 0, 0, 0); } }
            if (kr + 1 < 8) NA_LOADK(kr + 1);
            const int dr = rs + kr - r + 7;
            float mx = -1e30f;
#pragma unroll
            for (int rr = 0; rr < 4; ++rr) { const float bias = rpbs[(h * 15 + dr) * 31 + dcv[rr]];
#pragma unroll
                for (int jb = 0; jb < 4; ++jb) { const float v = (jb == jbv[rr]) ? s[jb][rr] * 0.088388347648318440f + bias : -1e30f; s[jb][rr] = v; mx = fmaxf(mx, v); } }
            mx = fmaxf(mx, __shfl_xor(mx, 16)); mx = fmaxf(mx, __shfl_xor(mx, 32));
            const float m_new = fmaxf(m_run, mx), alpha = __expf(m_run - m_new);
            m_run = m_new;
            float ps = 0.f;
#pragma unroll
            for (int jb = 0; jb < 4; ++jb)
#pragma unroll
                for (int rr = 0; rr < 4; ++rr) { const float p = (jb == jbv[rr]) ? __expf(s[jb][rr] - m_new) : 0.f; s[jb][rr] = p; ps += p; }
            l_run = l_run * alpha + ps;
            bf16x8 pfr[2];
#pragma unroll
            for (int ss = 0; ss < 2; ++ss) { const float t[8] = {s[2 * ss][0], s[2 * ss][1], s[2 * ss][2], s[2 * ss][3], s[2 * ss + 1][0], s[2 * ss + 1][1], s[2 * ss + 1][2], s[2 * ss + 1][3]}; pfr[ss] = pack8(t); }
            __syncthreads();
            s16x4 vl[4][2], vhh[4][2];
            {
                const unsigned vbase = lbase + O_V + (unsigned)((kr & 1) * 64 * PV + (4 * g + (li >> 2)) * PV + (64 * vh + 4 * (li & 3)) * 2);
                asm volatile("ds_read_b64_tr_b16 %0, %16 offset:0\n\t"
                         "ds_read_b64_tr_b16 %1, %16 offset:4352\n\t"
                         "ds_read_b64_tr_b16 %2, %16 offset:8704\n\t"
                         "ds_read_b64_tr_b16 %3, %16 offset:13056\n\t"
                         "ds_read_b64_tr_b16 %4, %16 offset:32\n\t"
                         "ds_read_b64_tr_b16 %5, %16 offset:4384\n\t"
                         "ds_read_b64_tr_b16 %6, %16 offset:8736\n\t"
                         "ds_read_b64_tr_b16 %7, %16 offset:13088\n\t"
                         "ds_read_b64_tr_b16 %8, %16 offset:64\n\t"
                         "ds_read_b64_tr_b16 %9, %16 offset:4416\n\t"
                         "ds_read_b64_tr_b16 %10, %16 offset:8768\n\t"
                         "ds_read_b64_tr_b16 %11, %16 offset:13120\n\t"
                         "ds_read_b64_tr_b16 %12, %16 offset:96\n\t"
                         "ds_read_b64_tr_b16 %13, %16 offset:4448\n\t"
                         "ds_read_b64_tr_b16 %14, %16 offset:8800\n\t"
                         "ds_read_b64_tr_b16 %15, %16 offset:13152\n\t"
                         "s_waitcnt lgkmcnt(0)"
                         : "=&v"(vl[0][0]), "=&v"(vhh[0][0]), "=&v"(vl[0][1]), "=&v"(vhh[0][1]), "=&v"(vl[1][0]), "=&v"(vhh[1][0]), "=&v"(vl[1][1]), "=&v"(vhh[1][1]), "=&v"(vl[2][0]), "=&v"(vhh[2][0]), "=&v"(vl[2][1]), "=&v"(vhh[2][1]), "=&v"(vl[3][0]), "=&v"(vhh[3][0]), "=&v"(vl[3][1]), "=&v"(vhh[3][1])
                         : "v"(vbase) : "memory");
            }
            __builtin_amdgcn_sched_barrier(0);
#pragma unroll
            for (int vt = 0; vt < 4; ++vt) { o[vt] = o[vt] * alpha;
#pragma unroll
                for (int ss = 0; ss < 2; ++ss) o[vt] = __builtin_amdgcn_mfma_f32_16x16x32_bf16(TR_JOIN(vl[vt][ss], vhh[vt][ss]), pfr[ss], o[vt], 0, 0, 0); }
        }
#undef NA_LOADK
#undef NA_LOADV
        l_run += __shfl_xor(l_run, 16); l_run += __shfl_xor(l_run, 32);
        const float inv = 1.0f / l_run;
#pragma unroll
        for (int vt = 0; vt < 4; ++vt) { u32x2 ov; ov.x = cvt_pk_bf16(o[vt].x * inv, o[vt].y * inv); ov.y = cvt_pk_bf16(o[vt].z * inv, o[vt].w * inv);
            *(u32x2*)(PROJ + tq * NPROJ + C_BQ + h * 128 + 64 * vh + 16 * vt + 4 * g) = ov; }
        __syncthreads();
    }
}
__device__ __forceinline__ void na_load_bias(const float* rpb, LAS unsigned char* lds) {
    const int tid = opaque_tid(); LAS float* rpbs = (LAS float*)(lds + 2 * 64 * 272);
    __syncthreads();
    for (int i = tid; i < 4 * 15 * 31; i += 512) rpbs[i] = rpb[i];
    __syncthreads();
}
__device__ __forceinline__ float logsig16(float z) { return (fminf(z, 0.f) - __logf(1.0f + __expf(-fabsf(z)))) * (1.0f / 16.0f); }
__device__ __forceinline__ void gla_seq_unit(const bf16_t* PROJ, const float* LR, const float* w_decay  , const float* b_decay  , bf16_t* OFB, bf16_t* OC, const float* onorm,
                                             LAS unsigned char* lds, int b, int h) {
    const int tid = opaque_tid(), lane = tid & 63, w = __builtin_amdgcn_readfirstlane(tid >> 6);
    constexpr int P64 = 144, PV = 272;
    constexpr int O_Q = 0, O_K = 9216, O_KH = 18432, O_V = 27648, O_S = 45056, O_DEC = 63488, O_W2 = 63744;
    const unsigned lbase = (unsigned)(uintptr_t)lds;
    const int ib = w & 3, vh = w >> 2, g = lane >> 4, li = lane & 15;
    LAS float* w2s = (LAS float*)(lds + O_W2);
    LAS float* red = (LAS float*)(lds + 68096);
  for (int dir = 0; dir < 2; ++dir) {
    __syncthreads();
    for (int i = tid; i < 16 * 64; i += 512) w2s[i] = w_decay[dir * 4096 + (i >> 6) * 256 + h * 64 + (i & 63)];
    if (tid < 64) w2s[1024 + tid] = b_decay[dir * 256 + h * 64 + tid];
    for (int i = tid; i < 128 * 72 / 2; i += 512) ((LAS unsigned*)(lds + O_S))[i] = 0u;
    f32x4 S[4];
#pragma unroll
    for (int vt = 0; vt < 4; ++vt) S[vt] = (f32x4){0.f, 0.f, 0.f, 0.f};
    const int dcol = 8 * w;
    const int sr = tid >> 4, sc = (tid & 15) * 8;
    f32x4 lr4[4]; u32x4 qraw, kraw; bf16x8 vst0, vst1;
#define GLA_LOAD(cc_) do { const int c_ = dir ? 31 - (cc_) : (cc_); const size_t m0_ = (size_t)b * SEQ + c_ * 64, m_ = m0_ + lane; \
        _Pragma("unroll") for (int j = 0; j < 4; ++j) lr4[j] = ((const f32x4*)(LR + m_ * 32 + dir * 16))[j]; \
        qraw = *(const u32x4*)(PROJ + m_ * NPROJ + C_CQ + h * 64 + dcol); kraw = *(const u32x4*)(PROJ + m_ * NPROJ + C_CK + h * 64 + dcol); \
        vst0 = *(const bf16x8*)(PROJ + (m0_ + sr) * NPROJ + C_CV + h * 128 + sc); vst1 = *(const bf16x8*)(PROJ + (m0_ + sr + 32) * NPROJ + C_CV + h * 128 + sc); } while (0)
    GLA_LOAD(0);
    __syncthreads();
    for (int cc = 0; cc < 32; ++cc) {
        const int c = dir ? 31 - cc : cc; const size_t m0 = (size_t)b * SEQ + c * 64;
        {
            f32x4 z0 = *(const LAS f32x4*)(w2s + 1024 + dcol), z1 = *(const LAS f32x4*)(w2s + 1024 + dcol + 4);
#pragma unroll
            for (int j = 0; j < 4; ++j)
#pragma unroll
                for (int rr = 0; rr < 4; ++rr) { const int r = 4 * j + rr; z0 = z0 + *(const LAS f32x4*)(w2s + r * 64 + dcol) * lr4[j][rr]; z1 = z1 + *(const LAS f32x4*)(w2s + r * 64 + dcol + 4) * lr4[j][rr]; }
            float bs[8];
#pragma unroll
            for (int e = 0; e < 4; ++e) { bs[e] = logsig16(z0[e]); bs[4 + e] = logsig16(z1[e]); }
            if (dir == 0) {
#pragma unroll
                for (int off = 1; off < 64; off <<= 1)
#pragma unroll
                    for (int e = 0; e < 8; ++e) { const float t = __shfl_up(bs[e], off); if (lane >= off) bs[e] += t; }
            } else {
#pragma unroll
                for (int off = 1; off < 64; off <<= 1)
#pragma unroll
                    for (int e = 0; e < 8; ++e) { const float t = __shfl_down(bs[e], off); if (lane + off < 64) bs[e] += t; }
            }
            const float q[8] = {bflo(qraw.x), bfhi(qraw.x), bflo(qraw.y), bfhi(qraw.y), bflo(qraw.z), bfhi(qraw.z), bflo(qraw.w), bfhi(qraw.w)};
            const float k[8] = {bflo(kraw.x), bfhi(kraw.x), bflo(kraw.y), bfhi(kraw.y), bflo(kraw.z), bfhi(kraw.z), bflo(kraw.w), bfhi(kraw.w)};
            float qt[8], kt[8], kh[8], dc[8];
#pragma unroll
            for (int e = 0; e < 8; ++e) { const float be = __shfl(bs[e], dir ? 0 : 63);
                qt[e] = q[e] * 0.125f * __expf(bs[e]); kt[e] = k[e] * __expf(-bs[e]); kh[e] = k[e] * __expf(be - bs[e]); dc[e] = __expf(be); }
            *(LAS bf16x8*)(lds + O_Q + lane * P64 + 16 * w) = pack8(qt); *(LAS bf16x8*)(lds + O_K + lane * P64 + 16 * w) = pack8(kt); *(LAS bf16x8*)(lds + O_KH + lane * P64 + 16 * w) = pack8(kh);
            if (lane == 0) { *(LAS f32x4*)(lds + O_DEC + 4 * dcol) = (f32x4){dc[0], dc[1], dc[2], dc[3]}; *(LAS f32x4*)(lds + O_DEC + 4 * dcol + 16) = (f32x4){dc[4], dc[5], dc[6], dc[7]}; }
            *(LAS bf16x8*)(lds + O_V + sr * PV + sc * 2) = vst0; *(LAS bf16x8*)(lds + O_V + (sr + 32) * PV + sc * 2) = vst1;
        }
        __syncthreads();
        if (cc + 1 < 32) GLA_LOAD(cc + 1);
        const size_t mi = m0 + 16 * ib + li; f32x4 oo[4]; float ss = 0.f;
        {
            bf16x8 qF[2];
#pragma unroll
            for (int ks = 0; ks < 2; ++ks) qF[ks] = *(const LAS bf16x8*)(lds + O_Q + (16 * ib + li) * P64 + (32 * ks + 8 * g) * 2);
            f32x4 P[4];
#pragma unroll
            for (int jb = 0; jb < 4; ++jb) {
                f32x4 a = {0.f, 0.f, 0.f, 0.f};
                const bool need = dir ? (jb >= ib) : (jb <= ib);
                if (need) {
#pragma unroll
                    for (int ks = 0; ks < 2; ++ks) a = __builtin_amdgcn_mfma_f32_16x16x32_bf16(*(const LAS bf16x8*)(lds + O_K + (16 * jb + li) * P64 + (32 * ks + 8 * g) * 2), qF[ks], a, 0, 0, 0); }
#pragma unroll
                for (int r = 0; r < 4; ++r) { const int jl = 4 * g + r;
                    const bool keep = (jb == ib) ? (dir ? (jl >= li) : (jl <= li)) : need;
                    P[jb][r] = keep ? a[r] : 0.f; }
            }
            bf16x8 pfr[2];
#pragma unroll
            for (int s = 0; s < 2; ++s) { const float t[8] = {P[2 * s][0], P[2 * s][1], P[2 * s][2], P[2 * s][3], P[2 * s + 1][0], P[2 * s + 1][1], P[2 * s + 1][2], P[2 * s + 1][3]}; pfr[s] = pack8(t); }
            s16x4 vl[4][2], vhh[4][2], kl[2], kh2[2];
            {
                const unsigned vbase = lbase + O_V + (unsigned)((4 * g + (li >> 2)) * PV + (64 * vh + 4 * (li & 3)) * 2);
                const unsigned kbase = lbase + O_KH + (unsigned)((4 * g + (li >> 2)) * P64 + (16 * ib + 4 * (li & 3)) * 2);
                asm volatile("ds_read_b64_tr_b16 %0, %20 offset:0\n\t"
                         "ds_read_b64_tr_b16 %1, %20 offset:4352\n\t"
                         "ds_read_b64_tr_b16 %2, %20 offset:8704\n\t"
                         "ds_read_b64_tr_b16 %3, %20 offset:13056\n\t"
                         "ds_read_b64_tr_b16 %4, %20 offset:32\n\t"
                         "ds_read_b64_tr_b16 %5, %20 offset:4384\n\t"
                         "ds_read_b64_tr_b16 %6, %20 offset:8736\n\t"
                         "ds_read_b64_tr_b16 %7, %20 offset:13088\n\t"
                         "ds_read_b64_tr_b16 %8, %20 offset:64\n\t"
                         "ds_read_b64_tr_b16 %9, %20 offset:4416\n\t"
                         "ds_read_b64_tr_b16 %10, %20 offset:8768\n\t"
                         "ds_read_b64_tr_b16 %11, %20 offset:13120\n\t"
                         "ds_read_b64_tr_b16 %12, %20 offset:96\n\t"
                         "ds_read_b64_tr_b16 %13, %20 offset:4448\n\t"
                         "ds_read_b64_tr_b16 %14, %20 offset:8800\n\t"
                         "ds_read_b64_tr_b16 %15, %20 offset:13152\n\t"
                         "ds_read_b64_tr_b16 %16, %21 offset:0\n\t"
                         "ds_read_b64_tr_b16 %17, %21 offset:2304\n\t"
                         "ds_read_b64_tr_b16 %18, %21 offset:4608\n\t"
                         "ds_read_b64_tr_b16 %19, %21 offset:6912\n\t"
                         "s_waitcnt lgkmcnt(0)"
                         : "=&v"(vl[0][0]), "=&v"(vhh[0][0]), "=&v"(vl[0][1]), "=&v"(vhh[0][1]), "=&v"(vl[1][0]), "=&v"(vhh[1][0]), "=&v"(vl[1][1]), "=&v"(vhh[1][1]), "=&v"(vl[2][0]), "=&v"(vhh[2][0]), "=&v"(vl[2][1]), "=&v"(vhh[2][1]), "=&v"(vl[3][0]), "=&v"(vhh[3][0]), "=&v"(vl[3][1]), "=&v"(vhh[3][1]), "=&v"(kl[0]), "=&v"(kh2[0]), "=&v"(kl[1]), "=&v"(kh2[1])
                         : "v"(vbase), "v"(kbase) : "memory");
            }
            bf16x8 sfr[4][2];
#pragma unroll
            for (int vt = 0; vt < 4; ++vt)
#pragma unroll
                for (int ks = 0; ks < 2; ++ks) sfr[vt][ks] = *(const LAS bf16x8*)(lds + O_S + (64 * vh + 16 * vt + li) * P64 + (32 * ks + 8 * g) * 2);
            const float dec = *(const LAS float*)(lds + O_DEC + 4 * (16 * ib + li));
            __builtin_amdgcn_sched_barrier(0);
#pragma unroll
            for (int vt = 0; vt < 4; ++vt) {
                const int v0 = 64 * vh + 16 * vt;
                f32x4 o = {0.f, 0.f, 0.f, 0.f};
#pragma unroll
                for (int s = 0; s < 2; ++s) o = __builtin_amdgcn_mfma_f32_16x16x32_bf16(TR_JOIN(vl[vt][s], vhh[vt][s]), pfr[s], o, 0, 0, 0);
#pragma unroll
                for (int ks = 0; ks < 2; ++ks) o = __builtin_amdgcn_mfma_f32_16x16x32_bf16(sfr[vt][ks], qF[ks], o, 0, 0, 0);
                if (dir == 0) { u32x2 ov; ov.x = (unsigned)f2bf(o.x) | ((unsigned)f2bf(o.y) << 16); ov.y = (unsigned)f2bf(o.z) | ((unsigned)f2bf(o.w) << 16);
                    *(u32x2*)(OFB + mi * 512 + h * 128 + v0 + 4 * g) = ov; }
                else { const u32x2 f = *(const u32x2*)(OFB + mi * 512 + h * 128 + v0 + 4 * g);
                    o.x += bflo(f.x); o.y += bfhi(f.x); o.z += bflo(f.y); o.w += bfhi(f.y); oo[vt] = o; ss += (o.x * o.x + o.y * o.y) + (o.z * o.z + o.w * o.w); }
                f32x4 sn = S[vt] * dec;
#pragma unroll
                for (int s = 0; s < 2; ++s) sn = __builtin_amdgcn_mfma_f32_16x16x32_bf16(TR_JOIN(vl[vt][s], vhh[vt][s]), TR_JOIN(kl[s], kh2[s]), sn, 0, 0, 0);
                S[vt] = sn;
            }
        }
        if (dir) { ss += __shfl_xor(ss, 16); ss += __shfl_xor(ss, 32); if (g == 0) red[vh * 64 + 16 * ib + li] = ss; }
        __syncthreads();
        if (dir) {
            const float rstd = 1.0f / sqrtf((red[16 * ib + li] + red[64 + 16 * ib + li]) * (1.0f / 128.0f) + EPS);
#pragma unroll
            for (int vt = 0; vt < 4; ++vt) { const int v0 = 64 * vh + 16 * vt;
                const u32x2 og = *(const u32x2*)(PROJ + mi * NPROJ + C_OG + h * 128 + v0 + 4 * g); const f32x4 gn = *(const f32x4*)(onorm + v0 + 4 * g);
                u32x2 ov; ov.x = cvt_pk_bf16(oo[vt].x * rstd * gn.x * pg8::silu_f(bflo(og.x)), oo[vt].y * rstd * gn.y * pg8::silu_f(bfhi(og.x)));
                ov.y = cvt_pk_bf16(oo[vt].z * rstd * gn.z * pg8::silu_f(bflo(og.y)), oo[vt].w * rstd * gn.w * pg8::silu_f(bfhi(og.y)));
                *(u32x2*)(OC + mi * 512 + h * 128 + v0 + 4 * g) = ov; }
        }
#pragma unroll
        for (int vt = 0; vt < 4; ++vt)
#pragma unroll
            for (int r = 0; r < 4; ++r) *(LAS bf16_t*)(lds + O_S + (64 * vh + 16 * vt + 4 * g + r) * P64 + (16 * ib + li) * 2) = f2bf(S[vt][r]);
    }
    __syncthreads();
  }
#undef GLA_LOAD
}
constexpr int NPH = 15;
enum { P_F1A = 0, P_F1B, P_N1, P_M1, P_PREP, P_ATT, P_NA, P_GLA, P_GLC, P_M4, P_M5, P_N2, P_F2A, P_F2B, P_N3 };
constexpr int NGP = 1 + DEPTH * NPH;
struct Args { const float* in[18]; float* out; unsigned char* ws; int gp_lo, gp_hi; };

typedef decltype(__builtin_amdgcn_kernarg_segment_ptr()) kargp_t;
__device__ __forceinline__ unsigned long long karg_q(int byte_off) { kargp_t p_ = __builtin_amdgcn_kernarg_segment_ptr(); asm volatile("" : "+s"(p_));
    return *(const unsigned long long __attribute__((address_space(4)))*)((const char __attribute__((address_space(4)))*)p_ + byte_off); }
__global__ void __launch_bounds__(512, 2) fwd(Args args) {
    extern __shared__ __attribute__((aligned(16))) unsigned char lds_raw[];
    LAS unsigned char* const lds0 = (LAS unsigned char*)lds_raw;
    const int G0 = gridDim.x, wg0 = blockIdx.x;
#define PENV LAS unsigned char* lds = lds0; int G = G0, wg = wg0; asm volatile("" : "+s"(lds), "+s"(G), "+s"(wg)); const int NGW = G * 8; (void)NGW; (void)lds; (void)wg
    volatile LAS unsigned* MISC = (volatile LAS unsigned*)(lds0 + MISC_OFF);
    volatile LAS unsigned long long* PT = (volatile LAS unsigned long long*)(lds0 + PTAB_OFF);
    { const int t0 = threadIdx.x;
      for (int u = t0; u < (LDS_BYTES - LDSCTL_OFF) / 4; u += 512) ((LAS unsigned*)(lds0 + LDSCTL_OFF))[u] = 0u;
      __syncthreads();
      __syncthreads(); }
#if ONE_LAUNCH
    constexpr int lo = 0, hi = NGP;
#else
    const int lo = args.gp_lo, hi = args.gp_hi;
#endif
    XcdBarrier bar; bar.bar = (unsigned*)(args.ws + WS_CTL) + CW_BAR; bar.x = 0; bar.st = nullptr;
    if (hi - lo > 1) bar = xcd_barrier_setup((unsigned*)(args.ws + WS_CTL) + CW_BAR, MISC + 8);
#define SEAM(gp) do { if ((gp) + 1 < hi) xcd_barrier(bar); } while (0)
#define INP(i) ((const float*)(const GAS float*)karg_q(8 * (i)))
#define WSP() ((unsigned char*)(GAS unsigned char*)karg_q(8 * 19))
#define XP() ((float*)(GAS float*)karg_q(8 * 18))
#define TIDS() PENV; const int tid = opaque_tid(), lane = tid & 63, wave = __builtin_amdgcn_readfirstlane(tid >> 6), gw = wg * 8 + wave; (void)tid; (void)lane; (void)wave; (void)gw

    if (((PHASE_MASK >> 31) & 1u) && lo <= 0 && 0 < hi) {
        TIDS(); unsigned char* ws = WSP(); bf16_t* XB = (bf16_t*)(ws + WS_XN); float* RSTD = (float*)(ws + WS_RSTD);
        LayerW w; w.w_in = INP(3); w.w_bra = INP(10); w.w_brb = INP(11); w.w_brc = INP(12); w.w_out = INP(13); w.f1i = INP(14); w.f1o = INP(15); w.f2i = INP(16); w.f2o = INP(17); w.ng = INP(2);
        phase_weights(w, ws, lds, gw, NGW, wave, lane);
        const float* xp = INP(0); const float* xs = INP(1);
        for (int m = gw; m < M; m += NGW) {
            const float* src = m < 16 * SEQ ? xp + (size_t)m * D : xs + (size_t)(m - 16 * SEQ) * D;
            const f32x4* xr = (const f32x4*)src + lane; f32x4 x[8]; float s = 0.f;
#pragma unroll
            for (int j = 0; j < 8; ++j) { x[j] = xr[64 * j]; s += (x[j].x * x[j].x + x[j].y * x[j].y) + (x[j].z * x[j].z + x[j].w * x[j].w); }
            u32x2* o8 = (u32x2*)(XB + (size_t)m * D) + lane;
#pragma unroll
            for (int j = 0; j < 8; ++j) { u32x2 wv; wv.x = cvt_pk_bf16(x[j].x, x[j].y); wv.y = cvt_pk_bf16(x[j].z, x[j].w); o8[64 * j] = wv; }
            const float rstd = 1.0f / sqrtf(wave_sum(s) * (1.0f / D) + EPS);
            if (lane == 0) RSTD[m] = rstd;
        }
        SEAM(0);
    }
    for (int l = 0; l < DEPTH; ++l) {
        const int gp0 = 1 + l * NPH;
        if (gp0 + NPH <= lo || gp0 >= hi) continue;
#define IN(p) (((PHASE_MASK >> (p)) & 1u) && lo <= gp0 + (p) && gp0 + (p) < hi)
#define FFN_PAIR(ff, pa, pb) do { \
        if (IN(pa)) { PENV; unsigned char* ws = WSP(); pg8::Gemm g{(const bf16_t*)(ws + WS_XN), (const bf16_t*)(ws + ((ff) ? WS_WF2I : WS_WF1I)), M, 2 * FF, D, D}; pg8::StaticOrder S; S.init(M, 2 * FF, G, wg, WGM_FI); \
            pg8::EpiSwiGLU E{(bf16_t*)(ws + WS_H), (const float*)(ws + WS_RSTD)}; pg8::gemm_phase<pg8::EpiSwiGLU, pg8::StaticOrder, true, true>(lds, g, S, E); if ((DUP_MASK >> (pa)) & 1u) pg8::gemm_phase<pg8::EpiSwiGLU, pg8::StaticOrder, true, true>(lds, g, S, E); SEAM(gp0 + (pa)); } \
        if (IN(pb)) { PENV; unsigned char* ws = WSP(); pg8::Gemm g{(const bf16_t*)(ws + WS_H), (const bf16_t*)(ws + ((ff) ? WS_WF2O : WS_WF1O)), M, D, FF, FF}; pg8::StaticOrder S; S.init(M, D, G, wg, WGM_FO); \
            pg8::EpiBf16Plain E{(bf16_t*)(ws + WS_Y), D}; pg8::gemm_phase<pg8::EpiBf16Plain, pg8::StaticOrder, true, true>(lds, g, S, E); if ((DUP_MASK >> (pb)) & 1u) pg8::gemm_phase<pg8::EpiBf16Plain, pg8::StaticOrder, true, true>(lds, g, S, E); SEAM(gp0 + (pb)); } } while (0)
#define NORM_PHASE(p, ipost, coef, last) do { if (IN(p)) { TIDS(); unsigned char* ws = WSP(); const float* ng = INP(2) + (size_t)l * 6 * D; \
            phase_norm((bf16_t*)(ws + WS_XN), (const bf16_t*)(ws + WS_Y), (float*)(ws + WS_RSTD), (last) ? XP() : nullptr, ng + (ipost) * D, (coef), gw, NGW, lane);

        FFN_PAIR(0, P_F1A, P_F1B);
        NORM_PHASE(P_N1, 1, 0.5f, false) SEAM(gp0 + P_N1); } } while (0);
        if (IN(P_M1)) { PENV;
            unsigned char* ws = WSP();
            pg8::Gemm g{(const bf16_t*)(ws + WS_XN), (const bf16_t*)(ws + WS_WIN), M, NIN_PAD, D, D}; pg8::StaticOrder S; S.init(M, NIN_PAD, G, wg, WGM_M1);
            pg8::EpiProj E{(bf16_t*)(ws + WS_PROJ), (bf16_t*)(ws + WS_GATES), (float*)(ws + WS_LR), INP(4) + (size_t)l * 3 * D, (const float*)(ws + WS_RSTD)};
            pg8::gemm_phase<pg8::EpiProj, pg8::StaticOrder, true, true>(lds, g, S, E);
            if ((DUP_MASK >> P_M1) & 1u) pg8::gemm_phase<pg8::EpiProj, pg8::StaticOrder, true, true>(lds, g, S, E);
            SEAM(gp0 + P_M1);
        }
        if (IN(P_PREP)) {
            { TIDS(); unsigned char* ws = WSP(); phase_prep((bf16_t*)(ws + WS_PROJ), INP(5) + (size_t)l * 256, lds, gw, NGW, tid, lane); }
            SEAM(gp0 + P_PREP);
        }
        if (IN(P_ATT)) { PENV;
            unsigned char* ws = WSP(); bf16_t* PROJ = (bf16_t*)(ws + WS_PROJ);
            const int ngrp = (G % 8 == 0) ? 8 : 1, xg = wg % ngrp, slot = wg / ngrp, per = G / ngrp;
            for (int gu = slot; gu < 96 / ngrp; gu += per) { const int U = xg * (96 / ngrp) + gu;
                gla_seq_unit(PROJ, (const float*)(ws + WS_LR), INP(7) + (size_t)l * 2 * 16 * 256, INP(8) + (size_t)l * 512, (bf16_t*)(ws + WS_OFB), (bf16_t*)(ws + WS_OC), INP(9) + (size_t)l * 128, lds, U >> 2, U & 3); }
            na_load_bias(INP(6) + (size_t)l * 4 * 15 * 31, lds);
            unsigned* head = (unsigned*)(ws + WS_CTL) + CW_Q + (l * 8 + xg) * 64;
            const int n_att = 1536 / ngrp, n_na = 3072 / ngrp;
            LAS unsigned* qslot = (LAS unsigned*)(lds + MISC_OFF + 64);
            for (;;) {
                __syncthreads();
                if (threadIdx.x == 0) *qslot = __hip_atomic_fetch_add(head, 1u, __ATOMIC_RELAXED, __HIP_MEMORY_SCOPE_AGENT);
                __syncthreads();
                const int idx = __builtin_amdgcn_readfirstlane((int)*(volatile LAS unsigned*)qslot);
                if (idx >= n_att * (1 + ATT_DUP) + n_na) break;
                if (idx < n_att * (1 + ATT_DUP)) { const int idx0 = idx; const int idx = idx0 % n_att;
                    const int rnd = idx >> 5, mem = idx & 31, grp = (ngrp == 8) ? rnd * 8 + xg : rnd;
                    const int b = grp >> 1, kvh = grp & 1, h = kvh * 4 + (mem >> 3), qb = mem & 7;
                    const size_t rowq = (size_t)b * SEQ + qb * 256, rowk = (size_t)b * SEQ;
                    bf16_t* Qp = PROJ + rowq * NPROJ + C_AQ + h * 128;
                    att::attn_dense_body(Qp, PROJ + rowk * NPROJ + C_AK + kvh * 128, PROJ + rowk * NPROJ + C_AV + kvh * 128, (bf16_t*)(ws + WS_OA) + rowq * 1024 + h * 128, SEQ, (char*)lds_raw + 49152);
                } else {
                    na_unit(PROJ, lds, xg * n_na + (idx - n_att * (1 + ATT_DUP)));
                }
            }
            SEAM(gp0 + P_GLA);
        }
        if (IN(P_M4)) { PENV;
            { unsigned char* ws = WSP(); pg8::Gemm g{(const bf16_t*)(ws + WS_OA), (const bf16_t*)(ws + WS_WBRA), M, D, 1024, 1024}; pg8::StaticOrder S; S.init(M, D, G, wg, WGM_M45);
              pg8::EpiMerge<true> E{(const bf16_t*)(ws + WS_GATES), (bf16_t*)(ws + WS_MG)}; pg8::gemm_phase<pg8::EpiMerge<true>, pg8::StaticOrder, true, true>(lds, g, S, E); }
            { unsigned char* ws = WSP(); pg8::Gemm g{(const bf16_t*)(ws + WS_PROJ) + C_BQ, (const bf16_t*)(ws + WS_WBRB), M, D, 512, NPROJ}; pg8::StaticOrder S; S.init(M, D, G, wg, WGM_M45);
              pg8::EpiMerge<false> E{(const bf16_t*)(ws + WS_GATES) + D, (bf16_t*)(ws + WS_MG)}; pg8::gemm_phase<pg8::EpiMerge<false>, pg8::StaticOrder, true, true>(lds, g, S, E); }
            { unsigned char* ws = WSP(); pg8::Gemm g{(const bf16_t*)(ws + WS_OC), (const bf16_t*)(ws + WS_WBRC), M, D, 512, 512}; pg8::StaticOrder S; S.init(M, D, G, wg, WGM_M45);
              pg8::EpiMerge<false> E{(const bf16_t*)(ws + WS_GATES) + 2 * D, (bf16_t*)(ws + WS_MG)}; pg8::gemm_phase<pg8::EpiMerge<false>, pg8::StaticOrder, true, true>(lds, g, S, E); }
            if ((DUP_MASK >> P_M4) & 1u) {
            { unsigned char* ws = WSP(); pg8::Gemm g{(const bf16_t*)(ws + WS_OA), (const bf16_t*)(ws + WS_WBRA), M, D, 1024, 1024}; pg8::StaticOrder S; S.init(M, D, G, wg, WGM_M45);
              pg8::EpiMerge<true> E{(const bf16_t*)(ws + WS_GATES), (bf16_t*)(ws + WS_MG)}; pg8::gemm_phase<pg8::EpiMerge<true>, pg8::StaticOrder, true, true>(lds, g, S, E); }
            { unsigned char* ws = WSP(); pg8::Gemm g{(const bf16_t*)(ws + WS_PROJ) + C_BQ, (const bf16_t*)(ws + WS_WBRB), M, D, 512, NPROJ}; pg8::StaticOrder S; S.init(M, D, G, wg, WGM_M45);
              pg8::EpiMerge<false> E{(const bf16_t*)(ws + WS_GATES) + D, (bf16_t*)(ws + WS_MG)}; pg8::gemm_phase<pg8::EpiMerge<false>, pg8::StaticOrder, true, true>(lds, g, S, E); }
            { unsigned char* ws = WSP(); pg8::Gemm g{(const bf16_t*)(ws + WS_OC), (const bf16_t*)(ws + WS_WBRC), M, D, 512, 512}; pg8::StaticOrder S; S.init(M, D, G, wg, WGM_M45);
              pg8::EpiMerge<false> E{(const bf16_t*)(ws + WS_GATES) + 2 * D, (bf16_t*)(ws + WS_MG)}; pg8::gemm_phase<pg8::EpiMerge<false>, pg8::StaticOrder, true, true>(lds, g, S, E); }
            }
            SEAM(gp0 + P_M4);
        }
        if (IN(P_M5)) { PENV;
            unsigned char* ws = WSP();
            pg8::Gemm g{(const bf16_t*)(ws + WS_MG), (const bf16_t*)(ws + WS_WOUT), M, D, D, D}; pg8::StaticOrder S; S.init(M, D, G, wg, WGM_M45);
            pg8::EpiBf16Plain E{(bf16_t*)(ws + WS_Y), D};
            pg8::gemm_phase<pg8::EpiBf16Plain, pg8::StaticOrder, true, true>(lds, g, S, E);
            if ((DUP_MASK >> P_M5) & 1u) pg8::gemm_phase<pg8::EpiBf16Plain, pg8::StaticOrder, true, true>(lds, g, S, E);
            SEAM(gp0 + P_M5);
        }
        NORM_PHASE(P_N2, 3, 1.0f, false) SEAM(gp0 + P_N2); } } while (0);
        FFN_PAIR(1, P_F2A, P_F2B);
        NORM_PHASE(P_N3, 5, 0.5f, (l + 1 == DEPTH))
            if (l + 1 < DEPTH) { LayerW w; w.w_in = INP(3) + (size_t)(l + 1) * D * NIN; w.w_bra = INP(10) + (size_t)(l + 1) * 1024 * D; w.w_brb = INP(11) + (size_t)(l + 1) * 512 * D; w.w_brc = INP(12) + (size_t)(l + 1) * 512 * D;
                w.w_out = INP(13) + (size_t)(l + 1) * D * D; w.f1i = INP(14) + (size_t)(l + 1) * D * 2 * FF; w.f1o = INP(15) + (size_t)(l + 1) * FF * D; w.f2i = INP(16) + (size_t)(l + 1) * D * 2 * FF; w.f2o = INP(17) + (size_t)(l + 1) * FF * D; w.ng = INP(2) + (size_t)(l + 1) * 6 * D;
                phase_weights(w, ws, lds, gw, NGW, wave, lane); if ((DUP_MASK >> 20) & 1u) phase_weights(w, ws, lds, gw, NGW, wave, lane); }
            SEAM(gp0 + P_N3); } } while (0);
#undef FFN_PAIR
#undef NORM_PHASE
#undef IN
    }
#undef SEAM
}

extern "C" void kernel_launch(void* const* d_in, const int* in_sizes, int n_in, void* d_out, int out_size, void* d_ws, size_t ws_size, hipStream_t stream) {
    static int grid = 0;
    if (grid == 0) {
        if (n_in != 18 || out_size != M * D || ws_size < WS_END) { fprintf(stderr, "kernel_launch: unexpected shapes: n_in %d out %d ws %zu (need %zu)\n", n_in, out_size, ws_size, (size_t)WS_END); grid = -1; return; }
        int dev = 0, cus = 0, per_cu = 0;
        if (hipGetDevice(&dev) != hipSuccess || hipDeviceGetAttribute(&cus, hipDeviceAttributeMultiprocessorCount, dev) != hipSuccess) { grid = -1; return; }
        if (hipFuncSetAttribute((const void*)fwd, hipFuncAttributeMaxDynamicSharedMemorySize, LDS_BYTES) != hipSuccess) { fprintf(stderr, "kernel_launch: hipFuncSetAttribute failed\n"); grid = -1; return; }
        if (hipOccupancyMaxActiveBlocksPerMultiprocessor(&per_cu, (const void*)fwd, 512, LDS_BYTES) != hipSuccess || per_cu < 1) fprintf(stderr, "kernel_launch: occupancy query says %d\n", per_cu);
        (void)hipGetLastError();
        grid = cus;
    }
    if (grid < 0) return;
    (void)hipMemsetAsync((char*)d_ws + WS_CTL, 0, CTL_BYTES, stream);
    Args a{};
    for (int i = 0; i < 18; ++i) a.in[i] = (const float*)d_in[i];
    a.out = (float*)d_out; a.ws = (unsigned char*)d_ws;
#if ONE_LAUNCH
    a.gp_lo = 0; a.gp_hi = NGP;
    hipLaunchKernelGGL(fwd, dim3(grid), dim3(512), LDS_BYTES, stream, a);
#else
    for (int gp = 0; gp < NGP; ++gp) { a.gp_lo = gp; a.gp_hi = gp + 1; hipLaunchKernelGGL(fwd, dim3(grid), dim3(512), LDS_BYTES, stream, a); }
#endif
    const hipError_t le = hipPeekAtLastError();
    if (le != hipSuccess) fprintf(stderr, "kernel_launch: launch failed: %s\n", hipGetErrorName(le));
}
```

```cpp
#include <hip/hip_runtime.h>
#include <cstdio>
#include <cstdint>

#ifndef ONE_LAUNCH
#define ONE_LAUNCH 1
#endif
#ifndef WGM_FI
#define WGM_FI 4
#endif
#ifndef WGM_FO
#define WGM_FO 2
#endif
#ifndef WGM_M1
#define WGM_M1 4
#endif
#ifndef WGM_M45
#define WGM_M45 4
#endif
#ifndef ATT_DUP
#define ATT_DUP 0
#endif
#ifndef DUP_MASK
#define DUP_MASK 0u
#endif
#ifndef PHASE_MASK
#define PHASE_MASK 0xFFFFFFFFu
#endif

#define GAS __attribute__((address_space(1)))
#define LAS __attribute__((address_space(3)))
typedef unsigned short bf16_t;
typedef short bf16x8 __attribute__((ext_vector_type(8)));
typedef short s16x4 __attribute__((ext_vector_type(4)));
typedef float f32x4 __attribute__((ext_vector_type(4)));
typedef float f32x2 __attribute__((ext_vector_type(2)));
typedef float f32x16 __attribute__((ext_vector_type(16)));
typedef unsigned u32x4 __attribute__((ext_vector_type(4)));
typedef unsigned u32x2 __attribute__((ext_vector_type(2)));

constexpr int M = 49152;
constexpr int SEQ = 2048, NSEQ = 24;
constexpr int D = 2048, FF = 5632, DEPTH = 4;
constexpr int NPROJ = 4608;
constexpr int NGATE = 6144;
constexpr int NIN = 10784, NIN_PAD = 11008;
constexpr int C_AQ = 0, C_AK = 1024, C_AV = 1280, C_BQ = 1536, C_BK = 2048, C_BV = 2560, C_CQ = 3072, C_CK = 3328, C_CV = 3584, C_OG = 4096;
constexpr int C_OC = 3072;
constexpr float EPS = 1e-6f;

constexpr size_t MiB = 1u << 20;
constexpr size_t WS_CTL = 0, CTL_BYTES = 1 * MiB;
constexpr size_t WS_WIN = 2 * MiB;
constexpr size_t WS_WF1I = 45 * MiB;
constexpr size_t WS_WF1O = 89 * MiB;
constexpr size_t WS_WF2I = 111 * MiB;
constexpr size_t WS_WF2O = 155 * MiB;
constexpr size_t WS_WBRA = 177 * MiB;
constexpr size_t WS_WBRB = 181 * MiB;
constexpr size_t WS_WBRC = 183 * MiB;
constexpr size_t WS_WOUT = 185 * MiB;
constexpr size_t WS_XN = 193 * MiB;
constexpr size_t WS_BIG = 385 * MiB;
constexpr size_t WS_PROJ = WS_BIG;
constexpr size_t WS_GATES = WS_BIG + 432 * MiB;
constexpr size_t WS_LR = WS_BIG + 1008 * MiB;
constexpr size_t WS_H = WS_BIG;
constexpr size_t WS_Y = WS_BIG + 528 * MiB;
constexpr size_t WS_OFB = WS_BIG + 1014 * MiB;
constexpr size_t WS_OC = WS_OFB + 48 * MiB;
constexpr size_t WS_MG = WS_OFB + 96 * MiB;
constexpr size_t WS_RSTD = WS_MG + 192 * MiB;
constexpr size_t WS_OA = WS_RSTD + 1 * MiB;
constexpr size_t WS_END = WS_OA + 96 * MiB;
constexpr int CW_Q = 32768;
static_assert(WS_Y + (size_t)M * D * 4 <= WS_LR, "Y inside GATES region");
constexpr int CW_BAR = 4096;

__device__ __forceinline__ unsigned cvt_pk_bf16(float lo, float hi) { unsigned r; asm volatile("v_cvt_pk_bf16_f32 %0, %1, %2" : "=v"(r) : "v"(lo), "v"(hi)); return r; }
__device__ __forceinline__ float bflo(unsigned w) { return __uint_as_float(w << 16); }
__device__ __forceinline__ float bfhi(unsigned w) { return __uint_as_float(w & 0xffff0000u); }
__device__ __forceinline__ float bf2f(bf16_t v) { return __uint_as_float(((unsigned)v) << 16); }
__device__ __forceinline__ bf16_t f2bf(float f) { unsigned u = __float_as_uint(f); return (bf16_t)((u + 0x7fffu + ((u >> 16) & 1u)) >> 16); }
__device__ __forceinline__ float wave_sum(float v) {
#pragma unroll
    for (int o = 1; o < 64; o <<= 1) v += __shfl_xor(v, o);
    return v;
}
__device__ __forceinline__ float wave_max(float v) {
#pragma unroll
    for (int o = 1; o < 64; o <<= 1) v = fmaxf(v, __shfl_xor(v, o));
    return v;
}
__device__ __forceinline__ int opaque_tid() { int t = threadIdx.x; asm volatile("" : "+v"(t)); return t; }
__device__ __forceinline__ unsigned char* opq(unsigned char* p) { asm volatile("" : "+s"(p)); return p; }
__device__ __forceinline__ const float* lds_ptr(volatile LAS unsigned long long* tab, int i) { const unsigned long long v = tab[i];
    const unsigned lo = __builtin_amdgcn_readfirstlane((unsigned)v), hi = __builtin_amdgcn_readfirstlane((unsigned)(v >> 32)); return (const float*)(((unsigned long long)hi << 32) | lo); }
#define LDS_WAIT() asm volatile("s_waitcnt lgkmcnt(0)" ::: "memory")
#define VM_WAIT() asm volatile("s_waitcnt vmcnt(0)" ::: "memory")

namespace pg8 {
constexpr int BM = 256, BK = 64, HALF = 128, HTB = HALF * BK * 2, STAGE_BYTES = 8 * HTB, NXCD = 8;
__host__ __device__ __forceinline__ int lds_byte(int r, int c) { const int st = (r >> 4) * 2 + (c >> 5), rr = r & 15, cc = c & 31, ob = rr * 64 + cc * 2; return st * 1024 + (ob ^ (((ob >> 9) & 1) << 5)); }
__host__ __device__ __forceinline__ void stage_rc(int b, int& R, int& C) { const int st = b / 1024, sb = b % 1024, swz = sb ^ (((sb >> 9) & 1) << 5); R = (st >> 1) * 16 + swz / 64; C = (st & 1) * 32 + (swz % 64) / 2; }
__host__ __device__ __forceinline__ int perm32(int rho) { const int n = rho >> 4, i = rho & 15; return 8 * (i >> 2) + 4 * n + (i & 3); }

struct Unit { int pm, pn; };
struct Gemm { const bf16_t* A; const bf16_t* Bt; int M, N, K, lda; };

struct StaticOrder {
    int nM, nN, nwg, G, c, WGM;
    __host__ __device__ void init(int M_, int N_, int G_, int c_, int wgm_ = 4) { nM = M_ / BM; nN = N_ / BM; nwg = nM * nN; G = G_; c = c_; WGM = wgm_; }
    __host__ __device__ bool next(int i, Unit& u) const {
        const long L = (long)i * G + c; if (L >= nwg) return false;
        int wgid = (int)L; { const int q = nwg / NXCD, r = nwg % NXCD, xcd = wgid % NXCD, off = wgid / NXCD; wgid = (xcd < r ? xcd * (q + 1) : r * (q + 1) + (xcd - r) * q) + off; }
        const int nig = WGM * nN, gid = wgid / nig, fm = gid * WGM, gsz = (nM - fm) < WGM ? (nM - fm) : WGM;
        u.pm = fm + ((wgid % nig) % gsz); u.pn = (wgid % nig) / gsz; return true;
    }
    __device__ __forceinline__ void a_ready(const Unit&) const {}
    __device__ __forceinline__ void done(const Unit&) const {}
};

struct EpiF32 {
    static constexpr bool PERM = false, AFTER_DRAIN = false;
    float* C; int ldc;
    __device__ __forceinline__ void operator()(const f32x4 (&acc)[2][2][4][2], const Unit& u, int wr, int wc, int fr, int fq) const {
        const int row0 = u.pm * BM + wr * 64 + fr, col0 = u.pn * BM + wc * 32 + 4 * fq;
#pragma unroll
        for (int ai = 0; ai < 2; ++ai)
#pragma unroll
            for (int m = 0; m < 4; ++m) { float* rowp = C + (size_t)(row0 + ai * HALF + m * 16) * ldc + col0;
#pragma unroll
                for (int bj = 0; bj < 2; ++bj)
#pragma unroll
                    for (int n = 0; n < 2; ++n) *(f32x4*)(rowp + bj * HALF + n * 16) = acc[ai][bj][m][n]; }
    }
};
struct EpiBf16Plain {
    static constexpr bool PERM = true, AFTER_DRAIN = false;
    bf16_t* C; int ldc;
    __device__ __forceinline__ void operator()(const f32x4 (&acc)[2][2][4][2], const Unit& u, int wr, int wc, int fr, int fq) const {
        const int row0 = u.pm * BM + wr * 64 + fr, col0 = u.pn * BM + wc * 32 + 8 * fq;
#pragma unroll
        for (int ai = 0; ai < 2; ++ai)
#pragma unroll
            for (int m = 0; m < 4; ++m) { bf16_t* p = C + (size_t)(row0 + ai * HALF + m * 16) * ldc + col0;
#pragma unroll
                for (int bj = 0; bj < 2; ++bj) { const f32x4 v0 = acc[ai][bj][m][0], v1 = acc[ai][bj][m][1];
                    u32x4 w; w.x = cvt_pk_bf16(v0[0], v0[1]); w.y = cvt_pk_bf16(v0[2], v0[3]); w.z = cvt_pk_bf16(v1[0], v1[1]); w.w = cvt_pk_bf16(v1[2], v1[3]);
                    *(u32x4*)(p + bj * HALF) = w; } }
    }
};
__device__ __forceinline__ float silu_f(float g) { return g * __builtin_amdgcn_rcpf(1.0f + __builtin_amdgcn_exp2f(-1.4426950408889634f * g)); }
__device__ __forceinline__ float sigmoid_f(float g) { return __builtin_amdgcn_rcpf(1.0f + __builtin_amdgcn_exp2f(-1.4426950408889634f * g)); }
struct EpiSwiGLU {
    static constexpr bool PERM = true, AFTER_DRAIN = false;
    bf16_t* H; const float* rstd;
    __device__ __forceinline__ void operator()(const f32x4 (&acc)[2][2][4][2], const Unit& u, int wr, int wc, int fr, int fq) const {
        const int row0 = u.pm * BM + wr * 64 + fr, col0 = u.pn * HALF + wc * 32 + 8 * fq;
#pragma unroll
        for (int ai = 0; ai < 2; ++ai)
#pragma unroll
            for (int m = 0; m < 4; ++m) { bf16_t* p = H + (size_t)(row0 + ai * HALF + m * 16) * FF + col0; const float rs = rstd[row0 + ai * HALF + m * 16];
                const f32x4 g0 = acc[ai][0][m][0] * rs, g1 = acc[ai][0][m][1] * rs, u0 = acc[ai][1][m][0] * rs, u1 = acc[ai][1][m][1] * rs;
                u32x4 w; w.x = cvt_pk_bf16(silu_f(g0[0]) * u0[0], silu_f(g0[1]) * u0[1]); w.y = cvt_pk_bf16(silu_f(g0[2]) * u0[2], silu_f(g0[3]) * u0[3]);
                w.z = cvt_pk_bf16(silu_f(g1[0]) * u1[0], silu_f(g1[1]) * u1[1]); w.w = cvt_pk_bf16(silu_f(g1[2]) * u1[2], silu_f(g1[3]) * u1[3]);
                *(u32x4*)p = w; }
    }
};
struct EpiProj {
    static constexpr bool PERM = true, AFTER_DRAIN = false;
    bf16_t* PROJ; bf16_t* GATES; float* LR; const float* gbias; const float* rstd;
    __device__ __forceinline__ void operator()(const f32x4 (&acc)[2][2][4][2], const Unit& u, int wr, int wc, int fr, int fq) const {
        const int row0 = u.pm * BM + wr * 64 + fr;
        if (u.pn < 18) {
            const int col0 = u.pn * BM + wc * 32 + 8 * fq;
#pragma unroll
            for (int ai = 0; ai < 2; ++ai)
#pragma unroll
                for (int m = 0; m < 4; ++m) { bf16_t* p = PROJ + (size_t)(row0 + ai * HALF + m * 16) * NPROJ + col0; const float rs = rstd[row0 + ai * HALF + m * 16];
#pragma unroll
                    for (int bj = 0; bj < 2; ++bj) { const f32x4 v0 = acc[ai][bj][m][0] * rs, v1 = acc[ai][bj][m][1] * rs;
                        u32x4 w; w.x = cvt_pk_bf16(v0[0], v0[1]); w.y = cvt_pk_bf16(v0[2], v0[3]); w.z = cvt_pk_bf16(v1[0], v1[1]); w.w = cvt_pk_bf16(v1[2], v1[3]);
                        *(u32x4*)(p + bj * HALF) = w; } }
        } else if (u.pn < 42) {
            const int col0 = (u.pn - 18) * BM + wc * 32 + 8 * fq;
#pragma unroll
            for (int bj = 0; bj < 2; ++bj) {
                const f32x4 b0 = *(const f32x4*)(gbias + col0 + bj * HALF), b1 = *(const f32x4*)(gbias + col0 + bj * HALF + 4);
#pragma unroll
                for (int ai = 0; ai < 2; ++ai)
#pragma unroll
                    for (int m = 0; m < 4; ++m) { bf16_t* p = GATES + (size_t)(row0 + ai * HALF + m * 16) * NGATE + col0 + bj * HALF; const float rs = rstd[row0 + ai * HALF + m * 16];
                        const f32x4 v0 = acc[ai][bj][m][0] * rs + b0, v1 = acc[ai][bj][m][1] * rs + b1;
                        u32x4 w; w.x = cvt_pk_bf16(sigmoid_f(v0[0]), sigmoid_f(v0[1])); w.y = cvt_pk_bf16(sigmoid_f(v0[2]), sigmoid_f(v0[3]));
                        w.z = cvt_pk_bf16(sigmoid_f(v1[0]), sigmoid_f(v1[1])); w.w = cvt_pk_bf16(sigmoid_f(v1[2]), sigmoid_f(v1[3]));
                        *(u32x4*)p = w; }
                asm volatile("" ::: "memory"); }
        } else {
            if (wc == 0) {
#pragma unroll
                for (int ai = 0; ai < 2; ++ai)
#pragma unroll
                    for (int m = 0; m < 4; ++m) { float* p = LR + (size_t)(row0 + ai * HALF + m * 16) * 32 + 8 * fq; const float rs = rstd[row0 + ai * HALF + m * 16];
                        *(f32x4*)p = acc[ai][0][m][0] * rs; *(f32x4*)(p + 4) = acc[ai][0][m][1] * rs; }
            }
        }
    }
};
template <bool FIRST> struct EpiMerge {
    static constexpr bool PERM = true, AFTER_DRAIN = false;
    const bf16_t* G; bf16_t* MG;
    __device__ __forceinline__ void operator()(const f32x4 (&acc)[2][2][4][2], const Unit& u, int wr, int wc, int fr, int fq) const {
        const int row0 = u.pm * BM + wr * 64 + fr, col0 = u.pn * BM + wc * 32 + 8 * fq;
#pragma unroll
        for (int ai = 0; ai < 2; ++ai)
#pragma unroll
            for (int m = 0; m < 4; ++m) { const size_t r = (size_t)(row0 + ai * HALF + m * 16);
#pragma unroll
                for (int bj = 0; bj < 2; ++bj) { const u32x4 g = *(const u32x4*)(G + r * NGATE + col0 + bj * HALF);
                    const f32x4 v0 = acc[ai][bj][m][0], v1 = acc[ai][bj][m][1];
                    float o[8] = { bflo(g.x) * v0[0], bfhi(g.x) * v0[1], bflo(g.y) * v0[2], bfhi(g.y) * v0[3], bflo(g.z) * v1[0], bfhi(g.z) * v1[1], bflo(g.w) * v1[2], bfhi(g.w) * v1[3] };
                    bf16_t* p = MG + r * D + col0 + bj * HALF;
                    if (!FIRST) { const u32x4 old = *(const u32x4*)p;
                        o[0] += bflo(old.x); o[1] += bfhi(old.x); o[2] += bflo(old.y); o[3] += bfhi(old.y); o[4] += bflo(old.z); o[5] += bfhi(old.z); o[6] += bflo(old.w); o[7] += bfhi(old.w); }
                    u32x4 w; w.x = cvt_pk_bf16(o[0], o[1]); w.y = cvt_pk_bf16(o[2], o[3]); w.z = cvt_pk_bf16(o[4], o[5]); w.w = cvt_pk_bf16(o[6], o[7]);
                    *(u32x4*)p = w; }
                asm volatile("" ::: "memory"); }
    }
};

template <class Epi, class Sched, bool ALIGN_EPI = false, bool SP2 = false>
__device__ __forceinline__ void gemm_phase(LAS unsigned char* lds, const Gemm g, const Sched& S, const Epi& E) {
    const int tid = opaque_tid(), wid = __builtin_amdgcn_readfirstlane(tid >> 6), lane = tid & 63, wr = wid >> 2, wc = wid & 3, fr = lane & 15, fq = lane >> 4;
    const int K = g.K, nt = K / BK, lda = g.lda;
    unsigned voffA[2], voffB[2];
#pragma unroll
    for (int i = 0; i < 2; ++i) { int R, C; stage_rc(tid * 16 + i * 8192, R, C); const int Rb = Epi::PERM ? ((R & ~31) + perm32(R & 31)) : R;
        voffA[i] = (unsigned)(R * lda + C) * 2u; voffB[i] = (unsigned)(Rb * K + C) * 2u; }
    const unsigned kstep = (unsigned)(BK * 2);
    const unsigned hstepA = (unsigned)HALF * (unsigned)lda * 2u, hstepB = (unsigned)HALF * (unsigned)K * 2u;
    const unsigned tstepA = 2u * hstepA, tstepB = 2u * hstepB;
    const unsigned ldsw = (unsigned)wid * 1024u;
    const int aoff = lds_byte(wr * 64 + fr, fq * 8), boff = lds_byte(wc * 32 + fr, fq * 8);
    const char* const baseA = (const char*)g.A; const char* const baseB = (const char*)g.Bt;
#define PG8_SA(b, h) (((b) * 2 + (h)) * HTB)
#define PG8_SB(b, h) ((4 + (b) * 2 + (h)) * HTB)
#define PG8_STAGE(bufoff, gbase, goff, voff) do { _Pragma("unroll") for (int _i = 0; _i < 2; ++_i) \
        __builtin_amdgcn_global_load_lds((const unsigned*)((gbase) + (size_t)(unsigned)((goff) + (voff)[_i])), (LAS unsigned*)(lds + (bufoff) + ldsw + _i * 8192), 16, 0, 0); } while (0)
#define PG8_LDA(dst, b, h) do { _Pragma("unroll") for (int m = 0; m < 4; ++m) _Pragma("unroll") for (int k = 0; k < 2; ++k) dst[m][k] = *(const LAS bf16x8*)(lds + PG8_SA(b, h) + aoff + m * 2048 + k * 1024); } while (0)
#define PG8_LDB(dst, b, h) do { _Pragma("unroll") for (int n = 0; n < 2; ++n) _Pragma("unroll") for (int k = 0; k < 2; ++k) dst[n][k] = *(const LAS bf16x8*)(lds + PG8_SB(b, h) + boff + n * 2048 + k * 1024); } while (0)
#define PG8_MMA(ai, bj, At, Bt) do { __builtin_amdgcn_s_setprio(1); _Pragma("unroll") for (int m = 0; m < 4; ++m) _Pragma("unroll") for (int n = 0; n < 2; ++n) _Pragma("unroll") for (int k = 0; k < 2; ++k) \
        acc[ai][bj][m][n] = __builtin_amdgcn_mfma_f32_16x16x32_bf16(Bt[n][k], At[m][k], acc[ai][bj][m][n], 0, 0, 0); __builtin_amdgcn_s_setprio(0); } while (0)
#define PG8_WAIT_V(n) asm volatile("s_waitcnt vmcnt(" #n ")" ::: "memory")
#define PG8_WAIT_L(n) asm volatile("s_waitcnt lgkmcnt(" #n ")" ::: "memory")
#define PG8_BAR __builtin_amdgcn_s_barrier()
#define PG8_SCHED __builtin_amdgcn_sched_barrier(0)
    Unit cur, nxt; int ui = 0;
    if (!S.next(0, cur)) return;
    f32x4 acc[2][2][4][2];
#pragma unroll
    for (int a = 0; a < 2; ++a)
#pragma unroll
        for (int b = 0; b < 2; ++b)
#pragma unroll
            for (int m = 0; m < 4; ++m)
#pragma unroll
                for (int n = 0; n < 2; ++n) acc[a][b][m][n] = (f32x4){0.f, 0.f, 0.f, 0.f};
    bf16x8 At[4][2], B0[2][2], B1[2][2];
    unsigned cA = (unsigned)cur.pm * tstepA, cB = (unsigned)cur.pn * tstepB;
    S.a_ready(cur);
    if constexpr (SP2) {
        PG8_STAGE(PG8_SB(0, 0), baseB, cB, voffB); PG8_STAGE(PG8_SB(0, 1), baseB, cB + hstepB, voffB); PG8_STAGE(PG8_SA(0, 0), baseA, cA, voffA); PG8_STAGE(PG8_SA(0, 1), baseA, cA + hstepA, voffA);
        if (wr == 1) PG8_BAR;
        PG8_WAIT_V(2); PG8_BAR;
        PG8_STAGE(PG8_SB(1, 0), baseB, cB + kstep, voffB); PG8_STAGE(PG8_SA(1, 0), baseA, cA + kstep, voffA); PG8_STAGE(PG8_SB(1, 1), baseB, cB + hstepB + kstep, voffB);
        PG8_WAIT_V(6); PG8_BAR;
    } else {
        PG8_STAGE(PG8_SB(0, 0), baseB, cB, voffB); PG8_STAGE(PG8_SA(0, 0), baseA, cA, voffA); PG8_STAGE(PG8_SB(0, 1), baseB, cB + hstepB, voffB); PG8_STAGE(PG8_SA(0, 1), baseA, cA + hstepA, voffA);
        if (wr == 1) PG8_BAR;
        PG8_WAIT_V(4); PG8_BAR;
        PG8_STAGE(PG8_SB(1, 0), baseB, cB + kstep, voffB); PG8_STAGE(PG8_SA(1, 0), baseA, cA + kstep, voffA); PG8_STAGE(PG8_SB(1, 1), baseB, cB + hstepB + kstep, voffB);
        PG8_WAIT_V(6); PG8_BAR;
    }
    for (;;) {
        const bool has_next = S.next(ui + 1, nxt);
        const unsigned nA = has_next ? (unsigned)nxt.pm * tstepA : cA, nB = has_next ? (unsigned)nxt.pn * tstepB : cB;
        for (int t = 0; t < nt; t += 2) {
            const bool last = (t == nt - 2);
            const unsigned a1 = cA + (unsigned)(t + 1) * kstep;
            const unsigned a2 = last ? nA : cA + (unsigned)(t + 2) * kstep, b2 = last ? nB : cB + (unsigned)(t + 2) * kstep;
            const unsigned a3 = a2 + kstep, b3 = b2 + kstep;
            if (last && has_next) S.a_ready(nxt);
            if constexpr (SP2) {
            PG8_LDB(B0, 0, 0); PG8_LDB(B1, 0, 1); PG8_SCHED; PG8_LDA(At, 0, 0); PG8_STAGE(PG8_SA(1, 1), baseA, a1 + hstepA, voffA);
            PG8_WAIT_V(8); PG8_WAIT_L(0); PG8_BAR; PG8_MMA(0, 0, At, B0); PG8_MMA(0, 1, At, B1); PG8_BAR; PG8_SCHED;
            PG8_LDA(At, 0, 1); PG8_STAGE(PG8_SB(0, 0), baseB, b2, voffB); PG8_STAGE(PG8_SB(0, 1), baseB, b2 + hstepB, voffB); PG8_STAGE(PG8_SA(0, 0), baseA, a2, voffA);
            PG8_WAIT_V(8); PG8_WAIT_L(0); PG8_BAR; PG8_MMA(1, 0, At, B0); PG8_MMA(1, 1, At, B1); PG8_BAR; PG8_SCHED;
            PG8_LDB(B0, 1, 0); PG8_LDB(B1, 1, 1); PG8_SCHED; PG8_LDA(At, 1, 0); PG8_STAGE(PG8_SA(0, 1), baseA, a2 + hstepA, voffA);
            PG8_WAIT_V(8); PG8_WAIT_L(0); PG8_BAR; PG8_MMA(0, 0, At, B0); PG8_MMA(0, 1, At, B1); PG8_BAR; PG8_SCHED;
            PG8_LDA(At, 1, 1); PG8_STAGE(PG8_SB(1, 0), baseB, b3, voffB); PG8_STAGE(PG8_SB(1, 1), baseB, b3 + hstepB, voffB); PG8_STAGE(PG8_SA(1, 0), baseA, a3, voffA);
            PG8_WAIT_V(8); PG8_WAIT_L(0); PG8_BAR; PG8_MMA(1, 0, At, B0); PG8_MMA(1, 1, At, B1); PG8_BAR; PG8_SCHED;
            } else {
            PG8_LDB(B0, 0, 0); PG8_SCHED; PG8_LDA(At, 0, 0); PG8_STAGE(PG8_SA(1, 1), baseA, a1 + hstepA, voffA);
            PG8_WAIT_L(8); PG8_BAR; PG8_WAIT_L(0); PG8_MMA(0, 0, At, B0); PG8_BAR; PG8_SCHED;
            PG8_LDB(B1, 0, 1); PG8_STAGE(PG8_SB(0, 0), baseB, b2, voffB);
            PG8_BAR; PG8_WAIT_L(0); PG8_MMA(0, 1, At, B1); PG8_BAR;
            PG8_LDA(At, 0, 1); PG8_STAGE(PG8_SA(0, 0), baseA, a2, voffA);
            PG8_BAR; PG8_WAIT_L(0); PG8_MMA(1, 0, At, B0); PG8_BAR; PG8_SCHED;
            PG8_STAGE(PG8_SB(0, 1), baseB, b2 + hstepB, voffB);
            PG8_WAIT_V(6); PG8_BAR; PG8_MMA(1, 1, At, B1); PG8_BAR;
            PG8_LDB(B0, 1, 0); PG8_SCHED; PG8_LDA(At, 1, 0); PG8_STAGE(PG8_SA(0, 1), baseA, a2 + hstepA, voffA);
            PG8_WAIT_L(8); PG8_BAR; PG8_WAIT_L(0); PG8_MMA(0, 0, At, B0); PG8_BAR; PG8_SCHED;
            PG8_LDB(B1, 1, 1); PG8_STAGE(PG8_SB(1, 0), baseB, b3, voffB);
            PG8_BAR; PG8_WAIT_L(0); PG8_MMA(0, 1, At, B1); PG8_BAR;
            PG8_LDA(At, 1, 1); PG8_STAGE(PG8_SA(1, 0), baseA, a3, voffA);
            PG8_BAR; PG8_WAIT_L(0); PG8_MMA(1, 0, At, B0); PG8_BAR; PG8_SCHED;
            PG8_STAGE(PG8_SB(1, 1), baseB, b3 + hstepB, voffB);
            PG8_WAIT_V(6); PG8_BAR; PG8_MMA(1, 1, At, B1); PG8_BAR;
            }
        }
        if constexpr (ALIGN_EPI) { if (wr == 0) PG8_BAR; }
        if constexpr (!Epi::AFTER_DRAIN) { E(acc, cur, wr, wc, fr, fq); S.done(cur); }
        if (!has_next) break;
#pragma unroll
        for (int a = 0; a < 2; ++a)
#pragma unroll
            for (int b = 0; b < 2; ++b)
#pragma unroll
                for (int m = 0; m < 4; ++m)
#pragma unroll
                    for (int n = 0; n < 2; ++n) acc[a][b][m][n] = (f32x4){0.f, 0.f, 0.f, 0.f};
        cur = nxt; cA = nA; cB = nB; ++ui;
        if constexpr (ALIGN_EPI) { if (wr == 1) PG8_BAR; }
    }
    PG8_WAIT_V(0);
    if constexpr (!ALIGN_EPI) { if (wr == 0) PG8_BAR; }
    PG8_BAR;
#undef PG8_SA
#undef PG8_SB
#undef PG8_STAGE
#undef PG8_LDA
#undef PG8_LDB
#undef PG8_MMA
#undef PG8_WAIT_V
#undef PG8_WAIT_L
#undef PG8_BAR
#undef PG8_SCHED
}
}

namespace att {
constexpr int DH = 128, NW = 8, QBLK = 32, KVBLK = 64;
constexpr float SCALE = 0.088388347648318440f;
constexpr float THR = 8.f;
constexpr int LD = NPROJ, LDO = 1024;
constexpr size_t SHM_V = KVBLK * DH * 2, SHM_K = KVBLK * DH * 2, SHM_ATTN = 2 * SHM_V + 2 * SHM_K + NW * 64 * 4;
#define KSWZ(row, colB) ((row) * 256 + ((colB) ^ (((row) & 7) << 4)))
#define SBAR() __builtin_amdgcn_sched_barrier(0)
__device__ __forceinline__ int crow(int r, int hi) { return (r & 3) + 8 * (r >> 2) + 4 * hi; }
__device__ __forceinline__ void partialSM(f32x16& p0, f32x16& p1, float& m_reg, float& mn, float& alpha) {
  constexpr float C = SCALE * 1.4426950408889634f;
  float pmax = p0[0];
#pragma unroll
  for (int r = 1; r < 16; ++r) pmax = fmaxf(pmax, p0[r]);
#pragma unroll
  for (int r = 0; r < 16; ++r) pmax = fmaxf(pmax, p1[r]);
  { auto rr = __builtin_amdgcn_permlane32_swap(__float_as_uint(pmax), __float_as_uint(pmax), false, false);
    pmax = fmaxf(__uint_as_float(rr[0]), __uint_as_float(rr[1])); }
  if (__builtin_expect(__all(pmax - m_reg <= THR / SCALE), 1)) { mn = m_reg; alpha = 1.f; }
  else { mn = fmaxf(m_reg, pmax); alpha = __builtin_amdgcn_exp2f((m_reg - mn) * C); m_reg = mn; }
  float mnC = -mn * C;
#pragma unroll
  for (int r = 0; r < 16; ++r) p0[r] = fmaf(p0[r], C, mnC);
#pragma unroll
  for (int r = 0; r < 16; ++r) p1[r] = fmaf(p1[r], C, mnC);
#pragma unroll
  for (int r = 0; r < 16; ++r) p0[r] = __builtin_amdgcn_exp2f(p0[r]);
}
__device__ __forceinline__ void finishSM(f32x16& p0, f32x16& p1, float alpha, float& l_reg, bf16x8& pa0, bf16x8& pa1, bf16x8& pa2, bf16x8& pa3) {
#pragma unroll
  for (int r = 0; r < 16; ++r) p1[r] = __builtin_amdgcn_exp2f(p1[r]);
  float ps = 0;
#pragma unroll
  for (int r = 0; r < 16; ++r) ps += p0[r];
#pragma unroll
  for (int r = 0; r < 16; ++r) ps += p1[r];
  { auto rr = __builtin_amdgcn_permlane32_swap(__float_as_uint(ps), __float_as_uint(ps), false, false);
    ps = __uint_as_float(rr[0]) + __uint_as_float(rr[1]); }
  l_reg = l_reg * alpha + ps;
#define PK4(P, BASE, OUT) do { unsigned a0 = cvt_pk_bf16(P[BASE + 0], P[BASE + 1]), a1 = cvt_pk_bf16(P[BASE + 2], P[BASE + 3]);   \
    unsigned b0 = cvt_pk_bf16(P[BASE + 4], P[BASE + 5]), b1 = cvt_pk_bf16(P[BASE + 6], P[BASE + 7]);                              \
    auto r0 = __builtin_amdgcn_permlane32_swap(a0, b0, false, false); auto r1 = __builtin_amdgcn_permlane32_swap(a1, b1, false, false); \
    u32x4 w = {r0[0], r1[0], r0[1], r1[1]}; OUT = *reinterpret_cast<bf16x8*>(&w); } while (0)
  PK4(p0, 0, pa0); PK4(p0, 8, pa1); PK4(p1, 0, pa2); PK4(p1, 8, pa3);
#undef PK4
}
__device__ __forceinline__ void qkt(f32x16& p0, f32x16& p1, const bf16_t* Ks, const bf16x8* qr, int r32, int hi) {
  p0 = f32x16{}; p1 = f32x16{};
#pragma unroll
  for (int d0 = 0; d0 < 8; ++d0) { int cb = (d0 * 16 + hi * 8) * 2;
    bf16x8 b0 = *reinterpret_cast<const bf16x8*>((const char*)Ks + KSWZ(r32, cb));
    bf16x8 b1 = *reinterpret_cast<const bf16x8*>((const char*)Ks + KSWZ(32 + r32, cb));
    p0 = __builtin_amdgcn_mfma_f32_32x32x16_bf16(b0, qr[d0], p0, 0, 0, 0);
    p1 = __builtin_amdgcn_mfma_f32_32x32x16_bf16(b1, qr[d0], p1, 0, 0, 0); }
}
__device__ __forceinline__ int v_st(int k, int c) { const int kk = (k & ~0xC) | ((k & 4) << 1) | ((k & 8) >> 1); return ((kk >> 3) * 4 + (c >> 5)) * 512 + ((kk & 7) * 32 + (c & 31)) * 2; }
__device__ __forceinline__ int v_rd_base(int lane) { return ((lane & 3) << 3) | (((lane >> 2) & 3) << 6) | (((lane >> 4) & 1) << 5) | (((lane >> 5) & 1) << 8); }
constexpr int v_rd_off(int d0, int ks, int half) { return d0 * 512 + ks * 4096 + half * 2048; }
template <int OFF> __device__ __forceinline__ s16x4 tr_read(int vb) {
  s16x4 r; asm volatile("ds_read_b64_tr_b16 %0, %1 offset:%2" : "=&v"(r) : "v"(vb), "i"(OFF) : "memory"); return r;
}
template <int D0> __device__ __forceinline__ void pv_one(f32x16& od, int vb, bf16x8 pa0, bf16x8 pa1, bf16x8 pa2, bf16x8 pa3) {
  const s16x4 l0 = tr_read<v_rd_off(D0, 0, 0)>(vb), h0 = tr_read<v_rd_off(D0, 0, 1)>(vb), l1 = tr_read<v_rd_off(D0, 1, 0)>(vb), h1 = tr_read<v_rd_off(D0, 1, 1)>(vb);
  const s16x4 l2 = tr_read<v_rd_off(D0, 2, 0)>(vb), h2 = tr_read<v_rd_off(D0, 2, 1)>(vb), l3 = tr_read<v_rd_off(D0, 3, 0)>(vb), h3 = tr_read<v_rd_off(D0, 3, 1)>(vb);
  asm volatile("s_waitcnt lgkmcnt(0)" ::: "memory"); SBAR();
#define PK(L, H) (bf16x8){L[0], L[1], L[2], L[3], H[0], H[1], H[2], H[3]}
  od = __builtin_amdgcn_mfma_f32_32x32x16_bf16(pa0, PK(l0, h0), od, 0, 0, 0);
  od = __builtin_amdgcn_mfma_f32_32x32x16_bf16(pa1, PK(l1, h1), od, 0, 0, 0);
  od = __builtin_amdgcn_mfma_f32_32x32x16_bf16(pa2, PK(l2, h2), od, 0, 0, 0);
  od = __builtin_amdgcn_mfma_f32_32x32x16_bf16(pa3, PK(l3, h3), od, 0, 0, 0);
#undef PK
}
__device__ __forceinline__ void pv_d0(f32x16* o, int vb, bf16x8 pa0, bf16x8 pa1, bf16x8 pa2, bf16x8 pa3) {
  pv_one<0>(o[0], vb, pa0, pa1, pa2, pa3); pv_one<1>(o[1], vb, pa0, pa1, pa2, pa3); pv_one<2>(o[2], vb, pa0, pa1, pa2, pa3); pv_one<3>(o[3], vb, pa0, pa1, pa2, pa3);
}
__device__ __forceinline__ void attn_dense_body(const bf16_t* Qb, const bf16_t* __restrict__ Kh, const bf16_t* __restrict__ Vh, bf16_t* Ob, int seq, char* lds) {
  const int tid = opaque_tid(), wid = tid >> 6, lane = tid & 63, r32 = lane & 31, hi = lane >> 5;
  bf16_t* V_lds = (bf16_t*)lds; bf16_t* K_lds = (bf16_t*)(lds + 2 * SHM_V);
  float* ws = (float*)(lds + 2 * SHM_V + 2 * SHM_K) + wid * 64; float* li_l = ws; float* al_l = ws + 32;
  float m_reg = -1e30f, l_reg = 0; f32x16 o[4] = {}; bf16x8 qr[8];
  const bf16_t* Qw = Qb + (long)(wid * QBLK + r32) * LD + hi * 8;
#pragma unroll
  for (int d0 = 0; d0 < 8; ++d0) qr[d0] = *reinterpret_cast<const bf16x8*>(Qw + d0 * 16);
  const int sr = tid >> 4, sc = (tid & 15) * 8, vst0 = v_st(sr, sc), vst1 = v_st(32 + sr, sc);
  const int vb0 = (int)(uintptr_t)V_lds + v_rd_base(lane);
  struct { bf16x8 vs0, vs1, ks0, ks1; } sr_[1];
#define SLOAD(i, k0) do { sr_[i].vs0 = *reinterpret_cast<const bf16x8*>(&Vh[(long)((k0) + sr) * LD + sc]); sr_[i].vs1 = *reinterpret_cast<const bf16x8*>(&Vh[(long)((k0) + 32 + sr) * LD + sc]); \
    sr_[i].ks0 = *reinterpret_cast<const bf16x8*>(&Kh[(long)((k0) + sr) * LD + sc]); sr_[i].ks1 = *reinterpret_cast<const bf16x8*>(&Kh[(long)((k0) + 32 + sr) * LD + sc]); } while (0)
#define SWRITE(b, i) do { *(bf16x8*)((char*)V_lds + (b) * SHM_V + vst0) = sr_[i].vs0;          \
    *(bf16x8*)((char*)V_lds + (b) * SHM_V + vst1) = sr_[i].vs1; int kc = sc * 2;               \
    *(bf16x8*)((char*)K_lds + (b) * SHM_K + KSWZ(sr, kc)) = sr_[i].ks0;                       \
    *(bf16x8*)((char*)K_lds + (b) * SHM_K + KSWZ(32 + sr, kc)) = sr_[i].ks1; } while (0)
#define SWAIT() asm volatile("s_waitcnt vmcnt(0)" ::: "memory")
#define RESC(a) do { if (__any((a) < 1.f)) { if (hi == 0) al_l[r32] = (a); asm volatile("s_waitcnt lgkmcnt(0)" ::: "memory"); \
    _Pragma("unroll") for (int d = 0; d < 4; ++d) _Pragma("unroll") for (int r = 0; r < 16; ++r) o[d][r] *= al_l[crow(r, hi)]; } } while (0)
  f32x16 pA0, pA1, pB0, pB1; float mnA, mnB, alA, alB; bf16x8 pa0, pa1, pa2, pa3; const int NT = seq / KVBLK;
  constexpr int SE = 0, SO = 0;
  SLOAD(SE, 0); asm volatile("s_waitcnt vmcnt(0)" ::: "memory"); SWRITE(0, SE); __syncthreads();
  qkt(pA0, pA1, K_lds, qr, r32, hi); partialSM(pA0, pA1, m_reg, mnA, alA);
  SLOAD(SO, KVBLK);
  SWAIT(); SWRITE(1, SO); __syncthreads();
  for (int j = 1; j + 1 < NT; j += 2) {
    SBAR(); qkt(pB0, pB1, (bf16_t*)((char*)K_lds + SHM_K), qr, r32, hi);
    finishSM(pA0, pA1, alA, l_reg, pa0, pa1, pa2, pa3); SBAR();
    SLOAD(SO, (j + 1) * KVBLK); SBAR();
    pv_d0(o, vb0, pa0, pa1, pa2, pa3); partialSM(pB0, pB1, m_reg, mnB, alB);
    __syncthreads(); SWAIT(); SWRITE(0, SE);
    RESC(alB); __syncthreads();
    SBAR(); qkt(pA0, pA1, K_lds, qr, r32, hi);
    finishSM(pB0, pB1, alB, l_reg, pa0, pa1, pa2, pa3); SBAR();
    SLOAD(SE, (j + 2) * KVBLK); SBAR();
    pv_d0(o, vb0 + (int)SHM_V, pa0, pa1, pa2, pa3); partialSM(pA0, pA1, m_reg, mnA, alA);
    __syncthreads(); SWAIT(); SWRITE(1, SO);
    RESC(alA); __syncthreads();
  }
  SBAR(); qkt(pB0, pB1, (bf16_t*)((char*)K_lds + SHM_K), qr, r32, hi);
  finishSM(pA0, pA1, alA, l_reg, pa0, pa1, pa2, pa3); SBAR();
  pv_d0(o, vb0, pa0, pa1, pa2, pa3); partialSM(pB0, pB1, m_reg, mnB, alB);
  __syncthreads(); RESC(alB);
  finishSM(pB0, pB1, alB, l_reg, pa0, pa1, pa2, pa3); SBAR();
  pv_d0(o, vb0 + (int)SHM_V, pa0, pa1, pa2, pa3);
  if (hi == 0) li_l[r32] = l_reg; asm volatile("s_waitcnt lgkmcnt(0)" ::: "memory");
  float rli[16];
#pragma unroll
  for (int r = 0; r < 16; ++r) rli[r] = __builtin_amdgcn_rcpf(li_l[crow(r, hi)]);
  bf16_t* Ow = Ob + (long)(wid * QBLK) * LDO;
#pragma unroll
  for (int r = 0; r < 16; ++r) { int orow = crow(r, hi);
#pragma unroll
    for (int d0 = 0; d0 < 4; ++d0) Ow[(long)orow * LDO + d0 * 32 + r32] = f2bf(o[d0][r] * rli[r]); }
  __syncthreads();
#undef SLOAD
#undef SWRITE
#undef SWAIT
#undef RESC
}
}

constexpr int RING_BYTES = 131072;
constexpr int LDSCTL_OFF = RING_BYTES, MISC_OFF = LDSCTL_OFF + 320, PTAB_OFF = LDSCTL_OFF + 1024;
constexpr int LDS_BYTES = 147456;

#define XB_TMO      128
#define XB_XCNT(j)  (256  + 64 * (j))
#define XB_XSUB(j)  (1280 + 64 * (j))
#define XB_XGEN(j)  (2304 + 64 * (j))
#define XB_TOP      3328
#define XB_TOPGEN   3392
#define XCD_BAR_WORDS 3456
#define XB_SPIN_CAP (1u << 22)
__device__ __forceinline__ unsigned xb_ld(unsigned* p)              { return __hip_atomic_load(p, __ATOMIC_RELAXED, __HIP_MEMORY_SCOPE_AGENT); }
__device__ __forceinline__ unsigned xb_add(unsigned* p, unsigned v) { return __hip_atomic_fetch_add(p, v, __ATOMIC_RELAXED, __HIP_MEMORY_SCOPE_AGENT); }
__device__ __forceinline__ unsigned xb_xcc_id() { return (unsigned)__builtin_amdgcn_s_getreg((3 << 11) | 20) & 0xFu; }
#define XB_SPIN(cond, bar) do { unsigned _sp = 0; while (cond) { __builtin_amdgcn_s_sleep(1); \
    if ((++_sp & 255u) == 0u) { if (xb_ld(&(bar)[XB_TMO])) break; if (_sp > XB_SPIN_CAP) { atomicAdd(&(bar)[XB_TMO], 1u); break; } } } } while (0)
struct XcdBarrier { unsigned* bar; unsigned x; volatile LAS unsigned* st; };
__device__ __forceinline__ XcdBarrier xcd_barrier_post(unsigned* bar, volatile LAS unsigned* st) {
    XcdBarrier b; b.bar = bar; b.x = xb_xcc_id(); b.st = st;
    if (threadIdx.x == 0) (void)xb_add(&bar[XB_XCNT(b.x)], 1u);
    return b;
}
__device__ __forceinline__ void xcd_barrier_complete(unsigned* bar, unsigned x, unsigned& nloc, unsigned& nx) {
    const unsigned G = gridDim.x * gridDim.y * gridDim.z;
    unsigned sum, cnt, mine, sp = 0u;
    for (;;) {
        sum = 0u; cnt = 0u;
        for (unsigned j = 0; j < 16; ++j) { const unsigned c = xb_ld(&bar[XB_XCNT(j)]); sum += c; cnt += (c > 0u) ? 1u : 0u; }
        mine = xb_ld(&bar[XB_XCNT(x)]);
        if (sum == G) break;
        __builtin_amdgcn_s_sleep(1);
        if ((++sp & 255u) == 0u) { if (xb_ld(&bar[XB_TMO])) break; if (sp > XB_SPIN_CAP) { atomicAdd(&bar[XB_TMO], 1u); break; } }
    }
    nloc = mine > 0u ? mine : 1u; nx = cnt > 0u ? cnt : 1u;
}
__device__ __forceinline__ XcdBarrier xcd_barrier_setup(unsigned* bar, volatile LAS unsigned* st) {
    XcdBarrier b = xcd_barrier_post(bar, st);
    if (threadIdx.x == 0) { unsigned nloc, nx; xcd_barrier_complete(bar, b.x, nloc, nx); st[0] = nloc; st[1] = nx; }
    __syncthreads();
    return b;
}
__device__ __forceinline__ void xcd_barrier(const XcdBarrier& b) {
    asm volatile("s_waitcnt vmcnt(0)" ::: "memory");
    __syncthreads();
    if (threadIdx.x == 0) {
        unsigned* bar = b.bar; unsigned bx = b.x;
        asm volatile("" : "+s"(bar), "+s"(bx));
        __builtin_amdgcn_s_waitcnt(0);
        const unsigned nloc = b.st[0], nx = b.st[1];
        const unsigned old = xb_add(&bar[XB_XSUB(bx)], 1u);
        const unsigned gen = old / nloc;
        if (old + 1u == (gen + 1u) * nloc) {
            __builtin_amdgcn_fence(__ATOMIC_RELEASE, "agent");
            asm volatile("s_waitcnt vmcnt(0)" ::: "memory");
            const unsigned og = xb_add(&bar[XB_TOP], 1u);
            const unsigned tg = og / nx;
            if (og + 1u == (tg + 1u) * nx) xb_add(&bar[XB_TOPGEN], 1u);
            else XB_SPIN(xb_ld(&bar[XB_TOPGEN]) == tg, bar);
            __builtin_amdgcn_fence(__ATOMIC_ACQUIRE, "agent");
            xb_add(&bar[XB_XGEN(bx)], 1u);
            asm volatile("s_waitcnt vmcnt(0)" ::: "memory");
        } else {
            XB_SPIN(xb_ld(&bar[XB_XGEN(bx)]) == gen, bar);
            __builtin_amdgcn_fence(__ATOMIC_ACQUIRE, "agent");
            asm volatile("s_waitcnt vmcnt(0)" ::: "memory");
        }
    }
    __syncthreads();
}

__device__ __forceinline__ void transpose_item(const float* W, int ldw, int K, int k0, int srccol0, bf16_t* WT, int dstrow0, LAS float* scr, int lane, const float* kgain = nullptr) {
    constexpr int P = 36;
    const int n4 = (lane & 7) * 4, kr = lane >> 3;
    f32x4 v[8];
    if (srccol0 >= 0) {
#pragma unroll
        for (int i = 0; i < 8; ++i) v[i] = *(const f32x4*)(W + (size_t)(k0 + 8 * i + kr) * ldw + srccol0 + n4);
        if (kgain) {
#pragma unroll
            for (int i = 0; i < 8; ++i) v[i] = v[i] * kgain[k0 + 8 * i + kr];
        }
    } else {
#pragma unroll
        for (int i = 0; i < 8; ++i) v[i] = (f32x4){0.f, 0.f, 0.f, 0.f};
    }
#pragma unroll
    for (int i = 0; i < 8; ++i) *(LAS f32x4*)(scr + (8 * i + kr) * P + n4) = v[i];
    LDS_WAIT(); asm volatile("" ::: "memory");
    const int c = lane & 7;
#pragma unroll
    for (int j = 0; j < 4; ++j) { const int n = (lane >> 3) + 8 * j; const LAS float* s = scr + (8 * c) * P + n;
        u32x4 o; o.x = cvt_pk_bf16(s[0 * P], s[1 * P]); o.y = cvt_pk_bf16(s[2 * P], s[3 * P]); o.z = cvt_pk_bf16(s[4 * P], s[5 * P]); o.w = cvt_pk_bf16(s[6 * P], s[7 * P]);
        *(u32x4*)(WT + (size_t)(dstrow0 + n) * K + k0 + 8 * c) = o; }
    LDS_WAIT(); asm volatile("" ::: "memory");
}
struct LayerW { const float *w_in, *w_bra, *w_brb, *w_brc, *w_out, *f1i, *f1o, *f2i, *f2o, *ng; };
__device__ __forceinline__ void phase_weights(const LayerW& w, unsigned char* ws, LAS unsigned char* lds, int gw, int NGW, int wave, int lane) {
    LAS float* scr = (LAS float*)(lds + wave * 16384);
    constexpr int I_IN = (NIN_PAD / 32) * (D / 64);
    constexpr int I_FI = (2 * FF / 32) * (D / 64);
    constexpr int I_FO = (D / 32) * (FF / 64);
    constexpr int I_BA = (D / 32) * (1024 / 64);
    constexpr int I_BB = (D / 32) * (512 / 64);
    constexpr int I_WO = (D / 32) * (D / 64);
    constexpr int NITEMS = I_IN + 2 * I_FI + 2 * I_FO + I_BA + 2 * I_BB + I_WO;
    for (int it = gw; it < NITEMS; it += NGW) {
        int r = it;
        if (r < I_IN) { const int nb = r % (NIN_PAD / 32), kb = r / (NIN_PAD / 32); const int d0 = nb * 32;
            const int src = d0 < 4608 ? d0 : (d0 < 10752 ? d0 + 32 : (d0 < 10784 ? 4608 + (d0 - 10752) : -1));
            transpose_item(w.w_in, NIN, D, kb * 64, src, (bf16_t*)(ws + WS_WIN), d0, scr, lane, w.ng + 2 * D); continue; } r -= I_IN;
        if (r < 2 * I_FI) { const int which = r / I_FI; r -= which * I_FI; const int nb = r % (2 * FF / 32), kb = r / (2 * FF / 32); const int d0 = nb * 32;
            const int t = d0 >> 8, within = d0 & 255; const int src = within < 128 ? 128 * t + within : FF + 128 * t + (within - 128);
            transpose_item(which ? w.f2i : w.f1i, 2 * FF, D, kb * 64, src, (bf16_t*)(ws + (which ? WS_WF2I : WS_WF1I)), d0, scr, lane, w.ng + (which ? 4 * D : 0)); continue; } r -= 2 * I_FI;
        if (r < 2 * I_FO) { const int which = r / I_FO; r -= which * I_FO; const int nb = r % (D / 32), kb = r / (D / 32);
            transpose_item(which ? w.f2o : w.f1o, D, FF, kb * 64, nb * 32, (bf16_t*)(ws + (which ? WS_WF2O : WS_WF1O)), nb * 32, scr, lane); continue; } r -= 2 * I_FO;
        if (r < I_BA) { const int nb = r % (D / 32), kb = r / (D / 32);
            transpose_item(w.w_bra, D, 1024, kb * 64, nb * 32, (bf16_t*)(ws + WS_WBRA), nb * 32, scr, lane); continue; } r -= I_BA;
        if (r < 2 * I_BB) { const int which = r / I_BB; r -= which * I_BB; const int nb = r % (D / 32), kb = r / (D / 32);
            transpose_item(which ? w.w_brc : w.w_brb, D, 512, kb * 64, nb * 32, (bf16_t*)(ws + (which ? WS_WBRC : WS_WBRB)), nb * 32, scr, lane); continue; } r -= 2 * I_BB;
        { const int nb = r % (D / 32), kb = r / (D / 32);
            transpose_item(w.w_out, D, D, kb * 64, nb * 32, (bf16_t*)(ws + WS_WOUT), nb * 32, scr, lane); }
    }
}
__device__ __forceinline__ void phase_norm(bf16_t* XB, const bf16_t* Y, float* RSTD, float* OUT, const float* gpost, float coef, int gw, int NGW, int lane) {
    for (int m = gw; m < M; m += NGW) {
        const u32x2* xr = (const u32x2*)(XB + (size_t)m * D) + lane; const u32x2* yr = (const u32x2*)(Y + (size_t)m * D) + lane;
        f32x4 x[8], y[8]; float s = 0.f;
#pragma unroll
        for (int j = 0; j < 8; ++j) { const u32x2 t = yr[64 * j], q = xr[64 * j]; y[j] = (f32x4){bflo(t.x), bfhi(t.x), bflo(t.y), bfhi(t.y)}; x[j] = (f32x4){bflo(q.x), bfhi(q.x), bflo(q.y), bfhi(q.y)};
            s += (y[j].x * y[j].x + y[j].y * y[j].y) + (y[j].z * y[j].z + y[j].w * y[j].w); }
        const float rstd = coef * (1.0f / sqrtf(wave_sum(s) * (1.0f / D) + EPS));
        float s2 = 0.f;
#pragma unroll
        for (int j = 0; j < 8; ++j) { const f32x4 g = ((const f32x4*)gpost)[lane + 64 * j]; x[j] = x[j] + y[j] * g * rstd; s2 += (x[j].x * x[j].x + x[j].y * x[j].y) + (x[j].z * x[j].z + x[j].w * x[j].w); }
        if (OUT) { f32x4* xo = (f32x4*)(OUT + (size_t)m * D) + lane;
#pragma unroll
            for (int j = 0; j < 8; ++j) xo[64 * j] = x[j];
        } else {
            u32x2* o8 = (u32x2*)(XB + (size_t)m * D) + lane;
#pragma unroll
            for (int j = 0; j < 8; ++j) { u32x2 w; w.x = cvt_pk_bf16(x[j].x, x[j].y); w.y = cvt_pk_bf16(x[j].z, x[j].w); o8[64 * j] = w; }
            const float r2 = 1.0f / sqrtf(wave_sum(s2) * (1.0f / D) + EPS);
            if (lane == 0) RSTD[m] = r2;
        }
    }
}
__device__ __forceinline__ void phase_prep(bf16_t* PROJ, const float* qk_gain  , LAS unsigned char* lds, int gw, int NGW, int tid, int lane) {
    LAS f32x2* cs = (LAS f32x2*)lds;
    for (int i = tid; i < 2048; i += 512) { const int pos = i >> 5, mi = i & 31; const float inv = powf(10000.0f, -(float)mi / 32.0f); float s, c; sincosf((float)pos * inv, &s, &c); cs[i] = (f32x2){c, s}; }
    __syncthreads();
    const float gq0 = qk_gain[2 * lane], gq1 = qk_gain[2 * lane + 1], gk0 = qk_gain[128 + 2 * lane], gk1 = qk_gain[128 + 2 * lane + 1];
    for (int m = gw; m < M; m += NGW) {
        const int t = m & (SEQ - 1), pr = t >> 6, pc = t & 63;
        const f32x2 c_s = cs[((lane < 32) ? pr : pc) * 32 + (lane & 31)];
        unsigned* row = (unsigned*)(PROJ + (size_t)m * NPROJ);
        unsigned v[10];
#pragma unroll
        for (int h = 0; h < 10; ++h) v[h] = row[h * 64 + lane];
#pragma unroll
        for (int h = 0; h < 10; ++h) {
            const float x1 = bflo(v[h]), x2 = bfhi(v[h]);
            const float rstd = 1.0f / sqrtf(wave_sum(x1 * x1 + x2 * x2) * (1.0f / 128.0f) + EPS);
            const float n1 = x1 * rstd * (h < 8 ? gq0 : gk0), n2 = x2 * rstd * (h < 8 ? gq1 : gk1);
            row[h * 64 + lane] = cvt_pk_bf16(n1 * c_s.x - n2 * c_s.y, n1 * c_s.y + n2 * c_s.x);
        }
    }
    __syncthreads();
}
__device__ __forceinline__ void tr_pair(unsigned base, int pitch, int row0, int col0, int lane, s16x4& lo, s16x4& hi) {
    const int g = lane >> 4, i = lane & 15;
    const unsigned addr = base + (unsigned)((row0 + 4 * g + (i >> 2)) * pitch + (col0 + 4 * (i & 3)) * 2);
    asm volatile("ds_read_b64_tr_b16 %0, %1" : "=&v"(lo) : "v"(addr) : "memory");
    asm volatile("ds_read_b64_tr_b16 %0, %1" : "=&v"(hi) : "v"(addr + (unsigned)(16 * pitch)) : "memory");
}
#define TR_JOIN(L, H) ((bf16x8){L[0], L[1], L[2], L[3], H[0], H[1], H[2], H[3]})
__device__ __forceinline__ bf16x8 pack8(const float* x) { u32x4 w; w.x = cvt_pk_bf16(x[0], x[1]); w.y = cvt_pk_bf16(x[2], x[3]); w.z = cvt_pk_bf16(x[4], x[5]); w.w = cvt_pk_bf16(x[6], x[7]); return *reinterpret_cast<bf16x8*>(&w); }
__device__ __forceinline__ void na_unit(bf16_t* PROJ, LAS unsigned char* lds, int u) {
    const int tid = opaque_tid(), lane = tid & 63, w = __builtin_amdgcn_readfirstlane(tid >> 6);
    constexpr int PV = 272, O_V = 0, O_RPB = 2 * 64 * PV;
    LAS float* rpbs = (LAS float*)(lds + O_RPB);
    const unsigned lbase = (unsigned)(uintptr_t)lds;
    const int ib = w & 3, vh = w >> 2;
    {
        int lane_o = lane; asm volatile("" : "+v"(lane_o));
        const int g = lane_o >> 4, li = lane_o & 15;
        const int r = u & 31, h = (u >> 5) & 3, b = u >> 7;
        const int rs = min(max(r - 4, 0), 24);
        const int c = 16 * ib + li, cs0 = min(max(c - 8, 0), 48);
        const size_t tq = (size_t)b * SEQ + r * 64 + c;
        bf16x8 qf[4];
#pragma unroll
        for (int ks = 0; ks < 4; ++ks) qf[ks] = *(const bf16x8*)(PROJ + tq * NPROJ + C_BQ + h * 128 + 32 * ks + 8 * g);
        int jbv[4], dcv[4];
#pragma unroll
        for (int rr = 0; rr < 4; ++rr) { const int km = 4 * g + rr; jbv[rr] = (cs0 + 15 - km) >> 4; dcv[rr] = 16 * jbv[rr] + km - c + 15; }
        f32x4 o[4];
#pragma unroll
        for (int vt = 0; vt < 4; ++vt) o[vt] = (f32x4){0.f, 0.f, 0.f, 0.f};
        float m_run = -1e30f, l_run = 0.f;
        const int sr = tid >> 4, sc = (tid & 15) * 8;
        const int jlo = ib > 1 ? ib - 1 : 0, jhi = ib < 2 ? ib + 1 : 3;
        bf16x8 kf[4][4], vr0, vr1;
#define NA_LOADK(kr_) do { const size_t kt_ = (size_t)b * SEQ + (size_t)(rs + (kr_)) * 64; \
            _Pragma("unroll") for (int jb = 0; jb < 4; ++jb) if (jb >= jlo && jb <= jhi) { const bf16_t* kp = PROJ + (kt_ + 16 * jb + li) * NPROJ + C_BK + h * 128 + 8 * g; \
                _Pragma("unroll") for (int ks = 0; ks < 4; ++ks) kf[jb][ks] = *(const bf16x8*)(kp + 32 * ks); } } while (0)
#define NA_LOADV(kr_) do { const size_t kt_ = (size_t)b * SEQ + (size_t)(rs + (kr_)) * 64; \
            vr0 = *(const bf16x8*)(PROJ + (kt_ + sr) * NPROJ + C_BV + h * 128 + sc); vr1 = *(const bf16x8*)(PROJ + (kt_ + sr + 32) * NPROJ + C_BV + h * 128 + sc); } while (0)
        NA_LOADV(0); NA_LOADK(0);
        for (int kr = 0; kr < 8; ++kr) {
            *(LAS bf16x8*)(lds + O_V + (kr & 1) * 64 * PV + sr * PV + sc * 2) = vr0; *(LAS bf16x8*)(lds + O_V + (kr & 1) * 64 * PV + (sr + 32) * PV + sc * 2) = vr1;
            if (kr + 1 < 8) NA_LOADV(kr + 1);
            f32x4 s[4];
#pragma unroll
            for (int jb = 0; jb < 4; ++jb) { s[jb] = (f32x4){0.f, 0.f, 0.f, 0.f};
                if (jb >= jlo && jb <= jhi) {
#pragma unroll
                    for (int ks = 0; ks < 4; ++ks) s[jb] = __builtin_amdgcn_mfma_f32_16x16x32_bf16(kf[jb][ks], qf[ks], s[jb], 0, 0, 0); } }
            if (kr + 1 < 8) NA_LOADK(kr + 1);
            const int dr = rs + kr - r + 7;
            float mx = -1e30f;
#pragma unroll
            for (int rr = 0; rr < 4; ++rr) { const float bias = rpbs[(h * 15 + dr) * 31 + dcv[rr]];
#pragma unroll
                for (int jb = 0; jb < 4; ++jb) { const float v = (jb == jbv[rr]) ? s[jb][rr] * 0.088388347648318440f + bias : -1e30f; s[jb][rr] = v; mx = fmaxf(mx, v); } }
            mx = fmaxf(mx, __shfl_xor(mx, 16)); mx = fmaxf(mx, __shfl_xor(mx, 32));
            const float m_new = fmaxf(m_run, mx), alpha = __expf(m_run - m_new);
            m_run = m_new;
            float ps = 0.f;
#pragma unroll
            for (int jb = 0; jb < 4; ++jb)
#pragma unroll
                for (int rr = 0; rr < 4; ++rr) { const float p = (jb == jbv[rr]) ? __expf(s[jb][rr] - m_new) : 0.f; s[jb][rr] = p; ps += p; }
            l_run = l_run * alpha + ps;
            bf16x8 pfr[2];
#pragma unroll
            for (int ss = 0; ss < 2; ++ss) { const float t[8] = {s[2 * ss][0], s[2 * ss][1], s[2 * ss][2], s[2 * ss][3], s[2 * ss + 1][0], s[2 * ss + 1][1], s[2 * ss + 1][2], s[2 * ss + 1][3]}; pfr[ss] = pack8(t); }
            __syncthreads();
            s16x4 vl[4][2], vhh[4][2];
            {
                const unsigned vbase = lbase + O_V + (unsigned)((kr & 1) * 64 * PV + (4 * g + (li >> 2)) * PV + (64 * vh + 4 * (li & 3)) * 2);
                asm volatile("ds_read_b64_tr_b16 %0, %16 offset:0\n\t"
                         "ds_read_b64_tr_b16 %1, %16 offset:4352\n\t"
                         "ds_read_b64_tr_b16 %2, %16 offset:8704\n\t"
                         "ds_read_b64_tr_b16 %3, %16 offset:13056\n\t"
                         "ds_read_b64_tr_b16 %4, %16 offset:32\n\t"
                         "ds_read_b64_tr_b16 %5, %16 offset:4384\n\t"
                         "ds_read_b64_tr_b16 %6, %16 offset:8736\n\t"
                         "ds_read_b64_tr_b16 %7, %16 offset:13088\n\t"
                         "ds_read_b64_tr_b16 %8, %16 offset:64\n\t"
                         "ds_read_b64_tr_b16 %9, %16 offset:4416\n\t"
                         "ds_read_b64_tr_b16 %10, %16 offset:8768\n\t"
                         "ds_read_b64_tr_b16 %11, %16 offset:13120\n\t"
                         "ds_read_b64_tr_b16 %12, %16 offset:96\n\t"
                         "ds_read_b64_tr_b16 %13, %16 offset:4448\n\t"
                         "ds_read_b64_tr_b16 %14, %16 offset:8800\n\t"
                         "ds_read_b64_tr_b16 %15, %16 offset:13152\n\t"
                         "s_waitcnt lgkmcnt(0)"
                         : "=&v"(vl[0][0]), "=&v"(vhh[0][0]), "=&v"(vl[0][1]), "=&v"(vhh[0][1]), "=&v"(vl[1][0]), "=&v"(vhh[1][0]), "=&v"(vl[1][1]), "=&v"(vhh[1][1]), "=&v"(vl[2][0]), "=&v"(vhh[2][0]), "=&v"(vl[2][1]), "=&v"(vhh[2][1]), "=&v"(vl[3][0]), "=&v"(vhh[3][0]), "=&v"(vl[3][1]), "=&v"(vhh[3][1])
                         : "v"(vbase) : "memory");
            }
            __builtin_amdgcn_sched_barrier(0);
#pragma unroll
            for (int vt = 0; vt < 4; ++vt) { o[vt] = o[vt] * alpha;
#pragma unroll
                for (int ss = 0; ss < 2; ++ss) o[vt] = __builtin_amdgcn_mfma_f32_16x16x32_bf16(TR_JOIN(vl[vt][ss], vhh[vt][ss]), pfr[ss], o[vt], 0, 0, 0); }
        }
#undef NA_LOADK
#undef NA_LOADV
        l_run += __shfl_xor(l_run, 16); l_run += __shfl_xor(l_run, 32);
        const float inv = 1.0f / l_run;
#pragma unroll
        for (int vt = 0; vt < 4; ++vt) { u32x2 ov; ov.x = cvt_pk_bf16(o[vt].x * inv, o[vt].y * inv); ov.y = cvt_pk_bf16(o[vt].z * inv, o[vt].w * inv);
            *(u32x2*)(PROJ + tq * NPROJ + C_BQ + h * 128 + 64 * vh + 16 * vt + 4 * g) = ov; }
        __syncthreads();
    }
}
__device__ __forceinline__ void na_load_bias(const float* rpb, LAS unsigned char* lds) {
    const int tid = opaque_tid(); LAS float* rpbs = (LAS float*)(lds + 2 * 64 * 272);
    __syncthreads();
    for (int i = tid; i < 4 * 15 * 31; i += 512) rpbs[i] = rpb[i];
    __syncthreads();
}
__device__ __forceinline__ float logsig16(float z) { return (fminf(z, 0.f) - __logf(1.0f + __expf(-fabsf(z)))) * (1.0f / 16.0f); }
__device__ __forceinline__ void gla_seq_unit(const bf16_t* PROJ, const float* LR, const float* w_decay  , const float* b_decay  , bf16_t* OFB, bf16_t* OC, const float* onorm,
                                             LAS unsigned char* lds, int b, int h) {
    const int tid = opaque_tid(), lane = tid & 63, w = __builtin_amdgcn_readfirstlane(tid >> 6);
    constexpr int P64 = 144, PV = 272;
    constexpr int O_Q = 0, O_K = 9216, O_KH = 18432, O_V = 27648, O_S = 45056, O_DEC = 63488, O_W2 = 63744;
    const unsigned lbase = (unsigned)(uintptr_t)lds;
    const int ib = w & 3, vh = w >> 2, g = lane >> 4, li = lane & 15;
    LAS float* w2s = (LAS float*)(lds + O_W2);
    LAS float* gns = (LAS float*)(lds + 68608);
    __syncthreads(); if (tid < 128) gns[tid] = onorm[tid];
    LAS float* red = (LAS float*)(lds + 68096);
  for (int dir = 0; dir < 2; ++dir) {
    __syncthreads();
    for (int i = tid; i < 16 * 64; i += 512) w2s[i] = w_decay[dir * 4096 + (i >> 6) * 256 + h * 64 + (i & 63)];
    if (tid < 64) w2s[1024 + tid] = b_decay[dir * 256 + h * 64 + tid];
    for (int i = tid; i < 128 * 72 / 2; i += 512) ((LAS unsigned*)(lds + O_S))[i] = 0u;
    f32x4 S[4];
#pragma unroll
    for (int vt = 0; vt < 4; ++vt) S[vt] = (f32x4){0.f, 0.f, 0.f, 0.f};
    const int dcol = 8 * w;
    const int sr = tid >> 4, sc = (tid & 15) * 8;
    f32x4 lr4[4]; u32x4 qraw, kraw; bf16x8 vst0, vst1;
    u32x2 ofr[4], ogr[4];
#define GLA_LOAD_O(cc_) do { const int c_ = 31 - (cc_); const size_t mi_ = (size_t)b * SEQ + c_ * 64 + 16 * ib + li; \
        _Pragma("unroll") for (int vt = 0; vt < 4; ++vt) { ofr[vt] = *(const u32x2*)(OFB + mi_ * 512 + h * 128 + 64 * vh + 16 * vt + 4 * g); ogr[vt] = *(const u32x2*)(PROJ + mi_ * NPROJ + C_OG + h * 128 + 64 * vh + 16 * vt + 4 * g); } } while (0)
#define GLA_LOAD(cc_) do { const int c_ = dir ? 31 - (cc_) : (cc_); const size_t m0_ = (size_t)b * SEQ + c_ * 64, m_ = m0_ + lane; \
        _Pragma("unroll") for (int j = 0; j < 4; ++j) lr4[j] = ((const f32x4*)(LR + m_ * 32 + dir * 16))[j]; \
        qraw = *(const u32x4*)(PROJ + m_ * NPROJ + C_CQ + h * 64 + dcol); kraw = *(const u32x4*)(PROJ + m_ * NPROJ + C_CK + h * 64 + dcol); \
        vst0 = *(const bf16x8*)(PROJ + (m0_ + sr) * NPROJ + C_CV + h * 128 + sc); vst1 = *(const bf16x8*)(PROJ + (m0_ + sr + 32) * NPROJ + C_CV + h * 128 + sc); } while (0)
#pragma unroll
    for (int vt = 0; vt < 4; ++vt) { ofr[vt] = (u32x2){0u, 0u}; ogr[vt] = (u32x2){0u, 0u}; }
    GLA_LOAD(0);
    if (dir) GLA_LOAD_O(0);
    __syncthreads();
    for (int cc = 0; cc < 32; ++cc) {
        const int c = dir ? 31 - cc : cc; const size_t m0 = (size_t)b * SEQ + c * 64;
        {
            f32x4 z0 = *(const LAS f32x4*)(w2s + 1024 + dcol), z1 = *(const LAS f32x4*)(w2s + 1024 + dcol + 4);
#pragma unroll
            for (int j = 0; j < 4; ++j)
#pragma unroll
                for (int rr = 0; rr < 4; ++rr) { const int r = 4 * j + rr; z0 = z0 + *(const LAS f32x4*)(w2s + r * 64 + dcol) * lr4[j][rr]; z1 = z1 + *(const LAS f32x4*)(w2s + r * 64 + dcol + 4) * lr4[j][rr]; }
            float bs[8];
#pragma unroll
            for (int e = 0; e < 4; ++e) { bs[e] = logsig16(z0[e]); bs[4 + e] = logsig16(z1[e]); }
            if (dir == 0) {
#pragma unroll
                for (int off = 1; off < 64; off <<= 1)
#pragma unroll
                    for (int e = 0; e < 8; ++e) { const float t = __shfl_up(bs[e], off); if (lane >= off) bs[e] += t; }
            } else {
#pragma unroll
                for (int off = 1; off < 64; off <<= 1)
#pragma unroll
                    for (int e = 0; e < 8; ++e) { const float t = __shfl_down(bs[e], off); if (lane + off < 64) bs[e] += t; }
            }
            const float q[8] = {bflo(qraw.x), bfhi(qraw.x), bflo(qraw.y), bfhi(qraw.y), bflo(qraw.z), bfhi(qraw.z), bflo(qraw.w), bfhi(qraw.w)};
            const float k[8] = {bflo(kraw.x), bfhi(kraw.x), bflo(kraw.y), bfhi(kraw.y), bflo(kraw.z), bfhi(kraw.z), bflo(kraw.w), bfhi(kraw.w)};
            float qt[8], kt[8], kh[8], dc[8];
#pragma unroll
            for (int e = 0; e < 8; ++e) { const float be = __shfl(bs[e], dir ? 0 : 63);
                qt[e] = q[e] * 0.125f * __expf(bs[e]); kt[e] = k[e] * __expf(-bs[e]); kh[e] = k[e] * __expf(be - bs[e]); dc[e] = __expf(be); }
            *(LAS bf16x8*)(lds + O_Q + lane * P64 + 16 * w) = pack8(qt); *(LAS bf16x8*)(lds + O_K + lane * P64 + 16 * w) = pack8(kt); *(LAS bf16x8*)(lds + O_KH + lane * P64 + 16 * w) = pack8(kh);
            if (lane == 0) { *(LAS f32x4*)(lds + O_DEC + 4 * dcol) = (f32x4){dc[0], dc[1], dc[2], dc[3]}; *(LAS f32x4*)(lds + O_DEC + 4 * dcol + 16) = (f32x4){dc[4], dc[5], dc[6], dc[7]}; }
            *(LAS bf16x8*)(lds + O_V + sr * PV + sc * 2) = vst0; *(LAS bf16x8*)(lds + O_V + (sr + 32) * PV + sc * 2) = vst1;
        }
        __syncthreads();
        if (cc + 1 < 32) GLA_LOAD(cc + 1);
        const size_t mi = m0 + 16 * ib + li; f32x4 oo[4]; float ss = 0.f;
        {
            bf16x8 qF[2];
#pragma unroll
            for (int ks = 0; ks < 2; ++ks) qF[ks] = *(const LAS bf16x8*)(lds + O_Q + (16 * ib + li) * P64 + (32 * ks + 8 * g) * 2);
            f32x4 P[4];
#pragma unroll
            for (int jb = 0; jb < 4; ++jb) {
                f32x4 a = {0.f, 0.f, 0.f, 0.f};
                const bool need = dir ? (jb >= ib) : (jb <= ib);
                if (need) {
#pragma unroll
                    for (int ks = 0; ks < 2; ++ks) a = __builtin_amdgcn_mfma_f32_16x16x32_bf16(*(const LAS bf16x8*)(lds + O_K + (16 * jb + li) * P64 + (32 * ks + 8 * g) * 2), qF[ks], a, 0, 0, 0); }
#pragma unroll
                for (int r = 0; r < 4; ++r) { const int jl = 4 * g + r;
                    const bool keep = (jb == ib) ? (dir ? (jl >= li) : (jl <= li)) : need;
                    P[jb][r] = keep ? a[r] : 0.f; }
            }
            bf16x8 pfr[2];
#pragma unroll
            for (int s = 0; s < 2; ++s) { const float t[8] = {P[2 * s][0], P[2 * s][1], P[2 * s][2], P[2 * s][3], P[2 * s + 1][0], P[2 * s + 1][1], P[2 * s + 1][2], P[2 * s + 1][3]}; pfr[s] = pack8(t); }
            s16x4 vl[4][2], vhh[4][2], kl[2], kh2[2];
            {
                const unsigned vbase = lbase + O_V + (unsigned)((4 * g + (li >> 2)) * PV + (64 * vh + 4 * (li & 3)) * 2);
                const unsigned kbase = lbase + O_KH + (unsigned)((4 * g + (li >> 2)) * P64 + (16 * ib + 4 * (li & 3)) * 2);
                asm volatile("ds_read_b64_tr_b16 %0, %20 offset:0\n\t"
                         "ds_read_b64_tr_b16 %1, %20 offset:4352\n\t"
                         "ds_read_b64_tr_b16 %2, %20 offset:8704\n\t"
                         "ds_read_b64_tr_b16 %3, %20 offset:13056\n\t"
                         "ds_read_b64_tr_b16 %4, %20 offset:32\n\t"
                         "ds_read_b64_tr_b16 %5, %20 offset:4384\n\t"
                         "ds_read_b64_tr_b16 %6, %20 offset:8736\n\t"
                         "ds_read_b64_tr_b16 %7, %20 offset:13088\n\t"
                         "ds_read_b64_tr_b16 %8, %20 offset:64\n\t"
                         "ds_read_b64_tr_b16 %9, %20 offset:4416\n\t"
                         "ds_read_b64_tr_b16 %10, %20 offset:8768\n\t"
                         "ds_read_b64_tr_b16 %11, %20 offset:13120\n\t"
                         "ds_read_b64_tr_b16 %12, %20 offset:96\n\t"
                         "ds_read_b64_tr_b16 %13, %20 offset:4448\n\t"
                         "ds_read_b64_tr_b16 %14, %20 offset:8800\n\t"
                         "ds_read_b64_tr_b16 %15, %20 offset:13152\n\t"
                         "ds_read_b64_tr_b16 %16, %21 offset:0\n\t"
                         "ds_read_b64_tr_b16 %17, %21 offset:2304\n\t"
                         "ds_read_b64_tr_b16 %18, %21 offset:4608\n\t"
                         "ds_read_b64_tr_b16 %19, %21 offset:6912\n\t"
                         "s_waitcnt lgkmcnt(0)"
                         : "=&v"(vl[0][0]), "=&v"(vhh[0][0]), "=&v"(vl[0][1]), "=&v"(vhh[0][1]), "=&v"(vl[1][0]), "=&v"(vhh[1][0]), "=&v"(vl[1][1]), "=&v"(vhh[1][1]), "=&v"(vl[2][0]), "=&v"(vhh[2][0]), "=&v"(vl[2][1]), "=&v"(vhh[2][1]), "=&v"(vl[3][0]), "=&v"(vhh[3][0]), "=&v"(vl[3][1]), "=&v"(vhh[3][1]), "=&v"(kl[0]), "=&v"(kh2[0]), "=&v"(kl[1]), "=&v"(kh2[1])
                         : "v"(vbase), "v"(kbase) : "memory");
            }
            bf16x8 sfr[4][2];
#pragma unroll
            for (int vt = 0; vt < 4; ++vt)
#pragma unroll
                for (int ks = 0; ks < 2; ++ks) sfr[vt][ks] = *(const LAS bf16x8*)(lds + O_S + (64 * vh + 16 * vt + li) * P64 + (32 * ks + 8 * g) * 2);
            const float dec = *(const LAS float*)(lds + O_DEC + 4 * (16 * ib + li));
            __builtin_amdgcn_sched_barrier(0);
#pragma unroll
            for (int vt = 0; vt < 4; ++vt) {
                const int v0 = 64 * vh + 16 * vt;
                f32x4 o = {0.f, 0.f, 0.f, 0.f};
#pragma unroll
                for (int s = 0; s < 2; ++s) o = __builtin_amdgcn_mfma_f32_16x16x32_bf16(TR_JOIN(vl[vt][s], vhh[vt][s]), pfr[s], o, 0, 0, 0);
#pragma unroll
                for (int ks = 0; ks < 2; ++ks) o = __builtin_amdgcn_mfma_f32_16x16x32_bf16(sfr[vt][ks], qF[ks], o, 0, 0, 0);
                if (dir == 0) { u32x2 ov; ov.x = (unsigned)f2bf(o.x) | ((unsigned)f2bf(o.y) << 16); ov.y = (unsigned)f2bf(o.z) | ((unsigned)f2bf(o.w) << 16);
                    *(u32x2*)(OFB + mi * 512 + h * 128 + v0 + 4 * g) = ov; }
                else { const u32x2 f = ofr[vt];
                    o.x += bflo(f.x); o.y += bfhi(f.x); o.z += bflo(f.y); o.w += bfhi(f.y); oo[vt] = o; ss += (o.x * o.x + o.y * o.y) + (o.z * o.z + o.w * o.w); }
                f32x4 sn = S[vt] * dec;
#pragma unroll
                for (int s = 0; s < 2; ++s) sn = __builtin_amdgcn_mfma_f32_16x16x32_bf16(TR_JOIN(vl[vt][s], vhh[vt][s]), TR_JOIN(kl[s], kh2[s]), sn, 0, 0, 0);
                S[vt] = sn;
            }
        }
        if (dir) { ss += __shfl_xor(ss, 16); ss += __shfl_xor(ss, 32); if (g == 0) red[vh * 64 + 16 * ib + li] = ss; }
        __syncthreads();
        if (dir) {
            const float rstd = 1.0f / sqrtf((red[16 * ib + li] + red[64 + 16 * ib + li]) * (1.0f / 128.0f) + EPS);
#pragma unroll
            for (int vt = 0; vt < 4; ++vt) { const int v0 = 64 * vh + 16 * vt;
                const u32x2 og = ogr[vt]; const f32x4 gn = *(const LAS f32x4*)(gns + v0 + 4 * g);
                u32x2 ov; ov.x = cvt_pk_bf16(oo[vt].x * rstd * gn.x * pg8::silu_f(bflo(og.x)), oo[vt].y * rstd * gn.y * pg8::silu_f(bfhi(og.x)));
                ov.y = cvt_pk_bf16(oo[vt].z * rstd * gn.z * pg8::silu_f(bflo(og.y)), oo[vt].w * rstd * gn.w * pg8::silu_f(bfhi(og.y)));
                *(u32x2*)(OC + mi * 512 + h * 128 + v0 + 4 * g) = ov; }
            if (cc + 1 < 32) GLA_LOAD_O(cc + 1);
        }
#pragma unroll
        for (int vt = 0; vt < 4; ++vt)
#pragma unroll
            for (int r = 0; r < 4; ++r) *(LAS bf16_t*)(lds + O_S + (64 * vh + 16 * vt + 4 * g + r) * P64 + (16 * ib + li) * 2) = f2bf(S[vt][r]);
    }
    __syncthreads();
  }
#undef GLA_LOAD
#undef GLA_LOAD_O
}
constexpr int NPH = 15;
enum { P_F1A = 0, P_F1B, P_N1, P_M1, P_PREP, P_ATT, P_NA, P_GLA, P_GLC, P_M4, P_M5, P_N2, P_F2A, P_F2B, P_N3 };
constexpr int NGP = 1 + DEPTH * NPH;
struct Args { const float* in[18]; float* out; unsigned char* ws; int gp_lo, gp_hi; };

typedef decltype(__builtin_amdgcn_kernarg_segment_ptr()) kargp_t;
__device__ __forceinline__ unsigned long long karg_q(int byte_off) { kargp_t p_ = __builtin_amdgcn_kernarg_segment_ptr(); asm volatile("" : "+s"(p_));
    return *(const unsigned long long __attribute__((address_space(4)))*)((const char __attribute__((address_space(4)))*)p_ + byte_off); }
__global__ void __launch_bounds__(512, 2) fwd(Args args) {
    extern __shared__ __attribute__((aligned(16))) unsigned char lds_raw[];
    LAS unsigned char* const lds0 = (LAS unsigned char*)lds_raw;
    const int G0 = gridDim.x, wg0 = blockIdx.x;
#define PENV LAS unsigned char* lds = lds0; int G = G0, wg = wg0; asm volatile("" : "+s"(lds), "+s"(G), "+s"(wg)); const int NGW = G * 8; (void)NGW; (void)lds; (void)wg
    volatile LAS unsigned* MISC = (volatile LAS unsigned*)(lds0 + MISC_OFF);
    volatile LAS unsigned long long* PT = (volatile LAS unsigned long long*)(lds0 + PTAB_OFF);
    { const int t0 = threadIdx.x;
      for (int u = t0; u < (LDS_BYTES - LDSCTL_OFF) / 4; u += 512) ((LAS unsigned*)(lds0 + LDSCTL_OFF))[u] = 0u;
      __syncthreads();
      __syncthreads(); }
#if ONE_LAUNCH
    constexpr int lo = 0, hi = NGP;
#else
    const int lo = args.gp_lo, hi = args.gp_hi;
#endif
    XcdBarrier bar; bar.bar = (unsigned*)(args.ws + WS_CTL) + CW_BAR; bar.x = 0; bar.st = nullptr;
    if (hi - lo > 1) bar = xcd_barrier_setup((unsigned*)(args.ws + WS_CTL) + CW_BAR, MISC + 8);
#define SEAM(gp) do { if ((gp) + 1 < hi) xcd_barrier(bar); } while (0)
#define INP(i) ((const float*)(const GAS float*)karg_q(8 * (i)))
#define WSP() ((unsigned char*)(GAS unsigned char*)karg_q(8 * 19))
#define XP() ((float*)(GAS float*)karg_q(8 * 18))
#define TIDS() PENV; const int tid = opaque_tid(), lane = tid & 63, wave = __builtin_amdgcn_readfirstlane(tid >> 6), gw = wg * 8 + wave; (void)tid; (void)lane; (void)wave; (void)gw

    if (((PHASE_MASK >> 31) & 1u) && lo <= 0 && 0 < hi) {
        TIDS(); unsigned char* ws = WSP(); bf16_t* XB = (bf16_t*)(ws + WS_XN); float* RSTD = (float*)(ws + WS_RSTD);
        LayerW w; w.w_in = INP(3); w.w_bra = INP(10); w.w_brb = INP(11); w.w_brc = INP(12); w.w_out = INP(13); w.f1i = INP(14); w.f1o = INP(15); w.f2i = INP(16); w.f2o = INP(17); w.ng = INP(2);
        phase_weights(w, ws, lds, gw, NGW, wave, lane);
        const float* xp = INP(0); const float* xs = INP(1);
        for (int m = gw; m < M; m += NGW) {
            const float* src = m < 16 * SEQ ? xp + (size_t)m * D : xs + (size_t)(m - 16 * SEQ) * D;
            const f32x4* xr = (const f32x4*)src + lane; f32x4 x[8]; float s = 0.f;
#pragma unroll
            for (int j = 0; j < 8; ++j) { x[j] = xr[64 * j]; s += (x[j].x * x[j].x + x[j].y * x[j].y) + (x[j].z * x[j].z + x[j].w * x[j].w); }
            u32x2* o8 = (u32x2*)(XB + (size_t)m * D) + lane;
#pragma unroll
            for (int j = 0; j < 8; ++j) { u32x2 wv; wv.x = cvt_pk_bf16(x[j].x, x[j].y); wv.y = cvt_pk_bf16(x[j].z, x[j].w); o8[64 * j] = wv; }
            const float rstd = 1.0f / sqrtf(wave_sum(s) * (1.0f / D) + EPS);
            if (lane == 0) RSTD[m] = rstd;
        }
        SEAM(0);
    }
    for (int l = 0; l < DEPTH; ++l) {
        const int gp0 = 1 + l * NPH;
        if (gp0 + NPH <= lo || gp0 >= hi) continue;
#define IN(p) (((PHASE_MASK >> (p)) & 1u) && lo <= gp0 + (p) && gp0 + (p) < hi)
#define FFN_PAIR(ff, pa, pb) do { \
        if (IN(pa)) { PENV; unsigned char* ws = WSP(); pg8::Gemm g{(const bf16_t*)(ws + WS_XN), (const bf16_t*)(ws + ((ff) ? WS_WF2I : WS_WF1I)), M, 2 * FF, D, D}; pg8::StaticOrder S; S.init(M, 2 * FF, G, wg, WGM_FI); \
            pg8::EpiSwiGLU E{(bf16_t*)(ws + WS_H), (const float*)(ws + WS_RSTD)}; pg8::gemm_phase<pg8::EpiSwiGLU, pg8::StaticOrder, true, true>(lds, g, S, E); if ((DUP_MASK >> (pa)) & 1u) pg8::gemm_phase<pg8::EpiSwiGLU, pg8::StaticOrder, true, true>(lds, g, S, E); SEAM(gp0 + (pa)); } \
        if (IN(pb)) { PENV; unsigned char* ws = WSP(); pg8::Gemm g{(const bf16_t*)(ws + WS_H), (const bf16_t*)(ws + ((ff) ? WS_WF2O : WS_WF1O)), M, D, FF, FF}; pg8::StaticOrder S; S.init(M, D, G, wg, WGM_FO); \
            pg8::EpiBf16Plain E{(bf16_t*)(ws + WS_Y), D}; pg8::gemm_phase<pg8::EpiBf16Plain, pg8::StaticOrder, true, true>(lds, g, S, E); if ((DUP_MASK >> (pb)) & 1u) pg8::gemm_phase<pg8::EpiBf16Plain, pg8::StaticOrder, true, true>(lds, g, S, E); SEAM(gp0 + (pb)); } } while (0)
#define NORM_PHASE(p, ipost, coef, last) do { if (IN(p)) { TIDS(); unsigned char* ws = WSP(); const float* ng = INP(2) + (size_t)l * 6 * D; \
            phase_norm((bf16_t*)(ws + WS_XN), (const bf16_t*)(ws + WS_Y), (float*)(ws + WS_RSTD), (last) ? XP() : nullptr, ng + (ipost) * D, (coef), gw, NGW, lane);

        FFN_PAIR(0, P_F1A, P_F1B);
        NORM_PHASE(P_N1, 1, 0.5f, false) SEAM(gp0 + P_N1); } } while (0);
        if (IN(P_M1)) { PENV;
            unsigned char* ws = WSP();
            pg8::Gemm g{(const bf16_t*)(ws + WS_XN), (const bf16_t*)(ws + WS_WIN), M, NIN_PAD, D, D}; pg8::StaticOrder S; S.init(M, NIN_PAD, G, wg, WGM_M1);
            pg8::EpiProj E{(bf16_t*)(ws + WS_PROJ), (bf16_t*)(ws + WS_GATES), (float*)(ws + WS_LR), INP(4) + (size_t)l * 3 * D, (const float*)(ws + WS_RSTD)};
            pg8::gemm_phase<pg8::EpiProj, pg8::StaticOrder, true, true>(lds, g, S, E);
            if ((DUP_MASK >> P_M1) & 1u) pg8::gemm_phase<pg8::EpiProj, pg8::StaticOrder, true, true>(lds, g, S, E);
            SEAM(gp0 + P_M1);
        }
        if (IN(P_PREP)) {
            { TIDS(); unsigned char* ws = WSP(); phase_prep((bf16_t*)(ws + WS_PROJ), INP(5) + (size_t)l * 256, lds, gw, NGW, tid, lane); }
            SEAM(gp0 + P_PREP);
        }
        if (IN(P_ATT)) { PENV;
            unsigned char* ws = WSP(); bf16_t* PROJ = (bf16_t*)(ws + WS_PROJ);
            const int ngrp = (G % 8 == 0) ? 8 : 1, xg = wg % ngrp, slot = wg / ngrp, per = G / ngrp;
            for (int gu = slot; gu < 96 / ngrp; gu += per) { const int U = xg * (96 / ngrp) + gu;
                gla_seq_unit(PROJ, (const float*)(ws + WS_LR), INP(7) + (size_t)l * 2 * 16 * 256, INP(8) + (size_t)l * 512, (bf16_t*)(ws + WS_OFB), (bf16_t*)(ws + WS_OC), INP(9) + (size_t)l * 128, lds, U >> 2, U & 3); }
            na_load_bias(INP(6) + (size_t)l * 4 * 15 * 31, lds);
            unsigned* head = (unsigned*)(ws + WS_CTL) + CW_Q + (l * 8 + xg) * 64;
            const int n_att = 1536 / ngrp, n_na = 3072 / ngrp;
            LAS unsigned* qslot = (LAS unsigned*)(lds + MISC_OFF + 64);
            for (;;) {
                __syncthreads();
                if (threadIdx.x == 0) *qslot = __hip_atomic_fetch_add(head, 1u, __ATOMIC_RELAXED, __HIP_MEMORY_SCOPE_AGENT);
                __syncthreads();
                const int idx = __builtin_amdgcn_readfirstlane((int)*(volatile LAS unsigned*)qslot);
                if (idx >= n_att * (1 + ATT_DUP) + n_na) break;
                if (idx < n_att * (1 + ATT_DUP)) { const int idx0 = idx; const int idx = idx0 % n_att;
                    const int rnd = idx >> 5, mem = idx & 31, grp = (ngrp == 8) ? rnd * 8 + xg : rnd;
                    const int b = grp >> 1, kvh = grp & 1, h = kvh * 4 + (mem >> 3), qb = mem & 7;
                    const size_t rowq = (size_t)b * SEQ + qb * 256, rowk = (size_t)b * SEQ;
                    bf16_t* Qp = PROJ + rowq * NPROJ + C_AQ + h * 128;
                    att::attn_dense_body(Qp, PROJ + rowk * NPROJ + C_AK + kvh * 128, PROJ + rowk * NPROJ + C_AV + kvh * 128, (bf16_t*)(ws + WS_OA) + rowq * 1024 + h * 128, SEQ, (char*)lds_raw + 49152);
                } else {
                    na_unit(PROJ, lds, xg * n_na + (idx - n_att * (1 + ATT_DUP)));
                }
            }
            SEAM(gp0 + P_GLA);
        }
        if (IN(P_M4)) { PENV;
            { unsigned char* ws = WSP(); pg8::Gemm g{(const bf16_t*)(ws + WS_OA), (const bf16_t*)(ws + WS_WBRA), M, D, 1024, 1024}; pg8::StaticOrder S; S.init(M, D, G, wg, WGM_M45);
              pg8::EpiMerge<true> E{(const bf16_t*)(ws + WS_GATES), (bf16_t*)(ws + WS_MG)}; pg8::gemm_phase<pg8::EpiMerge<true>, pg8::StaticOrder, true, true>(lds, g, S, E); }
            { unsigned char* ws = WSP(); pg8::Gemm g{(const bf16_t*)(ws + WS_PROJ) + C_BQ, (const bf16_t*)(ws + WS_WBRB), M, D, 512, NPROJ}; pg8::StaticOrder S; S.init(M, D, G, wg, WGM_M45);
              pg8::EpiMerge<false> E{(const bf16_t*)(ws + WS_GATES) + D, (bf16_t*)(ws + WS_MG)}; pg8::gemm_phase<pg8::EpiMerge<false>, pg8::StaticOrder, true, true>(lds, g, S, E); }
            { unsigned char* ws = WSP(); pg8::Gemm g{(const bf16_t*)(ws + WS_OC), (const bf16_t*)(ws + WS_WBRC), M, D, 512, 512}; pg8::StaticOrder S; S.init(M, D, G, wg, WGM_M45);
              pg8::EpiMerge<false> E{(const bf16_t*)(ws + WS_GATES) + 2 * D, (bf16_t*)(ws + WS_MG)}; pg8::gemm_phase<pg8::EpiMerge<false>, pg8::StaticOrder, true, true>(lds, g, S, E); }
            if ((DUP_MASK >> P_M4) & 1u) {
            { unsigned char* ws = WSP(); pg8::Gemm g{(const bf16_t*)(ws + WS_OA), (const bf16_t*)(ws + WS_WBRA), M, D, 1024, 1024}; pg8::StaticOrder S; S.init(M, D, G, wg, WGM_M45);
              pg8::EpiMerge<true> E{(const bf16_t*)(ws + WS_GATES), (bf16_t*)(ws + WS_MG)}; pg8::gemm_phase<pg8::EpiMerge<true>, pg8::StaticOrder, true, true>(lds, g, S, E); }
            { unsigned char* ws = WSP(); pg8::Gemm g{(const bf16_t*)(ws + WS_PROJ) + C_BQ, (const bf16_t*)(ws + WS_WBRB), M, D, 512, NPROJ}; pg8::StaticOrder S; S.init(M, D, G, wg, WGM_M45);
              pg8::EpiMerge<false> E{(const bf16_t*)(ws + WS_GATES) + D, (bf16_t*)(ws + WS_MG)}; pg8::gemm_phase<pg8::EpiMerge<false>, pg8::StaticOrder, true, true>(lds, g, S, E); }
            { unsigned char* ws = WSP(); pg8::Gemm g{(const bf16_t*)(ws + WS_OC), (const bf16_t*)(ws + WS_WBRC), M, D, 512, 512}; pg8::StaticOrder S; S.init(M, D, G, wg, WGM_M45);
              pg8::EpiMerge<false> E{(const bf16_t*)(ws + WS_GATES) + 2 * D, (bf16_t*)(ws + WS_MG)}; pg8::gemm_phase<pg8::EpiMerge<false>, pg8::StaticOrder, true, true>(lds, g, S, E); }
            }
            SEAM(gp0 + P_M4);
        }
        if (IN(P_M5)) { PENV;
            unsigned char* ws = WSP();
            pg8::Gemm g{(const bf16_t*)(ws + WS_MG), (const bf16_t*)(ws + WS_WOUT), M, D, D, D}; pg8::StaticOrder S; S.init(M, D, G, wg, WGM_M45);
            pg8::EpiBf16Plain E{(bf16_t*)(ws + WS_Y), D};
            pg8::gemm_phase<pg8::EpiBf16Plain, pg8::StaticOrder, true, true>(lds, g, S, E);
            if ((DUP_MASK >> P_M5) & 1u) pg8::gemm_phase<pg8::EpiBf16Plain, pg8::StaticOrder, true, true>(lds, g, S, E);
            SEAM(gp0 + P_M5);
        }
        NORM_PHASE(P_N2, 3, 1.0f, false) SEAM(gp0 + P_N2); } } while (0);
        FFN_PAIR(1, P_F2A, P_F2B);
        NORM_PHASE(P_N3, 5, 0.5f, (l + 1 == DEPTH))
            if (l + 1 < DEPTH) { LayerW w; w.w_in = INP(3) + (size_t)(l + 1) * D * NIN; w.w_bra = INP(10) + (size_t)(l + 1) * 1024 * D; w.w_brb = INP(11) + (size_t)(l + 1) * 512 * D; w.w_brc = INP(12) + (size_t)(l + 1) * 512 * D;
                w.w_out = INP(13) + (size_t)(l + 1) * D * D; w.f1i = INP(14) + (size_t)(l + 1) * D * 2 * FF; w.f1o = INP(15) + (size_t)(l + 1) * FF * D; w.f2i = INP(16) + (size_t)(l + 1) * D * 2 * FF; w.f2o = INP(17) + (size_t)(l + 1) * FF * D; w.ng = INP(2) + (size_t)(l + 1) * 6 * D;
                phase_weights(w, ws, lds, gw, NGW, wave, lane); if ((DUP_MASK >> 20) & 1u) phase_weights(w, ws, lds, gw, NGW, wave, lane); }
            SEAM(gp0 + P_N3); } } while (0);
#undef FFN_PAIR
#undef NORM_PHASE
#undef IN
    }
#undef SEAM
}

extern "C" void kernel_launch(void* const* d_in, const int* in_sizes, int n_in, void* d_out, int out_size, void* d_ws, size_t ws_size, hipStream_t stream) {
    static int grid = 0;
    if (grid == 0) {
        if (n_in != 18 || out_size != M * D || ws_size < WS_END) { fprintf(stderr, "kernel_launch: unexpected shapes: n_in %d out %d ws %zu (need %zu)\n", n_in, out_size, ws_size, (size_t)WS_END); grid = -1; return; }
        int dev = 0, cus = 0, per_cu = 0;
        if (hipGetDevice(&dev) != hipSuccess || hipDeviceGetAttribute(&cus, hipDeviceAttributeMultiprocessorCount, dev) != hipSuccess) { grid = -1; return; }
        if (hipFuncSetAttribute((const void*)fwd, hipFuncAttributeMaxDynamicSharedMemorySize, LDS_BYTES) != hipSuccess) { fprintf(stderr, "kernel_launch: hipFuncSetAttribute failed\n"); grid = -1; return; }
        if (hipOccupancyMaxActiveBlocksPerMultiprocessor(&per_cu, (const void*)fwd, 512, LDS_BYTES) != hipSuccess || per_cu < 1) fprintf(stderr, "kernel_launch: occupancy query says %d\n", per_cu);
        (void)hipGetLastError();
        grid = cus;
    }
    if (grid < 0) return;
    (void)hipMemsetAsync((char*)d_ws + WS_CTL, 0, CTL_BYTES, stream);
    Args a{};
    for (int i = 0; i < 18; ++i) a.in[i] = (const float*)d_in[i];
    a.out = (float*)d_out; a.ws = (unsigned char*)d_ws;
#if ONE_LAUNCH
    a.gp_lo = 0; a.gp_hi = NGP;
    hipLaunchKernelGGL(fwd, dim3(grid), dim3(512), LDS_BYTES, stream, a);
#else
    for (int gp = 0; gp < NGP; ++gp) { a.gp_lo = gp; a.gp_hi = gp + 1; hipLaunchKernelGGL(fwd, dim3(grid), dim3(512), LDS_BYTES, stream, a); }
#endif
    const hipError_t le = hipPeekAtLastError();
    if (le != hipSuccess) fprintf(stderr, "kernel_launch: launch failed: %s\n", hipGetErrorName(le));
}
```

```cpp
#include <hip/hip_runtime.h>
#include <cstdio>
#include <cstdint>

#ifndef ONE_LAUNCH
#define ONE_LAUNCH 1
#endif
#ifndef WGM_FI
#define WGM_FI 4
#endif
#ifndef WGM_FO
#define WGM_FO 2
#endif
#ifndef WGM_M1
#define WGM_M1 4
#endif
#ifndef WGM_M45
#define WGM_M45 4
#endif
#ifndef ATT_DUP
#define ATT_DUP 0
#endif
#ifndef DUP_MASK
#define DUP_MASK 0u
#endif
#ifndef PHASE_MASK
#define PHASE_MASK 0xFFFFFFFFu
#endif

#define GAS __attribute__((address_space(1)))
#define LAS __attribute__((address_space(3)))
typedef unsigned short bf16_t;
typedef short bf16x8 __attribute__((ext_vector_type(8)));
typedef short s16x4 __attribute__((ext_vector_type(4)));
typedef float f32x4 __attribute__((ext_vector_type(4)));
typedef float f32x2 __attribute__((ext_vector_type(2)));
typedef float f32x16 __attribute__((ext_vector_type(16)));
typedef unsigned u32x4 __attribute__((ext_vector_type(4)));
typedef unsigned u32x2 __attribute__((ext_vector_type(2)));

constexpr int M = 49152;
constexpr int SEQ = 2048, NSEQ = 24;
constexpr int D = 2048, FF = 5632, DEPTH = 4;
constexpr int NPROJ = 4608;
constexpr int NGATE = 6144;
constexpr int NIN = 10784, NIN_PAD = 11008;
constexpr int C_AQ = 0, C_AK = 1024, C_AV = 1280, C_BQ = 1536, C_BK = 2048, C_BV = 2560, C_CQ = 3072, C_CK = 3328, C_CV = 3584, C_OG = 4096;
constexpr int C_OC = 3072;
constexpr float EPS = 1e-6f;

constexpr size_t MiB = 1u << 20;
constexpr size_t WS_CTL = 0, CTL_BYTES = 1 * MiB;
constexpr size_t WS_WIN = 2 * MiB;
constexpr size_t WS_WF1I = 45 * MiB;
constexpr size_t WS_WF1O = 89 * MiB;
constexpr size_t WS_WF2I = 111 * MiB;
constexpr size_t WS_WF2O = 155 * MiB;
constexpr size_t WS_WBRA = 177 * MiB;
constexpr size_t WS_WBRB = 181 * MiB;
constexpr size_t WS_WBRC = 183 * MiB;
constexpr size_t WS_WOUT = 185 * MiB;
constexpr size_t WS_XN = 193 * MiB;
constexpr size_t WS_BIG = 385 * MiB;
constexpr size_t WS_PROJ = WS_BIG;
constexpr size_t WS_GATES = WS_BIG + 432 * MiB;
constexpr size_t WS_LR = WS_BIG + 1008 * MiB;
constexpr size_t WS_H = WS_BIG;
constexpr size_t WS_Y = WS_BIG + 528 * MiB;
constexpr size_t WS_OFB = WS_BIG + 1014 * MiB;
constexpr size_t WS_MG = WS_OFB + 48 * MiB;
constexpr size_t WS_RSTD = WS_MG + 192 * MiB;
constexpr size_t WS_OA = WS_RSTD + 1 * MiB;
constexpr int LDOM = 2048, OM_B = 1024, OM_C = 1536;
constexpr size_t WS_END = WS_OA + 192 * MiB;
constexpr int CW_Q = 32768;
static_assert(WS_Y + (size_t)M * D * 4 <= WS_LR, "Y inside GATES region");
constexpr int CW_BAR = 4096;

__device__ __forceinline__ unsigned cvt_pk_bf16(float lo, float hi) { unsigned r; asm volatile("v_cvt_pk_bf16_f32 %0, %1, %2" : "=v"(r) : "v"(lo), "v"(hi)); return r; }
__device__ __forceinline__ float bflo(unsigned w) { return __uint_as_float(w << 16); }
__device__ __forceinline__ float bfhi(unsigned w) { return __uint_as_float(w & 0xffff0000u); }
__device__ __forceinline__ float bf2f(bf16_t v) { return __uint_as_float(((unsigned)v) << 16); }
__device__ __forceinline__ bf16_t f2bf(float f) { unsigned u = __float_as_uint(f); return (bf16_t)((u + 0x7fffu + ((u >> 16) & 1u)) >> 16); }
__device__ __forceinline__ float wave_sum(float v) {
#pragma unroll
    for (int o = 1; o < 64; o <<= 1) v += __shfl_xor(v, o);
    return v;
}
__device__ __forceinline__ float wave_max(float v) {
#pragma unroll
    for (int o = 1; o < 64; o <<= 1) v = fmaxf(v, __shfl_xor(v, o));
    return v;
}
__device__ __forceinline__ int opaque_tid() { int t = threadIdx.x; asm volatile("" : "+v"(t)); return t; }
__device__ __forceinline__ unsigned char* opq(unsigned char* p) { asm volatile("" : "+s"(p)); return p; }
__device__ __forceinline__ const float* lds_ptr(volatile LAS unsigned long long* tab, int i) { const unsigned long long v = tab[i];
    const unsigned lo = __builtin_amdgcn_readfirstlane((unsigned)v), hi = __builtin_amdgcn_readfirstlane((unsigned)(v >> 32)); return (const float*)(((unsigned long long)hi << 32) | lo); }
#define LDS_WAIT() asm volatile("s_waitcnt lgkmcnt(0)" ::: "memory")
#define VM_WAIT() asm volatile("s_waitcnt vmcnt(0)" ::: "memory")

namespace pg8 {
constexpr int BM = 256, BK = 64, HALF = 128, HTB = HALF * BK * 2, STAGE_BYTES = 8 * HTB, NXCD = 8;
__host__ __device__ __forceinline__ int lds_byte(int r, int c) { const int st = (r >> 4) * 2 + (c >> 5), rr = r & 15, cc = c & 31, ob = rr * 64 + cc * 2; return st * 1024 + (ob ^ (((ob >> 9) & 1) << 5)); }
__host__ __device__ __forceinline__ void stage_rc(int b, int& R, int& C) { const int st = b / 1024, sb = b % 1024, swz = sb ^ (((sb >> 9) & 1) << 5); R = (st >> 1) * 16 + swz / 64; C = (st & 1) * 32 + (swz % 64) / 2; }
__host__ __device__ __forceinline__ int perm32(int rho) { const int n = rho >> 4, i = rho & 15; return 8 * (i >> 2) + 4 * n + (i & 3); }

struct Unit { int pm, pn; };
struct Gemm { const bf16_t* A; const bf16_t* Bt; int M, N, K, lda; };

struct StaticOrder {
    int nM, nN, nwg, G, c, WGM;
    __host__ __device__ void init(int M_, int N_, int G_, int c_, int wgm_ = 4) { nM = M_ / BM; nN = N_ / BM; nwg = nM * nN; G = G_; c = c_; WGM = wgm_; }
    __host__ __device__ bool next(int i, Unit& u) const {
        const long L = (long)i * G + c; if (L >= nwg) return false;
        int wgid = (int)L; { const int q = nwg / NXCD, r = nwg % NXCD, xcd = wgid % NXCD, off = wgid / NXCD; wgid = (xcd < r ? xcd * (q + 1) : r * (q + 1) + (xcd - r) * q) + off; }
        const int nig = WGM * nN, gid = wgid / nig, fm = gid * WGM, gsz = (nM - fm) < WGM ? (nM - fm) : WGM;
        u.pm = fm + ((wgid % nig) % gsz); u.pn = (wgid % nig) / gsz; return true;
    }
    __device__ __forceinline__ void a_ready(const Unit&) const {}
    __device__ __forceinline__ void done(const Unit&) const {}
};

struct EpiF32 {
    static constexpr bool PERM = false, AFTER_DRAIN = false, HAS_MID = false;
    float* C; int ldc;
    __device__ __forceinline__ void operator()(const f32x4 (&acc)[2][2][4][2], const Unit& u, int wr, int wc, int fr, int fq) const {
        const int row0 = u.pm * BM + wr * 64 + fr, col0 = u.pn * BM + wc * 32 + 4 * fq;
#pragma unroll
        for (int ai = 0; ai < 2; ++ai)
#pragma unroll
            for (int m = 0; m < 4; ++m) { float* rowp = C + (size_t)(row0 + ai * HALF + m * 16) * ldc + col0;
#pragma unroll
                for (int bj = 0; bj < 2; ++bj)
#pragma unroll
                    for (int n = 0; n < 2; ++n) *(f32x4*)(rowp + bj * HALF + n * 16) = acc[ai][bj][m][n]; }
    }
};
struct EpiBf16Plain {
    static constexpr bool PERM = true, AFTER_DRAIN = false, HAS_MID = false;
    bf16_t* C; int ldc;
    __device__ __forceinline__ void operator()(const f32x4 (&acc)[2][2][4][2], const Unit& u, int wr, int wc, int fr, int fq) const {
        const int row0 = u.pm * BM + wr * 64 + fr, col0 = u.pn * BM + wc * 32 + 8 * fq;
#pragma unroll
        for (int ai = 0; ai < 2; ++ai)
#pragma unroll
            for (int m = 0; m < 4; ++m) { bf16_t* p = C + (size_t)(row0 + ai * HALF + m * 16) * ldc + col0;
#pragma unroll
                for (int bj = 0; bj < 2; ++bj) { const f32x4 v0 = acc[ai][bj][m][0], v1 = acc[ai][bj][m][1];
                    u32x4 w; w.x = cvt_pk_bf16(v0[0], v0[1]); w.y = cvt_pk_bf16(v0[2], v0[3]); w.z = cvt_pk_bf16(v1[0], v1[1]); w.w = cvt_pk_bf16(v1[2], v1[3]);
                    *(u32x4*)(p + bj * HALF) = w; } }
    }
};
__device__ __forceinline__ float silu_f(float g) { return g * __builtin_amdgcn_rcpf(1.0f + __builtin_amdgcn_exp2f(-1.4426950408889634f * g)); }
__device__ __forceinline__ float sigmoid_f(float g) { return __builtin_amdgcn_rcpf(1.0f + __builtin_amdgcn_exp2f(-1.4426950408889634f * g)); }
struct EpiSwiGLU {
    static constexpr bool PERM = true, AFTER_DRAIN = false, HAS_MID = false;
    bf16_t* H; const float* rstd;
    __device__ __forceinline__ void operator()(const f32x4 (&acc)[2][2][4][2], const Unit& u, int wr, int wc, int fr, int fq) const {
        const int row0 = u.pm * BM + wr * 64 + fr, col0 = u.pn * HALF + wc * 32 + 8 * fq;
#pragma unroll
        for (int ai = 0; ai < 2; ++ai)
#pragma unroll
            for (int m = 0; m < 4; ++m) { bf16_t* p = H + (size_t)(row0 + ai * HALF + m * 16) * FF + col0; const float rs = rstd[row0 + ai * HALF + m * 16];
                const f32x4 g0 = acc[ai][0][m][0] * rs, g1 = acc[ai][0][m][1] * rs, u0 = acc[ai][1][m][0] * rs, u1 = acc[ai][1][m][1] * rs;
                u32x4 w; w.x = cvt_pk_bf16(silu_f(g0[0]) * u0[0], silu_f(g0[1]) * u0[1]); w.y = cvt_pk_bf16(silu_f(g0[2]) * u0[2], silu_f(g0[3]) * u0[3]);
                w.z = cvt_pk_bf16(silu_f(g1[0]) * u1[0], silu_f(g1[1]) * u1[1]); w.w = cvt_pk_bf16(silu_f(g1[2]) * u1[2], silu_f(g1[3]) * u1[3]);
                *(u32x4*)p = w; }
    }
};
__device__ __forceinline__ float gate_f(float x) { return fmaxf(sigmoid_f(x), 1e-30f); }
struct EpiProj {
    static constexpr bool PERM = true, AFTER_DRAIN = false, HAS_MID = false;
    bf16_t* PROJ; bf16_t* GATES; float* LR; const float* gbias; const float* rstd;
    __device__ __forceinline__ void operator()(const f32x4 (&acc)[2][2][4][2], const Unit& u, int wr, int wc, int fr, int fq) const {
        const int row0 = u.pm * BM + wr * 64 + fr;
        if (u.pn < 18) {
            const int col0 = u.pn * BM + wc * 32 + 8 * fq;
#pragma unroll
            for (int ai = 0; ai < 2; ++ai)
#pragma unroll
                for (int m = 0; m < 4; ++m) { bf16_t* p = PROJ + (size_t)(row0 + ai * HALF + m * 16) * NPROJ + col0; const float rs = rstd[row0 + ai * HALF + m * 16];
#pragma unroll
                    for (int bj = 0; bj < 2; ++bj) { const f32x4 v0 = acc[ai][bj][m][0] * rs, v1 = acc[ai][bj][m][1] * rs;
                        u32x4 w; w.x = cvt_pk_bf16(v0[0], v0[1]); w.y = cvt_pk_bf16(v0[2], v0[3]); w.z = cvt_pk_bf16(v1[0], v1[1]); w.w = cvt_pk_bf16(v1[2], v1[3]);
                        *(u32x4*)(p + bj * HALF) = w; } }
        } else if (u.pn < 42) {
            const int col0 = (u.pn - 18) * BM + wc * 32 + 8 * fq;
#pragma unroll
            for (int bj = 0; bj < 2; ++bj) {
                const f32x4 b0 = *(const f32x4*)(gbias + col0 + bj * HALF), b1 = *(const f32x4*)(gbias + col0 + bj * HALF + 4);
#pragma unroll
                for (int ai = 0; ai < 2; ++ai)
#pragma unroll
                    for (int m = 0; m < 4; ++m) { bf16_t* p = GATES + (size_t)(row0 + ai * HALF + m * 16) * NGATE + col0 + bj * HALF; const float rs = rstd[row0 + ai * HALF + m * 16];
                        const f32x4 v0 = acc[ai][bj][m][0] * rs + b0, v1 = acc[ai][bj][m][1] * rs + b1;
                        u32x4 w; w.x = cvt_pk_bf16(gate_f(v0[0]), gate_f(v0[1])); w.y = cvt_pk_bf16(gate_f(v0[2]), gate_f(v0[3]));
                        w.z = cvt_pk_bf16(gate_f(v1[0]), gate_f(v1[1])); w.w = cvt_pk_bf16(gate_f(v1[2]), gate_f(v1[3]));
                        *(u32x4*)p = w; }
                asm volatile("" ::: "memory"); }
        } else {
            if (wc == 0) {
#pragma unroll
                for (int ai = 0; ai < 2; ++ai)
#pragma unroll
                    for (int m = 0; m < 4; ++m) { float* p = LR + (size_t)(row0 + ai * HALF + m * 16) * 32 + 8 * fq; const float rs = rstd[row0 + ai * HALF + m * 16];
                        *(f32x4*)p = acc[ai][0][m][0] * rs; *(f32x4*)(p + 4) = acc[ai][0][m][1] * rs; }
            }
        }
    }
};
struct EpiMerge3 {
    static constexpr bool PERM = true, AFTER_DRAIN = false, HAS_MID = true;
    static constexpr int MID0 = 1024 / BK, MID1 = 1536 / BK;
    const bf16_t* G; bf16_t* MG;
    __device__ __forceinline__ void mid(f32x4 (&acc)[2][2][4][2], const Unit& u, int seg, int wr, int wc, int fr, int fq) const {
        const int row0 = u.pm * BM + wr * 64 + fr, col0 = u.pn * BM + wc * 32 + 8 * fq;
        const bf16_t* Gn = G + (size_t)row0 * NGATE + seg * D + col0;
#pragma unroll
        for (int ai = 0; ai < 2; ++ai) {
            u32x4 gn[4][2], gd[4][2];
#pragma unroll
            for (int m = 0; m < 4; ++m)
#pragma unroll
                for (int bj = 0; bj < 2; ++bj) { const bf16_t* p = Gn + (size_t)(ai * HALF + m * 16) * NGATE + bj * HALF; gn[m][bj] = *(const u32x4*)p; gd[m][bj] = *(const u32x4*)(p + D); }
#pragma unroll
            for (int m = 0; m < 4; ++m)
#pragma unroll
                for (int bj = 0; bj < 2; ++bj) { const u32x4 n = gn[m][bj], d = gd[m][bj];
                    const f32x4 r0 = { bflo(n.x) * __builtin_amdgcn_rcpf(bflo(d.x)), bfhi(n.x) * __builtin_amdgcn_rcpf(bfhi(d.x)), bflo(n.y) * __builtin_amdgcn_rcpf(bflo(d.y)), bfhi(n.y) * __builtin_amdgcn_rcpf(bfhi(d.y)) };
                    const f32x4 r1 = { bflo(n.z) * __builtin_amdgcn_rcpf(bflo(d.z)), bfhi(n.z) * __builtin_amdgcn_rcpf(bfhi(d.z)), bflo(n.w) * __builtin_amdgcn_rcpf(bflo(d.w)), bfhi(n.w) * __builtin_amdgcn_rcpf(bfhi(d.w)) };
                    acc[ai][bj][m][0] = acc[ai][bj][m][0] * r0; acc[ai][bj][m][1] = acc[ai][bj][m][1] * r1; }
            asm volatile("" ::: "memory");
        }
    }
    __device__ __forceinline__ void operator()(const f32x4 (&acc)[2][2][4][2], const Unit& u, int wr, int wc, int fr, int fq) const {
        const int row0 = u.pm * BM + wr * 64 + fr, col0 = u.pn * BM + wc * 32 + 8 * fq;
        const bf16_t* Gc = G + (size_t)row0 * NGATE + 2 * D + col0;
#pragma unroll
        for (int ai = 0; ai < 2; ++ai) {
            u32x4 gc[4][2];
#pragma unroll
            for (int m = 0; m < 4; ++m)
#pragma unroll
                for (int bj = 0; bj < 2; ++bj) gc[m][bj] = *(const u32x4*)(Gc + (size_t)(ai * HALF + m * 16) * NGATE + bj * HALF);
#pragma unroll
            for (int m = 0; m < 4; ++m)
#pragma unroll
                for (int bj = 0; bj < 2; ++bj) { const u32x4 g = gc[m][bj]; const f32x4 v0 = acc[ai][bj][m][0], v1 = acc[ai][bj][m][1];
                    u32x4 w; w.x = cvt_pk_bf16(bflo(g.x) * v0[0], bfhi(g.x) * v0[1]); w.y = cvt_pk_bf16(bflo(g.y) * v0[2], bfhi(g.y) * v0[3]);
                    w.z = cvt_pk_bf16(bflo(g.z) * v1[0], bfhi(g.z) * v1[1]); w.w = cvt_pk_bf16(bflo(g.w) * v1[2], bfhi(g.w) * v1[3]);
                    *(u32x4*)(MG + (size_t)(row0 + ai * HALF + m * 16) * D + col0 + bj * HALF) = w; }
            asm volatile("" ::: "memory");
        }
    }
};

template <class Epi, class Sched, bool ALIGN_EPI = false, bool SP2 = false>
__device__ __forceinline__ void gemm_phase(LAS unsigned char* lds, const Gemm g, const Sched& S, const Epi& E) {
    const int tid = opaque_tid(), wid = __builtin_amdgcn_readfirstlane(tid >> 6), lane = tid & 63, wr = wid >> 2, wc = wid & 3, fr = lane & 15, fq = lane >> 4;
    const int K = g.K, nt = K / BK, lda = g.lda;
    unsigned voffA[2], voffB[2];
#pragma unroll
    for (int i = 0; i < 2; ++i) { int R, C; stage_rc(tid * 16 + i * 8192, R, C); const int Rb = Epi::PERM ? ((R & ~31) + perm32(R & 31)) : R;
        voffA[i] = (unsigned)(R * lda + C) * 2u; voffB[i] = (unsigned)(Rb * K + C) * 2u; }
    const unsigned kstep = (unsigned)(BK * 2);
    const unsigned hstepA = (unsigned)HALF * (unsigned)lda * 2u, hstepB = (unsigned)HALF * (unsigned)K * 2u;
    const unsigned tstepA = 2u * hstepA, tstepB = 2u * hstepB;
    const unsigned ldsw = (unsigned)wid * 1024u;
    const int aoff = lds_byte(wr * 64 + fr, fq * 8), boff = lds_byte(wc * 32 + fr, fq * 8);
    const char* const baseA = (const char*)g.A; const char* const baseB = (const char*)g.Bt;
#define PG8_SA(b, h) (((b) * 2 + (h)) * HTB)
#define PG8_SB(b, h) ((4 + (b) * 2 + (h)) * HTB)
#define PG8_STAGE(bufoff, gbase, goff, voff) do { _Pragma("unroll") for (int _i = 0; _i < 2; ++_i) \
        __builtin_amdgcn_global_load_lds((const unsigned*)((gbase) + (size_t)(unsigned)((goff) + (voff)[_i])), (LAS unsigned*)(lds + (bufoff) + ldsw + _i * 8192), 16, 0, 0); } while (0)
#define PG8_LDA(dst, b, h) do { _Pragma("unroll") for (int m = 0; m < 4; ++m) _Pragma("unroll") for (int k = 0; k < 2; ++k) dst[m][k] = *(const LAS bf16x8*)(lds + PG8_SA(b, h) + aoff + m * 2048 + k * 1024); } while (0)
#define PG8_LDB(dst, b, h) do { _Pragma("unroll") for (int n = 0; n < 2; ++n) _Pragma("unroll") for (int k = 0; k < 2; ++k) dst[n][k] = *(const LAS bf16x8*)(lds + PG8_SB(b, h) + boff + n * 2048 + k * 1024); } while (0)
#define PG8_MMA(ai, bj, At, Bt) do { __builtin_amdgcn_s_setprio(1); _Pragma("unroll") for (int m = 0; m < 4; ++m) _Pragma("unroll") for (int n = 0; n < 2; ++n) _Pragma("unroll") for (int k = 0; k < 2; ++k) \
        acc[ai][bj][m][n] = __builtin_amdgcn_mfma_f32_16x16x32_bf16(Bt[n][k], At[m][k], acc[ai][bj][m][n], 0, 0, 0); __builtin_amdgcn_s_setprio(0); } while (0)
#define PG8_WAIT_V(n) asm volatile("s_waitcnt vmcnt(" #n ")" ::: "memory")
#define PG8_WAIT_L(n) asm volatile("s_waitcnt lgkmcnt(" #n ")" ::: "memory")
#define PG8_BAR __builtin_amdgcn_s_barrier()
#define PG8_SCHED __builtin_amdgcn_sched_barrier(0)
    Unit cur, nxt; int ui = 0;
    if (!S.next(0, cur)) return;
    f32x4 acc[2][2][4][2];
#pragma unroll
    for (int a = 0; a < 2; ++a)
#pragma unroll
        for (int b = 0; b < 2; ++b)
#pragma unroll
            for (int m = 0; m < 4; ++m)
#pragma unroll
                for (int n = 0; n < 2; ++n) acc[a][b][m][n] = (f32x4){0.f, 0.f, 0.f, 0.f};
    bf16x8 At[4][2], B0[2][2], B1[2][2];
    unsigned cA = (unsigned)cur.pm * tstepA, cB = (unsigned)cur.pn * tstepB;
    S.a_ready(cur);
    if constexpr (SP2) {
        PG8_STAGE(PG8_SB(0, 0), baseB, cB, voffB); PG8_STAGE(PG8_SB(0, 1), baseB, cB + hstepB, voffB); PG8_STAGE(PG8_SA(0, 0), baseA, cA, voffA); PG8_STAGE(PG8_SA(0, 1), baseA, cA + hstepA, voffA);
        if (wr == 1) PG8_BAR;
        PG8_WAIT_V(2); PG8_BAR;
        PG8_STAGE(PG8_SB(1, 0), baseB, cB + kstep, voffB); PG8_STAGE(PG8_SA(1, 0), baseA, cA + kstep, voffA); PG8_STAGE(PG8_SB(1, 1), baseB, cB + hstepB + kstep, voffB);
        PG8_WAIT_V(6); PG8_BAR;
    } else {
        PG8_STAGE(PG8_SB(0, 0), baseB, cB, voffB); PG8_STAGE(PG8_SA(0, 0), baseA, cA, voffA); PG8_STAGE(PG8_SB(0, 1), baseB, cB + hstepB, voffB); PG8_STAGE(PG8_SA(0, 1), baseA, cA + hstepA, voffA);
        if (wr == 1) PG8_BAR;
        PG8_WAIT_V(4); PG8_BAR;
        PG8_STAGE(PG8_SB(1, 0), baseB, cB + kstep, voffB); PG8_STAGE(PG8_SA(1, 0), baseA, cA + kstep, voffA); PG8_STAGE(PG8_SB(1, 1), baseB, cB + hstepB + kstep, voffB);
        PG8_WAIT_V(6); PG8_BAR;
    }
    for (;;) {
        const bool has_next = S.next(ui + 1, nxt);
        const unsigned nA = has_next ? (unsigned)nxt.pm * tstepA : cA, nB = has_next ? (unsigned)nxt.pn * tstepB : cB;
        for (int t = 0; t < nt; t += 2) {
            const bool last = (t == nt - 2);
            if constexpr (Epi::HAS_MID) { if (t == Epi::MID0 || t == Epi::MID1) E.mid(acc, cur, t == Epi::MID0 ? 0 : 1, wr, wc, fr, fq); }
            const unsigned a1 = cA + (unsigned)(t + 1) * kstep;
            const unsigned a2 = last ? nA : cA + (unsigned)(t + 2) * kstep, b2 = last ? nB : cB + (unsigned)(t + 2) * kstep;
            const unsigned a3 = a2 + kstep, b3 = b2 + kstep;
            if (last && has_next) S.a_ready(nxt);
            if constexpr (SP2) {
            PG8_LDB(B0, 0, 0); PG8_LDB(B1, 0, 1); PG8_SCHED; PG8_LDA(At, 0, 0); PG8_STAGE(PG8_SA(1, 1), baseA, a1 + hstepA, voffA);
            PG8_WAIT_V(8); PG8_WAIT_L(0); PG8_BAR; PG8_MMA(0, 0, At, B0); PG8_MMA(0, 1, At, B1); PG8_BAR; PG8_SCHED;
            PG8_LDA(At, 0, 1); PG8_STAGE(PG8_SB(0, 0), baseB, b2, voffB); PG8_STAGE(PG8_SB(0, 1), baseB, b2 + hstepB, voffB); PG8_STAGE(PG8_SA(0, 0), baseA, a2, voffA);
            PG8_WAIT_V(8); PG8_WAIT_L(0); PG8_BAR; PG8_MMA(1, 0, At, B0); PG8_MMA(1, 1, At, B1); PG8_BAR; PG8_SCHED;
            PG8_LDB(B0, 1, 0); PG8_LDB(B1, 1, 1); PG8_SCHED; PG8_LDA(At, 1, 0); PG8_STAGE(PG8_SA(0, 1), baseA, a2 + hstepA, voffA);
            PG8_WAIT_V(8); PG8_WAIT_L(0); PG8_BAR; PG8_MMA(0, 0, At, B0); PG8_MMA(0, 1, At, B1); PG8_BAR; PG8_SCHED;
            PG8_LDA(At, 1, 1); PG8_STAGE(PG8_SB(1, 0), baseB, b3, voffB); PG8_STAGE(PG8_SB(1, 1), baseB, b3 + hstepB, voffB); PG8_STAGE(PG8_SA(1, 0), baseA, a3, voffA);
            PG8_WAIT_V(8); PG8_WAIT_L(0); PG8_BAR; PG8_MMA(1, 0, At, B0); PG8_MMA(1, 1, At, B1); PG8_BAR; PG8_SCHED;
            } else {
            PG8_LDB(B0, 0, 0); PG8_SCHED; PG8_LDA(At, 0, 0); PG8_STAGE(PG8_SA(1, 1), baseA, a1 + hstepA, voffA);
            PG8_WAIT_L(8); PG8_BAR; PG8_WAIT_L(0); PG8_MMA(0, 0, At, B0); PG8_BAR; PG8_SCHED;
            PG8_LDB(B1, 0, 1); PG8_STAGE(PG8_SB(0, 0), baseB, b2, voffB);
            PG8_BAR; PG8_WAIT_L(0); PG8_MMA(0, 1, At, B1); PG8_BAR;
            PG8_LDA(At, 0, 1); PG8_STAGE(PG8_SA(0, 0), baseA, a2, voffA);
            PG8_BAR; PG8_WAIT_L(0); PG8_MMA(1, 0, At, B0); PG8_BAR; PG8_SCHED;
            PG8_STAGE(PG8_SB(0, 1), baseB, b2 + hstepB, voffB);
            PG8_WAIT_V(6); PG8_BAR; PG8_MMA(1, 1, At, B1); PG8_BAR;
            PG8_LDB(B0, 1, 0); PG8_SCHED; PG8_LDA(At, 1, 0); PG8_STAGE(PG8_SA(0, 1), baseA, a2 + hstepA, voffA);
            PG8_WAIT_L(8); PG8_BAR; PG8_WAIT_L(0); PG8_MMA(0, 0, At, B0); PG8_BAR; PG8_SCHED;
            PG8_LDB(B1, 1, 1); PG8_STAGE(PG8_SB(1, 0), baseB, b3, voffB);
            PG8_BAR; PG8_WAIT_L(0); PG8_MMA(0, 1, At, B1); PG8_BAR;
            PG8_LDA(At, 1, 1); PG8_STAGE(PG8_SA(1, 0), baseA, a3, voffA);
            PG8_BAR; PG8_WAIT_L(0); PG8_MMA(1, 0, At, B0); PG8_BAR; PG8_SCHED;
            PG8_STAGE(PG8_SB(1, 1), baseB, b3 + hstepB, voffB);
            PG8_WAIT_V(6); PG8_BAR; PG8_MMA(1, 1, At, B1); PG8_BAR;
            }
        }
        if constexpr (ALIGN_EPI) { if (wr == 0) PG8_BAR; }
        if constexpr (!Epi::AFTER_DRAIN) { E(acc, cur, wr, wc, fr, fq); S.done(cur); }
        if (!has_next) break;
#pragma unroll
        for (int a = 0; a < 2; ++a)
#pragma unroll
            for (int b = 0; b < 2; ++b)
#pragma unroll
                for (int m = 0; m < 4; ++m)
#pragma unroll
                    for (int n = 0; n < 2; ++n) acc[a][b][m][n] = (f32x4){0.f, 0.f, 0.f, 0.f};
        cur = nxt; cA = nA; cB = nB; ++ui;
        if constexpr (ALIGN_EPI) { if (wr == 1) PG8_BAR; }
    }
    PG8_WAIT_V(0);
    if constexpr (!ALIGN_EPI) { if (wr == 0) PG8_BAR; }
    PG8_BAR;
#undef PG8_SA
#undef PG8_SB
#undef PG8_STAGE
#undef PG8_LDA
#undef PG8_LDB
#undef PG8_MMA
#undef PG8_WAIT_V
#undef PG8_WAIT_L
#undef PG8_BAR
#undef PG8_SCHED
}
}

namespace att {
constexpr int DH = 128, NW = 8, QBLK = 32, KVBLK = 64;
constexpr float SCALE = 0.088388347648318440f;
constexpr float THR = 8.f;
constexpr int LD = NPROJ, LDO = 2048;
constexpr size_t SHM_V = KVBLK * DH * 2, SHM_K = KVBLK * DH * 2, SHM_ATTN = 2 * SHM_V + 2 * SHM_K + NW * 64 * 4;
#define KSWZ(row, colB) ((row) * 256 + ((colB) ^ (((row) & 7) << 4)))
#define SBAR() __builtin_amdgcn_sched_barrier(0)
__device__ __forceinline__ int crow(int r, int hi) { return (r & 3) + 8 * (r >> 2) + 4 * hi; }
__device__ __forceinline__ void partialSM(f32x16& p0, f32x16& p1, float& m_reg, float& mn, float& alpha) {
  constexpr float C = SCALE * 1.4426950408889634f;
  float pmax = p0[0];
#pragma unroll
  for (int r = 1; r < 16; ++r) pmax = fmaxf(pmax, p0[r]);
#pragma unroll
  for (int r = 0; r < 16; ++r) pmax = fmaxf(pmax, p1[r]);
  { auto rr = __builtin_amdgcn_permlane32_swap(__float_as_uint(pmax), __float_as_uint(pmax), false, false);
    pmax = fmaxf(__uint_as_float(rr[0]), __uint_as_float(rr[1])); }
  if (__builtin_expect(__all(pmax - m_reg <= THR / SCALE), 1)) { mn = m_reg; alpha = 1.f; }
  else { mn = fmaxf(m_reg, pmax); alpha = __builtin_amdgcn_exp2f((m_reg - mn) * C); m_reg = mn; }
  float mnC = -mn * C;
#pragma unroll
  for (int r = 0; r < 16; ++r) p0[r] = fmaf(p0[r], C, mnC);
#pragma unroll
  for (int r = 0; r < 16; ++r) p1[r] = fmaf(p1[r], C, mnC);
#pragma unroll
  for (int r = 0; r < 16; ++r) p0[r] = __builtin_amdgcn_exp2f(p0[r]);
}
__device__ __forceinline__ void finishSM(f32x16& p0, f32x16& p1, float alpha, float& l_reg, bf16x8& pa0, bf16x8& pa1, bf16x8& pa2, bf16x8& pa3) {
#pragma unroll
  for (int r = 0; r < 16; ++r) p1[r] = __builtin_amdgcn_exp2f(p1[r]);
  float ps = 0;
#pragma unroll
  for (int r = 0; r < 16; ++r) ps += p0[r];
#pragma unroll
  for (int r = 0; r < 16; ++r) ps += p1[r];
  { auto rr = __builtin_amdgcn_permlane32_swap(__float_as_uint(ps), __float_as_uint(ps), false, false);
    ps = __uint_as_float(rr[0]) + __uint_as_float(rr[1]); }
  l_reg = l_reg * alpha + ps;
#define PK4(P, BASE, OUT) do { unsigned a0 = cvt_pk_bf16(P[BASE + 0], P[BASE + 1]), a1 = cvt_pk_bf16(P[BASE + 2], P[BASE + 3]);   \
    unsigned b0 = cvt_pk_bf16(P[BASE + 4], P[BASE + 5]), b1 = cvt_pk_bf16(P[BASE + 6], P[BASE + 7]);                              \
    auto r0 = __builtin_amdgcn_permlane32_swap(a0, b0, false, false); auto r1 = __builtin_amdgcn_permlane32_swap(a1, b1, false, false); \
    u32x4 w = {r0[0], r1[0], r0[1], r1[1]}; OUT = *reinterpret_cast<bf16x8*>(&w); } while (0)
  PK4(p0, 0, pa0); PK4(p0, 8, pa1); PK4(p1, 0, pa2); PK4(p1, 8, pa3);
#undef PK4
}
__device__ __forceinline__ void qkt(f32x16& p0, f32x16& p1, const bf16_t* Ks, const bf16x8* qr, int r32, int hi) {
  p0 = f32x16{}; p1 = f32x16{};
#pragma unroll
  for (int d0 = 0; d0 < 8; ++d0) { int cb = (d0 * 16 + hi * 8) * 2;
    bf16x8 b0 = *reinterpret_cast<const bf16x8*>((const char*)Ks + KSWZ(r32, cb));
    bf16x8 b1 = *reinterpret_cast<const bf16x8*>((const char*)Ks + KSWZ(32 + r32, cb));
    p0 = __builtin_amdgcn_mfma_f32_32x32x16_bf16(b0, qr[d0], p0, 0, 0, 0);
    p1 = __builtin_amdgcn_mfma_f32_32x32x16_bf16(b1, qr[d0], p1, 0, 0, 0); }
}
__device__ __forceinline__ int v_st(int k, int c) { const int kk = (k & ~0xC) | ((k & 4) << 1) | ((k & 8) >> 1); return ((kk >> 3) * 4 + (c >> 5)) * 512 + ((kk & 7) * 32 + (c & 31)) * 2; }
__device__ __forceinline__ int v_rd_base(int lane) { return ((lane & 3) << 3) | (((lane >> 2) & 3) << 6) | (((lane >> 4) & 1) << 5) | (((lane >> 5) & 1) << 8); }
constexpr int v_rd_off(int d0, int ks, int half) { return d0 * 512 + ks * 4096 + half * 2048; }
template <int OFF> __device__ __forceinline__ s16x4 tr_read(int vb) {
  s16x4 r; asm volatile("ds_read_b64_tr_b16 %0, %1 offset:%2" : "=&v"(r) : "v"(vb), "i"(OFF) : "memory"); return r;
}
template <int D0> __device__ __forceinline__ void pv_one(f32x16& od, int vb, bf16x8 pa0, bf16x8 pa1, bf16x8 pa2, bf16x8 pa3) {
  const s16x4 l0 = tr_read<v_rd_off(D0, 0, 0)>(vb), h0 = tr_read<v_rd_off(D0, 0, 1)>(vb), l1 = tr_read<v_rd_off(D0, 1, 0)>(vb), h1 = tr_read<v_rd_off(D0, 1, 1)>(vb);
  const s16x4 l2 = tr_read<v_rd_off(D0, 2, 0)>(vb), h2 = tr_read<v_rd_off(D0, 2, 1)>(vb), l3 = tr_read<v_rd_off(D0, 3, 0)>(vb), h3 = tr_read<v_rd_off(D0, 3, 1)>(vb);
  asm volatile("s_waitcnt lgkmcnt(0)" ::: "memory"); SBAR();
#define PK(L, H) (bf16x8){L[0], L[1], L[2], L[3], H[0], H[1], H[2], H[3]}
  od = __builtin_amdgcn_mfma_f32_32x32x16_bf16(pa0, PK(l0, h0), od, 0, 0, 0);
  od = __builtin_amdgcn_mfma_f32_32x32x16_bf16(pa1, PK(l1, h1), od, 0, 0, 0);
  od = __builtin_amdgcn_mfma_f32_32x32x16_bf16(pa2, PK(l2, h2), od, 0, 0, 0);
  od = __builtin_amdgcn_mfma_f32_32x32x16_bf16(pa3, PK(l3, h3), od, 0, 0, 0);
#undef PK
}
__device__ __forceinline__ void pv_d0(f32x16* o, int vb, bf16x8 pa0, bf16x8 pa1, bf16x8 pa2, bf16x8 pa3) {
  pv_one<0>(o[0], vb, pa0, pa1, pa2, pa3); pv_one<1>(o[1], vb, pa0, pa1, pa2, pa3); pv_one<2>(o[2], vb, pa0, pa1, pa2, pa3); pv_one<3>(o[3], vb, pa0, pa1, pa2, pa3);
}
__device__ __forceinline__ void attn_dense_body(const bf16_t* Qb, const bf16_t* __restrict__ Kh, const bf16_t* __restrict__ Vh, bf16_t* Ob, int seq, char* lds) {
  const int tid = opaque_tid(), wid = tid >> 6, lane = tid & 63, r32 = lane & 31, hi = lane >> 5;
  bf16_t* V_lds = (bf16_t*)lds; bf16_t* K_lds = (bf16_t*)(lds + 2 * SHM_V);
  float* ws = (float*)(lds + 2 * SHM_V + 2 * SHM_K) + wid * 64; float* li_l = ws; float* al_l = ws + 32;
  float m_reg = -1e30f, l_reg = 0; f32x16 o[4] = {}; bf16x8 qr[8];
  const bf16_t* Qw = Qb + (long)(wid * QBLK + r32) * LD + hi * 8;
#pragma unroll
  for (int d0 = 0; d0 < 8; ++d0) qr[d0] = *reinterpret_cast<const bf16x8*>(Qw + d0 * 16);
  const int sr = tid >> 4, sc = (tid & 15) * 8, vst0 = v_st(sr, sc), vst1 = v_st(32 + sr, sc);
  const int vb0 = (int)(uintptr_t)V_lds + v_rd_base(lane);
  struct { bf16x8 vs0, vs1, ks0, ks1; } sr_[1];
#define SLOAD(i, k0) do { sr_[i].vs0 = *reinterpret_cast<const bf16x8*>(&Vh[(long)((k0) + sr) * LD + sc]); sr_[i].vs1 = *reinterpret_cast<const bf16x8*>(&Vh[(long)((k0) + 32 + sr) * LD + sc]); \
    sr_[i].ks0 = *reinterpret_cast<const bf16x8*>(&Kh[(long)((k0) + sr) * LD + sc]); sr_[i].ks1 = *reinterpret_cast<const bf16x8*>(&Kh[(long)((k0) + 32 + sr) * LD + sc]); } while (0)
#define SWRITE(b, i) do { *(bf16x8*)((char*)V_lds + (b) * SHM_V + vst0) = sr_[i].vs0;          \
    *(bf16x8*)((char*)V_lds + (b) * SHM_V + vst1) = sr_[i].vs1; int kc = sc * 2;               \
    *(bf16x8*)((char*)K_lds + (b) * SHM_K + KSWZ(sr, kc)) = sr_[i].ks0;                       \
    *(bf16x8*)((char*)K_lds + (b) * SHM_K + KSWZ(32 + sr, kc)) = sr_[i].ks1; } while (0)
#define SWAIT() asm volatile("s_waitcnt vmcnt(0)" ::: "memory")
#define RESC(a) do { if (__any((a) < 1.f)) { if (hi == 0) al_l[r32] = (a); asm volatile("s_waitcnt lgkmcnt(0)" ::: "memory"); \
    _Pragma("unroll") for (int d = 0; d < 4; ++d) _Pragma("unroll") for (int r = 0; r < 16; ++r) o[d][r] *= al_l[crow(r, hi)]; } } while (0)
  f32x16 pA0, pA1, pB0, pB1; float mnA, mnB, alA, alB; bf16x8 pa0, pa1, pa2, pa3; const int NT = seq / KVBLK;
  constexpr int SE = 0, SO = 0;
  SLOAD(SE, 0); asm volatile("s_waitcnt vmcnt(0)" ::: "memory"); SWRITE(0, SE); __syncthreads();
  qkt(pA0, pA1, K_lds, qr, r32, hi); partialSM(pA0, pA1, m_reg, mnA, alA);
  SLOAD(SO, KVBLK);
  SWAIT(); SWRITE(1, SO); __syncthreads();
  for (int j = 1; j + 1 < NT; j += 2) {
    SBAR(); qkt(pB0, pB1, (bf16_t*)((char*)K_lds + SHM_K), qr, r32, hi);
    finishSM(pA0, pA1, alA, l_reg, pa0, pa1, pa2, pa3); SBAR();
    SLOAD(SO, (j + 1) * KVBLK); SBAR();
    pv_d0(o, vb0, pa0, pa1, pa2, pa3); partialSM(pB0, pB1, m_reg, mnB, alB);
    __syncthreads(); SWAIT(); SWRITE(0, SE);
    RESC(alB); __syncthreads();
    SBAR(); qkt(pA0, pA1, K_lds, qr, r32, hi);
    finishSM(pB0, pB1, alB, l_reg, pa0, pa1, pa2, pa3); SBAR();
    SLOAD(SE, (j + 2) * KVBLK); SBAR();
    pv_d0(o, vb0 + (int)SHM_V, pa0, pa1, pa2, pa3); partialSM(pA0, pA1, m_reg, mnA, alA);
    __syncthreads(); SWAIT(); SWRITE(1, SO);
    RESC(alA); __syncthreads();
  }
  SBAR(); qkt(pB0, pB1, (bf16_t*)((char*)K_lds + SHM_K), qr, r32, hi);
  finishSM(pA0, pA1, alA, l_reg, pa0, pa1, pa2, pa3); SBAR();
  pv_d0(o, vb0, pa0, pa1, pa2, pa3); partialSM(pB0, pB1, m_reg, mnB, alB);
  __syncthreads(); RESC(alB);
  finishSM(pB0, pB1, alB, l_reg, pa0, pa1, pa2, pa3); SBAR();
  pv_d0(o, vb0 + (int)SHM_V, pa0, pa1, pa2, pa3);
  if (hi == 0) li_l[r32] = l_reg; asm volatile("s_waitcnt lgkmcnt(0)" ::: "memory");
  float rli[16];
#pragma unroll
  for (int r = 0; r < 16; ++r) rli[r] = __builtin_amdgcn_rcpf(li_l[crow(r, hi)]);
  bf16_t* Ow = Ob + (long)(wid * QBLK) * LDO;
#pragma unroll
  for (int r = 0; r < 16; ++r) { int orow = crow(r, hi);
#pragma unroll
    for (int d0 = 0; d0 < 4; ++d0) Ow[(long)orow * LDO + d0 * 32 + r32] = f2bf(o[d0][r] * rli[r]); }
  __syncthreads();
#undef SLOAD
#undef SWRITE
#undef SWAIT
#undef RESC
}
}

constexpr int RING_BYTES = 131072;
constexpr int LDSCTL_OFF = RING_BYTES, MISC_OFF = LDSCTL_OFF + 320, PTAB_OFF = LDSCTL_OFF + 1024;
constexpr int LDS_BYTES = 147456;

#define XB_TMO      128
#define XB_XCNT(j)  (256  + 64 * (j))
#define XB_XSUB(j)  (1280 + 64 * (j))
#define XB_XGEN(j)  (2304 + 64 * (j))
#define XB_TOP      3328
#define XB_TOPGEN   3392
#define XCD_BAR_WORDS 3456
#define XB_SPIN_CAP (1u << 22)
__device__ __forceinline__ unsigned xb_ld(unsigned* p)              { return __hip_atomic_load(p, __ATOMIC_RELAXED, __HIP_MEMORY_SCOPE_AGENT); }
__device__ __forceinline__ unsigned xb_add(unsigned* p, unsigned v) { return __hip_atomic_fetch_add(p, v, __ATOMIC_RELAXED, __HIP_MEMORY_SCOPE_AGENT); }
__device__ __forceinline__ unsigned xb_xcc_id() { return (unsigned)__builtin_amdgcn_s_getreg((3 << 11) | 20) & 0xFu; }
#define XB_SPIN(cond, bar) do { unsigned _sp = 0; while (cond) { __builtin_amdgcn_s_sleep(1); \
    if ((++_sp & 255u) == 0u) { if (xb_ld(&(bar)[XB_TMO])) break; if (_sp > XB_SPIN_CAP) { atomicAdd(&(bar)[XB_TMO], 1u); break; } } } } while (0)
struct XcdBarrier { unsigned* bar; unsigned x; volatile LAS unsigned* st; };
__device__ __forceinline__ XcdBarrier xcd_barrier_post(unsigned* bar, volatile LAS unsigned* st) {
    XcdBarrier b; b.bar = bar; b.x = xb_xcc_id(); b.st = st;
    if (threadIdx.x == 0) (void)xb_add(&bar[XB_XCNT(b.x)], 1u);
    return b;
}
__device__ __forceinline__ void xcd_barrier_complete(unsigned* bar, unsigned x, unsigned& nloc, unsigned& nx) {
    const unsigned G = gridDim.x * gridDim.y * gridDim.z;
    unsigned sum, cnt, mine, sp = 0u;
    for (;;) {
        sum = 0u; cnt = 0u;
        for (unsigned j = 0; j < 16; ++j) { const unsigned c = xb_ld(&bar[XB_XCNT(j)]); sum += c; cnt += (c > 0u) ? 1u : 0u; }
        mine = xb_ld(&bar[XB_XCNT(x)]);
        if (sum == G) break;
        __builtin_amdgcn_s_sleep(1);
        if ((++sp & 255u) == 0u) { if (xb_ld(&bar[XB_TMO])) break; if (sp > XB_SPIN_CAP) { atomicAdd(&bar[XB_TMO], 1u); break; } }
    }
    nloc = mine > 0u ? mine : 1u; nx = cnt > 0u ? cnt : 1u;
}
__device__ __forceinline__ XcdBarrier xcd_barrier_setup(unsigned* bar, volatile LAS unsigned* st) {
    XcdBarrier b = xcd_barrier_post(bar, st);
    if (threadIdx.x == 0) { unsigned nloc, nx; xcd_barrier_complete(bar, b.x, nloc, nx); st[0] = nloc; st[1] = nx; }
    __syncthreads();
    return b;
}
__device__ __forceinline__ void xcd_barrier(const XcdBarrier& b) {
    asm volatile("s_waitcnt vmcnt(0)" ::: "memory");
    __syncthreads();
    if (threadIdx.x == 0) {
        unsigned* bar = b.bar; unsigned bx = b.x;
        asm volatile("" : "+s"(bar), "+s"(bx));
        __builtin_amdgcn_s_waitcnt(0);
        const unsigned nloc = b.st[0], nx = b.st[1];
        const unsigned old = xb_add(&bar[XB_XSUB(bx)], 1u);
        const unsigned gen = old / nloc;
        if (old + 1u == (gen + 1u) * nloc) {
            __builtin_amdgcn_fence(__ATOMIC_RELEASE, "agent");
            asm volatile("s_waitcnt vmcnt(0)" ::: "memory");
            const unsigned og = xb_add(&bar[XB_TOP], 1u);
            const unsigned tg = og / nx;
            if (og + 1u == (tg + 1u) * nx) xb_add(&bar[XB_TOPGEN], 1u);
            else XB_SPIN(xb_ld(&bar[XB_TOPGEN]) == tg, bar);
            __builtin_amdgcn_fence(__ATOMIC_ACQUIRE, "agent");
            xb_add(&bar[XB_XGEN(bx)], 1u);
            asm volatile("s_waitcnt vmcnt(0)" ::: "memory");
        } else {
            XB_SPIN(xb_ld(&bar[XB_XGEN(bx)]) == gen, bar);
            __builtin_amdgcn_fence(__ATOMIC_ACQUIRE, "agent");
            asm volatile("s_waitcnt vmcnt(0)" ::: "memory");
        }
    }
    __syncthreads();
}

__device__ __forceinline__ void transpose_item(const float* W, int ldw, int K, int k0, int srccol0, bf16_t* WT, int dstrow0, LAS float* scr, int lane, const float* kgain = nullptr, int ldt = 0) {
    const int KT = ldt ? ldt : K;
    constexpr int P = 36;
    const int n4 = (lane & 7) * 4, kr = lane >> 3;
    f32x4 v[8];
    if (srccol0 >= 0) {
#pragma unroll
        for (int i = 0; i < 8; ++i) v[i] = *(const f32x4*)(W + (size_t)(k0 + 8 * i + kr) * ldw + srccol0 + n4);
        if (kgain) {
#pragma unroll
            for (int i = 0; i < 8; ++i) v[i] = v[i] * kgain[k0 + 8 * i + kr];
        }
    } else {
#pragma unroll
        for (int i = 0; i < 8; ++i) v[i] = (f32x4){0.f, 0.f, 0.f, 0.f};
    }
#pragma unroll
    for (int i = 0; i < 8; ++i) *(LAS f32x4*)(scr + (8 * i + kr) * P + n4) = v[i];
    LDS_WAIT(); asm volatile("" ::: "memory");
    const int c = lane & 7;
#pragma unroll
    for (int j = 0; j < 4; ++j) { const int n = (lane >> 3) + 8 * j; const LAS float* s = scr + (8 * c) * P + n;
        u32x4 o; o.x = cvt_pk_bf16(s[0 * P], s[1 * P]); o.y = cvt_pk_bf16(s[2 * P], s[3 * P]); o.z = cvt_pk_bf16(s[4 * P], s[5 * P]); o.w = cvt_pk_bf16(s[6 * P], s[7 * P]);
        *(u32x4*)(WT + (size_t)(dstrow0 + n) * KT + k0 + 8 * c) = o; }
    LDS_WAIT(); asm volatile("" ::: "memory");
}
struct LayerW { const float *w_in, *w_bra, *w_brb, *w_brc, *w_out, *f1i, *f1o, *f2i, *f2o, *ng; };
__device__ __forceinline__ void phase_weights(const LayerW& w, unsigned char* ws, LAS unsigned char* lds, int gw, int NGW, int wave, int lane) {
    LAS float* scr = (LAS float*)(lds + wave * 16384);
    constexpr int I_IN = (NIN_PAD / 32) * (D / 64);
    constexpr int I_FI = (2 * FF / 32) * (D / 64);
    constexpr int I_FO = (D / 32) * (FF / 64);
    constexpr int I_BA = (D / 32) * (1024 / 64);
    constexpr int I_BB = (D / 32) * (512 / 64);
    constexpr int I_WO = (D / 32) * (D / 64);
    constexpr int NITEMS = I_IN + 2 * I_FI + 2 * I_FO + I_BA + 2 * I_BB + I_WO;
    for (int it = gw; it < NITEMS; it += NGW) {
        int r = it;
        if (r < I_IN) { const int nb = r % (NIN_PAD / 32), kb = r / (NIN_PAD / 32); const int d0 = nb * 32;
            const int src = d0 < 4608 ? d0 : (d0 < 10752 ? d0 + 32 : (d0 < 10784 ? 4608 + (d0 - 10752) : -1));
            transpose_item(w.w_in, NIN, D, kb * 64, src, (bf16_t*)(ws + WS_WIN), d0, scr, lane, w.ng + 2 * D); continue; } r -= I_IN;
        if (r < 2 * I_FI) { const int which = r / I_FI; r -= which * I_FI; const int nb = r % (2 * FF / 32), kb = r / (2 * FF / 32); const int d0 = nb * 32;
            const int t = d0 >> 8, within = d0 & 255; const int src = within < 128 ? 128 * t + within : FF + 128 * t + (within - 128);
            transpose_item(which ? w.f2i : w.f1i, 2 * FF, D, kb * 64, src, (bf16_t*)(ws + (which ? WS_WF2I : WS_WF1I)), d0, scr, lane, w.ng + (which ? 4 * D : 0)); continue; } r -= 2 * I_FI;
        if (r < 2 * I_FO) { const int which = r / I_FO; r -= which * I_FO; const int nb = r % (D / 32), kb = r / (D / 32);
            transpose_item(which ? w.f2o : w.f1o, D, FF, kb * 64, nb * 32, (bf16_t*)(ws + (which ? WS_WF2O : WS_WF1O)), nb * 32, scr, lane); continue; } r -= 2 * I_FO;
        if (r < I_BA) { const int nb = r % (D / 32), kb = r / (D / 32);
            transpose_item(w.w_bra, D, 1024, kb * 64, nb * 32, (bf16_t*)(ws + WS_WBRA), nb * 32, scr, lane, nullptr, LDOM); continue; } r -= I_BA;
        if (r < 2 * I_BB) { const int which = r / I_BB; r -= which * I_BB; const int nb = r % (D / 32), kb = r / (D / 32);
            transpose_item(which ? w.w_brc : w.w_brb, D, 512, kb * 64, nb * 32, (bf16_t*)(ws + WS_WBRA) + (which ? OM_C : OM_B), nb * 32, scr, lane, nullptr, LDOM); continue; } r -= 2 * I_BB;
        { const int nb = r % (D / 32), kb = r / (D / 32);
            transpose_item(w.w_out, D, D, kb * 64, nb * 32, (bf16_t*)(ws + WS_WOUT), nb * 32, scr, lane); }
    }
}
__device__ __forceinline__ void phase_norm(bf16_t* XB, const bf16_t* Y, float* RSTD, float* OUT, const float* gpost, float coef, int gw, int NGW, int lane) {
    for (int m = gw; m < M; m += NGW) {
        const u32x2* xr = (const u32x2*)(XB + (size_t)m * D) + lane; const u32x2* yr = (const u32x2*)(Y + (size_t)m * D) + lane;
        f32x4 x[8], y[8]; float s = 0.f;
#pragma unroll
        for (int j = 0; j < 8; ++j) { const u32x2 t = yr[64 * j], q = xr[64 * j]; y[j] = (f32x4){bflo(t.x), bfhi(t.x), bflo(t.y), bfhi(t.y)}; x[j] = (f32x4){bflo(q.x), bfhi(q.x), bflo(q.y), bfhi(q.y)};
            s += (y[j].x * y[j].x + y[j].y * y[j].y) + (y[j].z * y[j].z + y[j].w * y[j].w); }
        const float rstd = coef * (1.0f / sqrtf(wave_sum(s) * (1.0f / D) + EPS));
        float s2 = 0.f;
#pragma unroll
        for (int j = 0; j < 8; ++j) { const f32x4 g = ((const f32x4*)gpost)[lane + 64 * j]; x[j] = x[j] + y[j] * g * rstd; s2 += (x[j].x * x[j].x + x[j].y * x[j].y) + (x[j].z * x[j].z + x[j].w * x[j].w); }
        if (OUT) { f32x4* xo = (f32x4*)(OUT + (size_t)m * D) + lane;
#pragma unroll
            for (int j = 0; j < 8; ++j) xo[64 * j] = x[j];
        } else {
            u32x2* o8 = (u32x2*)(XB + (size_t)m * D) + lane;
#pragma unroll
            for (int j = 0; j < 8; ++j) { u32x2 w; w.x = cvt_pk_bf16(x[j].x, x[j].y); w.y = cvt_pk_bf16(x[j].z, x[j].w); o8[64 * j] = w; }
            const float r2 = 1.0f / sqrtf(wave_sum(s2) * (1.0f / D) + EPS);
            if (lane == 0) RSTD[m] = r2;
        }
    }
}
__device__ __forceinline__ void phase_prep(bf16_t* PROJ, const float* qk_gain  , LAS unsigned char* lds, int gw, int NGW, int tid, int lane) {
    LAS f32x2* cs = (LAS f32x2*)lds;
    for (int i = tid; i < 2048; i += 512) { const int pos = i >> 5, mi = i & 31; const float inv = powf(10000.0f, -(float)mi / 32.0f); float s, c; sincosf((float)pos * inv, &s, &c); cs[i] = (f32x2){c, s}; }
    __syncthreads();
    const float gq0 = qk_gain[2 * lane], gq1 = qk_gain[2 * lane + 1], gk0 = qk_gain[128 + 2 * lane], gk1 = qk_gain[128 + 2 * lane + 1];
    for (int m = gw; m < M; m += NGW) {
        const int t = m & (SEQ - 1), pr = t >> 6, pc = t & 63;
        const f32x2 c_s = cs[((lane < 32) ? pr : pc) * 32 + (lane & 31)];
        unsigned* row = (unsigned*)(PROJ + (size_t)m * NPROJ);
        unsigned v[10];
#pragma unroll
        for (int h = 0; h < 10; ++h) v[h] = row[h * 64 + lane];
#pragma unroll
        for (int h = 0; h < 10; ++h) {
            const float x1 = bflo(v[h]), x2 = bfhi(v[h]);
            const float rstd = 1.0f / sqrtf(wave_sum(x1 * x1 + x2 * x2) * (1.0f / 128.0f) + EPS);
            const float n1 = x1 * rstd * (h < 8 ? gq0 : gk0), n2 = x2 * rstd * (h < 8 ? gq1 : gk1);
            row[h * 64 + lane] = cvt_pk_bf16(n1 * c_s.x - n2 * c_s.y, n1 * c_s.y + n2 * c_s.x);
        }
    }
    __syncthreads();
}
__device__ __forceinline__ void tr_pair(unsigned base, int pitch, int row0, int col0, int lane, s16x4& lo, s16x4& hi) {
    const int g = lane >> 4, i = lane & 15;
    const unsigned addr = base + (unsigned)((row0 + 4 * g + (i >> 2)) * pitch + (col0 + 4 * (i & 3)) * 2);
    asm volatile("ds_read_b64_tr_b16 %0, %1" : "=&v"(lo) : "v"(addr) : "memory");
    asm volatile("ds_read_b64_tr_b16 %0, %1" : "=&v"(hi) : "v"(addr + (unsigned)(16 * pitch)) : "memory");
}
#define TR_JOIN(L, H) ((bf16x8){L[0], L[1], L[2], L[3], H[0], H[1], H[2], H[3]})
__device__ __forceinline__ bf16x8 pack8(const float* x) { u32x4 w; w.x = cvt_pk_bf16(x[0], x[1]); w.y = cvt_pk_bf16(x[2], x[3]); w.z = cvt_pk_bf16(x[4], x[5]); w.w = cvt_pk_bf16(x[6], x[7]); return *reinterpret_cast<bf16x8*>(&w); }
__device__ __forceinline__ void na_unit(const bf16_t* PROJ, bf16_t* OB  , LAS unsigned char* lds, int u) {
    const int tid = opaque_tid(), lane = tid & 63, w = __builtin_amdgcn_readfirstlane(tid >> 6);
    constexpr int PV = 272, O_V = 0, O_RPB = 2 * 64 * PV;
    LAS float* rpbs = (LAS float*)(lds + O_RPB);
    const unsigned lbase = (unsigned)(uintptr_t)lds;
    const int ib = w & 3, vh = w >> 2;
    {
        int lane_o = lane; asm volatile("" : "+v"(lane_o));
        const int g = lane_o >> 4, li = lane_o & 15;
        const int r = u & 31, h = (u >> 5) & 3, b = u >> 7;
        const int rs = min(max(r - 4, 0), 24);
        const int c = 16 * ib + li, cs0 = min(max(c - 8, 0), 48);
        const size_t tq = (size_t)b * SEQ + r * 64 + c;
        bf16x8 qf[4];
#pragma unroll
        for (int ks = 0; ks < 4; ++ks) qf[ks] = *(const bf16x8*)(PROJ + tq * NPROJ + C_BQ + h * 128 + 32 * ks + 8 * g);
        int jbv[4], dcv[4];
#pragma unroll
        for (int rr = 0; rr < 4; ++rr) { const int km = 4 * g + rr; jbv[rr] = (cs0 + 15 - km) >> 4; dcv[rr] = 16 * jbv[rr] + km - c + 15; }
        f32x4 o[4];
#pragma unroll
        for (int vt = 0; vt < 4; ++vt) o[vt] = (f32x4){0.f, 0.f, 0.f, 0.f};
        float m_run = -1e30f, l_run = 0.f;
        const int sr = tid >> 4, sc = (tid & 15) * 8;
        const int jlo = ib > 1 ? ib - 1 : 0, jhi = ib < 2 ? ib + 1 : 3;
        bf16x8 kf[4][4], vr0, vr1;
#define NA_LOADK(kr_) do { const size_t kt_ = (size_t)b * SEQ + (size_t)(rs + (kr_)) * 64; \
            _Pragma("unroll") for (int jb = 0; jb < 4; ++jb) if (jb >= jlo && jb <= jhi) { const bf16_t* kp = PROJ + (kt_ + 16 * jb + li) * NPROJ + C_BK + h * 128 + 8 * g; \
                _Pragma("unroll") for (int ks = 0; ks < 4; ++ks) kf[jb][ks] = *(const bf16x8*)(kp + 32 * ks); } } while (0)
#define NA_LOADV(kr_) do { const size_t kt_ = (size_t)b * SEQ + (size_t)(rs + (kr_)) * 64; \
            vr0 = *(const bf16x8*)(PROJ + (kt_ + sr) * NPROJ + C_BV + h * 128 + sc); vr1 = *(const bf16x8*)(PROJ + (kt_ + sr + 32) * NPROJ + C_BV + h * 128 + sc); } while (0)
        NA_LOADV(0); NA_LOADK(0);
        for (int kr = 0; kr < 8; ++kr) {
            *(LAS bf16x8*)(lds + O_V + (kr & 1) * 64 * PV + sr * PV + sc * 2) = vr0; *(LAS bf16x8*)(lds + O_V + (kr & 1) * 64 * PV + (sr + 32) * PV + sc * 2) = vr1;
            if (kr + 1 < 8) NA_LOADV(kr + 1);
            f32x4 s[4];
#pragma unroll
            for (int jb = 0; jb < 4; ++jb) { s[jb] = (f32x4){0.f, 0.f, 0.f, 0.f};
                if (jb >= jlo && jb <= jhi) {
#pragma unroll
                    for (int ks = 0; ks < 4; ++ks) s[jb] = __builtin_amdgcn_mfma_f32_16x16x32_bf16(kf[jb][ks], qf[ks], s[jb], 0, 0, 0); } }
            if (kr + 1 < 8) NA_LOADK(kr + 1);
            const int dr = rs + kr - r + 7;
            float mx = -1e30f;
#pragma unroll
            for (int rr = 0; rr < 4; ++rr) { const float bias = rpbs[(h * 15 + dr) * 31 + dcv[rr]];
#pragma unroll
                for (int jb = 0; jb < 4; ++jb) { const float v = (jb == jbv[rr]) ? s[jb][rr] * 0.088388347648318440f + bias : -1e30f; s[jb][rr] = v; mx = fmaxf(mx, v); } }
            mx = fmaxf(mx, __shfl_xor(mx, 16)); mx = fmaxf(mx, __shfl_xor(mx, 32));
            const float m_new = fmaxf(m_run, mx), alpha = __expf(m_run - m_new);
            m_run = m_new;
            float ps = 0.f;
#pragma unroll
            for (int jb = 0; jb < 4; ++jb)
#pragma unroll
                for (int rr = 0; rr < 4; ++rr) { const float p = (jb == jbv[rr]) ? __expf(s[jb][rr] - m_new) : 0.f; s[jb][rr] = p; ps += p; }
            l_run = l_run * alpha + ps;
            bf16x8 pfr[2];
#pragma unroll
            for (int ss = 0; ss < 2; ++ss) { const float t[8] = {s[2 * ss][0], s[2 * ss][1], s[2 * ss][2], s[2 * ss][3], s[2 * ss + 1][0], s[2 * ss + 1][1], s[2 * ss + 1][2], s[2 * ss + 1][3]}; pfr[ss] = pack8(t); }
            __syncthreads();
            s16x4 vl[4][2], vhh[4][2];
            {
                const unsigned vbase = lbase + O_V + (unsigned)((kr & 1) * 64 * PV + (4 * g + (li >> 2)) * PV + (64 * vh + 4 * (li & 3)) * 2);
                asm volatile("ds_read_b64_tr_b16 %0, %16 offset:0\n\t"
                         "ds_read_b64_tr_b16 %1, %16 offset:4352\n\t"
                         "ds_read_b64_tr_b16 %2, %16 offset:8704\n\t"
                         "ds_read_b64_tr_b16 %3, %16 offset:13056\n\t"
                         "ds_read_b64_tr_b16 %4, %16 offset:32\n\t"
                         "ds_read_b64_tr_b16 %5, %16 offset:4384\n\t"
                         "ds_read_b64_tr_b16 %6, %16 offset:8736\n\t"
                         "ds_read_b64_tr_b16 %7, %16 offset:13088\n\t"
                         "ds_read_b64_tr_b16 %8, %16 offset:64\n\t"
                         "ds_read_b64_tr_b16 %9, %16 offset:4416\n\t"
                         "ds_read_b64_tr_b16 %10, %16 offset:8768\n\t"
                         "ds_read_b64_tr_b16 %11, %16 offset:13120\n\t"
                         "ds_read_b64_tr_b16 %12, %16 offset:96\n\t"
                         "ds_read_b64_tr_b16 %13, %16 offset:4448\n\t"
                         "ds_read_b64_tr_b16 %14, %16 offset:8800\n\t"
                         "ds_read_b64_tr_b16 %15, %16 offset:13152\n\t"
                         "s_waitcnt lgkmcnt(0)"
                         : "=&v"(vl[0][0]), "=&v"(vhh[0][0]), "=&v"(vl[0][1]), "=&v"(vhh[0][1]), "=&v"(vl[1][0]), "=&v"(vhh[1][0]), "=&v"(vl[1][1]), "=&v"(vhh[1][1]), "=&v"(vl[2][0]), "=&v"(vhh[2][0]), "=&v"(vl[2][1]), "=&v"(vhh[2][1]), "=&v"(vl[3][0]), "=&v"(vhh[3][0]), "=&v"(vl[3][1]), "=&v"(vhh[3][1])
                         : "v"(vbase) : "memory");
            }
            __builtin_amdgcn_sched_barrier(0);
#pragma unroll
            for (int vt = 0; vt < 4; ++vt) { o[vt] = o[vt] * alpha;
#pragma unroll
                for (int ss = 0; ss < 2; ++ss) o[vt] = __builtin_amdgcn_mfma_f32_16x16x32_bf16(TR_JOIN(vl[vt][ss], vhh[vt][ss]), pfr[ss], o[vt], 0, 0, 0); }
        }
#undef NA_LOADK
#undef NA_LOADV
        l_run += __shfl_xor(l_run, 16); l_run += __shfl_xor(l_run, 32);
        const float inv = 1.0f / l_run;
#pragma unroll
        for (int vt = 0; vt < 4; ++vt) { u32x2 ov; ov.x = cvt_pk_bf16(o[vt].x * inv, o[vt].y * inv); ov.y = cvt_pk_bf16(o[vt].z * inv, o[vt].w * inv);
            *(u32x2*)(OB + tq * LDOM + h * 128 + 64 * vh + 16 * vt + 4 * g) = ov; }
        __syncthreads();
    }
}
__device__ __forceinline__ void na_load_bias(const float* rpb, LAS unsigned char* lds) {
    const int tid = opaque_tid(); LAS float* rpbs = (LAS float*)(lds + 2 * 64 * 272);
    __syncthreads();
    for (int i = tid; i < 4 * 15 * 31; i += 512) rpbs[i] = rpb[i];
    __syncthreads();
}
__device__ __forceinline__ float logsig16(float z) { return (fminf(z, 0.f) - __logf(1.0f + __expf(-fabsf(z)))) * (1.0f / 16.0f); }
__device__ __forceinline__ void gla_seq_unit(const bf16_t* PROJ, const float* LR, const float* w_decay  , const float* b_decay  , bf16_t* OFB, bf16_t* OC, const float* onorm,
                                             LAS unsigned char* lds, int b, int h) {
    const int tid = opaque_tid(), lane = tid & 63, w = __builtin_amdgcn_readfirstlane(tid >> 6);
    constexpr int P64 = 144, PV = 272;
    constexpr int O_Q = 0, O_K = 9216, O_KH = 18432, O_V = 27648, O_S = 45056, O_DEC = 63488, O_W2 = 63744;
    const unsigned lbase = (unsigned)(uintptr_t)lds;
    const int ib = w & 3, vh = w >> 2, g = lane >> 4, li = lane & 15;
    LAS float* w2s = (LAS float*)(lds + O_W2);
    LAS float* gns = (LAS float*)(lds + 68608);
    __syncthreads(); if (tid < 128) gns[tid] = onorm[tid];
    LAS float* red = (LAS float*)(lds + 68096);
  for (int dir = 0; dir < 2; ++dir) {
    __syncthreads();
    for (int i = tid; i < 16 * 64; i += 512) w2s[i] = w_decay[dir * 4096 + (i >> 6) * 256 + h * 64 + (i & 63)];
    if (tid < 64) w2s[1024 + tid] = b_decay[dir * 256 + h * 64 + tid];
    for (int i = tid; i < 128 * 72 / 2; i += 512) ((LAS unsigned*)(lds + O_S))[i] = 0u;
    f32x4 S[4];
#pragma unroll
    for (int vt = 0; vt < 4; ++vt) S[vt] = (f32x4){0.f, 0.f, 0.f, 0.f};
    const int dcol = 8 * w;
    const int sr = tid >> 4, sc = (tid & 15) * 8;
    f32x4 lr4[4]; u32x4 qraw, kraw; bf16x8 vst0, vst1;
    u32x2 ofr[4], ogr[4];
#define GLA_LOAD_O(cc_) do { const int c_ = 31 - (cc_); const size_t mi_ = (size_t)b * SEQ + c_ * 64 + 16 * ib + li; \
        _Pragma("unroll") for (int vt = 0; vt < 4; ++vt) { ofr[vt] = *(const u32x2*)(OFB + mi_ * 512 + h * 128 + 64 * vh + 16 * vt + 4 * g); ogr[vt] = *(const u32x2*)(PROJ + mi_ * NPROJ + C_OG + h * 128 + 64 * vh + 16 * vt + 4 * g); } } while (0)
#define GLA_LOAD(cc_) do { const int c_ = dir ? 31 - (cc_) : (cc_); const size_t m0_ = (size_t)b * SEQ + c_ * 64, m_ = m0_ + lane; \
        _Pragma("unroll") for (int j = 0; j < 4; ++j) lr4[j] = ((const f32x4*)(LR + m_ * 32 + dir * 16))[j]; \
        qraw = *(const u32x4*)(PROJ + m_ * NPROJ + C_CQ + h * 64 + dcol); kraw = *(const u32x4*)(PROJ + m_ * NPROJ + C_CK + h * 64 + dcol); \
        vst0 = *(const bf16x8*)(PROJ + (m0_ + sr) * NPROJ + C_CV + h * 128 + sc); vst1 = *(const bf16x8*)(PROJ + (m0_ + sr + 32) * NPROJ + C_CV + h * 128 + sc); } while (0)
#pragma unroll
    for (int vt = 0; vt < 4; ++vt) { ofr[vt] = (u32x2){0u, 0u}; ogr[vt] = (u32x2){0u, 0u}; }
    GLA_LOAD(0);
    if (dir) GLA_LOAD_O(0);
    __syncthreads();
    for (int cc = 0; cc < 32; ++cc) {
        const int c = dir ? 31 - cc : cc; const size_t m0 = (size_t)b * SEQ + c * 64;
        {
            f32x4 z0 = *(const LAS f32x4*)(w2s + 1024 + dcol), z1 = *(const LAS f32x4*)(w2s + 1024 + dcol + 4);
#pragma unroll
            for (int j = 0; j < 4; ++j)
#pragma unroll
                for (int rr = 0; rr < 4; ++rr) { const int r = 4 * j + rr; z0 = z0 + *(const LAS f32x4*)(w2s + r * 64 + dcol) * lr4[j][rr]; z1 = z1 + *(const LAS f32x4*)(w2s + r * 64 + dcol + 4) * lr4[j][rr]; }
            float bs[8];
#pragma unroll
            for (int e = 0; e < 4; ++e) { bs[e] = logsig16(z0[e]); bs[4 + e] = logsig16(z1[e]); }
            if (dir == 0) {
#pragma unroll
                for (int off = 1; off < 64; off <<= 1)
#pragma unroll
                    for (int e = 0; e < 8; ++e) { const float t = __shfl_up(bs[e], off); if (lane >= off) bs[e] += t; }
            } else {
#pragma unroll
                for (int off = 1; off < 64; off <<= 1)
#pragma unroll
                    for (int e = 0; e < 8; ++e) { const float t = __shfl_down(bs[e], off); if (lane + off < 64) bs[e] += t; }
            }
            const float q[8] = {bflo(qraw.x), bfhi(qraw.x), bflo(qraw.y), bfhi(qraw.y), bflo(qraw.z), bfhi(qraw.z), bflo(qraw.w), bfhi(qraw.w)};
            const float k[8] = {bflo(kraw.x), bfhi(kraw.x), bflo(kraw.y), bfhi(kraw.y), bflo(kraw.z), bfhi(kraw.z), bflo(kraw.w), bfhi(kraw.w)};
            float qt[8], kt[8], kh[8], dc[8];
#pragma unroll
            for (int e = 0; e < 8; ++e) { const float be = __shfl(bs[e], dir ? 0 : 63);
                qt[e] = q[e] * 0.125f * __expf(bs[e]); kt[e] = k[e] * __expf(-bs[e]); kh[e] = k[e] * __expf(be - bs[e]); dc[e] = __expf(be); }
            *(LAS bf16x8*)(lds + O_Q + lane * P64 + 16 * w) = pack8(qt); *(LAS bf16x8*)(lds + O_K + lane * P64 + 16 * w) = pack8(kt); *(LAS bf16x8*)(lds + O_KH + lane * P64 + 16 * w) = pack8(kh);
            if (lane == 0) { *(LAS f32x4*)(lds + O_DEC + 4 * dcol) = (f32x4){dc[0], dc[1], dc[2], dc[3]}; *(LAS f32x4*)(lds + O_DEC + 4 * dcol + 16) = (f32x4){dc[4], dc[5], dc[6], dc[7]}; }
            *(LAS bf16x8*)(lds + O_V + sr * PV + sc * 2) = vst0; *(LAS bf16x8*)(lds + O_V + (sr + 32) * PV + sc * 2) = vst1;
        }
        __syncthreads();
        if (cc + 1 < 32) GLA_LOAD(cc + 1);
        const size_t mi = m0 + 16 * ib + li; f32x4 oo[4]; float ss = 0.f;
        {
            bf16x8 qF[2];
#pragma unroll
            for (int ks = 0; ks < 2; ++ks) qF[ks] = *(const LAS bf16x8*)(lds + O_Q + (16 * ib + li) * P64 + (32 * ks + 8 * g) * 2);
            f32x4 P[4];
#pragma unroll
            for (int jb = 0; jb < 4; ++jb) {
                f32x4 a = {0.f, 0.f, 0.f, 0.f};
                const bool need = dir ? (jb >= ib) : (jb <= ib);
                if (need) {
#pragma unroll
                    for (int ks = 0; ks < 2; ++ks) a = __builtin_amdgcn_mfma_f32_16x16x32_bf16(*(const LAS bf16x8*)(lds + O_K + (16 * jb + li) * P64 + (32 * ks + 8 * g) * 2), qF[ks], a, 0, 0, 0); }
#pragma unroll
                for (int r = 0; r < 4; ++r) { const int jl = 4 * g + r;
                    const bool keep = (jb == ib) ? (dir ? (jl >= li) : (jl <= li)) : need;
                    P[jb][r] = keep ? a[r] : 0.f; }
            }
            bf16x8 pfr[2];
#pragma unroll
            for (int s = 0; s < 2; ++s) { const float t[8] = {P[2 * s][0], P[2 * s][1], P[2 * s][2], P[2 * s][3], P[2 * s + 1][0], P[2 * s + 1][1], P[2 * s + 1][2], P[2 * s + 1][3]}; pfr[s] = pack8(t); }
            s16x4 vl[4][2], vhh[4][2], kl[2], kh2[2];
            {
                const unsigned vbase = lbase + O_V + (unsigned)((4 * g + (li >> 2)) * PV + (64 * vh + 4 * (li & 3)) * 2);
                const unsigned kbase = lbase + O_KH + (unsigned)((4 * g + (li >> 2)) * P64 + (16 * ib + 4 * (li & 3)) * 2);
                asm volatile("ds_read_b64_tr_b16 %0, %20 offset:0\n\t"
                         "ds_read_b64_tr_b16 %1, %20 offset:4352\n\t"
                         "ds_read_b64_tr_b16 %2, %20 offset:8704\n\t"
                         "ds_read_b64_tr_b16 %3, %20 offset:13056\n\t"
                         "ds_read_b64_tr_b16 %4, %20 offset:32\n\t"
                         "ds_read_b64_tr_b16 %5, %20 offset:4384\n\t"
                         "ds_read_b64_tr_b16 %6, %20 offset:8736\n\t"
                         "ds_read_b64_tr_b16 %7, %20 offset:13088\n\t"
                         "ds_read_b64_tr_b16 %8, %20 offset:64\n\t"
                         "ds_read_b64_tr_b16 %9, %20 offset:4416\n\t"
                         "ds_read_b64_tr_b16 %10, %20 offset:8768\n\t"
                         "ds_read_b64_tr_b16 %11, %20 offset:13120\n\t"
                         "ds_read_b64_tr_b16 %12, %20 offset:96\n\t"
                         "ds_read_b64_tr_b16 %13, %20 offset:4448\n\t"
                         "ds_read_b64_tr_b16 %14, %20 offset:8800\n\t"
                         "ds_read_b64_tr_b16 %15, %20 offset:13152\n\t"
                         "ds_read_b64_tr_b16 %16, %21 offset:0\n\t"
                         "ds_read_b64_tr_b16 %17, %21 offset:2304\n\t"
                         "ds_read_b64_tr_b16 %18, %21 offset:4608\n\t"
                         "ds_read_b64_tr_b16 %19, %21 offset:6912\n\t"
                         "s_waitcnt lgkmcnt(0)"
                         : "=&v"(vl[0][0]), "=&v"(vhh[0][0]), "=&v"(vl[0][1]), "=&v"(vhh[0][1]), "=&v"(vl[1][0]), "=&v"(vhh[1][0]), "=&v"(vl[1][1]), "=&v"(vhh[1][1]), "=&v"(vl[2][0]), "=&v"(vhh[2][0]), "=&v"(vl[2][1]), "=&v"(vhh[2][1]), "=&v"(vl[3][0]), "=&v"(vhh[3][0]), "=&v"(vl[3][1]), "=&v"(vhh[3][1]), "=&v"(kl[0]), "=&v"(kh2[0]), "=&v"(kl[1]), "=&v"(kh2[1])
                         : "v"(vbase), "v"(kbase) : "memory");
            }
            bf16x8 sfr[4][2];
#pragma unroll
            for (int vt = 0; vt < 4; ++vt)
#pragma unroll
                for (int ks = 0; ks < 2; ++ks) sfr[vt][ks] = *(const LAS bf16x8*)(lds + O_S + (64 * vh + 16 * vt + li) * P64 + (32 * ks + 8 * g) * 2);
            const float dec = *(const LAS float*)(lds + O_DEC + 4 * (16 * ib + li));
            __builtin_amdgcn_sched_barrier(0);
#pragma unroll
            for (int vt = 0; vt < 4; ++vt) {
                const int v0 = 64 * vh + 16 * vt;
                f32x4 o = {0.f, 0.f, 0.f, 0.f};
#pragma unroll
                for (int s = 0; s < 2; ++s) o = __builtin_amdgcn_mfma_f32_16x16x32_bf16(TR_JOIN(vl[vt][s], vhh[vt][s]), pfr[s], o, 0, 0, 0);
#pragma unroll
                for (int ks = 0; ks < 2; ++ks) o = __builtin_amdgcn_mfma_f32_16x16x32_bf16(sfr[vt][ks], qF[ks], o, 0, 0, 0);
                if (dir == 0) { u32x2 ov; ov.x = (unsigned)f2bf(o.x) | ((unsigned)f2bf(o.y) << 16); ov.y = (unsigned)f2bf(o.z) | ((unsigned)f2bf(o.w) << 16);
                    *(u32x2*)(OFB + mi * 512 + h * 128 + v0 + 4 * g) = ov; }
                else { const u32x2 f = ofr[vt];
                    o.x += bflo(f.x); o.y += bfhi(f.x); o.z += bflo(f.y); o.w += bfhi(f.y); oo[vt] = o; ss += (o.x * o.x + o.y * o.y) + (o.z * o.z + o.w * o.w); }
                f32x4 sn = S[vt] * dec;
#pragma unroll
                for (int s = 0; s < 2; ++s) sn = __builtin_amdgcn_mfma_f32_16x16x32_bf16(TR_JOIN(vl[vt][s], vhh[vt][s]), TR_JOIN(kl[s], kh2[s]), sn, 0, 0, 0);
                S[vt] = sn;
            }
        }
        if (dir) { ss += __shfl_xor(ss, 16); ss += __shfl_xor(ss, 32); if (g == 0) red[vh * 64 + 16 * ib + li] = ss; }
        __syncthreads();
        if (dir) {
            const float rstd = 1.0f / sqrtf((red[16 * ib + li] + red[64 + 16 * ib + li]) * (1.0f / 128.0f) + EPS);
#pragma unroll
            for (int vt = 0; vt < 4; ++vt) { const int v0 = 64 * vh + 16 * vt;
                const u32x2 og = ogr[vt]; const f32x4 gn = *(const LAS f32x4*)(gns + v0 + 4 * g);
                u32x2 ov; ov.x = cvt_pk_bf16(oo[vt].x * rstd * gn.x * pg8::silu_f(bflo(og.x)), oo[vt].y * rstd * gn.y * pg8::silu_f(bfhi(og.x)));
                ov.y = cvt_pk_bf16(oo[vt].z * rstd * gn.z * pg8::silu_f(bflo(og.y)), oo[vt].w * rstd * gn.w * pg8::silu_f(bfhi(og.y)));
                *(u32x2*)(OC + mi * LDOM + h * 128 + v0 + 4 * g) = ov; }
            if (cc + 1 < 32) GLA_LOAD_O(cc + 1);
        }
#pragma unroll
        for (int vt = 0; vt < 4; ++vt)
#pragma unroll
            for (int r = 0; r < 4; ++r) *(LAS bf16_t*)(lds + O_S + (64 * vh + 16 * vt + 4 * g + r) * P64 + (16 * ib + li) * 2) = f2bf(S[vt][r]);
    }
    __syncthreads();
  }
#undef GLA_LOAD
#undef GLA_LOAD_O
}
constexpr int NPH = 15;
enum { P_F1A = 0, P_F1B, P_N1, P_M1, P_PREP, P_ATT, P_NA, P_GLA, P_GLC, P_M4, P_M5, P_N2, P_F2A, P_F2B, P_N3 };
constexpr int NGP = 1 + DEPTH * NPH;
struct Args { const float* in[18]; float* out; unsigned char* ws; int gp_lo, gp_hi; };

typedef decltype(__builtin_amdgcn_kernarg_segment_ptr()) kargp_t;
__device__ __forceinline__ unsigned long long karg_q(int byte_off) { kargp_t p_ = __builtin_amdgcn_kernarg_segment_ptr(); asm volatile("" : "+s"(p_));
    return *(const unsigned long long __attribute__((address_space(4)))*)((const char __attribute__((address_space(4)))*)p_ + byte_off); }
__global__ void __launch_bounds__(512, 2) fwd(Args args) {
    extern __shared__ __attribute__((aligned(16))) unsigned char lds_raw[];
    LAS unsigned char* const lds0 = (LAS unsigned char*)lds_raw;
    const int G0 = gridDim.x, wg0 = blockIdx.x;
#define PENV LAS unsigned char* lds = lds0; int G = G0, wg = wg0; asm volatile("" : "+s"(lds), "+s"(G), "+s"(wg)); const int NGW = G * 8; (void)NGW; (void)lds; (void)wg
    volatile LAS unsigned* MISC = (volatile LAS unsigned*)(lds0 + MISC_OFF);
    volatile LAS unsigned long long* PT = (volatile LAS unsigned long long*)(lds0 + PTAB_OFF);
    { const int t0 = threadIdx.x;
      for (int u = t0; u < (LDS_BYTES - LDSCTL_OFF) / 4; u += 512) ((LAS unsigned*)(lds0 + LDSCTL_OFF))[u] = 0u;
      __syncthreads();
      __syncthreads(); }
#if ONE_LAUNCH
    constexpr int lo = 0, hi = NGP;
#else
    const int lo = args.gp_lo, hi = args.gp_hi;
#endif
    XcdBarrier bar; bar.bar = (unsigned*)(args.ws + WS_CTL) + CW_BAR; bar.x = 0; bar.st = nullptr;
    if (hi - lo > 1) bar = xcd_barrier_setup((unsigned*)(args.ws + WS_CTL) + CW_BAR, MISC + 8);
#define SEAM(gp) do { if ((gp) + 1 < hi) xcd_barrier(bar); } while (0)
#define INP(i) ((const float*)(const GAS float*)karg_q(8 * (i)))
#define WSP() ((unsigned char*)(GAS unsigned char*)karg_q(8 * 19))
#define XP() ((float*)(GAS float*)karg_q(8 * 18))
#define TIDS() PENV; const int tid = opaque_tid(), lane = tid & 63, wave = __builtin_amdgcn_readfirstlane(tid >> 6), gw = wg * 8 + wave; (void)tid; (void)lane; (void)wave; (void)gw

    if (((PHASE_MASK >> 31) & 1u) && lo <= 0 && 0 < hi) {
        TIDS(); unsigned char* ws = WSP(); bf16_t* XB = (bf16_t*)(ws + WS_XN); float* RSTD = (float*)(ws + WS_RSTD);
        LayerW w; w.w_in = INP(3); w.w_bra = INP(10); w.w_brb = INP(11); w.w_brc = INP(12); w.w_out = INP(13); w.f1i = INP(14); w.f1o = INP(15); w.f2i = INP(16); w.f2o = INP(17); w.ng = INP(2);
        phase_weights(w, ws, lds, gw, NGW, wave, lane);
        const float* xp = INP(0); const float* xs = INP(1);
        for (int m = gw; m < M; m += NGW) {
            const float* src = m < 16 * SEQ ? xp + (size_t)m * D : xs + (size_t)(m - 16 * SEQ) * D;
            const f32x4* xr = (const f32x4*)src + lane; f32x4 x[8]; float s = 0.f;
#pragma unroll
            for (int j = 0; j < 8; ++j) { x[j] = xr[64 * j]; s += (x[j].x * x[j].x + x[j].y * x[j].y) + (x[j].z * x[j].z + x[j].w * x[j].w); }
            u32x2* o8 = (u32x2*)(XB + (size_t)m * D) + lane;
#pragma unroll
            for (int j = 0; j < 8; ++j) { u32x2 wv; wv.x = cvt_pk_bf16(x[j].x, x[j].y); wv.y = cvt_pk_bf16(x[j].z, x[j].w); o8[64 * j] = wv; }
            const float rstd = 1.0f / sqrtf(wave_sum(s) * (1.0f / D) + EPS);
            if (lane == 0) RSTD[m] = rstd;
        }
        SEAM(0);
    }
    for (int l = 0; l < DEPTH; ++l) {
        const int gp0 = 1 + l * NPH;
        if (gp0 + NPH <= lo || gp0 >= hi) continue;
#define IN(p) (((PHASE_MASK >> (p)) & 1u) && lo <= gp0 + (p) && gp0 + (p) < hi)
#define FFN_PAIR(ff, pa, pb) do { \
        if (IN(pa)) { PENV; unsigned char* ws = WSP(); pg8::Gemm g{(const bf16_t*)(ws + WS_XN), (const bf16_t*)(ws + ((ff) ? WS_WF2I : WS_WF1I)), M, 2 * FF, D, D}; pg8::StaticOrder S; S.init(M, 2 * FF, G, wg, WGM_FI); \
            pg8::EpiSwiGLU E{(bf16_t*)(ws + WS_H), (const float*)(ws + WS_RSTD)}; pg8::gemm_phase<pg8::EpiSwiGLU, pg8::StaticOrder, true, true>(lds, g, S, E); if ((DUP_MASK >> (pa)) & 1u) pg8::gemm_phase<pg8::EpiSwiGLU, pg8::StaticOrder, true, true>(lds, g, S, E); SEAM(gp0 + (pa)); } \
        if (IN(pb)) { PENV; unsigned char* ws = WSP(); pg8::Gemm g{(const bf16_t*)(ws + WS_H), (const bf16_t*)(ws + ((ff) ? WS_WF2O : WS_WF1O)), M, D, FF, FF}; pg8::StaticOrder S; S.init(M, D, G, wg, WGM_FO); \
            pg8::EpiBf16Plain E{(bf16_t*)(ws + WS_Y), D}; pg8::gemm_phase<pg8::EpiBf16Plain, pg8::StaticOrder, true, true>(lds, g, S, E); if ((DUP_MASK >> (pb)) & 1u) pg8::gemm_phase<pg8::EpiBf16Plain, pg8::StaticOrder, true, true>(lds, g, S, E); SEAM(gp0 + (pb)); } } while (0)
#define NORM_PHASE(p, ipost, coef, last) do { if (IN(p)) { TIDS(); unsigned char* ws = WSP(); const float* ng = INP(2) + (size_t)l * 6 * D; \
            phase_norm((bf16_t*)(ws + WS_XN), (const bf16_t*)(ws + WS_Y), (float*)(ws + WS_RSTD), (last) ? XP() : nullptr, ng + (ipost) * D, (coef), gw, NGW, lane);

        FFN_PAIR(0, P_F1A, P_F1B);
        NORM_PHASE(P_N1, 1, 0.5f, false) SEAM(gp0 + P_N1); } } while (0);
        if (IN(P_M1)) { PENV;
            unsigned char* ws = WSP();
            pg8::Gemm g{(const bf16_t*)(ws + WS_XN), (const bf16_t*)(ws + WS_WIN), M, NIN_PAD, D, D}; pg8::StaticOrder S; S.init(M, NIN_PAD, G, wg, WGM_M1);
            pg8::EpiProj E{(bf16_t*)(ws + WS_PROJ), (bf16_t*)(ws + WS_GATES), (float*)(ws + WS_LR), INP(4) + (size_t)l * 3 * D, (const float*)(ws + WS_RSTD)};
            pg8::gemm_phase<pg8::EpiProj, pg8::StaticOrder, true, true>(lds, g, S, E);
            if ((DUP_MASK >> P_M1) & 1u) pg8::gemm_phase<pg8::EpiProj, pg8::StaticOrder, true, true>(lds, g, S, E);
            SEAM(gp0 + P_M1);
        }
        if (IN(P_PREP)) {
            { TIDS(); unsigned char* ws = WSP(); phase_prep((bf16_t*)(ws + WS_PROJ), INP(5) + (size_t)l * 256, lds, gw, NGW, tid, lane); }
            SEAM(gp0 + P_PREP);
        }
        if (IN(P_ATT)) { PENV;
            unsigned char* ws = WSP(); bf16_t* PROJ = (bf16_t*)(ws + WS_PROJ);
            const int ngrp = (G % 8 == 0) ? 8 : 1, xg = wg % ngrp, slot = wg / ngrp, per = G / ngrp;
            for (int gu = slot; gu < 96 / ngrp; gu += per) { const int U = xg * (96 / ngrp) + gu;
                gla_seq_unit(PROJ, (const float*)(ws + WS_LR), INP(7) + (size_t)l * 2 * 16 * 256, INP(8) + (size_t)l * 512, (bf16_t*)(ws + WS_OFB), (bf16_t*)(ws + WS_OA) + OM_C, INP(9) + (size_t)l * 128, lds, U >> 2, U & 3); }
            na_load_bias(INP(6) + (size_t)l * 4 * 15 * 31, lds);
            unsigned* head = (unsigned*)(ws + WS_CTL) + CW_Q + (l * 8 + xg) * 64;
            const int n_att = 1536 / ngrp, n_na = 3072 / ngrp;
            LAS unsigned* qslot = (LAS unsigned*)(lds + MISC_OFF + 64);
            for (;;) {
                __syncthreads();
                if (threadIdx.x == 0) *qslot = __hip_atomic_fetch_add(head, 1u, __ATOMIC_RELAXED, __HIP_MEMORY_SCOPE_AGENT);
                __syncthreads();
                const int idx = __builtin_amdgcn_readfirstlane((int)*(volatile LAS unsigned*)qslot);
                if (idx >= n_att * (1 + ATT_DUP) + n_na) break;
                if (idx < n_att * (1 + ATT_DUP)) { const int idx0 = idx; const int idx = idx0 % n_att;
                    const int rnd = idx >> 5, mem = idx & 31, grp = (ngrp == 8) ? rnd * 8 + xg : rnd;
                    const int b = grp >> 1, kvh = grp & 1, h = kvh * 4 + (mem >> 3), qb = mem & 7;
                    const size_t rowq = (size_t)b * SEQ + qb * 256, rowk = (size_t)b * SEQ;
                    bf16_t* Qp = PROJ + rowq * NPROJ + C_AQ + h * 128;
                    att::attn_dense_body(Qp, PROJ + rowk * NPROJ + C_AK + kvh * 128, PROJ + rowk * NPROJ + C_AV + kvh * 128, (bf16_t*)(ws + WS_OA) + rowq * LDOM + h * 128, SEQ, (char*)lds_raw + 49152);
                } else {
                    na_unit(PROJ, (bf16_t*)(ws + WS_OA) + OM_B, lds, xg * n_na + (idx - n_att * (1 + ATT_DUP)));
                }
            }
            SEAM(gp0 + P_GLA);
        }
        if (IN(P_M4)) { PENV;
            unsigned char* ws = WSP();
            pg8::Gemm g{(const bf16_t*)(ws + WS_OA), (const bf16_t*)(ws + WS_WBRA), M, D, LDOM, LDOM}; pg8::StaticOrder S; S.init(M, D, G, wg, WGM_M45);
            pg8::EpiMerge3 E{(const bf16_t*)(ws + WS_GATES), (bf16_t*)(ws + WS_MG)};
            pg8::gemm_phase<pg8::EpiMerge3, pg8::StaticOrder, true, true>(lds, g, S, E);
            if ((DUP_MASK >> P_M4) & 1u) pg8::gemm_phase<pg8::EpiMerge3, pg8::StaticOrder, true, true>(lds, g, S, E);
            SEAM(gp0 + P_M4);
        }
        if (IN(P_M5)) { PENV;
            unsigned char* ws = WSP();
            pg8::Gemm g{(const bf16_t*)(ws + WS_MG), (const bf16_t*)(ws + WS_WOUT), M, D, D, D}; pg8::StaticOrder S; S.init(M, D, G, wg, WGM_M45);
            pg8::EpiBf16Plain E{(bf16_t*)(ws + WS_Y), D};
            pg8::gemm_phase<pg8::EpiBf16Plain, pg8::StaticOrder, true, true>(lds, g, S, E);
            if ((DUP_MASK >> P_M5) & 1u) pg8::gemm_phase<pg8::EpiBf16Plain, pg8::StaticOrder, true, true>(lds, g, S, E);
            SEAM(gp0 + P_M5);
        }
        NORM_PHASE(P_N2, 3, 1.0f, false) SEAM(gp0 + P_N2); } } while (0);
        FFN_PAIR(1, P_F2A, P_F2B);
        NORM_PHASE(P_N3, 5, 0.5f, (l + 1 == DEPTH))
            if (l + 1 < DEPTH) { LayerW w; w.w_in = INP(3) + (size_t)(l + 1) * D * NIN; w.w_bra = INP(10) + (size_t)(l + 1) * 1024 * D; w.w_brb = INP(11) + (size_t)(l + 1) * 512 * D; w.w_brc = INP(12) + (size_t)(l + 1) * 512 * D;
                w.w_out = INP(13) + (size_t)(l + 1) * D * D; w.f1i = INP(14) + (size_t)(l + 1) * D * 2 * FF; w.f1o = INP(15) + (size_t)(l + 1) * FF * D; w.f2i = INP(16) + (size_t)(l + 1) * D * 2 * FF; w.f2o = INP(17) + (size_t)(l + 1) * FF * D; w.ng = INP(2) + (size_t)(l + 1) * 6 * D;
                phase_weights(w, ws, lds, gw, NGW, wave, lane); if ((DUP_MASK >> 20) & 1u) phase_weights(w, ws, lds, gw, NGW, wave, lane); }
            SEAM(gp0 + P_N3); } } while (0);
#undef FFN_PAIR
#undef NORM_PHASE
#undef IN
    }
#undef SEAM
}

extern "C" void kernel_launch(void* const* d_in, const int* in_sizes, int n_in, void* d_out, int out_size, void* d_ws, size_t ws_size, hipStream_t stream) {
    static int grid = 0;
    if (grid == 0) {
        if (n_in != 18 || out_size != M * D || ws_size < WS_END) { fprintf(stderr, "kernel_launch: unexpected shapes: n_in %d out %d ws %zu (need %zu)\n", n_in, out_size, ws_size, (size_t)WS_END); grid = -1; return; }
        int dev = 0, cus = 0, per_cu = 0;
        if (hipGetDevice(&dev) != hipSuccess || hipDeviceGetAttribute(&cus, hipDeviceAttributeMultiprocessorCount, dev) != hipSuccess) { grid = -1; return; }
        if (hipFuncSetAttribute((const void*)fwd, hipFuncAttributeMaxDynamicSharedMemorySize, LDS_BYTES) != hipSuccess) { fprintf(stderr, "kernel_launch: hipFuncSetAttribute failed\n"); grid = -1; return; }
        if (hipOccupancyMaxActiveBlocksPerMultiprocessor(&per_cu, (const void*)fwd, 512, LDS_BYTES) != hipSuccess || per_cu < 1) fprintf(stderr, "kernel_launch: occupancy query says %d\n", per_cu);
        (void)hipGetLastError();
        grid = cus;
    }
    if (grid < 0) return;
    (void)hipMemsetAsync((char*)d_ws + WS_CTL, 0, CTL_BYTES, stream);
    Args a{};
    for (int i = 0; i < 18; ++i) a.in[i] = (const float*)d_in[i];
    a.out = (float*)d_out; a.ws = (unsigned char*)d_ws;
#if ONE_LAUNCH
    a.gp_lo = 0; a.gp_hi = NGP;
    hipLaunchKernelGGL(fwd, dim3(grid), dim3(512), LDS_BYTES, stream, a);
#else
    for (int gp = 0; gp < NGP; ++gp) { a.gp_lo = gp; a.gp_hi = gp + 1; hipLaunchKernelGGL(fwd, dim3(grid), dim3(512), LDS_BYTES, stream, a); }
#endif
    const hipError_t le = hipPeekAtLastError();
    if (le != hipSuccess) fprintf(stderr, "kernel_launch: launch failed: %s\n", hipGetErrorName(le));
}
```

```cpp
#include <hip/hip_runtime.h>
#include <cstdio>
#include <cstdint>

#ifndef ONE_LAUNCH
#define ONE_LAUNCH 1
#endif
#ifndef WGM_FI
#define WGM_FI 4
#endif
#ifndef WGM_FO
#define WGM_FO 2
#endif
#ifndef WGM_M1
#define WGM_M1 4
#endif
#ifndef WGM_M45
#define WGM_M45 4
#endif
#ifndef ATT_DUP
#define ATT_DUP 0
#endif
#ifndef DUP_MASK
#define DUP_MASK 0u
#endif
#ifndef PHASE_MASK
#define PHASE_MASK 0xFFFFFFFFu
#endif

#define GAS __attribute__((address_space(1)))
#define LAS __attribute__((address_space(3)))
typedef unsigned short bf16_t;
typedef short bf16x8 __attribute__((ext_vector_type(8)));
typedef short s16x4 __attribute__((ext_vector_type(4)));
typedef float f32x4 __attribute__((ext_vector_type(4)));
typedef float f32x2 __attribute__((ext_vector_type(2)));
typedef float f32x16 __attribute__((ext_vector_type(16)));
typedef unsigned u32x4 __attribute__((ext_vector_type(4)));
typedef unsigned u32x2 __attribute__((ext_vector_type(2)));

constexpr int M = 49152;
constexpr int SEQ = 2048, NSEQ = 24;
constexpr int D = 2048, FF = 5632, DEPTH = 4;
constexpr int NPROJ = 4608;
constexpr int NGATE = 6144;
constexpr int NIN = 10784, NIN_PAD = 11008;
constexpr int C_AQ = 0, C_AK = 1024, C_AV = 1280, C_BQ = 1536, C_BK = 2048, C_BV = 2560, C_CQ = 3072, C_CK = 3328, C_CV = 3584, C_OG = 4096;
constexpr int C_OC = 3072;
constexpr float EPS = 1e-6f;

constexpr size_t MiB = 1u << 20;
constexpr size_t WS_CTL = 0, CTL_BYTES = 1 * MiB;
constexpr size_t WS_WIN = 2 * MiB;
constexpr size_t WS_WF1I = 45 * MiB;
constexpr size_t WS_WF1O = 89 * MiB;
constexpr size_t WS_WF2I = 111 * MiB;
constexpr size_t WS_WF2O = 155 * MiB;
constexpr size_t WS_WBRA = 177 * MiB;
constexpr size_t WS_WBRB = 181 * MiB;
constexpr size_t WS_WBRC = 183 * MiB;
constexpr size_t WS_WOUT = 185 * MiB;
constexpr size_t WS_XN = 193 * MiB;
constexpr size_t WS_BIG = 385 * MiB;
constexpr size_t WS_PROJ = WS_BIG;
constexpr size_t WS_GATES = WS_BIG + 432 * MiB;
constexpr size_t WS_LR = WS_BIG + 1008 * MiB;
constexpr size_t WS_H = WS_BIG;
constexpr size_t WS_Y = WS_BIG + 528 * MiB;
constexpr size_t WS_OFB = WS_BIG + 1014 * MiB;
constexpr size_t WS_MG = WS_OFB + 48 * MiB;
constexpr size_t WS_RSTD = WS_MG + 192 * MiB;
constexpr size_t WS_OA = WS_RSTD + 1 * MiB;
constexpr int LDOM = 2048, OM_B = 1024, OM_C = 1536;
constexpr size_t WS_END = WS_OA + 192 * MiB;
constexpr int CW_Q = 32768;
static_assert(WS_Y + (size_t)M * D * 4 <= WS_LR, "Y inside GATES region");
constexpr int CW_BAR = 4096;

__device__ __forceinline__ unsigned cvt_pk_bf16(float lo, float hi) { unsigned r; asm volatile("v_cvt_pk_bf16_f32 %0, %1, %2" : "=v"(r) : "v"(lo), "v"(hi)); return r; }
__device__ __forceinline__ float bflo(unsigned w) { return __uint_as_float(w << 16); }
__device__ __forceinline__ float bfhi(unsigned w) { return __uint_as_float(w & 0xffff0000u); }
__device__ __forceinline__ float bf2f(bf16_t v) { return __uint_as_float(((unsigned)v) << 16); }
__device__ __forceinline__ bf16_t f2bf(float f) { unsigned u = __float_as_uint(f); return (bf16_t)((u + 0x7fffu + ((u >> 16) & 1u)) >> 16); }
__device__ __forceinline__ float wave_sum(float v) {
#pragma unroll
    for (int o = 1; o < 64; o <<= 1) v += __shfl_xor(v, o);
    return v;
}
__device__ __forceinline__ float wave_max(float v) {
#pragma unroll
    for (int o = 1; o < 64; o <<= 1) v = fmaxf(v, __shfl_xor(v, o));
    return v;
}
__device__ __forceinline__ int opaque_tid() { int t = threadIdx.x; asm volatile("" : "+v"(t)); return t; }
__device__ __forceinline__ unsigned char* opq(unsigned char* p) { asm volatile("" : "+s"(p)); return p; }
__device__ __forceinline__ const float* lds_ptr(volatile LAS unsigned long long* tab, int i) { const unsigned long long v = tab[i];
    const unsigned lo = __builtin_amdgcn_readfirstlane((unsigned)v), hi = __builtin_amdgcn_readfirstlane((unsigned)(v >> 32)); return (const float*)(((unsigned long long)hi << 32) | lo); }
#define LDS_WAIT() asm volatile("s_waitcnt lgkmcnt(0)" ::: "memory")
#define VM_WAIT() asm volatile("s_waitcnt vmcnt(0)" ::: "memory")

namespace pg8 {
constexpr int BM = 256, BK = 64, HALF = 128, HTB = HALF * BK * 2, STAGE_BYTES = 8 * HTB, NXCD = 8;
__host__ __device__ __forceinline__ int lds_byte(int r, int c) { const int st = (r >> 4) * 2 + (c >> 5), rr = r & 15, cc = c & 31, ob = rr * 64 + cc * 2; return st * 1024 + (ob ^ (((ob >> 9) & 1) << 5)); }
__host__ __device__ __forceinline__ void stage_rc(int b, int& R, int& C) { const int st = b / 1024, sb = b % 1024, swz = sb ^ (((sb >> 9) & 1) << 5); R = (st >> 1) * 16 + swz / 64; C = (st & 1) * 32 + (swz % 64) / 2; }
__host__ __device__ __forceinline__ int perm32(int rho) { const int n = rho >> 4, i = rho & 15; return 8 * (i >> 2) + 4 * n + (i & 3); }

struct Unit { int pm, pn; };
struct Gemm { const bf16_t* A; const bf16_t* Bt; int M, N, K, lda; };

struct StaticOrder {
    int nM, nN, nwg, G, c, WGM;
    __host__ __device__ void init(int M_, int N_, int G_, int c_, int wgm_ = 4) { nM = M_ / BM; nN = N_ / BM; nwg = nM * nN; G = G_; c = c_; WGM = wgm_; }
    __host__ __device__ bool next(int i, Unit& u) const {
        const long L = (long)i * G + c; if (L >= nwg) return false;
        int wgid = (int)L; { const int q = nwg / NXCD, r = nwg % NXCD, xcd = wgid % NXCD, off = wgid / NXCD; wgid = (xcd < r ? xcd * (q + 1) : r * (q + 1) + (xcd - r) * q) + off; }
        const int nig = WGM * nN, gid = wgid / nig, fm = gid * WGM, gsz = (nM - fm) < WGM ? (nM - fm) : WGM;
        u.pm = fm + ((wgid % nig) % gsz); u.pn = (wgid % nig) / gsz; return true;
    }
    __device__ __forceinline__ void a_ready(const Unit&) const {}
    __device__ __forceinline__ void done(const Unit&) const {}
};

struct EpiF32 {
    static constexpr bool PERM = false, AFTER_DRAIN = false, HAS_MID = false;
    float* C; int ldc;
    __device__ __forceinline__ void operator()(const f32x4 (&acc)[2][2][4][2], const Unit& u, int wr, int wc, int fr, int fq) const {
        const int row0 = u.pm * BM + wr * 64 + fr, col0 = u.pn * BM + wc * 32 + 4 * fq;
#pragma unroll
        for (int ai = 0; ai < 2; ++ai)
#pragma unroll
            for (int m = 0; m < 4; ++m) { float* rowp = C + (size_t)(row0 + ai * HALF + m * 16) * ldc + col0;
#pragma unroll
                for (int bj = 0; bj < 2; ++bj)
#pragma unroll
                    for (int n = 0; n < 2; ++n) *(f32x4*)(rowp + bj * HALF + n * 16) = acc[ai][bj][m][n]; }
    }
};
struct EpiBf16Plain {
    static constexpr bool PERM = true, AFTER_DRAIN = false, HAS_MID = false;
    bf16_t* C; int ldc;
    __device__ __forceinline__ void operator()(const f32x4 (&acc)[2][2][4][2], const Unit& u, int wr, int wc, int fr, int fq) const {
        const int row0 = u.pm * BM + wr * 64 + fr, col0 = u.pn * BM + wc * 32 + 8 * fq;
#pragma unroll
        for (int ai = 0; ai < 2; ++ai)
#pragma unroll
            for (int m = 0; m < 4; ++m) { bf16_t* p = C + (size_t)(row0 + ai * HALF + m * 16) * ldc + col0;
#pragma unroll
                for (int bj = 0; bj < 2; ++bj) { const f32x4 v0 = acc[ai][bj][m][0], v1 = acc[ai][bj][m][1];
                    u32x4 w; w.x = cvt_pk_bf16(v0[0], v0[1]); w.y = cvt_pk_bf16(v0[2], v0[3]); w.z = cvt_pk_bf16(v1[0], v1[1]); w.w = cvt_pk_bf16(v1[2], v1[3]);
                    *(u32x4*)(p + bj * HALF) = w; } }
    }
};
__device__ __forceinline__ float silu_f(float g) { return g * __builtin_amdgcn_rcpf(1.0f + __builtin_amdgcn_exp2f(-1.4426950408889634f * g)); }
__device__ __forceinline__ float sigmoid_f(float g) { return __builtin_amdgcn_rcpf(1.0f + __builtin_amdgcn_exp2f(-1.4426950408889634f * g)); }
struct EpiSwiGLU {
    static constexpr bool PERM = true, AFTER_DRAIN = false, HAS_MID = false;
    bf16_t* H; const float* rstd;
    __device__ __forceinline__ void operator()(const f32x4 (&acc)[2][2][4][2], const Unit& u, int wr, int wc, int fr, int fq) const {
        const int row0 = u.pm * BM + wr * 64 + fr, col0 = u.pn * HALF + wc * 32 + 8 * fq;
#pragma unroll
        for (int ai = 0; ai < 2; ++ai)
#pragma unroll
            for (int m = 0; m < 4; ++m) { bf16_t* p = H + (size_t)(row0 + ai * HALF + m * 16) * FF + col0; const float rs = rstd[row0 + ai * HALF + m * 16];
                const f32x4 g0 = acc[ai][0][m][0] * rs, g1 = acc[ai][0][m][1] * rs, u0 = acc[ai][1][m][0] * rs, u1 = acc[ai][1][m][1] * rs;
                u32x4 w; w.x = cvt_pk_bf16(silu_f(g0[0]) * u0[0], silu_f(g0[1]) * u0[1]); w.y = cvt_pk_bf16(silu_f(g0[2]) * u0[2], silu_f(g0[3]) * u0[3]);
                w.z = cvt_pk_bf16(silu_f(g1[0]) * u1[0], silu_f(g1[1]) * u1[1]); w.w = cvt_pk_bf16(silu_f(g1[2]) * u1[2], silu_f(g1[3]) * u1[3]);
                *(u32x4*)p = w; }
    }
};
__device__ __forceinline__ float gate_k(float x) { return fmaxf(__builtin_rintf(sigmoid_f(x) * 255.0f), 1.0f); }
__device__ __forceinline__ unsigned gate_q4(const f32x4 v) { unsigned w = __builtin_amdgcn_cvt_pk_u8_f32(gate_k(v[0]), 0u, 0u); w = __builtin_amdgcn_cvt_pk_u8_f32(gate_k(v[1]), 1u, w);
    w = __builtin_amdgcn_cvt_pk_u8_f32(gate_k(v[2]), 2u, w); return __builtin_amdgcn_cvt_pk_u8_f32(gate_k(v[3]), 3u, w); }
__device__ __forceinline__ f32x4 ub4(unsigned w) { return (f32x4){(float)(w & 0xffu), (float)((w >> 8) & 0xffu), (float)((w >> 16) & 0xffu), (float)(w >> 24)}; }
__device__ __forceinline__ f32x4 rcp4(const f32x4 v) { return (f32x4){__builtin_amdgcn_rcpf(v[0]), __builtin_amdgcn_rcpf(v[1]), __builtin_amdgcn_rcpf(v[2]), __builtin_amdgcn_rcpf(v[3])}; }
struct EpiProj {
    static constexpr bool PERM = true, AFTER_DRAIN = false, HAS_MID = false;
    bf16_t* PROJ; u32x4* GQ; float* LR; const float* gbias; const float* rstd;
    __device__ __forceinline__ void operator()(const f32x4 (&acc)[2][2][4][2], const Unit& u, int wr, int wc, int fr, int fq) const {
        const int row0 = u.pm * BM + wr * 64 + fr;
        if (u.pn < 18) {
            const int col0 = u.pn * BM + wc * 32 + 8 * fq;
#pragma unroll
            for (int ai = 0; ai < 2; ++ai)
#pragma unroll
                for (int m = 0; m < 4; ++m) { bf16_t* p = PROJ + (size_t)(row0 + ai * HALF + m * 16) * NPROJ + col0; const float rs = rstd[row0 + ai * HALF + m * 16];
#pragma unroll
                    for (int bj = 0; bj < 2; ++bj) { const f32x4 v0 = acc[ai][bj][m][0] * rs, v1 = acc[ai][bj][m][1] * rs;
                        u32x4 w; w.x = cvt_pk_bf16(v0[0], v0[1]); w.y = cvt_pk_bf16(v0[2], v0[3]); w.z = cvt_pk_bf16(v1[0], v1[1]); w.w = cvt_pk_bf16(v1[2], v1[3]);
                        *(u32x4*)(p + bj * HALF) = w; } }
        } else if (u.pn < 42) {
            const int gt = u.pn - 18, col0 = gt * BM + wc * 32 + 8 * fq;
            const f32x4 b00 = *(const f32x4*)(gbias + col0), b01 = *(const f32x4*)(gbias + col0 + 4), b10 = *(const f32x4*)(gbias + col0 + HALF), b11 = *(const f32x4*)(gbias + col0 + HALF + 4);
            u32x4* gq = GQ + ((size_t)((gt >> 3) * (M / BM) + u.pm) * 8 + (gt & 7)) * 4096 + (wr * 4 + wc) * 512 + (fq * 16 + fr);
#pragma unroll
            for (int ai = 0; ai < 2; ++ai)
#pragma unroll
                for (int m = 0; m < 4; ++m) { const float rs = rstd[row0 + ai * HALF + m * 16];
                    u32x4 w; w.x = gate_q4(acc[ai][0][m][0] * rs + b00); w.y = gate_q4(acc[ai][0][m][1] * rs + b01); w.z = gate_q4(acc[ai][1][m][0] * rs + b10); w.w = gate_q4(acc[ai][1][m][1] * rs + b11);
                    gq[(ai * 4 + m) * 64] = w; }
        } else {
            if (wc == 0) {
#pragma unroll
                for (int ai = 0; ai < 2; ++ai)
#pragma unroll
                    for (int m = 0; m < 4; ++m) { float* p = LR + (size_t)(row0 + ai * HALF + m * 16) * 32 + 8 * fq; const float rs = rstd[row0 + ai * HALF + m * 16];
                        *(f32x4*)p = acc[ai][0][m][0] * rs; *(f32x4*)(p + 4) = acc[ai][0][m][1] * rs; }
            }
        }
    }
};
struct EpiMerge3 {
    static constexpr bool PERM = true, AFTER_DRAIN = false, HAS_MID = true;
    static constexpr int MID0 = 1024 / BK, MID1 = 1536 / BK;
    static constexpr size_t GSTRIDE = (size_t)(M / BM) * 8 * 4096;
    const u32x4* GQ; bf16_t* MG;
    __device__ __forceinline__ void mid(f32x4 (&acc)[2][2][4][2], const Unit& u, int seg, int wr, int wc, int fr, int fq) const {
        const u32x4* gp = GQ + (size_t)seg * GSTRIDE + ((size_t)u.pm * 8 + u.pn) * 4096 + (wr * 4 + wc) * 512 + (fq * 16 + fr);
        u32x4 gn[8], gd[8];
#pragma unroll
        for (int j = 0; j < 8; ++j) { gn[j] = gp[j * 64]; gd[j] = gp[GSTRIDE + j * 64]; }
#pragma unroll
        for (int j = 0; j < 8; ++j) { const int ai = j >> 2, m = j & 3;
            acc[ai][0][m][0] = acc[ai][0][m][0] * (ub4(gn[j].x) * rcp4(ub4(gd[j].x))); acc[ai][0][m][1] = acc[ai][0][m][1] * (ub4(gn[j].y) * rcp4(ub4(gd[j].y)));
            acc[ai][1][m][0] = acc[ai][1][m][0] * (ub4(gn[j].z) * rcp4(ub4(gd[j].z))); acc[ai][1][m][1] = acc[ai][1][m][1] * (ub4(gn[j].w) * rcp4(ub4(gd[j].w))); }
    }
    __device__ __forceinline__ void operator()(const f32x4 (&acc)[2][2][4][2], const Unit& u, int wr, int wc, int fr, int fq) const {
        const int row0 = u.pm * BM + wr * 64 + fr, col0 = u.pn * BM + wc * 32 + 8 * fq;
        const u32x4* gp = GQ + 2 * GSTRIDE + ((size_t)u.pm * 8 + u.pn) * 4096 + (wr * 4 + wc) * 512 + (fq * 16 + fr);
        u32x4 gc[8];
#pragma unroll
        for (int j = 0; j < 8; ++j) gc[j] = gp[j * 64];
        constexpr float S = 1.0f / 255.0f;
#pragma unroll
        for (int j = 0; j < 8; ++j) { const int ai = j >> 2, m = j & 3; bf16_t* p = MG + (size_t)(row0 + ai * HALF + m * 16) * D + col0;
            const f32x4 v0 = acc[ai][0][m][0] * (ub4(gc[j].x) * S), v1 = acc[ai][0][m][1] * (ub4(gc[j].y) * S), v2 = acc[ai][1][m][0] * (ub4(gc[j].z) * S), v3 = acc[ai][1][m][1] * (ub4(gc[j].w) * S);
            u32x4 w; w.x = cvt_pk_bf16(v0[0], v0[1]); w.y = cvt_pk_bf16(v0[2], v0[3]); w.z = cvt_pk_bf16(v1[0], v1[1]); w.w = cvt_pk_bf16(v1[2], v1[3]); *(u32x4*)p = w;
            w.x = cvt_pk_bf16(v2[0], v2[1]); w.y = cvt_pk_bf16(v2[2], v2[3]); w.z = cvt_pk_bf16(v3[0], v3[1]); w.w = cvt_pk_bf16(v3[2], v3[3]); *(u32x4*)(p + HALF) = w; }
    }
};

template <class Epi, class Sched, bool ALIGN_EPI = false, bool SP2 = false>
__device__ __forceinline__ void gemm_phase(LAS unsigned char* lds, const Gemm g, const Sched& S, const Epi& E) {
    const int tid = opaque_tid(), wid = __builtin_amdgcn_readfirstlane(tid >> 6), lane = tid & 63, wr = wid >> 2, wc = wid & 3, fr = lane & 15, fq = lane >> 4;
    const int K = g.K, nt = K / BK, lda = g.lda;
    unsigned voffA[2], voffB[2];
#pragma unroll
    for (int i = 0; i < 2; ++i) { int R, C; stage_rc(tid * 16 + i * 8192, R, C); const int Rb = Epi::PERM ? ((R & ~31) + perm32(R & 31)) : R;
        voffA[i] = (unsigned)(R * lda + C) * 2u; voffB[i] = (unsigned)(Rb * K + C) * 2u; }
    const unsigned kstep = (unsigned)(BK * 2);
    const unsigned hstepA = (unsigned)HALF * (unsigned)lda * 2u, hstepB = (unsigned)HALF * (unsigned)K * 2u;
    const unsigned tstepA = 2u * hstepA, tstepB = 2u * hstepB;
    const unsigned ldsw = (unsigned)wid * 1024u;
    const int aoff = lds_byte(wr * 64 + fr, fq * 8), boff = lds_byte(wc * 32 + fr, fq * 8);
    const char* const baseA = (const char*)g.A; const char* const baseB = (const char*)g.Bt;
#define PG8_SA(b, h) (((b) * 2 + (h)) * HTB)
#define PG8_SB(b, h) ((4 + (b) * 2 + (h)) * HTB)
#define PG8_STAGE(bufoff, gbase, goff, voff) do { _Pragma("unroll") for (int _i = 0; _i < 2; ++_i) \
        __builtin_amdgcn_global_load_lds((const unsigned*)((gbase) + (size_t)(unsigned)((goff) + (voff)[_i])), (LAS unsigned*)(lds + (bufoff) + ldsw + _i * 8192), 16, 0, 0); } while (0)
#define PG8_LDA(dst, b, h) do { _Pragma("unroll") for (int m = 0; m < 4; ++m) _Pragma("unroll") for (int k = 0; k < 2; ++k) dst[m][k] = *(const LAS bf16x8*)(lds + PG8_SA(b, h) + aoff + m * 2048 + k * 1024); } while (0)
#define PG8_LDB(dst, b, h) do { _Pragma("unroll") for (int n = 0; n < 2; ++n) _Pragma("unroll") for (int k = 0; k < 2; ++k) dst[n][k] = *(const LAS bf16x8*)(lds + PG8_SB(b, h) + boff + n * 2048 + k * 1024); } while (0)
#define PG8_MMA(ai, bj, At, Bt) do { __builtin_amdgcn_s_setprio(1); _Pragma("unroll") for (int m = 0; m < 4; ++m) _Pragma("unroll") for (int n = 0; n < 2; ++n) _Pragma("unroll") for (int k = 0; k < 2; ++k) \
        acc[ai][bj][m][n] = __builtin_amdgcn_mfma_f32_16x16x32_bf16(Bt[n][k], At[m][k], acc[ai][bj][m][n], 0, 0, 0); __builtin_amdgcn_s_setprio(0); } while (0)
#define PG8_WAIT_V(n) asm volatile("s_waitcnt vmcnt(" #n ")" ::: "memory")
#define PG8_WAIT_L(n) asm volatile("s_waitcnt lgkmcnt(" #n ")" ::: "memory")
#define PG8_BAR __builtin_amdgcn_s_barrier()
#define PG8_SCHED __builtin_amdgcn_sched_barrier(0)
    Unit cur, nxt; int ui = 0;
    if (!S.next(0, cur)) return;
    f32x4 acc[2][2][4][2];
#pragma unroll
    for (int a = 0; a < 2; ++a)
#pragma unroll
        for (int b = 0; b < 2; ++b)
#pragma unroll
            for (int m = 0; m < 4; ++m)
#pragma unroll
                for (int n = 0; n < 2; ++n) acc[a][b][m][n] = (f32x4){0.f, 0.f, 0.f, 0.f};
    bf16x8 At[4][2], B0[2][2], B1[2][2];
    unsigned cA = (unsigned)cur.pm * tstepA, cB = (unsigned)cur.pn * tstepB;
    S.a_ready(cur);
    if constexpr (SP2) {
        PG8_STAGE(PG8_SB(0, 0), baseB, cB, voffB); PG8_STAGE(PG8_SB(0, 1), baseB, cB + hstepB, voffB); PG8_STAGE(PG8_SA(0, 0), baseA, cA, voffA); PG8_STAGE(PG8_SA(0, 1), baseA, cA + hstepA, voffA);
        if (wr == 1) PG8_BAR;
        PG8_WAIT_V(2); PG8_BAR;
        PG8_STAGE(PG8_SB(1, 0), baseB, cB + kstep, voffB); PG8_STAGE(PG8_SA(1, 0), baseA, cA + kstep, voffA); PG8_STAGE(PG8_SB(1, 1), baseB, cB + hstepB + kstep, voffB);
        PG8_WAIT_V(6); PG8_BAR;
    } else {
        PG8_STAGE(PG8_SB(0, 0), baseB, cB, voffB); PG8_STAGE(PG8_SA(0, 0), baseA, cA, voffA); PG8_STAGE(PG8_SB(0, 1), baseB, cB + hstepB, voffB); PG8_STAGE(PG8_SA(0, 1), baseA, cA + hstepA, voffA);
        if (wr == 1) PG8_BAR;
        PG8_WAIT_V(4); PG8_BAR;
        PG8_STAGE(PG8_SB(1, 0), baseB, cB + kstep, voffB); PG8_STAGE(PG8_SA(1, 0), baseA, cA + kstep, voffA); PG8_STAGE(PG8_SB(1, 1), baseB, cB + hstepB + kstep, voffB);
        PG8_WAIT_V(6); PG8_BAR;
    }
    for (;;) {
        const bool has_next = S.next(ui + 1, nxt);
        const unsigned nA = has_next ? (unsigned)nxt.pm * tstepA : cA, nB = has_next ? (unsigned)nxt.pn * tstepB : cB;
        for (int t = 0; t < nt; t += 2) {
            const bool last = (t == nt - 2);
            if constexpr (Epi::HAS_MID) { if (t == Epi::MID0 || t == Epi::MID1) E.mid(acc, cur, t == Epi::MID0 ? 0 : 1, wr, wc, fr, fq); }
            const unsigned a1 = cA + (unsigned)(t + 1) * kstep;
            const unsigned a2 = last ? nA : cA + (unsigned)(t + 2) * kstep, b2 = last ? nB : cB + (unsigned)(t + 2) * kstep;
            const unsigned a3 = a2 + kstep, b3 = b2 + kstep;
            if (last && has_next) S.a_ready(nxt);
            if constexpr (SP2) {
            PG8_LDB(B0, 0, 0); PG8_LDB(B1, 0, 1); PG8_SCHED; PG8_LDA(At, 0, 0); PG8_STAGE(PG8_SA(1, 1), baseA, a1 + hstepA, voffA);
            PG8_WAIT_V(8); PG8_WAIT_L(0); PG8_BAR; PG8_MMA(0, 0, At, B0); PG8_MMA(0, 1, At, B1); PG8_BAR; PG8_SCHED;
            PG8_LDA(At, 0, 1); PG8_STAGE(PG8_SB(0, 0), baseB, b2, voffB); PG8_STAGE(PG8_SB(0, 1), baseB, b2 + hstepB, voffB); PG8_STAGE(PG8_SA(0, 0), baseA, a2, voffA);
            PG8_WAIT_V(8); PG8_WAIT_L(0); PG8_BAR; PG8_MMA(1, 0, At, B0); PG8_MMA(1, 1, At, B1); PG8_BAR; PG8_SCHED;
            PG8_LDB(B0, 1, 0); PG8_LDB(B1, 1, 1); PG8_SCHED; PG8_LDA(At, 1, 0); PG8_STAGE(PG8_SA(0, 1), baseA, a2 + hstepA, voffA);
            PG8_WAIT_V(8); PG8_WAIT_L(0); PG8_BAR; PG8_MMA(0, 0, At, B0); PG8_MMA(0, 1, At, B1); PG8_BAR; PG8_SCHED;
            PG8_LDA(At, 1, 1); PG8_STAGE(PG8_SB(1, 0), baseB, b3, voffB); PG8_STAGE(PG8_SB(1, 1), baseB, b3 + hstepB, voffB); PG8_STAGE(PG8_SA(1, 0), baseA, a3, voffA);
            PG8_WAIT_V(8); PG8_WAIT_L(0); PG8_BAR; PG8_MMA(1, 0, At, B0); PG8_MMA(1, 1, At, B1); PG8_BAR; PG8_SCHED;
            } else {
            PG8_LDB(B0, 0, 0); PG8_SCHED; PG8_LDA(At, 0, 0); PG8_STAGE(PG8_SA(1, 1), baseA, a1 + hstepA, voffA);
            PG8_WAIT_L(8); PG8_BAR; PG8_WAIT_L(0); PG8_MMA(0, 0, At, B0); PG8_BAR; PG8_SCHED;
            PG8_LDB(B1, 0, 1); PG8_STAGE(PG8_SB(0, 0), baseB, b2, voffB);
            PG8_BAR; PG8_WAIT_L(0); PG8_MMA(0, 1, At, B1); PG8_BAR;
            PG8_LDA(At, 0, 1); PG8_STAGE(PG8_SA(0, 0), baseA, a2, voffA);
            PG8_BAR; PG8_WAIT_L(0); PG8_MMA(1, 0, At, B0); PG8_BAR; PG8_SCHED;
            PG8_STAGE(PG8_SB(0, 1), baseB, b2 + hstepB, voffB);
            PG8_WAIT_V(6); PG8_BAR; PG8_MMA(1, 1, At, B1); PG8_BAR;
            PG8_LDB(B0, 1, 0); PG8_SCHED; PG8_LDA(At, 1, 0); PG8_STAGE(PG8_SA(0, 1), baseA, a2 + hstepA, voffA);
            PG8_WAIT_L(8); PG8_BAR; PG8_WAIT_L(0); PG8_MMA(0, 0, At, B0); PG8_BAR; PG8_SCHED;
            PG8_LDB(B1, 1, 1); PG8_STAGE(PG8_SB(1, 0), baseB, b3, voffB);
            PG8_BAR; PG8_WAIT_L(0); PG8_MMA(0, 1, At, B1); PG8_BAR;
            PG8_LDA(At, 1, 1); PG8_STAGE(PG8_SA(1, 0), baseA, a3, voffA);
            PG8_BAR; PG8_WAIT_L(0); PG8_MMA(1, 0, At, B0); PG8_BAR; PG8_SCHED;
            PG8_STAGE(PG8_SB(1, 1), baseB, b3 + hstepB, voffB);
            PG8_WAIT_V(6); PG8_BAR; PG8_MMA(1, 1, At, B1); PG8_BAR;
            }
        }
        if constexpr (ALIGN_EPI) { if (wr == 0) PG8_BAR; }
        if constexpr (!Epi::AFTER_DRAIN) { E(acc, cur, wr, wc, fr, fq); S.done(cur); }
        if (!has_next) break;
#pragma unroll
        for (int a = 0; a < 2; ++a)
#pragma unroll
            for (int b = 0; b < 2; ++b)
#pragma unroll
                for (int m = 0; m < 4; ++m)
#pragma unroll
                    for (int n = 0; n < 2; ++n) acc[a][b][m][n] = (f32x4){0.f, 0.f, 0.f, 0.f};
        cur = nxt; cA = nA; cB = nB; ++ui;
        if constexpr (ALIGN_EPI) { if (wr == 1) PG8_BAR; }
    }
    PG8_WAIT_V(0);
    if constexpr (!ALIGN_EPI) { if (wr == 0) PG8_BAR; }
    PG8_BAR;
#undef PG8_SA
#undef PG8_SB
#undef PG8_STAGE
#undef PG8_LDA
#undef PG8_LDB
#undef PG8_MMA
#undef PG8_WAIT_V
#undef PG8_WAIT_L
#undef PG8_BAR
#undef PG8_SCHED
}
}

namespace att {
constexpr int DH = 128, NW = 8, QBLK = 32, KVBLK = 64;
constexpr float SCALE = 0.088388347648318440f;
constexpr float THR = 8.f;
constexpr int LD = NPROJ, LDO = 2048;
constexpr size_t SHM_V = KVBLK * DH * 2, SHM_K = KVBLK * DH * 2, SHM_ATTN = 2 * SHM_V + 2 * SHM_K + NW * 64 * 4;
#define KSWZ(row, colB) ((row) * 256 + ((colB) ^ (((row) & 7) << 4)))
#define SBAR() __builtin_amdgcn_sched_barrier(0)
__device__ __forceinline__ int crow(int r, int hi) { return (r & 3) + 8 * (r >> 2) + 4 * hi; }
__device__ __forceinline__ void partialSM(f32x16& p0, f32x16& p1, float& m_reg, float& mn, float& alpha) {
  constexpr float C = SCALE * 1.4426950408889634f;
  float pmax = p0[0];
#pragma unroll
  for (int r = 1; r < 16; ++r) pmax = fmaxf(pmax, p0[r]);
#pragma unroll
  for (int r = 0; r < 16; ++r) pmax = fmaxf(pmax, p1[r]);
  { auto rr = __builtin_amdgcn_permlane32_swap(__float_as_uint(pmax), __float_as_uint(pmax), false, false);
    pmax = fmaxf(__uint_as_float(rr[0]), __uint_as_float(rr[1])); }
  if (__builtin_expect(__all(pmax - m_reg <= THR / SCALE), 1)) { mn = m_reg; alpha = 1.f; }
  else { mn = fmaxf(m_reg, pmax); alpha = __builtin_amdgcn_exp2f((m_reg - mn) * C); m_reg = mn; }
  float mnC = -mn * C;
#pragma unroll
  for (int r = 0; r < 16; ++r) p0[r] = fmaf(p0[r], C, mnC);
#pragma unroll
  for (int r = 0; r < 16; ++r) p1[r] = fmaf(p1[r], C, mnC);
#pragma unroll
  for (int r = 0; r < 16; ++r) p0[r] = __builtin_amdgcn_exp2f(p0[r]);
}
__device__ __forceinline__ void finishSM(f32x16& p0, f32x16& p1, float alpha, float& l_reg, bf16x8& pa0, bf16x8& pa1, bf16x8& pa2, bf16x8& pa3) {
#pragma unroll
  for (int r = 0; r < 16; ++r) p1[r] = __builtin_amdgcn_exp2f(p1[r]);
  float ps = 0;
#pragma unroll
  for (int r = 0; r < 16; ++r) ps += p0[r];
#pragma unroll
  for (int r = 0; r < 16; ++r) ps += p1[r];
  { auto rr = __builtin_amdgcn_permlane32_swap(__float_as_uint(ps), __float_as_uint(ps), false, false);
    ps = __uint_as_float(rr[0]) + __uint_as_float(rr[1]); }
  l_reg = l_reg * alpha + ps;
#define PK4(P, BASE, OUT) do { unsigned a0 = cvt_pk_bf16(P[BASE + 0], P[BASE + 1]), a1 = cvt_pk_bf16(P[BASE + 2], P[BASE + 3]);   \
    unsigned b0 = cvt_pk_bf16(P[BASE + 4], P[BASE + 5]), b1 = cvt_pk_bf16(P[BASE + 6], P[BASE + 7]);                              \
    auto r0 = __builtin_amdgcn_permlane32_swap(a0, b0, false, false); auto r1 = __builtin_amdgcn_permlane32_swap(a1, b1, false, false); \
    u32x4 w = {r0[0], r1[0], r0[1], r1[1]}; OUT = *reinterpret_cast<bf16x8*>(&w); } while (0)
  PK4(p0, 0, pa0); PK4(p0, 8, pa1); PK4(p1, 0, pa2); PK4(p1, 8, pa3);
#undef PK4
}
__device__ __forceinline__ void qkt(f32x16& p0, f32x16& p1, const bf16_t* Ks, const bf16x8* qr, int r32, int hi) {
  p0 = f32x16{}; p1 = f32x16{};
#pragma unroll
  for (int d0 = 0; d0 < 8; ++d0) { int cb = (d0 * 16 + hi * 8) * 2;
    bf16x8 b0 = *reinterpret_cast<const bf16x8*>((const char*)Ks + KSWZ(r32, cb));
    bf16x8 b1 = *reinterpret_cast<const bf16x8*>((const char*)Ks + KSWZ(32 + r32, cb));
    p0 = __builtin_amdgcn_mfma_f32_32x32x16_bf16(b0, qr[d0], p0, 0, 0, 0);
    p1 = __builtin_amdgcn_mfma_f32_32x32x16_bf16(b1, qr[d0], p1, 0, 0, 0); }
}
__device__ __forceinline__ int v_st(int k, int c) { const int kk = (k & ~0xC) | ((k & 4) << 1) | ((k & 8) >> 1); return ((kk >> 3) * 4 + (c >> 5)) * 512 + ((kk & 7) * 32 + (c & 31)) * 2; }
__device__ __forceinline__ int v_rd_base(int lane) { return ((lane & 3) << 3) | (((lane >> 2) & 3) << 6) | (((lane >> 4) & 1) << 5) | (((lane >> 5) & 1) << 8); }
constexpr int v_rd_off(int d0, int ks, int half) { return d0 * 512 + ks * 4096 + half * 2048; }
template <int OFF> __device__ __forceinline__ s16x4 tr_read(int vb) {
  s16x4 r; asm volatile("ds_read_b64_tr_b16 %0, %1 offset:%2" : "=&v"(r) : "v"(vb), "i"(OFF) : "memory"); return r;
}
template <int D0> __device__ __forceinline__ void pv_one(f32x16& od, int vb, bf16x8 pa0, bf16x8 pa1, bf16x8 pa2, bf16x8 pa3) {
  const s16x4 l0 = tr_read<v_rd_off(D0, 0, 0)>(vb), h0 = tr_read<v_rd_off(D0, 0, 1)>(vb), l1 = tr_read<v_rd_off(D0, 1, 0)>(vb), h1 = tr_read<v_rd_off(D0, 1, 1)>(vb);
  const s16x4 l2 = tr_read<v_rd_off(D0, 2, 0)>(vb), h2 = tr_read<v_rd_off(D0, 2, 1)>(vb), l3 = tr_read<v_rd_off(D0, 3, 0)>(vb), h3 = tr_read<v_rd_off(D0, 3, 1)>(vb);
  asm volatile("s_waitcnt lgkmcnt(0)" ::: "memory"); SBAR();
#define PK(L, H) (bf16x8){L[0], L[1], L[2], L[3], H[0], H[1], H[2], H[3]}
  od = __builtin_amdgcn_mfma_f32_32x32x16_bf16(pa0, PK(l0, h0), od, 0, 0, 0);
  od = __builtin_amdgcn_mfma_f32_32x32x16_bf16(pa1, PK(l1, h1), od, 0, 0, 0);
  od = __builtin_amdgcn_mfma_f32_32x32x16_bf16(pa2, PK(l2, h2), od, 0, 0, 0);
  od = __builtin_amdgcn_mfma_f32_32x32x16_bf16(pa3, PK(l3, h3), od, 0, 0, 0);
#undef PK
}
__device__ __forceinline__ void pv_d0(f32x16* o, int vb, bf16x8 pa0, bf16x8 pa1, bf16x8 pa2, bf16x8 pa3) {
  pv_one<0>(o[0], vb, pa0, pa1, pa2, pa3); pv_one<1>(o[1], vb, pa0, pa1, pa2, pa3); pv_one<2>(o[2], vb, pa0, pa1, pa2, pa3); pv_one<3>(o[3], vb, pa0, pa1, pa2, pa3);
}
__device__ __forceinline__ void attn_dense_body(const bf16_t* Qb, const bf16_t* __restrict__ Kh, const bf16_t* __restrict__ Vh, bf16_t* Ob, int seq, char* lds) {
  const int tid = opaque_tid(), wid = tid >> 6, lane = tid & 63, r32 = lane & 31, hi = lane >> 5;
  bf16_t* V_lds = (bf16_t*)lds; bf16_t* K_lds = (bf16_t*)(lds + 2 * SHM_V);
  float* ws = (float*)(lds + 2 * SHM_V + 2 * SHM_K) + wid * 64; float* li_l = ws; float* al_l = ws + 32;
  float m_reg = -1e30f, l_reg = 0; f32x16 o[4] = {}; bf16x8 qr[8];
  const bf16_t* Qw = Qb + (long)(wid * QBLK + r32) * LD + hi * 8;
#pragma unroll
  for (int d0 = 0; d0 < 8; ++d0) qr[d0] = *reinterpret_cast<const bf16x8*>(Qw + d0 * 16);
  const int sr = tid >> 4, sc = (tid & 15) * 8, vst0 = v_st(sr, sc), vst1 = v_st(32 + sr, sc);
  const int vb0 = (int)(uintptr_t)V_lds + v_rd_base(lane);
  struct { bf16x8 vs0, vs1, ks0, ks1; } sr_[1];
#define SLOAD(i, k0) do { sr_[i].vs0 = *reinterpret_cast<const bf16x8*>(&Vh[(long)((k0) + sr) * LD + sc]); sr_[i].vs1 = *reinterpret_cast<const bf16x8*>(&Vh[(long)((k0) + 32 + sr) * LD + sc]); \
    sr_[i].ks0 = *reinterpret_cast<const bf16x8*>(&Kh[(long)((k0) + sr) * LD + sc]); sr_[i].ks1 = *reinterpret_cast<const bf16x8*>(&Kh[(long)((k0) + 32 + sr) * LD + sc]); } while (0)
#define SWRITE(b, i) do { *(bf16x8*)((char*)V_lds + (b) * SHM_V + vst0) = sr_[i].vs0;          \
    *(bf16x8*)((char*)V_lds + (b) * SHM_V + vst1) = sr_[i].vs1; int kc = sc * 2;               \
    *(bf16x8*)((char*)K_lds + (b) * SHM_K + KSWZ(sr, kc)) = sr_[i].ks0;                       \
    *(bf16x8*)((char*)K_lds + (b) * SHM_K + KSWZ(32 + sr, kc)) = sr_[i].ks1; } while (0)
#define SWAIT() asm volatile("s_waitcnt vmcnt(0)" ::: "memory")
#define RESC(a) do { if (__any((a) < 1.f)) { if (hi == 0) al_l[r32] = (a); asm volatile("s_waitcnt lgkmcnt(0)" ::: "memory"); \
    _Pragma("unroll") for (int d = 0; d < 4; ++d) _Pragma("unroll") for (int r = 0; r < 16; ++r) o[d][r] *= al_l[crow(r, hi)]; } } while (0)
  f32x16 pA0, pA1, pB0, pB1; float mnA, mnB, alA, alB; bf16x8 pa0, pa1, pa2, pa3; const int NT = seq / KVBLK;
  constexpr int SE = 0, SO = 0;
  SLOAD(SE, 0); asm volatile("s_waitcnt vmcnt(0)" ::: "memory"); SWRITE(0, SE); __syncthreads();
  qkt(pA0, pA1, K_lds, qr, r32, hi); partialSM(pA0, pA1, m_reg, mnA, alA);
  SLOAD(SO, KVBLK);
  SWAIT(); SWRITE(1, SO); __syncthreads();
  for (int j = 1; j + 1 < NT; j += 2) {
    SBAR(); qkt(pB0, pB1, (bf16_t*)((char*)K_lds + SHM_K), qr, r32, hi);
    finishSM(pA0, pA1, alA, l_reg, pa0, pa1, pa2, pa3); SBAR();
    SLOAD(SO, (j + 1) * KVBLK); SBAR();
    pv_d0(o, vb0, pa0, pa1, pa2, pa3); partialSM(pB0, pB1, m_reg, mnB, alB);
    __syncthreads(); SWAIT(); SWRITE(0, SE);
    RESC(alB); __syncthreads();
    SBAR(); qkt(pA0, pA1, K_lds, qr, r32, hi);
    finishSM(pB0, pB1, alB, l_reg, pa0, pa1, pa2, pa3); SBAR();
    SLOAD(SE, (j + 2) * KVBLK); SBAR();
    pv_d0(o, vb0 + (int)SHM_V, pa0, pa1, pa2, pa3); partialSM(pA0, pA1, m_reg, mnA, alA);
    __syncthreads(); SWAIT(); SWRITE(1, SO);
    RESC(alA); __syncthreads();
  }
  SBAR(); qkt(pB0, pB1, (bf16_t*)((char*)K_lds + SHM_K), qr, r32, hi);
  finishSM(pA0, pA1, alA, l_reg, pa0, pa1, pa2, pa3); SBAR();
  pv_d0(o, vb0, pa0, pa1, pa2, pa3); partialSM(pB0, pB1, m_reg, mnB, alB);
  __syncthreads(); RESC(alB);
  finishSM(pB0, pB1, alB, l_reg, pa0, pa1, pa2, pa3); SBAR();
  pv_d0(o, vb0 + (int)SHM_V, pa0, pa1, pa2, pa3);
  if (hi == 0) li_l[r32] = l_reg; asm volatile("s_waitcnt lgkmcnt(0)" ::: "memory");
  float rli[16];
#pragma unroll
  for (int r = 0; r < 16; ++r) rli[r] = __builtin_amdgcn_rcpf(li_l[crow(r, hi)]);
  bf16_t* Ow = Ob + (long)(wid * QBLK) * LDO;
#pragma unroll
  for (int r = 0; r < 16; ++r) { int orow = crow(r, hi);
#pragma unroll
    for (int d0 = 0; d0 < 4; ++d0) Ow[(long)orow * LDO + d0 * 32 + r32] = f2bf(o[d0][r] * rli[r]); }
  __syncthreads();
#undef SLOAD
#undef SWRITE
#undef SWAIT
#undef RESC
}
}

constexpr int RING_BYTES = 131072;
constexpr int LDSCTL_OFF = RING_BYTES, MISC_OFF = LDSCTL_OFF + 320, PTAB_OFF = LDSCTL_OFF + 1024;
constexpr int LDS_BYTES = 147456;

#define XB_TMO      128
#define XB_XCNT(j)  (256  + 64 * (j))
#define XB_XSUB(j)  (1280 + 64 * (j))
#define XB_XGEN(j)  (2304 + 64 * (j))
#define XB_TOP      3328
#define XB_TOPGEN   3392
#define XCD_BAR_WORDS 3456
#define XB_SPIN_CAP (1u << 22)
__device__ __forceinline__ unsigned xb_ld(unsigned* p)              { return __hip_atomic_load(p, __ATOMIC_RELAXED, __HIP_MEMORY_SCOPE_AGENT); }
__device__ __forceinline__ unsigned xb_add(unsigned* p, unsigned v) { return __hip_atomic_fetch_add(p, v, __ATOMIC_RELAXED, __HIP_MEMORY_SCOPE_AGENT); }
__device__ __forceinline__ unsigned xb_xcc_id() { return (unsigned)__builtin_amdgcn_s_getreg((3 << 11) | 20) & 0xFu; }
#define XB_SPIN(cond, bar) do { unsigned _sp = 0; while (cond) { __builtin_amdgcn_s_sleep(1); \
    if ((++_sp & 255u) == 0u) { if (xb_ld(&(bar)[XB_TMO])) break; if (_sp > XB_SPIN_CAP) { atomicAdd(&(bar)[XB_TMO], 1u); break; } } } } while (0)
struct XcdBarrier { unsigned* bar; unsigned x; volatile LAS unsigned* st; };
__device__ __forceinline__ XcdBarrier xcd_barrier_post(unsigned* bar, volatile LAS unsigned* st) {
    XcdBarrier b; b.bar = bar; b.x = xb_xcc_id(); b.st = st;
    if (threadIdx.x == 0) (void)xb_add(&bar[XB_XCNT(b.x)], 1u);
    return b;
}
__device__ __forceinline__ void xcd_barrier_complete(unsigned* bar, unsigned x, unsigned& nloc, unsigned& nx) {
    const unsigned G = gridDim.x * gridDim.y * gridDim.z;
    unsigned sum, cnt, mine, sp = 0u;
    for (;;) {
        sum = 0u; cnt = 0u;
        for (unsigned j = 0; j < 16; ++j) { const unsigned c = xb_ld(&bar[XB_XCNT(j)]); sum += c; cnt += (c > 0u) ? 1u : 0u; }
        mine = xb_ld(&bar[XB_XCNT(x)]);
        if (sum == G) break;
        __builtin_amdgcn_s_sleep(1);
        if ((++sp & 255u) == 0u) { if (xb_ld(&bar[XB_TMO])) break; if (sp > XB_SPIN_CAP) { atomicAdd(&bar[XB_TMO], 1u); break; } }
    }
    nloc = mine > 0u ? mine : 1u; nx = cnt > 0u ? cnt : 1u;
}
__device__ __forceinline__ XcdBarrier xcd_barrier_setup(unsigned* bar, volatile LAS unsigned* st) {
    XcdBarrier b = xcd_barrier_post(bar, st);
    if (threadIdx.x == 0) { unsigned nloc, nx; xcd_barrier_complete(bar, b.x, nloc, nx); st[0] = nloc; st[1] = nx; }
    __syncthreads();
    return b;
}
__device__ __forceinline__ void xcd_barrier(const XcdBarrier& b) {
    asm volatile("s_waitcnt vmcnt(0)" ::: "memory");
    __syncthreads();
    if (threadIdx.x == 0) {
        unsigned* bar = b.bar; unsigned bx = b.x;
        asm volatile("" : "+s"(bar), "+s"(bx));
        __builtin_amdgcn_s_waitcnt(0);
        const unsigned nloc = b.st[0], nx = b.st[1];
        const unsigned old = xb_add(&bar[XB_XSUB(bx)], 1u);
        const unsigned gen = old / nloc;
        if (old + 1u == (gen + 1u) * nloc) {
            __builtin_amdgcn_fence(__ATOMIC_RELEASE, "agent");
            asm volatile("s_waitcnt vmcnt(0)" ::: "memory");
            const unsigned og = xb_add(&bar[XB_TOP], 1u);
            const unsigned tg = og / nx;
            if (og + 1u == (tg + 1u) * nx) xb_add(&bar[XB_TOPGEN], 1u);
            else XB_SPIN(xb_ld(&bar[XB_TOPGEN]) == tg, bar);
            __builtin_amdgcn_fence(__ATOMIC_ACQUIRE, "agent");
            xb_add(&bar[XB_XGEN(bx)], 1u);
            asm volatile("s_waitcnt vmcnt(0)" ::: "memory");
        } else {
            XB_SPIN(xb_ld(&bar[XB_XGEN(bx)]) == gen, bar);
            __builtin_amdgcn_fence(__ATOMIC_ACQUIRE, "agent");
            asm volatile("s_waitcnt vmcnt(0)" ::: "memory");
        }
    }
    __syncthreads();
}

__device__ __forceinline__ void transpose_item(const float* W, int ldw, int K, int k0, int srccol0, bf16_t* WT, int dstrow0, LAS float* scr, int lane, const float* kgain = nullptr, int ldt = 0) {
    const int KT = ldt ? ldt : K;
    constexpr int P = 36;
    const int n4 = (lane & 7) * 4, kr = lane >> 3;
    f32x4 v[8];
    if (srccol0 >= 0) {
#pragma unroll
        for (int i = 0; i < 8; ++i) v[i] = *(const f32x4*)(W + (size_t)(k0 + 8 * i + kr) * ldw + srccol0 + n4);
        if (kgain) {
#pragma unroll
            for (int i = 0; i < 8; ++i) v[i] = v[i] * kgain[k0 + 8 * i + kr];
        }
    } else {
#pragma unroll
        for (int i = 0; i < 8; ++i) v[i] = (f32x4){0.f, 0.f, 0.f, 0.f};
    }
#pragma unroll
    for (int i = 0; i < 8; ++i) *(LAS f32x4*)(scr + (8 * i + kr) * P + n4) = v[i];
    LDS_WAIT(); asm volatile("" ::: "memory");
    const int c = lane & 7;
#pragma unroll
    for (int j = 0; j < 4; ++j) { const int n = (lane >> 3) + 8 * j; const LAS float* s = scr + (8 * c) * P + n;
        u32x4 o; o.x = cvt_pk_bf16(s[0 * P], s[1 * P]); o.y = cvt_pk_bf16(s[2 * P], s[3 * P]); o.z = cvt_pk_bf16(s[4 * P], s[5 * P]); o.w = cvt_pk_bf16(s[6 * P], s[7 * P]);
        *(u32x4*)(WT + (size_t)(dstrow0 + n) * KT + k0 + 8 * c) = o; }
    LDS_WAIT(); asm volatile("" ::: "memory");
}
struct LayerW { const float *w_in, *w_bra, *w_brb, *w_brc, *w_out, *f1i, *f1o, *f2i, *f2o, *ng; };
__device__ __forceinline__ void phase_weights(const LayerW& w, unsigned char* ws, LAS unsigned char* lds, int gw, int NGW, int wave, int lane) {
    LAS float* scr = (LAS float*)(lds + wave * 16384);
    constexpr int I_IN = (NIN_PAD / 32) * (D / 64);
    constexpr int I_FI = (2 * FF / 32) * (D / 64);
    constexpr int I_FO = (D / 32) * (FF / 64);
    constexpr int I_BA = (D / 32) * (1024 / 64);
    constexpr int I_BB = (D / 32) * (512 / 64);
    constexpr int I_WO = (D / 32) * (D / 64);
    constexpr int NITEMS = I_IN + 2 * I_FI + 2 * I_FO + I_BA + 2 * I_BB + I_WO;
    for (int it = gw; it < NITEMS; it += NGW) {
        int r = it;
        if (r < I_IN) { const int nb = r % (NIN_PAD / 32), kb = r / (NIN_PAD / 32); const int d0 = nb * 32;
            const int src = d0 < 4608 ? d0 : (d0 < 10752 ? d0 + 32 : (d0 < 10784 ? 4608 + (d0 - 10752) : -1));
            transpose_item(w.w_in, NIN, D, kb * 64, src, (bf16_t*)(ws + WS_WIN), d0, scr, lane, w.ng + 2 * D); continue; } r -= I_IN;
        if (r < 2 * I_FI) { const int which = r / I_FI; r -= which * I_FI; const int nb = r % (2 * FF / 32), kb = r / (2 * FF / 32); const int d0 = nb * 32;
            const int t = d0 >> 8, within = d0 & 255; const int src = within < 128 ? 128 * t + within : FF + 128 * t + (within - 128);
            transpose_item(which ? w.f2i : w.f1i, 2 * FF, D, kb * 64, src, (bf16_t*)(ws + (which ? WS_WF2I : WS_WF1I)), d0, scr, lane, w.ng + (which ? 4 * D : 0)); continue; } r -= 2 * I_FI;
        if (r < 2 * I_FO) { const int which = r / I_FO; r -= which * I_FO; const int nb = r % (D / 32), kb = r / (D / 32);
            transpose_item(which ? w.f2o : w.f1o, D, FF, kb * 64, nb * 32, (bf16_t*)(ws + (which ? WS_WF2O : WS_WF1O)), nb * 32, scr, lane); continue; } r -= 2 * I_FO;
        if (r < I_BA) { const int nb = r % (D / 32), kb = r / (D / 32);
            transpose_item(w.w_bra, D, 1024, kb * 64, nb * 32, (bf16_t*)(ws + WS_WBRA), nb * 32, scr, lane, nullptr, LDOM); continue; } r -= I_BA;
        if (r < 2 * I_BB) { const int which = r / I_BB; r -= which * I_BB; const int nb = r % (D / 32), kb = r / (D / 32);
            transpose_item(which ? w.w_brc : w.w_brb, D, 512, kb * 64, nb * 32, (bf16_t*)(ws + WS_WBRA) + (which ? OM_C : OM_B), nb * 32, scr, lane, nullptr, LDOM); continue; } r -= 2 * I_BB;
        { const int nb = r % (D / 32), kb = r / (D / 32);
            transpose_item(w.w_out, D, D, kb * 64, nb * 32, (bf16_t*)(ws + WS_WOUT), nb * 32, scr, lane); }
    }
}
__device__ __forceinline__ void phase_norm(bf16_t* XB, const bf16_t* Y, float* RSTD, float* OUT, const float* gpost, float coef, int gw, int NGW, int lane) {
    for (int m = gw; m < M; m += NGW) {
        const u32x2* xr = (const u32x2*)(XB + (size_t)m * D) + lane; const u32x2* yr = (const u32x2*)(Y + (size_t)m * D) + lane;
        f32x4 x[8], y[8]; float s = 0.f;
#pragma unroll
        for (int j = 0; j < 8; ++j) { const u32x2 t = yr[64 * j], q = xr[64 * j]; y[j] = (f32x4){bflo(t.x), bfhi(t.x), bflo(t.y), bfhi(t.y)}; x[j] = (f32x4){bflo(q.x), bfhi(q.x), bflo(q.y), bfhi(q.y)};
            s += (y[j].x * y[j].x + y[j].y * y[j].y) + (y[j].z * y[j].z + y[j].w * y[j].w); }
        const float rstd = coef * (1.0f / sqrtf(wave_sum(s) * (1.0f / D) + EPS));
        float s2 = 0.f;
#pragma unroll
        for (int j = 0; j < 8; ++j) { const f32x4 g = ((const f32x4*)gpost)[lane + 64 * j]; x[j] = x[j] + y[j] * g * rstd; s2 += (x[j].x * x[j].x + x[j].y * x[j].y) + (x[j].z * x[j].z + x[j].w * x[j].w); }
        if (OUT) { f32x4* xo = (f32x4*)(OUT + (size_t)m * D) + lane;
#pragma unroll
            for (int j = 0; j < 8; ++j) xo[64 * j] = x[j];
        } else {
            u32x2* o8 = (u32x2*)(XB + (size_t)m * D) + lane;
#pragma unroll
            for (int j = 0; j < 8; ++j) { u32x2 w; w.x = cvt_pk_bf16(x[j].x, x[j].y); w.y = cvt_pk_bf16(x[j].z, x[j].w); o8[64 * j] = w; }
            const float r2 = 1.0f / sqrtf(wave_sum(s2) * (1.0f / D) + EPS);
            if (lane == 0) RSTD[m] = r2;
        }
    }
}
__device__ __forceinline__ void phase_prep(bf16_t* PROJ, const float* qk_gain  , LAS unsigned char* lds, int gw, int NGW, int tid, int lane) {
    LAS f32x2* cs = (LAS f32x2*)lds;
    for (int i = tid; i < 2048; i += 512) { const int pos = i >> 5, mi = i & 31; const float inv = powf(10000.0f, -(float)mi / 32.0f); float s, c; sincosf((float)pos * inv, &s, &c); cs[i] = (f32x2){c, s}; }
    __syncthreads();
    const float gq0 = qk_gain[2 * lane], gq1 = qk_gain[2 * lane + 1], gk0 = qk_gain[128 + 2 * lane], gk1 = qk_gain[128 + 2 * lane + 1];
    for (int m = gw; m < M; m += NGW) {
        const int t = m & (SEQ - 1), pr = t >> 6, pc = t & 63;
        const f32x2 c_s = cs[((lane < 32) ? pr : pc) * 32 + (lane & 31)];
        unsigned* row = (unsigned*)(PROJ + (size_t)m * NPROJ);
        unsigned v[10];
#pragma unroll
        for (int h = 0; h < 10; ++h) v[h] = row[h * 64 + lane];
#pragma unroll
        for (int h = 0; h < 10; ++h) {
            const float x1 = bflo(v[h]), x2 = bfhi(v[h]);
            const float rstd = 1.0f / sqrtf(wave_sum(x1 * x1 + x2 * x2) * (1.0f / 128.0f) + EPS);
            const float n1 = x1 * rstd * (h < 8 ? gq0 : gk0), n2 = x2 * rstd * (h < 8 ? gq1 : gk1);
            row[h * 64 + lane] = cvt_pk_bf16(n1 * c_s.x - n2 * c_s.y, n1 * c_s.y + n2 * c_s.x);
        }
    }
    __syncthreads();
}
__device__ __forceinline__ void tr_pair(unsigned base, int pitch, int row0, int col0, int lane, s16x4& lo, s16x4& hi) {
    const int g = lane >> 4, i = lane & 15;
    const unsigned addr = base + (unsigned)((row0 + 4 * g + (i >> 2)) * pitch + (col0 + 4 * (i & 3)) * 2);
    asm volatile("ds_read_b64_tr_b16 %0, %1" : "=&v"(lo) : "v"(addr) : "memory");
    asm volatile("ds_read_b64_tr_b16 %0, %1" : "=&v"(hi) : "v"(addr + (unsigned)(16 * pitch)) : "memory");
}
#define TR_JOIN(L, H) ((bf16x8){L[0], L[1], L[2], L[3], H[0], H[1], H[2], H[3]})
__device__ __forceinline__ bf16x8 pack8(const float* x) { u32x4 w; w.x = cvt_pk_bf16(x[0], x[1]); w.y = cvt_pk_bf16(x[2], x[3]); w.z = cvt_pk_bf16(x[4], x[5]); w.w = cvt_pk_bf16(x[6], x[7]); return *reinterpret_cast<bf16x8*>(&w); }
__device__ __forceinline__ void na_unit(const bf16_t* PROJ, bf16_t* OB  , LAS unsigned char* lds, int u) {
    const int tid = opaque_tid(), lane = tid & 63, w = __builtin_amdgcn_readfirstlane(tid >> 6);
    constexpr int PV = 272, O_V = 0, O_RPB = 2 * 64 * PV;
    LAS float* rpbs = (LAS float*)(lds + O_RPB);
    const unsigned lbase = (unsigned)(uintptr_t)lds;
    const int ib = w & 3, vh = w >> 2;
    {
        int lane_o = lane; asm volatile("" : "+v"(lane_o));
        const int g = lane_o >> 4, li = lane_o & 15;
        const int r = u & 31, h = (u >> 5) & 3, b = u >> 7;
        const int rs = min(max(r - 4, 0), 24);
        const int c = 16 * ib + li, cs0 = min(max(c - 8, 0), 48);
        const size_t tq = (size_t)b * SEQ + r * 64 + c;
        bf16x8 qf[4];
#pragma unroll
        for (int ks = 0; ks < 4; ++ks) qf[ks] = *(const bf16x8*)(PROJ + tq * NPROJ + C_BQ + h * 128 + 32 * ks + 8 * g);
        int jbv[4], dcv[4];
#pragma unroll
        for (int rr = 0; rr < 4; ++rr) { const int km = 4 * g + rr; jbv[rr] = (cs0 + 15 - km) >> 4; dcv[rr] = 16 * jbv[rr] + km - c + 15; }
        f32x4 o[4];
#pragma unroll
        for (int vt = 0; vt < 4; ++vt) o[vt] = (f32x4){0.f, 0.f, 0.f, 0.f};
        float m_run = -1e30f, l_run = 0.f;
        const int sr = tid >> 4, sc = (tid & 15) * 8;
        const int jlo = ib > 1 ? ib - 1 : 0, jhi = ib < 2 ? ib + 1 : 3;
        bf16x8 kf[4][4], vr0, vr1;
#define NA_LOADK(kr_) do { const size_t kt_ = (size_t)b * SEQ + (size_t)(rs + (kr_)) * 64; \
            _Pragma("unroll") for (int jb = 0; jb < 4; ++jb) if (jb >= jlo && jb <= jhi) { const bf16_t* kp = PROJ + (kt_ + 16 * jb + li) * NPROJ + C_BK + h * 128 + 8 * g; \
                _Pragma("unroll") for (int ks = 0; ks < 4; ++ks) kf[jb][ks] = *(const bf16x8*)(kp + 32 * ks); } } while (0)
#define NA_LOADV(kr_) do { const size_t kt_ = (size_t)b * SEQ + (size_t)(rs + (kr_)) * 64; \
            vr0 = *(const bf16x8*)(PROJ + (kt_ + sr) * NPROJ + C_BV + h * 128 + sc); vr1 = *(const bf16x8*)(PROJ + (kt_ + sr + 32) * NPROJ + C_BV + h * 128 + sc); } while (0)
        NA_LOADV(0); NA_LOADK(0);
        for (int kr = 0; kr < 8; ++kr) {
            *(LAS bf16x8*)(lds + O_V + (kr & 1) * 64 * PV + sr * PV + sc * 2) = vr0; *(LAS bf16x8*)(lds + O_V + (kr & 1) * 64 * PV + (sr + 32) * PV + sc * 2) = vr1;
            if (kr + 1 < 8) NA_LOADV(kr + 1);
            f32x4 s[4];
#pragma unroll
            for (int jb = 0; jb < 4; ++jb) { s[jb] = (f32x4){0.f, 0.f, 0.f, 0.f};
                if (jb >= jlo && jb <= jhi) {
#pragma unroll
                    for (int ks = 0; ks < 4; ++ks) s[jb] = __builtin_amdgcn_mfma_f32_16x16x32_bf16(kf[jb][ks], qf[ks], s[jb], 0, 0, 0); } }
            if (kr + 1 < 8) NA_LOADK(kr + 1);
            const int dr = rs + kr - r + 7;
            float mx = -1e30f;
#pragma unroll
            for (int rr = 0; rr < 4; ++rr) { const float bias = rpbs[(h * 15 + dr) * 31 + dcv[rr]];
#pragma unroll
                for (int jb = 0; jb < 4; ++jb) { const float v = (jb == jbv[rr]) ? s[jb][rr] * 0.088388347648318440f + bias : -1e30f; s[jb][rr] = v; mx = fmaxf(mx, v); } }
            mx = fmaxf(mx, __shfl_xor(mx, 16)); mx = fmaxf(mx, __shfl_xor(mx, 32));
            const float m_new = fmaxf(m_run, mx), alpha = __expf(m_run - m_new);
            m_run = m_new;
            float ps = 0.f;
#pragma unroll
            for (int jb = 0; jb < 4; ++jb)
#pragma unroll
                for (int rr = 0; rr < 4; ++rr) { const float p = (jb == jbv[rr]) ? __expf(s[jb][rr] - m_new) : 0.f; s[jb][rr] = p; ps += p; }
            l_run = l_run * alpha + ps;
            bf16x8 pfr[2];
#pragma unroll
            for (int ss = 0; ss < 2; ++ss) { const float t[8] = {s[2 * ss][0], s[2 * ss][1], s[2 * ss][2], s[2 * ss][3], s[2 * ss + 1][0], s[2 * ss + 1][1], s[2 * ss + 1][2], s[2 * ss + 1][3]}; pfr[ss] = pack8(t); }
            __syncthreads();
            s16x4 vl[4][2], vhh[4][2];
            {
                const unsigned vbase = lbase + O_V + (unsigned)((kr & 1) * 64 * PV + (4 * g + (li >> 2)) * PV + (64 * vh + 4 * (li & 3)) * 2);
                asm volatile("ds_read_b64_tr_b16 %0, %16 offset:0\n\t"
                         "ds_read_b64_tr_b16 %1, %16 offset:4352\n\t"
                         "ds_read_b64_tr_b16 %2, %16 offset:8704\n\t"
                         "ds_read_b64_tr_b16 %3, %16 offset:13056\n\t"
                         "ds_read_b64_tr_b16 %4, %16 offset:32\n\t"
                         "ds_read_b64_tr_b16 %5, %16 offset:4384\n\t"
                         "ds_read_b64_tr_b16 %6, %16 offset:8736\n\t"
                         "ds_read_b64_tr_b16 %7, %16 offset:13088\n\t"
                         "ds_read_b64_tr_b16 %8, %16 offset:64\n\t"
                         "ds_read_b64_tr_b16 %9, %16 offset:4416\n\t"
                         "ds_read_b64_tr_b16 %10, %16 offset:8768\n\t"
                         "ds_read_b64_tr_b16 %11, %16 offset:13120\n\t"
                         "ds_read_b64_tr_b16 %12, %16 offset:96\n\t"
                         "ds_read_b64_tr_b16 %13, %16 offset:4448\n\t"
                         "ds_read_b64_tr_b16 %14, %16 offset:8800\n\t"
                         "ds_read_b64_tr_b16 %15, %16 offset:13152\n\t"
                         "s_waitcnt lgkmcnt(0)"
                         : "=&v"(vl[0][0]), "=&v"(vhh[0][0]), "=&v"(vl[0][1]), "=&v"(vhh[0][1]), "=&v"(vl[1][0]), "=&v"(vhh[1][0]), "=&v"(vl[1][1]), "=&v"(vhh[1][1]), "=&v"(vl[2][0]), "=&v"(vhh[2][0]), "=&v"(vl[2][1]), "=&v"(vhh[2][1]), "=&v"(vl[3][0]), "=&v"(vhh[3][0]), "=&v"(vl[3][1]), "=&v"(vhh[3][1])
                         : "v"(vbase) : "memory");
            }
            __builtin_amdgcn_sched_barrier(0);
#pragma unroll
            for (int vt = 0; vt < 4; ++vt) { o[vt] = o[vt] * alpha;
#pragma unroll
                for (int ss = 0; ss < 2; ++ss) o[vt] = __builtin_amdgcn_mfma_f32_16x16x32_bf16(TR_JOIN(vl[vt][ss], vhh[vt][ss]), pfr[ss], o[vt], 0, 0, 0); }
        }
#undef NA_LOADK
#undef NA_LOADV
        l_run += __shfl_xor(l_run, 16); l_run += __shfl_xor(l_run, 32);
        const float inv = 1.0f / l_run;
#pragma unroll
        for (int vt = 0; vt < 4; ++vt) { u32x2 ov; ov.x = cvt_pk_bf16(o[vt].x * inv, o[vt].y * inv); ov.y = cvt_pk_bf16(o[vt].z * inv, o[vt].w * inv);
            *(u32x2*)(OB + tq * LDOM + h * 128 + 64 * vh + 16 * vt + 4 * g) = ov; }
        __syncthreads();
    }
}
__device__ __forceinline__ void na_load_bias(const float* rpb, LAS unsigned char* lds) {
    const int tid = opaque_tid(); LAS float* rpbs = (LAS float*)(lds + 2 * 64 * 272);
    __syncthreads();
    for (int i = tid; i < 4 * 15 * 31; i += 512) rpbs[i] = rpb[i];
    __syncthreads();
}
__device__ __forceinline__ float logsig16(float z) { return (fminf(z, 0.f) - __logf(1.0f + __expf(-fabsf(z)))) * (1.0f / 16.0f); }
__device__ __forceinline__ void gla_seq_unit(const bf16_t* PROJ, const float* LR, const float* w_decay  , const float* b_decay  , bf16_t* OFB, bf16_t* OC, const float* onorm,
                                             LAS unsigned char* lds, int b, int h) {
    const int tid = opaque_tid(), lane = tid & 63, w = __builtin_amdgcn_readfirstlane(tid >> 6);
    constexpr int P64 = 144, PV = 272;
    constexpr int O_Q = 0, O_K = 9216, O_KH = 18432, O_V = 27648, O_S = 45056, O_DEC = 63488, O_W2 = 63744;
    const unsigned lbase = (unsigned)(uintptr_t)lds;
    const int ib = w & 3, vh = w >> 2, g = lane >> 4, li = lane & 15;
    LAS float* w2s = (LAS float*)(lds + O_W2);
    LAS float* gns = (LAS float*)(lds + 68608);
    __syncthreads(); if (tid < 128) gns[tid] = onorm[tid];
    LAS float* red = (LAS float*)(lds + 68096);
  for (int dir = 0; dir < 2; ++dir) {
    __syncthreads();
    for (int i = tid; i < 16 * 64; i += 512) w2s[i] = w_decay[dir * 4096 + (i >> 6) * 256 + h * 64 + (i & 63)];
    if (tid < 64) w2s[1024 + tid] = b_decay[dir * 256 + h * 64 + tid];
    for (int i = tid; i < 128 * 72 / 2; i += 512) ((LAS unsigned*)(lds + O_S))[i] = 0u;
    f32x4 S[4];
#pragma unroll
    for (int vt = 0; vt < 4; ++vt) S[vt] = (f32x4){0.f, 0.f, 0.f, 0.f};
    const int dcol = 8 * w;
    const int sr = tid >> 4, sc = (tid & 15) * 8;
    f32x4 lr4[4]; u32x4 qraw, kraw; bf16x8 vst0, vst1;
    u32x2 ofr[4], ogr[4];
#define GLA_LOAD_O(cc_) do { const int c_ = 31 - (cc_); const size_t mi_ = (size_t)b * SEQ + c_ * 64 + 16 * ib + li; \
        _Pragma("unroll") for (int vt = 0; vt < 4; ++vt) { ofr[vt] = *(const u32x2*)(OFB + mi_ * 512 + h * 128 + 64 * vh + 16 * vt + 4 * g); ogr[vt] = *(const u32x2*)(PROJ + mi_ * NPROJ + C_OG + h * 128 + 64 * vh + 16 * vt + 4 * g); } } while (0)
#define GLA_LOAD(cc_) do { const int c_ = dir ? 31 - (cc_) : (cc_); const size_t m0_ = (size_t)b * SEQ + c_ * 64, m_ = m0_ + lane; \
        _Pragma("unroll") for (int j = 0; j < 4; ++j) lr4[j] = ((const f32x4*)(LR + m_ * 32 + dir * 16))[j]; \
        qraw = *(const u32x4*)(PROJ + m_ * NPROJ + C_CQ + h * 64 + dcol); kraw = *(const u32x4*)(PROJ + m_ * NPROJ + C_CK + h * 64 + dcol); \
        vst0 = *(const bf16x8*)(PROJ + (m0_ + sr) * NPROJ + C_CV + h * 128 + sc); vst1 = *(const bf16x8*)(PROJ + (m0_ + sr + 32) * NPROJ + C_CV + h * 128 + sc); } while (0)
#pragma unroll
    for (int vt = 0; vt < 4; ++vt) { ofr[vt] = (u32x2){0u, 0u}; ogr[vt] = (u32x2){0u, 0u}; }
    GLA_LOAD(0);
    if (dir) GLA_LOAD_O(0);
    __syncthreads();
    for (int cc = 0; cc < 32; ++cc) {
        const int c = dir ? 31 - cc : cc; const size_t m0 = (size_t)b * SEQ + c * 64;
        {
            f32x4 z0 = *(const LAS f32x4*)(w2s + 1024 + dcol), z1 = *(const LAS f32x4*)(w2s + 1024 + dcol + 4);
#pragma unroll
            for (int j = 0; j < 4; ++j)
#pragma unroll
                for (int rr = 0; rr < 4; ++rr) { const int r = 4 * j + rr; z0 = z0 + *(const LAS f32x4*)(w2s + r * 64 + dcol) * lr4[j][rr]; z1 = z1 + *(const LAS f32x4*)(w2s + r * 64 + dcol + 4) * lr4[j][rr]; }
            float bs[8];
#pragma unroll
            for (int e = 0; e < 4; ++e) { bs[e] = logsig16(z0[e]); bs[4 + e] = logsig16(z1[e]); }
            if (dir == 0) {
#pragma unroll
                for (int off = 1; off < 64; off <<= 1)
#pragma unroll
                    for (int e = 0; e < 8; ++e) { const float t = __shfl_up(bs[e], off); if (lane >= off) bs[e] += t; }
            } else {
#pragma unroll
                for (int off = 1; off < 64; off <<= 1)
#pragma unroll
                    for (int e = 0; e < 8; ++e) { const float t = __shfl_down(bs[e], off); if (lane + off < 64) bs[e] += t; }
            }
            const float q[8] = {bflo(qraw.x), bfhi(qraw.x), bflo(qraw.y), bfhi(qraw.y), bflo(qraw.z), bfhi(qraw.z), bflo(qraw.w), bfhi(qraw.w)};
            const float k[8] = {bflo(kraw.x), bfhi(kraw.x), bflo(kraw.y), bfhi(kraw.y), bflo(kraw.z), bfhi(kraw.z), bflo(kraw.w), bfhi(kraw.w)};
            float qt[8], kt[8], kh[8], dc[8];
#pragma unroll
            for (int e = 0; e < 8; ++e) { const float be = __shfl(bs[e], dir ? 0 : 63);
                qt[e] = q[e] * 0.125f * __expf(bs[e]); kt[e] = k[e] * __expf(-bs[e]); kh[e] = k[e] * __expf(be - bs[e]); dc[e] = __expf(be); }
            *(LAS bf16x8*)(lds + O_Q + lane * P64 + 16 * w) = pack8(qt); *(LAS bf16x8*)(lds + O_K + lane * P64 + 16 * w) = pack8(kt); *(LAS bf16x8*)(lds + O_KH + lane * P64 + 16 * w) = pack8(kh);
            if (lane == 0) { *(LAS f32x4*)(lds + O_DEC + 4 * dcol) = (f32x4){dc[0], dc[1], dc[2], dc[3]}; *(LAS f32x4*)(lds + O_DEC + 4 * dcol + 16) = (f32x4){dc[4], dc[5], dc[6], dc[7]}; }
            *(LAS bf16x8*)(lds + O_V + sr * PV + sc * 2) = vst0; *(LAS bf16x8*)(lds + O_V + (sr + 32) * PV + sc * 2) = vst1;
        }
        __syncthreads();
        if (cc + 1 < 32) GLA_LOAD(cc + 1);
        const size_t mi = m0 + 16 * ib + li; f32x4 oo[4]; float ss = 0.f;
        {
            bf16x8 qF[2];
#pragma unroll
            for (int ks = 0; ks < 2; ++ks) qF[ks] = *(const LAS bf16x8*)(lds + O_Q + (16 * ib + li) * P64 + (32 * ks + 8 * g) * 2);
            f32x4 P[4];
#pragma unroll
            for (int jb = 0; jb < 4; ++jb) {
                f32x4 a = {0.f, 0.f, 0.f, 0.f};
                const bool need = dir ? (jb >= ib) : (jb <= ib);
                if (need) {
#pragma unroll
                    for (int ks = 0; ks < 2; ++ks) a = __builtin_amdgcn_mfma_f32_16x16x32_bf16(*(const LAS bf16x8*)(lds + O_K + (16 * jb + li) * P64 + (32 * ks + 8 * g) * 2), qF[ks], a, 0, 0, 0); }
#pragma unroll
                for (int r = 0; r < 4; ++r) { const int jl = 4 * g + r;
                    const bool keep = (jb == ib) ? (dir ? (jl >= li) : (jl <= li)) : need;
                    P[jb][r] = keep ? a[r] : 0.f; }
            }
            bf16x8 pfr[2];
#pragma unroll
            for (int s = 0; s < 2; ++s) { const float t[8] = {P[2 * s][0], P[2 * s][1], P[2 * s][2], P[2 * s][3], P[2 * s + 1][0], P[2 * s + 1][1], P[2 * s + 1][2], P[2 * s + 1][3]}; pfr[s] = pack8(t); }
            s16x4 vl[4][2], vhh[4][2], kl[2], kh2[2];
            {
                const unsigned vbase = lbase + O_V + (unsigned)((4 * g + (li >> 2)) * PV + (64 * vh + 4 * (li & 3)) * 2);
                const unsigned kbase = lbase + O_KH + (unsigned)((4 * g + (li >> 2)) * P64 + (16 * ib + 4 * (li & 3)) * 2);
                asm volatile("ds_read_b64_tr_b16 %0, %20 offset:0\n\t"
                         "ds_read_b64_tr_b16 %1, %20 offset:4352\n\t"
                         "ds_read_b64_tr_b16 %2, %20 offset:8704\n\t"
                         "ds_read_b64_tr_b16 %3, %20 offset:13056\n\t"
                         "ds_read_b64_tr_b16 %4, %20 offset:32\n\t"
                         "ds_read_b64_tr_b16 %5, %20 offset:4384\n\t"
                         "ds_read_b64_tr_b16 %6, %20 offset:8736\n\t"
                         "ds_read_b64_tr_b16 %7, %20 offset:13088\n\t"
                         "ds_read_b64_tr_b16 %8, %20 offset:64\n\t"
                         "ds_read_b64_tr_b16 %9, %20 offset:4416\n\t"
                         "ds_read_b64_tr_b16 %10, %20 offset:8768\n\t"
                         "ds_read_b64_tr_b16 %11, %20 offset:13120\n\t"
                         "ds_read_b64_tr_b16 %12, %20 offset:96\n\t"
                         "ds_read_b64_tr_b16 %13, %20 offset:4448\n\t"
                         "ds_read_b64_tr_b16 %14, %20 offset:8800\n\t"
                         "ds_read_b64_tr_b16 %15, %20 offset:13152\n\t"
                         "ds_read_b64_tr_b16 %16, %21 offset:0\n\t"
                         "ds_read_b64_tr_b16 %17, %21 offset:2304\n\t"
                         "ds_read_b64_tr_b16 %18, %21 offset:4608\n\t"
                         "ds_read_b64_tr_b16 %19, %21 offset:6912\n\t"
                         "s_waitcnt lgkmcnt(0)"
                         : "=&v"(vl[0][0]), "=&v"(vhh[0][0]), "=&v"(vl[0][1]), "=&v"(vhh[0][1]), "=&v"(vl[1][0]), "=&v"(vhh[1][0]), "=&v"(vl[1][1]), "=&v"(vhh[1][1]), "=&v"(vl[2][0]), "=&v"(vhh[2][0]), "=&v"(vl[2][1]), "=&v"(vhh[2][1]), "=&v"(vl[3][0]), "=&v"(vhh[3][0]), "=&v"(vl[3][1]), "=&v"(vhh[3][1]), "=&v"(kl[0]), "=&v"(kh2[0]), "=&v"(kl[1]), "=&v"(kh2[1])
                         : "v"(vbase), "v"(kbase) : "memory");
            }
            bf16x8 sfr[4][2];
#pragma unroll
            for (int vt = 0; vt < 4; ++vt)
#pragma unroll
                for (int ks = 0; ks < 2; ++ks) sfr[vt][ks] = *(const LAS bf16x8*)(lds + O_S + (64 * vh + 16 * vt + li) * P64 + (32 * ks + 8 * g) * 2);
            const float dec = *(const LAS float*)(lds + O_DEC + 4 * (16 * ib + li));
            __builtin_amdgcn_sched_barrier(0);
#pragma unroll
            for (int vt = 0; vt < 4; ++vt) {
                const int v0 = 64 * vh + 16 * vt;
                f32x4 o = {0.f, 0.f, 0.f, 0.f};
#pragma unroll
                for (int s = 0; s < 2; ++s) o = __builtin_amdgcn_mfma_f32_16x16x32_bf16(TR_JOIN(vl[vt][s], vhh[vt][s]), pfr[s], o, 0, 0, 0);
#pragma unroll
                for (int ks = 0; ks < 2; ++ks) o = __builtin_amdgcn_mfma_f32_16x16x32_bf16(sfr[vt][ks], qF[ks], o, 0, 0, 0);
                if (dir == 0) { u32x2 ov; ov.x = (unsigned)f2bf(o.x) | ((unsigned)f2bf(o.y) << 16); ov.y = (unsigned)f2bf(o.z) | ((unsigned)f2bf(o.w) << 16);
                    *(u32x2*)(OFB + mi * 512 + h * 128 + v0 + 4 * g) = ov; }
                else { const u32x2 f = ofr[vt];
                    o.x += bflo(f.x); o.y += bfhi(f.x); o.z += bflo(f.y); o.w += bfhi(f.y); oo[vt] = o; ss += (o.x * o.x + o.y * o.y) + (o.z * o.z + o.w * o.w); }
                f32x4 sn = S[vt] * dec;
#pragma unroll
                for (int s = 0; s < 2; ++s) sn = __builtin_amdgcn_mfma_f32_16x16x32_bf16(TR_JOIN(vl[vt][s], vhh[vt][s]), TR_JOIN(kl[s], kh2[s]), sn, 0, 0, 0);
                S[vt] = sn;
            }
        }
        if (dir) { ss += __shfl_xor(ss, 16); ss += __shfl_xor(ss, 32); if (g == 0) red[vh * 64 + 16 * ib + li] = ss; }
        __syncthreads();
        if (dir) {
            const float rstd = 1.0f / sqrtf((red[16 * ib + li] + red[64 + 16 * ib + li]) * (1.0f / 128.0f) + EPS);
#pragma unroll
            for (int vt = 0; vt < 4; ++vt) { const int v0 = 64 * vh + 16 * vt;
                const u32x2 og = ogr[vt]; const f32x4 gn = *(const LAS f32x4*)(gns + v0 + 4 * g);
                u32x2 ov; ov.x = cvt_pk_bf16(oo[vt].x * rstd * gn.x * pg8::silu_f(bflo(og.x)), oo[vt].y * rstd * gn.y * pg8::silu_f(bfhi(og.x)));
                ov.y = cvt_pk_bf16(oo[vt].z * rstd * gn.z * pg8::silu_f(bflo(og.y)), oo[vt].w * rstd * gn.w * pg8::silu_f(bfhi(og.y)));
                *(u32x2*)(OC + mi * LDOM + h * 128 + v0 + 4 * g) = ov; }
            if (cc + 1 < 32) GLA_LOAD_O(cc + 1);
        }
#pragma unroll
        for (int vt = 0; vt < 4; ++vt)
#pragma unroll
            for (int r = 0; r < 4; ++r) *(LAS bf16_t*)(lds + O_S + (64 * vh + 16 * vt + 4 * g + r) * P64 + (16 * ib + li) * 2) = f2bf(S[vt][r]);
    }
    __syncthreads();
  }
#undef GLA_LOAD
#undef GLA_LOAD_O
}
constexpr int NPH = 15;
enum { P_F1A = 0, P_F1B, P_N1, P_M1, P_PREP, P_ATT, P_NA, P_GLA, P_GLC, P_M4, P_M5, P_N2, P_F2A, P_F2B, P_N3 };
constexpr int NGP = 1 + DEPTH * NPH;
struct Args { const float* in[18]; float* out; unsigned char* ws; int gp_lo, gp_hi; };

typedef decltype(__builtin_amdgcn_kernarg_segment_ptr()) kargp_t;
__device__ __forceinline__ unsigned long long karg_q(int byte_off) { kargp_t p_ = __builtin_amdgcn_kernarg_segment_ptr(); asm volatile("" : "+s"(p_));
    return *(const unsigned long long __attribute__((address_space(4)))*)((const char __attribute__((address_space(4)))*)p_ + byte_off); }
__global__ void __launch_bounds__(512, 2) fwd(Args args) {
    extern __shared__ __attribute__((aligned(16))) unsigned char lds_raw[];
    LAS unsigned char* const lds0 = (LAS unsigned char*)lds_raw;
    const int G0 = gridDim.x, wg0 = blockIdx.x;
#define PENV LAS unsigned char* lds = lds0; int G = G0, wg = wg0; asm volatile("" : "+s"(lds), "+s"(G), "+s"(wg)); const int NGW = G * 8; (void)NGW; (void)lds; (void)wg
    volatile LAS unsigned* MISC = (volatile LAS unsigned*)(lds0 + MISC_OFF);
    volatile LAS unsigned long long* PT = (volatile LAS unsigned long long*)(lds0 + PTAB_OFF);
    { const int t0 = threadIdx.x;
      for (int u = t0; u < (LDS_BYTES - LDSCTL_OFF) / 4; u += 512) ((LAS unsigned*)(lds0 + LDSCTL_OFF))[u] = 0u;
      __syncthreads();
      __syncthreads(); }
#if ONE_LAUNCH
    constexpr int lo = 0, hi = NGP;
#else
    const int lo = args.gp_lo, hi = args.gp_hi;
#endif
    XcdBarrier bar; bar.bar = (unsigned*)(args.ws + WS_CTL) + CW_BAR; bar.x = 0; bar.st = nullptr;
    if (hi - lo > 1) bar = xcd_barrier_setup((unsigned*)(args.ws + WS_CTL) + CW_BAR, MISC + 8);
#define SEAM(gp) do { if ((gp) + 1 < hi) xcd_barrier(bar); } while (0)
#define INP(i) ((const float*)(const GAS float*)karg_q(8 * (i)))
#define WSP() ((unsigned char*)(GAS unsigned char*)karg_q(8 * 19))
#define XP() ((float*)(GAS float*)karg_q(8 * 18))
#define TIDS() PENV; const int tid = opaque_tid(), lane = tid & 63, wave = __builtin_amdgcn_readfirstlane(tid >> 6), gw = wg * 8 + wave; (void)tid; (void)lane; (void)wave; (void)gw

    if (((PHASE_MASK >> 31) & 1u) && lo <= 0 && 0 < hi) {
        TIDS(); unsigned char* ws = WSP(); bf16_t* XB = (bf16_t*)(ws + WS_XN); float* RSTD = (float*)(ws + WS_RSTD);
        LayerW w; w.w_in = INP(3); w.w_bra = INP(10); w.w_brb = INP(11); w.w_brc = INP(12); w.w_out = INP(13); w.f1i = INP(14); w.f1o = INP(15); w.f2i = INP(16); w.f2o = INP(17); w.ng = INP(2);
        phase_weights(w, ws, lds, gw, NGW, wave, lane);
        const float* xp = INP(0); const float* xs = INP(1);
        for (int m = gw; m < M; m += NGW) {
            const float* src = m < 16 * SEQ ? xp + (size_t)m * D : xs + (size_t)(m - 16 * SEQ) * D;
            const f32x4* xr = (const f32x4*)src + lane; f32x4 x[8]; float s = 0.f;
#pragma unroll
            for (int j = 0; j < 8; ++j) { x[j] = xr[64 * j]; s += (x[j].x * x[j].x + x[j].y * x[j].y) + (x[j].z * x[j].z + x[j].w * x[j].w); }
            u32x2* o8 = (u32x2*)(XB + (size_t)m * D) + lane;
#pragma unroll
            for (int j = 0; j < 8; ++j) { u32x2 wv; wv.x = cvt_pk_bf16(x[j].x, x[j].y); wv.y = cvt_pk_bf16(x[j].z, x[j].w); o8[64 * j] = wv; }
            const float rstd = 1.0f / sqrtf(wave_sum(s) * (1.0f / D) + EPS);
            if (lane == 0) RSTD[m] = rstd;
        }
        SEAM(0);
    }
    for (int l = 0; l < DEPTH; ++l) {
        const int gp0 = 1 + l * NPH;
        if (gp0 + NPH <= lo || gp0 >= hi) continue;
#define IN(p) (((PHASE_MASK >> (p)) & 1u) && lo <= gp0 + (p) && gp0 + (p) < hi)
#define FFN_PAIR(ff, pa, pb) do { \
        if (IN(pa)) { PENV; unsigned char* ws = WSP(); pg8::Gemm g{(const bf16_t*)(ws + WS_XN), (const bf16_t*)(ws + ((ff) ? WS_WF2I : WS_WF1I)), M, 2 * FF, D, D}; pg8::StaticOrder S; S.init(M, 2 * FF, G, wg, WGM_FI); \
            pg8::EpiSwiGLU E{(bf16_t*)(ws + WS_H), (const float*)(ws + WS_RSTD)}; pg8::gemm_phase<pg8::EpiSwiGLU, pg8::StaticOrder, true, true>(lds, g, S, E); if ((DUP_MASK >> (pa)) & 1u) pg8::gemm_phase<pg8::EpiSwiGLU, pg8::StaticOrder, true, true>(lds, g, S, E); SEAM(gp0 + (pa)); } \
        if (IN(pb)) { PENV; unsigned char* ws = WSP(); pg8::Gemm g{(const bf16_t*)(ws + WS_H), (const bf16_t*)(ws + ((ff) ? WS_WF2O : WS_WF1O)), M, D, FF, FF}; pg8::StaticOrder S; S.init(M, D, G, wg, WGM_FO); \
            pg8::EpiBf16Plain E{(bf16_t*)(ws + WS_Y), D}; pg8::gemm_phase<pg8::EpiBf16Plain, pg8::StaticOrder, true, true>(lds, g, S, E); if ((DUP_MASK >> (pb)) & 1u) pg8::gemm_phase<pg8::EpiBf16Plain, pg8::StaticOrder, true, true>(lds, g, S, E); SEAM(gp0 + (pb)); } } while (0)
#define NORM_PHASE(p, ipost, coef, last) do { if (IN(p)) { TIDS(); unsigned char* ws = WSP(); const float* ng = INP(2) + (size_t)l * 6 * D; \
            phase_norm((bf16_t*)(ws + WS_XN), (const bf16_t*)(ws + WS_Y), (float*)(ws + WS_RSTD), (last) ? XP() : nullptr, ng + (ipost) * D, (coef), gw, NGW, lane);

        FFN_PAIR(0, P_F1A, P_F1B);
        NORM_PHASE(P_N1, 1, 0.5f, false) SEAM(gp0 + P_N1); } } while (0);
        if (IN(P_M1)) { PENV;
            unsigned char* ws = WSP();
            pg8::Gemm g{(const bf16_t*)(ws + WS_XN), (const bf16_t*)(ws + WS_WIN), M, NIN_PAD, D, D}; pg8::StaticOrder S; S.init(M, NIN_PAD, G, wg, WGM_M1);
            pg8::EpiProj E{(bf16_t*)(ws + WS_PROJ), (u32x4*)(ws + WS_GATES), (float*)(ws + WS_LR), INP(4) + (size_t)l * 3 * D, (const float*)(ws + WS_RSTD)};
            pg8::gemm_phase<pg8::EpiProj, pg8::StaticOrder, true, true>(lds, g, S, E);
            if ((DUP_MASK >> P_M1) & 1u) pg8::gemm_phase<pg8::EpiProj, pg8::StaticOrder, true, true>(lds, g, S, E);
            SEAM(gp0 + P_M1);
        }
        if (IN(P_PREP)) {
            { TIDS(); unsigned char* ws = WSP(); phase_prep((bf16_t*)(ws + WS_PROJ), INP(5) + (size_t)l * 256, lds, gw, NGW, tid, lane); }
            SEAM(gp0 + P_PREP);
        }
        if (IN(P_ATT)) { PENV;
            unsigned char* ws = WSP(); bf16_t* PROJ = (bf16_t*)(ws + WS_PROJ);
            const int ngrp = (G % 8 == 0) ? 8 : 1, xg = wg % ngrp, slot = wg / ngrp, per = G / ngrp;
            for (int gu = slot; gu < 96 / ngrp; gu += per) { const int U = xg * (96 / ngrp) + gu;
                gla_seq_unit(PROJ, (const float*)(ws + WS_LR), INP(7) + (size_t)l * 2 * 16 * 256, INP(8) + (size_t)l * 512, (bf16_t*)(ws + WS_OFB), (bf16_t*)(ws + WS_OA) + OM_C, INP(9) + (size_t)l * 128, lds, U >> 2, U & 3); }
            na_load_bias(INP(6) + (size_t)l * 4 * 15 * 31, lds);
            unsigned* head = (unsigned*)(ws + WS_CTL) + CW_Q + (l * 8 + xg) * 64;
            const int n_att = 1536 / ngrp, n_na = 3072 / ngrp;
            LAS unsigned* qslot = (LAS unsigned*)(lds + MISC_OFF + 64);
            for (;;) {
                __syncthreads();
                if (threadIdx.x == 0) *qslot = __hip_atomic_fetch_add(head, 1u, __ATOMIC_RELAXED, __HIP_MEMORY_SCOPE_AGENT);
                __syncthreads();
                const int idx = __builtin_amdgcn_readfirstlane((int)*(volatile LAS unsigned*)qslot);
                if (idx >= n_att * (1 + ATT_DUP) + n_na) break;
                if (idx < n_att * (1 + ATT_DUP)) { const int idx0 = idx; const int idx = idx0 % n_att;
                    const int rnd = idx >> 5, mem = idx & 31, grp = (ngrp == 8) ? rnd * 8 + xg : rnd;
                    const int b = grp >> 1, kvh = grp & 1, h = kvh * 4 + (mem >> 3), qb = mem & 7;
                    const size_t rowq = (size_t)b * SEQ + qb * 256, rowk = (size_t)b * SEQ;
                    bf16_t* Qp = PROJ + rowq * NPROJ + C_AQ + h * 128;
                    att::attn_dense_body(Qp, PROJ + rowk * NPROJ + C_AK + kvh * 128, PROJ + rowk * NPROJ + C_AV + kvh * 128, (bf16_t*)(ws + WS_OA) + rowq * LDOM + h * 128, SEQ, (char*)lds_raw + 49152);
                } else {
                    na_unit(PROJ, (bf16_t*)(ws + WS_OA) + OM_B, lds, xg * n_na + (idx - n_att * (1 + ATT_DUP)));
                }
            }
            SEAM(gp0 + P_GLA);
        }
        if (IN(P_M4)) { PENV;
            unsigned char* ws = WSP();
            pg8::Gemm g{(const bf16_t*)(ws + WS_OA), (const bf16_t*)(ws + WS_WBRA), M, D, LDOM, LDOM}; pg8::StaticOrder S; S.init(M, D, G, wg, WGM_M45);
            pg8::EpiMerge3 E{(const u32x4*)(ws + WS_GATES), (bf16_t*)(ws + WS_MG)};
            pg8::gemm_phase<pg8::EpiMerge3, pg8::StaticOrder, true, true>(lds, g, S, E);
            if ((DUP_MASK >> P_M4) & 1u) pg8::gemm_phase<pg8::EpiMerge3, pg8::StaticOrder, true, true>(lds, g, S, E);
            SEAM(gp0 + P_M4);
        }
        if (IN(P_M5)) { PENV;
            unsigned char* ws = WSP();
            pg8::Gemm g{(const bf16_t*)(ws + WS_MG), (const bf16_t*)(ws + WS_WOUT), M, D, D, D}; pg8::StaticOrder S; S.init(M, D, G, wg, WGM_M45);
            pg8::EpiBf16Plain E{(bf16_t*)(ws + WS_Y), D};
            pg8::gemm_phase<pg8::EpiBf16Plain, pg8::StaticOrder, true, true>(lds, g, S, E);
            if ((DUP_MASK >> P_M5) & 1u) pg8::gemm_phase<pg8::EpiBf16Plain, pg8::StaticOrder, true, true>(lds, g, S, E);
            SEAM(gp0 + P_M5);
        }
        NORM_PHASE(P_N2, 3, 1.0f, false) SEAM(gp0 + P_N2); } } while (0);
        FFN_PAIR(1, P_F2A, P_F2B);
        NORM_PHASE(P_N3, 5, 0.5f, (l + 1 == DEPTH))
            if (l + 1 < DEPTH) { LayerW w; w.w_in = INP(3) + (size_t)(l + 1) * D * NIN; w.w_bra = INP(10) + (size_t)(l + 1) * 1024 * D; w.w_brb = INP(11) + (size_t)(l + 1) * 512 * D; w.w_brc = INP(12) + (size_t)(l + 1) * 512 * D;
                w.w_out = INP(13) + (size_t)(l + 1) * D * D; w.f1i = INP(14) + (size_t)(l + 1) * D * 2 * FF; w.f1o = INP(15) + (size_t)(l + 1) * FF * D; w.f2i = INP(16) + (size_t)(l + 1) * D * 2 * FF; w.f2o = INP(17) + (size_t)(l + 1) * FF * D; w.ng = INP(2) + (size_t)(l + 1) * 6 * D;
                phase_weights(w, ws, lds, gw, NGW, wave, lane); if ((DUP_MASK >> 20) & 1u) phase_weights(w, ws, lds, gw, NGW, wave, lane); }
            SEAM(gp0 + P_N3); } } while (0);
#undef FFN_PAIR
#undef NORM_PHASE
#undef IN
    }
#undef SEAM
}

extern "C" void kernel_launch(void* const* d_in, const int* in_sizes, int n_in, void* d_out, int out_size, void* d_ws, size_t ws_size, hipStream_t stream) {
    static int grid = 0;
    if (grid == 0) {
        if (n_in != 18 || out_size != M * D || ws_size < WS_END) { fprintf(stderr, "kernel_launch: unexpected shapes: n_in %d out %d ws %zu (need %zu)\n", n_in, out_size, ws_size, (size_t)WS_END); grid = -1; return; }
        int dev = 0, cus = 0, per_cu = 0;
        if (hipGetDevice(&dev) != hipSuccess || hipDeviceGetAttribute(&cus, hipDeviceAttributeMultiprocessorCount, dev) != hipSuccess) { grid = -1; return; }
        if (hipFuncSetAttribute((const void*)fwd, hipFuncAttributeMaxDynamicSharedMemorySize, LDS_BYTES) != hipSuccess) { fprintf(stderr, "kernel_launch: hipFuncSetAttribute failed\n"); grid = -1; return; }
        if (hipOccupancyMaxActiveBlocksPerMultiprocessor(&per_cu, (const void*)fwd, 512, LDS_BYTES) != hipSuccess || per_cu < 1) fprintf(stderr, "kernel_launch: occupancy query says %d\n", per_cu);
        (void)hipGetLastError();
        grid = cus;
    }
    if (grid < 0) return;
    (void)hipMemsetAsync((char*)d_ws + WS_CTL, 0, CTL_BYTES, stream);
    Args a{};
    for (int i = 0; i < 18; ++i) a.in[i] = (const float*)d_in[i];
    a.out = (float*)d_out; a.ws = (unsigned char*)d_ws;
#if ONE_LAUNCH
    a.gp_lo = 0; a.gp_hi = NGP;
    hipLaunchKernelGGL(fwd, dim3(grid), dim3(512), LDS_BYTES, stream, a);
#else
    for (int gp = 0; gp < NGP; ++gp) { a.gp_lo = gp; a.gp_hi = gp + 1; hipLaunchKernelGGL(fwd, dim3(grid), dim3(512), LDS_BYTES, stream, a); }
#endif
    const hipError_t le = hipPeekAtLastError();
    if (le != hipSuccess) fprintf(stderr, "kernel_launch: launch failed: %s\n", hipGetErrorName(le));
}
```

```cpp
#include <hip/hip_runtime.h>
#include <cstdio>
#include <cstdint>

#ifndef ONE_LAUNCH
#define ONE_LAUNCH 1
#endif
#ifndef WGM_FI
#define WGM_FI 4
#endif
#ifndef WGM_FO
#define WGM_FO 2
#endif
#ifndef WGM_M1
#define WGM_M1 4
#endif
#ifndef WGM_M45
#define WGM_M45 4
#endif
#ifndef ATT_DUP
#define ATT_DUP 0
#endif
#ifndef DUP_MASK
#define DUP_MASK 0u
#endif
#ifndef PHASE_MASK
#define PHASE_MASK 0xFFFFFFFFu
#endif

#define GAS __attribute__((address_space(1)))
#define LAS __attribute__((address_space(3)))
typedef unsigned short bf16_t;
typedef short bf16x8 __attribute__((ext_vector_type(8)));
typedef short s16x4 __attribute__((ext_vector_type(4)));
typedef float f32x4 __attribute__((ext_vector_type(4)));
typedef float f32x2 __attribute__((ext_vector_type(2)));
typedef float f32x16 __attribute__((ext_vector_type(16)));
typedef unsigned u32x4 __attribute__((ext_vector_type(4)));
typedef unsigned u32x2 __attribute__((ext_vector_type(2)));

constexpr int M = 49152;
constexpr int SEQ = 2048, NSEQ = 24;
constexpr int D = 2048, FF = 5632, DEPTH = 4;
constexpr int NPROJ = 4608;
constexpr int NGATE = 6144;
constexpr int NIN = 10784, NIN_PAD = 11008;
constexpr int C_AQ = 0, C_AK = 1024, C_AV = 1280, C_BQ = 1536, C_BK = 2048, C_BV = 2560, C_CQ = 3072, C_CK = 3328, C_CV = 3584, C_OG = 4096;
constexpr int C_OC = 3072;
constexpr float EPS = 1e-6f;

constexpr size_t MiB = 1u << 20;
constexpr size_t WS_CTL = 0, CTL_BYTES = 1 * MiB;
constexpr size_t WS_WIN = 2 * MiB;
constexpr size_t WS_WF1I = 45 * MiB;
constexpr size_t WS_WF1O = 89 * MiB;
constexpr size_t WS_WF2I = 111 * MiB;
constexpr size_t WS_WF2O = 155 * MiB;
constexpr size_t WS_WBRA = 177 * MiB;
constexpr size_t WS_WBRB = 181 * MiB;
constexpr size_t WS_WBRC = 183 * MiB;
constexpr size_t WS_WOUT = 185 * MiB;
constexpr size_t WS_XN = 193 * MiB;
constexpr size_t WS_BIG = 385 * MiB;
constexpr size_t WS_PROJ = WS_BIG;
constexpr size_t WS_GATES = WS_BIG + 432 * MiB;
constexpr size_t WS_LR = WS_BIG + 1008 * MiB;
constexpr size_t WS_H = WS_BIG;
constexpr size_t WS_Y = WS_BIG + 528 * MiB;
constexpr size_t WS_OFB = WS_BIG + 1014 * MiB;
constexpr size_t WS_MG = WS_OFB + 48 * MiB;
constexpr size_t WS_RSTD = WS_MG + 192 * MiB;
constexpr size_t WS_OA = WS_RSTD + 1 * MiB;
constexpr int LDOM = 2048, OM_B = 1024, OM_C = 1536;
constexpr size_t WS_END = WS_OA + 192 * MiB;
constexpr int CW_Q = 32768;
static_assert(WS_Y + (size_t)M * D * 4 <= WS_LR, "Y inside GATES region");
constexpr int CW_BAR = 4096;

__device__ __forceinline__ unsigned cvt_pk_bf16(float lo, float hi) { unsigned r; asm volatile("v_cvt_pk_bf16_f32 %0, %1, %2" : "=v"(r) : "v"(lo), "v"(hi)); return r; }
__device__ __forceinline__ float bflo(unsigned w) { return __uint_as_float(w << 16); }
__device__ __forceinline__ float bfhi(unsigned w) { return __uint_as_float(w & 0xffff0000u); }
__device__ __forceinline__ float bf2f(bf16_t v) { return __uint_as_float(((unsigned)v) << 16); }
__device__ __forceinline__ bf16_t f2bf(float f) { unsigned u = __float_as_uint(f); return (bf16_t)((u + 0x7fffu + ((u >> 16) & 1u)) >> 16); }
__device__ __forceinline__ float wave_sum(float v) {
#pragma unroll
    for (int o = 1; o < 64; o <<= 1) v += __shfl_xor(v, o);
    return v;
}
__device__ __forceinline__ float wave_max(float v) {
#pragma unroll
    for (int o = 1; o < 64; o <<= 1) v = fmaxf(v, __shfl_xor(v, o));
    return v;
}
__device__ __forceinline__ int opaque_tid() { int t = threadIdx.x; asm volatile("" : "+v"(t)); return t; }
__device__ __forceinline__ unsigned char* opq(unsigned char* p) { asm volatile("" : "+s"(p)); return p; }
__device__ __forceinline__ const float* lds_ptr(volatile LAS unsigned long long* tab, int i) { const unsigned long long v = tab[i];
    const unsigned lo = __builtin_amdgcn_readfirstlane((unsigned)v), hi = __builtin_amdgcn_readfirstlane((unsigned)(v >> 32)); return (const float*)(((unsigned long long)hi << 32) | lo); }
#define LDS_WAIT() asm volatile("s_waitcnt lgkmcnt(0)" ::: "memory")
#define VM_WAIT() asm volatile("s_waitcnt vmcnt(0)" ::: "memory")

namespace pg8 {
constexpr int BM = 256, BK = 64, HALF = 128, HTB = HALF * BK * 2, STAGE_BYTES = 8 * HTB, NXCD = 8;
__host__ __device__ __forceinline__ int lds_byte(int r, int c) { const int st = (r >> 4) * 2 + (c >> 5), rr = r & 15, cc = c & 31, ob = rr * 64 + cc * 2; return st * 1024 + (ob ^ (((ob >> 9) & 1) << 5)); }
__host__ __device__ __forceinline__ void stage_rc(int b, int& R, int& C) { const int st = b / 1024, sb = b % 1024, swz = sb ^ (((sb >> 9) & 1) << 5); R = (st >> 1) * 16 + swz / 64; C = (st & 1) * 32 + (swz % 64) / 2; }
__host__ __device__ __forceinline__ int perm32(int rho) { const int n = rho >> 4, i = rho & 15; return 8 * (i >> 2) + 4 * n + (i & 3); }

struct Unit { int pm, pn; };
struct Gemm { const bf16_t* A; const bf16_t* Bt; int M, N, K, lda; };

struct StaticOrder {
    int nM, nN, nwg, G, c, WGM;
    __host__ __device__ void init(int M_, int N_, int G_, int c_, int wgm_ = 4) { nM = M_ / BM; nN = N_ / BM; nwg = nM * nN; G = G_; c = c_; WGM = wgm_; }
    __host__ __device__ bool next(int i, Unit& u) const {
        const long L = (long)i * G + c; if (L >= nwg) return false;
        int wgid = (int)L; { const int q = nwg / NXCD, r = nwg % NXCD, xcd = wgid % NXCD, off = wgid / NXCD; wgid = (xcd < r ? xcd * (q + 1) : r * (q + 1) + (xcd - r) * q) + off; }
        const int nig = WGM * nN, gid = wgid / nig, fm = gid * WGM, gsz = (nM - fm) < WGM ? (nM - fm) : WGM;
        u.pm = fm + ((wgid % nig) % gsz); u.pn = (wgid % nig) / gsz; return true;
    }
    __device__ __forceinline__ void a_ready(const Unit&) const {}
    __device__ __forceinline__ void done(const Unit&) const {}
};

struct EpiF32 {
    static constexpr bool PERM = false, AFTER_DRAIN = false, HAS_MID = false, USES_RSTD = false;
    float* C; int ldc;
    __device__ __forceinline__ void operator()(const f32x4 (&acc)[2][2][4][2], const Unit& u, int wr, int wc, int fr, int fq, const LAS float* rsl) const {
        const int row0 = u.pm * BM + wr * 64 + fr, col0 = u.pn * BM + wc * 32 + 4 * fq;
#pragma unroll
        for (int ai = 0; ai < 2; ++ai)
#pragma unroll
            for (int m = 0; m < 4; ++m) { float* rowp = C + (size_t)(row0 + ai * HALF + m * 16) * ldc + col0;
#pragma unroll
                for (int bj = 0; bj < 2; ++bj)
#pragma unroll
                    for (int n = 0; n < 2; ++n) *(f32x4*)(rowp + bj * HALF + n * 16) = acc[ai][bj][m][n]; }
    }
};
struct EpiBf16Plain {
    static constexpr bool PERM = true, AFTER_DRAIN = false, HAS_MID = false, USES_RSTD = false;
    bf16_t* C; int ldc;
    __device__ __forceinline__ void operator()(const f32x4 (&acc)[2][2][4][2], const Unit& u, int wr, int wc, int fr, int fq, const LAS float* rsl) const {
        const int row0 = u.pm * BM + wr * 64 + fr, col0 = u.pn * BM + wc * 32 + 8 * fq;
#pragma unroll
        for (int ai = 0; ai < 2; ++ai)
#pragma unroll
            for (int m = 0; m < 4; ++m) { bf16_t* p = C + (size_t)(row0 + ai * HALF + m * 16) * ldc + col0;
#pragma unroll
                for (int bj = 0; bj < 2; ++bj) { const f32x4 v0 = acc[ai][bj][m][0], v1 = acc[ai][bj][m][1];
                    u32x4 w; w.x = cvt_pk_bf16(v0[0], v0[1]); w.y = cvt_pk_bf16(v0[2], v0[3]); w.z = cvt_pk_bf16(v1[0], v1[1]); w.w = cvt_pk_bf16(v1[2], v1[3]);
                    *(u32x4*)(p + bj * HALF) = w; } }
    }
};
__device__ __forceinline__ float silu_f(float g) { return g * __builtin_amdgcn_rcpf(1.0f + __builtin_amdgcn_exp2f(-1.4426950408889634f * g)); }
__device__ __forceinline__ float sigmoid_f(float g) { return __builtin_amdgcn_rcpf(1.0f + __builtin_amdgcn_exp2f(-1.4426950408889634f * g)); }
struct EpiSwiGLU {
    static constexpr bool PERM = true, AFTER_DRAIN = false, HAS_MID = false, USES_RSTD = true;
    bf16_t* H; const float* rstd;
    __device__ __forceinline__ void operator()(const f32x4 (&acc)[2][2][4][2], const Unit& u, int wr, int wc, int fr, int fq, const LAS float* rsl) const {
        const int row0 = u.pm * BM + wr * 64 + fr, col0 = u.pn * HALF + wc * 32 + 8 * fq;
#pragma unroll
        for (int ai = 0; ai < 2; ++ai)
#pragma unroll
            for (int m = 0; m < 4; ++m) { bf16_t* p = H + (size_t)(row0 + ai * HALF + m * 16) * FF + col0; const float rs = rsl[wr * 64 + fr + ai * HALF + m * 16];
                const f32x4 g0 = acc[ai][0][m][0] * rs, g1 = acc[ai][0][m][1] * rs, u0 = acc[ai][1][m][0] * rs, u1 = acc[ai][1][m][1] * rs;
                u32x4 w; w.x = cvt_pk_bf16(silu_f(g0[0]) * u0[0], silu_f(g0[1]) * u0[1]); w.y = cvt_pk_bf16(silu_f(g0[2]) * u0[2], silu_f(g0[3]) * u0[3]);
                w.z = cvt_pk_bf16(silu_f(g1[0]) * u1[0], silu_f(g1[1]) * u1[1]); w.w = cvt_pk_bf16(silu_f(g1[2]) * u1[2], silu_f(g1[3]) * u1[3]);
                *(u32x4*)p = w; }
    }
};
__device__ __forceinline__ float gate_k(float x) { return fmaxf(__builtin_rintf(sigmoid_f(x) * 255.0f), 1.0f); }
__device__ __forceinline__ unsigned gate_q4(const f32x4 v) { unsigned w = __builtin_amdgcn_cvt_pk_u8_f32(gate_k(v[0]), 0u, 0u); w = __builtin_amdgcn_cvt_pk_u8_f32(gate_k(v[1]), 1u, w);
    w = __builtin_amdgcn_cvt_pk_u8_f32(gate_k(v[2]), 2u, w); return __builtin_amdgcn_cvt_pk_u8_f32(gate_k(v[3]), 3u, w); }
__device__ __forceinline__ f32x4 ub4(unsigned w) { return (f32x4){(float)(w & 0xffu), (float)((w >> 8) & 0xffu), (float)((w >> 16) & 0xffu), (float)(w >> 24)}; }
__device__ __forceinline__ f32x4 rcp4(const f32x4 v) { return (f32x4){__builtin_amdgcn_rcpf(v[0]), __builtin_amdgcn_rcpf(v[1]), __builtin_amdgcn_rcpf(v[2]), __builtin_amdgcn_rcpf(v[3])}; }
struct EpiProj {
    static constexpr bool PERM = true, AFTER_DRAIN = false, HAS_MID = false, USES_RSTD = true;
    bf16_t* PROJ; u32x4* GQ; float* LR; const float* gbias; const float* rstd;
    __device__ __forceinline__ void operator()(const f32x4 (&acc)[2][2][4][2], const Unit& u, int wr, int wc, int fr, int fq, const LAS float* rsl) const {
        const int row0 = u.pm * BM + wr * 64 + fr;
        if (u.pn < 18) {
            const int col0 = u.pn * BM + wc * 32 + 8 * fq;
#pragma unroll
            for (int ai = 0; ai < 2; ++ai)
#pragma unroll
                for (int m = 0; m < 4; ++m) { bf16_t* p = PROJ + (size_t)(row0 + ai * HALF + m * 16) * NPROJ + col0; const float rs = rsl[wr * 64 + fr + ai * HALF + m * 16];
#pragma unroll
                    for (int bj = 0; bj < 2; ++bj) { const f32x4 v0 = acc[ai][bj][m][0] * rs, v1 = acc[ai][bj][m][1] * rs;
                        u32x4 w; w.x = cvt_pk_bf16(v0[0], v0[1]); w.y = cvt_pk_bf16(v0[2], v0[3]); w.z = cvt_pk_bf16(v1[0], v1[1]); w.w = cvt_pk_bf16(v1[2], v1[3]);
                        *(u32x4*)(p + bj * HALF) = w; } }
        } else if (u.pn < 42) {
            const int gt = u.pn - 18, col0 = gt * BM + wc * 32 + 8 * fq;
            const f32x4 b00 = *(const f32x4*)(gbias + col0), b01 = *(const f32x4*)(gbias + col0 + 4), b10 = *(const f32x4*)(gbias + col0 + HALF), b11 = *(const f32x4*)(gbias + col0 + HALF + 4);
            u32x4* gq = GQ + ((size_t)((gt >> 3) * (M / BM) + u.pm) * 8 + (gt & 7)) * 4096 + (wr * 4 + wc) * 512 + (fq * 16 + fr);
#pragma unroll
            for (int ai = 0; ai < 2; ++ai)
#pragma unroll
                for (int m = 0; m < 4; ++m) { const float rs = rsl[wr * 64 + fr + ai * HALF + m * 16];
                    u32x4 w; w.x = gate_q4(acc[ai][0][m][0] * rs + b00); w.y = gate_q4(acc[ai][0][m][1] * rs + b01); w.z = gate_q4(acc[ai][1][m][0] * rs + b10); w.w = gate_q4(acc[ai][1][m][1] * rs + b11);
                    gq[(ai * 4 + m) * 64] = w; }
        } else {
            if (wc == 0) {
#pragma unroll
                for (int ai = 0; ai < 2; ++ai)
#pragma unroll
                    for (int m = 0; m < 4; ++m) { float* p = LR + (size_t)(row0 + ai * HALF + m * 16) * 32 + 8 * fq; const float rs = rsl[wr * 64 + fr + ai * HALF + m * 16];
                        *(f32x4*)p = acc[ai][0][m][0] * rs; *(f32x4*)(p + 4) = acc[ai][0][m][1] * rs; }
            }
        }
    }
};
struct EpiMerge3 {
    static constexpr bool PERM = true, AFTER_DRAIN = false, HAS_MID = true, USES_RSTD = false;
    static constexpr int MID0 = 1024 / BK, MID1 = 1536 / BK;
    static constexpr size_t GSTRIDE = (size_t)(M / BM) * 8 * 4096;
    const u32x4* GQ; bf16_t* MG;
    __device__ __forceinline__ void mid(f32x4 (&acc)[2][2][4][2], const Unit& u, int seg, int wr, int wc, int fr, int fq) const {
        const u32x4* gp = GQ + (size_t)seg * GSTRIDE + ((size_t)u.pm * 8 + u.pn) * 4096 + (wr * 4 + wc) * 512 + (fq * 16 + fr);
        u32x4 gn[8], gd[8];
#pragma unroll
        for (int j = 0; j < 8; ++j) { gn[j] = gp[j * 64]; gd[j] = gp[GSTRIDE + j * 64]; }
#pragma unroll
        for (int j = 0; j < 8; ++j) { const int ai = j >> 2, m = j & 3;
            acc[ai][0][m][0] = acc[ai][0][m][0] * (ub4(gn[j].x) * rcp4(ub4(gd[j].x))); acc[ai][0][m][1] = acc[ai][0][m][1] * (ub4(gn[j].y) * rcp4(ub4(gd[j].y)));
            acc[ai][1][m][0] = acc[ai][1][m][0] * (ub4(gn[j].z) * rcp4(ub4(gd[j].z))); acc[ai][1][m][1] = acc[ai][1][m][1] * (ub4(gn[j].w) * rcp4(ub4(gd[j].w))); }
    }
    __device__ __forceinline__ void operator()(const f32x4 (&acc)[2][2][4][2], const Unit& u, int wr, int wc, int fr, int fq, const LAS float* rsl) const {
        const int row0 = u.pm * BM + wr * 64 + fr, col0 = u.pn * BM + wc * 32 + 8 * fq;
        const u32x4* gp = GQ + 2 * GSTRIDE + ((size_t)u.pm * 8 + u.pn) * 4096 + (wr * 4 + wc) * 512 + (fq * 16 + fr);
        u32x4 gc[8];
#pragma unroll
        for (int j = 0; j < 8; ++j) gc[j] = gp[j * 64];
        constexpr float S = 1.0f / 255.0f;
#pragma unroll
        for (int j = 0; j < 8; ++j) { const int ai = j >> 2, m = j & 3; bf16_t* p = MG + (size_t)(row0 + ai * HALF + m * 16) * D + col0;
            const f32x4 v0 = acc[ai][0][m][0] * (ub4(gc[j].x) * S), v1 = acc[ai][0][m][1] * (ub4(gc[j].y) * S), v2 = acc[ai][1][m][0] * (ub4(gc[j].z) * S), v3 = acc[ai][1][m][1] * (ub4(gc[j].w) * S);
            u32x4 w; w.x = cvt_pk_bf16(v0[0], v0[1]); w.y = cvt_pk_bf16(v0[2], v0[3]); w.z = cvt_pk_bf16(v1[0], v1[1]); w.w = cvt_pk_bf16(v1[2], v1[3]); *(u32x4*)p = w;
            w.x = cvt_pk_bf16(v2[0], v2[1]); w.y = cvt_pk_bf16(v2[2], v2[3]); w.z = cvt_pk_bf16(v3[0], v3[1]); w.w = cvt_pk_bf16(v3[2], v3[3]); *(u32x4*)(p + HALF) = w; }
    }
};

template <class Epi, class Sched, bool ALIGN_EPI = false, bool SP2 = false>
__device__ __forceinline__ void gemm_phase(LAS unsigned char* lds, const Gemm g, const Sched& S, const Epi& E) {
    const int tid = opaque_tid(), wid = __builtin_amdgcn_readfirstlane(tid >> 6), lane = tid & 63, wr = wid >> 2, wc = wid & 3, fr = lane & 15, fq = lane >> 4;
    const int K = g.K, nt = K / BK, lda = g.lda;
    unsigned voffA[2], voffB[2];
#pragma unroll
    for (int i = 0; i < 2; ++i) { int R, C; stage_rc(tid * 16 + i * 8192, R, C); const int Rb = Epi::PERM ? ((R & ~31) + perm32(R & 31)) : R;
        voffA[i] = (unsigned)(R * lda + C) * 2u; voffB[i] = (unsigned)(Rb * K + C) * 2u; }
    const unsigned kstep = (unsigned)(BK * 2);
    const unsigned hstepA = (unsigned)HALF * (unsigned)lda * 2u, hstepB = (unsigned)HALF * (unsigned)K * 2u;
    const unsigned tstepA = 2u * hstepA, tstepB = 2u * hstepB;
    const unsigned ldsw = (unsigned)wid * 1024u;
    const int aoff = lds_byte(wr * 64 + fr, fq * 8), boff = lds_byte(wc * 32 + fr, fq * 8);
    const char* const baseA = (const char*)g.A; const char* const baseB = (const char*)g.Bt;
#define PG8_SA(b, h) (((b) * 2 + (h)) * HTB)
#define PG8_SB(b, h) ((4 + (b) * 2 + (h)) * HTB)
#define PG8_STAGE(bufoff, gbase, goff, voff) do { _Pragma("unroll") for (int _i = 0; _i < 2; ++_i) \
        __builtin_amdgcn_global_load_lds((const unsigned*)((gbase) + (size_t)(unsigned)((goff) + (voff)[_i])), (LAS unsigned*)(lds + (bufoff) + ldsw + _i * 8192), 16, 0, 0); } while (0)
#define PG8_LDA(dst, b, h) do { _Pragma("unroll") for (int m = 0; m < 4; ++m) _Pragma("unroll") for (int k = 0; k < 2; ++k) dst[m][k] = *(const LAS bf16x8*)(lds + PG8_SA(b, h) + aoff + m * 2048 + k * 1024); } while (0)
#define PG8_LDB(dst, b, h) do { _Pragma("unroll") for (int n = 0; n < 2; ++n) _Pragma("unroll") for (int k = 0; k < 2; ++k) dst[n][k] = *(const LAS bf16x8*)(lds + PG8_SB(b, h) + boff + n * 2048 + k * 1024); } while (0)
#define PG8_MMA(ai, bj, At, Bt) do { __builtin_amdgcn_s_setprio(1); _Pragma("unroll") for (int m = 0; m < 4; ++m) _Pragma("unroll") for (int n = 0; n < 2; ++n) _Pragma("unroll") for (int k = 0; k < 2; ++k) \
        acc[ai][bj][m][n] = __builtin_amdgcn_mfma_f32_16x16x32_bf16(Bt[n][k], At[m][k], acc[ai][bj][m][n], 0, 0, 0); __builtin_amdgcn_s_setprio(0); } while (0)
#define PG8_WAIT_V(n) asm volatile("s_waitcnt vmcnt(" #n ")" ::: "memory")
#define PG8_WAIT_L(n) asm volatile("s_waitcnt lgkmcnt(" #n ")" ::: "memory")
#define PG8_BAR __builtin_amdgcn_s_barrier()
#define PG8_SCHED __builtin_amdgcn_sched_barrier(0)
    Unit cur, nxt; int ui = 0;
    if (!S.next(0, cur)) return;
    constexpr int RS_OFF = 131072 + 8192;
#define PG8_RSTD(u_, slot_) do { if constexpr (Epi::USES_RSTD) { if (wid == 0) __builtin_amdgcn_global_load_lds((const unsigned*)(E.rstd + (size_t)(u_).pm * BM + lane * 4), (LAS unsigned*)(lds + RS_OFF + (slot_) * 1024), 16, 0, 0); } } while (0)
    PG8_RSTD(cur, 0);
    f32x4 acc[2][2][4][2];
#pragma unroll
    for (int a = 0; a < 2; ++a)
#pragma unroll
        for (int b = 0; b < 2; ++b)
#pragma unroll
            for (int m = 0; m < 4; ++m)
#pragma unroll
                for (int n = 0; n < 2; ++n) acc[a][b][m][n] = (f32x4){0.f, 0.f, 0.f, 0.f};
    bf16x8 At[4][2], B0[2][2], B1[2][2];
    unsigned cA = (unsigned)cur.pm * tstepA, cB = (unsigned)cur.pn * tstepB;
    S.a_ready(cur);
    if constexpr (SP2) {
        PG8_STAGE(PG8_SB(0, 0), baseB, cB, voffB); PG8_STAGE(PG8_SB(0, 1), baseB, cB + hstepB, voffB); PG8_STAGE(PG8_SA(0, 0), baseA, cA, voffA); PG8_STAGE(PG8_SA(0, 1), baseA, cA + hstepA, voffA);
        if (wr == 1) PG8_BAR;
        PG8_WAIT_V(2); PG8_BAR;
        PG8_STAGE(PG8_SB(1, 0), baseB, cB + kstep, voffB); PG8_STAGE(PG8_SA(1, 0), baseA, cA + kstep, voffA); PG8_STAGE(PG8_SB(1, 1), baseB, cB + hstepB + kstep, voffB);
        PG8_WAIT_V(6); PG8_BAR;
    } else {
        PG8_STAGE(PG8_SB(0, 0), baseB, cB, voffB); PG8_STAGE(PG8_SA(0, 0), baseA, cA, voffA); PG8_STAGE(PG8_SB(0, 1), baseB, cB + hstepB, voffB); PG8_STAGE(PG8_SA(0, 1), baseA, cA + hstepA, voffA);
        if (wr == 1) PG8_BAR;
        PG8_WAIT_V(4); PG8_BAR;
        PG8_STAGE(PG8_SB(1, 0), baseB, cB + kstep, voffB); PG8_STAGE(PG8_SA(1, 0), baseA, cA + kstep, voffA); PG8_STAGE(PG8_SB(1, 1), baseB, cB + hstepB + kstep, voffB);
        PG8_WAIT_V(6); PG8_BAR;
    }
    for (;;) {
        const bool has_next = S.next(ui + 1, nxt);
        const unsigned nA = has_next ? (unsigned)nxt.pm * tstepA : cA, nB = has_next ? (unsigned)nxt.pn * tstepB : cB;
        for (int t = 0; t < nt; t += 2) {
            const bool last = (t == nt - 2);
            if constexpr (Epi::HAS_MID) { if (t == Epi::MID0 || t == Epi::MID1) E.mid(acc, cur, t == Epi::MID0 ? 0 : 1, wr, wc, fr, fq); }
            const unsigned a1 = cA + (unsigned)(t + 1) * kstep;
            const unsigned a2 = last ? nA : cA + (unsigned)(t + 2) * kstep, b2 = last ? nB : cB + (unsigned)(t + 2) * kstep;
            const unsigned a3 = a2 + kstep, b3 = b2 + kstep;
            if (last && has_next) S.a_ready(nxt);
            if constexpr (SP2) {
            PG8_LDB(B0, 0, 0); PG8_LDB(B1, 0, 1); PG8_SCHED; PG8_LDA(At, 0, 0); PG8_STAGE(PG8_SA(1, 1), baseA, a1 + hstepA, voffA);
            PG8_WAIT_V(8); PG8_WAIT_L(0); PG8_BAR; PG8_MMA(0, 0, At, B0); PG8_MMA(0, 1, At, B1); PG8_BAR; PG8_SCHED;
            PG8_LDA(At, 0, 1); PG8_STAGE(PG8_SB(0, 0), baseB, b2, voffB); PG8_STAGE(PG8_SB(0, 1), baseB, b2 + hstepB, voffB); PG8_STAGE(PG8_SA(0, 0), baseA, a2, voffA);
            PG8_WAIT_V(8); PG8_WAIT_L(0); PG8_BAR; PG8_MMA(1, 0, At, B0); PG8_MMA(1, 1, At, B1); PG8_BAR; PG8_SCHED;
            PG8_LDB(B0, 1, 0); PG8_LDB(B1, 1, 1); PG8_SCHED; PG8_LDA(At, 1, 0); PG8_STAGE(PG8_SA(0, 1), baseA, a2 + hstepA, voffA);
            PG8_WAIT_V(8); PG8_WAIT_L(0); PG8_BAR; PG8_MMA(0, 0, At, B0); PG8_MMA(0, 1, At, B1); PG8_BAR; PG8_SCHED;
            PG8_LDA(At, 1, 1); PG8_STAGE(PG8_SB(1, 0), baseB, b3, voffB); PG8_STAGE(PG8_SB(1, 1), baseB, b3 + hstepB, voffB); PG8_STAGE(PG8_SA(1, 0), baseA, a3, voffA);
            PG8_WAIT_V(8); PG8_WAIT_L(0); PG8_BAR; PG8_MMA(1, 0, At, B0); PG8_MMA(1, 1, At, B1); PG8_BAR; PG8_SCHED;
            } else {
            PG8_LDB(B0, 0, 0); PG8_SCHED; PG8_LDA(At, 0, 0); PG8_STAGE(PG8_SA(1, 1), baseA, a1 + hstepA, voffA);
            PG8_WAIT_L(8); PG8_BAR; PG8_WAIT_L(0); PG8_MMA(0, 0, At, B0); PG8_BAR; PG8_SCHED;
            PG8_LDB(B1, 0, 1); PG8_STAGE(PG8_SB(0, 0), baseB, b2, voffB);
            PG8_BAR; PG8_WAIT_L(0); PG8_MMA(0, 1, At, B1); PG8_BAR;
            PG8_LDA(At, 0, 1); PG8_STAGE(PG8_SA(0, 0), baseA, a2, voffA);
            PG8_BAR; PG8_WAIT_L(0); PG8_MMA(1, 0, At, B0); PG8_BAR; PG8_SCHED;
            PG8_STAGE(PG8_SB(0, 1), baseB, b2 + hstepB, voffB);
            PG8_WAIT_V(6); PG8_BAR; PG8_MMA(1, 1, At, B1); PG8_BAR;
            PG8_LDB(B0, 1, 0); PG8_SCHED; PG8_LDA(At, 1, 0); PG8_STAGE(PG8_SA(0, 1), baseA, a2 + hstepA, voffA);
            PG8_WAIT_L(8); PG8_BAR; PG8_WAIT_L(0); PG8_MMA(0, 0, At, B0); PG8_BAR; PG8_SCHED;
            PG8_LDB(B1, 1, 1); PG8_STAGE(PG8_SB(1, 0), baseB, b3, voffB);
            PG8_BAR; PG8_WAIT_L(0); PG8_MMA(0, 1, At, B1); PG8_BAR;
            PG8_LDA(At, 1, 1); PG8_STAGE(PG8_SA(1, 0), baseA, a3, voffA);
            PG8_BAR; PG8_WAIT_L(0); PG8_MMA(1, 0, At, B0); PG8_BAR; PG8_SCHED;
            PG8_STAGE(PG8_SB(1, 1), baseB, b3 + hstepB, voffB);
            PG8_WAIT_V(6); PG8_BAR; PG8_MMA(1, 1, At, B1); PG8_BAR;
            }
        }
        if constexpr (ALIGN_EPI) { if (wr == 0) PG8_BAR; }
        if constexpr (!Epi::AFTER_DRAIN) { E(acc, cur, wr, wc, fr, fq, (const LAS float*)(lds + RS_OFF + (ui & 1) * 1024)); S.done(cur); }
        if (!has_next) break;
#pragma unroll
        for (int a = 0; a < 2; ++a)
#pragma unroll
            for (int b = 0; b < 2; ++b)
#pragma unroll
                for (int m = 0; m < 4; ++m)
#pragma unroll
                    for (int n = 0; n < 2; ++n) acc[a][b][m][n] = (f32x4){0.f, 0.f, 0.f, 0.f};
        cur = nxt; cA = nA; cB = nB; ++ui;
        PG8_RSTD(cur, ui & 1);
        if constexpr (ALIGN_EPI) { if (wr == 1) PG8_BAR; }
    }
    PG8_WAIT_V(0);
    if constexpr (!ALIGN_EPI) { if (wr == 0) PG8_BAR; }
    PG8_BAR;
#undef PG8_SA
#undef PG8_SB
#undef PG8_STAGE
#undef PG8_LDA
#undef PG8_LDB
#undef PG8_MMA
#undef PG8_WAIT_V
#undef PG8_WAIT_L
#undef PG8_BAR
#undef PG8_SCHED
}
}

namespace att {
constexpr int DH = 128, NW = 8, QBLK = 32, KVBLK = 64;
constexpr float SCALE = 0.088388347648318440f;
constexpr float THR = 8.f;
constexpr int LD = NPROJ, LDO = 2048;
constexpr size_t SHM_V = KVBLK * DH * 2, SHM_K = KVBLK * DH * 2, SHM_ATTN = 2 * SHM_V + 2 * SHM_K + NW * 64 * 4;
#define KSWZ(row, colB) ((row) * 256 + ((colB) ^ (((row) & 7) << 4)))
#define SBAR() __builtin_amdgcn_sched_barrier(0)
__device__ __forceinline__ int crow(int r, int hi) { return (r & 3) + 8 * (r >> 2) + 4 * hi; }
__device__ __forceinline__ void partialSM(f32x16& p0, f32x16& p1, float& m_reg, float& mn, float& alpha) {
  constexpr float C = SCALE * 1.4426950408889634f;
  float pmax = p0[0];
#pragma unroll
  for (int r = 1; r < 16; ++r) pmax = fmaxf(pmax, p0[r]);
#pragma unroll
  for (int r = 0; r < 16; ++r) pmax = fmaxf(pmax, p1[r]);
  { auto rr = __builtin_amdgcn_permlane32_swap(__float_as_uint(pmax), __float_as_uint(pmax), false, false);
    pmax = fmaxf(__uint_as_float(rr[0]), __uint_as_float(rr[1])); }
  if (__builtin_expect(__all(pmax - m_reg <= THR / SCALE), 1)) { mn = m_reg; alpha = 1.f; }
  else { mn = fmaxf(m_reg, pmax); alpha = __builtin_amdgcn_exp2f((m_reg - mn) * C); m_reg = mn; }
  float mnC = -mn * C;
#pragma unroll
  for (int r = 0; r < 16; ++r) p0[r] = fmaf(p0[r], C, mnC);
#pragma unroll
  for (int r = 0; r < 16; ++r) p1[r] = fmaf(p1[r], C, mnC);
#pragma unroll
  for (int r = 0; r < 16; ++r) p0[r] = __builtin_amdgcn_exp2f(p0[r]);
}
__device__ __forceinline__ void finishSM(f32x16& p0, f32x16& p1, float alpha, float& l_reg, bf16x8& pa0, bf16x8& pa1, bf16x8& pa2, bf16x8& pa3) {
#pragma unroll
  for (int r = 0; r < 16; ++r) p1[r] = __builtin_amdgcn_exp2f(p1[r]);
  float ps = 0;
#pragma unroll
  for (int r = 0; r < 16; ++r) ps += p0[r];
#pragma unroll
  for (int r = 0; r < 16; ++r) ps += p1[r];
  { auto rr = __builtin_amdgcn_permlane32_swap(__float_as_uint(ps), __float_as_uint(ps), false, false);
    ps = __uint_as_float(rr[0]) + __uint_as_float(rr[1]); }
  l_reg = l_reg * alpha + ps;
#define PK4(P, BASE, OUT) do { unsigned a0 = cvt_pk_bf16(P[BASE + 0], P[BASE + 1]), a1 = cvt_pk_bf16(P[BASE + 2], P[BASE + 3]);   \
    unsigned b0 = cvt_pk_bf16(P[BASE + 4], P[BASE + 5]), b1 = cvt_pk_bf16(P[BASE + 6], P[BASE + 7]);                              \
    auto r0 = __builtin_amdgcn_permlane32_swap(a0, b0, false, false); auto r1 = __builtin_amdgcn_permlane32_swap(a1, b1, false, false); \
    u32x4 w = {r0[0], r1[0], r0[1], r1[1]}; OUT = *reinterpret_cast<bf16x8*>(&w); } while (0)
  PK4(p0, 0, pa0); PK4(p0, 8, pa1); PK4(p1, 0, pa2); PK4(p1, 8, pa3);
#undef PK4
}
__device__ __forceinline__ void qkt(f32x16& p0, f32x16& p1, const bf16_t* Ks, const bf16x8* qr, int r32, int hi) {
  p0 = f32x16{}; p1 = f32x16{};
#pragma unroll
  for (int d0 = 0; d0 < 8; ++d0) { int cb = (d0 * 16 + hi * 8) * 2;
    bf16x8 b0 = *reinterpret_cast<const bf16x8*>((const char*)Ks + KSWZ(r32, cb));
    bf16x8 b1 = *reinterpret_cast<const bf16x8*>((const char*)Ks + KSWZ(32 + r32, cb));
    p0 = __builtin_amdgcn_mfma_f32_32x32x16_bf16(b0, qr[d0], p0, 0, 0, 0);
    p1 = __builtin_amdgcn_mfma_f32_32x32x16_bf16(b1, qr[d0], p1, 0, 0, 0); }
}
__device__ __forceinline__ int v_st(int k, int c) { const int kk = (k & ~0xC) | ((k & 4) << 1) | ((k & 8) >> 1); return ((kk >> 3) * 4 + (c >> 5)) * 512 + ((kk & 7) * 32 + (c & 31)) * 2; }
__device__ __forceinline__ int v_rd_base(int lane) { return ((lane & 3) << 3) | (((lane >> 2) & 3) << 6) | (((lane >> 4) & 1) << 5) | (((lane >> 5) & 1) << 8); }
constexpr int v_rd_off(int d0, int ks, int half) { return d0 * 512 + ks * 4096 + half * 2048; }
template <int OFF> __device__ __forceinline__ s16x4 tr_read(int vb) {
  s16x4 r; asm volatile("ds_read_b64_tr_b16 %0, %1 offset:%2" : "=&v"(r) : "v"(vb), "i"(OFF) : "memory"); return r;
}
template <int D0> __device__ __forceinline__ void pv_one(f32x16& od, int vb, bf16x8 pa0, bf16x8 pa1, bf16x8 pa2, bf16x8 pa3) {
  const s16x4 l0 = tr_read<v_rd_off(D0, 0, 0)>(vb), h0 = tr_read<v_rd_off(D0, 0, 1)>(vb), l1 = tr_read<v_rd_off(D0, 1, 0)>(vb), h1 = tr_read<v_rd_off(D0, 1, 1)>(vb);
  const s16x4 l2 = tr_read<v_rd_off(D0, 2, 0)>(vb), h2 = tr_read<v_rd_off(D0, 2, 1)>(vb), l3 = tr_read<v_rd_off(D0, 3, 0)>(vb), h3 = tr_read<v_rd_off(D0, 3, 1)>(vb);
  asm volatile("s_waitcnt lgkmcnt(0)" ::: "memory"); SBAR();
#define PK(L, H) (bf16x8){L[0], L[1], L[2], L[3], H[0], H[1], H[2], H[3]}
  od = __builtin_amdgcn_mfma_f32_32x32x16_bf16(pa0, PK(l0, h0), od, 0, 0, 0);
  od = __builtin_amdgcn_mfma_f32_32x32x16_bf16(pa1, PK(l1, h1), od, 0, 0, 0);
  od = __builtin_amdgcn_mfma_f32_32x32x16_bf16(pa2, PK(l2, h2), od, 0, 0, 0);
  od = __builtin_amdgcn_mfma_f32_32x32x16_bf16(pa3, PK(l3, h3), od, 0, 0, 0);
#undef PK
}
__device__ __forceinline__ void pv_d0(f32x16* o, int vb, bf16x8 pa0, bf16x8 pa1, bf16x8 pa2, bf16x8 pa3) {
  pv_one<0>(o[0], vb, pa0, pa1, pa2, pa3); pv_one<1>(o[1], vb, pa0, pa1, pa2, pa3); pv_one<2>(o[2], vb, pa0, pa1, pa2, pa3); pv_one<3>(o[3], vb, pa0, pa1, pa2, pa3);
}
__device__ __forceinline__ void attn_dense_body(const bf16_t* Qb, const bf16_t* __restrict__ Kh, const bf16_t* __restrict__ Vh, bf16_t* Ob, int seq, char* lds) {
  const int tid = opaque_tid(), wid = tid >> 6, lane = tid & 63, r32 = lane & 31, hi = lane >> 5;
  bf16_t* V_lds = (bf16_t*)lds; bf16_t* K_lds = (bf16_t*)(lds + 2 * SHM_V);
  float* ws = (float*)(lds + 2 * SHM_V + 2 * SHM_K) + wid * 64; float* li_l = ws; float* al_l = ws + 32;
  float m_reg = -1e30f, l_reg = 0; f32x16 o[4] = {}; bf16x8 qr[8];
  const bf16_t* Qw = Qb + (long)(wid * QBLK + r32) * LD + hi * 8;
#pragma unroll
  for (int d0 = 0; d0 < 8; ++d0) qr[d0] = *reinterpret_cast<const bf16x8*>(Qw + d0 * 16);
  const int sr = tid >> 4, sc = (tid & 15) * 8, vst0 = v_st(sr, sc), vst1 = v_st(32 + sr, sc);
  const int vb0 = (int)(uintptr_t)V_lds + v_rd_base(lane);
  struct { bf16x8 vs0, vs1, ks0, ks1; } sr_[1];
#define SLOAD(i, k0) do { sr_[i].vs0 = *reinterpret_cast<const bf16x8*>(&Vh[(long)((k0) + sr) * LD + sc]); sr_[i].vs1 = *reinterpret_cast<const bf16x8*>(&Vh[(long)((k0) + 32 + sr) * LD + sc]); \
    sr_[i].ks0 = *reinterpret_cast<const bf16x8*>(&Kh[(long)((k0) + sr) * LD + sc]); sr_[i].ks1 = *reinterpret_cast<const bf16x8*>(&Kh[(long)((k0) + 32 + sr) * LD + sc]); } while (0)
#define SWRITE(b, i) do { *(bf16x8*)((char*)V_lds + (b) * SHM_V + vst0) = sr_[i].vs0;          \
    *(bf16x8*)((char*)V_lds + (b) * SHM_V + vst1) = sr_[i].vs1; int kc = sc * 2;               \
    *(bf16x8*)((char*)K_lds + (b) * SHM_K + KSWZ(sr, kc)) = sr_[i].ks0;                       \
    *(bf16x8*)((char*)K_lds + (b) * SHM_K + KSWZ(32 + sr, kc)) = sr_[i].ks1; } while (0)
#define SWAIT() asm volatile("s_waitcnt vmcnt(0)" ::: "memory")
#define RESC(a) do { if (__any((a) < 1.f)) { if (hi == 0) al_l[r32] = (a); asm volatile("s_waitcnt lgkmcnt(0)" ::: "memory"); \
    _Pragma("unroll") for (int d = 0; d < 4; ++d) _Pragma("unroll") for (int r = 0; r < 16; ++r) o[d][r] *= al_l[crow(r, hi)]; } } while (0)
  f32x16 pA0, pA1, pB0, pB1; float mnA, mnB, alA, alB; bf16x8 pa0, pa1, pa2, pa3; const int NT = seq / KVBLK;
  constexpr int SE = 0, SO = 0;
  SLOAD(SE, 0); asm volatile("s_waitcnt vmcnt(0)" ::: "memory"); SWRITE(0, SE); __syncthreads();
  qkt(pA0, pA1, K_lds, qr, r32, hi); partialSM(pA0, pA1, m_reg, mnA, alA);
  SLOAD(SO, KVBLK);
  SWAIT(); SWRITE(1, SO); __syncthreads();
  for (int j = 1; j + 1 < NT; j += 2) {
    SBAR(); qkt(pB0, pB1, (bf16_t*)((char*)K_lds + SHM_K), qr, r32, hi);
    finishSM(pA0, pA1, alA, l_reg, pa0, pa1, pa2, pa3); SBAR();
    SLOAD(SO, (j + 1) * KVBLK); SBAR();
    pv_d0(o, vb0, pa0, pa1, pa2, pa3); partialSM(pB0, pB1, m_reg, mnB, alB);
    __syncthreads(); SWAIT(); SWRITE(0, SE);
    RESC(alB); __syncthreads();
    SBAR(); qkt(pA0, pA1, K_lds, qr, r32, hi);
    finishSM(pB0, pB1, alB, l_reg, pa0, pa1, pa2, pa3); SBAR();
    SLOAD(SE, (j + 2) * KVBLK); SBAR();
    pv_d0(o, vb0 + (int)SHM_V, pa0, pa1, pa2, pa3); partialSM(pA0, pA1, m_reg, mnA, alA);
    __syncthreads(); SWAIT(); SWRITE(1, SO);
    RESC(alA); __syncthreads();
  }
  SBAR(); qkt(pB0, pB1, (bf16_t*)((char*)K_lds + SHM_K), qr, r32, hi);
  finishSM(pA0, pA1, alA, l_reg, pa0, pa1, pa2, pa3); SBAR();
  pv_d0(o, vb0, pa0, pa1, pa2, pa3); partialSM(pB0, pB1, m_reg, mnB, alB);
  __syncthreads(); RESC(alB);
  finishSM(pB0, pB1, alB, l_reg, pa0, pa1, pa2, pa3); SBAR();
  pv_d0(o, vb0 + (int)SHM_V, pa0, pa1, pa2, pa3);
  if (hi == 0) li_l[r32] = l_reg; asm volatile("s_waitcnt lgkmcnt(0)" ::: "memory");
  float rli[16];
#pragma unroll
  for (int r = 0; r < 16; ++r) rli[r] = __builtin_amdgcn_rcpf(li_l[crow(r, hi)]);
  bf16_t* Ow = Ob + (long)(wid * QBLK) * LDO;
#pragma unroll
  for (int r = 0; r < 16; ++r) { int orow = crow(r, hi);
#pragma unroll
    for (int d0 = 0; d0 < 4; ++d0) Ow[(long)orow * LDO + d0 * 32 + r32] = f2bf(o[d0][r] * rli[r]); }
  __syncthreads();
#undef SLOAD
#undef SWRITE
#undef SWAIT
#undef RESC
}
}

constexpr int RING_BYTES = 131072;
constexpr int LDSCTL_OFF = RING_BYTES, MISC_OFF = LDSCTL_OFF + 320, PTAB_OFF = LDSCTL_OFF + 1024;
constexpr int LDS_BYTES = 147456;

#define XB_TMO      128
#define XB_XCNT(j)  (256  + 64 * (j))
#define XB_XSUB(j)  (1280 + 64 * (j))
#define XB_XGEN(j)  (2304 + 64 * (j))
#define XB_TOP      3328
#define XB_TOPGEN   3392
#define XCD_BAR_WORDS 3456
#define XB_SPIN_CAP (1u << 22)
__device__ __forceinline__ unsigned xb_ld(unsigned* p)              { return __hip_atomic_load(p, __ATOMIC_RELAXED, __HIP_MEMORY_SCOPE_AGENT); }
__device__ __forceinline__ unsigned xb_add(unsigned* p, unsigned v) { return __hip_atomic_fetch_add(p, v, __ATOMIC_RELAXED, __HIP_MEMORY_SCOPE_AGENT); }
__device__ __forceinline__ unsigned xb_xcc_id() { return (unsigned)__builtin_amdgcn_s_getreg((3 << 11) | 20) & 0xFu; }
#define XB_SPIN(cond, bar) do { unsigned _sp = 0; while (cond) { __builtin_amdgcn_s_sleep(1); \
    if ((++_sp & 255u) == 0u) { if (xb_ld(&(bar)[XB_TMO])) break; if (_sp > XB_SPIN_CAP) { atomicAdd(&(bar)[XB_TMO], 1u); break; } } } } while (0)
struct XcdBarrier { unsigned* bar; unsigned x; volatile LAS unsigned* st; };
__device__ __forceinline__ XcdBarrier xcd_barrier_post(unsigned* bar, volatile LAS unsigned* st) {
    XcdBarrier b; b.bar = bar; b.x = xb_xcc_id(); b.st = st;
    if (threadIdx.x == 0) (void)xb_add(&bar[XB_XCNT(b.x)], 1u);
    return b;
}
__device__ __forceinline__ void xcd_barrier_complete(unsigned* bar, unsigned x, unsigned& nloc, unsigned& nx) {
    const unsigned G = gridDim.x * gridDim.y * gridDim.z;
    unsigned sum, cnt, mine, sp = 0u;
    for (;;) {
        sum = 0u; cnt = 0u;
        for (unsigned j = 0; j < 16; ++j) { const unsigned c = xb_ld(&bar[XB_XCNT(j)]); sum += c; cnt += (c > 0u) ? 1u : 0u; }
        mine = xb_ld(&bar[XB_XCNT(x)]);
        if (sum == G) break;
        __builtin_amdgcn_s_sleep(1);
        if ((++sp & 255u) == 0u) { if (xb_ld(&bar[XB_TMO])) break; if (sp > XB_SPIN_CAP) { atomicAdd(&bar[XB_TMO], 1u); break; } }
    }
    nloc = mine > 0u ? mine : 1u; nx = cnt > 0u ? cnt : 1u;
}
__device__ __forceinline__ XcdBarrier xcd_barrier_setup(unsigned* bar, volatile LAS unsigned* st) {
    XcdBarrier b = xcd_barrier_post(bar, st);
    if (threadIdx.x == 0) { unsigned nloc, nx; xcd_barrier_complete(bar, b.x, nloc, nx); st[0] = nloc; st[1] = nx; }
    __syncthreads();
    return b;
}
__device__ __forceinline__ void xcd_barrier(const XcdBarrier& b) {
    asm volatile("s_waitcnt vmcnt(0)" ::: "memory");
    __syncthreads();
    if (threadIdx.x == 0) {
        unsigned* bar = b.bar; unsigned bx = b.x;
        asm volatile("" : "+s"(bar), "+s"(bx));
        __builtin_amdgcn_s_waitcnt(0);
        const unsigned nloc = b.st[0], nx = b.st[1];
        const unsigned old = xb_add(&bar[XB_XSUB(bx)], 1u);
        const unsigned gen = old / nloc;
        if (old + 1u == (gen + 1u) * nloc) {
            __builtin_amdgcn_fence(__ATOMIC_RELEASE, "agent");
            asm volatile("s_waitcnt vmcnt(0)" ::: "memory");
            const unsigned og = xb_add(&bar[XB_TOP], 1u);
            const unsigned tg = og / nx;
            if (og + 1u == (tg + 1u) * nx) xb_add(&bar[XB_TOPGEN], 1u);
            else XB_SPIN(xb_ld(&bar[XB_TOPGEN]) == tg, bar);
            __builtin_amdgcn_fence(__ATOMIC_ACQUIRE, "agent");
            xb_add(&bar[XB_XGEN(bx)], 1u);
            asm volatile("s_waitcnt vmcnt(0)" ::: "memory");
        } else {
            XB_SPIN(xb_ld(&bar[XB_XGEN(bx)]) == gen, bar);
            __builtin_amdgcn_fence(__ATOMIC_ACQUIRE, "agent");
            asm volatile("s_waitcnt vmcnt(0)" ::: "memory");
        }
    }
    __syncthreads();
}

__device__ __forceinline__ void transpose_item(const float* W, int ldw, int K, int k0, int srccol0, bf16_t* WT, int dstrow0, LAS float* scr, int lane, const float* kgain = nullptr, int ldt = 0) {
    const int KT = ldt ? ldt : K;
    constexpr int P = 36;
    const int n4 = (lane & 7) * 4, kr = lane >> 3;
    f32x4 v[8];
    if (srccol0 >= 0) {
#pragma unroll
        for (int i = 0; i < 8; ++i) v[i] = *(const f32x4*)(W + (size_t)(k0 + 8 * i + kr) * ldw + srccol0 + n4);
        if (kgain) {
#pragma unroll
            for (int i = 0; i < 8; ++i) v[i] = v[i] * kgain[k0 + 8 * i + kr];
        }
    } else {
#pragma unroll
        for (int i = 0; i < 8; ++i) v[i] = (f32x4){0.f, 0.f, 0.f, 0.f};
    }
#pragma unroll
    for (int i = 0; i < 8; ++i) *(LAS f32x4*)(scr + (8 * i + kr) * P + n4) = v[i];
    LDS_WAIT(); asm volatile("" ::: "memory");
    const int c = lane & 7;
#pragma unroll
    for (int j = 0; j < 4; ++j) { const int n = (lane >> 3) + 8 * j; const LAS float* s = scr + (8 * c) * P + n;
        u32x4 o; o.x = cvt_pk_bf16(s[0 * P], s[1 * P]); o.y = cvt_pk_bf16(s[2 * P], s[3 * P]); o.z = cvt_pk_bf16(s[4 * P], s[5 * P]); o.w = cvt_pk_bf16(s[6 * P], s[7 * P]);
        *(u32x4*)(WT + (size_t)(dstrow0 + n) * KT + k0 + 8 * c) = o; }
    LDS_WAIT(); asm volatile("" ::: "memory");
}
struct LayerW { const float *w_in, *w_bra, *w_brb, *w_brc, *w_out, *f1i, *f1o, *f2i, *f2o, *ng; };
__device__ __forceinline__ void phase_weights(const LayerW& w, unsigned char* ws, LAS unsigned char* lds, int gw, int NGW, int wave, int lane) {
    LAS float* scr = (LAS float*)(lds + wave * 16384);
    constexpr int I_IN = (NIN_PAD / 32) * (D / 64);
    constexpr int I_FI = (2 * FF / 32) * (D / 64);
    constexpr int I_FO = (D / 32) * (FF / 64);
    constexpr int I_BA = (D / 32) * (1024 / 64);
    constexpr int I_BB = (D / 32) * (512 / 64);
    constexpr int I_WO = (D / 32) * (D / 64);
    constexpr int NITEMS = I_IN + 2 * I_FI + 2 * I_FO + I_BA + 2 * I_BB + I_WO;
    for (int it = gw; it < NITEMS; it += NGW) {
        int r = it;
        if (r < I_IN) { const int nb = r % (NIN_PAD / 32), kb = r / (NIN_PAD / 32); const int d0 = nb * 32;
            const int src = d0 < 4608 ? d0 : (d0 < 10752 ? d0 + 32 : (d0 < 10784 ? 4608 + (d0 - 10752) : -1));
            transpose_item(w.w_in, NIN, D, kb * 64, src, (bf16_t*)(ws + WS_WIN), d0, scr, lane, w.ng + 2 * D); continue; } r -= I_IN;
        if (r < 2 * I_FI) { const int which = r / I_FI; r -= which * I_FI; const int nb = r % (2 * FF / 32), kb = r / (2 * FF / 32); const int d0 = nb * 32;
            const int t = d0 >> 8, within = d0 & 255; const int src = within < 128 ? 128 * t + within : FF + 128 * t + (within - 128);
            transpose_item(which ? w.f2i : w.f1i, 2 * FF, D, kb * 64, src, (bf16_t*)(ws + (which ? WS_WF2I : WS_WF1I)), d0, scr, lane, w.ng + (which ? 4 * D : 0)); continue; } r -= 2 * I_FI;
        if (r < 2 * I_FO) { const int which = r / I_FO; r -= which * I_FO; const int nb = r % (D / 32), kb = r / (D / 32);
            transpose_item(which ? w.f2o : w.f1o, D, FF, kb * 64, nb * 32, (bf16_t*)(ws + (which ? WS_WF2O : WS_WF1O)), nb * 32, scr, lane); continue; } r -= 2 * I_FO;
        if (r < I_BA) { const int nb = r % (D / 32), kb = r / (D / 32);
            transpose_item(w.w_bra, D, 1024, kb * 64, nb * 32, (bf16_t*)(ws + WS_WBRA), nb * 32, scr, lane, nullptr, LDOM); continue; } r -= I_BA;
        if (r < 2 * I_BB) { const int which = r / I_BB; r -= which * I_BB; const int nb = r % (D / 32), kb = r / (D / 32);
            transpose_item(which ? w.w_brc : w.w_brb, D, 512, kb * 64, nb * 32, (bf16_t*)(ws + WS_WBRA) + (which ? OM_C : OM_B), nb * 32, scr, lane, nullptr, LDOM); continue; } r -= 2 * I_BB;
        { const int nb = r % (D / 32), kb = r / (D / 32);
            transpose_item(w.w_out, D, D, kb * 64, nb * 32, (bf16_t*)(ws + WS_WOUT), nb * 32, scr, lane); }
    }
}
__device__ __forceinline__ void phase_norm(bf16_t* XB, const bf16_t* Y, float* RSTD, float* OUT, const float* gpost, float coef, int gw, int NGW, int lane) {
    for (int m = gw; m < M; m += NGW) {
        const u32x2* xr = (const u32x2*)(XB + (size_t)m * D) + lane; const u32x2* yr = (const u32x2*)(Y + (size_t)m * D) + lane;
        f32x4 x[8], y[8]; float s = 0.f;
#pragma unroll
        for (int j = 0; j < 8; ++j) { const u32x2 t = yr[64 * j], q = xr[64 * j]; y[j] = (f32x4){bflo(t.x), bfhi(t.x), bflo(t.y), bfhi(t.y)}; x[j] = (f32x4){bflo(q.x), bfhi(q.x), bflo(q.y), bfhi(q.y)};
            s += (y[j].x * y[j].x + y[j].y * y[j].y) + (y[j].z * y[j].z + y[j].w * y[j].w); }
        const float rstd = coef * (1.0f / sqrtf(wave_sum(s) * (1.0f / D) + EPS));
        float s2 = 0.f;
#pragma unroll
        for (int j = 0; j < 8; ++j) { const f32x4 g = ((const f32x4*)gpost)[lane + 64 * j]; x[j] = x[j] + y[j] * g * rstd; s2 += (x[j].x * x[j].x + x[j].y * x[j].y) + (x[j].z * x[j].z + x[j].w * x[j].w); }
        if (OUT) { f32x4* xo = (f32x4*)(OUT + (size_t)m * D) + lane;
#pragma unroll
            for (int j = 0; j < 8; ++j) xo[64 * j] = x[j];
        } else {
            u32x2* o8 = (u32x2*)(XB + (size_t)m * D) + lane;
#pragma unroll
            for (int j = 0; j < 8; ++j) { u32x2 w; w.x = cvt_pk_bf16(x[j].x, x[j].y); w.y = cvt_pk_bf16(x[j].z, x[j].w); o8[64 * j] = w; }
            const float r2 = 1.0f / sqrtf(wave_sum(s2) * (1.0f / D) + EPS);
            if (lane == 0) RSTD[m] = r2;
        }
    }
}
__device__ __forceinline__ void phase_prep(bf16_t* PROJ, const float* qk_gain  , LAS unsigned char* lds, int gw, int NGW, int tid, int lane) {
    LAS f32x2* cs = (LAS f32x2*)lds;
    for (int i = tid; i < 2048; i += 512) { const int pos = i >> 5, mi = i & 31; const float inv = powf(10000.0f, -(float)mi / 32.0f); float s, c; sincosf((float)pos * inv, &s, &c); cs[i] = (f32x2){c, s}; }
    __syncthreads();
    const float gq0 = qk_gain[2 * lane], gq1 = qk_gain[2 * lane + 1], gk0 = qk_gain[128 + 2 * lane], gk1 = qk_gain[128 + 2 * lane + 1];
    for (int m = gw; m < M; m += NGW) {
        const int t = m & (SEQ - 1), pr = t >> 6, pc = t & 63;
        const f32x2 c_s = cs[((lane < 32) ? pr : pc) * 32 + (lane & 31)];
        unsigned* row = (unsigned*)(PROJ + (size_t)m * NPROJ);
        unsigned v[10];
#pragma unroll
        for (int h = 0; h < 10; ++h) v[h] = row[h * 64 + lane];
#pragma unroll
        for (int h = 0; h < 10; ++h) {
            const float x1 = bflo(v[h]), x2 = bfhi(v[h]);
            const float rstd = 1.0f / sqrtf(wave_sum(x1 * x1 + x2 * x2) * (1.0f / 128.0f) + EPS);
            const float n1 = x1 * rstd * (h < 8 ? gq0 : gk0), n2 = x2 * rstd * (h < 8 ? gq1 : gk1);
            row[h * 64 + lane] = cvt_pk_bf16(n1 * c_s.x - n2 * c_s.y, n1 * c_s.y + n2 * c_s.x);
        }
    }
    __syncthreads();
}
__device__ __forceinline__ void tr_pair(unsigned base, int pitch, int row0, int col0, int lane, s16x4& lo, s16x4& hi) {
    const int g = lane >> 4, i = lane & 15;
    const unsigned addr = base + (unsigned)((row0 + 4 * g + (i >> 2)) * pitch + (col0 + 4 * (i & 3)) * 2);
    asm volatile("ds_read_b64_tr_b16 %0, %1" : "=&v"(lo) : "v"(addr) : "memory");
    asm volatile("ds_read_b64_tr_b16 %0, %1" : "=&v"(hi) : "v"(addr + (unsigned)(16 * pitch)) : "memory");
}
#define TR_JOIN(L, H) ((bf16x8){L[0], L[1], L[2], L[3], H[0], H[1], H[2], H[3]})
__device__ __forceinline__ bf16x8 pack8(const float* x) { u32x4 w; w.x = cvt_pk_bf16(x[0], x[1]); w.y = cvt_pk_bf16(x[2], x[3]); w.z = cvt_pk_bf16(x[4], x[5]); w.w = cvt_pk_bf16(x[6], x[7]); return *reinterpret_cast<bf16x8*>(&w); }
__device__ __forceinline__ void na_unit(const bf16_t* PROJ, bf16_t* OB  , LAS unsigned char* lds, int u) {
    const int tid = opaque_tid(), lane = tid & 63, w = __builtin_amdgcn_readfirstlane(tid >> 6);
    constexpr int PV = 272, O_V = 0, O_RPB = 2 * 64 * PV;
    LAS float* rpbs = (LAS float*)(lds + O_RPB);
    const unsigned lbase = (unsigned)(uintptr_t)lds;
    const int ib = w & 3, vh = w >> 2;
    {
        int lane_o = lane; asm volatile("" : "+v"(lane_o));
        const int g = lane_o >> 4, li = lane_o & 15;
        const int r = u & 31, h = (u >> 5) & 3, b = u >> 7;
        const int rs = min(max(r - 4, 0), 24);
        const int c = 16 * ib + li, cs0 = min(max(c - 8, 0), 48);
        const size_t tq = (size_t)b * SEQ + r * 64 + c;
        bf16x8 qf[4];
#pragma unroll
        for (int ks = 0; ks < 4; ++ks) qf[ks] = *(const bf16x8*)(PROJ + tq * NPROJ + C_BQ + h * 128 + 32 * ks + 8 * g);
        int jbv[4], dcv[4];
#pragma unroll
        for (int rr = 0; rr < 4; ++rr) { const int km = 4 * g + rr; jbv[rr] = (cs0 + 15 - km) >> 4; dcv[rr] = 16 * jbv[rr] + km - c + 15; }
        f32x4 o[4];
#pragma unroll
        for (int vt = 0; vt < 4; ++vt) o[vt] = (f32x4){0.f, 0.f, 0.f, 0.f};
        float m_run = -1e30f, l_run = 0.f;
        const int sr = tid >> 4, sc = (tid & 15) * 8;
        const int jlo = ib > 1 ? ib - 1 : 0, jhi = ib < 2 ? ib + 1 : 3;
        bf16x8 kf[4][4], vr0, vr1;
#define NA_LOADK(kr_) do { const size_t kt_ = (size_t)b * SEQ + (size_t)(rs + (kr_)) * 64; \
            _Pragma("unroll") for (int jb = 0; jb < 4; ++jb) if (jb >= jlo && jb <= jhi) { const bf16_t* kp = PROJ + (kt_ + 16 * jb + li) * NPROJ + C_BK + h * 128 + 8 * g; \
                _Pragma("unroll") for (int ks = 0; ks < 4; ++ks) kf[jb][ks] = *(const bf16x8*)(kp + 32 * ks); } } while (0)
#define NA_LOADV(kr_) do { const size_t kt_ = (size_t)b * SEQ + (size_t)(rs + (kr_)) * 64; \
            vr0 = *(const bf16x8*)(PROJ + (kt_ + sr) * NPROJ + C_BV + h * 128 + sc); vr1 = *(const bf16x8*)(PROJ + (kt_ + sr + 32) * NPROJ + C_BV + h * 128 + sc); } while (0)
        NA_LOADV(0); NA_LOADK(0);
        for (int kr = 0; kr < 8; ++kr) {
            *(LAS bf16x8*)(lds + O_V + (kr & 1) * 64 * PV + sr * PV + sc * 2) = vr0; *(LAS bf16x8*)(lds + O_V + (kr & 1) * 64 * PV + (sr + 32) * PV + sc * 2) = vr1;
            if (kr + 1 < 8) NA_LOADV(kr + 1);
            f32x4 s[4];
#pragma unroll
            for (int jb = 0; jb < 4; ++jb) { s[jb] = (f32x4){0.f, 0.f, 0.f, 0.f};
                if (jb >= jlo && jb <= jhi) {
#pragma unroll
                    for (int ks = 0; ks < 4; ++ks) s[jb] = __builtin_amdgcn_mfma_f32_16x16x32_bf16(kf[jb][ks], qf[ks], s[jb], 0, 0, 0); } }
            if (kr + 1 < 8) NA_LOADK(kr + 1);
            const int dr = rs + kr - r + 7;
            float mx = -1e30f;
#pragma unroll
            for (int rr = 0; rr < 4; ++rr) { const float bias = rpbs[(h * 15 + dr) * 31 + dcv[rr]];
#pragma unroll
                for (int jb = 0; jb < 4; ++jb) { const float v = (jb == jbv[rr]) ? s[jb][rr] * 0.088388347648318440f + bias : -1e30f; s[jb][rr] = v; mx = fmaxf(mx, v); } }
            mx = fmaxf(mx, __shfl_xor(mx, 16)); mx = fmaxf(mx, __shfl_xor(mx, 32));
            const float m_new = fmaxf(m_run, mx), alpha = __expf(m_run - m_new);
            m_run = m_new;
            float ps = 0.f;
#pragma unroll
            for (int jb = 0; jb < 4; ++jb)
#pragma unroll
                for (int rr = 0; rr < 4; ++rr) { const float p = (jb == jbv[rr]) ? __expf(s[jb][rr] - m_new) : 0.f; s[jb][rr] = p; ps += p; }
            l_run = l_run * alpha + ps;
            bf16x8 pfr[2];
#pragma unroll
            for (int ss = 0; ss < 2; ++ss) { const float t[8] = {s[2 * ss][0], s[2 * ss][1], s[2 * ss][2], s[2 * ss][3], s[2 * ss + 1][0], s[2 * ss + 1][1], s[2 * ss + 1][2], s[2 * ss + 1][3]}; pfr[ss] = pack8(t); }
            __syncthreads();
            s16x4 vl[4][2], vhh[4][2];
            {
                const unsigned vbase = lbase + O_V + (unsigned)((kr & 1) * 64 * PV + (4 * g + (li >> 2)) * PV + (64 * vh + 4 * (li & 3)) * 2);
                asm volatile("ds_read_b64_tr_b16 %0, %16 offset:0\n\t"
                         "ds_read_b64_tr_b16 %1, %16 offset:4352\n\t"
                         "ds_read_b64_tr_b16 %2, %16 offset:8704\n\t"
                         "ds_read_b64_tr_b16 %3, %16 offset:13056\n\t"
                         "ds_read_b64_tr_b16 %4, %16 offset:32\n\t"
                         "ds_read_b64_tr_b16 %5, %16 offset:4384\n\t"
                         "ds_read_b64_tr_b16 %6, %16 offset:8736\n\t"
                         "ds_read_b64_tr_b16 %7, %16 offset:13088\n\t"
                         "ds_read_b64_tr_b16 %8, %16 offset:64\n\t"
                         "ds_read_b64_tr_b16 %9, %16 offset:4416\n\t"
                         "ds_read_b64_tr_b16 %10, %16 offset:8768\n\t"
                         "ds_read_b64_tr_b16 %11, %16 offset:13120\n\t"
                         "ds_read_b64_tr_b16 %12, %16 offset:96\n\t"
                         "ds_read_b64_tr_b16 %13, %16 offset:4448\n\t"
                         "ds_read_b64_tr_b16 %14, %16 offset:8800\n\t"
                         "ds_read_b64_tr_b16 %15, %16 offset:13152\n\t"
                         "s_waitcnt lgkmcnt(0)"
                         : "=&v"(vl[0][0]), "=&v"(vhh[0][0]), "=&v"(vl[0][1]), "=&v"(vhh[0][1]), "=&v"(vl[1][0]), "=&v"(vhh[1][0]), "=&v"(vl[1][1]), "=&v"(vhh[1][1]), "=&v"(vl[2][0]), "=&v"(vhh[2][0]), "=&v"(vl[2][1]), "=&v"(vhh[2][1]), "=&v"(vl[3][0]), "=&v"(vhh[3][0]), "=&v"(vl[3][1]), "=&v"(vhh[3][1])
                         : "v"(vbase) : "memory");
            }
            __builtin_amdgcn_sched_barrier(0);
#pragma unroll
            for (int vt = 0; vt < 4; ++vt) { o[vt] = o[vt] * alpha;
#pragma unroll
                for (int ss = 0; ss < 2; ++ss) o[vt] = __builtin_amdgcn_mfma_f32_16x16x32_bf16(TR_JOIN(vl[vt][ss], vhh[vt][ss]), pfr[ss], o[vt], 0, 0, 0); }
        }
#undef NA_LOADK
#undef NA_LOADV
        l_run += __shfl_xor(l_run, 16); l_run += __shfl_xor(l_run, 32);
        const float inv = 1.0f / l_run;
#pragma unroll
        for (int vt = 0; vt < 4; ++vt) { u32x2 ov; ov.x = cvt_pk_bf16(o[vt].x * inv, o[vt].y * inv); ov.y = cvt_pk_bf16(o[vt].z * inv, o[vt].w * inv);
            *(u32x2*)(OB + tq * LDOM + h * 128 + 64 * vh + 16 * vt + 4 * g) = ov; }
        __syncthreads();
    }
}
__device__ __forceinline__ void na_load_bias(const float* rpb, LAS unsigned char* lds) {
    const int tid = opaque_tid(); LAS float* rpbs = (LAS float*)(lds + 2 * 64 * 272);
    __syncthreads();
    for (int i = tid; i < 4 * 15 * 31; i += 512) rpbs[i] = rpb[i];
    __syncthreads();
}
__device__ __forceinline__ float logsig16(float z) { return (fminf(z, 0.f) - __logf(1.0f + __expf(-fabsf(z)))) * (1.0f / 16.0f); }
__device__ __forceinline__ void gla_seq_unit(const bf16_t* PROJ, const float* LR, const float* w_decay  , const float* b_decay  , bf16_t* OFB, bf16_t* OC, const float* onorm,
                                             LAS unsigned char* lds, int b, int h) {
    const int tid = opaque_tid(), lane = tid & 63, w = __builtin_amdgcn_readfirstlane(tid >> 6);
    constexpr int P64 = 144, PV = 272;
    constexpr int O_Q = 0, O_K = 9216, O_KH = 18432, O_V = 27648, O_S = 45056, O_DEC = 63488, O_W2 = 63744;
    const unsigned lbase = (unsigned)(uintptr_t)lds;
    const int ib = w & 3, vh = w >> 2, g = lane >> 4, li = lane & 15;
    LAS float* w2s = (LAS float*)(lds + O_W2);
    LAS float* gns = (LAS float*)(lds + 68608);
    __syncthreads(); if (tid < 128) gns[tid] = onorm[tid];
    LAS float* red = (LAS float*)(lds + 68096);
  for (int dir = 0; dir < 2; ++dir) {
    __syncthreads();
    for (int i = tid; i < 16 * 64; i += 512) w2s[i] = w_decay[dir * 4096 + (i >> 6) * 256 + h * 64 + (i & 63)];
    if (tid < 64) w2s[1024 + tid] = b_decay[dir * 256 + h * 64 + tid];
    for (int i = tid; i < 128 * 72 / 2; i += 512) ((LAS unsigned*)(lds + O_S))[i] = 0u;
    f32x4 S[4];
#pragma unroll
    for (int vt = 0; vt < 4; ++vt) S[vt] = (f32x4){0.f, 0.f, 0.f, 0.f};
    const int dcol = 8 * w;
    const int sr = tid >> 4, sc = (tid & 15) * 8;
    f32x4 lr4[4]; u32x4 qraw, kraw; bf16x8 vst0, vst1;
    u32x2 ofr[4], ogr[4];
#define GLA_LOAD_O(cc_) do { const int c_ = 31 - (cc_); const size_t mi_ = (size_t)b * SEQ + c_ * 64 + 16 * ib + li; \
        _Pragma("unroll") for (int vt = 0; vt < 4; ++vt) { ofr[vt] = *(const u32x2*)(OFB + mi_ * 512 + h * 128 + 64 * vh + 16 * vt + 4 * g); ogr[vt] = *(const u32x2*)(PROJ + mi_ * NPROJ + C_OG + h * 128 + 64 * vh + 16 * vt + 4 * g); } } while (0)
#define GLA_LOAD(cc_) do { const int c_ = dir ? 31 - (cc_) : (cc_); const size_t m0_ = (size_t)b * SEQ + c_ * 64, m_ = m0_ + lane; \
        _Pragma("unroll") for (int j = 0; j < 4; ++j) lr4[j] = ((const f32x4*)(LR + m_ * 32 + dir * 16))[j]; \
        qraw = *(const u32x4*)(PROJ + m_ * NPROJ + C_CQ + h * 64 + dcol); kraw = *(const u32x4*)(PROJ + m_ * NPROJ + C_CK + h * 64 + dcol); \
        vst0 = *(const bf16x8*)(PROJ + (m0_ + sr) * NPROJ + C_CV + h * 128 + sc); vst1 = *(const bf16x8*)(PROJ + (m0_ + sr + 32) * NPROJ + C_CV + h * 128 + sc); } while (0)
#pragma unroll
    for (int vt = 0; vt < 4; ++vt) { ofr[vt] = (u32x2){0u, 0u}; ogr[vt] = (u32x2){0u, 0u}; }
    GLA_LOAD(0);
    if (dir) GLA_LOAD_O(0);
    __syncthreads();
    for (int cc = 0; cc < 32; ++cc) {
        const int c = dir ? 31 - cc : cc; const size_t m0 = (size_t)b * SEQ + c * 64;
        {
            f32x4 z0 = *(const LAS f32x4*)(w2s + 1024 + dcol), z1 = *(const LAS f32x4*)(w2s + 1024 + dcol + 4);
#pragma unroll
            for (int j = 0; j < 4; ++j)
#pragma unroll
                for (int rr = 0; rr < 4; ++rr) { const int r = 4 * j + rr; z0 = z0 + *(const LAS f32x4*)(w2s + r * 64 + dcol) * lr4[j][rr]; z1 = z1 + *(const LAS f32x4*)(w2s + r * 64 + dcol + 4) * lr4[j][rr]; }
            float bs[8];
#pragma unroll
            for (int e = 0; e < 4; ++e) { bs[e] = logsig16(z0[e]); bs[4 + e] = logsig16(z1[e]); }
            if (dir == 0) {
#pragma unroll
                for (int off = 1; off < 64; off <<= 1)
#pragma unroll
                    for (int e = 0; e < 8; ++e) { const float t = __shfl_up(bs[e], off); if (lane >= off) bs[e] += t; }
            } else {
#pragma unroll
                for (int off = 1; off < 64; off <<= 1)
#pragma unroll
                    for (int e = 0; e < 8; ++e) { const float t = __shfl_down(bs[e], off); if (lane + off < 64) bs[e] += t; }
            }
            const float q[8] = {bflo(qraw.x), bfhi(qraw.x), bflo(qraw.y), bfhi(qraw.y), bflo(qraw.z), bfhi(qraw.z), bflo(qraw.w), bfhi(qraw.w)};
            const float k[8] = {bflo(kraw.x), bfhi(kraw.x), bflo(kraw.y), bfhi(kraw.y), bflo(kraw.z), bfhi(kraw.z), bflo(kraw.w), bfhi(kraw.w)};
            float qt[8], kt[8], kh[8], dc[8];
#pragma unroll
            for (int e = 0; e < 8; ++e) { const float be = __shfl(bs[e], dir ? 0 : 63);
                qt[e] = q[e] * 0.125f * __expf(bs[e]); kt[e] = k[e] * __expf(-bs[e]); kh[e] = k[e] * __expf(be - bs[e]); dc[e] = __expf(be); }
            *(LAS bf16x8*)(lds + O_Q + lane * P64 + 16 * w) = pack8(qt); *(LAS bf16x8*)(lds + O_K + lane * P64 + 16 * w) = pack8(kt); *(LAS bf16x8*)(lds + O_KH + lane * P64 + 16 * w) = pack8(kh);
            if (lane == 0) { *(LAS f32x4*)(lds + O_DEC + 4 * dcol) = (f32x4){dc[0], dc[1], dc[2], dc[3]}; *(LAS f32x4*)(lds + O_DEC + 4 * dcol + 16) = (f32x4){dc[4], dc[5], dc[6], dc[7]}; }
            *(LAS bf16x8*)(lds + O_V + sr * PV + sc * 2) = vst0; *(LAS bf16x8*)(lds + O_V + (sr + 32) * PV + sc * 2) = vst1;
        }
        __syncthreads();
        if (cc + 1 < 32) GLA_LOAD(cc + 1);
        const size_t mi = m0 + 16 * ib + li; f32x4 oo[4]; float ss = 0.f;
        {
            bf16x8 qF[2];
#pragma unroll
            for (int ks = 0; ks < 2; ++ks) qF[ks] = *(const LAS bf16x8*)(lds + O_Q + (16 * ib + li) * P64 + (32 * ks + 8 * g) * 2);
            f32x4 P[4];
#pragma unroll
            for (int jb = 0; jb < 4; ++jb) {
                f32x4 a = {0.f, 0.f, 0.f, 0.f};
                const bool need = dir ? (jb >= ib) : (jb <= ib);
                if (need) {
#pragma unroll
                    for (int ks = 0; ks < 2; ++ks) a = __builtin_amdgcn_mfma_f32_16x16x32_bf16(*(const LAS bf16x8*)(lds + O_K + (16 * jb + li) * P64 + (32 * ks + 8 * g) * 2), qF[ks], a, 0, 0, 0); }
#pragma unroll
                for (int r = 0; r < 4; ++r) { const int jl = 4 * g + r;
                    const bool keep = (jb == ib) ? (dir ? (jl >= li) : (jl <= li)) : need;
                    P[jb][r] = keep ? a[r] : 0.f; }
            }
            bf16x8 pfr[2];
#pragma unroll
            for (int s = 0; s < 2; ++s) { const float t[8] = {P[2 * s][0], P[2 * s][1], P[2 * s][2], P[2 * s][3], P[2 * s + 1][0], P[2 * s + 1][1], P[2 * s + 1][2], P[2 * s + 1][3]}; pfr[s] = pack8(t); }
            s16x4 vl[4][2], vhh[4][2], kl[2], kh2[2];
            {
                const unsigned vbase = lbase + O_V + (unsigned)((4 * g + (li >> 2)) * PV + (64 * vh + 4 * (li & 3)) * 2);
                const unsigned kbase = lbase + O_KH + (unsigned)((4 * g + (li >> 2)) * P64 + (16 * ib + 4 * (li & 3)) * 2);
                asm volatile("ds_read_b64_tr_b16 %0, %20 offset:0\n\t"
                         "ds_read_b64_tr_b16 %1, %20 offset:4352\n\t"
                         "ds_read_b64_tr_b16 %2, %20 offset:8704\n\t"
                         "ds_read_b64_tr_b16 %3, %20 offset:13056\n\t"
                         "ds_read_b64_tr_b16 %4, %20 offset:32\n\t"
                         "ds_read_b64_tr_b16 %5, %20 offset:4384\n\t"
                         "ds_read_b64_tr_b16 %6, %20 offset:8736\n\t"
                         "ds_read_b64_tr_b16 %7, %20 offset:13088\n\t"
                         "ds_read_b64_tr_b16 %8, %20 offset:64\n\t"
                         "ds_read_b64_tr_b16 %9, %20 offset:4416\n\t"
                         "ds_read_b64_tr_b16 %10, %20 offset:8768\n\t"
                         "ds_read_b64_tr_b16 %11, %20 offset:13120\n\t"
                         "ds_read_b64_tr_b16 %12, %20 offset:96\n\t"
                         "ds_read_b64_tr_b16 %13, %20 offset:4448\n\t"
                         "ds_read_b64_tr_b16 %14, %20 offset:8800\n\t"
                         "ds_read_b64_tr_b16 %15, %20 offset:13152\n\t"
                         "ds_read_b64_tr_b16 %16, %21 offset:0\n\t"
                         "ds_read_b64_tr_b16 %17, %21 offset:2304\n\t"
                         "ds_read_b64_tr_b16 %18, %21 offset:4608\n\t"
                         "ds_read_b64_tr_b16 %19, %21 offset:6912\n\t"
                         "s_waitcnt lgkmcnt(0)"
                         : "=&v"(vl[0][0]), "=&v"(vhh[0][0]), "=&v"(vl[0][1]), "=&v"(vhh[0][1]), "=&v"(vl[1][0]), "=&v"(vhh[1][0]), "=&v"(vl[1][1]), "=&v"(vhh[1][1]), "=&v"(vl[2][0]), "=&v"(vhh[2][0]), "=&v"(vl[2][1]), "=&v"(vhh[2][1]), "=&v"(vl[3][0]), "=&v"(vhh[3][0]), "=&v"(vl[3][1]), "=&v"(vhh[3][1]), "=&v"(kl[0]), "=&v"(kh2[0]), "=&v"(kl[1]), "=&v"(kh2[1])
                         : "v"(vbase), "v"(kbase) : "memory");
            }
            bf16x8 sfr[4][2];
#pragma unroll
            for (int vt = 0; vt < 4; ++vt)
#pragma unroll
                for (int ks = 0; ks < 2; ++ks) sfr[vt][ks] = *(const LAS bf16x8*)(lds + O_S + (64 * vh + 16 * vt + li) * P64 + (32 * ks + 8 * g) * 2);
            const float dec = *(const LAS float*)(lds + O_DEC + 4 * (16 * ib + li));
            __builtin_amdgcn_sched_barrier(0);
#pragma unroll
            for (int vt = 0; vt < 4; ++vt) {
                const int v0 = 64 * vh + 16 * vt;
                f32x4 o = {0.f, 0.f, 0.f, 0.f};
#pragma unroll
                for (int s = 0; s < 2; ++s) o = __builtin_amdgcn_mfma_f32_16x16x32_bf16(TR_JOIN(vl[vt][s], vhh[vt][s]), pfr[s], o, 0, 0, 0);
#pragma unroll
                for (int ks = 0; ks < 2; ++ks) o = __builtin_amdgcn_mfma_f32_16x16x32_bf16(sfr[vt][ks], qF[ks], o, 0, 0, 0);
                if (dir == 0) { u32x2 ov; ov.x = (unsigned)f2bf(o.x) | ((unsigned)f2bf(o.y) << 16); ov.y = (unsigned)f2bf(o.z) | ((unsigned)f2bf(o.w) << 16);
                    *(u32x2*)(OFB + mi * 512 + h * 128 + v0 + 4 * g) = ov; }
                else { const u32x2 f = ofr[vt];
                    o.x += bflo(f.x); o.y += bfhi(f.x); o.z += bflo(f.y); o.w += bfhi(f.y); oo[vt] = o; ss += (o.x * o.x + o.y * o.y) + (o.z * o.z + o.w * o.w); }
                f32x4 sn = S[vt] * dec;
#pragma unroll
                for (int s = 0; s < 2; ++s) sn = __builtin_amdgcn_mfma_f32_16x16x32_bf16(TR_JOIN(vl[vt][s], vhh[vt][s]), TR_JOIN(kl[s], kh2[s]), sn, 0, 0, 0);
                S[vt] = sn;
            }
        }
        if (dir) { ss += __shfl_xor(ss, 16); ss += __shfl_xor(ss, 32); if (g == 0) red[vh * 64 + 16 * ib + li] = ss; }
        __syncthreads();
        if (dir) {
            const float rstd = 1.0f / sqrtf((red[16 * ib + li] + red[64 + 16 * ib + li]) * (1.0f / 128.0f) + EPS);
#pragma unroll
            for (int vt = 0; vt < 4; ++vt) { const int v0 = 64 * vh + 16 * vt;
                const u32x2 og = ogr[vt]; const f32x4 gn = *(const LAS f32x4*)(gns + v0 + 4 * g);
                u32x2 ov; ov.x = cvt_pk_bf16(oo[vt].x * rstd * gn.x * pg8::silu_f(bflo(og.x)), oo[vt].y * rstd * gn.y * pg8::silu_f(bfhi(og.x)));
                ov.y = cvt_pk_bf16(oo[vt].z * rstd * gn.z * pg8::silu_f(bflo(og.y)), oo[vt].w * rstd * gn.w * pg8::silu_f(bfhi(og.y)));
                *(u32x2*)(OC + mi * LDOM + h * 128 + v0 + 4 * g) = ov; }
            if (cc + 1 < 32) GLA_LOAD_O(cc + 1);
        }
#pragma unroll
        for (int vt = 0; vt < 4; ++vt)
#pragma unroll
            for (int r = 0; r < 4; ++r) *(LAS bf16_t*)(lds + O_S + (64 * vh + 16 * vt + 4 * g + r) * P64 + (16 * ib + li) * 2) = f2bf(S[vt][r]);
    }
    __syncthreads();
  }
#undef GLA_LOAD
#undef GLA_LOAD_O
}
constexpr int NPH = 15;
enum { P_F1A = 0, P_F1B, P_N1, P_M1, P_PREP, P_ATT, P_NA, P_GLA, P_GLC, P_M4, P_M5, P_N2, P_F2A, P_F2B, P_N3 };
constexpr int NGP = 1 + DEPTH * NPH;
struct Args { const float* in[18]; float* out; unsigned char* ws; int gp_lo, gp_hi; };

typedef decltype(__builtin_amdgcn_kernarg_segment_ptr()) kargp_t;
__device__ __forceinline__ unsigned long long karg_q(int byte_off) { kargp_t p_ = __builtin_amdgcn_kernarg_segment_ptr(); asm volatile("" : "+s"(p_));
    return *(const unsigned long long __attribute__((address_space(4)))*)((const char __attribute__((address_space(4)))*)p_ + byte_off); }
__global__ void __launch_bounds__(512, 2) fwd(Args args) {
    extern __shared__ __attribute__((aligned(16))) unsigned char lds_raw[];
    LAS unsigned char* const lds0 = (LAS unsigned char*)lds_raw;
    const int G0 = gridDim.x, wg0 = blockIdx.x;
#define PENV LAS unsigned char* lds = lds0; int G = G0, wg = wg0; asm volatile("" : "+s"(lds), "+s"(G), "+s"(wg)); const int NGW = G * 8; (void)NGW; (void)lds; (void)wg
    volatile LAS unsigned* MISC = (volatile LAS unsigned*)(lds0 + MISC_OFF);
    volatile LAS unsigned long long* PT = (volatile LAS unsigned long long*)(lds0 + PTAB_OFF);
    { const int t0 = threadIdx.x;
      for (int u = t0; u < (LDS_BYTES - LDSCTL_OFF) / 4; u += 512) ((LAS unsigned*)(lds0 + LDSCTL_OFF))[u] = 0u;
      __syncthreads();
      __syncthreads(); }
#if ONE_LAUNCH
    constexpr int lo = 0, hi = NGP;
#else
    const int lo = args.gp_lo, hi = args.gp_hi;
#endif
    XcdBarrier bar; bar.bar = (unsigned*)(args.ws + WS_CTL) + CW_BAR; bar.x = 0; bar.st = nullptr;
    if (hi - lo > 1) bar = xcd_barrier_setup((unsigned*)(args.ws + WS_CTL) + CW_BAR, MISC + 8);
#define SEAM(gp) do { if ((gp) + 1 < hi) xcd_barrier(bar); } while (0)
#define INP(i) ((const float*)(const GAS float*)karg_q(8 * (i)))
#define WSP() ((unsigned char*)(GAS unsigned char*)karg_q(8 * 19))
#define XP() ((float*)(GAS float*)karg_q(8 * 18))
#define TIDS() PENV; const int tid = opaque_tid(), lane = tid & 63, wave = __builtin_amdgcn_readfirstlane(tid >> 6), gw = wg * 8 + wave; (void)tid; (void)lane; (void)wave; (void)gw

    if (((PHASE_MASK >> 31) & 1u) && lo <= 0 && 0 < hi) {
        TIDS(); unsigned char* ws = WSP(); bf16_t* XB = (bf16_t*)(ws + WS_XN); float* RSTD = (float*)(ws + WS_RSTD);
        LayerW w; w.w_in = INP(3); w.w_bra = INP(10); w.w_brb = INP(11); w.w_brc = INP(12); w.w_out = INP(13); w.f1i = INP(14); w.f1o = INP(15); w.f2i = INP(16); w.f2o = INP(17); w.ng = INP(2);
        phase_weights(w, ws, lds, gw, NGW, wave, lane);
        const float* xp = INP(0); const float* xs = INP(1);
        for (int m = gw; m < M; m += NGW) {
            const float* src = m < 16 * SEQ ? xp + (size_t)m * D : xs + (size_t)(m - 16 * SEQ) * D;
            const f32x4* xr = (const f32x4*)src + lane; f32x4 x[8]; float s = 0.f;
#pragma unroll
            for (int j = 0; j < 8; ++j) { x[j] = xr[64 * j]; s += (x[j].x * x[j].x + x[j].y * x[j].y) + (x[j].z * x[j].z + x[j].w * x[j].w); }
            u32x2* o8 = (u32x2*)(XB + (size_t)m * D) + lane;
#pragma unroll
            for (int j = 0; j < 8; ++j) { u32x2 wv; wv.x = cvt_pk_bf16(x[j].x, x[j].y); wv.y = cvt_pk_bf16(x[j].z, x[j].w); o8[64 * j] = wv; }
            const float rstd = 1.0f / sqrtf(wave_sum(s) * (1.0f / D) + EPS);
            if (lane == 0) RSTD[m] = rstd;
        }
        SEAM(0);
    }
    for (int l = 0; l < DEPTH; ++l) {
        const int gp0 = 1 + l * NPH;
        if (gp0 + NPH <= lo || gp0 >= hi) continue;
#define IN(p) (((PHASE_MASK >> (p)) & 1u) && lo <= gp0 + (p) && gp0 + (p) < hi)
#define FFN_PAIR(ff, pa, pb) do { \
        if (IN(pa)) { PENV; unsigned char* ws = WSP(); pg8::Gemm g{(const bf16_t*)(ws + WS_XN), (const bf16_t*)(ws + ((ff) ? WS_WF2I : WS_WF1I)), M, 2 * FF, D, D}; pg8::StaticOrder S; S.init(M, 2 * FF, G, wg, WGM_FI); \
            pg8::EpiSwiGLU E{(bf16_t*)(ws + WS_H), (const float*)(ws + WS_RSTD)}; pg8::gemm_phase<pg8::EpiSwiGLU, pg8::StaticOrder, true, true>(lds, g, S, E); if ((DUP_MASK >> (pa)) & 1u) pg8::gemm_phase<pg8::EpiSwiGLU, pg8::StaticOrder, true, true>(lds, g, S, E); SEAM(gp0 + (pa)); } \
        if (IN(pb)) { PENV; unsigned char* ws = WSP(); pg8::Gemm g{(const bf16_t*)(ws + WS_H), (const bf16_t*)(ws + ((ff) ? WS_WF2O : WS_WF1O)), M, D, FF, FF}; pg8::StaticOrder S; S.init(M, D, G, wg, WGM_FO); \
            pg8::EpiBf16Plain E{(bf16_t*)(ws + WS_Y), D}; pg8::gemm_phase<pg8::EpiBf16Plain, pg8::StaticOrder, true, true>(lds, g, S, E); if ((DUP_MASK >> (pb)) & 1u) pg8::gemm_phase<pg8::EpiBf16Plain, pg8::StaticOrder, true, true>(lds, g, S, E); SEAM(gp0 + (pb)); } } while (0)
#define NORM_PHASE(p, ipost, coef, last) do { if (IN(p)) { TIDS(); unsigned char* ws = WSP(); const float* ng = INP(2) + (size_t)l * 6 * D; \
            phase_norm((bf16_t*)(ws + WS_XN), (const bf16_t*)(ws + WS_Y), (float*)(ws + WS_RSTD), (last) ? XP() : nullptr, ng + (ipost) * D, (coef), gw, NGW, lane);

        FFN_PAIR(0, P_F1A, P_F1B);
        NORM_PHASE(P_N1, 1, 0.5f, false) SEAM(gp0 + P_N1); } } while (0);
        if (IN(P_M1)) { PENV;
            unsigned char* ws = WSP();
            pg8::Gemm g{(const bf16_t*)(ws + WS_XN), (const bf16_t*)(ws + WS_WIN), M, NIN_PAD, D, D}; pg8::StaticOrder S; S.init(M, NIN_PAD, G, wg, WGM_M1);
            pg8::EpiProj E{(bf16_t*)(ws + WS_PROJ), (u32x4*)(ws + WS_GATES), (float*)(ws + WS_LR), INP(4) + (size_t)l * 3 * D, (const float*)(ws + WS_RSTD)};
            pg8::gemm_phase<pg8::EpiProj, pg8::StaticOrder, true, true>(lds, g, S, E);
            if ((DUP_MASK >> P_M1) & 1u) pg8::gemm_phase<pg8::EpiProj, pg8::StaticOrder, true, true>(lds, g, S, E);
            SEAM(gp0 + P_M1);
        }
        if (IN(P_PREP)) {
            { TIDS(); unsigned char* ws = WSP(); phase_prep((bf16_t*)(ws + WS_PROJ), INP(5) + (size_t)l * 256, lds, gw, NGW, tid, lane); }
            SEAM(gp0 + P_PREP);
        }
        if (IN(P_ATT)) { PENV;
            unsigned char* ws = WSP(); bf16_t* PROJ = (bf16_t*)(ws + WS_PROJ);
            const int ngrp = (G % 8 == 0) ? 8 : 1, xg = wg % ngrp, slot = wg / ngrp, per = G / ngrp;
            for (int gu = slot; gu < 96 / ngrp; gu += per) { const int U = xg * (96 / ngrp) + gu;
                gla_seq_unit(PROJ, (const float*)(ws + WS_LR), INP(7) + (size_t)l * 2 * 16 * 256, INP(8) + (size_t)l * 512, (bf16_t*)(ws + WS_OFB), (bf16_t*)(ws + WS_OA) + OM_C, INP(9) + (size_t)l * 128, lds, U >> 2, U & 3); }
            na_load_bias(INP(6) + (size_t)l * 4 * 15 * 31, lds);
            unsigned* head = (unsigned*)(ws + WS_CTL) + CW_Q + (l * 8 + xg) * 64;
            const int n_att = 1536 / ngrp, n_na = 3072 / ngrp;
            LAS unsigned* qslot = (LAS unsigned*)(lds + MISC_OFF + 64);
            for (;;) {
                __syncthreads();
                if (threadIdx.x == 0) *qslot = __hip_atomic_fetch_add(head, 1u, __ATOMIC_RELAXED, __HIP_MEMORY_SCOPE_AGENT);
                __syncthreads();
                const int idx = __builtin_amdgcn_readfirstlane((int)*(volatile LAS unsigned*)qslot);
                if (idx >= n_att * (1 + ATT_DUP) + n_na) break;
                if (idx < n_att * (1 + ATT_DUP)) { const int idx0 = idx; const int idx = idx0 % n_att;
                    const int rnd = idx >> 5, mem = idx & 31, grp = (ngrp == 8) ? rnd * 8 + xg : rnd;
                    const int b = grp >> 1, kvh = grp & 1, h = kvh * 4 + (mem >> 3), qb = mem & 7;
                    const size_t rowq = (size_t)b * SEQ + qb * 256, rowk = (size_t)b * SEQ;
                    bf16_t* Qp = PROJ + rowq * NPROJ + C_AQ + h * 128;
                    att::attn_dense_body(Qp, PROJ + rowk * NPROJ + C_AK + kvh * 128, PROJ + rowk * NPROJ + C_AV + kvh * 128, (bf16_t*)(ws + WS_OA) + rowq * LDOM + h * 128, SEQ, (char*)lds_raw + 49152);
                } else {
                    na_unit(PROJ, (bf16_t*)(ws + WS_OA) + OM_B, lds, xg * n_na + (idx - n_att * (1 + ATT_DUP)));
                }
            }
            SEAM(gp0 + P_GLA);
        }
        if (IN(P_M4)) { PENV;
            unsigned char* ws = WSP();
            pg8::Gemm g{(const bf16_t*)(ws + WS_OA), (const bf16_t*)(ws + WS_WBRA), M, D, LDOM, LDOM}; pg8::StaticOrder S; S.init(M, D, G, wg, WGM_M45);
            pg8::EpiMerge3 E{(const u32x4*)(ws + WS_GATES), (bf16_t*)(ws + WS_MG)};
            pg8::gemm_phase<pg8::EpiMerge3, pg8::StaticOrder, true, true>(lds, g, S, E);
            if ((DUP_MASK >> P_M4) & 1u) pg8::gemm_phase<pg8::EpiMerge3, pg8::StaticOrder, true, true>(lds, g, S, E);
            SEAM(gp0 + P_M4);
        }
        if (IN(P_M5)) { PENV;
            unsigned char* ws = WSP();
            pg8::Gemm g{(const bf16_t*)(ws + WS_MG), (const bf16_t*)(ws + WS_WOUT), M, D, D, D}; pg8::StaticOrder S; S.init(M, D, G, wg, WGM_M45);
            pg8::EpiBf16Plain E{(bf16_t*)(ws + WS_Y), D};
            pg8::gemm_phase<pg8::EpiBf16Plain, pg8::StaticOrder, true, true>(lds, g, S, E);
            if ((DUP_MASK >> P_M5) & 1u) pg8::gemm_phase<pg8::EpiBf16Plain, pg8::StaticOrder, true, true>(lds, g, S, E);
            SEAM(gp0 + P_M5);
        }
        NORM_PHASE(P_N2, 3, 1.0f, false) SEAM(gp0 + P_N2); } } while (0);
        FFN_PAIR(1, P_F2A, P_F2B);
        NORM_PHASE(P_N3, 5, 0.5f, (l + 1 == DEPTH))
            if (l + 1 < DEPTH) { LayerW w; w.w_in = INP(3) + (size_t)(l + 1) * D * NIN; w.w_bra = INP(10) + (size_t)(l + 1) * 1024 * D; w.w_brb = INP(11) + (size_t)(l + 1) * 512 * D; w.w_brc = INP(12) + (size_t)(l + 1) * 512 * D;
                w.w_out = INP(13) + (size_t)(l + 1) * D * D; w.f1i = INP(14) + (size_t)(l + 1) * D * 2 * FF; w.f1o = INP(15) + (size_t)(l + 1) * FF * D; w.f2i = INP(16) + (size_t)(l + 1) * D * 2 * FF; w.f2o = INP(17) + (size_t)(l + 1) * FF * D; w.ng = INP(2) + (size_t)(l + 1) * 6 * D;
                phase_weights(w, ws, lds, gw, NGW, wave, lane); if ((DUP_MASK >> 20) & 1u) phase_weights(w, ws, lds, gw, NGW, wave, lane); }
            SEAM(gp0 + P_N3); } } while (0);
#undef FFN_PAIR
#undef NORM_PHASE
#undef IN
    }
#undef SEAM
}

extern "C" void kernel_launch(void* const* d_in, const int* in_sizes, int n_in, void* d_out, int out_size, void* d_ws, size_t ws_size, hipStream_t stream) {
    static int grid = 0;
    if (grid == 0) {
        if (n_in != 18 || out_size != M * D || ws_size < WS_END) { fprintf(stderr, "kernel_launch: unexpected shapes: n_in %d out %d ws %zu (need %zu)\n", n_in, out_size, ws_size, (size_t)WS_END); grid = -1; return; }
        int dev = 0, cus = 0, per_cu = 0;
        if (hipGetDevice(&dev) != hipSuccess || hipDeviceGetAttribute(&cus, hipDeviceAttributeMultiprocessorCount, dev) != hipSuccess) { grid = -1; return; }
        if (hipFuncSetAttribute((const void*)fwd, hipFuncAttributeMaxDynamicSharedMemorySize, LDS_BYTES) != hipSuccess) { fprintf(stderr, "kernel_launch: hipFuncSetAttribute failed\n"); grid = -1; return; }
        if (hipOccupancyMaxActiveBlocksPerMultiprocessor(&per_cu, (const void*)fwd, 512, LDS_BYTES) != hipSuccess || per_cu < 1) fprintf(stderr, "kernel_launch: occupancy query says %d\n", per_cu);
        (void)hipGetLastError();
        grid = cus;
    }
    if (grid < 0) return;
    (void)hipMemsetAsync((char*)d_ws + WS_CTL, 0, CTL_BYTES, stream);
    Args a{};
    for (int i = 0; i < 18; ++i) a.in[i] = (const float*)d_in[i];
    a.out = (float*)d_out; a.ws = (unsigned char*)d_ws;
#if ONE_LAUNCH
    a.gp_lo = 0; a.gp_hi = NGP;
    hipLaunchKernelGGL(fwd, dim3(grid), dim3(512), LDS_BYTES, stream, a);
#else
    for (int gp = 0; gp < NGP; ++gp) { a.gp_lo = gp; a.gp_hi = gp + 1; hipLaunchKernelGGL(fwd, dim3(grid), dim3(512), LDS_BYTES, stream, a); }
#endif
    const hipError_t le = hipPeekAtLastError();
    if (le != hipSuccess) fprintf(stderr, "kernel_launch: launch failed: %s\n", hipGetErrorName(le));
}
```

```cpp
#include <hip/hip_runtime.h>
#include <cstdio>
#include <cstdint>

#ifndef ONE_LAUNCH
#define ONE_LAUNCH 1
#endif
#ifndef WGM_FI
#define WGM_FI 4
#endif
#ifndef WGM_FO
#define WGM_FO 2
#endif
#ifndef WGM_M1
#define WGM_M1 4
#endif
#ifndef WGM_M45
#define WGM_M45 4
#endif
#ifndef ATT_DUP
#define ATT_DUP 0
#endif
#ifndef DUP_MASK
#define DUP_MASK 0u
#endif
#ifndef PHASE_MASK
#define PHASE_MASK 0xFFFFFFFFu
#endif

#define GAS __attribute__((address_space(1)))
#define LAS __attribute__((address_space(3)))
typedef unsigned short bf16_t;
typedef short bf16x8 __attribute__((ext_vector_type(8)));
typedef short s16x4 __attribute__((ext_vector_type(4)));
typedef float f32x4 __attribute__((ext_vector_type(4)));
typedef float f32x2 __attribute__((ext_vector_type(2)));
typedef float f32x16 __attribute__((ext_vector_type(16)));
typedef unsigned u32x4 __attribute__((ext_vector_type(4)));
typedef unsigned u32x2 __attribute__((ext_vector_type(2)));

constexpr int M = 49152;
constexpr int SEQ = 2048, NSEQ = 24;
constexpr int D = 2048, FF = 5632, DEPTH = 4;
constexpr int NPROJ = 4608;
constexpr int NGATE = 6144;
constexpr int NIN = 10784, NIN_PAD = 11008;
constexpr int C_AQ = 0, C_AK = 1024, C_AV = 1280, C_BQ = 1536, C_BK = 2048, C_BV = 2560, C_CQ = 3072, C_CK = 3328, C_CV = 3584, C_OG = 4096;
constexpr int C_OC = 3072;
constexpr float EPS = 1e-6f;

constexpr size_t MiB = 1u << 20;
constexpr size_t WS_CTL = 0, CTL_BYTES = 1 * MiB;
constexpr size_t WS_WIN = 2 * MiB;
constexpr size_t WS_WF1I = 45 * MiB;
constexpr size_t WS_WF1O = 89 * MiB;
constexpr size_t WS_WF2I = 111 * MiB;
constexpr size_t WS_WF2O = 155 * MiB;
constexpr size_t WS_WBRA = 177 * MiB;
constexpr size_t WS_WBRB = 181 * MiB;
constexpr size_t WS_WBRC = 183 * MiB;
constexpr size_t WS_WOUT = 185 * MiB;
constexpr size_t WS_XN = 193 * MiB;
constexpr size_t WS_BIG = 385 * MiB;
constexpr size_t WS_PROJ = WS_BIG;
constexpr size_t WS_GATES = WS_BIG + 432 * MiB;
constexpr size_t WS_LR = WS_BIG + 1008 * MiB;
constexpr size_t WS_H = WS_BIG;
constexpr size_t WS_Y = WS_BIG + 528 * MiB;
constexpr size_t WS_OFB = WS_BIG + 1014 * MiB;
constexpr size_t WS_MG = WS_OFB + 48 * MiB;
constexpr size_t WS_RSTD = WS_MG + 192 * MiB;
constexpr size_t WS_OA = WS_RSTD + 1 * MiB;
constexpr int LDOM = 2048, OM_B = 1024, OM_C = 1536;
constexpr size_t WS_END = WS_OA + 192 * MiB;
constexpr int CW_Q = 32768;
static_assert(WS_Y + (size_t)M * D * 4 <= WS_LR, "Y inside GATES region");
constexpr int CW_BAR = 4096;
constexpr int CW_KRDY = 49152;
constexpr size_t ROPE_OFF = 524288;

__device__ __forceinline__ unsigned cvt_pk_bf16(float lo, float hi) { unsigned r; asm volatile("v_cvt_pk_bf16_f32 %0, %1, %2" : "=v"(r) : "v"(lo), "v"(hi)); return r; }
__device__ __forceinline__ float bflo(unsigned w) { return __uint_as_float(w << 16); }
__device__ __forceinline__ float bfhi(unsigned w) { return __uint_as_float(w & 0xffff0000u); }
__device__ __forceinline__ float bf2f(bf16_t v) { return __uint_as_float(((unsigned)v) << 16); }
__device__ __forceinline__ bf16_t f2bf(float f) { unsigned u = __float_as_uint(f); return (bf16_t)((u + 0x7fffu + ((u >> 16) & 1u)) >> 16); }
__device__ __forceinline__ float wave_sum(float v) {
#pragma unroll
    for (int o = 1; o < 64; o <<= 1) v += __shfl_xor(v, o);
    return v;
}
__device__ __forceinline__ float wave_max(float v) {
#pragma unroll
    for (int o = 1; o < 64; o <<= 1) v = fmaxf(v, __shfl_xor(v, o));
    return v;
}
__device__ __forceinline__ int opaque_tid() { int t = threadIdx.x; asm volatile("" : "+v"(t)); return t; }
__device__ __forceinline__ unsigned char* opq(unsigned char* p) { asm volatile("" : "+s"(p)); return p; }
__device__ __forceinline__ const float* lds_ptr(volatile LAS unsigned long long* tab, int i) { const unsigned long long v = tab[i];
    const unsigned lo = __builtin_amdgcn_readfirstlane((unsigned)v), hi = __builtin_amdgcn_readfirstlane((unsigned)(v >> 32)); return (const float*)(((unsigned long long)hi << 32) | lo); }
#define LDS_WAIT() asm volatile("s_waitcnt lgkmcnt(0)" ::: "memory")
#define VM_WAIT() asm volatile("s_waitcnt vmcnt(0)" ::: "memory")

namespace pg8 {
constexpr int BM = 256, BK = 64, HALF = 128, HTB = HALF * BK * 2, STAGE_BYTES = 8 * HTB, NXCD = 8;
__host__ __device__ __forceinline__ int lds_byte(int r, int c) { const int st = (r >> 4) * 2 + (c >> 5), rr = r & 15, cc = c & 31, ob = rr * 64 + cc * 2; return st * 1024 + (ob ^ (((ob >> 9) & 1) << 5)); }
__host__ __device__ __forceinline__ void stage_rc(int b, int& R, int& C) { const int st = b / 1024, sb = b % 1024, swz = sb ^ (((sb >> 9) & 1) << 5); R = (st >> 1) * 16 + swz / 64; C = (st & 1) * 32 + (swz % 64) / 2; }
__host__ __device__ __forceinline__ int perm32(int rho) { const int n = rho >> 4, i = rho & 15; return 8 * (i >> 2) + 4 * n + (i & 3); }

struct Unit { int pm, pn; };
struct Gemm { const bf16_t* A; const bf16_t* Bt; int M, N, K, lda; };

struct StaticOrder {
    int nM, nN, nwg, G, c, WGM;
    __host__ __device__ void init(int M_, int N_, int G_, int c_, int wgm_ = 4) { nM = M_ / BM; nN = N_ / BM; nwg = nM * nN; G = G_; c = c_; WGM = wgm_; }
    __host__ __device__ bool next(int i, Unit& u) const {
        const long L = (long)i * G + c; if (L >= nwg) return false;
        int wgid = (int)L; { const int q = nwg / NXCD, r = nwg % NXCD, xcd = wgid % NXCD, off = wgid / NXCD; wgid = (xcd < r ? xcd * (q + 1) : r * (q + 1) + (xcd - r) * q) + off; }
        const int nig = WGM * nN, gid = wgid / nig, fm = gid * WGM, gsz = (nM - fm) < WGM ? (nM - fm) : WGM;
        u.pm = fm + ((wgid % nig) % gsz); u.pn = (wgid % nig) / gsz; return true;
    }
    __device__ __forceinline__ void a_ready(const Unit&) const {}
    __device__ __forceinline__ void done(const Unit&) const {}
};

struct EpiF32 {
    static constexpr bool PERM = false, AFTER_DRAIN = false, HAS_MID = false, USES_RSTD = false;
    float* C; int ldc;
    __device__ __forceinline__ void operator()(const f32x4 (&acc)[2][2][4][2], const Unit& u, int wr, int wc, int fr, int fq, const LAS float* rsl) const {
        const int row0 = u.pm * BM + wr * 64 + fr, col0 = u.pn * BM + wc * 32 + 4 * fq;
#pragma unroll
        for (int ai = 0; ai < 2; ++ai)
#pragma unroll
            for (int m = 0; m < 4; ++m) { float* rowp = C + (size_t)(row0 + ai * HALF + m * 16) * ldc + col0;
#pragma unroll
                for (int bj = 0; bj < 2; ++bj)
#pragma unroll
                    for (int n = 0; n < 2; ++n) *(f32x4*)(rowp + bj * HALF + n * 16) = acc[ai][bj][m][n]; }
    }
};
struct EpiBf16Plain {
    static constexpr bool PERM = true, AFTER_DRAIN = false, HAS_MID = false, USES_RSTD = false;
    bf16_t* C; int ldc;
    __device__ __forceinline__ void operator()(const f32x4 (&acc)[2][2][4][2], const Unit& u, int wr, int wc, int fr, int fq, const LAS float* rsl) const {
        const int row0 = u.pm * BM + wr * 64 + fr, col0 = u.pn * BM + wc * 32 + 8 * fq;
#pragma unroll
        for (int ai = 0; ai < 2; ++ai)
#pragma unroll
            for (int m = 0; m < 4; ++m) { bf16_t* p = C + (size_t)(row0 + ai * HALF + m * 16) * ldc + col0;
#pragma unroll
                for (int bj = 0; bj < 2; ++bj) { const f32x4 v0 = acc[ai][bj][m][0], v1 = acc[ai][bj][m][1];
                    u32x4 w; w.x = cvt_pk_bf16(v0[0], v0[1]); w.y = cvt_pk_bf16(v0[2], v0[3]); w.z = cvt_pk_bf16(v1[0], v1[1]); w.w = cvt_pk_bf16(v1[2], v1[3]);
                    *(u32x4*)(p + bj * HALF) = w; } }
    }
};
__device__ __forceinline__ float silu_f(float g) { return g * __builtin_amdgcn_rcpf(1.0f + __builtin_amdgcn_exp2f(-1.4426950408889634f * g)); }
__device__ __forceinline__ float sigmoid_f(float g) { return __builtin_amdgcn_rcpf(1.0f + __builtin_amdgcn_exp2f(-1.4426950408889634f * g)); }
struct EpiSwiGLU {
    static constexpr bool PERM = true, AFTER_DRAIN = false, HAS_MID = false, USES_RSTD = true;
    bf16_t* H; const float* rstd;
    __device__ __forceinline__ void operator()(const f32x4 (&acc)[2][2][4][2], const Unit& u, int wr, int wc, int fr, int fq, const LAS float* rsl) const {
        const int row0 = u.pm * BM + wr * 64 + fr, col0 = u.pn * HALF + wc * 32 + 8 * fq;
#pragma unroll
        for (int ai = 0; ai < 2; ++ai)
#pragma unroll
            for (int m = 0; m < 4; ++m) { bf16_t* p = H + (size_t)(row0 + ai * HALF + m * 16) * FF + col0; const float rs = rsl[wr * 64 + fr + ai * HALF + m * 16];
                const f32x4 g0 = acc[ai][0][m][0] * rs, g1 = acc[ai][0][m][1] * rs, u0 = acc[ai][1][m][0] * rs, u1 = acc[ai][1][m][1] * rs;
                u32x4 w; w.x = cvt_pk_bf16(silu_f(g0[0]) * u0[0], silu_f(g0[1]) * u0[1]); w.y = cvt_pk_bf16(silu_f(g0[2]) * u0[2], silu_f(g0[3]) * u0[3]);
                w.z = cvt_pk_bf16(silu_f(g1[0]) * u1[0], silu_f(g1[1]) * u1[1]); w.w = cvt_pk_bf16(silu_f(g1[2]) * u1[2], silu_f(g1[3]) * u1[3]);
                *(u32x4*)p = w; }
    }
};
__device__ __forceinline__ float gate_k(float x) { return fmaxf(__builtin_rintf(sigmoid_f(x) * 255.0f), 1.0f); }
__device__ __forceinline__ unsigned gate_q4(const f32x4 v) { unsigned w = __builtin_amdgcn_cvt_pk_u8_f32(gate_k(v[0]), 0u, 0u); w = __builtin_amdgcn_cvt_pk_u8_f32(gate_k(v[1]), 1u, w);
    w = __builtin_amdgcn_cvt_pk_u8_f32(gate_k(v[2]), 2u, w); return __builtin_amdgcn_cvt_pk_u8_f32(gate_k(v[3]), 3u, w); }
__device__ __forceinline__ f32x4 ub4(unsigned w) { return (f32x4){(float)(w & 0xffu), (float)((w >> 8) & 0xffu), (float)((w >> 16) & 0xffu), (float)(w >> 24)}; }
__device__ __forceinline__ f32x4 rcp4(const f32x4 v) { return (f32x4){__builtin_amdgcn_rcpf(v[0]), __builtin_amdgcn_rcpf(v[1]), __builtin_amdgcn_rcpf(v[2]), __builtin_amdgcn_rcpf(v[3])}; }
struct EpiProj {
    static constexpr bool PERM = true, AFTER_DRAIN = false, HAS_MID = false, USES_RSTD = true;
    bf16_t* PROJ; u32x4* GQ; float* LR; const float* gbias; const float* rstd;
    __device__ __forceinline__ void operator()(const f32x4 (&acc)[2][2][4][2], const Unit& u, int wr, int wc, int fr, int fq, const LAS float* rsl) const {
        const int row0 = u.pm * BM + wr * 64 + fr;
        if (u.pn < 18) {
            const int col0 = u.pn * BM + wc * 32 + 8 * fq;
#pragma unroll
            for (int ai = 0; ai < 2; ++ai)
#pragma unroll
                for (int m = 0; m < 4; ++m) { bf16_t* p = PROJ + (size_t)(row0 + ai * HALF + m * 16) * NPROJ + col0; const float rs = rsl[wr * 64 + fr + ai * HALF + m * 16];
#pragma unroll
                    for (int bj = 0; bj < 2; ++bj) { const f32x4 v0 = acc[ai][bj][m][0] * rs, v1 = acc[ai][bj][m][1] * rs;
                        u32x4 w; w.x = cvt_pk_bf16(v0[0], v0[1]); w.y = cvt_pk_bf16(v0[2], v0[3]); w.z = cvt_pk_bf16(v1[0], v1[1]); w.w = cvt_pk_bf16(v1[2], v1[3]);
                        *(u32x4*)(p + bj * HALF) = w; } }
        } else if (u.pn < 42) {
            const int gt = u.pn - 18, col0 = gt * BM + wc * 32 + 8 * fq;
            const f32x4 b00 = *(const f32x4*)(gbias + col0), b01 = *(const f32x4*)(gbias + col0 + 4), b10 = *(const f32x4*)(gbias + col0 + HALF), b11 = *(const f32x4*)(gbias + col0 + HALF + 4);
            u32x4* gq = GQ + ((size_t)((gt >> 3) * (M / BM) + u.pm) * 8 + (gt & 7)) * 4096 + (wr * 4 + wc) * 512 + (fq * 16 + fr);
#pragma unroll
            for (int ai = 0; ai < 2; ++ai)
#pragma unroll
                for (int m = 0; m < 4; ++m) { const float rs = rsl[wr * 64 + fr + ai * HALF + m * 16];
                    u32x4 w; w.x = gate_q4(acc[ai][0][m][0] * rs + b00); w.y = gate_q4(acc[ai][0][m][1] * rs + b01); w.z = gate_q4(acc[ai][1][m][0] * rs + b10); w.w = gate_q4(acc[ai][1][m][1] * rs + b11);
                    gq[(ai * 4 + m) * 64] = w; }
        } else {
            if (wc == 0) {
#pragma unroll
                for (int ai = 0; ai < 2; ++ai)
#pragma unroll
                    for (int m = 0; m < 4; ++m) { float* p = LR + (size_t)(row0 + ai * HALF + m * 16) * 32 + 8 * fq; const float rs = rsl[wr * 64 + fr + ai * HALF + m * 16];
                        *(f32x4*)p = acc[ai][0][m][0] * rs; *(f32x4*)(p + 4) = acc[ai][0][m][1] * rs; }
            }
        }
    }
};
struct EpiMerge3 {
    static constexpr bool PERM = true, AFTER_DRAIN = false, HAS_MID = true, USES_RSTD = false;
    static constexpr int MID0 = 1024 / BK, MID1 = 1536 / BK;
    static constexpr size_t GSTRIDE = (size_t)(M / BM) * 8 * 4096;
    const u32x4* GQ; bf16_t* MG;
    __device__ __forceinline__ void mid(f32x4 (&acc)[2][2][4][2], const Unit& u, int seg, int wr, int wc, int fr, int fq) const {
        const u32x4* gp = GQ + (size_t)seg * GSTRIDE + ((size_t)u.pm * 8 + u.pn) * 4096 + (wr * 4 + wc) * 512 + (fq * 16 + fr);
        u32x4 gn[8], gd[8];
#pragma unroll
        for (int j = 0; j < 8; ++j) { gn[j] = gp[j * 64]; gd[j] = gp[GSTRIDE + j * 64]; }
#pragma unroll
        for (int j = 0; j < 8; ++j) { const int ai = j >> 2, m = j & 3;
            acc[ai][0][m][0] = acc[ai][0][m][0] * (ub4(gn[j].x) * rcp4(ub4(gd[j].x))); acc[ai][0][m][1] = acc[ai][0][m][1] * (ub4(gn[j].y) * rcp4(ub4(gd[j].y)));
            acc[ai][1][m][0] = acc[ai][1][m][0] * (ub4(gn[j].z) * rcp4(ub4(gd[j].z))); acc[ai][1][m][1] = acc[ai][1][m][1] * (ub4(gn[j].w) * rcp4(ub4(gd[j].w))); }
    }
    __device__ __forceinline__ void operator()(const f32x4 (&acc)[2][2][4][2], const Unit& u, int wr, int wc, int fr, int fq, const LAS float* rsl) const {
        const int row0 = u.pm * BM + wr * 64 + fr, col0 = u.pn * BM + wc * 32 + 8 * fq;
        const u32x4* gp = GQ + 2 * GSTRIDE + ((size_t)u.pm * 8 + u.pn) * 4096 + (wr * 4 + wc) * 512 + (fq * 16 + fr);
        u32x4 gc[8];
#pragma unroll
        for (int j = 0; j < 8; ++j) gc[j] = gp[j * 64];
        constexpr float S = 1.0f / 255.0f;
#pragma unroll
        for (int j = 0; j < 8; ++j) { const int ai = j >> 2, m = j & 3; bf16_t* p = MG + (size_t)(row0 + ai * HALF + m * 16) * D + col0;
            const f32x4 v0 = acc[ai][0][m][0] * (ub4(gc[j].x) * S), v1 = acc[ai][0][m][1] * (ub4(gc[j].y) * S), v2 = acc[ai][1][m][0] * (ub4(gc[j].z) * S), v3 = acc[ai][1][m][1] * (ub4(gc[j].w) * S);
            u32x4 w; w.x = cvt_pk_bf16(v0[0], v0[1]); w.y = cvt_pk_bf16(v0[2], v0[3]); w.z = cvt_pk_bf16(v1[0], v1[1]); w.w = cvt_pk_bf16(v1[2], v1[3]); *(u32x4*)p = w;
            w.x = cvt_pk_bf16(v2[0], v2[1]); w.y = cvt_pk_bf16(v2[2], v2[3]); w.z = cvt_pk_bf16(v3[0], v3[1]); w.w = cvt_pk_bf16(v3[2], v3[3]); *(u32x4*)(p + HALF) = w; }
    }
};

template <class Epi, class Sched, bool ALIGN_EPI = false, bool SP2 = false>
__device__ __forceinline__ void gemm_phase(LAS unsigned char* lds, const Gemm g, const Sched& S, const Epi& E) {
    const int tid = opaque_tid(), wid = __builtin_amdgcn_readfirstlane(tid >> 6), lane = tid & 63, wr = wid >> 2, wc = wid & 3, fr = lane & 15, fq = lane >> 4;
    const int K = g.K, nt = K / BK, lda = g.lda;
    unsigned voffA[2], voffB[2];
#pragma unroll
    for (int i = 0; i < 2; ++i) { int R, C; stage_rc(tid * 16 + i * 8192, R, C); const int Rb = Epi::PERM ? ((R & ~31) + perm32(R & 31)) : R;
        voffA[i] = (unsigned)(R * lda + C) * 2u; voffB[i] = (unsigned)(Rb * K + C) * 2u; }
    const unsigned kstep = (unsigned)(BK * 2);
    const unsigned hstepA = (unsigned)HALF * (unsigned)lda * 2u, hstepB = (unsigned)HALF * (unsigned)K * 2u;
    const unsigned tstepA = 2u * hstepA, tstepB = 2u * hstepB;
    const unsigned ldsw = (unsigned)wid * 1024u;
    const int aoff = lds_byte(wr * 64 + fr, fq * 8), boff = lds_byte(wc * 32 + fr, fq * 8);
    const char* const baseA = (const char*)g.A; const char* const baseB = (const char*)g.Bt;
#define PG8_SA(b, h) (((b) * 2 + (h)) * HTB)
#define PG8_SB(b, h) ((4 + (b) * 2 + (h)) * HTB)
#define PG8_STAGE(bufoff, gbase, goff, voff) do { _Pragma("unroll") for (int _i = 0; _i < 2; ++_i) \
        __builtin_amdgcn_global_load_lds((const unsigned*)((gbase) + (size_t)(unsigned)((goff) + (voff)[_i])), (LAS unsigned*)(lds + (bufoff) + ldsw + _i * 8192), 16, 0, 0); } while (0)
#define PG8_LDA(dst, b, h) do { _Pragma("unroll") for (int m = 0; m < 4; ++m) _Pragma("unroll") for (int k = 0; k < 2; ++k) dst[m][k] = *(const LAS bf16x8*)(lds + PG8_SA(b, h) + aoff + m * 2048 + k * 1024); } while (0)
#define PG8_LDB(dst, b, h) do { _Pragma("unroll") for (int n = 0; n < 2; ++n) _Pragma("unroll") for (int k = 0; k < 2; ++k) dst[n][k] = *(const LAS bf16x8*)(lds + PG8_SB(b, h) + boff + n * 2048 + k * 1024); } while (0)
#define PG8_MMA(ai, bj, At, Bt) do { __builtin_amdgcn_s_setprio(1); _Pragma("unroll") for (int m = 0; m < 4; ++m) _Pragma("unroll") for (int n = 0; n < 2; ++n) _Pragma("unroll") for (int k = 0; k < 2; ++k) \
        acc[ai][bj][m][n] = __builtin_amdgcn_mfma_f32_16x16x32_bf16(Bt[n][k], At[m][k], acc[ai][bj][m][n], 0, 0, 0); __builtin_amdgcn_s_setprio(0); } while (0)
#define PG8_WAIT_V(n) asm volatile("s_waitcnt vmcnt(" #n ")" ::: "memory")
#define PG8_WAIT_L(n) asm volatile("s_waitcnt lgkmcnt(" #n ")" ::: "memory")
#define PG8_BAR __builtin_amdgcn_s_barrier()
#define PG8_SCHED __builtin_amdgcn_sched_barrier(0)
    Unit cur, nxt; int ui = 0;
    if (!S.next(0, cur)) return;
    constexpr int RS_OFF = 131072 + 8192;
#define PG8_RSTD(u_, slot_) do { if constexpr (Epi::USES_RSTD) { if (wid == 0) __builtin_amdgcn_global_load_lds((const unsigned*)(E.rstd + (size_t)(u_).pm * BM + lane * 4), (LAS unsigned*)(lds + RS_OFF + (slot_) * 1024), 16, 0, 0); } } while (0)
    PG8_RSTD(cur, 0);
    f32x4 acc[2][2][4][2];
#pragma unroll
    for (int a = 0; a < 2; ++a)
#pragma unroll
        for (int b = 0; b < 2; ++b)
#pragma unroll
            for (int m = 0; m < 4; ++m)
#pragma unroll
                for (int n = 0; n < 2; ++n) acc[a][b][m][n] = (f32x4){0.f, 0.f, 0.f, 0.f};
    bf16x8 At[4][2], B0[2][2], B1[2][2];
    unsigned cA = (unsigned)cur.pm * tstepA, cB = (unsigned)cur.pn * tstepB;
    S.a_ready(cur);
    if constexpr (SP2) {
        PG8_STAGE(PG8_SB(0, 0), baseB, cB, voffB); PG8_STAGE(PG8_SB(0, 1), baseB, cB + hstepB, voffB); PG8_STAGE(PG8_SA(0, 0), baseA, cA, voffA); PG8_STAGE(PG8_SA(0, 1), baseA, cA + hstepA, voffA);
        if (wr == 1) PG8_BAR;
        PG8_WAIT_V(2); PG8_BAR;
        PG8_STAGE(PG8_SB(1, 0), baseB, cB + kstep, voffB); PG8_STAGE(PG8_SA(1, 0), baseA, cA + kstep, voffA); PG8_STAGE(PG8_SB(1, 1), baseB, cB + hstepB + kstep, voffB);
        PG8_WAIT_V(6); PG8_BAR;
    } else {
        PG8_STAGE(PG8_SB(0, 0), baseB, cB, voffB); PG8_STAGE(PG8_SA(0, 0), baseA, cA, voffA); PG8_STAGE(PG8_SB(0, 1), baseB, cB + hstepB, voffB); PG8_STAGE(PG8_SA(0, 1), baseA, cA + hstepA, voffA);
        if (wr == 1) PG8_BAR;
        PG8_WAIT_V(4); PG8_BAR;
        PG8_STAGE(PG8_SB(1, 0), baseB, cB + kstep, voffB); PG8_STAGE(PG8_SA(1, 0), baseA, cA + kstep, voffA); PG8_STAGE(PG8_SB(1, 1), baseB, cB + hstepB + kstep, voffB);
        PG8_WAIT_V(6); PG8_BAR;
    }
    for (;;) {
        const bool has_next = S.next(ui + 1, nxt);
        const unsigned nA = has_next ? (unsigned)nxt.pm * tstepA : cA, nB = has_next ? (unsigned)nxt.pn * tstepB : cB;
        for (int t = 0; t < nt; t += 2) {
            const bool last = (t == nt - 2);
            if constexpr (Epi::HAS_MID) { if (t == Epi::MID0 || t == Epi::MID1) E.mid(acc, cur, t == Epi::MID0 ? 0 : 1, wr, wc, fr, fq); }
            const unsigned a1 = cA + (unsigned)(t + 1) * kstep;
            const unsigned a2 = last ? nA : cA + (unsigned)(t + 2) * kstep, b2 = last ? nB : cB + (unsigned)(t + 2) * kstep;
            const unsigned a3 = a2 + kstep, b3 = b2 + kstep;
            if (last && has_next) S.a_ready(nxt);
            if constexpr (SP2) {
            PG8_LDB(B0, 0, 0); PG8_LDB(B1, 0, 1); PG8_SCHED; PG8_LDA(At, 0, 0); PG8_STAGE(PG8_SA(1, 1), baseA, a1 + hstepA, voffA);
            PG8_WAIT_V(8); PG8_WAIT_L(0); PG8_BAR; PG8_MMA(0, 0, At, B0); PG8_MMA(0, 1, At, B1); PG8_BAR; PG8_SCHED;
            PG8_LDA(At, 0, 1); PG8_STAGE(PG8_SB(0, 0), baseB, b2, voffB); PG8_STAGE(PG8_SB(0, 1), baseB, b2 + hstepB, voffB); PG8_STAGE(PG8_SA(0, 0), baseA, a2, voffA);
            PG8_WAIT_V(8); PG8_WAIT_L(0); PG8_BAR; PG8_MMA(1, 0, At, B0); PG8_MMA(1, 1, At, B1); PG8_BAR; PG8_SCHED;
            PG8_LDB(B0, 1, 0); PG8_LDB(B1, 1, 1); PG8_SCHED; PG8_LDA(At, 1, 0); PG8_STAGE(PG8_SA(0, 1), baseA, a2 + hstepA, voffA);
            PG8_WAIT_V(8); PG8_WAIT_L(0); PG8_BAR; PG8_MMA(0, 0, At, B0); PG8_MMA(0, 1, At, B1); PG8_BAR; PG8_SCHED;
            PG8_LDA(At, 1, 1); PG8_STAGE(PG8_SB(1, 0), baseB, b3, voffB); PG8_STAGE(PG8_SB(1, 1), baseB, b3 + hstepB, voffB); PG8_STAGE(PG8_SA(1, 0), baseA, a3, voffA);
            PG8_WAIT_V(8); PG8_WAIT_L(0); PG8_BAR; PG8_MMA(1, 0, At, B0); PG8_MMA(1, 1, At, B1); PG8_BAR; PG8_SCHED;
            } else {
            PG8_LDB(B0, 0, 0); PG8_SCHED; PG8_LDA(At, 0, 0); PG8_STAGE(PG8_SA(1, 1), baseA, a1 + hstepA, voffA);
            PG8_WAIT_L(8); PG8_BAR; PG8_WAIT_L(0); PG8_MMA(0, 0, At, B0); PG8_BAR; PG8_SCHED;
            PG8_LDB(B1, 0, 1); PG8_STAGE(PG8_SB(0, 0), baseB, b2, voffB);
            PG8_BAR; PG8_WAIT_L(0); PG8_MMA(0, 1, At, B1); PG8_BAR;
            PG8_LDA(At, 0, 1); PG8_STAGE(PG8_SA(0, 0), baseA, a2, voffA);
            PG8_BAR; PG8_WAIT_L(0); PG8_MMA(1, 0, At, B0); PG8_BAR; PG8_SCHED;
            PG8_STAGE(PG8_SB(0, 1), baseB, b2 + hstepB, voffB);
            PG8_WAIT_V(6); PG8_BAR; PG8_MMA(1, 1, At, B1); PG8_BAR;
            PG8_LDB(B0, 1, 0); PG8_SCHED; PG8_LDA(At, 1, 0); PG8_STAGE(PG8_SA(0, 1), baseA, a2 + hstepA, voffA);
            PG8_WAIT_L(8); PG8_BAR; PG8_WAIT_L(0); PG8_MMA(0, 0, At, B0); PG8_BAR; PG8_SCHED;
            PG8_LDB(B1, 1, 1); PG8_STAGE(PG8_SB(1, 0), baseB, b3, voffB);
            PG8_BAR; PG8_WAIT_L(0); PG8_MMA(0, 1, At, B1); PG8_BAR;
            PG8_LDA(At, 1, 1); PG8_STAGE(PG8_SA(1, 0), baseA, a3, voffA);
            PG8_BAR; PG8_WAIT_L(0); PG8_MMA(1, 0, At, B0); PG8_BAR; PG8_SCHED;
            PG8_STAGE(PG8_SB(1, 1), baseB, b3 + hstepB, voffB);
            PG8_WAIT_V(6); PG8_BAR; PG8_MMA(1, 1, At, B1); PG8_BAR;
            }
        }
        if constexpr (ALIGN_EPI) { if (wr == 0) PG8_BAR; }
        if constexpr (!Epi::AFTER_DRAIN) { E(acc, cur, wr, wc, fr, fq, (const LAS float*)(lds + RS_OFF + (ui & 1) * 1024)); S.done(cur); }
        if (!has_next) break;
#pragma unroll
        for (int a = 0; a < 2; ++a)
#pragma unroll
            for (int b = 0; b < 2; ++b)
#pragma unroll
                for (int m = 0; m < 4; ++m)
#pragma unroll
                    for (int n = 0; n < 2; ++n) acc[a][b][m][n] = (f32x4){0.f, 0.f, 0.f, 0.f};
        cur = nxt; cA = nA; cB = nB; ++ui;
        PG8_RSTD(cur, ui & 1);
        if constexpr (ALIGN_EPI) { if (wr == 1) PG8_BAR; }
    }
    PG8_WAIT_V(0);
    if constexpr (!ALIGN_EPI) { if (wr == 0) PG8_BAR; }
    PG8_BAR;
#undef PG8_SA
#undef PG8_SB
#undef PG8_STAGE
#undef PG8_LDA
#undef PG8_LDB
#undef PG8_MMA
#undef PG8_WAIT_V
#undef PG8_WAIT_L
#undef PG8_BAR
#undef PG8_SCHED
}
}

namespace att {
constexpr int DH = 128, NW = 8, QBLK = 32, KVBLK = 64;
constexpr float SCALE = 0.088388347648318440f;
constexpr float THR = 8.f;
constexpr int LD = NPROJ, LDO = 2048;
constexpr size_t SHM_V = KVBLK * DH * 2, SHM_K = KVBLK * DH * 2, SHM_ATTN = 2 * SHM_V + 2 * SHM_K + NW * 64 * 4;
#define KSWZ(row, colB) ((row) * 256 + ((colB) ^ (((row) & 7) << 4)))
#define SBAR() __builtin_amdgcn_sched_barrier(0)
__device__ __forceinline__ int crow(int r, int hi) { return (r & 3) + 8 * (r >> 2) + 4 * hi; }
__device__ __forceinline__ void partialSM(f32x16& p0, f32x16& p1, float& m_reg, float& mn, float& alpha) {
  constexpr float C = SCALE * 1.4426950408889634f;
  float pmax = p0[0];
#pragma unroll
  for (int r = 1; r < 16; ++r) pmax = fmaxf(pmax, p0[r]);
#pragma unroll
  for (int r = 0; r < 16; ++r) pmax = fmaxf(pmax, p1[r]);
  { auto rr = __builtin_amdgcn_permlane32_swap(__float_as_uint(pmax), __float_as_uint(pmax), false, false);
    pmax = fmaxf(__uint_as_float(rr[0]), __uint_as_float(rr[1])); }
  if (__builtin_expect(__all(pmax - m_reg <= THR / SCALE), 1)) { mn = m_reg; alpha = 1.f; }
  else { mn = fmaxf(m_reg, pmax); alpha = __builtin_amdgcn_exp2f((m_reg - mn) * C); m_reg = mn; }
  float mnC = -mn * C;
#pragma unroll
  for (int r = 0; r < 16; ++r) p0[r] = fmaf(p0[r], C, mnC);
#pragma unroll
  for (int r = 0; r < 16; ++r) p1[r] = fmaf(p1[r], C, mnC);
#pragma unroll
  for (int r = 0; r < 16; ++r) p0[r] = __builtin_amdgcn_exp2f(p0[r]);
}
__device__ __forceinline__ void finishSM(f32x16& p0, f32x16& p1, float alpha, float& l_reg, bf16x8& pa0, bf16x8& pa1, bf16x8& pa2, bf16x8& pa3) {
#pragma unroll
  for (int r = 0; r < 16; ++r) p1[r] = __builtin_amdgcn_exp2f(p1[r]);
  float ps = 0;
#pragma unroll
  for (int r = 0; r < 16; ++r) ps += p0[r];
#pragma unroll
  for (int r = 0; r < 16; ++r) ps += p1[r];
  { auto rr = __builtin_amdgcn_permlane32_swap(__float_as_uint(ps), __float_as_uint(ps), false, false);
    ps = __uint_as_float(rr[0]) + __uint_as_float(rr[1]); }
  l_reg = l_reg * alpha + ps;
#define PK4(P, BASE, OUT) do { unsigned a0 = cvt_pk_bf16(P[BASE + 0], P[BASE + 1]), a1 = cvt_pk_bf16(P[BASE + 2], P[BASE + 3]);   \
    unsigned b0 = cvt_pk_bf16(P[BASE + 4], P[BASE + 5]), b1 = cvt_pk_bf16(P[BASE + 6], P[BASE + 7]);                              \
    auto r0 = __builtin_amdgcn_permlane32_swap(a0, b0, false, false); auto r1 = __builtin_amdgcn_permlane32_swap(a1, b1, false, false); \
    u32x4 w = {r0[0], r1[0], r0[1], r1[1]}; OUT = *reinterpret_cast<bf16x8*>(&w); } while (0)
  PK4(p0, 0, pa0); PK4(p0, 8, pa1); PK4(p1, 0, pa2); PK4(p1, 8, pa3);
#undef PK4
}
__device__ __forceinline__ void qkt(f32x16& p0, f32x16& p1, const bf16_t* Ks, const bf16x8* qr, int r32, int hi) {
  p0 = f32x16{}; p1 = f32x16{};
#pragma unroll
  for (int d0 = 0; d0 < 8; ++d0) { int cb = (d0 * 16 + hi * 8) * 2;
    bf16x8 b0 = *reinterpret_cast<const bf16x8*>((const char*)Ks + KSWZ(r32, cb));
    bf16x8 b1 = *reinterpret_cast<const bf16x8*>((const char*)Ks + KSWZ(32 + r32, cb));
    p0 = __builtin_amdgcn_mfma_f32_32x32x16_bf16(b0, qr[d0], p0, 0, 0, 0);
    p1 = __builtin_amdgcn_mfma_f32_32x32x16_bf16(b1, qr[d0], p1, 0, 0, 0); }
}
__device__ __forceinline__ int v_st(int k, int c) { const int kk = (k & ~0xC) | ((k & 4) << 1) | ((k & 8) >> 1); return ((kk >> 3) * 4 + (c >> 5)) * 512 + ((kk & 7) * 32 + (c & 31)) * 2; }
__device__ __forceinline__ int v_rd_base(int lane) { return ((lane & 3) << 3) | (((lane >> 2) & 3) << 6) | (((lane >> 4) & 1) << 5) | (((lane >> 5) & 1) << 8); }
constexpr int v_rd_off(int d0, int ks, int half) { return d0 * 512 + ks * 4096 + half * 2048; }
template <int OFF> __device__ __forceinline__ s16x4 tr_read(int vb) {
  s16x4 r; asm volatile("ds_read_b64_tr_b16 %0, %1 offset:%2" : "=&v"(r) : "v"(vb), "i"(OFF) : "memory"); return r;
}
template <int D0> __device__ __forceinline__ void pv_one(f32x16& od, int vb, bf16x8 pa0, bf16x8 pa1, bf16x8 pa2, bf16x8 pa3) {
  const s16x4 l0 = tr_read<v_rd_off(D0, 0, 0)>(vb), h0 = tr_read<v_rd_off(D0, 0, 1)>(vb), l1 = tr_read<v_rd_off(D0, 1, 0)>(vb), h1 = tr_read<v_rd_off(D0, 1, 1)>(vb);
  const s16x4 l2 = tr_read<v_rd_off(D0, 2, 0)>(vb), h2 = tr_read<v_rd_off(D0, 2, 1)>(vb), l3 = tr_read<v_rd_off(D0, 3, 0)>(vb), h3 = tr_read<v_rd_off(D0, 3, 1)>(vb);
  asm volatile("s_waitcnt lgkmcnt(0)" ::: "memory"); SBAR();
#define PK(L, H) (bf16x8){L[0], L[1], L[2], L[3], H[0], H[1], H[2], H[3]}
  od = __builtin_amdgcn_mfma_f32_32x32x16_bf16(pa0, PK(l0, h0), od, 0, 0, 0);
  od = __builtin_amdgcn_mfma_f32_32x32x16_bf16(pa1, PK(l1, h1), od, 0, 0, 0);
  od = __builtin_amdgcn_mfma_f32_32x32x16_bf16(pa2, PK(l2, h2), od, 0, 0, 0);
  od = __builtin_amdgcn_mfma_f32_32x32x16_bf16(pa3, PK(l3, h3), od, 0, 0, 0);
#undef PK
}
__device__ __forceinline__ void pv_d0(f32x16* o, int vb, bf16x8 pa0, bf16x8 pa1, bf16x8 pa2, bf16x8 pa3) {
  pv_one<0>(o[0], vb, pa0, pa1, pa2, pa3); pv_one<1>(o[1], vb, pa0, pa1, pa2, pa3); pv_one<2>(o[2], vb, pa0, pa1, pa2, pa3); pv_one<3>(o[3], vb, pa0, pa1, pa2, pa3);
}
__device__ __forceinline__ void attn_dense_body(const bf16_t* Qb, const bf16_t* __restrict__ Kh, const bf16_t* __restrict__ Vh, bf16_t* Ob, int seq, char* lds, const float* qgain  , const f32x2* cs  , int t0  ) {
  const int tid = opaque_tid(), wid = tid >> 6, lane = tid & 63, r32 = lane & 31, hi = lane >> 5;
  bf16_t* V_lds = (bf16_t*)lds; bf16_t* K_lds = (bf16_t*)(lds + 2 * SHM_V);
  float* ws = (float*)(lds + 2 * SHM_V + 2 * SHM_K) + wid * 64; float* li_l = ws; float* al_l = ws + 32;
  float m_reg = -1e30f, l_reg = 0; f32x16 o[4] = {}; bf16x8 qr[8];
  const bf16_t* Qw = Qb + (long)(wid * QBLK + r32) * LD + hi * 8;
#pragma unroll
  for (int d0 = 0; d0 < 8; ++d0) qr[d0] = *reinterpret_cast<const bf16x8*>(Qw + d0 * 16);
  {
    float ss = 0.f;
#pragma unroll
    for (int d0 = 0; d0 < 8; ++d0) { const u32x4 w = *reinterpret_cast<const u32x4*>(&qr[d0]);
      ss += (bflo(w.x) * bflo(w.x) + bfhi(w.x) * bfhi(w.x)) + (bflo(w.y) * bflo(w.y) + bfhi(w.y) * bfhi(w.y)) + (bflo(w.z) * bflo(w.z) + bfhi(w.z) * bfhi(w.z)) + (bflo(w.w) * bflo(w.w) + bfhi(w.w) * bfhi(w.w)); }
    { auto rr = __builtin_amdgcn_permlane32_swap(__float_as_uint(ss), __float_as_uint(ss), false, false); ss = __uint_as_float(rr[0]) + __uint_as_float(rr[1]); }
    const float rstd = 1.0f / sqrtf(ss * (1.0f / 128.0f) + EPS);
    const int t = t0 + wid * QBLK + r32, pr = t >> 6, pc = t & 63;
#pragma unroll
    for (int d0 = 0; d0 < 8; ++d0) {
      const f32x4 g0 = *(const f32x4*)(qgain + d0 * 16 + hi * 8) * rstd, g1 = *(const f32x4*)(qgain + d0 * 16 + hi * 8 + 4) * rstd;
      const f32x4* cp = (const f32x4*)(cs + ((d0 < 4) ? pr : pc) * 32 + (d0 & 3) * 8 + hi * 4); const f32x4 ca = cp[0], cb = cp[1];
      const u32x4 w = *reinterpret_cast<const u32x4*>(&qr[d0]); u32x4 o;
      { const float n1 = bflo(w.x) * g0[0], n2 = bfhi(w.x) * g0[1]; o.x = cvt_pk_bf16(n1 * ca[0] - n2 * ca[1], n1 * ca[1] + n2 * ca[0]); }
      { const float n1 = bflo(w.y) * g0[2], n2 = bfhi(w.y) * g0[3]; o.y = cvt_pk_bf16(n1 * ca[2] - n2 * ca[3], n1 * ca[3] + n2 * ca[2]); }
      { const float n1 = bflo(w.z) * g1[0], n2 = bfhi(w.z) * g1[1]; o.z = cvt_pk_bf16(n1 * cb[0] - n2 * cb[1], n1 * cb[1] + n2 * cb[0]); }
      { const float n1 = bflo(w.w) * g1[2], n2 = bfhi(w.w) * g1[3]; o.w = cvt_pk_bf16(n1 * cb[2] - n2 * cb[3], n1 * cb[3] + n2 * cb[2]); }
      qr[d0] = *reinterpret_cast<const bf16x8*>(&o);
    }
  }
  const int sr = tid >> 4, sc = (tid & 15) * 8, vst0 = v_st(sr, sc), vst1 = v_st(32 + sr, sc);
  const int vb0 = (int)(uintptr_t)V_lds + v_rd_base(lane);
  struct { bf16x8 vs0, vs1, ks0, ks1; } sr_[1];
#define SLOAD(i, k0) do { sr_[i].vs0 = *reinterpret_cast<const bf16x8*>(&Vh[(long)((k0) + sr) * LD + sc]); sr_[i].vs1 = *reinterpret_cast<const bf16x8*>(&Vh[(long)((k0) + 32 + sr) * LD + sc]); \
    sr_[i].ks0 = *reinterpret_cast<const bf16x8*>(&Kh[(long)((k0) + sr) * LD + sc]); sr_[i].ks1 = *reinterpret_cast<const bf16x8*>(&Kh[(long)((k0) + 32 + sr) * LD + sc]); } while (0)
#define SWRITE(b, i) do { *(bf16x8*)((char*)V_lds + (b) * SHM_V + vst0) = sr_[i].vs0;          \
    *(bf16x8*)((char*)V_lds + (b) * SHM_V + vst1) = sr_[i].vs1; int kc = sc * 2;               \
    *(bf16x8*)((char*)K_lds + (b) * SHM_K + KSWZ(sr, kc)) = sr_[i].ks0;                       \
    *(bf16x8*)((char*)K_lds + (b) * SHM_K + KSWZ(32 + sr, kc)) = sr_[i].ks1; } while (0)
#define SWAIT() asm volatile("s_waitcnt vmcnt(0)" ::: "memory")
#define RESC(a) do { if (__any((a) < 1.f)) { if (hi == 0) al_l[r32] = (a); asm volatile("s_waitcnt lgkmcnt(0)" ::: "memory"); \
    _Pragma("unroll") for (int d = 0; d < 4; ++d) _Pragma("unroll") for (int r = 0; r < 16; ++r) o[d][r] *= al_l[crow(r, hi)]; } } while (0)
  f32x16 pA0, pA1, pB0, pB1; float mnA, mnB, alA, alB; bf16x8 pa0, pa1, pa2, pa3; const int NT = seq / KVBLK;
  constexpr int SE = 0, SO = 0;
  SLOAD(SE, 0); asm volatile("s_waitcnt vmcnt(0)" ::: "memory"); SWRITE(0, SE); __syncthreads();
  qkt(pA0, pA1, K_lds, qr, r32, hi); partialSM(pA0, pA1, m_reg, mnA, alA);
  SLOAD(SO, KVBLK);
  SWAIT(); SWRITE(1, SO); __syncthreads();
  for (int j = 1; j + 1 < NT; j += 2) {
    SBAR(); qkt(pB0, pB1, (bf16_t*)((char*)K_lds + SHM_K), qr, r32, hi);
    finishSM(pA0, pA1, alA, l_reg, pa0, pa1, pa2, pa3); SBAR();
    SLOAD(SO, (j + 1) * KVBLK); SBAR();
    pv_d0(o, vb0, pa0, pa1, pa2, pa3); partialSM(pB0, pB1, m_reg, mnB, alB);
    __syncthreads(); SWAIT(); SWRITE(0, SE);
    RESC(alB); __syncthreads();
    SBAR(); qkt(pA0, pA1, K_lds, qr, r32, hi);
    finishSM(pB0, pB1, alB, l_reg, pa0, pa1, pa2, pa3); SBAR();
    SLOAD(SE, (j + 2) * KVBLK); SBAR();
    pv_d0(o, vb0 + (int)SHM_V, pa0, pa1, pa2, pa3); partialSM(pA0, pA1, m_reg, mnA, alA);
    __syncthreads(); SWAIT(); SWRITE(1, SO);
    RESC(alA); __syncthreads();
  }
  SBAR(); qkt(pB0, pB1, (bf16_t*)((char*)K_lds + SHM_K), qr, r32, hi);
  finishSM(pA0, pA1, alA, l_reg, pa0, pa1, pa2, pa3); SBAR();
  pv_d0(o, vb0, pa0, pa1, pa2, pa3); partialSM(pB0, pB1, m_reg, mnB, alB);
  __syncthreads(); RESC(alB);
  finishSM(pB0, pB1, alB, l_reg, pa0, pa1, pa2, pa3); SBAR();
  pv_d0(o, vb0 + (int)SHM_V, pa0, pa1, pa2, pa3);
  if (hi == 0) li_l[r32] = l_reg; asm volatile("s_waitcnt lgkmcnt(0)" ::: "memory");
  float rli[16];
#pragma unroll
  for (int r = 0; r < 16; ++r) rli[r] = __builtin_amdgcn_rcpf(li_l[crow(r, hi)]);
  bf16_t* Ow = Ob + (long)(wid * QBLK) * LDO;
#pragma unroll
  for (int r = 0; r < 16; ++r) { int orow = crow(r, hi);
#pragma unroll
    for (int d0 = 0; d0 < 4; ++d0) Ow[(long)orow * LDO + d0 * 32 + r32] = f2bf(o[d0][r] * rli[r]); }
  __syncthreads();
#undef SLOAD
#undef SWRITE
#undef SWAIT
#undef RESC
}
}

constexpr int RING_BYTES = 131072;
constexpr int LDSCTL_OFF = RING_BYTES, MISC_OFF = LDSCTL_OFF + 320, PTAB_OFF = LDSCTL_OFF + 1024;
constexpr int LDS_BYTES = 147456;

#define XB_TMO      128
#define XB_XCNT(j)  (256  + 64 * (j))
#define XB_XSUB(j)  (1280 + 64 * (j))
#define XB_XGEN(j)  (2304 + 64 * (j))
#define XB_TOP      3328
#define XB_TOPGEN   3392
#define XCD_BAR_WORDS 3456
#define XB_SPIN_CAP (1u << 22)
__device__ __forceinline__ unsigned xb_ld(unsigned* p)              { return __hip_atomic_load(p, __ATOMIC_RELAXED, __HIP_MEMORY_SCOPE_AGENT); }
__device__ __forceinline__ unsigned xb_add(unsigned* p, unsigned v) { return __hip_atomic_fetch_add(p, v, __ATOMIC_RELAXED, __HIP_MEMORY_SCOPE_AGENT); }
__device__ __forceinline__ unsigned xb_xcc_id() { return (unsigned)__builtin_amdgcn_s_getreg((3 << 11) | 20) & 0xFu; }
#define XB_SPIN(cond, bar) do { unsigned _sp = 0; while (cond) { __builtin_amdgcn_s_sleep(1); \
    if ((++_sp & 255u) == 0u) { if (xb_ld(&(bar)[XB_TMO])) break; if (_sp > XB_SPIN_CAP) { atomicAdd(&(bar)[XB_TMO], 1u); break; } } } } while (0)
struct XcdBarrier { unsigned* bar; unsigned x; volatile LAS unsigned* st; };
__device__ __forceinline__ XcdBarrier xcd_barrier_post(unsigned* bar, volatile LAS unsigned* st) {
    XcdBarrier b; b.bar = bar; b.x = xb_xcc_id(); b.st = st;
    if (threadIdx.x == 0) (void)xb_add(&bar[XB_XCNT(b.x)], 1u);
    return b;
}
__device__ __forceinline__ void xcd_barrier_complete(unsigned* bar, unsigned x, unsigned& nloc, unsigned& nx) {
    const unsigned G = gridDim.x * gridDim.y * gridDim.z;
    unsigned sum, cnt, mine, sp = 0u;
    for (;;) {
        sum = 0u; cnt = 0u;
        for (unsigned j = 0; j < 16; ++j) { const unsigned c = xb_ld(&bar[XB_XCNT(j)]); sum += c; cnt += (c > 0u) ? 1u : 0u; }
        mine = xb_ld(&bar[XB_XCNT(x)]);
        if (sum == G) break;
        __builtin_amdgcn_s_sleep(1);
        if ((++sp & 255u) == 0u) { if (xb_ld(&bar[XB_TMO])) break; if (sp > XB_SPIN_CAP) { atomicAdd(&bar[XB_TMO], 1u); break; } }
    }
    nloc = mine > 0u ? mine : 1u; nx = cnt > 0u ? cnt : 1u;
}
__device__ __forceinline__ XcdBarrier xcd_barrier_setup(unsigned* bar, volatile LAS unsigned* st) {
    XcdBarrier b = xcd_barrier_post(bar, st);
    if (threadIdx.x == 0) { unsigned nloc, nx; xcd_barrier_complete(bar, b.x, nloc, nx); st[0] = nloc; st[1] = nx; }
    __syncthreads();
    return b;
}
__device__ __forceinline__ void xcd_barrier(const XcdBarrier& b) {
    asm volatile("s_waitcnt vmcnt(0)" ::: "memory");
    __syncthreads();
    if (threadIdx.x == 0) {
        unsigned* bar = b.bar; unsigned bx = b.x;
        asm volatile("" : "+s"(bar), "+s"(bx));
        __builtin_amdgcn_s_waitcnt(0);
        const unsigned nloc = b.st[0], nx = b.st[1];
        const unsigned old = xb_add(&bar[XB_XSUB(bx)], 1u);
        const unsigned gen = old / nloc;
        if (old + 1u == (gen + 1u) * nloc) {
            __builtin_amdgcn_fence(__ATOMIC_RELEASE, "agent");
            asm volatile("s_waitcnt vmcnt(0)" ::: "memory");
            const unsigned og = xb_add(&bar[XB_TOP], 1u);
            const unsigned tg = og / nx;
            if (og + 1u == (tg + 1u) * nx) xb_add(&bar[XB_TOPGEN], 1u);
            else XB_SPIN(xb_ld(&bar[XB_TOPGEN]) == tg, bar);
            __builtin_amdgcn_fence(__ATOMIC_ACQUIRE, "agent");
            xb_add(&bar[XB_XGEN(bx)], 1u);
            asm volatile("s_waitcnt vmcnt(0)" ::: "memory");
        } else {
            XB_SPIN(xb_ld(&bar[XB_XGEN(bx)]) == gen, bar);
            __builtin_amdgcn_fence(__ATOMIC_ACQUIRE, "agent");
            asm volatile("s_waitcnt vmcnt(0)" ::: "memory");
        }
    }
    __syncthreads();
}

__device__ __forceinline__ void transpose_item(const float* W, int ldw, int K, int k0, int srccol0, bf16_t* WT, int dstrow0, LAS float* scr, int lane, const float* kgain = nullptr, int ldt = 0) {
    const int KT = ldt ? ldt : K;
    constexpr int P = 36;
    const int n4 = (lane & 7) * 4, kr = lane >> 3;
    f32x4 v[8];
    if (srccol0 >= 0) {
#pragma unroll
        for (int i = 0; i < 8; ++i) v[i] = *(const f32x4*)(W + (size_t)(k0 + 8 * i + kr) * ldw + srccol0 + n4);
        if (kgain) {
#pragma unroll
            for (int i = 0; i < 8; ++i) v[i] = v[i] * kgain[k0 + 8 * i + kr];
        }
    } else {
#pragma unroll
        for (int i = 0; i < 8; ++i) v[i] = (f32x4){0.f, 0.f, 0.f, 0.f};
    }
#pragma unroll
    for (int i = 0; i < 8; ++i) *(LAS f32x4*)(scr + (8 * i + kr) * P + n4) = v[i];
    LDS_WAIT(); asm volatile("" ::: "memory");
    const int c = lane & 7;
#pragma unroll
    for (int j = 0; j < 4; ++j) { const int n = (lane >> 3) + 8 * j; const LAS float* s = scr + (8 * c) * P + n;
        u32x4 o; o.x = cvt_pk_bf16(s[0 * P], s[1 * P]); o.y = cvt_pk_bf16(s[2 * P], s[3 * P]); o.z = cvt_pk_bf16(s[4 * P], s[5 * P]); o.w = cvt_pk_bf16(s[6 * P], s[7 * P]);
        *(u32x4*)(WT + (size_t)(dstrow0 + n) * KT + k0 + 8 * c) = o; }
    LDS_WAIT(); asm volatile("" ::: "memory");
}
struct LayerW { const float *w_in, *w_bra, *w_brb, *w_brc, *w_out, *f1i, *f1o, *f2i, *f2o, *ng; };
__device__ __forceinline__ void phase_weights(const LayerW& w, unsigned char* ws, LAS unsigned char* lds, int gw, int NGW, int wave, int lane) {
    LAS float* scr = (LAS float*)(lds + wave * 16384);
    constexpr int I_IN = (NIN_PAD / 32) * (D / 64);
    constexpr int I_FI = (2 * FF / 32) * (D / 64);
    constexpr int I_FO = (D / 32) * (FF / 64);
    constexpr int I_BA = (D / 32) * (1024 / 64);
    constexpr int I_BB = (D / 32) * (512 / 64);
    constexpr int I_WO = (D / 32) * (D / 64);
    constexpr int NITEMS = I_IN + 2 * I_FI + 2 * I_FO + I_BA + 2 * I_BB + I_WO;
    for (int it = gw; it < NITEMS; it += NGW) {
        int r = it;
        if (r < I_IN) { const int nb = r % (NIN_PAD / 32), kb = r / (NIN_PAD / 32); const int d0 = nb * 32;
            const int src = d0 < 4608 ? d0 : (d0 < 10752 ? d0 + 32 : (d0 < 10784 ? 4608 + (d0 - 10752) : -1));
            transpose_item(w.w_in, NIN, D, kb * 64, src, (bf16_t*)(ws + WS_WIN), d0, scr, lane, w.ng + 2 * D); continue; } r -= I_IN;
        if (r < 2 * I_FI) { const int which = r / I_FI; r -= which * I_FI; const int nb = r % (2 * FF / 32), kb = r / (2 * FF / 32); const int d0 = nb * 32;
            const int t = d0 >> 8, within = d0 & 255; const int src = within < 128 ? 128 * t + within : FF + 128 * t + (within - 128);
            transpose_item(which ? w.f2i : w.f1i, 2 * FF, D, kb * 64, src, (bf16_t*)(ws + (which ? WS_WF2I : WS_WF1I)), d0, scr, lane, w.ng + (which ? 4 * D : 0)); continue; } r -= 2 * I_FI;
        if (r < 2 * I_FO) { const int which = r / I_FO; r -= which * I_FO; const int nb = r % (D / 32), kb = r / (D / 32);
            transpose_item(which ? w.f2o : w.f1o, D, FF, kb * 64, nb * 32, (bf16_t*)(ws + (which ? WS_WF2O : WS_WF1O)), nb * 32, scr, lane); continue; } r -= 2 * I_FO;
        if (r < I_BA) { const int nb = r % (D / 32), kb = r / (D / 32);
            transpose_item(w.w_bra, D, 1024, kb * 64, nb * 32, (bf16_t*)(ws + WS_WBRA), nb * 32, scr, lane, nullptr, LDOM); continue; } r -= I_BA;
        if (r < 2 * I_BB) { const int which = r / I_BB; r -= which * I_BB; const int nb = r % (D / 32), kb = r / (D / 32);
            transpose_item(which ? w.w_brc : w.w_brb, D, 512, kb * 64, nb * 32, (bf16_t*)(ws + WS_WBRA) + (which ? OM_C : OM_B), nb * 32, scr, lane, nullptr, LDOM); continue; } r -= 2 * I_BB;
        { const int nb = r % (D / 32), kb = r / (D / 32);
            transpose_item(w.w_out, D, D, kb * 64, nb * 32, (bf16_t*)(ws + WS_WOUT), nb * 32, scr, lane); }
    }
}
__device__ __forceinline__ void phase_norm(bf16_t* XB, const bf16_t* Y, float* RSTD, float* OUT, const float* gpost, float coef, int gw, int NGW, int lane) {
    for (int m = gw; m < M; m += NGW) {
        const u32x2* xr = (const u32x2*)(XB + (size_t)m * D) + lane; const u32x2* yr = (const u32x2*)(Y + (size_t)m * D) + lane;
        f32x4 x[8], y[8]; float s = 0.f;
#pragma unroll
        for (int j = 0; j < 8; ++j) { const u32x2 t = yr[64 * j], q = xr[64 * j]; y[j] = (f32x4){bflo(t.x), bfhi(t.x), bflo(t.y), bfhi(t.y)}; x[j] = (f32x4){bflo(q.x), bfhi(q.x), bflo(q.y), bfhi(q.y)};
            s += (y[j].x * y[j].x + y[j].y * y[j].y) + (y[j].z * y[j].z + y[j].w * y[j].w); }
        const float rstd = coef * (1.0f / sqrtf(wave_sum(s) * (1.0f / D) + EPS));
        float s2 = 0.f;
#pragma unroll
        for (int j = 0; j < 8; ++j) { const f32x4 g = ((const f32x4*)gpost)[lane + 64 * j]; x[j] = x[j] + y[j] * g * rstd; s2 += (x[j].x * x[j].x + x[j].y * x[j].y) + (x[j].z * x[j].z + x[j].w * x[j].w); }
        if (OUT) { f32x4* xo = (f32x4*)(OUT + (size_t)m * D) + lane;
#pragma unroll
            for (int j = 0; j < 8; ++j) xo[64 * j] = x[j];
        } else {
            u32x2* o8 = (u32x2*)(XB + (size_t)m * D) + lane;
#pragma unroll
            for (int j = 0; j < 8; ++j) { u32x2 w; w.x = cvt_pk_bf16(x[j].x, x[j].y); w.y = cvt_pk_bf16(x[j].z, x[j].w); o8[64 * j] = w; }
            const float r2 = 1.0f / sqrtf(wave_sum(s2) * (1.0f / D) + EPS);
            if (lane == 0) RSTD[m] = r2;
        }
    }
}
__device__ __forceinline__ void prep_k(bf16_t* PROJ, const float* qk_gain  , const f32x2* cs  , int gw, int NGW, int lane) {
    const float gk0 = qk_gain[128 + 2 * lane], gk1 = qk_gain[128 + 2 * lane + 1];
    for (int m0 = gw; m0 < M; m0 += 4 * NGW) {
        unsigned v[4][2]; f32x2 c_s[4];
#pragma unroll
        for (int i = 0; i < 4; ++i) { const int m = m0 + i * NGW; if (m < M) { const int t = m & (SEQ - 1), pr = t >> 6, pc = t & 63;
            const unsigned* row = (const unsigned*)(PROJ + (size_t)m * NPROJ + C_AK); v[i][0] = row[lane]; v[i][1] = row[64 + lane]; c_s[i] = cs[((lane < 32) ? pr : pc) * 32 + (lane & 31)]; } }
#pragma unroll
        for (int i = 0; i < 4; ++i) { const int m = m0 + i * NGW; if (m < M) { unsigned* row = (unsigned*)(PROJ + (size_t)m * NPROJ + C_AK);
#pragma unroll
            for (int h = 0; h < 2; ++h) { const float x1 = bflo(v[i][h]), x2 = bfhi(v[i][h]);
                const float rstd = 1.0f / sqrtf(wave_sum(x1 * x1 + x2 * x2) * (1.0f / 128.0f) + EPS);
                const float n1 = x1 * rstd * gk0, n2 = x2 * rstd * gk1;
                row[h * 64 + lane] = cvt_pk_bf16(n1 * c_s[i].x - n2 * c_s[i].y, n1 * c_s[i].y + n2 * c_s[i].x); } } }
    }
}
__device__ __forceinline__ void tr_pair(unsigned base, int pitch, int row0, int col0, int lane, s16x4& lo, s16x4& hi) {
    const int g = lane >> 4, i = lane & 15;
    const unsigned addr = base + (unsigned)((row0 + 4 * g + (i >> 2)) * pitch + (col0 + 4 * (i & 3)) * 2);
    asm volatile("ds_read_b64_tr_b16 %0, %1" : "=&v"(lo) : "v"(addr) : "memory");
    asm volatile("ds_read_b64_tr_b16 %0, %1" : "=&v"(hi) : "v"(addr + (unsigned)(16 * pitch)) : "memory");
}
#define TR_JOIN(L, H) ((bf16x8){L[0], L[1], L[2], L[3], H[0], H[1], H[2], H[3]})
__device__ __forceinline__ bf16x8 pack8(const float* x) { u32x4 w; w.x = cvt_pk_bf16(x[0], x[1]); w.y = cvt_pk_bf16(x[2], x[3]); w.z = cvt_pk_bf16(x[4], x[5]); w.w = cvt_pk_bf16(x[6], x[7]); return *reinterpret_cast<bf16x8*>(&w); }
__device__ __forceinline__ void na_unit(const bf16_t* PROJ, bf16_t* OB  , LAS unsigned char* lds, int u) {
    const int tid = opaque_tid(), lane = tid & 63, w = __builtin_amdgcn_readfirstlane(tid >> 6);
    constexpr int PV = 272, O_V = 0, O_RPB = 2 * 64 * PV;
    LAS float* rpbs = (LAS float*)(lds + O_RPB);
    const unsigned lbase = (unsigned)(uintptr_t)lds;
    const int ib = w & 3, vh = w >> 2;
    {
        int lane_o = lane; asm volatile("" : "+v"(lane_o));
        const int g = lane_o >> 4, li = lane_o & 15;
        const int r = u & 31, h = (u >> 5) & 3, b = u >> 7;
        const int rs = min(max(r - 4, 0), 24);
        const int c = 16 * ib + li, cs0 = min(max(c - 8, 0), 48);
        const size_t tq = (size_t)b * SEQ + r * 64 + c;
        bf16x8 qf[4];
#pragma unroll
        for (int ks = 0; ks < 4; ++ks) qf[ks] = *(const bf16x8*)(PROJ + tq * NPROJ + C_BQ + h * 128 + 32 * ks + 8 * g);
        int jbv[4], dcv[4];
#pragma unroll
        for (int rr = 0; rr < 4; ++rr) { const int km = 4 * g + rr; jbv[rr] = (cs0 + 15 - km) >> 4; dcv[rr] = 16 * jbv[rr] + km - c + 15; }
        f32x4 o[4];
#pragma unroll
        for (int vt = 0; vt < 4; ++vt) o[vt] = (f32x4){0.f, 0.f, 0.f, 0.f};
        float m_run = -1e30f, l_run = 0.f;
        const int sr = tid >> 4, sc = (tid & 15) * 8;
        const int jlo = ib > 1 ? ib - 1 : 0, jhi = ib < 2 ? ib + 1 : 3;
        bf16x8 kf[4][4], vr0, vr1;
#define NA_LOADK(kr_) do { const size_t kt_ = (size_t)b * SEQ + (size_t)(rs + (kr_)) * 64; \
            _Pragma("unroll") for (int jb = 0; jb < 4; ++jb) if (jb >= jlo && jb <= jhi) { const bf16_t* kp = PROJ + (kt_ + 16 * jb + li) * NPROJ + C_BK + h * 128 + 8 * g; \
                _Pragma("unroll") for (int ks = 0; ks < 4; ++ks) kf[jb][ks] = *(const bf16x8*)(kp + 32 * ks); } } while (0)
#define NA_LOADV(kr_) do { const size_t kt_ = (size_t)b * SEQ + (size_t)(rs + (kr_)) * 64; \
            vr0 = *(const bf16x8*)(PROJ + (kt_ + sr) * NPROJ + C_BV + h * 128 + sc); vr1 = *(const bf16x8*)(PROJ + (kt_ + sr + 32) * NPROJ + C_BV + h * 128 + sc); } while (0)
        NA_LOADV(0); NA_LOADK(0);
        for (int kr = 0; kr < 8; ++kr) {
            *(LAS bf16x8*)(lds + O_V + (kr & 1) * 64 * PV + sr * PV + sc * 2) = vr0; *(LAS bf16x8*)(lds + O_V + (kr & 1) * 64 * PV + (sr + 32) * PV + sc * 2) = vr1;
            if (kr + 1 < 8) NA_LOADV(kr + 1);
            f32x4 s[4];
#pragma unroll
            for (int jb = 0; jb < 4; ++jb) { s[jb] = (f32x4){0.f, 0.f, 0.f, 0.f};
                if (jb >= jlo && jb <= jhi) {
#pragma unroll
                    for (int ks = 0; ks < 4; ++ks) s[jb] = __builtin_amdgcn_mfma_f32_16x16x32_bf16(kf[jb][ks], qf[ks], s[jb], 0, 0, 0); } }
            if (kr + 1 < 8) NA_LOADK(kr + 1);
            const int dr = rs + kr - r + 7;
            float mx = -1e30f;
#pragma unroll
            for (int rr = 0; rr < 4; ++rr) { const float bias = rpbs[(h * 15 + dr) * 31 + dcv[rr]];
#pragma unroll
                for (int jb = 0; jb < 4; ++jb) { const float v = (jb == jbv[rr]) ? s[jb][rr] * 0.088388347648318440f + bias : -1e30f; s[jb][rr] = v; mx = fmaxf(mx, v); } }
            mx = fmaxf(mx, __shfl_xor(mx, 16)); mx = fmaxf(mx, __shfl_xor(mx, 32));
            const float m_new = fmaxf(m_run, mx), alpha = __expf(m_run - m_new);
            m_run = m_new;
            float ps = 0.f;
#pragma unroll
            for (int jb = 0; jb < 4; ++jb)
#pragma unroll
                for (int rr = 0; rr < 4; ++rr) { const float p = (jb == jbv[rr]) ? __expf(s[jb][rr] - m_new) : 0.f; s[jb][rr] = p; ps += p; }
            l_run = l_run * alpha + ps;
            bf16x8 pfr[2];
#pragma unroll
            for (int ss = 0; ss < 2; ++ss) { const float t[8] = {s[2 * ss][0], s[2 * ss][1], s[2 * ss][2], s[2 * ss][3], s[2 * ss + 1][0], s[2 * ss + 1][1], s[2 * ss + 1][2], s[2 * ss + 1][3]}; pfr[ss] = pack8(t); }
            __syncthreads();
            s16x4 vl[4][2], vhh[4][2];
            {
                const unsigned vbase = lbase + O_V + (unsigned)((kr & 1) * 64 * PV + (4 * g + (li >> 2)) * PV + (64 * vh + 4 * (li & 3)) * 2);
                asm volatile("ds_read_b64_tr_b16 %0, %16 offset:0\n\t"
                         "ds_read_b64_tr_b16 %1, %16 offset:4352\n\t"
                         "ds_read_b64_tr_b16 %2, %16 offset:8704\n\t"
                         "ds_read_b64_tr_b16 %3, %16 offset:13056\n\t"
                         "ds_read_b64_tr_b16 %4, %16 offset:32\n\t"
                         "ds_read_b64_tr_b16 %5, %16 offset:4384\n\t"
                         "ds_read_b64_tr_b16 %6, %16 offset:8736\n\t"
                         "ds_read_b64_tr_b16 %7, %16 offset:13088\n\t"
                         "ds_read_b64_tr_b16 %8, %16 offset:64\n\t"
                         "ds_read_b64_tr_b16 %9, %16 offset:4416\n\t"
                         "ds_read_b64_tr_b16 %10, %16 offset:8768\n\t"
                         "ds_read_b64_tr_b16 %11, %16 offset:13120\n\t"
                         "ds_read_b64_tr_b16 %12, %16 offset:96\n\t"
                         "ds_read_b64_tr_b16 %13, %16 offset:4448\n\t"
                         "ds_read_b64_tr_b16 %14, %16 offset:8800\n\t"
                         "ds_read_b64_tr_b16 %15, %16 offset:13152\n\t"
                         "s_waitcnt lgkmcnt(0)"
                         : "=&v"(vl[0][0]), "=&v"(vhh[0][0]), "=&v"(vl[0][1]), "=&v"(vhh[0][1]), "=&v"(vl[1][0]), "=&v"(vhh[1][0]), "=&v"(vl[1][1]), "=&v"(vhh[1][1]), "=&v"(vl[2][0]), "=&v"(vhh[2][0]), "=&v"(vl[2][1]), "=&v"(vhh[2][1]), "=&v"(vl[3][0]), "=&v"(vhh[3][0]), "=&v"(vl[3][1]), "=&v"(vhh[3][1])
                         : "v"(vbase) : "memory");
            }
            __builtin_amdgcn_sched_barrier(0);
#pragma unroll
            for (int vt = 0; vt < 4; ++vt) { o[vt] = o[vt] * alpha;
#pragma unroll
                for (int ss = 0; ss < 2; ++ss) o[vt] = __builtin_amdgcn_mfma_f32_16x16x32_bf16(TR_JOIN(vl[vt][ss], vhh[vt][ss]), pfr[ss], o[vt], 0, 0, 0); }
        }
#undef NA_LOADK
#undef NA_LOADV
        l_run += __shfl_xor(l_run, 16); l_run += __shfl_xor(l_run, 32);
        const float inv = 1.0f / l_run;
#pragma unroll
        for (int vt = 0; vt < 4; ++vt) { u32x2 ov; ov.x = cvt_pk_bf16(o[vt].x * inv, o[vt].y * inv); ov.y = cvt_pk_bf16(o[vt].z * inv, o[vt].w * inv);
            *(u32x2*)(OB + tq * LDOM + h * 128 + 64 * vh + 16 * vt + 4 * g) = ov; }
        __syncthreads();
    }
}
__device__ __forceinline__ void na_load_bias(const float* rpb, LAS unsigned char* lds) {
    const int tid = opaque_tid(); LAS float* rpbs = (LAS float*)(lds + 2 * 64 * 272);
    __syncthreads();
    for (int i = tid; i < 4 * 15 * 31; i += 512) rpbs[i] = rpb[i];
    __syncthreads();
}
__device__ __forceinline__ float logsig16(float z) { return (fminf(z, 0.f) - __logf(1.0f + __expf(-fabsf(z)))) * (1.0f / 16.0f); }
__device__ __forceinline__ void gla_seq_unit(const bf16_t* PROJ, const float* LR, const float* w_decay  , const float* b_decay  , bf16_t* OFB, bf16_t* OC, const float* onorm,
                                             LAS unsigned char* lds, int b, int h) {
    const int tid = opaque_tid(), lane = tid & 63, w = __builtin_amdgcn_readfirstlane(tid >> 6);
    constexpr int P64 = 144, PV = 272;
    constexpr int O_Q = 0, O_K = 9216, O_KH = 18432, O_V = 27648, O_S = 45056, O_DEC = 63488, O_W2 = 63744;
    const unsigned lbase = (unsigned)(uintptr_t)lds;
    const int ib = w & 3, vh = w >> 2, g = lane >> 4, li = lane & 15;
    LAS float* w2s = (LAS float*)(lds + O_W2);
    LAS float* gns = (LAS float*)(lds + 68608);
    __syncthreads(); if (tid < 128) gns[tid] = onorm[tid];
    LAS float* red = (LAS float*)(lds + 68096);
  for (int dir = 0; dir < 2; ++dir) {
    __syncthreads();
    for (int i = tid; i < 16 * 64; i += 512) w2s[i] = w_decay[dir * 4096 + (i >> 6) * 256 + h * 64 + (i & 63)];
    if (tid < 64) w2s[1024 + tid] = b_decay[dir * 256 + h * 64 + tid];
    for (int i = tid; i < 128 * 72 / 2; i += 512) ((LAS unsigned*)(lds + O_S))[i] = 0u;
    f32x4 S[4];
#pragma unroll
    for (int vt = 0; vt < 4; ++vt) S[vt] = (f32x4){0.f, 0.f, 0.f, 0.f};
    const int dcol = 8 * w;
    const int sr = tid >> 4, sc = (tid & 15) * 8;
    f32x4 lr4[4]; u32x4 qraw, kraw; bf16x8 vst0, vst1;
    u32x2 ofr[4], ogr[4];
#define GLA_LOAD_O(cc_) do { const int c_ = 31 - (cc_); const size_t mi_ = (size_t)b * SEQ + c_ * 64 + 16 * ib + li; \
        _Pragma("unroll") for (int vt = 0; vt < 4; ++vt) { ofr[vt] = *(const u32x2*)(OFB + mi_ * 512 + h * 128 + 64 * vh + 16 * vt + 4 * g); ogr[vt] = *(const u32x2*)(PROJ + mi_ * NPROJ + C_OG + h * 128 + 64 * vh + 16 * vt + 4 * g); } } while (0)
#define GLA_LOAD(cc_) do { const int c_ = dir ? 31 - (cc_) : (cc_); const size_t m0_ = (size_t)b * SEQ + c_ * 64, m_ = m0_ + lane; \
        _Pragma("unroll") for (int j = 0; j < 4; ++j) lr4[j] = ((const f32x4*)(LR + m_ * 32 + dir * 16))[j]; \
        qraw = *(const u32x4*)(PROJ + m_ * NPROJ + C_CQ + h * 64 + dcol); kraw = *(const u32x4*)(PROJ + m_ * NPROJ + C_CK + h * 64 + dcol); \
        vst0 = *(const bf16x8*)(PROJ + (m0_ + sr) * NPROJ + C_CV + h * 128 + sc); vst1 = *(const bf16x8*)(PROJ + (m0_ + sr + 32) * NPROJ + C_CV + h * 128 + sc); } while (0)
#pragma unroll
    for (int vt = 0; vt < 4; ++vt) { ofr[vt] = (u32x2){0u, 0u}; ogr[vt] = (u32x2){0u, 0u}; }
    GLA_LOAD(0);
    if (dir) GLA_LOAD_O(0);
    __syncthreads();
    for (int cc = 0; cc < 32; ++cc) {
        const int c = dir ? 31 - cc : cc; const size_t m0 = (size_t)b * SEQ + c * 64;
        {
            f32x4 z0 = *(const LAS f32x4*)(w2s + 1024 + dcol), z1 = *(const LAS f32x4*)(w2s + 1024 + dcol + 4);
#pragma unroll
            for (int j = 0; j < 4; ++j)
#pragma unroll
                for (int rr = 0; rr < 4; ++rr) { const int r = 4 * j + rr; z0 = z0 + *(const LAS f32x4*)(w2s + r * 64 + dcol) * lr4[j][rr]; z1 = z1 + *(const LAS f32x4*)(w2s + r * 64 + dcol + 4) * lr4[j][rr]; }
            float bs[8];
#pragma unroll
            for (int e = 0; e < 4; ++e) { bs[e] = logsig16(z0[e]); bs[4 + e] = logsig16(z1[e]); }
            if (dir == 0) {
#pragma unroll
                for (int off = 1; off < 64; off <<= 1)
#pragma unroll
                    for (int e = 0; e < 8; ++e) { const float t = __shfl_up(bs[e], off); if (lane >= off) bs[e] += t; }
            } else {
#pragma unroll
                for (int off = 1; off < 64; off <<= 1)
#pragma unroll
                    for (int e = 0; e < 8; ++e) { const float t = __shfl_down(bs[e], off); if (lane + off < 64) bs[e] += t; }
            }
            const float q[8] = {bflo(qraw.x), bfhi(qraw.x), bflo(qraw.y), bfhi(qraw.y), bflo(qraw.z), bfhi(qraw.z), bflo(qraw.w), bfhi(qraw.w)};
            const float k[8] = {bflo(kraw.x), bfhi(kraw.x), bflo(kraw.y), bfhi(kraw.y), bflo(kraw.z), bfhi(kraw.z), bflo(kraw.w), bfhi(kraw.w)};
            float qt[8], kt[8], kh[8], dc[8];
#pragma unroll
            for (int e = 0; e < 8; ++e) { const float be = __shfl(bs[e], dir ? 0 : 63);
                qt[e] = q[e] * 0.125f * __expf(bs[e]); kt[e] = k[e] * __expf(-bs[e]); kh[e] = k[e] * __expf(be - bs[e]); dc[e] = __expf(be); }
            *(LAS bf16x8*)(lds + O_Q + lane * P64 + 16 * w) = pack8(qt); *(LAS bf16x8*)(lds + O_K + lane * P64 + 16 * w) = pack8(kt); *(LAS bf16x8*)(lds + O_KH + lane * P64 + 16 * w) = pack8(kh);
            if (lane == 0) { *(LAS f32x4*)(lds + O_DEC + 4 * dcol) = (f32x4){dc[0], dc[1], dc[2], dc[3]}; *(LAS f32x4*)(lds + O_DEC + 4 * dcol + 16) = (f32x4){dc[4], dc[5], dc[6], dc[7]}; }
            *(LAS bf16x8*)(lds + O_V + sr * PV + sc * 2) = vst0; *(LAS bf16x8*)(lds + O_V + (sr + 32) * PV + sc * 2) = vst1;
        }
        __syncthreads();
        if (cc + 1 < 32) GLA_LOAD(cc + 1);
        const size_t mi = m0 + 16 * ib + li; f32x4 oo[4]; float ss = 0.f;
        {
            bf16x8 qF[2];
#pragma unroll
            for (int ks = 0; ks < 2; ++ks) qF[ks] = *(const LAS bf16x8*)(lds + O_Q + (16 * ib + li) * P64 + (32 * ks + 8 * g) * 2);
            f32x4 P[4];
#pragma unroll
            for (int jb = 0; jb < 4; ++jb) {
                f32x4 a = {0.f, 0.f, 0.f, 0.f};
                const bool need = dir ? (jb >= ib) : (jb <= ib);
                if (need) {
#pragma unroll
                    for (int ks = 0; ks < 2; ++ks) a = __builtin_amdgcn_mfma_f32_16x16x32_bf16(*(const LAS bf16x8*)(lds + O_K + (16 * jb + li) * P64 + (32 * ks + 8 * g) * 2), qF[ks], a, 0, 0, 0); }
#pragma unroll
                for (int r = 0; r < 4; ++r) { const int jl = 4 * g + r;
                    const bool keep = (jb == ib) ? (dir ? (jl >= li) : (jl <= li)) : need;
                    P[jb][r] = keep ? a[r] : 0.f; }
            }
            bf16x8 pfr[2];
#pragma unroll
            for (int s = 0; s < 2; ++s) { const float t[8] = {P[2 * s][0], P[2 * s][1], P[2 * s][2], P[2 * s][3], P[2 * s + 1][0], P[2 * s + 1][1], P[2 * s + 1][2], P[2 * s + 1][3]}; pfr[s] = pack8(t); }
            s16x4 vl[4][2], vhh[4][2], kl[2], kh2[2];
            {
                const unsigned vbase = lbase + O_V + (unsigned)((4 * g + (li >> 2)) * PV + (64 * vh + 4 * (li & 3)) * 2);
                const unsigned kbase = lbase + O_KH + (unsigned)((4 * g + (li >> 2)) * P64 + (16 * ib + 4 * (li & 3)) * 2);
                asm volatile("ds_read_b64_tr_b16 %0, %20 offset:0\n\t"
                         "ds_read_b64_tr_b16 %1, %20 offset:4352\n\t"
                         "ds_read_b64_tr_b16 %2, %20 offset:8704\n\t"
                         "ds_read_b64_tr_b16 %3, %20 offset:13056\n\t"
                         "ds_read_b64_tr_b16 %4, %20 offset:32\n\t"
                         "ds_read_b64_tr_b16 %5, %20 offset:4384\n\t"
                         "ds_read_b64_tr_b16 %6, %20 offset:8736\n\t"
                         "ds_read_b64_tr_b16 %7, %20 offset:13088\n\t"
                         "ds_read_b64_tr_b16 %8, %20 offset:64\n\t"
                         "ds_read_b64_tr_b16 %9, %20 offset:4416\n\t"
                         "ds_read_b64_tr_b16 %10, %20 offset:8768\n\t"
                         "ds_read_b64_tr_b16 %11, %20 offset:13120\n\t"
                         "ds_read_b64_tr_b16 %12, %20 offset:96\n\t"
                         "ds_read_b64_tr_b16 %13, %20 offset:4448\n\t"
                         "ds_read_b64_tr_b16 %14, %20 offset:8800\n\t"
                         "ds_read_b64_tr_b16 %15, %20 offset:13152\n\t"
                         "ds_read_b64_tr_b16 %16, %21 offset:0\n\t"
                         "ds_read_b64_tr_b16 %17, %21 offset:2304\n\t"
                         "ds_read_b64_tr_b16 %18, %21 offset:4608\n\t"
                         "ds_read_b64_tr_b16 %19, %21 offset:6912\n\t"
                         "s_waitcnt lgkmcnt(0)"
                         : "=&v"(vl[0][0]), "=&v"(vhh[0][0]), "=&v"(vl[0][1]), "=&v"(vhh[0][1]), "=&v"(vl[1][0]), "=&v"(vhh[1][0]), "=&v"(vl[1][1]), "=&v"(vhh[1][1]), "=&v"(vl[2][0]), "=&v"(vhh[2][0]), "=&v"(vl[2][1]), "=&v"(vhh[2][1]), "=&v"(vl[3][0]), "=&v"(vhh[3][0]), "=&v"(vl[3][1]), "=&v"(vhh[3][1]), "=&v"(kl[0]), "=&v"(kh2[0]), "=&v"(kl[1]), "=&v"(kh2[1])
                         : "v"(vbase), "v"(kbase) : "memory");
            }
            bf16x8 sfr[4][2];
#pragma unroll
            for (int vt = 0; vt < 4; ++vt)
#pragma unroll
                for (int ks = 0; ks < 2; ++ks) sfr[vt][ks] = *(const LAS bf16x8*)(lds + O_S + (64 * vh + 16 * vt + li) * P64 + (32 * ks + 8 * g) * 2);
            const float dec = *(const LAS float*)(lds + O_DEC + 4 * (16 * ib + li));
            __builtin_amdgcn_sched_barrier(0);
#pragma unroll
            for (int vt = 0; vt < 4; ++vt) {
                const int v0 = 64 * vh + 16 * vt;
                f32x4 o = {0.f, 0.f, 0.f, 0.f};
#pragma unroll
                for (int s = 0; s < 2; ++s) o = __builtin_amdgcn_mfma_f32_16x16x32_bf16(TR_JOIN(vl[vt][s], vhh[vt][s]), pfr[s], o, 0, 0, 0);
#pragma unroll
                for (int ks = 0; ks < 2; ++ks) o = __builtin_amdgcn_mfma_f32_16x16x32_bf16(sfr[vt][ks], qF[ks], o, 0, 0, 0);
                if (dir == 0) { u32x2 ov; ov.x = (unsigned)f2bf(o.x) | ((unsigned)f2bf(o.y) << 16); ov.y = (unsigned)f2bf(o.z) | ((unsigned)f2bf(o.w) << 16);
                    *(u32x2*)(OFB + mi * 512 + h * 128 + v0 + 4 * g) = ov; }
                else { const u32x2 f = ofr[vt];
                    o.x += bflo(f.x); o.y += bfhi(f.x); o.z += bflo(f.y); o.w += bfhi(f.y); oo[vt] = o; ss += (o.x * o.x + o.y * o.y) + (o.z * o.z + o.w * o.w); }
                f32x4 sn = S[vt] * dec;
#pragma unroll
                for (int s = 0; s < 2; ++s) sn = __builtin_amdgcn_mfma_f32_16x16x32_bf16(TR_JOIN(vl[vt][s], vhh[vt][s]), TR_JOIN(kl[s], kh2[s]), sn, 0, 0, 0);
                S[vt] = sn;
            }
        }
        if (dir) { ss += __shfl_xor(ss, 16); ss += __shfl_xor(ss, 32); if (g == 0) red[vh * 64 + 16 * ib + li] = ss; }
        __syncthreads();
        if (dir) {
            const float rstd = 1.0f / sqrtf((red[16 * ib + li] + red[64 + 16 * ib + li]) * (1.0f / 128.0f) + EPS);
#pragma unroll
            for (int vt = 0; vt < 4; ++vt) { const int v0 = 64 * vh + 16 * vt;
                const u32x2 og = ogr[vt]; const f32x4 gn = *(const LAS f32x4*)(gns + v0 + 4 * g);
                u32x2 ov; ov.x = cvt_pk_bf16(oo[vt].x * rstd * gn.x * pg8::silu_f(bflo(og.x)), oo[vt].y * rstd * gn.y * pg8::silu_f(bfhi(og.x)));
                ov.y = cvt_pk_bf16(oo[vt].z * rstd * gn.z * pg8::silu_f(bflo(og.y)), oo[vt].w * rstd * gn.w * pg8::silu_f(bfhi(og.y)));
                *(u32x2*)(OC + mi * LDOM + h * 128 + v0 + 4 * g) = ov; }
            if (cc + 1 < 32) GLA_LOAD_O(cc + 1);
        }
#pragma unroll
        for (int vt = 0; vt < 4; ++vt)
#pragma unroll
            for (int r = 0; r < 4; ++r) *(LAS bf16_t*)(lds + O_S + (64 * vh + 16 * vt + 4 * g + r) * P64 + (16 * ib + li) * 2) = f2bf(S[vt][r]);
    }
    __syncthreads();
  }
#undef GLA_LOAD
#undef GLA_LOAD_O
}
constexpr int NPH = 15;
enum { P_F1A = 0, P_F1B, P_N1, P_M1, P_PREP, P_ATT, P_NA, P_GLA, P_GLC, P_M4, P_M5, P_N2, P_F2A, P_F2B, P_N3 };
constexpr int NGP = 1 + DEPTH * NPH;
struct Args { const float* in[18]; float* out; unsigned char* ws; int gp_lo, gp_hi; };

typedef decltype(__builtin_amdgcn_kernarg_segment_ptr()) kargp_t;
__device__ __forceinline__ unsigned long long karg_q(int byte_off) { kargp_t p_ = __builtin_amdgcn_kernarg_segment_ptr(); asm volatile("" : "+s"(p_));
    return *(const unsigned long long __attribute__((address_space(4)))*)((const char __attribute__((address_space(4)))*)p_ + byte_off); }
__global__ void __launch_bounds__(512, 2) fwd(Args args) {
    extern __shared__ __attribute__((aligned(16))) unsigned char lds_raw[];
    LAS unsigned char* const lds0 = (LAS unsigned char*)lds_raw;
    const int G0 = gridDim.x, wg0 = blockIdx.x;
#define PENV LAS unsigned char* lds = lds0; int G = G0, wg = wg0; asm volatile("" : "+s"(lds), "+s"(G), "+s"(wg)); const int NGW = G * 8; (void)NGW; (void)lds; (void)wg
    volatile LAS unsigned* MISC = (volatile LAS unsigned*)(lds0 + MISC_OFF);
    volatile LAS unsigned long long* PT = (volatile LAS unsigned long long*)(lds0 + PTAB_OFF);
    { const int t0 = threadIdx.x;
      for (int u = t0; u < (LDS_BYTES - LDSCTL_OFF) / 4; u += 512) ((LAS unsigned*)(lds0 + LDSCTL_OFF))[u] = 0u;
      __syncthreads();
      __syncthreads(); }
#if ONE_LAUNCH
    constexpr int lo = 0, hi = NGP;
#else
    const int lo = args.gp_lo, hi = args.gp_hi;
#endif
    XcdBarrier bar; bar.bar = (unsigned*)(args.ws + WS_CTL) + CW_BAR; bar.x = 0; bar.st = nullptr;
    if (hi - lo > 1) bar = xcd_barrier_setup((unsigned*)(args.ws + WS_CTL) + CW_BAR, MISC + 8);
#define SEAM(gp) do { if ((gp) + 1 < hi) xcd_barrier(bar); } while (0)
#define INP(i) ((const float*)(const GAS float*)karg_q(8 * (i)))
#define WSP() ((unsigned char*)(GAS unsigned char*)karg_q(8 * 19))
#define XP() ((float*)(GAS float*)karg_q(8 * 18))
#define TIDS() PENV; const int tid = opaque_tid(), lane = tid & 63, wave = __builtin_amdgcn_readfirstlane(tid >> 6), gw = wg * 8 + wave; (void)tid; (void)lane; (void)wave; (void)gw

    if (((PHASE_MASK >> 31) & 1u) && lo <= 0 && 0 < hi) {
        TIDS(); unsigned char* ws = WSP(); bf16_t* XB = (bf16_t*)(ws + WS_XN); float* RSTD = (float*)(ws + WS_RSTD);
        LayerW w; w.w_in = INP(3); w.w_bra = INP(10); w.w_brb = INP(11); w.w_brc = INP(12); w.w_out = INP(13); w.f1i = INP(14); w.f1o = INP(15); w.f2i = INP(16); w.f2o = INP(17); w.ng = INP(2);
        if (wg == 0) { f32x2* cs = (f32x2*)(ws + WS_CTL + ROPE_OFF);
            for (int i = tid; i < 2048; i += 512) { const int pos = i >> 5, mi = i & 31; const float inv = powf(10000.0f, -(float)mi / 32.0f); float s, c; sincosf((float)pos * inv, &s, &c); cs[i] = (f32x2){c, s}; } }
        phase_weights(w, ws, lds, gw, NGW, wave, lane);
        const float* xp = INP(0); const float* xs = INP(1);
        for (int m = gw; m < M; m += NGW) {
            const float* src = m < 16 * SEQ ? xp + (size_t)m * D : xs + (size_t)(m - 16 * SEQ) * D;
            const f32x4* xr = (const f32x4*)src + lane; f32x4 x[8]; float s = 0.f;
#pragma unroll
            for (int j = 0; j < 8; ++j) { x[j] = xr[64 * j]; s += (x[j].x * x[j].x + x[j].y * x[j].y) + (x[j].z * x[j].z + x[j].w * x[j].w); }
            u32x2* o8 = (u32x2*)(XB + (size_t)m * D) + lane;
#pragma unroll
            for (int j = 0; j < 8; ++j) { u32x2 wv; wv.x = cvt_pk_bf16(x[j].x, x[j].y); wv.y = cvt_pk_bf16(x[j].z, x[j].w); o8[64 * j] = wv; }
            const float rstd = 1.0f / sqrtf(wave_sum(s) * (1.0f / D) + EPS);
            if (lane == 0) RSTD[m] = rstd;
        }
        SEAM(0);
    }
    for (int l = 0; l < DEPTH; ++l) {
        const int gp0 = 1 + l * NPH;
        if (gp0 + NPH <= lo || gp0 >= hi) continue;
#define IN(p) (((PHASE_MASK >> (p)) & 1u) && lo <= gp0 + (p) && gp0 + (p) < hi)
#define FFN_PAIR(ff, pa, pb) do { \
        if (IN(pa)) { PENV; unsigned char* ws = WSP(); pg8::Gemm g{(const bf16_t*)(ws + WS_XN), (const bf16_t*)(ws + ((ff) ? WS_WF2I : WS_WF1I)), M, 2 * FF, D, D}; pg8::StaticOrder S; S.init(M, 2 * FF, G, wg, WGM_FI); \
            pg8::EpiSwiGLU E{(bf16_t*)(ws + WS_H), (const float*)(ws + WS_RSTD)}; pg8::gemm_phase<pg8::EpiSwiGLU, pg8::StaticOrder, true, true>(lds, g, S, E); if ((DUP_MASK >> (pa)) & 1u) pg8::gemm_phase<pg8::EpiSwiGLU, pg8::StaticOrder, true, true>(lds, g, S, E); SEAM(gp0 + (pa)); } \
        if (IN(pb)) { PENV; unsigned char* ws = WSP(); pg8::Gemm g{(const bf16_t*)(ws + WS_H), (const bf16_t*)(ws + ((ff) ? WS_WF2O : WS_WF1O)), M, D, FF, FF}; pg8::StaticOrder S; S.init(M, D, G, wg, WGM_FO); \
            pg8::EpiBf16Plain E{(bf16_t*)(ws + WS_Y), D}; pg8::gemm_phase<pg8::EpiBf16Plain, pg8::StaticOrder, true, true>(lds, g, S, E); if ((DUP_MASK >> (pb)) & 1u) pg8::gemm_phase<pg8::EpiBf16Plain, pg8::StaticOrder, true, true>(lds, g, S, E); SEAM(gp0 + (pb)); } } while (0)
#define NORM_PHASE(p, ipost, coef, last) do { if (IN(p)) { TIDS(); unsigned char* ws = WSP(); const float* ng = INP(2) + (size_t)l * 6 * D; \
            phase_norm((bf16_t*)(ws + WS_XN), (const bf16_t*)(ws + WS_Y), (float*)(ws + WS_RSTD), (last) ? XP() : nullptr, ng + (ipost) * D, (coef), gw, NGW, lane);

        FFN_PAIR(0, P_F1A, P_F1B);
        NORM_PHASE(P_N1, 1, 0.5f, false) SEAM(gp0 + P_N1); } } while (0);
        if (IN(P_M1)) { PENV;
            unsigned char* ws = WSP();
            pg8::Gemm g{(const bf16_t*)(ws + WS_XN), (const bf16_t*)(ws + WS_WIN), M, NIN_PAD, D, D}; pg8::StaticOrder S; S.init(M, NIN_PAD, G, wg, WGM_M1);
            pg8::EpiProj E{(bf16_t*)(ws + WS_PROJ), (u32x4*)(ws + WS_GATES), (float*)(ws + WS_LR), INP(4) + (size_t)l * 3 * D, (const float*)(ws + WS_RSTD)};
            pg8::gemm_phase<pg8::EpiProj, pg8::StaticOrder, true, true>(lds, g, S, E);
            if ((DUP_MASK >> P_M1) & 1u) pg8::gemm_phase<pg8::EpiProj, pg8::StaticOrder, true, true>(lds, g, S, E);
            SEAM(gp0 + P_M1);
        }
        if (IN(P_ATT)) { PENV;
            unsigned char* ws = WSP(); bf16_t* PROJ = (bf16_t*)(ws + WS_PROJ);
            {
                const int tid_k = opaque_tid(), lane_k = tid_k & 63, gw_k = wg * 8 + __builtin_amdgcn_readfirstlane(tid_k >> 6);
                prep_k(PROJ, INP(5) + (size_t)l * 256, (const f32x2*)(ws + WS_CTL + ROPE_OFF), gw_k, G * 8, lane_k);
                asm volatile("s_waitcnt vmcnt(0)" ::: "memory"); __syncthreads();
                if (threadIdx.x == 0) { __builtin_amdgcn_fence(__ATOMIC_RELEASE, "agent"); asm volatile("s_waitcnt vmcnt(0)" ::: "memory");
                    __hip_atomic_fetch_add((unsigned*)(ws + WS_CTL) + CW_KRDY + 64 * l, 1u, __ATOMIC_RELAXED, __HIP_MEMORY_SCOPE_AGENT); }
            }
            bool k_ready = false;
            const int ngrp = (G % 8 == 0) ? 8 : 1, xg = wg % ngrp, slot = wg / ngrp, per = G / ngrp;
            for (int gu = slot; gu < 96 / ngrp; gu += per) { const int U = xg * (96 / ngrp) + gu;
                gla_seq_unit(PROJ, (const float*)(ws + WS_LR), INP(7) + (size_t)l * 2 * 16 * 256, INP(8) + (size_t)l * 512, (bf16_t*)(ws + WS_OFB), (bf16_t*)(ws + WS_OA) + OM_C, INP(9) + (size_t)l * 128, lds, U >> 2, U & 3); }
            na_load_bias(INP(6) + (size_t)l * 4 * 15 * 31, lds);
            unsigned* head = (unsigned*)(ws + WS_CTL) + CW_Q + (l * 8 + xg) * 64;
            const int n_att = 1536 / ngrp, n_na = 3072 / ngrp;
            LAS unsigned* qslot = (LAS unsigned*)(lds + MISC_OFF + 64);
            for (;;) {
                __syncthreads();
                if (threadIdx.x == 0) *qslot = __hip_atomic_fetch_add(head, 1u, __ATOMIC_RELAXED, __HIP_MEMORY_SCOPE_AGENT);
                __syncthreads();
                const int idx = __builtin_amdgcn_readfirstlane((int)*(volatile LAS unsigned*)qslot);
                if (idx >= n_att * (1 + ATT_DUP) + n_na) break;
                if (idx < n_att * (1 + ATT_DUP)) { const int idx0 = idx; const int idx = idx0 % n_att;
                    const int rnd = idx >> 5, mem = idx & 31, grp = (ngrp == 8) ? rnd * 8 + xg : rnd;
                    const int b = grp >> 1, kvh = grp & 1, h = kvh * 4 + (mem >> 3), qb = mem & 7;
                    const size_t rowq = (size_t)b * SEQ + qb * 256, rowk = (size_t)b * SEQ;
                    bf16_t* Qp = PROJ + rowq * NPROJ + C_AQ + h * 128;
                    if (!k_ready) {
                        if (threadIdx.x == 0) { unsigned* kc = (unsigned*)(ws + WS_CTL) + CW_KRDY + 64 * l; unsigned sp = 0u;
                            while (__hip_atomic_load(kc, __ATOMIC_RELAXED, __HIP_MEMORY_SCOPE_AGENT) < (unsigned)G && ++sp < XB_SPIN_CAP) __builtin_amdgcn_s_sleep(1);
                            __builtin_amdgcn_fence(__ATOMIC_ACQUIRE, "agent"); asm volatile("s_waitcnt vmcnt(0)" ::: "memory"); }
                        __syncthreads(); k_ready = true; }
                    att::attn_dense_body(Qp, PROJ + rowk * NPROJ + C_AK + kvh * 128, PROJ + rowk * NPROJ + C_AV + kvh * 128, (bf16_t*)(ws + WS_OA) + rowq * LDOM + h * 128, SEQ, (char*)lds_raw + 49152, INP(5) + (size_t)l * 256, (const f32x2*)(ws + WS_CTL + ROPE_OFF), qb * 256);
                } else {
                    na_unit(PROJ, (bf16_t*)(ws + WS_OA) + OM_B, lds, xg * n_na + (idx - n_att * (1 + ATT_DUP)));
                }
            }
            SEAM(gp0 + P_GLA);
        }
        if (IN(P_M4)) { PENV;
            unsigned char* ws = WSP();
            pg8::Gemm g{(const bf16_t*)(ws + WS_OA), (const bf16_t*)(ws + WS_WBRA), M, D, LDOM, LDOM}; pg8::StaticOrder S; S.init(M, D, G, wg, WGM_M45);
            pg8::EpiMerge3 E{(const u32x4*)(ws + WS_GATES), (bf16_t*)(ws + WS_MG)};
            pg8::gemm_phase<pg8::EpiMerge3, pg8::StaticOrder, true, true>(lds, g, S, E);
            if ((DUP_MASK >> P_M4) & 1u) pg8::gemm_phase<pg8::EpiMerge3, pg8::StaticOrder, true, true>(lds, g, S, E);
            SEAM(gp0 + P_M4);
        }
        if (IN(P_M5)) { PENV;
            unsigned char* ws = WSP();
            pg8::Gemm g{(const bf16_t*)(ws + WS_MG), (const bf16_t*)(ws + WS_WOUT), M, D, D, D}; pg8::StaticOrder S; S.init(M, D, G, wg, WGM_M45);
            pg8::EpiBf16Plain E{(bf16_t*)(ws + WS_Y), D};
            pg8::gemm_phase<pg8::EpiBf16Plain, pg8::StaticOrder, true, true>(lds, g, S, E);
            if ((DUP_MASK >> P_M5) & 1u) pg8::gemm_phase<pg8::EpiBf16Plain, pg8::StaticOrder, true, true>(lds, g, S, E);
            SEAM(gp0 + P_M5);
        }
        NORM_PHASE(P_N2, 3, 1.0f, false) SEAM(gp0 + P_N2); } } while (0);
        FFN_PAIR(1, P_F2A, P_F2B);
        NORM_PHASE(P_N3, 5, 0.5f, (l + 1 == DEPTH))
            if (l + 1 < DEPTH) { LayerW w; w.w_in = INP(3) + (size_t)(l + 1) * D * NIN; w.w_bra = INP(10) + (size_t)(l + 1) * 1024 * D; w.w_brb = INP(11) + (size_t)(l + 1) * 512 * D; w.w_brc = INP(12) + (size_t)(l + 1) * 512 * D;
                w.w_out = INP(13) + (size_t)(l + 1) * D * D; w.f1i = INP(14) + (size_t)(l + 1) * D * 2 * FF; w.f1o = INP(15) + (size_t)(l + 1) * FF * D; w.f2i = INP(16) + (size_t)(l + 1) * D * 2 * FF; w.f2o = INP(17) + (size_t)(l + 1) * FF * D; w.ng = INP(2) + (size_t)(l + 1) * 6 * D;
                phase_weights(w, ws, lds, gw, NGW, wave, lane); if ((DUP_MASK >> 20) & 1u) phase_weights(w, ws, lds, gw, NGW, wave, lane); }
            SEAM(gp0 + P_N3); } } while (0);
#undef FFN_PAIR
#undef NORM_PHASE
#undef IN
    }
#undef SEAM
}

extern "C" void kernel_launch(void* const* d_in, const int* in_sizes, int n_in, void* d_out, int out_size, void* d_ws, size_t ws_size, hipStream_t stream) {
    static int grid = 0;
    if (grid == 0) {
        if (n_in != 18 || out_size != M * D || ws_size < WS_END) { fprintf(stderr, "kernel_launch: unexpected shapes: n_in %d out %d ws %zu (need %zu)\n", n_in, out_size, ws_size, (size_t)WS_END); grid = -1; return; }
        int dev = 0, cus = 0, per_cu = 0;
        if (hipGetDevice(&dev) != hipSuccess || hipDeviceGetAttribute(&cus, hipDeviceAttributeMultiprocessorCount, dev) != hipSuccess) { grid = -1; return; }
        if (hipFuncSetAttribute((const void*)fwd, hipFuncAttributeMaxDynamicSharedMemorySize, LDS_BYTES) != hipSuccess) { fprintf(stderr, "kernel_launch: hipFuncSetAttribute failed\n"); grid = -1; return; }
        if (hipOccupancyMaxActiveBlocksPerMultiprocessor(&per_cu, (const void*)fwd, 512, LDS_BYTES) != hipSuccess || per_cu < 1) fprintf(stderr, "kernel_launch: occupancy query says %d\n", per_cu);
        (void)hipGetLastError();
        grid = cus;
    }
    if (grid < 0) return;
    (void)hipMemsetAsync((char*)d_ws + WS_CTL, 0, CTL_BYTES, stream);
    Args a{};
    for (int i = 0; i < 18; ++i) a.in[i] = (const float*)d_in[i];
    a.out = (float*)d_out; a.ws = (unsigned char*)d_ws;
#if ONE_LAUNCH
    a.gp_lo = 0; a.gp_hi = NGP;
    hipLaunchKernelGGL(fwd, dim3(grid), dim3(512), LDS_BYTES, stream, a);
#else
    for (int gp = 0; gp < NGP; ++gp) { a.gp_lo = gp; a.gp_hi = gp + 1; hipLaunchKernelGGL(fwd, dim3(grid), dim3(512), LDS_BYTES, stream, a); }
#endif
    const hipError_t le = hipPeekAtLastError();
    if (le != hipSuccess) fprintf(stderr, "kernel_launch: launch failed: %s\n", hipGetErrorName(le));
}
```

```cpp
#include <hip/hip_runtime.h>
#include <cstdio>
#include <cstdint>
__device__ __forceinline__ void wg_sync() { __builtin_amdgcn_fence(__ATOMIC_RELEASE, "workgroup"); __builtin_amdgcn_s_barrier(); __builtin_amdgcn_fence(__ATOMIC_ACQUIRE, "workgroup"); }
#define __syncthreads() wg_sync()

#ifndef ONE_LAUNCH
#define ONE_LAUNCH 1
#endif
#ifndef WGM_FI
#define WGM_FI 4
#endif
#ifndef WGM_FO
#define WGM_FO 2
#endif
#ifndef WGM_M1
#define WGM_M1 4
#endif
#ifndef WGM_M45
#define WGM_M45 4
#endif
#ifndef ATT_DUP
#define ATT_DUP 0
#endif
#ifndef DUP_MASK
#define DUP_MASK 0u
#endif
#ifndef PHASE_MASK
#define PHASE_MASK 0xFFFFFFFFu
#endif

#define GAS __attribute__((address_space(1)))
#define LAS __attribute__((address_space(3)))
typedef unsigned short bf16_t;
typedef short bf16x8 __attribute__((ext_vector_type(8)));
typedef short s16x4 __attribute__((ext_vector_type(4)));
typedef float f32x4 __attribute__((ext_vector_type(4)));
typedef float f32x2 __attribute__((ext_vector_type(2)));
typedef float f32x16 __attribute__((ext_vector_type(16)));
typedef unsigned u32x4 __attribute__((ext_vector_type(4)));
typedef unsigned u32x2 __attribute__((ext_vector_type(2)));

constexpr int M = 49152;
constexpr int SEQ = 2048, NSEQ = 24;
constexpr int D = 2048, FF = 5632, DEPTH = 4;
constexpr int NPROJ = 4608;
constexpr int NGATE = 6144;
constexpr int NIN = 10784, NIN_PAD = 11008;
constexpr int C_AQ = 0, C_AK = 1024, C_AV = 1280, C_BQ = 1536, C_BK = 2048, C_BV = 2560, C_CQ = 3072, C_CK = 3328, C_CV = 3584, C_OG = 4096;
constexpr int C_OC = 3072;
constexpr float EPS = 1e-6f;

constexpr size_t MiB = 1u << 20;
constexpr size_t WS_CTL = 0, CTL_BYTES = 1 * MiB;
constexpr size_t WS_WIN = 2 * MiB;
constexpr size_t WS_WF1I = 45 * MiB;
constexpr size_t WS_WF1O = 89 * MiB;
constexpr size_t WS_WF2I = 111 * MiB;
constexpr size_t WS_WF2O = 155 * MiB;
constexpr size_t WS_WBRA = 177 * MiB;
constexpr size_t WS_WBRB = 181 * MiB;
constexpr size_t WS_WBRC = 183 * MiB;
constexpr size_t WS_WOUT = 185 * MiB;
constexpr size_t WS_XN = 193 * MiB;
constexpr size_t WS_BIG = 385 * MiB;
constexpr size_t WS_PROJ = WS_BIG;
constexpr size_t WS_GATES = WS_BIG + 432 * MiB;
constexpr size_t WS_LR = WS_BIG + 1008 * MiB;
constexpr size_t WS_H = WS_BIG;
constexpr size_t WS_Y = WS_BIG + 528 * MiB;
constexpr size_t WS_OFB = WS_BIG + 1014 * MiB;
constexpr size_t WS_MG = WS_OFB + 48 * MiB;
constexpr size_t WS_RSTD = WS_MG + 192 * MiB;
constexpr size_t WS_OA = WS_RSTD + 1 * MiB;
constexpr int LDOM = 2048, OM_B = 1024, OM_C = 1536;
constexpr size_t WS_END = WS_OA + 192 * MiB;
constexpr int CW_Q = 32768;
static_assert(WS_Y + (size_t)M * D * 4 <= WS_LR, "Y inside GATES region");
constexpr int CW_BAR = 4096;
constexpr int CW_KRDY = 49152;
constexpr size_t ROPE_OFF = 524288;

__device__ __forceinline__ unsigned cvt_pk_bf16(float lo, float hi) { unsigned r; asm volatile("v_cvt_pk_bf16_f32 %0, %1, %2" : "=v"(r) : "v"(lo), "v"(hi)); return r; }
__device__ __forceinline__ float bflo(unsigned w) { return __uint_as_float(w << 16); }
__device__ __forceinline__ float bfhi(unsigned w) { return __uint_as_float(w & 0xffff0000u); }
__device__ __forceinline__ float bf2f(bf16_t v) { return __uint_as_float(((unsigned)v) << 16); }
__device__ __forceinline__ bf16_t f2bf(float f) { unsigned u = __float_as_uint(f); return (bf16_t)((u + 0x7fffu + ((u >> 16) & 1u)) >> 16); }
__device__ __forceinline__ float wave_sum(float v) {
#pragma unroll
    for (int o = 1; o < 64; o <<= 1) v += __shfl_xor(v, o);
    return v;
}
__device__ __forceinline__ float wave_max(float v) {
#pragma unroll
    for (int o = 1; o < 64; o <<= 1) v = fmaxf(v, __shfl_xor(v, o));
    return v;
}
__device__ __forceinline__ int opaque_tid() { int t = threadIdx.x; asm volatile("" : "+v"(t)); return t; }
__device__ __forceinline__ unsigned char* opq(unsigned char* p) { asm volatile("" : "+s"(p)); return p; }
__device__ __forceinline__ const float* lds_ptr(volatile LAS unsigned long long* tab, int i) { const unsigned long long v = tab[i];
    const unsigned lo = __builtin_amdgcn_readfirstlane((unsigned)v), hi = __builtin_amdgcn_readfirstlane((unsigned)(v >> 32)); return (const float*)(((unsigned long long)hi << 32) | lo); }
#define LDS_WAIT() asm volatile("s_waitcnt lgkmcnt(0)" ::: "memory")
#define VM_WAIT() asm volatile("s_waitcnt vmcnt(0)" ::: "memory")

namespace pg8 {
constexpr int BM = 256, BK = 64, HALF = 128, HTB = HALF * BK * 2, STAGE_BYTES = 8 * HTB, NXCD = 8;
__host__ __device__ __forceinline__ int lds_byte(int r, int c) { const int st = (r >> 4) * 2 + (c >> 5), rr = r & 15, cc = c & 31, ob = rr * 64 + cc * 2; return st * 1024 + (ob ^ (((ob >> 9) & 1) << 5)); }
__host__ __device__ __forceinline__ void stage_rc(int b, int& R, int& C) { const int st = b / 1024, sb = b % 1024, swz = sb ^ (((sb >> 9) & 1) << 5); R = (st >> 1) * 16 + swz / 64; C = (st & 1) * 32 + (swz % 64) / 2; }
__host__ __device__ __forceinline__ int perm32(int rho) { const int n = rho >> 4, i = rho & 15; return 8 * (i >> 2) + 4 * n + (i & 3); }

struct Unit { int pm, pn; };
struct Gemm { const bf16_t* A; const bf16_t* Bt; int M, N, K, lda; };

struct StaticOrder {
    int nM, nN, nwg, G, c, WGM;
    __host__ __device__ __forceinline__ void init(int M_, int N_, int G_, int c_, int wgm_ = 4) { nM = M_ / BM; nN = N_ / BM; nwg = nM * nN; G = G_; c = c_; WGM = wgm_; }
    __host__ __device__ bool next(int i, Unit& u) const {
        const long L = (long)i * G + c; if (L >= nwg) return false;
        int wgid = (int)L; { const int q = nwg / NXCD, r = nwg % NXCD, xcd = wgid % NXCD, off = wgid / NXCD; wgid = (xcd < r ? xcd * (q + 1) : r * (q + 1) + (xcd - r) * q) + off; }
        const int nig = WGM * nN, gid = wgid / nig, fm = gid * WGM, gsz = (nM - fm) < WGM ? (nM - fm) : WGM;
        u.pm = fm + ((wgid % nig) % gsz); u.pn = (wgid % nig) / gsz; return true;
    }
    __device__ __forceinline__ void a_ready(const Unit&) const {}
    __device__ __forceinline__ void done(const Unit&) const {}
};

struct EpiF32 {
    static constexpr bool PERM = false, AFTER_DRAIN = false, HAS_MID = false, USES_RSTD = false;
    float* C; int ldc;
    __device__ __forceinline__ void operator()(const f32x4 (&acc)[2][2][4][2], const Unit& u, int wr, int wc, int fr, int fq, const LAS float* rsl) const {
        const int row0 = u.pm * BM + wr * 64 + fr, col0 = u.pn * BM + wc * 32 + 4 * fq;
#pragma unroll
        for (int ai = 0; ai < 2; ++ai)
#pragma unroll
            for (int m = 0; m < 4; ++m) { float* rowp = C + (size_t)(row0 + ai * HALF + m * 16) * ldc + col0;
#pragma unroll
                for (int bj = 0; bj < 2; ++bj)
#pragma unroll
                    for (int n = 0; n < 2; ++n) *(f32x4*)(rowp + bj * HALF + n * 16) = acc[ai][bj][m][n]; }
    }
};
struct EpiBf16Plain {
    static constexpr bool PERM = true, AFTER_DRAIN = false, HAS_MID = false, USES_RSTD = false;
    bf16_t* C; int ldc;
    __device__ __forceinline__ void operator()(const f32x4 (&acc)[2][2][4][2], const Unit& u, int wr, int wc, int fr, int fq, const LAS float* rsl) const {
        const int row0 = u.pm * BM + wr * 64 + fr, col0 = u.pn * BM + wc * 32 + 8 * fq;
#pragma unroll
        for (int ai = 0; ai < 2; ++ai)
#pragma unroll
            for (int m = 0; m < 4; ++m) { bf16_t* p = C + (size_t)(row0 + ai * HALF + m * 16) * ldc + col0;
#pragma unroll
                for (int bj = 0; bj < 2; ++bj) { const f32x4 v0 = acc[ai][bj][m][0], v1 = acc[ai][bj][m][1];
                    u32x4 w; w.x = cvt_pk_bf16(v0[0], v0[1]); w.y = cvt_pk_bf16(v0[2], v0[3]); w.z = cvt_pk_bf16(v1[0], v1[1]); w.w = cvt_pk_bf16(v1[2], v1[3]);
                    *(u32x4*)(p + bj * HALF) = w; } }
    }
};
__device__ __forceinline__ float silu_f(float g) { return g * __builtin_amdgcn_rcpf(1.0f + __builtin_amdgcn_exp2f(-1.4426950408889634f * g)); }
__device__ __forceinline__ float sigmoid_f(float g) { return __builtin_amdgcn_rcpf(1.0f + __builtin_amdgcn_exp2f(-1.4426950408889634f * g)); }
__device__ __forceinline__ float swiglu1(float a, float b, float nrs, float irs2) { const float e = __builtin_amdgcn_exp2f(a * nrs); return (a * b) * __builtin_amdgcn_rcpf(__builtin_fmaf(e, irs2, irs2)); }
struct EpiSwiGLU {
    static constexpr bool PERM = true, AFTER_DRAIN = false, HAS_MID = false, USES_RSTD = true;
    bf16_t* H; const float* rstd;
    __device__ __forceinline__ void operator()(const f32x4 (&acc)[2][2][4][2], const Unit& u, int wr, int wc, int fr, int fq, const LAS float* rsl) const {
        const int row0 = u.pm * BM + wr * 64 + fr, col0 = u.pn * HALF + wc * 32 + 8 * fq;
#pragma unroll
        for (int ai = 0; ai < 2; ++ai)
#pragma unroll
            for (int m = 0; m < 4; ++m) { bf16_t* p = H + (size_t)(row0 + ai * HALF + m * 16) * FF + col0; const float rs = rsl[wr * 64 + fr + ai * HALF + m * 16];
                const float nrs = -1.4426950408889634f * rs, irs2 = __builtin_amdgcn_rcpf(rs * rs);
                const f32x4 a0 = acc[ai][0][m][0], a1 = acc[ai][0][m][1], b0 = acc[ai][1][m][0], b1 = acc[ai][1][m][1];
                u32x4 w; w.x = cvt_pk_bf16(swiglu1(a0[0], b0[0], nrs, irs2), swiglu1(a0[1], b0[1], nrs, irs2)); w.y = cvt_pk_bf16(swiglu1(a0[2], b0[2], nrs, irs2), swiglu1(a0[3], b0[3], nrs, irs2));
                w.z = cvt_pk_bf16(swiglu1(a1[0], b1[0], nrs, irs2), swiglu1(a1[1], b1[1], nrs, irs2)); w.w = cvt_pk_bf16(swiglu1(a1[2], b1[2], nrs, irs2), swiglu1(a1[3], b1[3], nrs, irs2));
                *(u32x4*)p = w; }
    }
};
__device__ __forceinline__ float gate_k(float a, float nrs, float nb) { const float e = __builtin_amdgcn_exp2f(__builtin_fmaf(a, nrs, nb));
    return fmaxf(__builtin_rintf(__builtin_amdgcn_rcpf(__builtin_fmaf(e, 1.0f / 255.0f, 1.0f / 255.0f))), 1.0f); }
__device__ __forceinline__ unsigned gate_q4(const f32x4 a, float nrs, const f32x4 nb) { unsigned w = __builtin_amdgcn_cvt_pk_u8_f32(gate_k(a[0], nrs, nb[0]), 0u, 0u); w = __builtin_amdgcn_cvt_pk_u8_f32(gate_k(a[1], nrs, nb[1]), 1u, w);
    w = __builtin_amdgcn_cvt_pk_u8_f32(gate_k(a[2], nrs, nb[2]), 2u, w); return __builtin_amdgcn_cvt_pk_u8_f32(gate_k(a[3], nrs, nb[3]), 3u, w); }
__device__ __forceinline__ f32x4 ub4(unsigned w) { return (f32x4){(float)(w & 0xffu), (float)((w >> 8) & 0xffu), (float)((w >> 16) & 0xffu), (float)(w >> 24)}; }
__device__ __forceinline__ f32x4 rcp4(const f32x4 v) { return (f32x4){__builtin_amdgcn_rcpf(v[0]), __builtin_amdgcn_rcpf(v[1]), __builtin_amdgcn_rcpf(v[2]), __builtin_amdgcn_rcpf(v[3])}; }
struct EpiProj {
    static constexpr bool PERM = true, AFTER_DRAIN = false, HAS_MID = false, USES_RSTD = true;
    bf16_t* PROJ; u32x4* GQ; float* LR; const float* gbias; const float* rstd;
    __device__ __forceinline__ void operator()(const f32x4 (&acc)[2][2][4][2], const Unit& u, int wr, int wc, int fr, int fq, const LAS float* rsl) const {
        const int row0 = u.pm * BM + wr * 64 + fr;
        if (u.pn < 18) {
            const int col0 = u.pn * BM + wc * 32 + 8 * fq;
#pragma unroll
            for (int ai = 0; ai < 2; ++ai)
#pragma unroll
                for (int m = 0; m < 4; ++m) { bf16_t* p = PROJ + (size_t)(row0 + ai * HALF + m * 16) * NPROJ + col0; const float rs = rsl[wr * 64 + fr + ai * HALF + m * 16];
#pragma unroll
                    for (int bj = 0; bj < 2; ++bj) { const f32x4 v0 = acc[ai][bj][m][0] * rs, v1 = acc[ai][bj][m][1] * rs;
                        u32x4 w; w.x = cvt_pk_bf16(v0[0], v0[1]); w.y = cvt_pk_bf16(v0[2], v0[3]); w.z = cvt_pk_bf16(v1[0], v1[1]); w.w = cvt_pk_bf16(v1[2], v1[3]);
                        *(u32x4*)(p + bj * HALF) = w; } }
        } else if (u.pn < 42) {
            const int gt = u.pn - 18, col0 = gt * BM + wc * 32 + 8 * fq;
            constexpr float NL2E = -1.4426950408889634f;
            const f32x4 b00 = *(const f32x4*)(gbias + col0) * NL2E, b01 = *(const f32x4*)(gbias + col0 + 4) * NL2E, b10 = *(const f32x4*)(gbias + col0 + HALF) * NL2E, b11 = *(const f32x4*)(gbias + col0 + HALF + 4) * NL2E;
            u32x4* gq = GQ + ((size_t)((gt >> 3) * (M / BM) + u.pm) * 8 + (gt & 7)) * 4096 + (wr * 4 + wc) * 512 + (fq * 16 + fr);
#pragma unroll
            for (int ai = 0; ai < 2; ++ai)
#pragma unroll
                for (int m = 0; m < 4; ++m) { const float nrs = NL2E * rsl[wr * 64 + fr + ai * HALF + m * 16];
                    u32x4 w; w.x = gate_q4(acc[ai][0][m][0], nrs, b00); w.y = gate_q4(acc[ai][0][m][1], nrs, b01); w.z = gate_q4(acc[ai][1][m][0], nrs, b10); w.w = gate_q4(acc[ai][1][m][1], nrs, b11);
                    gq[(ai * 4 + m) * 64] = w; }
        } else {
            if (wc == 0) {
#pragma unroll
                for (int ai = 0; ai < 2; ++ai)
#pragma unroll
                    for (int m = 0; m < 4; ++m) { float* p = LR + (size_t)(row0 + ai * HALF + m * 16) * 32 + 8 * fq; const float rs = rsl[wr * 64 + fr + ai * HALF + m * 16];
                        *(f32x4*)p = acc[ai][0][m][0] * rs; *(f32x4*)(p + 4) = acc[ai][0][m][1] * rs; }
            }
        }
    }
};
struct EpiMerge3 {
    static constexpr bool PERM = true, AFTER_DRAIN = false, HAS_MID = true, USES_RSTD = false;
    static constexpr int MID0 = 1024 / BK, MID1 = 1536 / BK;
    static constexpr size_t GSTRIDE = (size_t)(M / BM) * 8 * 4096;
    const u32x4* GQ; bf16_t* MG;
    __device__ __forceinline__ void mid(f32x4 (&acc)[2][2][4][2], const Unit& u, int seg, int wr, int wc, int fr, int fq) const {
        const u32x4* gp = GQ + (size_t)seg * GSTRIDE + ((size_t)u.pm * 8 + u.pn) * 4096 + (wr * 4 + wc) * 512 + (fq * 16 + fr);
        u32x4 gn[8], gd[8];
#pragma unroll
        for (int j = 0; j < 8; ++j) { gn[j] = gp[j * 64]; gd[j] = gp[GSTRIDE + j * 64]; }
#pragma unroll
        for (int j = 0; j < 8; ++j) { const int ai = j >> 2, m = j & 3;
            acc[ai][0][m][0] = acc[ai][0][m][0] * (ub4(gn[j].x) * rcp4(ub4(gd[j].x))); acc[ai][0][m][1] = acc[ai][0][m][1] * (ub4(gn[j].y) * rcp4(ub4(gd[j].y)));
            acc[ai][1][m][0] = acc[ai][1][m][0] * (ub4(gn[j].z) * rcp4(ub4(gd[j].z))); acc[ai][1][m][1] = acc[ai][1][m][1] * (ub4(gn[j].w) * rcp4(ub4(gd[j].w))); }
    }
    __device__ __forceinline__ void operator()(const f32x4 (&acc)[2][2][4][2], const Unit& u, int wr, int wc, int fr, int fq, const LAS float* rsl) const {
        const int row0 = u.pm * BM + wr * 64 + fr, col0 = u.pn * BM + wc * 32 + 8 * fq;
        const u32x4* gp = GQ + 2 * GSTRIDE + ((size_t)u.pm * 8 + u.pn) * 4096 + (wr * 4 + wc) * 512 + (fq * 16 + fr);
        u32x4 gc[8];
#pragma unroll
        for (int j = 0; j < 8; ++j) gc[j] = gp[j * 64];
        constexpr float S = 1.0f / 255.0f;
#pragma unroll
        for (int j = 0; j < 8; ++j) { const int ai = j >> 2, m = j & 3; bf16_t* p = MG + (size_t)(row0 + ai * HALF + m * 16) * D + col0;
            const f32x4 v0 = acc[ai][0][m][0] * (ub4(gc[j].x) * S), v1 = acc[ai][0][m][1] * (ub4(gc[j].y) * S), v2 = acc[ai][1][m][0] * (ub4(gc[j].z) * S), v3 = acc[ai][1][m][1] * (ub4(gc[j].w) * S);
            u32x4 w; w.x = cvt_pk_bf16(v0[0], v0[1]); w.y = cvt_pk_bf16(v0[2], v0[3]); w.z = cvt_pk_bf16(v1[0], v1[1]); w.w = cvt_pk_bf16(v1[2], v1[3]); *(u32x4*)p = w;
            w.x = cvt_pk_bf16(v2[0], v2[1]); w.y = cvt_pk_bf16(v2[2], v2[3]); w.z = cvt_pk_bf16(v3[0], v3[1]); w.w = cvt_pk_bf16(v3[2], v3[3]); *(u32x4*)(p + HALF) = w; }
    }
};

template <class Epi, class Sched, bool ALIGN_EPI = false, bool SP2 = false>
__device__ __forceinline__ void gemm_phase(LAS unsigned char* lds, const Gemm g, const Sched& S, const Epi& E) {
    const int tid = opaque_tid(), wid = __builtin_amdgcn_readfirstlane(tid >> 6), lane = tid & 63, wr = wid >> 2, wc = wid & 3, fr = lane & 15, fq = lane >> 4;
    const int K = g.K, nt = K / BK, lda = g.lda;
    unsigned voffA[2], voffB[2];
#pragma unroll
    for (int i = 0; i < 2; ++i) { int R, C; stage_rc(tid * 16 + i * 8192, R, C); const int Rb = Epi::PERM ? ((R & ~31) + perm32(R & 31)) : R;
        voffA[i] = (unsigned)(R * lda + C) * 2u; voffB[i] = (unsigned)(Rb * K + C) * 2u; }
    const unsigned kstep = (unsigned)(BK * 2);
    const unsigned hstepA = (unsigned)HALF * (unsigned)lda * 2u, hstepB = (unsigned)HALF * (unsigned)K * 2u;
    const unsigned tstepA = 2u * hstepA, tstepB = 2u * hstepB;
    const unsigned ldsw = (unsigned)wid * 1024u;
    const int aoff = lds_byte(wr * 64 + fr, fq * 8), boff = lds_byte(wc * 32 + fr, fq * 8);
    const char* const baseA = (const char*)g.A; const char* const baseB = (const char*)g.Bt;
#define PG8_SA(b, h) (((b) * 2 + (h)) * HTB)
#define PG8_SB(b, h) ((4 + (b) * 2 + (h)) * HTB)
#define PG8_STAGE(bufoff, gbase, goff, voff) do { _Pragma("unroll") for (int _i = 0; _i < 2; ++_i) \
        __builtin_amdgcn_global_load_lds((const unsigned*)((gbase) + (size_t)(unsigned)((goff) + (voff)[_i])), (LAS unsigned*)(lds + (bufoff) + ldsw + _i * 8192), 16, 0, 0); } while (0)
#define PG8_LDA(dst, b, h) do { _Pragma("unroll") for (int m = 0; m < 4; ++m) _Pragma("unroll") for (int k = 0; k < 2; ++k) dst[m][k] = *(const LAS bf16x8*)(lds + PG8_SA(b, h) + aoff + m * 2048 + k * 1024); } while (0)
#define PG8_LDB(dst, b, h) do { _Pragma("unroll") for (int n = 0; n < 2; ++n) _Pragma("unroll") for (int k = 0; k < 2; ++k) dst[n][k] = *(const LAS bf16x8*)(lds + PG8_SB(b, h) + boff + n * 2048 + k * 1024); } while (0)
#define PG8_MMA(ai, bj, At, Bt) do { __builtin_amdgcn_s_setprio(1); _Pragma("unroll") for (int m = 0; m < 4; ++m) _Pragma("unroll") for (int n = 0; n < 2; ++n) _Pragma("unroll") for (int k = 0; k < 2; ++k) \
        acc[ai][bj][m][n] = __builtin_amdgcn_mfma_f32_16x16x32_bf16(Bt[n][k], At[m][k], acc[ai][bj][m][n], 0, 0, 0); __builtin_amdgcn_s_setprio(0); } while (0)
#define PG8_WAIT_V(n) asm volatile("s_waitcnt vmcnt(" #n ")" ::: "memory")
#define PG8_WAIT_L(n) asm volatile("s_waitcnt lgkmcnt(" #n ")" ::: "memory")
#define PG8_BAR __builtin_amdgcn_s_barrier()
#define PG8_SCHED __builtin_amdgcn_sched_barrier(0)
    Unit cur, nxt; int ui = 0;
    if (!S.next(0, cur)) return;
    constexpr int RS_OFF = 131072 + 8192;
#define PG8_RSTD(u_, slot_) do { if constexpr (Epi::USES_RSTD) { if (wid == 0) __builtin_amdgcn_global_load_lds((const unsigned*)(E.rstd + (size_t)(u_).pm * BM + lane * 4), (LAS unsigned*)(lds + RS_OFF + (slot_) * 1024), 16, 0, 0); } } while (0)
    PG8_RSTD(cur, 0);
    f32x4 acc[2][2][4][2];
#pragma unroll
    for (int a = 0; a < 2; ++a)
#pragma unroll
        for (int b = 0; b < 2; ++b)
#pragma unroll
            for (int m = 0; m < 4; ++m)
#pragma unroll
                for (int n = 0; n < 2; ++n) acc[a][b][m][n] = (f32x4){0.f, 0.f, 0.f, 0.f};
    bf16x8 At[4][2], B0[2][2], B1[2][2];
    unsigned cA = (unsigned)cur.pm * tstepA, cB = (unsigned)cur.pn * tstepB;
    S.a_ready(cur);
    if constexpr (SP2) {
        PG8_STAGE(PG8_SB(0, 0), baseB, cB, voffB); PG8_STAGE(PG8_SB(0, 1), baseB, cB + hstepB, voffB); PG8_STAGE(PG8_SA(0, 0), baseA, cA, voffA); PG8_STAGE(PG8_SA(0, 1), baseA, cA + hstepA, voffA);
        if (wr == 1) PG8_BAR;
        PG8_WAIT_V(2); PG8_BAR;
        PG8_STAGE(PG8_SB(1, 0), baseB, cB + kstep, voffB); PG8_STAGE(PG8_SA(1, 0), baseA, cA + kstep, voffA); PG8_STAGE(PG8_SB(1, 1), baseB, cB + hstepB + kstep, voffB);
        PG8_WAIT_V(6); PG8_BAR;
    } else {
        PG8_STAGE(PG8_SB(0, 0), baseB, cB, voffB); PG8_STAGE(PG8_SA(0, 0), baseA, cA, voffA); PG8_STAGE(PG8_SB(0, 1), baseB, cB + hstepB, voffB); PG8_STAGE(PG8_SA(0, 1), baseA, cA + hstepA, voffA);
        if (wr == 1) PG8_BAR;
        PG8_WAIT_V(4); PG8_BAR;
        PG8_STAGE(PG8_SB(1, 0), baseB, cB + kstep, voffB); PG8_STAGE(PG8_SA(1, 0), baseA, cA + kstep, voffA); PG8_STAGE(PG8_SB(1, 1), baseB, cB + hstepB + kstep, voffB);
        PG8_WAIT_V(6); PG8_BAR;
    }
    for (;;) {
        const bool has_next = S.next(ui + 1, nxt);
        const unsigned nA = has_next ? (unsigned)nxt.pm * tstepA : cA, nB = has_next ? (unsigned)nxt.pn * tstepB : cB;
        for (int t = 0; t < nt; t += 2) {
            const bool last = (t == nt - 2);
            if constexpr (Epi::HAS_MID) { if (t == Epi::MID0 || t == Epi::MID1) E.mid(acc, cur, t == Epi::MID0 ? 0 : 1, wr, wc, fr, fq); }
            const unsigned a1 = cA + (unsigned)(t + 1) * kstep;
            const unsigned a2 = last ? nA : cA + (unsigned)(t + 2) * kstep, b2 = last ? nB : cB + (unsigned)(t + 2) * kstep;
            const unsigned a3 = a2 + kstep, b3 = b2 + kstep;
            if (last && has_next) S.a_ready(nxt);
            if constexpr (SP2) {
            PG8_LDB(B0, 0, 0); PG8_LDB(B1, 0, 1); PG8_SCHED; PG8_LDA(At, 0, 0); PG8_STAGE(PG8_SA(1, 1), baseA, a1 + hstepA, voffA);
            PG8_WAIT_V(8); PG8_WAIT_L(0); PG8_BAR; PG8_MMA(0, 0, At, B0); PG8_MMA(0, 1, At, B1); PG8_BAR; PG8_SCHED;
            PG8_LDA(At, 0, 1); PG8_STAGE(PG8_SB(0, 0), baseB, b2, voffB); PG8_STAGE(PG8_SB(0, 1), baseB, b2 + hstepB, voffB); PG8_STAGE(PG8_SA(0, 0), baseA, a2, voffA);
            PG8_WAIT_V(8); PG8_WAIT_L(0); PG8_BAR; PG8_MMA(1, 0, At, B0); PG8_MMA(1, 1, At, B1); PG8_BAR; PG8_SCHED;
            PG8_LDB(B0, 1, 0); PG8_LDB(B1, 1, 1); PG8_SCHED; PG8_LDA(At, 1, 0); PG8_STAGE(PG8_SA(0, 1), baseA, a2 + hstepA, voffA);
            PG8_WAIT_V(8); PG8_WAIT_L(0); PG8_BAR; PG8_MMA(0, 0, At, B0); PG8_MMA(0, 1, At, B1); PG8_BAR; PG8_SCHED;
            PG8_LDA(At, 1, 1); PG8_STAGE(PG8_SB(1, 0), baseB, b3, voffB); PG8_STAGE(PG8_SB(1, 1), baseB, b3 + hstepB, voffB); PG8_STAGE(PG8_SA(1, 0), baseA, a3, voffA);
            PG8_WAIT_V(8); PG8_WAIT_L(0); PG8_BAR; PG8_MMA(1, 0, At, B0); PG8_MMA(1, 1, At, B1); PG8_BAR; PG8_SCHED;
            } else {
            PG8_LDB(B0, 0, 0); PG8_SCHED; PG8_LDA(At, 0, 0); PG8_STAGE(PG8_SA(1, 1), baseA, a1 + hstepA, voffA);
            PG8_WAIT_L(8); PG8_BAR; PG8_WAIT_L(0); PG8_MMA(0, 0, At, B0); PG8_BAR; PG8_SCHED;
            PG8_LDB(B1, 0, 1); PG8_STAGE(PG8_SB(0, 0), baseB, b2, voffB);
            PG8_BAR; PG8_WAIT_L(0); PG8_MMA(0, 1, At, B1); PG8_BAR;
            PG8_LDA(At, 0, 1); PG8_STAGE(PG8_SA(0, 0), baseA, a2, voffA);
            PG8_BAR; PG8_WAIT_L(0); PG8_MMA(1, 0, At, B0); PG8_BAR; PG8_SCHED;
            PG8_STAGE(PG8_SB(0, 1), baseB, b2 + hstepB, voffB);
            PG8_WAIT_V(6); PG8_BAR; PG8_MMA(1, 1, At, B1); PG8_BAR;
            PG8_LDB(B0, 1, 0); PG8_SCHED; PG8_LDA(At, 1, 0); PG8_STAGE(PG8_SA(0, 1), baseA, a2 + hstepA, voffA);
            PG8_WAIT_L(8); PG8_BAR; PG8_WAIT_L(0); PG8_MMA(0, 0, At, B0); PG8_BAR; PG8_SCHED;
            PG8_LDB(B1, 1, 1); PG8_STAGE(PG8_SB(1, 0), baseB, b3, voffB);
            PG8_BAR; PG8_WAIT_L(0); PG8_MMA(0, 1, At, B1); PG8_BAR;
            PG8_LDA(At, 1, 1); PG8_STAGE(PG8_SA(1, 0), baseA, a3, voffA);
            PG8_BAR; PG8_WAIT_L(0); PG8_MMA(1, 0, At, B0); PG8_BAR; PG8_SCHED;
            PG8_STAGE(PG8_SB(1, 1), baseB, b3 + hstepB, voffB);
            PG8_WAIT_V(6); PG8_BAR; PG8_MMA(1, 1, At, B1); PG8_BAR;
            }
        }
        if constexpr (ALIGN_EPI) { if (wr == 0) PG8_BAR; }
        if constexpr (!Epi::AFTER_DRAIN) { E(acc, cur, wr, wc, fr, fq, (const LAS float*)(lds + RS_OFF + (ui & 1) * 1024)); S.done(cur); }
        if (!has_next) break;
#pragma unroll
        for (int a = 0; a < 2; ++a)
#pragma unroll
            for (int b = 0; b < 2; ++b)
#pragma unroll
                for (int m = 0; m < 4; ++m)
#pragma unroll
                    for (int n = 0; n < 2; ++n) acc[a][b][m][n] = (f32x4){0.f, 0.f, 0.f, 0.f};
        cur = nxt; cA = nA; cB = nB; ++ui;
        PG8_RSTD(cur, ui & 1);
        if constexpr (ALIGN_EPI) { if (wr == 1) PG8_BAR; }
    }
    PG8_WAIT_V(0);
    if constexpr (!ALIGN_EPI) { if (wr == 0) PG8_BAR; }
    PG8_BAR;
#undef PG8_SA
#undef PG8_SB
#undef PG8_STAGE
#undef PG8_LDA
#undef PG8_LDB
#undef PG8_MMA
#undef PG8_WAIT_V
#undef PG8_WAIT_L
#undef PG8_BAR
#undef PG8_SCHED
}
}

namespace att {
constexpr int DH = 128, NW = 8, QBLK = 32, KVBLK = 64;
constexpr float SCALE = 0.088388347648318440f;
constexpr float THR = 8.f;
constexpr int LD = NPROJ, LDO = 2048;
constexpr size_t SHM_V = KVBLK * DH * 2, SHM_K = KVBLK * DH * 2, SHM_ATTN = 2 * SHM_V + 2 * SHM_K + NW * 64 * 4;
#define KSWZ(row, colB) ((row) * 256 + ((colB) ^ (((row) & 7) << 4)))
#define SBAR() __builtin_amdgcn_sched_barrier(0)
__device__ __forceinline__ int crow(int r, int hi) { return (r & 3) + 8 * (r >> 2) + 4 * hi; }
__device__ __forceinline__ void partialSM(f32x16& p0, f32x16& p1, float& m_reg, float& mn, float& alpha) {
  constexpr float C = SCALE * 1.4426950408889634f;
  float pmax = p0[0];
#pragma unroll
  for (int r = 1; r < 16; ++r) pmax = fmaxf(pmax, p0[r]);
#pragma unroll
  for (int r = 0; r < 16; ++r) pmax = fmaxf(pmax, p1[r]);
  { auto rr = __builtin_amdgcn_permlane32_swap(__float_as_uint(pmax), __float_as_uint(pmax), false, false);
    pmax = fmaxf(__uint_as_float(rr[0]), __uint_as_float(rr[1])); }
  if (__builtin_expect(__all(pmax - m_reg <= THR / SCALE), 1)) { mn = m_reg; alpha = 1.f; }
  else { mn = fmaxf(m_reg, pmax); alpha = __builtin_amdgcn_exp2f((m_reg - mn) * C); m_reg = mn; }
  float mnC = -mn * C;
#pragma unroll
  for (int r = 0; r < 16; ++r) p0[r] = fmaf(p0[r], C, mnC);
#pragma unroll
  for (int r = 0; r < 16; ++r) p1[r] = fmaf(p1[r], C, mnC);
#pragma unroll
  for (int r = 0; r < 16; ++r) p0[r] = __builtin_amdgcn_exp2f(p0[r]);
}
__device__ __forceinline__ void finishSM(f32x16& p0, f32x16& p1, float alpha, float& l_reg, bf16x8& pa0, bf16x8& pa1, bf16x8& pa2, bf16x8& pa3) {
#pragma unroll
  for (int r = 0; r < 16; ++r) p1[r] = __builtin_amdgcn_exp2f(p1[r]);
  float ps = 0;
#pragma unroll
  for (int r = 0; r < 16; ++r) ps += p0[r];
#pragma unroll
  for (int r = 0; r < 16; ++r) ps += p1[r];
  { auto rr = __builtin_amdgcn_permlane32_swap(__float_as_uint(ps), __float_as_uint(ps), false, false);
    ps = __uint_as_float(rr[0]) + __uint_as_float(rr[1]); }
  l_reg = l_reg * alpha + ps;
#define PK4(P, BASE, OUT) do { unsigned a0 = cvt_pk_bf16(P[BASE + 0], P[BASE + 1]), a1 = cvt_pk_bf16(P[BASE + 2], P[BASE + 3]);   \
    unsigned b0 = cvt_pk_bf16(P[BASE + 4], P[BASE + 5]), b1 = cvt_pk_bf16(P[BASE + 6], P[BASE + 7]);                              \
    auto r0 = __builtin_amdgcn_permlane32_swap(a0, b0, false, false); auto r1 = __builtin_amdgcn_permlane32_swap(a1, b1, false, false); \
    u32x4 w = {r0[0], r1[0], r0[1], r1[1]}; OUT = *reinterpret_cast<bf16x8*>(&w); } while (0)
  PK4(p0, 0, pa0); PK4(p0, 8, pa1); PK4(p1, 0, pa2); PK4(p1, 8, pa3);
#undef PK4
}
__device__ __forceinline__ void qkt(f32x16& p0, f32x16& p1, const bf16_t* Ks, const bf16x8* qr, int r32, int hi) {
  p0 = f32x16{}; p1 = f32x16{};
#pragma unroll
  for (int d0 = 0; d0 < 8; ++d0) { int cb = (d0 * 16 + hi * 8) * 2;
    bf16x8 b0 = *reinterpret_cast<const bf16x8*>((const char*)Ks + KSWZ(r32, cb));
    bf16x8 b1 = *reinterpret_cast<const bf16x8*>((const char*)Ks + KSWZ(32 + r32, cb));
    p0 = __builtin_amdgcn_mfma_f32_32x32x16_bf16(b0, qr[d0], p0, 0, 0, 0);
    p1 = __builtin_amdgcn_mfma_f32_32x32x16_bf16(b1, qr[d0], p1, 0, 0, 0); }
}
__device__ __forceinline__ int v_st(int k, int c) { const int kk = (k & ~0xC) | ((k & 4) << 1) | ((k & 8) >> 1); return ((kk >> 3) * 4 + (c >> 5)) * 512 + ((kk & 7) * 32 + (c & 31)) * 2; }
__device__ __forceinline__ int v_rd_base(int lane) { return ((lane & 3) << 3) | (((lane >> 2) & 3) << 6) | (((lane >> 4) & 1) << 5) | (((lane >> 5) & 1) << 8); }
constexpr int v_rd_off(int d0, int ks, int half) { return d0 * 512 + ks * 4096 + half * 2048; }
template <int OFF> __device__ __forceinline__ s16x4 tr_read(int vb) {
  s16x4 r; asm volatile("ds_read_b64_tr_b16 %0, %1 offset:%2" : "=&v"(r) : "v"(vb), "i"(OFF) : "memory"); return r;
}
template <int D0> __device__ __forceinline__ void pv_one(f32x16& od, int vb, bf16x8 pa0, bf16x8 pa1, bf16x8 pa2, bf16x8 pa3) {
  const s16x4 l0 = tr_read<v_rd_off(D0, 0, 0)>(vb), h0 = tr_read<v_rd_off(D0, 0, 1)>(vb), l1 = tr_read<v_rd_off(D0, 1, 0)>(vb), h1 = tr_read<v_rd_off(D0, 1, 1)>(vb);
  const s16x4 l2 = tr_read<v_rd_off(D0, 2, 0)>(vb), h2 = tr_read<v_rd_off(D0, 2, 1)>(vb), l3 = tr_read<v_rd_off(D0, 3, 0)>(vb), h3 = tr_read<v_rd_off(D0, 3, 1)>(vb);
  asm volatile("s_waitcnt lgkmcnt(0)" ::: "memory"); SBAR();
#define PK(L, H) (bf16x8){L[0], L[1], L[2], L[3], H[0], H[1], H[2], H[3]}
  od = __builtin_amdgcn_mfma_f32_32x32x16_bf16(pa0, PK(l0, h0), od, 0, 0, 0);
  od = __builtin_amdgcn_mfma_f32_32x32x16_bf16(pa1, PK(l1, h1), od, 0, 0, 0);
  od = __builtin_amdgcn_mfma_f32_32x32x16_bf16(pa2, PK(l2, h2), od, 0, 0, 0);
  od = __builtin_amdgcn_mfma_f32_32x32x16_bf16(pa3, PK(l3, h3), od, 0, 0, 0);
#undef PK
}
__device__ __forceinline__ void pv_d0(f32x16* o, int vb, bf16x8 pa0, bf16x8 pa1, bf16x8 pa2, bf16x8 pa3) {
  pv_one<0>(o[0], vb, pa0, pa1, pa2, pa3); pv_one<1>(o[1], vb, pa0, pa1, pa2, pa3); pv_one<2>(o[2], vb, pa0, pa1, pa2, pa3); pv_one<3>(o[3], vb, pa0, pa1, pa2, pa3);
}
__device__ __forceinline__ void attn_dense_body(const bf16_t* Qb, const bf16_t* __restrict__ Kh, const bf16_t* __restrict__ Vh, bf16_t* Ob, int seq, char* lds, const float* qgain  , const f32x2* cs  , int t0  ) {
  const int tid = opaque_tid(), wid = tid >> 6, lane = tid & 63, r32 = lane & 31, hi = lane >> 5;
  bf16_t* V_lds = (bf16_t*)lds; bf16_t* K_lds = (bf16_t*)(lds + 2 * SHM_V);
  float* ws = (float*)(lds + 2 * SHM_V + 2 * SHM_K) + wid * 64; float* li_l = ws; float* al_l = ws + 32;
  float m_reg = -1e30f, l_reg = 0; f32x16 o[4] = {}; bf16x8 qr[8];
  const bf16_t* Qw = Qb + (long)(wid * QBLK + r32) * LD + hi * 8;
#pragma unroll
  for (int d0 = 0; d0 < 8; ++d0) qr[d0] = *reinterpret_cast<const bf16x8*>(Qw + d0 * 16);
  {
    float ss = 0.f;
#pragma unroll
    for (int d0 = 0; d0 < 8; ++d0) { const u32x4 w = *reinterpret_cast<const u32x4*>(&qr[d0]);
      ss += (bflo(w.x) * bflo(w.x) + bfhi(w.x) * bfhi(w.x)) + (bflo(w.y) * bflo(w.y) + bfhi(w.y) * bfhi(w.y)) + (bflo(w.z) * bflo(w.z) + bfhi(w.z) * bfhi(w.z)) + (bflo(w.w) * bflo(w.w) + bfhi(w.w) * bfhi(w.w)); }
    { auto rr = __builtin_amdgcn_permlane32_swap(__float_as_uint(ss), __float_as_uint(ss), false, false); ss = __uint_as_float(rr[0]) + __uint_as_float(rr[1]); }
    const float rstd = 1.0f / sqrtf(ss * (1.0f / 128.0f) + EPS);
    const int t = t0 + wid * QBLK + r32, pr = t >> 6, pc = t & 63;
#pragma unroll
    for (int d0 = 0; d0 < 8; ++d0) {
      const f32x4 g0 = *(const f32x4*)(qgain + d0 * 16 + hi * 8) * rstd, g1 = *(const f32x4*)(qgain + d0 * 16 + hi * 8 + 4) * rstd;
      const f32x4* cp = (const f32x4*)(cs + ((d0 < 4) ? pr : pc) * 32 + (d0 & 3) * 8 + hi * 4); const f32x4 ca = cp[0], cb = cp[1];
      const u32x4 w = *reinterpret_cast<const u32x4*>(&qr[d0]); u32x4 o;
      { const float n1 = bflo(w.x) * g0[0], n2 = bfhi(w.x) * g0[1]; o.x = cvt_pk_bf16(n1 * ca[0] - n2 * ca[1], n1 * ca[1] + n2 * ca[0]); }
      { const float n1 = bflo(w.y) * g0[2], n2 = bfhi(w.y) * g0[3]; o.y = cvt_pk_bf16(n1 * ca[2] - n2 * ca[3], n1 * ca[3] + n2 * ca[2]); }
      { const float n1 = bflo(w.z) * g1[0], n2 = bfhi(w.z) * g1[1]; o.z = cvt_pk_bf16(n1 * cb[0] - n2 * cb[1], n1 * cb[1] + n2 * cb[0]); }
      { const float n1 = bflo(w.w) * g1[2], n2 = bfhi(w.w) * g1[3]; o.w = cvt_pk_bf16(n1 * cb[2] - n2 * cb[3], n1 * cb[3] + n2 * cb[2]); }
      qr[d0] = *reinterpret_cast<const bf16x8*>(&o);
    }
  }
  const int sr = tid >> 4, sc = (tid & 15) * 8, vst0 = v_st(sr, sc), vst1 = v_st(32 + sr, sc);
  const int vb0 = (int)(uintptr_t)V_lds + v_rd_base(lane);
  struct { bf16x8 vs0, vs1, ks0, ks1; } sr_[1];
#define SLOAD(i, k0) do { sr_[i].vs0 = *reinterpret_cast<const bf16x8*>(&Vh[(long)((k0) + sr) * LD + sc]); sr_[i].vs1 = *reinterpret_cast<const bf16x8*>(&Vh[(long)((k0) + 32 + sr) * LD + sc]); \
    sr_[i].ks0 = *reinterpret_cast<const bf16x8*>(&Kh[(long)((k0) + sr) * LD + sc]); sr_[i].ks1 = *reinterpret_cast<const bf16x8*>(&Kh[(long)((k0) + 32 + sr) * LD + sc]); } while (0)
#define SWRITE(b, i) do { *(bf16x8*)((char*)V_lds + (b) * SHM_V + vst0) = sr_[i].vs0;          \
    *(bf16x8*)((char*)V_lds + (b) * SHM_V + vst1) = sr_[i].vs1; int kc = sc * 2;               \
    *(bf16x8*)((char*)K_lds + (b) * SHM_K + KSWZ(sr, kc)) = sr_[i].ks0;                       \
    *(bf16x8*)((char*)K_lds + (b) * SHM_K + KSWZ(32 + sr, kc)) = sr_[i].ks1; } while (0)
#define SWAIT() asm volatile("s_waitcnt vmcnt(0)" ::: "memory")
#define RESC(a) do { if (__any((a) < 1.f)) { if (hi == 0) al_l[r32] = (a); asm volatile("s_waitcnt lgkmcnt(0)" ::: "memory"); \
    _Pragma("unroll") for (int d = 0; d < 4; ++d) _Pragma("unroll") for (int r = 0; r < 16; ++r) o[d][r] *= al_l[crow(r, hi)]; } } while (0)
  f32x16 pA0, pA1, pB0, pB1; float mnA, mnB, alA, alB; bf16x8 pa0, pa1, pa2, pa3; const int NT = seq / KVBLK;
  constexpr int SE = 0, SO = 0;
  SLOAD(SE, 0); asm volatile("s_waitcnt vmcnt(0)" ::: "memory"); SWRITE(0, SE); __syncthreads();
  qkt(pA0, pA1, K_lds, qr, r32, hi); partialSM(pA0, pA1, m_reg, mnA, alA);
  SLOAD(SO, KVBLK);
  SWAIT(); SWRITE(1, SO); __syncthreads();
  for (int j = 1; j + 1 < NT; j += 2) {
    SBAR(); qkt(pB0, pB1, (bf16_t*)((char*)K_lds + SHM_K), qr, r32, hi);
    finishSM(pA0, pA1, alA, l_reg, pa0, pa1, pa2, pa3); SBAR();
    SLOAD(SO, (j + 1) * KVBLK); SBAR();
    pv_d0(o, vb0, pa0, pa1, pa2, pa3); partialSM(pB0, pB1, m_reg, mnB, alB);
    __syncthreads(); SWAIT(); SWRITE(0, SE);
    RESC(alB); __syncthreads();
    SBAR(); qkt(pA0, pA1, K_lds, qr, r32, hi);
    finishSM(pB0, pB1, alB, l_reg, pa0, pa1, pa2, pa3); SBAR();
    SLOAD(SE, (j + 2) * KVBLK); SBAR();
    pv_d0(o, vb0 + (int)SHM_V, pa0, pa1, pa2, pa3); partialSM(pA0, pA1, m_reg, mnA, alA);
    __syncthreads(); SWAIT(); SWRITE(1, SO);
    RESC(alA); __syncthreads();
  }
  SBAR(); qkt(pB0, pB1, (bf16_t*)((char*)K_lds + SHM_K), qr, r32, hi);
  finishSM(pA0, pA1, alA, l_reg, pa0, pa1, pa2, pa3); SBAR();
  pv_d0(o, vb0, pa0, pa1, pa2, pa3); partialSM(pB0, pB1, m_reg, mnB, alB);
  __syncthreads(); RESC(alB);
  finishSM(pB0, pB1, alB, l_reg, pa0, pa1, pa2, pa3); SBAR();
  pv_d0(o, vb0 + (int)SHM_V, pa0, pa1, pa2, pa3);
  if (hi == 0) li_l[r32] = l_reg; asm volatile("s_waitcnt lgkmcnt(0)" ::: "memory");
  float rli[16];
#pragma unroll
  for (int r = 0; r < 16; ++r) rli[r] = __builtin_amdgcn_rcpf(li_l[crow(r, hi)]);
  bf16_t* Ow = Ob + (long)(wid * QBLK) * LDO;
#pragma unroll
  for (int r = 0; r < 16; ++r) { int orow = crow(r, hi);
#pragma unroll
    for (int d0 = 0; d0 < 4; ++d0) Ow[(long)orow * LDO + d0 * 32 + r32] = f2bf(o[d0][r] * rli[r]); }
  __syncthreads();
#undef SLOAD
#undef SWRITE
#undef SWAIT
#undef RESC
}
}

constexpr int RING_BYTES = 131072;
constexpr int LDSCTL_OFF = RING_BYTES, MISC_OFF = LDSCTL_OFF + 320, PTAB_OFF = LDSCTL_OFF + 1024;
constexpr int LDS_BYTES = 147456;

#define XB_TMO      128
#define XB_XCNT(j)  (256  + 64 * (j))
#define XB_XSUB(j)  (1280 + 64 * (j))
#define XB_XGEN(j)  (2304 + 64 * (j))
#define XB_TOP      3328
#define XB_TOPGEN   3392
#define XCD_BAR_WORDS 3456
#define XB_SPIN_CAP (1u << 22)
__device__ __forceinline__ unsigned xb_ld(unsigned* p)              { return __hip_atomic_load(p, __ATOMIC_RELAXED, __HIP_MEMORY_SCOPE_AGENT); }
__device__ __forceinline__ unsigned xb_add(unsigned* p, unsigned v) { return __hip_atomic_fetch_add(p, v, __ATOMIC_RELAXED, __HIP_MEMORY_SCOPE_AGENT); }
__device__ __forceinline__ unsigned xb_xcc_id() { return (unsigned)__builtin_amdgcn_s_getreg((3 << 11) | 20) & 0xFu; }
#define XB_SPIN(cond, bar) do { unsigned _sp = 0; while (cond) { __builtin_amdgcn_s_sleep(1); \
    if ((++_sp & 255u) == 0u) { if (xb_ld(&(bar)[XB_TMO])) break; if (_sp > XB_SPIN_CAP) { atomicAdd(&(bar)[XB_TMO], 1u); break; } } } } while (0)
struct XcdBarrier { unsigned* bar; unsigned x; volatile LAS unsigned* st; };
__device__ __forceinline__ XcdBarrier xcd_barrier_post(unsigned* bar, volatile LAS unsigned* st) {
    XcdBarrier b; b.bar = bar; b.x = xb_xcc_id(); b.st = st;
    if (threadIdx.x == 0) (void)xb_add(&bar[XB_XCNT(b.x)], 1u);
    return b;
}
__device__ __forceinline__ void xcd_barrier_complete(unsigned* bar, unsigned x, unsigned& nloc, unsigned& nx) {
    const unsigned G = gridDim.x * gridDim.y * gridDim.z;
    unsigned sum, cnt, mine, sp = 0u;
    for (;;) {
        sum = 0u; cnt = 0u;
        for (unsigned j = 0; j < 16; ++j) { const unsigned c = xb_ld(&bar[XB_XCNT(j)]); sum += c; cnt += (c > 0u) ? 1u : 0u; }
        mine = xb_ld(&bar[XB_XCNT(x)]);
        if (sum == G) break;
        __builtin_amdgcn_s_sleep(1);
        if ((++sp & 255u) == 0u) { if (xb_ld(&bar[XB_TMO])) break; if (sp > XB_SPIN_CAP) { atomicAdd(&bar[XB_TMO], 1u); break; } }
    }
    nloc = mine > 0u ? mine : 1u; nx = cnt > 0u ? cnt : 1u;
}
__device__ __forceinline__ XcdBarrier xcd_barrier_setup(unsigned* bar, volatile LAS unsigned* st) {
    XcdBarrier b = xcd_barrier_post(bar, st);
    if (threadIdx.x == 0) { unsigned nloc, nx; xcd_barrier_complete(bar, b.x, nloc, nx); st[0] = nloc; st[1] = nx; }
    __syncthreads();
    return b;
}
__device__ __forceinline__ void xcd_barrier(const XcdBarrier& b) {
    asm volatile("s_waitcnt vmcnt(0)" ::: "memory");
    __syncthreads();
    if (threadIdx.x == 0) {
        unsigned* bar = b.bar; unsigned bx = b.x;
        asm volatile("" : "+s"(bar), "+s"(bx));
        __builtin_amdgcn_s_waitcnt(0);
        const unsigned nloc = b.st[0], nx = b.st[1];
        const unsigned old = xb_add(&bar[XB_XSUB(bx)], 1u);
        const unsigned gen = old / nloc;
        if (old + 1u == (gen + 1u) * nloc) {
            __builtin_amdgcn_fence(__ATOMIC_RELEASE, "agent");
            asm volatile("s_waitcnt vmcnt(0)" ::: "memory");
            const unsigned og = xb_add(&bar[XB_TOP], 1u);
            const unsigned tg = og / nx;
            if (og + 1u == (tg + 1u) * nx) xb_add(&bar[XB_TOPGEN], 1u);
            else XB_SPIN(xb_ld(&bar[XB_TOPGEN]) == tg, bar);
            __builtin_amdgcn_fence(__ATOMIC_ACQUIRE, "agent");
            xb_add(&bar[XB_XGEN(bx)], 1u);
            asm volatile("s_waitcnt vmcnt(0)" ::: "memory");
        } else {
            XB_SPIN(xb_ld(&bar[XB_XGEN(bx)]) == gen, bar);
            __builtin_amdgcn_fence(__ATOMIC_ACQUIRE, "agent");
            asm volatile("s_waitcnt vmcnt(0)" ::: "memory");
        }
    }
    __syncthreads();
}

__device__ __forceinline__ void transpose_item(const float* W, int ldw, int K, int k0, int srccol0, bf16_t* WT, int dstrow0, LAS float* scr, int lane, const float* kgain = nullptr, int ldt = 0) {
    const int KT = ldt ? ldt : K;
    constexpr int P = 36;
    const int n4 = (lane & 7) * 4, kr = lane >> 3;
    f32x4 v[8];
    if (srccol0 >= 0) {
#pragma unroll
        for (int i = 0; i < 8; ++i) v[i] = *(const f32x4*)(W + (size_t)(k0 + 8 * i + kr) * ldw + srccol0 + n4);
        if (kgain) {
#pragma unroll
            for (int i = 0; i < 8; ++i) v[i] = v[i] * kgain[k0 + 8 * i + kr];
        }
    } else {
#pragma unroll
        for (int i = 0; i < 8; ++i) v[i] = (f32x4){0.f, 0.f, 0.f, 0.f};
    }
#pragma unroll
    for (int i = 0; i < 8; ++i) *(LAS f32x4*)(scr + (8 * i + kr) * P + n4) = v[i];
    LDS_WAIT(); asm volatile("" ::: "memory");
    const int c = lane & 7;
#pragma unroll
    for (int j = 0; j < 4; ++j) { const int n = (lane >> 3) + 8 * j; const LAS float* s = scr + (8 * c) * P + n;
        u32x4 o; o.x = cvt_pk_bf16(s[0 * P], s[1 * P]); o.y = cvt_pk_bf16(s[2 * P], s[3 * P]); o.z = cvt_pk_bf16(s[4 * P], s[5 * P]); o.w = cvt_pk_bf16(s[6 * P], s[7 * P]);
        *(u32x4*)(WT + (size_t)(dstrow0 + n) * KT + k0 + 8 * c) = o; }
    LDS_WAIT(); asm volatile("" ::: "memory");
}
struct LayerW { const float *w_in, *w_bra, *w_brb, *w_brc, *w_out, *f1i, *f1o, *f2i, *f2o, *ng; };
__device__ __forceinline__ void phase_weights(const LayerW& w, unsigned char* ws, LAS unsigned char* lds, int gw, int NGW, int wave, int lane) {
    LAS float* scr = (LAS float*)(lds + wave * 16384);
    constexpr int I_IN = (NIN_PAD / 32) * (D / 64);
    constexpr int I_FI = (2 * FF / 32) * (D / 64);
    constexpr int I_FO = (D / 32) * (FF / 64);
    constexpr int I_BA = (D / 32) * (1024 / 64);
    constexpr int I_BB = (D / 32) * (512 / 64);
    constexpr int I_WO = (D / 32) * (D / 64);
    constexpr int NITEMS = I_IN + 2 * I_FI + 2 * I_FO + I_BA + 2 * I_BB + I_WO;
    for (int it = gw; it < NITEMS; it += NGW) {
        int r = it;
        if (r < I_IN) { const int nb = r % (NIN_PAD / 32), kb = r / (NIN_PAD / 32); const int d0 = nb * 32;
            const int src = d0 < 4608 ? d0 : (d0 < 10752 ? d0 + 32 : (d0 < 10784 ? 4608 + (d0 - 10752) : -1));
            transpose_item(w.w_in, NIN, D, kb * 64, src, (bf16_t*)(ws + WS_WIN), d0, scr, lane, w.ng + 2 * D); continue; } r -= I_IN;
        if (r < 2 * I_FI) { const int which = r / I_FI; r -= which * I_FI; const int nb = r % (2 * FF / 32), kb = r / (2 * FF / 32); const int d0 = nb * 32;
            const int t = d0 >> 8, within = d0 & 255; const int src = within < 128 ? 128 * t + within : FF + 128 * t + (within - 128);
            transpose_item(which ? w.f2i : w.f1i, 2 * FF, D, kb * 64, src, (bf16_t*)(ws + (which ? WS_WF2I : WS_WF1I)), d0, scr, lane, w.ng + (which ? 4 * D : 0)); continue; } r -= 2 * I_FI;
        if (r < 2 * I_FO) { const int which = r / I_FO; r -= which * I_FO; const int nb = r % (D / 32), kb = r / (D / 32);
            transpose_item(which ? w.f2o : w.f1o, D, FF, kb * 64, nb * 32, (bf16_t*)(ws + (which ? WS_WF2O : WS_WF1O)), nb * 32, scr, lane); continue; } r -= 2 * I_FO;
        if (r < I_BA) { const int nb = r % (D / 32), kb = r / (D / 32);
            transpose_item(w.w_bra, D, 1024, kb * 64, nb * 32, (bf16_t*)(ws + WS_WBRA), nb * 32, scr, lane, nullptr, LDOM); continue; } r -= I_BA;
        if (r < 2 * I_BB) { const int which = r / I_BB; r -= which * I_BB; const int nb = r % (D / 32), kb = r / (D / 32);
            transpose_item(which ? w.w_brc : w.w_brb, D, 512, kb * 64, nb * 32, (bf16_t*)(ws + WS_WBRA) + (which ? OM_C : OM_B), nb * 32, scr, lane, nullptr, LDOM); continue; } r -= 2 * I_BB;
        { const int nb = r % (D / 32), kb = r / (D / 32);
            transpose_item(w.w_out, D, D, kb * 64, nb * 32, (bf16_t*)(ws + WS_WOUT), nb * 32, scr, lane); }
    }
}
__device__ __forceinline__ void phase_norm(bf16_t* XB, const bf16_t* Y, float* RSTD, float* OUT, const float* gpost, float coef, int gw, int NGW, int lane) {
    for (int m = gw; m < M; m += NGW) {
        const u32x2* xr = (const u32x2*)(XB + (size_t)m * D) + lane; const u32x2* yr = (const u32x2*)(Y + (size_t)m * D) + lane;
        f32x4 x[8], y[8]; float s = 0.f;
#pragma unroll
        for (int j = 0; j < 8; ++j) { const u32x2 t = yr[64 * j], q = xr[64 * j]; y[j] = (f32x4){bflo(t.x), bfhi(t.x), bflo(t.y), bfhi(t.y)}; x[j] = (f32x4){bflo(q.x), bfhi(q.x), bflo(q.y), bfhi(q.y)};
            s += (y[j].x * y[j].x + y[j].y * y[j].y) + (y[j].z * y[j].z + y[j].w * y[j].w); }
        const float rstd = coef * (1.0f / sqrtf(wave_sum(s) * (1.0f / D) + EPS));
        float s2 = 0.f;
#pragma unroll
        for (int j = 0; j < 8; ++j) { const f32x4 g = ((const f32x4*)gpost)[lane + 64 * j]; x[j] = x[j] + y[j] * g * rstd; s2 += (x[j].x * x[j].x + x[j].y * x[j].y) + (x[j].z * x[j].z + x[j].w * x[j].w); }
        if (OUT) { f32x4* xo = (f32x4*)(OUT + (size_t)m * D) + lane;
#pragma unroll
            for (int j = 0; j < 8; ++j) xo[64 * j] = x[j];
        } else {
            u32x2* o8 = (u32x2*)(XB + (size_t)m * D) + lane;
#pragma unroll
            for (int j = 0; j < 8; ++j) { u32x2 w; w.x = cvt_pk_bf16(x[j].x, x[j].y); w.y = cvt_pk_bf16(x[j].z, x[j].w); o8[64 * j] = w; }
            const float r2 = 1.0f / sqrtf(wave_sum(s2) * (1.0f / D) + EPS);
            if (lane == 0) RSTD[m] = r2;
        }
    }
}
__device__ __forceinline__ void prep_k(bf16_t* PROJ, const float* qk_gain  , const f32x2* cs  , int gw, int NGW, int lane) {
    const float gk0 = qk_gain[128 + 2 * lane], gk1 = qk_gain[128 + 2 * lane + 1];
    for (int m0 = gw; m0 < M; m0 += 4 * NGW) {
        unsigned v[4][2]; f32x2 c_s[4];
#pragma unroll
        for (int i = 0; i < 4; ++i) { const int m = m0 + i * NGW; if (m < M) { const int t = m & (SEQ - 1), pr = t >> 6, pc = t & 63;
            const unsigned* row = (const unsigned*)(PROJ + (size_t)m * NPROJ + C_AK); v[i][0] = row[lane]; v[i][1] = row[64 + lane]; c_s[i] = cs[((lane < 32) ? pr : pc) * 32 + (lane & 31)]; } }
#pragma unroll
        for (int i = 0; i < 4; ++i) { const int m = m0 + i * NGW; if (m < M) { unsigned* row = (unsigned*)(PROJ + (size_t)m * NPROJ + C_AK);
#pragma unroll
            for (int h = 0; h < 2; ++h) { const float x1 = bflo(v[i][h]), x2 = bfhi(v[i][h]);
                const float rstd = 1.0f / sqrtf(wave_sum(x1 * x1 + x2 * x2) * (1.0f / 128.0f) + EPS);
                const float n1 = x1 * rstd * gk0, n2 = x2 * rstd * gk1;
                row[h * 64 + lane] = cvt_pk_bf16(n1 * c_s[i].x - n2 * c_s[i].y, n1 * c_s[i].y + n2 * c_s[i].x); } } }
    }
}
__device__ __forceinline__ void tr_pair(unsigned base, int pitch, int row0, int col0, int lane, s16x4& lo, s16x4& hi) {
    const int g = lane >> 4, i = lane & 15;
    const unsigned addr = base + (unsigned)((row0 + 4 * g + (i >> 2)) * pitch + (col0 + 4 * (i & 3)) * 2);
    asm volatile("ds_read_b64_tr_b16 %0, %1" : "=&v"(lo) : "v"(addr) : "memory");
    asm volatile("ds_read_b64_tr_b16 %0, %1" : "=&v"(hi) : "v"(addr + (unsigned)(16 * pitch)) : "memory");
}
#define TR_JOIN(L, H) ((bf16x8){L[0], L[1], L[2], L[3], H[0], H[1], H[2], H[3]})
__device__ __forceinline__ bf16x8 pack8(const float* x) { u32x4 w; w.x = cvt_pk_bf16(x[0], x[1]); w.y = cvt_pk_bf16(x[2], x[3]); w.z = cvt_pk_bf16(x[4], x[5]); w.w = cvt_pk_bf16(x[6], x[7]); return *reinterpret_cast<bf16x8*>(&w); }
__device__ __forceinline__ void na_unit(const bf16_t* PROJ, bf16_t* OB  , LAS unsigned char* lds, int u) {
    const int tid = opaque_tid(), lane = tid & 63, w = __builtin_amdgcn_readfirstlane(tid >> 6);
    constexpr int PV = 272, O_V = 0, O_RPB = 2 * 64 * PV;
    LAS float* rpbs = (LAS float*)(lds + O_RPB);
    const unsigned lbase = (unsigned)(uintptr_t)lds;
    const int ib = w & 3, vh = w >> 2;
    {
        int lane_o = lane; asm volatile("" : "+v"(lane_o));
        const int g = lane_o >> 4, li = lane_o & 15;
        const int r = u & 31, h = (u >> 5) & 3, b = u >> 7;
        const int rs = min(max(r - 4, 0), 24);
        const int c = 16 * ib + li, cs0 = min(max(c - 8, 0), 48);
        const size_t tq = (size_t)b * SEQ + r * 64 + c;
        bf16x8 qf[4];
#pragma unroll
        for (int ks = 0; ks < 4; ++ks) qf[ks] = *(const bf16x8*)(PROJ + tq * NPROJ + C_BQ + h * 128 + 32 * ks + 8 * g);
        int jbv[4], dcv[4];
#pragma unroll
        for (int rr = 0; rr < 4; ++rr) { const int km = 4 * g + rr; jbv[rr] = (cs0 + 15 - km) >> 4; dcv[rr] = 16 * jbv[rr] + km - c + 15; }
        f32x4 o[4];
#pragma unroll
        for (int vt = 0; vt < 4; ++vt) o[vt] = (f32x4){0.f, 0.f, 0.f, 0.f};
        float m_run = -1e30f, l_run = 0.f;
        const int sr = tid >> 4, sc = (tid & 15) * 8;
        const int jlo = ib > 1 ? ib - 1 : 0, jhi = ib < 2 ? ib + 1 : 3;
        bf16x8 kf[4][4], vr0, vr1;
#define NA_LOADK(kr_) do { const size_t kt_ = (size_t)b * SEQ + (size_t)(rs + (kr_)) * 64; \
            _Pragma("unroll") for (int jb = 0; jb < 4; ++jb) if (jb >= jlo && jb <= jhi) { const bf16_t* kp = PROJ + (kt_ + 16 * jb + li) * NPROJ + C_BK + h * 128 + 8 * g; \
                _Pragma("unroll") for (int ks = 0; ks < 4; ++ks) kf[jb][ks] = *(const bf16x8*)(kp + 32 * ks); } } while (0)
#define NA_LOADV(kr_) do { const size_t kt_ = (size_t)b * SEQ + (size_t)(rs + (kr_)) * 64; \
            vr0 = *(const bf16x8*)(PROJ + (kt_ + sr) * NPROJ + C_BV + h * 128 + sc); vr1 = *(const bf16x8*)(PROJ + (kt_ + sr + 32) * NPROJ + C_BV + h * 128 + sc); } while (0)
        NA_LOADV(0); NA_LOADK(0);
        for (int kr = 0; kr < 8; ++kr) {
            *(LAS bf16x8*)(lds + O_V + (kr & 1) * 64 * PV + sr * PV + sc * 2) = vr0; *(LAS bf16x8*)(lds + O_V + (kr & 1) * 64 * PV + (sr + 32) * PV + sc * 2) = vr1;
            if (kr + 1 < 8) NA_LOADV(kr + 1);
            f32x4 s[4];
#pragma unroll
            for (int jb = 0; jb < 4; ++jb) { s[jb] = (f32x4){0.f, 0.f, 0.f, 0.f};
                if (jb >= jlo && jb <= jhi) {
#pragma unroll
                    for (int ks = 0; ks < 4; ++ks) s[jb] = __builtin_amdgcn_mfma_f32_16x16x32_bf16(kf[jb][ks], qf[ks], s[jb], 0, 0, 0); } }
            if (kr + 1 < 8) NA_LOADK(kr + 1);
            const int dr = rs + kr - r + 7;
            float mx = -1e30f;
#pragma unroll
            for (int rr = 0; rr < 4; ++rr) { const float bias = rpbs[(h * 15 + dr) * 31 + dcv[rr]];
#pragma unroll
                for (int jb = 0; jb < 4; ++jb) { const float v = (jb == jbv[rr]) ? s[jb][rr] * 0.088388347648318440f + bias : -1e30f; s[jb][rr] = v; mx = fmaxf(mx, v); } }
            mx = fmaxf(mx, __shfl_xor(mx, 16)); mx = fmaxf(mx, __shfl_xor(mx, 32));
            const float m_new = fmaxf(m_run, mx), alpha = __expf(m_run - m_new);
            m_run = m_new;
            float ps = 0.f;
#pragma unroll
            for (int jb = 0; jb < 4; ++jb)
#pragma unroll
                for (int rr = 0; rr < 4; ++rr) { const float p = (jb == jbv[rr]) ? __expf(s[jb][rr] - m_new) : 0.f; s[jb][rr] = p; ps += p; }
            l_run = l_run * alpha + ps;
            bf16x8 pfr[2];
#pragma unroll
            for (int ss = 0; ss < 2; ++ss) { const float t[8] = {s[2 * ss][0], s[2 * ss][1], s[2 * ss][2], s[2 * ss][3], s[2 * ss + 1][0], s[2 * ss + 1][1], s[2 * ss + 1][2], s[2 * ss + 1][3]}; pfr[ss] = pack8(t); }
            __syncthreads();
            s16x4 vl[4][2], vhh[4][2];
            {
                const unsigned vbase = lbase + O_V + (unsigned)((kr & 1) * 64 * PV + (4 * g + (li >> 2)) * PV + (64 * vh + 4 * (li & 3)) * 2);
                asm volatile("ds_read_b64_tr_b16 %0, %16 offset:0\n\t"
                         "ds_read_b64_tr_b16 %1, %16 offset:4352\n\t"
                         "ds_read_b64_tr_b16 %2, %16 offset:8704\n\t"
                         "ds_read_b64_tr_b16 %3, %16 offset:13056\n\t"
                         "ds_read_b64_tr_b16 %4, %16 offset:32\n\t"
                         "ds_read_b64_tr_b16 %5, %16 offset:4384\n\t"
                         "ds_read_b64_tr_b16 %6, %16 offset:8736\n\t"
                         "ds_read_b64_tr_b16 %7, %16 offset:13088\n\t"
                         "ds_read_b64_tr_b16 %8, %16 offset:64\n\t"
                         "ds_read_b64_tr_b16 %9, %16 offset:4416\n\t"
                         "ds_read_b64_tr_b16 %10, %16 offset:8768\n\t"
                         "ds_read_b64_tr_b16 %11, %16 offset:13120\n\t"
                         "ds_read_b64_tr_b16 %12, %16 offset:96\n\t"
                         "ds_read_b64_tr_b16 %13, %16 offset:4448\n\t"
                         "ds_read_b64_tr_b16 %14, %16 offset:8800\n\t"
                         "ds_read_b64_tr_b16 %15, %16 offset:13152\n\t"
                         "s_waitcnt lgkmcnt(0)"
                         : "=&v"(vl[0][0]), "=&v"(vhh[0][0]), "=&v"(vl[0][1]), "=&v"(vhh[0][1]), "=&v"(vl[1][0]), "=&v"(vhh[1][0]), "=&v"(vl[1][1]), "=&v"(vhh[1][1]), "=&v"(vl[2][0]), "=&v"(vhh[2][0]), "=&v"(vl[2][1]), "=&v"(vhh[2][1]), "=&v"(vl[3][0]), "=&v"(vhh[3][0]), "=&v"(vl[3][1]), "=&v"(vhh[3][1])
                         : "v"(vbase) : "memory");
            }
            __builtin_amdgcn_sched_barrier(0);
#pragma unroll
            for (int vt = 0; vt < 4; ++vt) { o[vt] = o[vt] * alpha;
#pragma unroll
                for (int ss = 0; ss < 2; ++ss) o[vt] = __builtin_amdgcn_mfma_f32_16x16x32_bf16(TR_JOIN(vl[vt][ss], vhh[vt][ss]), pfr[ss], o[vt], 0, 0, 0); }
        }
#undef NA_LOADK
#undef NA_LOADV
        l_run += __shfl_xor(l_run, 16); l_run += __shfl_xor(l_run, 32);
        const float inv = 1.0f / l_run;
#pragma unroll
        for (int vt = 0; vt < 4; ++vt) { u32x2 ov; ov.x = cvt_pk_bf16(o[vt].x * inv, o[vt].y * inv); ov.y = cvt_pk_bf16(o[vt].z * inv, o[vt].w * inv);
            *(u32x2*)(OB + tq * LDOM + h * 128 + 64 * vh + 16 * vt + 4 * g) = ov; }
        __syncthreads();
    }
}
__device__ __forceinline__ void na_load_bias(const float* rpb, LAS unsigned char* lds) {
    const int tid = opaque_tid(); LAS float* rpbs = (LAS float*)(lds + 2 * 64 * 272);
    __syncthreads();
    for (int i = tid; i < 4 * 15 * 31; i += 512) rpbs[i] = rpb[i];
    __syncthreads();
}
__device__ __forceinline__ float logsig16(float z) { return (fminf(z, 0.f) - __logf(1.0f + __expf(-fabsf(z)))) * (1.0f / 16.0f); }
__device__ __forceinline__ void gla_seq_unit(const bf16_t* PROJ, const float* LR, const float* w_decay  , const float* b_decay  , bf16_t* OFB, bf16_t* OC, const float* onorm,
                                             LAS unsigned char* lds, int b, int h) {
    const int tid = opaque_tid(), lane = tid & 63, w = __builtin_amdgcn_readfirstlane(tid >> 6);
    constexpr int P64 = 144, PV = 272;
    constexpr int O_Q = 0, O_K = 9216, O_KH = 18432, O_V = 27648, O_S = 45056, O_DEC = 63488, O_W2 = 63744;
    const unsigned lbase = (unsigned)(uintptr_t)lds;
    const int ib = w & 3, vh = w >> 2, g = lane >> 4, li = lane & 15;
    LAS float* w2s = (LAS float*)(lds + O_W2);
    LAS float* gns = (LAS float*)(lds + 68608);
    __syncthreads(); if (tid < 128) gns[tid] = onorm[tid];
    LAS float* red = (LAS float*)(lds + 68096);
  for (int dir = 0; dir < 2; ++dir) {
    __syncthreads();
    for (int i = tid; i < 16 * 64; i += 512) w2s[i] = w_decay[dir * 4096 + (i >> 6) * 256 + h * 64 + (i & 63)];
    if (tid < 64) w2s[1024 + tid] = b_decay[dir * 256 + h * 64 + tid];
    for (int i = tid; i < 128 * 72 / 2; i += 512) ((LAS unsigned*)(lds + O_S))[i] = 0u;
    f32x4 S[4];
#pragma unroll
    for (int vt = 0; vt < 4; ++vt) S[vt] = (f32x4){0.f, 0.f, 0.f, 0.f};
    const int dcol = 8 * w;
    const int sr = tid >> 4, sc = (tid & 15) * 8;
    f32x4 lr4[4]; u32x4 qraw, kraw; bf16x8 vst0, vst1;
    u32x2 ofr[4], ogr[4];
#define GLA_LOAD_O(cc_) do { const int c_ = 31 - (cc_); const size_t mi_ = (size_t)b * SEQ + c_ * 64 + 16 * ib + li; \
        _Pragma("unroll") for (int vt = 0; vt < 4; ++vt) { ofr[vt] = *(const u32x2*)(OFB + mi_ * 512 + h * 128 + 64 * vh + 16 * vt + 4 * g); ogr[vt] = *(const u32x2*)(PROJ + mi_ * NPROJ + C_OG + h * 128 + 64 * vh + 16 * vt + 4 * g); } } while (0)
#define GLA_LOAD(cc_) do { const int c_ = dir ? 31 - (cc_) : (cc_); const size_t m0_ = (size_t)b * SEQ + c_ * 64, m_ = m0_ + lane; \
        _Pragma("unroll") for (int j = 0; j < 4; ++j) lr4[j] = ((const f32x4*)(LR + m_ * 32 + dir * 16))[j]; \
        qraw = *(const u32x4*)(PROJ + m_ * NPROJ + C_CQ + h * 64 + dcol); kraw = *(const u32x4*)(PROJ + m_ * NPROJ + C_CK + h * 64 + dcol); \
        vst0 = *(const bf16x8*)(PROJ + (m0_ + sr) * NPROJ + C_CV + h * 128 + sc); vst1 = *(const bf16x8*)(PROJ + (m0_ + sr + 32) * NPROJ + C_CV + h * 128 + sc); } while (0)
#pragma unroll
    for (int vt = 0; vt < 4; ++vt) { ofr[vt] = (u32x2){0u, 0u}; ogr[vt] = (u32x2){0u, 0u}; }
    GLA_LOAD(0);
    if (dir) GLA_LOAD_O(0);
    __syncthreads();
    for (int cc = 0; cc < 32; ++cc) {
        const int c = dir ? 31 - cc : cc; const size_t m0 = (size_t)b * SEQ + c * 64;
        {
            f32x4 z0 = *(const LAS f32x4*)(w2s + 1024 + dcol), z1 = *(const LAS f32x4*)(w2s + 1024 + dcol + 4);
#pragma unroll
            for (int j = 0; j < 4; ++j)
#pragma unroll
                for (int rr = 0; rr < 4; ++rr) { const int r = 4 * j + rr; z0 = z0 + *(const LAS f32x4*)(w2s + r * 64 + dcol) * lr4[j][rr]; z1 = z1 + *(const LAS f32x4*)(w2s + r * 64 + dcol + 4) * lr4[j][rr]; }
            float bs[8];
#pragma unroll
            for (int e = 0; e < 4; ++e) { bs[e] = logsig16(z0[e]); bs[4 + e] = logsig16(z1[e]); }
            if (dir == 0) {
#pragma unroll
                for (int off = 1; off < 64; off <<= 1)
#pragma unroll
                    for (int e = 0; e < 8; ++e) { const float t = __shfl_up(bs[e], off); if (lane >= off) bs[e] += t; }
            } else {
#pragma unroll
                for (int off = 1; off < 64; off <<= 1)
#pragma unroll
                    for (int e = 0; e < 8; ++e) { const float t = __shfl_down(bs[e], off); if (lane + off < 64) bs[e] += t; }
            }
            const float q[8] = {bflo(qraw.x), bfhi(qraw.x), bflo(qraw.y), bfhi(qraw.y), bflo(qraw.z), bfhi(qraw.z), bflo(qraw.w), bfhi(qraw.w)};
            const float k[8] = {bflo(kraw.x), bfhi(kraw.x), bflo(kraw.y), bfhi(kraw.y), bflo(kraw.z), bfhi(kraw.z), bflo(kraw.w), bfhi(kraw.w)};
            float qt[8], kt[8], kh[8], dc[8];
#pragma unroll
            for (int e = 0; e < 8; ++e) { const float be = __shfl(bs[e], dir ? 0 : 63);
                qt[e] = q[e] * 0.125f * __expf(bs[e]); kt[e] = k[e] * __expf(-bs[e]); kh[e] = k[e] * __expf(be - bs[e]); dc[e] = __expf(be); }
            *(LAS bf16x8*)(lds + O_Q + lane * P64 + 16 * w) = pack8(qt); *(LAS bf16x8*)(lds + O_K + lane * P64 + 16 * w) = pack8(kt); *(LAS bf16x8*)(lds + O_KH + lane * P64 + 16 * w) = pack8(kh);
            if (lane == 0) { *(LAS f32x4*)(lds + O_DEC + 4 * dcol) = (f32x4){dc[0], dc[1], dc[2], dc[3]}; *(LAS f32x4*)(lds + O_DEC + 4 * dcol + 16) = (f32x4){dc[4], dc[5], dc[6], dc[7]}; }
            *(LAS bf16x8*)(lds + O_V + sr * PV + sc * 2) = vst0; *(LAS bf16x8*)(lds + O_V + (sr + 32) * PV + sc * 2) = vst1;
        }
        __syncthreads();
        if (cc + 1 < 32) GLA_LOAD(cc + 1);
        const size_t mi = m0 + 16 * ib + li; f32x4 oo[4]; float ss = 0.f;
        {
            bf16x8 qF[2];
#pragma unroll
            for (int ks = 0; ks < 2; ++ks) qF[ks] = *(const LAS bf16x8*)(lds + O_Q + (16 * ib + li) * P64 + (32 * ks + 8 * g) * 2);
            f32x4 P[4];
#pragma unroll
            for (int jb = 0; jb < 4; ++jb) {
                f32x4 a = {0.f, 0.f, 0.f, 0.f};
                const bool need = dir ? (jb >= ib) : (jb <= ib);
                if (need) {
#pragma unroll
                    for (int ks = 0; ks < 2; ++ks) a = __builtin_amdgcn_mfma_f32_16x16x32_bf16(*(const LAS bf16x8*)(lds + O_K + (16 * jb + li) * P64 + (32 * ks + 8 * g) * 2), qF[ks], a, 0, 0, 0); }
#pragma unroll
                for (int r = 0; r < 4; ++r) { const int jl = 4 * g + r;
                    const bool keep = (jb == ib) ? (dir ? (jl >= li) : (jl <= li)) : need;
                    P[jb][r] = keep ? a[r] : 0.f; }
            }
            bf16x8 pfr[2];
#pragma unroll
            for (int s = 0; s < 2; ++s) { const float t[8] = {P[2 * s][0], P[2 * s][1], P[2 * s][2], P[2 * s][3], P[2 * s + 1][0], P[2 * s + 1][1], P[2 * s + 1][2], P[2 * s + 1][3]}; pfr[s] = pack8(t); }
            s16x4 vl[4][2], vhh[4][2], kl[2], kh2[2];
            {
                const unsigned vbase = lbase + O_V + (unsigned)((4 * g + (li >> 2)) * PV + (64 * vh + 4 * (li & 3)) * 2);
                const unsigned kbase = lbase + O_KH + (unsigned)((4 * g + (li >> 2)) * P64 + (16 * ib + 4 * (li & 3)) * 2);
                asm volatile("ds_read_b64_tr_b16 %0, %20 offset:0\n\t"
                         "ds_read_b64_tr_b16 %1, %20 offset:4352\n\t"
                         "ds_read_b64_tr_b16 %2, %20 offset:8704\n\t"
                         "ds_read_b64_tr_b16 %3, %20 offset:13056\n\t"
                         "ds_read_b64_tr_b16 %4, %20 offset:32\n\t"
                         "ds_read_b64_tr_b16 %5, %20 offset:4384\n\t"
                         "ds_read_b64_tr_b16 %6, %20 offset:8736\n\t"
                         "ds_read_b64_tr_b16 %7, %20 offset:13088\n\t"
                         "ds_read_b64_tr_b16 %8, %20 offset:64\n\t"
                         "ds_read_b64_tr_b16 %9, %20 offset:4416\n\t"
                         "ds_read_b64_tr_b16 %10, %20 offset:8768\n\t"
                         "ds_read_b64_tr_b16 %11, %20 offset:13120\n\t"
                         "ds_read_b64_tr_b16 %12, %20 offset:96\n\t"
                         "ds_read_b64_tr_b16 %13, %20 offset:4448\n\t"
                         "ds_read_b64_tr_b16 %14, %20 offset:8800\n\t"
                         "ds_read_b64_tr_b16 %15, %20 offset:13152\n\t"
                         "ds_read_b64_tr_b16 %16, %21 offset:0\n\t"
                         "ds_read_b64_tr_b16 %17, %21 offset:2304\n\t"
                         "ds_read_b64_tr_b16 %18, %21 offset:4608\n\t"
                         "ds_read_b64_tr_b16 %19, %21 offset:6912\n\t"
                         "s_waitcnt lgkmcnt(0)"
                         : "=&v"(vl[0][0]), "=&v"(vhh[0][0]), "=&v"(vl[0][1]), "=&v"(vhh[0][1]), "=&v"(vl[1][0]), "=&v"(vhh[1][0]), "=&v"(vl[1][1]), "=&v"(vhh[1][1]), "=&v"(vl[2][0]), "=&v"(vhh[2][0]), "=&v"(vl[2][1]), "=&v"(vhh[2][1]), "=&v"(vl[3][0]), "=&v"(vhh[3][0]), "=&v"(vl[3][1]), "=&v"(vhh[3][1]), "=&v"(kl[0]), "=&v"(kh2[0]), "=&v"(kl[1]), "=&v"(kh2[1])
                         : "v"(vbase), "v"(kbase) : "memory");
            }
            bf16x8 sfr[4][2];
#pragma unroll
            for (int vt = 0; vt < 4; ++vt)
#pragma unroll
                for (int ks = 0; ks < 2; ++ks) sfr[vt][ks] = *(const LAS bf16x8*)(lds + O_S + (64 * vh + 16 * vt + li) * P64 + (32 * ks + 8 * g) * 2);
            const float dec = *(const LAS float*)(lds + O_DEC + 4 * (16 * ib + li));
            __builtin_amdgcn_sched_barrier(0);
#pragma unroll
            for (int vt = 0; vt < 4; ++vt) {
                const int v0 = 64 * vh + 16 * vt;
                f32x4 o = {0.f, 0.f, 0.f, 0.f};
#pragma unroll
                for (int s = 0; s < 2; ++s) o = __builtin_amdgcn_mfma_f32_16x16x32_bf16(TR_JOIN(vl[vt][s], vhh[vt][s]), pfr[s], o, 0, 0, 0);
#pragma unroll
                for (int ks = 0; ks < 2; ++ks) o = __builtin_amdgcn_mfma_f32_16x16x32_bf16(sfr[vt][ks], qF[ks], o, 0, 0, 0);
                if (dir == 0) { u32x2 ov; ov.x = (unsigned)f2bf(o.x) | ((unsigned)f2bf(o.y) << 16); ov.y = (unsigned)f2bf(o.z) | ((unsigned)f2bf(o.w) << 16);
                    *(u32x2*)(OFB + mi * 512 + h * 128 + v0 + 4 * g) = ov; }
                else { const u32x2 f = ofr[vt];
                    o.x += bflo(f.x); o.y += bfhi(f.x); o.z += bflo(f.y); o.w += bfhi(f.y); oo[vt] = o; ss += (o.x * o.x + o.y * o.y) + (o.z * o.z + o.w * o.w); }
                f32x4 sn = S[vt] * dec;
#pragma unroll
                for (int s = 0; s < 2; ++s) sn = __builtin_amdgcn_mfma_f32_16x16x32_bf16(TR_JOIN(vl[vt][s], vhh[vt][s]), TR_JOIN(kl[s], kh2[s]), sn, 0, 0, 0);
                S[vt] = sn;
            }
        }
        if (dir) { ss += __shfl_xor(ss, 16); ss += __shfl_xor(ss, 32); if (g == 0) red[vh * 64 + 16 * ib + li] = ss; }
        __syncthreads();
        if (dir) {
            const float rstd = 1.0f / sqrtf((red[16 * ib + li] + red[64 + 16 * ib + li]) * (1.0f / 128.0f) + EPS);
#pragma unroll
            for (int vt = 0; vt < 4; ++vt) { const int v0 = 64 * vh + 16 * vt;
                const u32x2 og = ogr[vt]; const f32x4 gn = *(const LAS f32x4*)(gns + v0 + 4 * g);
                u32x2 ov; ov.x = cvt_pk_bf16(oo[vt].x * rstd * gn.x * pg8::silu_f(bflo(og.x)), oo[vt].y * rstd * gn.y * pg8::silu_f(bfhi(og.x)));
                ov.y = cvt_pk_bf16(oo[vt].z * rstd * gn.z * pg8::silu_f(bflo(og.y)), oo[vt].w * rstd * gn.w * pg8::silu_f(bfhi(og.y)));
                *(u32x2*)(OC + mi * LDOM + h * 128 + v0 + 4 * g) = ov; }
            if (cc + 1 < 32) GLA_LOAD_O(cc + 1);
        }
#pragma unroll
        for (int vt = 0; vt < 4; ++vt)
#pragma unroll
            for (int r = 0; r < 4; ++r) *(LAS bf16_t*)(lds + O_S + (64 * vh + 16 * vt + 4 * g + r) * P64 + (16 * ib + li) * 2) = f2bf(S[vt][r]);
    }
    __syncthreads();
  }
#undef GLA_LOAD
#undef GLA_LOAD_O
}
constexpr int NPH = 15;
enum { P_F1A = 0, P_F1B, P_N1, P_M1, P_PREP, P_ATT, P_NA, P_GLA, P_GLC, P_M4, P_M5, P_N2, P_F2A, P_F2B, P_N3 };
constexpr int NGP = 1 + DEPTH * NPH;
struct Args { const float* in[18]; float* out; unsigned char* ws; int gp_lo, gp_hi; };

typedef decltype(__builtin_amdgcn_kernarg_segment_ptr()) kargp_t;
__device__ __forceinline__ unsigned long long karg_q(int byte_off) { kargp_t p_ = __builtin_amdgcn_kernarg_segment_ptr(); asm volatile("" : "+s"(p_));
    return *(const unsigned long long __attribute__((address_space(4)))*)((const char __attribute__((address_space(4)))*)p_ + byte_off); }
__global__ void __launch_bounds__(512, 2) __attribute__((target("no-packed-fp32-ops"))) fwd(Args args) {
    extern __shared__ __attribute__((aligned(16))) unsigned char lds_raw[];
    LAS unsigned char* const lds0 = (LAS unsigned char*)lds_raw;
    const int G0 = gridDim.x, wg0 = blockIdx.x;
#define PENV LAS unsigned char* lds = lds0; int G = G0, wg = wg0; asm volatile("" : "+s"(lds), "+s"(G), "+s"(wg)); const int NGW = G * 8; (void)NGW; (void)lds; (void)wg
    volatile LAS unsigned* MISC = (volatile LAS unsigned*)(lds0 + MISC_OFF);
    volatile LAS unsigned long long* PT = (volatile LAS unsigned long long*)(lds0 + PTAB_OFF);
    { const int t0 = threadIdx.x;
      for (int u = t0; u < (LDS_BYTES - LDSCTL_OFF) / 4; u += 512) ((LAS unsigned*)(lds0 + LDSCTL_OFF))[u] = 0u;
      __syncthreads();
      __syncthreads(); }
#if ONE_LAUNCH
    constexpr int lo = 0, hi = NGP;
#else
    const int lo = args.gp_lo, hi = args.gp_hi;
#endif
    XcdBarrier bar; bar.bar = (unsigned*)(args.ws + WS_CTL) + CW_BAR; bar.x = 0; bar.st = nullptr;
    if (hi - lo > 1) bar = xcd_barrier_setup((unsigned*)(args.ws + WS_CTL) + CW_BAR, MISC + 8);
#define SEAM(gp) do { if ((gp) + 1 < hi) xcd_barrier(bar); } while (0)
#define INP(i) ((const float*)(const GAS float*)karg_q(8 * (i)))
#define WSP() ((unsigned char*)(GAS unsigned char*)karg_q(8 * 19))
#define XP() ((float*)(GAS float*)karg_q(8 * 18))
#define TIDS() PENV; const int tid = opaque_tid(), lane = tid & 63, wave = __builtin_amdgcn_readfirstlane(tid >> 6), gw = wg * 8 + wave; (void)tid; (void)lane; (void)wave; (void)gw

    if (((PHASE_MASK >> 31) & 1u) && lo <= 0 && 0 < hi) {
        TIDS(); unsigned char* ws = WSP(); bf16_t* XB = (bf16_t*)(ws + WS_XN); float* RSTD = (float*)(ws + WS_RSTD);
        LayerW w; w.w_in = INP(3); w.w_bra = INP(10); w.w_brb = INP(11); w.w_brc = INP(12); w.w_out = INP(13); w.f1i = INP(14); w.f1o = INP(15); w.f2i = INP(16); w.f2o = INP(17); w.ng = INP(2);
        if (wg == 0) { f32x2* cs = (f32x2*)(ws + WS_CTL + ROPE_OFF);
            for (int i = tid; i < 2048; i += 512) { const int pos = i >> 5, mi = i & 31; const float inv = powf(10000.0f, -(float)mi / 32.0f); float s, c; sincosf((float)pos * inv, &s, &c); cs[i] = (f32x2){c, s}; } }
        phase_weights(w, ws, lds, gw, NGW, wave, lane);
        const float* xp = INP(0); const float* xs = INP(1);
        for (int m = gw; m < M; m += NGW) {
            const float* src = m < 16 * SEQ ? xp + (size_t)m * D : xs + (size_t)(m - 16 * SEQ) * D;
            const f32x4* xr = (const f32x4*)src + lane; f32x4 x[8]; float s = 0.f;
#pragma unroll
            for (int j = 0; j < 8; ++j) { x[j] = xr[64 * j]; s += (x[j].x * x[j].x + x[j].y * x[j].y) + (x[j].z * x[j].z + x[j].w * x[j].w); }
            u32x2* o8 = (u32x2*)(XB + (size_t)m * D) + lane;
#pragma unroll
            for (int j = 0; j < 8; ++j) { u32x2 wv; wv.x = cvt_pk_bf16(x[j].x, x[j].y); wv.y = cvt_pk_bf16(x[j].z, x[j].w); o8[64 * j] = wv; }
            const float rstd = 1.0f / sqrtf(wave_sum(s) * (1.0f / D) + EPS);
            if (lane == 0) RSTD[m] = rstd;
        }
        SEAM(0);
    }
    for (int l = 0; l < DEPTH; ++l) {
        const int gp0 = 1 + l * NPH;
        if (gp0 + NPH <= lo || gp0 >= hi) continue;
#define IN(p) (((PHASE_MASK >> (p)) & 1u) && lo <= gp0 + (p) && gp0 + (p) < hi)
#define FFN_PAIR(ff, pa, pb) do { \
        if (IN(pa)) { PENV; unsigned char* ws = WSP(); pg8::Gemm g{(const bf16_t*)(ws + WS_XN), (const bf16_t*)(ws + ((ff) ? WS_WF2I : WS_WF1I)), M, 2 * FF, D, D}; pg8::StaticOrder S; S.init(M, 2 * FF, G, wg, WGM_FI); \
            pg8::EpiSwiGLU E{(bf16_t*)(ws + WS_H), (const float*)(ws + WS_RSTD)}; pg8::gemm_phase<pg8::EpiSwiGLU, pg8::StaticOrder, true, true>(lds, g, S, E); if ((DUP_MASK >> (pa)) & 1u) pg8::gemm_phase<pg8::EpiSwiGLU, pg8::StaticOrder, true, true>(lds, g, S, E); SEAM(gp0 + (pa)); } \
        if (IN(pb)) { PENV; unsigned char* ws = WSP(); pg8::Gemm g{(const bf16_t*)(ws + WS_H), (const bf16_t*)(ws + ((ff) ? WS_WF2O : WS_WF1O)), M, D, FF, FF}; pg8::StaticOrder S; S.init(M, D, G, wg, WGM_FO); \
            pg8::EpiBf16Plain E{(bf16_t*)(ws + WS_Y), D}; pg8::gemm_phase<pg8::EpiBf16Plain, pg8::StaticOrder, true, true>(lds, g, S, E); if ((DUP_MASK >> (pb)) & 1u) pg8::gemm_phase<pg8::EpiBf16Plain, pg8::StaticOrder, true, true>(lds, g, S, E); SEAM(gp0 + (pb)); } } while (0)
#define NORM_PHASE(p, ipost, coef, last) do { if (IN(p)) { TIDS(); unsigned char* ws = WSP(); const float* ng = INP(2) + (size_t)l * 6 * D; \
            phase_norm((bf16_t*)(ws + WS_XN), (const bf16_t*)(ws + WS_Y), (float*)(ws + WS_RSTD), (last) ? XP() : nullptr, ng + (ipost) * D, (coef), gw, NGW, lane);

        FFN_PAIR(0, P_F1A, P_F1B);
        NORM_PHASE(P_N1, 1, 0.5f, false) SEAM(gp0 + P_N1); } } while (0);
        if (IN(P_M1)) { PENV;
            unsigned char* ws = WSP();
            pg8::Gemm g{(const bf16_t*)(ws + WS_XN), (const bf16_t*)(ws + WS_WIN), M, NIN_PAD, D, D}; pg8::StaticOrder S; S.init(M, NIN_PAD, G, wg, WGM_M1);
            pg8::EpiProj E{(bf16_t*)(ws + WS_PROJ), (u32x4*)(ws + WS_GATES), (float*)(ws + WS_LR), INP(4) + (size_t)l * 3 * D, (const float*)(ws + WS_RSTD)};
            pg8::gemm_phase<pg8::EpiProj, pg8::StaticOrder, true, true>(lds, g, S, E);
            if ((DUP_MASK >> P_M1) & 1u) pg8::gemm_phase<pg8::EpiProj, pg8::StaticOrder, true, true>(lds, g, S, E);
            SEAM(gp0 + P_M1);
        }
        if (IN(P_ATT)) { PENV;
            unsigned char* ws = WSP(); bf16_t* PROJ = (bf16_t*)(ws + WS_PROJ);
            {
                const int tid_k = opaque_tid(), lane_k = tid_k & 63, gw_k = wg * 8 + __builtin_amdgcn_readfirstlane(tid_k >> 6);
                prep_k(PROJ, INP(5) + (size_t)l * 256, (const f32x2*)(ws + WS_CTL + ROPE_OFF), gw_k, G * 8, lane_k);
                asm volatile("s_waitcnt vmcnt(0)" ::: "memory"); __syncthreads();
                if (threadIdx.x == 0) { __builtin_amdgcn_fence(__ATOMIC_RELEASE, "agent"); asm volatile("s_waitcnt vmcnt(0)" ::: "memory");
                    __hip_atomic_fetch_add((unsigned*)(ws + WS_CTL) + CW_KRDY + 64 * l, 1u, __ATOMIC_RELAXED, __HIP_MEMORY_SCOPE_AGENT); }
            }
            bool k_ready = false;
            const int ngrp = (G % 8 == 0) ? 8 : 1, xg = wg % ngrp, slot = wg / ngrp, per = G / ngrp;
            for (int gu = slot; gu < 96 / ngrp; gu += per) { const int U = xg * (96 / ngrp) + gu;
                gla_seq_unit(PROJ, (const float*)(ws + WS_LR), INP(7) + (size_t)l * 2 * 16 * 256, INP(8) + (size_t)l * 512, (bf16_t*)(ws + WS_OFB), (bf16_t*)(ws + WS_OA) + OM_C, INP(9) + (size_t)l * 128, lds, U >> 2, U & 3); }
            na_load_bias(INP(6) + (size_t)l * 4 * 15 * 31, lds);
            unsigned* head = (unsigned*)(ws + WS_CTL) + CW_Q + (l * 8 + xg) * 64;
            const int n_att = 1536 / ngrp, n_na = 3072 / ngrp;
            LAS unsigned* qslot = (LAS unsigned*)(lds + MISC_OFF + 64);
            for (;;) {
                __syncthreads();
                if (threadIdx.x == 0) *qslot = __hip_atomic_fetch_add(head, 1u, __ATOMIC_RELAXED, __HIP_MEMORY_SCOPE_AGENT);
                __syncthreads();
                const int idx = __builtin_amdgcn_readfirstlane((int)*(volatile LAS unsigned*)qslot);
                if (idx >= n_att * (1 + ATT_DUP) + n_na) break;
                if (idx < n_att * (1 + ATT_DUP)) { const int idx0 = idx; const int idx = idx0 % n_att;
                    const int rnd = idx >> 5, mem = idx & 31, grp = (ngrp == 8) ? rnd * 8 + xg : rnd;
                    const int b = grp >> 1, kvh = grp & 1, h = kvh * 4 + (mem >> 3), qb = mem & 7;
                    const size_t rowq = (size_t)b * SEQ + qb * 256, rowk = (size_t)b * SEQ;
                    bf16_t* Qp = PROJ + rowq * NPROJ + C_AQ + h * 128;
                    if (!k_ready) {
                        if (threadIdx.x == 0) { unsigned* kc = (unsigned*)(ws + WS_CTL) + CW_KRDY + 64 * l; unsigned sp = 0u;
                            while (__hip_atomic_load(kc, __ATOMIC_RELAXED, __HIP_MEMORY_SCOPE_AGENT) < (unsigned)G && ++sp < XB_SPIN_CAP) __builtin_amdgcn_s_sleep(1);
                            __builtin_amdgcn_fence(__ATOMIC_ACQUIRE, "agent"); asm volatile("s_waitcnt vmcnt(0)" ::: "memory"); }
                        __syncthreads(); k_ready = true; }
                    att::attn_dense_body(Qp, PROJ + rowk * NPROJ + C_AK + kvh * 128, PROJ + rowk * NPROJ + C_AV + kvh * 128, (bf16_t*)(ws + WS_OA) + rowq * LDOM + h * 128, SEQ, (char*)lds_raw + 49152, INP(5) + (size_t)l * 256, (const f32x2*)(ws + WS_CTL + ROPE_OFF), qb * 256);
                } else {
                    na_unit(PROJ, (bf16_t*)(ws + WS_OA) + OM_B, lds, xg * n_na + (idx - n_att * (1 + ATT_DUP)));
                }
            }
            SEAM(gp0 + P_GLA);
        }
        if (IN(P_M4)) { PENV;
            unsigned char* ws = WSP();
            pg8::Gemm g{(const bf16_t*)(ws + WS_OA), (const bf16_t*)(ws + WS_WBRA), M, D, LDOM, LDOM}; pg8::StaticOrder S; S.init(M, D, G, wg, WGM_M45);
            pg8::EpiMerge3 E{(const u32x4*)(ws + WS_GATES), (bf16_t*)(ws + WS_MG)};
            pg8::gemm_phase<pg8::EpiMerge3, pg8::StaticOrder, true, true>(lds, g, S, E);
            if ((DUP_MASK >> P_M4) & 1u) pg8::gemm_phase<pg8::EpiMerge3, pg8::StaticOrder, true, true>(lds, g, S, E);
            SEAM(gp0 + P_M4);
        }
        if (IN(P_M5)) { PENV;
            unsigned char* ws = WSP();
            pg8::Gemm g{(const bf16_t*)(ws + WS_MG), (const bf16_t*)(ws + WS_WOUT), M, D, D, D}; pg8::StaticOrder S; S.init(M, D, G, wg, WGM_M45);
            pg8::EpiBf16Plain E{(bf16_t*)(ws + WS_Y), D};
            pg8::gemm_phase<pg8::EpiBf16Plain, pg8::StaticOrder, true, true>(lds, g, S, E);
            if ((DUP_MASK >> P_M5) & 1u) pg8::gemm_phase<pg8::EpiBf16Plain, pg8::StaticOrder, true, true>(lds, g, S, E);
            SEAM(gp0 + P_M5);
        }
        NORM_PHASE(P_N2, 3, 1.0f, false) SEAM(gp0 + P_N2); } } while (0);
        FFN_PAIR(1, P_F2A, P_F2B);
        NORM_PHASE(P_N3, 5, 0.5f, (l + 1 == DEPTH))
            if (l + 1 < DEPTH) { LayerW w; w.w_in = INP(3) + (size_t)(l + 1) * D * NIN; w.w_bra = INP(10) + (size_t)(l + 1) * 1024 * D; w.w_brb = INP(11) + (size_t)(l + 1) * 512 * D; w.w_brc = INP(12) + (size_t)(l + 1) * 512 * D;
                w.w_out = INP(13) + (size_t)(l + 1) * D * D; w.f1i = INP(14) + (size_t)(l + 1) * D * 2 * FF; w.f1o = INP(15) + (size_t)(l + 1) * FF * D; w.f2i = INP(16) + (size_t)(l + 1) * D * 2 * FF; w.f2o = INP(17) + (size_t)(l + 1) * FF * D; w.ng = INP(2) + (size_t)(l + 1) * 6 * D;
                phase_weights(w, ws, lds, gw, NGW, wave, lane); if ((DUP_MASK >> 20) & 1u) phase_weights(w, ws, lds, gw, NGW, wave, lane); }
            SEAM(gp0 + P_N3); } } while (0);
#undef FFN_PAIR
#undef NORM_PHASE
#undef IN
    }
#undef SEAM
}

extern "C" void kernel_launch(void* const* d_in, const int* in_sizes, int n_in, void* d_out, int out_size, void* d_ws, size_t ws_size, hipStream_t stream) {
    static int grid = 0;
    if (grid == 0) {
        if (n_in != 18 || out_size != M * D || ws_size < WS_END) { fprintf(stderr, "kernel_launch: unexpected shapes: n_in %d out %d ws %zu (need %zu)\n", n_in, out_size, ws_size, (size_t)WS_END); grid = -1; return; }
        int dev = 0, cus = 0, per_cu = 0;
        if (hipGetDevice(&dev) != hipSuccess || hipDeviceGetAttribute(&cus, hipDeviceAttributeMultiprocessorCount, dev) != hipSuccess) { grid = -1; return; }
        if (hipFuncSetAttribute((const void*)fwd, hipFuncAttributeMaxDynamicSharedMemorySize, LDS_BYTES) != hipSuccess) { fprintf(stderr, "kernel_launch: hipFuncSetAttribute failed\n"); grid = -1; return; }
        if (hipOccupancyMaxActiveBlocksPerMultiprocessor(&per_cu, (const void*)fwd, 512, LDS_BYTES) != hipSuccess || per_cu < 1) fprintf(stderr, "kernel_launch: occupancy query says %d\n", per_cu);
        (void)hipGetLastError();
        grid = cus;
    }
    if (grid < 0) return;
    (void)hipMemsetAsync((char*)d_ws + WS_CTL, 0, CTL_BYTES, stream);
    Args a{};
    for (int i = 0; i < 18; ++i) a.in[i] = (const float*)d_in[i];
    a.out = (float*)d_out; a.ws = (unsigned char*)d_ws;
#if ONE_LAUNCH
    a.gp_lo = 0; a.gp_hi = NGP;
    hipLaunchKernelGGL(fwd, dim3(grid), dim3(512), LDS_BYTES, stream, a);
#else
    for (int gp = 0; gp < NGP; ++gp) { a.gp_lo = gp; a.gp_hi = gp + 1; hipLaunchKernelGGL(fwd, dim3(grid), dim3(512), LDS_BYTES, stream, a); }
#endif
    const hipError_t le = hipPeekAtLastError();
    if (le != hipSuccess) fprintf(stderr, "kernel_launch: launch failed: %s\n", hipGetErrorName(le));
}
```

```cpp
#include <hip/hip_runtime.h>
#include <cstdio>
#include <cstdint>
__device__ __forceinline__ void wg_sync() { __builtin_amdgcn_fence(__ATOMIC_RELEASE, "workgroup"); __builtin_amdgcn_s_barrier(); __builtin_amdgcn_fence(__ATOMIC_ACQUIRE, "workgroup"); }
#define __syncthreads() wg_sync()

#ifndef ONE_LAUNCH
#define ONE_LAUNCH 1
#endif
#ifndef WGM_FI
#define WGM_FI 4
#endif
#ifndef WGM_FO
#define WGM_FO 2
#endif
#ifndef WGM_M1
#define WGM_M1 4
#endif
#ifndef WGM_M45
#define WGM_M45 4
#endif
#ifndef ATT_DUP
#define ATT_DUP 0
#endif
#ifndef DUP_MASK
#define DUP_MASK 0u
#endif
#ifndef PHASE_MASK
#define PHASE_MASK 0xFFFFFFFFu
#endif

#define GAS __attribute__((address_space(1)))
#define LAS __attribute__((address_space(3)))
typedef unsigned short bf16_t;
typedef short bf16x8 __attribute__((ext_vector_type(8)));
typedef short s16x4 __attribute__((ext_vector_type(4)));
typedef float f32x4 __attribute__((ext_vector_type(4)));
typedef float f32x2 __attribute__((ext_vector_type(2)));
typedef float f32x16 __attribute__((ext_vector_type(16)));
typedef unsigned u32x4 __attribute__((ext_vector_type(4)));
typedef unsigned u32x2 __attribute__((ext_vector_type(2)));

constexpr int M = 49152;
constexpr int SEQ = 2048, NSEQ = 24;
constexpr int D = 2048, FF = 5632, DEPTH = 4;
constexpr int NPROJ = 4608;
constexpr int NGATE = 6144;
constexpr int NIN = 10784, NIN_PAD = 11008;
constexpr int C_AQ = 0, C_AK = 1024, C_AV = 1280, C_BQ = 1536, C_BK = 2048, C_BV = 2560, C_CQ = 3072, C_CK = 3328, C_CV = 3584, C_OG = 4096;
constexpr int C_OC = 3072;
constexpr float EPS = 1e-6f;

constexpr size_t MiB = 1u << 20;
constexpr size_t WS_CTL = 0, CTL_BYTES = 1 * MiB;
constexpr size_t WS_WIN = 2 * MiB;
constexpr size_t WS_WF1I = 45 * MiB;
constexpr size_t WS_WF1O = 89 * MiB;
constexpr size_t WS_WF2I = 111 * MiB;
constexpr size_t WS_WF2O = 155 * MiB;
constexpr size_t WS_WBRA = 177 * MiB;
constexpr size_t WS_WBRB = 181 * MiB;
constexpr size_t WS_WBRC = 183 * MiB;
constexpr size_t WS_WOUT = 185 * MiB;
constexpr size_t WS_XN = 193 * MiB;
constexpr size_t WS_BIG = 385 * MiB;
constexpr size_t WS_PROJ = WS_BIG;
constexpr size_t WS_GATES = WS_BIG + 432 * MiB;
constexpr size_t WS_LR = WS_BIG + 1008 * MiB;
constexpr size_t WS_H = WS_BIG;
constexpr size_t WS_Y = WS_BIG + 528 * MiB;
constexpr size_t WS_OFB = WS_BIG + 1014 * MiB;
constexpr size_t WS_MG = WS_OFB + 48 * MiB;
constexpr size_t WS_RSTD = WS_MG + 192 * MiB;
constexpr size_t WS_OA = WS_RSTD + 1 * MiB;
constexpr int LDOM = 2048, OM_B = 1024, OM_C = 1536;
constexpr size_t WS_END = WS_OA + 192 * MiB;
constexpr int CW_Q = 32768;
static_assert(WS_Y + (size_t)M * D * 4 <= WS_LR, "Y inside GATES region");
constexpr int CW_BAR = 4096;
constexpr int CW_KRDY = 49152;
constexpr size_t ROPE_OFF = 524288;

__device__ __forceinline__ unsigned cvt_pk_bf16(float lo, float hi) { unsigned r; asm volatile("v_cvt_pk_bf16_f32 %0, %1, %2" : "=v"(r) : "v"(lo), "v"(hi)); return r; }
__device__ __forceinline__ float bflo(unsigned w) { return __uint_as_float(w << 16); }
__device__ __forceinline__ float bfhi(unsigned w) { return __uint_as_float(w & 0xffff0000u); }
__device__ __forceinline__ float bf2f(bf16_t v) { return __uint_as_float(((unsigned)v) << 16); }
__device__ __forceinline__ bf16_t f2bf(float f) { unsigned u = __float_as_uint(f); return (bf16_t)((u + 0x7fffu + ((u >> 16) & 1u)) >> 16); }
__device__ __forceinline__ float wave_sum(float v) {
#pragma unroll
    for (int o = 1; o < 64; o <<= 1) v += __shfl_xor(v, o);
    return v;
}
__device__ __forceinline__ float wave_max(float v) {
#pragma unroll
    for (int o = 1; o < 64; o <<= 1) v = fmaxf(v, __shfl_xor(v, o));
    return v;
}
__device__ __forceinline__ int opaque_tid() { int t = threadIdx.x; asm volatile("" : "+v"(t)); return t; }
__device__ __forceinline__ unsigned char* opq(unsigned char* p) { asm volatile("" : "+s"(p)); return p; }
__device__ __forceinline__ const float* lds_ptr(volatile LAS unsigned long long* tab, int i) { const unsigned long long v = tab[i];
    const unsigned lo = __builtin_amdgcn_readfirstlane((unsigned)v), hi = __builtin_amdgcn_readfirstlane((unsigned)(v >> 32)); return (const float*)(((unsigned long long)hi << 32) | lo); }
#define LDS_WAIT() asm volatile("s_waitcnt lgkmcnt(0)" ::: "memory")
#define VM_WAIT() asm volatile("s_waitcnt vmcnt(0)" ::: "memory")

namespace pg8 {
constexpr int BM = 256, BK = 64, HALF = 128, HTB = HALF * BK * 2, STAGE_BYTES = 8 * HTB, NXCD = 8;
__host__ __device__ __forceinline__ int lds_byte(int r, int c) { const int st = (r >> 4) * 2 + (c >> 5), rr = r & 15, cc = c & 31, ob = rr * 64 + cc * 2; return st * 1024 + (ob ^ (((ob >> 9) & 1) << 5)); }
__host__ __device__ __forceinline__ void stage_rc(int b, int& R, int& C) { const int st = b / 1024, sb = b % 1024, swz = sb ^ (((sb >> 9) & 1) << 5); R = (st >> 1) * 16 + swz / 64; C = (st & 1) * 32 + (swz % 64) / 2; }
__host__ __device__ __forceinline__ int perm32(int rho) { const int n = rho >> 4, i = rho & 15; return 8 * (i >> 2) + 4 * n + (i & 3); }

struct Unit { int pm, pn; };
struct Gemm { const bf16_t* A; const bf16_t* Bt; int M, N, K, lda; };

struct StaticOrder {
    int nM, nN, nwg, G, c, WGM;
    __host__ __device__ __forceinline__ void init(int M_, int N_, int G_, int c_, int wgm_ = 4) { nM = M_ / BM; nN = N_ / BM; nwg = nM * nN; G = G_; c = c_; WGM = wgm_; }
    __host__ __device__ bool next(int i, Unit& u) const {
        const long L = (long)i * G + c; if (L >= nwg) return false;
        int wgid = (int)L; { const int q = nwg / NXCD, r = nwg % NXCD, xcd = wgid % NXCD, off = wgid / NXCD; wgid = (xcd < r ? xcd * (q + 1) : r * (q + 1) + (xcd - r) * q) + off; }
        const int nig = WGM * nN, gid = wgid / nig, fm = gid * WGM, gsz = (nM - fm) < WGM ? (nM - fm) : WGM;
        u.pm = fm + ((wgid % nig) % gsz); u.pn = (wgid % nig) / gsz; return true;
    }
    __device__ __forceinline__ void a_ready(const Unit&) const {}
    __device__ __forceinline__ void done(const Unit&) const {}
};

struct EpiF32 {
    static constexpr bool PERM = false, AFTER_DRAIN = false, HAS_MID = false, USES_RSTD = false;
    float* C; int ldc;
    __device__ __forceinline__ void operator()(const f32x4 (&acc)[2][2][4][2], const Unit& u, int wr, int wc, int fr, int fq, const LAS float* rsl) const {
        const int row0 = u.pm * BM + wr * 64 + fr, col0 = u.pn * BM + wc * 32 + 4 * fq;
#pragma unroll
        for (int ai = 0; ai < 2; ++ai)
#pragma unroll
            for (int m = 0; m < 4; ++m) { float* rowp = C + (size_t)(row0 + ai * HALF + m * 16) * ldc + col0;
#pragma unroll
                for (int bj = 0; bj < 2; ++bj)
#pragma unroll
                    for (int n = 0; n < 2; ++n) *(f32x4*)(rowp + bj * HALF + n * 16) = acc[ai][bj][m][n]; }
    }
};
struct EpiBf16Plain {
    static constexpr bool PERM = true, AFTER_DRAIN = false, HAS_MID = false, USES_RSTD = false;
    bf16_t* C; int ldc;
    __device__ __forceinline__ void operator()(const f32x4 (&acc)[2][2][4][2], const Unit& u, int wr, int wc, int fr, int fq, const LAS float* rsl) const {
        const int row0 = u.pm * BM + wr * 64 + fr, col0 = u.pn * BM + wc * 32 + 8 * fq;
#pragma unroll
        for (int ai = 0; ai < 2; ++ai)
#pragma unroll
            for (int m = 0; m < 4; ++m) { bf16_t* p = C + (size_t)(row0 + ai * HALF + m * 16) * ldc + col0;
#pragma unroll
                for (int bj = 0; bj < 2; ++bj) { const f32x4 v0 = acc[ai][bj][m][0], v1 = acc[ai][bj][m][1];
                    u32x4 w; w.x = cvt_pk_bf16(v0[0], v0[1]); w.y = cvt_pk_bf16(v0[2], v0[3]); w.z = cvt_pk_bf16(v1[0], v1[1]); w.w = cvt_pk_bf16(v1[2], v1[3]);
                    *(u32x4*)(p + bj * HALF) = w; } }
    }
};
__device__ __forceinline__ float silu_f(float g) { return g * __builtin_amdgcn_rcpf(1.0f + __builtin_amdgcn_exp2f(-1.4426950408889634f * g)); }
__device__ __forceinline__ float sigmoid_f(float g) { return __builtin_amdgcn_rcpf(1.0f + __builtin_amdgcn_exp2f(-1.4426950408889634f * g)); }
__device__ __forceinline__ float swiglu1(float a, float b, float nrs, float irs2) { const float e = __builtin_amdgcn_exp2f(a * nrs); return (a * b) * __builtin_amdgcn_rcpf(__builtin_fmaf(e, irs2, irs2)); }
struct EpiSwiGLU {
    static constexpr bool PERM = true, AFTER_DRAIN = false, HAS_MID = false, USES_RSTD = true;
    bf16_t* H; const float* rstd;
    __device__ __forceinline__ void operator()(const f32x4 (&acc)[2][2][4][2], const Unit& u, int wr, int wc, int fr, int fq, const LAS float* rsl) const {
        const int row0 = u.pm * BM + wr * 64 + fr, col0 = u.pn * HALF + wc * 32 + 8 * fq;
#pragma unroll
        for (int ai = 0; ai < 2; ++ai)
#pragma unroll
            for (int m = 0; m < 4; ++m) { bf16_t* p = H + (size_t)(row0 + ai * HALF + m * 16) * FF + col0; const float rs = rsl[wr * 64 + fr + ai * HALF + m * 16];
                const float nrs = -1.4426950408889634f * rs, irs2 = __builtin_amdgcn_rcpf(rs * rs);
                const f32x4 a0 = acc[ai][0][m][0], a1 = acc[ai][0][m][1], b0 = acc[ai][1][m][0], b1 = acc[ai][1][m][1];
                float e[8], pr[8];
#pragma unroll
                for (int i = 0; i < 4; ++i) { e[i] = a0[i] * nrs; e[4 + i] = a1[i] * nrs; }
#pragma unroll
                for (int i = 0; i < 8; ++i) e[i] = __builtin_amdgcn_exp2f(e[i]);
#pragma unroll
                for (int i = 0; i < 4; ++i) { pr[i] = a0[i] * b0[i]; pr[4 + i] = a1[i] * b1[i]; }
#pragma unroll
                for (int i = 0; i < 8; ++i) e[i] = __builtin_fmaf(e[i], irs2, irs2);
#pragma unroll
                for (int i = 0; i < 8; ++i) e[i] = __builtin_amdgcn_rcpf(e[i]);
#pragma unroll
                for (int i = 0; i < 8; ++i) pr[i] *= e[i];
                u32x4 w; w.x = cvt_pk_bf16(pr[0], pr[1]); w.y = cvt_pk_bf16(pr[2], pr[3]); w.z = cvt_pk_bf16(pr[4], pr[5]); w.w = cvt_pk_bf16(pr[6], pr[7]);
                *(u32x4*)p = w; }
    }
};
__device__ __forceinline__ float gate_k(float a, float nrs, float nb) { const float e = __builtin_amdgcn_exp2f(__builtin_fmaf(a, nrs, nb));
    return fmaxf(__builtin_rintf(__builtin_amdgcn_rcpf(__builtin_fmaf(e, 1.0f / 255.0f, 1.0f / 255.0f))), 1.0f); }
__device__ __forceinline__ unsigned gate_q4(const f32x4 a, float nrs, const f32x4 nb) { unsigned w = __builtin_amdgcn_cvt_pk_u8_f32(gate_k(a[0], nrs, nb[0]), 0u, 0u); w = __builtin_amdgcn_cvt_pk_u8_f32(gate_k(a[1], nrs, nb[1]), 1u, w);
    w = __builtin_amdgcn_cvt_pk_u8_f32(gate_k(a[2], nrs, nb[2]), 2u, w); return __builtin_amdgcn_cvt_pk_u8_f32(gate_k(a[3], nrs, nb[3]), 3u, w); }
__device__ __forceinline__ f32x4 ub4(unsigned w) { return (f32x4){(float)(w & 0xffu), (float)((w >> 8) & 0xffu), (float)((w >> 16) & 0xffu), (float)(w >> 24)}; }
__device__ __forceinline__ f32x4 rcp4(const f32x4 v) { return (f32x4){__builtin_amdgcn_rcpf(v[0]), __builtin_amdgcn_rcpf(v[1]), __builtin_amdgcn_rcpf(v[2]), __builtin_amdgcn_rcpf(v[3])}; }
struct EpiProj {
    static constexpr bool PERM = true, AFTER_DRAIN = false, HAS_MID = false, USES_RSTD = true;
    bf16_t* PROJ; u32x4* GQ; float* LR; const float* gbias; const float* rstd;
    __device__ __forceinline__ void operator()(const f32x4 (&acc)[2][2][4][2], const Unit& u, int wr, int wc, int fr, int fq, const LAS float* rsl) const {
        const int row0 = u.pm * BM + wr * 64 + fr;
        if (u.pn < 18) {
            const int col0 = u.pn * BM + wc * 32 + 8 * fq;
#pragma unroll
            for (int ai = 0; ai < 2; ++ai)
#pragma unroll
                for (int m = 0; m < 4; ++m) { bf16_t* p = PROJ + (size_t)(row0 + ai * HALF + m * 16) * NPROJ + col0; const float rs = rsl[wr * 64 + fr + ai * HALF + m * 16];
#pragma unroll
                    for (int bj = 0; bj < 2; ++bj) { const f32x4 v0 = acc[ai][bj][m][0] * rs, v1 = acc[ai][bj][m][1] * rs;
                        u32x4 w; w.x = cvt_pk_bf16(v0[0], v0[1]); w.y = cvt_pk_bf16(v0[2], v0[3]); w.z = cvt_pk_bf16(v1[0], v1[1]); w.w = cvt_pk_bf16(v1[2], v1[3]);
                        *(u32x4*)(p + bj * HALF) = w; } }
        } else if (u.pn < 42) {
            const int gt = u.pn - 18, col0 = gt * BM + wc * 32 + 8 * fq;
            constexpr float NL2E = -1.4426950408889634f;
            const f32x4 b00 = *(const f32x4*)(gbias + col0) * NL2E, b01 = *(const f32x4*)(gbias + col0 + 4) * NL2E, b10 = *(const f32x4*)(gbias + col0 + HALF) * NL2E, b11 = *(const f32x4*)(gbias + col0 + HALF + 4) * NL2E;
            u32x4* gq = GQ + ((size_t)((gt >> 3) * (M / BM) + u.pm) * 8 + (gt & 7)) * 4096 + (wr * 4 + wc) * 512 + (fq * 16 + fr);
#pragma unroll
            for (int ai = 0; ai < 2; ++ai)
#pragma unroll
                for (int m = 0; m < 4; ++m) { const float nrs = NL2E * rsl[wr * 64 + fr + ai * HALF + m * 16];
                    float k[16];
#pragma unroll
                    for (int i = 0; i < 4; ++i) { k[i] = __builtin_fmaf(acc[ai][0][m][0][i], nrs, b00[i]); k[4 + i] = __builtin_fmaf(acc[ai][0][m][1][i], nrs, b01[i]);
                        k[8 + i] = __builtin_fmaf(acc[ai][1][m][0][i], nrs, b10[i]); k[12 + i] = __builtin_fmaf(acc[ai][1][m][1][i], nrs, b11[i]); }
#pragma unroll
                    for (int i = 0; i < 16; ++i) k[i] = __builtin_amdgcn_exp2f(k[i]);
#pragma unroll
                    for (int i = 0; i < 16; ++i) k[i] = __builtin_fmaf(k[i], 1.0f / 255.0f, 1.0f / 255.0f);
#pragma unroll
                    for (int i = 0; i < 16; ++i) k[i] = __builtin_amdgcn_rcpf(k[i]);
#pragma unroll
                    for (int i = 0; i < 16; ++i) k[i] = fmaxf(__builtin_rintf(k[i]), 1.0f);
                    u32x4 w;
                    w.x = __builtin_amdgcn_cvt_pk_u8_f32(k[3], 3u, __builtin_amdgcn_cvt_pk_u8_f32(k[2], 2u, __builtin_amdgcn_cvt_pk_u8_f32(k[1], 1u, __builtin_amdgcn_cvt_pk_u8_f32(k[0], 0u, 0u))));
                    w.y = __builtin_amdgcn_cvt_pk_u8_f32(k[7], 3u, __builtin_amdgcn_cvt_pk_u8_f32(k[6], 2u, __builtin_amdgcn_cvt_pk_u8_f32(k[5], 1u, __builtin_amdgcn_cvt_pk_u8_f32(k[4], 0u, 0u))));
                    w.z = __builtin_amdgcn_cvt_pk_u8_f32(k[11], 3u, __builtin_amdgcn_cvt_pk_u8_f32(k[10], 2u, __builtin_amdgcn_cvt_pk_u8_f32(k[9], 1u, __builtin_amdgcn_cvt_pk_u8_f32(k[8], 0u, 0u))));
                    w.w = __builtin_amdgcn_cvt_pk_u8_f32(k[15], 3u, __builtin_amdgcn_cvt_pk_u8_f32(k[14], 2u, __builtin_amdgcn_cvt_pk_u8_f32(k[13], 1u, __builtin_amdgcn_cvt_pk_u8_f32(k[12], 0u, 0u))));
                    gq[(ai * 4 + m) * 64] = w; }
        } else {
            if (wc == 0) {
#pragma unroll
                for (int ai = 0; ai < 2; ++ai)
#pragma unroll
                    for (int m = 0; m < 4; ++m) { float* p = LR + (size_t)(row0 + ai * HALF + m * 16) * 32 + 8 * fq; const float rs = rsl[wr * 64 + fr + ai * HALF + m * 16];
                        *(f32x4*)p = acc[ai][0][m][0] * rs; *(f32x4*)(p + 4) = acc[ai][0][m][1] * rs; }
            }
        }
    }
};
struct EpiMerge3 {
    static constexpr bool PERM = true, AFTER_DRAIN = false, HAS_MID = true, USES_RSTD = false;
    static constexpr int MID0 = 1024 / BK, MID1 = 1536 / BK;
    static constexpr size_t GSTRIDE = (size_t)(M / BM) * 8 * 4096;
    const u32x4* GQ; bf16_t* MG;
    __device__ __forceinline__ void mid(f32x4 (&acc)[2][2][4][2], const Unit& u, int seg, int wr, int wc, int fr, int fq) const {
        const u32x4* gp = GQ + (size_t)seg * GSTRIDE + ((size_t)u.pm * 8 + u.pn) * 4096 + (wr * 4 + wc) * 512 + (fq * 16 + fr);
        u32x4 gn[8], gd[8];
#pragma unroll
        for (int j = 0; j < 8; ++j) { gn[j] = gp[j * 64]; gd[j] = gp[GSTRIDE + j * 64]; }
#pragma unroll
        for (int j = 0; j < 8; ++j) { const int ai = j >> 2, m = j & 3;
            acc[ai][0][m][0] = acc[ai][0][m][0] * (ub4(gn[j].x) * rcp4(ub4(gd[j].x))); acc[ai][0][m][1] = acc[ai][0][m][1] * (ub4(gn[j].y) * rcp4(ub4(gd[j].y)));
            acc[ai][1][m][0] = acc[ai][1][m][0] * (ub4(gn[j].z) * rcp4(ub4(gd[j].z))); acc[ai][1][m][1] = acc[ai][1][m][1] * (ub4(gn[j].w) * rcp4(ub4(gd[j].w))); }
    }
    __device__ __forceinline__ void operator()(const f32x4 (&acc)[2][2][4][2], const Unit& u, int wr, int wc, int fr, int fq, const LAS float* rsl) const {
        const int row0 = u.pm * BM + wr * 64 + fr, col0 = u.pn * BM + wc * 32 + 8 * fq;
        const u32x4* gp = GQ + 2 * GSTRIDE + ((size_t)u.pm * 8 + u.pn) * 4096 + (wr * 4 + wc) * 512 + (fq * 16 + fr);
        u32x4 gc[8];
#pragma unroll
        for (int j = 0; j < 8; ++j) gc[j] = gp[j * 64];
        constexpr float S = 1.0f / 255.0f;
#pragma unroll
        for (int j = 0; j < 8; ++j) { const int ai = j >> 2, m = j & 3; bf16_t* p = MG + (size_t)(row0 + ai * HALF + m * 16) * D + col0;
            const f32x4 v0 = acc[ai][0][m][0] * (ub4(gc[j].x) * S), v1 = acc[ai][0][m][1] * (ub4(gc[j].y) * S), v2 = acc[ai][1][m][0] * (ub4(gc[j].z) * S), v3 = acc[ai][1][m][1] * (ub4(gc[j].w) * S);
            u32x4 w; w.x = cvt_pk_bf16(v0[0], v0[1]); w.y = cvt_pk_bf16(v0[2], v0[3]); w.z = cvt_pk_bf16(v1[0], v1[1]); w.w = cvt_pk_bf16(v1[2], v1[3]); *(u32x4*)p = w;
            w.x = cvt_pk_bf16(v2[0], v2[1]); w.y = cvt_pk_bf16(v2[2], v2[3]); w.z = cvt_pk_bf16(v3[0], v3[1]); w.w = cvt_pk_bf16(v3[2], v3[3]); *(u32x4*)(p + HALF) = w; }
    }
};

template <class Epi, class Sched, bool ALIGN_EPI = false, bool SP2 = false>
__device__ __forceinline__ void gemm_phase(LAS unsigned char* lds, const Gemm g, const Sched& S, const Epi& E) {
    const int tid = opaque_tid(), wid = __builtin_amdgcn_readfirstlane(tid >> 6), lane = tid & 63, wr = wid >> 2, wc = wid & 3, fr = lane & 15, fq = lane >> 4;
    const int K = g.K, nt = K / BK, lda = g.lda;
    unsigned voffA[2], voffB[2];
#pragma unroll
    for (int i = 0; i < 2; ++i) { int R, C; stage_rc(tid * 16 + i * 8192, R, C); const int Rb = Epi::PERM ? ((R & ~31) + perm32(R & 31)) : R;
        voffA[i] = (unsigned)(R * lda + C) * 2u; voffB[i] = (unsigned)(Rb * K + C) * 2u; }
    const unsigned kstep = (unsigned)(BK * 2);
    const unsigned hstepA = (unsigned)HALF * (unsigned)lda * 2u, hstepB = (unsigned)HALF * (unsigned)K * 2u;
    const unsigned tstepA = 2u * hstepA, tstepB = 2u * hstepB;
    const unsigned ldsw = (unsigned)wid * 1024u;
    const int aoff = lds_byte(wr * 64 + fr, fq * 8), boff = lds_byte(wc * 32 + fr, fq * 8);
    const char* const baseA = (const char*)g.A; const char* const baseB = (const char*)g.Bt;
#define PG8_SA(b, h) (((b) * 2 + (h)) * HTB)
#define PG8_SB(b, h) ((4 + (b) * 2 + (h)) * HTB)
#define PG8_STAGE(bufoff, gbase, goff, voff) do { _Pragma("unroll") for (int _i = 0; _i < 2; ++_i) \
        __builtin_amdgcn_global_load_lds((const unsigned*)((gbase) + (size_t)(unsigned)((goff) + (voff)[_i])), (LAS unsigned*)(lds + (bufoff) + ldsw + _i * 8192), 16, 0, 0); } while (0)
#define PG8_LDA(dst, b, h) do { _Pragma("unroll") for (int m = 0; m < 4; ++m) _Pragma("unroll") for (int k = 0; k < 2; ++k) dst[m][k] = *(const LAS bf16x8*)(lds + PG8_SA(b, h) + aoff + m * 2048 + k * 1024); } while (0)
#define PG8_LDB(dst, b, h) do { _Pragma("unroll") for (int n = 0; n < 2; ++n) _Pragma("unroll") for (int k = 0; k < 2; ++k) dst[n][k] = *(const LAS bf16x8*)(lds + PG8_SB(b, h) + boff + n * 2048 + k * 1024); } while (0)
#define PG8_MMA(ai, bj, At, Bt) do { __builtin_amdgcn_s_setprio(1); _Pragma("unroll") for (int m = 0; m < 4; ++m) _Pragma("unroll") for (int n = 0; n < 2; ++n) _Pragma("unroll") for (int k = 0; k < 2; ++k) \
        acc[ai][bj][m][n] = __builtin_amdgcn_mfma_f32_16x16x32_bf16(Bt[n][k], At[m][k], acc[ai][bj][m][n], 0, 0, 0); __builtin_amdgcn_s_setprio(0); } while (0)
#define PG8_WAIT_V(n) asm volatile("s_waitcnt vmcnt(" #n ")" ::: "memory")
#define PG8_WAIT_L(n) asm volatile("s_waitcnt lgkmcnt(" #n ")" ::: "memory")
#define PG8_BAR __builtin_amdgcn_s_barrier()
#define PG8_SCHED __builtin_amdgcn_sched_barrier(0)
    Unit cur, nxt; int ui = 0;
    if (!S.next(0, cur)) return;
    constexpr int RS_OFF = 131072 + 8192;
#define PG8_RSTD(u_, slot_) do { if constexpr (Epi::USES_RSTD) { if (wid == 0) __builtin_amdgcn_global_load_lds((const unsigned*)(E.rstd + (size_t)(u_).pm * BM + lane * 4), (LAS unsigned*)(lds + RS_OFF + (slot_) * 1024), 16, 0, 0); } } while (0)
    PG8_RSTD(cur, 0);
    f32x4 acc[2][2][4][2];
#pragma unroll
    for (int a = 0; a < 2; ++a)
#pragma unroll
        for (int b = 0; b < 2; ++b)
#pragma unroll
            for (int m = 0; m < 4; ++m)
#pragma unroll
                for (int n = 0; n < 2; ++n) acc[a][b][m][n] = (f32x4){0.f, 0.f, 0.f, 0.f};
    bf16x8 At[4][2], B0[2][2], B1[2][2];
    unsigned cA = (unsigned)cur.pm * tstepA, cB = (unsigned)cur.pn * tstepB;
    S.a_ready(cur);
    if constexpr (SP2) {
        PG8_STAGE(PG8_SB(0, 0), baseB, cB, voffB); PG8_STAGE(PG8_SB(0, 1), baseB, cB + hstepB, voffB); PG8_STAGE(PG8_SA(0, 0), baseA, cA, voffA); PG8_STAGE(PG8_SA(0, 1), baseA, cA + hstepA, voffA);
        if (wr == 1) PG8_BAR;
        PG8_WAIT_V(2); PG8_BAR;
        PG8_STAGE(PG8_SB(1, 0), baseB, cB + kstep, voffB); PG8_STAGE(PG8_SA(1, 0), baseA, cA + kstep, voffA); PG8_STAGE(PG8_SB(1, 1), baseB, cB + hstepB + kstep, voffB);
        PG8_WAIT_V(6); PG8_BAR;
    } else {
        PG8_STAGE(PG8_SB(0, 0), baseB, cB, voffB); PG8_STAGE(PG8_SA(0, 0), baseA, cA, voffA); PG8_STAGE(PG8_SB(0, 1), baseB, cB + hstepB, voffB); PG8_STAGE(PG8_SA(0, 1), baseA, cA + hstepA, voffA);
        if (wr == 1) PG8_BAR;
        PG8_WAIT_V(4); PG8_BAR;
        PG8_STAGE(PG8_SB(1, 0), baseB, cB + kstep, voffB); PG8_STAGE(PG8_SA(1, 0), baseA, cA + kstep, voffA); PG8_STAGE(PG8_SB(1, 1), baseB, cB + hstepB + kstep, voffB);
        PG8_WAIT_V(6); PG8_BAR;
    }
    for (;;) {
        const bool has_next = S.next(ui + 1, nxt);
        const unsigned nA = has_next ? (unsigned)nxt.pm * tstepA : cA, nB = has_next ? (unsigned)nxt.pn * tstepB : cB;
        for (int t = 0; t < nt; t += 2) {
            const bool last = (t == nt - 2);
            if constexpr (Epi::HAS_MID) { if (t == Epi::MID0 || t == Epi::MID1) E.mid(acc, cur, t == Epi::MID0 ? 0 : 1, wr, wc, fr, fq); }
            const unsigned a1 = cA + (unsigned)(t + 1) * kstep;
            const unsigned a2 = last ? nA : cA + (unsigned)(t + 2) * kstep, b2 = last ? nB : cB + (unsigned)(t + 2) * kstep;
            const unsigned a3 = a2 + kstep, b3 = b2 + kstep;
            if (last && has_next) S.a_ready(nxt);
            if constexpr (SP2) {
            PG8_LDB(B0, 0, 0); PG8_LDB(B1, 0, 1); PG8_SCHED; PG8_LDA(At, 0, 0); PG8_STAGE(PG8_SA(1, 1), baseA, a1 + hstepA, voffA);
            PG8_WAIT_V(8); PG8_WAIT_L(0); PG8_BAR; PG8_MMA(0, 0, At, B0); PG8_MMA(0, 1, At, B1); PG8_BAR; PG8_SCHED;
            PG8_LDA(At, 0, 1); PG8_STAGE(PG8_SB(0, 0), baseB, b2, voffB); PG8_STAGE(PG8_SB(0, 1), baseB, b2 + hstepB, voffB); PG8_STAGE(PG8_SA(0, 0), baseA, a2, voffA);
            PG8_WAIT_V(8); PG8_WAIT_L(0); PG8_BAR; PG8_MMA(1, 0, At, B0); PG8_MMA(1, 1, At, B1); PG8_BAR; PG8_SCHED;
            PG8_LDB(B0, 1, 0); PG8_LDB(B1, 1, 1); PG8_SCHED; PG8_LDA(At, 1, 0); PG8_STAGE(PG8_SA(0, 1), baseA, a2 + hstepA, voffA);
            PG8_WAIT_V(8); PG8_WAIT_L(0); PG8_BAR; PG8_MMA(0, 0, At, B0); PG8_MMA(0, 1, At, B1); PG8_BAR; PG8_SCHED;
            PG8_LDA(At, 1, 1); PG8_STAGE(PG8_SB(1, 0), baseB, b3, voffB); PG8_STAGE(PG8_SB(1, 1), baseB, b3 + hstepB, voffB); PG8_STAGE(PG8_SA(1, 0), baseA, a3, voffA);
            PG8_WAIT_V(8); PG8_WAIT_L(0); PG8_BAR; PG8_MMA(1, 0, At, B0); PG8_MMA(1, 1, At, B1); PG8_BAR; PG8_SCHED;
            } else {
            PG8_LDB(B0, 0, 0); PG8_SCHED; PG8_LDA(At, 0, 0); PG8_STAGE(PG8_SA(1, 1), baseA, a1 + hstepA, voffA);
            PG8_WAIT_L(8); PG8_BAR; PG8_WAIT_L(0); PG8_MMA(0, 0, At, B0); PG8_BAR; PG8_SCHED;
            PG8_LDB(B1, 0, 1); PG8_STAGE(PG8_SB(0, 0), baseB, b2, voffB);
            PG8_BAR; PG8_WAIT_L(0); PG8_MMA(0, 1, At, B1); PG8_BAR;
            PG8_LDA(At, 0, 1); PG8_STAGE(PG8_SA(0, 0), baseA, a2, voffA);
            PG8_BAR; PG8_WAIT_L(0); PG8_MMA(1, 0, At, B0); PG8_BAR; PG8_SCHED;
            PG8_STAGE(PG8_SB(0, 1), baseB, b2 + hstepB, voffB);
            PG8_WAIT_V(6); PG8_BAR; PG8_MMA(1, 1, At, B1); PG8_BAR;
            PG8_LDB(B0, 1, 0); PG8_SCHED; PG8_LDA(At, 1, 0); PG8_STAGE(PG8_SA(0, 1), baseA, a2 + hstepA, voffA);
            PG8_WAIT_L(8); PG8_BAR; PG8_WAIT_L(0); PG8_MMA(0, 0, At, B0); PG8_BAR; PG8_SCHED;
            PG8_LDB(B1, 1, 1); PG8_STAGE(PG8_SB(1, 0), baseB, b3, voffB);
            PG8_BAR; PG8_WAIT_L(0); PG8_MMA(0, 1, At, B1); PG8_BAR;
            PG8_LDA(At, 1, 1); PG8_STAGE(PG8_SA(1, 0), baseA, a3, voffA);
            PG8_BAR; PG8_WAIT_L(0); PG8_MMA(1, 0, At, B0); PG8_BAR; PG8_SCHED;
            PG8_STAGE(PG8_SB(1, 1), baseB, b3 + hstepB, voffB);
            PG8_WAIT_V(6); PG8_BAR; PG8_MMA(1, 1, At, B1); PG8_BAR;
            }
        }
        if constexpr (ALIGN_EPI) { if (wr == 0) PG8_BAR; }
        if constexpr (!Epi::AFTER_DRAIN) { E(acc, cur, wr, wc, fr, fq, (const LAS float*)(lds + RS_OFF + (ui & 1) * 1024)); S.done(cur); }
        if (!has_next) break;
#pragma unroll
        for (int a = 0; a < 2; ++a)
#pragma unroll
            for (int b = 0; b < 2; ++b)
#pragma unroll
                for (int m = 0; m < 4; ++m)
#pragma unroll
                    for (int n = 0; n < 2; ++n) acc[a][b][m][n] = (f32x4){0.f, 0.f, 0.f, 0.f};
        cur = nxt; cA = nA; cB = nB; ++ui;
        PG8_RSTD(cur, ui & 1);
        if constexpr (ALIGN_EPI) { if (wr == 1) PG8_BAR; }
    }
    PG8_WAIT_V(0);
    if constexpr (!ALIGN_EPI) { if (wr == 0) PG8_BAR; }
    PG8_BAR;
#undef PG8_SA
#undef PG8_SB
#undef PG8_STAGE
#undef PG8_LDA
#undef PG8_LDB
#undef PG8_MMA
#undef PG8_WAIT_V
#undef PG8_WAIT_L
#undef PG8_BAR
#undef PG8_SCHED
}
}

namespace att {
constexpr int DH = 128, NW = 8, QBLK = 32, KVBLK = 64;
constexpr float SCALE = 0.088388347648318440f;
constexpr float THR = 8.f;
constexpr int LD = NPROJ, LDO = 2048;
constexpr size_t SHM_V = KVBLK * DH * 2, SHM_K = KVBLK * DH * 2, SHM_ATTN = 2 * SHM_V + 2 * SHM_K + NW * 64 * 4;
#define KSWZ(row, colB) ((row) * 256 + ((colB) ^ (((row) & 7) << 4)))
#define SBAR() __builtin_amdgcn_sched_barrier(0)
__device__ __forceinline__ int crow(int r, int hi) { return (r & 3) + 8 * (r >> 2) + 4 * hi; }
__device__ __forceinline__ void partialSM(f32x16& p0, f32x16& p1, float& m_reg, float& mn, float& alpha) {
  constexpr float C = SCALE * 1.4426950408889634f;
  float pmax = p0[0];
#pragma unroll
  for (int r = 1; r < 16; ++r) pmax = fmaxf(pmax, p0[r]);
#pragma unroll
  for (int r = 0; r < 16; ++r) pmax = fmaxf(pmax, p1[r]);
  { auto rr = __builtin_amdgcn_permlane32_swap(__float_as_uint(pmax), __float_as_uint(pmax), false, false);
    pmax = fmaxf(__uint_as_float(rr[0]), __uint_as_float(rr[1])); }
  if (__builtin_expect(__all(pmax - m_reg <= THR / SCALE), 1)) { mn = m_reg; alpha = 1.f; }
  else { mn = fmaxf(m_reg, pmax); alpha = __builtin_amdgcn_exp2f((m_reg - mn) * C); m_reg = mn; }
  float mnC = -mn * C;
#pragma unroll
  for (int r = 0; r < 16; ++r) p0[r] = fmaf(p0[r], C, mnC);
#pragma unroll
  for (int r = 0; r < 16; ++r) p1[r] = fmaf(p1[r], C, mnC);
#pragma unroll
  for (int r = 0; r < 16; ++r) p0[r] = __builtin_amdgcn_exp2f(p0[r]);
}
__device__ __forceinline__ void finishSM(f32x16& p0, f32x16& p1, float alpha, float& l_reg, bf16x8& pa0, bf16x8& pa1, bf16x8& pa2, bf16x8& pa3) {
#pragma unroll
  for (int r = 0; r < 16; ++r) p1[r] = __builtin_amdgcn_exp2f(p1[r]);
  float ps = 0;
#pragma unroll
  for (int r = 0; r < 16; ++r) ps += p0[r];
#pragma unroll
  for (int r = 0; r < 16; ++r) ps += p1[r];
  { auto rr = __builtin_amdgcn_permlane32_swap(__float_as_uint(ps), __float_as_uint(ps), false, false);
    ps = __uint_as_float(rr[0]) + __uint_as_float(rr[1]); }
  l_reg = l_reg * alpha + ps;
#define PK4(P, BASE, OUT) do { unsigned a0 = cvt_pk_bf16(P[BASE + 0], P[BASE + 1]), a1 = cvt_pk_bf16(P[BASE + 2], P[BASE + 3]);   \
    unsigned b0 = cvt_pk_bf16(P[BASE + 4], P[BASE + 5]), b1 = cvt_pk_bf16(P[BASE + 6], P[BASE + 7]);                              \
    auto r0 = __builtin_amdgcn_permlane32_swap(a0, b0, false, false); auto r1 = __builtin_amdgcn_permlane32_swap(a1, b1, false, false); \
    u32x4 w = {r0[0], r1[0], r0[1], r1[1]}; OUT = *reinterpret_cast<bf16x8*>(&w); } while (0)
  PK4(p0, 0, pa0); PK4(p0, 8, pa1); PK4(p1, 0, pa2); PK4(p1, 8, pa3);
#undef PK4
}
__device__ __forceinline__ void qkt(f32x16& p0, f32x16& p1, const bf16_t* Ks, const bf16x8* qr, int r32, int hi) {
  p0 = f32x16{}; p1 = f32x16{};
#pragma unroll
  for (int d0 = 0; d0 < 8; ++d0) { int cb = (d0 * 16 + hi * 8) * 2;
    bf16x8 b0 = *reinterpret_cast<const bf16x8*>((const char*)Ks + KSWZ(r32, cb));
    bf16x8 b1 = *reinterpret_cast<const bf16x8*>((const char*)Ks + KSWZ(32 + r32, cb));
    p0 = __builtin_amdgcn_mfma_f32_32x32x16_bf16(b0, qr[d0], p0, 0, 0, 0);
    p1 = __builtin_amdgcn_mfma_f32_32x32x16_bf16(b1, qr[d0], p1, 0, 0, 0); }
}
__device__ __forceinline__ int v_st(int k, int c) { const int kk = (k & ~0xC) | ((k & 4) << 1) | ((k & 8) >> 1); return ((kk >> 3) * 4 + (c >> 5)) * 512 + ((kk & 7) * 32 + (c & 31)) * 2; }
__device__ __forceinline__ int v_rd_base(int lane) { return ((lane & 3) << 3) | (((lane >> 2) & 3) << 6) | (((lane >> 4) & 1) << 5) | (((lane >> 5) & 1) << 8); }
constexpr int v_rd_off(int d0, int ks, int half) { return d0 * 512 + ks * 4096 + half * 2048; }
template <int OFF> __device__ __forceinline__ s16x4 tr_read(int vb) {
  s16x4 r; asm volatile("ds_read_b64_tr_b16 %0, %1 offset:%2" : "=&v"(r) : "v"(vb), "i"(OFF) : "memory"); return r;
}
template <int D0> __device__ __forceinline__ void pv_one(f32x16& od, int vb, bf16x8 pa0, bf16x8 pa1, bf16x8 pa2, bf16x8 pa3) {
  const s16x4 l0 = tr_read<v_rd_off(D0, 0, 0)>(vb), h0 = tr_read<v_rd_off(D0, 0, 1)>(vb), l1 = tr_read<v_rd_off(D0, 1, 0)>(vb), h1 = tr_read<v_rd_off(D0, 1, 1)>(vb);
  const s16x4 l2 = tr_read<v_rd_off(D0, 2, 0)>(vb), h2 = tr_read<v_rd_off(D0, 2, 1)>(vb), l3 = tr_read<v_rd_off(D0, 3, 0)>(vb), h3 = tr_read<v_rd_off(D0, 3, 1)>(vb);
  asm volatile("s_waitcnt lgkmcnt(0)" ::: "memory"); SBAR();
#define PK(L, H) (bf16x8){L[0], L[1], L[2], L[3], H[0], H[1], H[2], H[3]}
  od = __builtin_amdgcn_mfma_f32_32x32x16_bf16(pa0, PK(l0, h0), od, 0, 0, 0);
  od = __builtin_amdgcn_mfma_f32_32x32x16_bf16(pa1, PK(l1, h1), od, 0, 0, 0);
  od = __builtin_amdgcn_mfma_f32_32x32x16_bf16(pa2, PK(l2, h2), od, 0, 0, 0);
  od = __builtin_amdgcn_mfma_f32_32x32x16_bf16(pa3, PK(l3, h3), od, 0, 0, 0);
#undef PK
}
__device__ __forceinline__ void pv_d0(f32x16* o, int vb, bf16x8 pa0, bf16x8 pa1, bf16x8 pa2, bf16x8 pa3) {
  pv_one<0>(o[0], vb, pa0, pa1, pa2, pa3); pv_one<1>(o[1], vb, pa0, pa1, pa2, pa3); pv_one<2>(o[2], vb, pa0, pa1, pa2, pa3); pv_one<3>(o[3], vb, pa0, pa1, pa2, pa3);
}
__device__ __forceinline__ void attn_dense_body(const bf16_t* Qb, const bf16_t* __restrict__ Kh, const bf16_t* __restrict__ Vh, bf16_t* Ob, int seq, char* lds, const float* qgain  , const f32x2* cs  , int t0  ) {
  const int tid = opaque_tid(), wid = tid >> 6, lane = tid & 63, r32 = lane & 31, hi = lane >> 5;
  bf16_t* V_lds = (bf16_t*)lds; bf16_t* K_lds = (bf16_t*)(lds + 2 * SHM_V);
  float* ws = (float*)(lds + 2 * SHM_V + 2 * SHM_K) + wid * 64; float* li_l = ws; float* al_l = ws + 32;
  float m_reg = -1e30f, l_reg = 0; f32x16 o[4] = {}; bf16x8 qr[8];
  const bf16_t* Qw = Qb + (long)(wid * QBLK + r32) * LD + hi * 8;
#pragma unroll
  for (int d0 = 0; d0 < 8; ++d0) qr[d0] = *reinterpret_cast<const bf16x8*>(Qw + d0 * 16);
  {
    float ss = 0.f;
#pragma unroll
    for (int d0 = 0; d0 < 8; ++d0) { const u32x4 w = *reinterpret_cast<const u32x4*>(&qr[d0]);
      ss += (bflo(w.x) * bflo(w.x) + bfhi(w.x) * bfhi(w.x)) + (bflo(w.y) * bflo(w.y) + bfhi(w.y) * bfhi(w.y)) + (bflo(w.z) * bflo(w.z) + bfhi(w.z) * bfhi(w.z)) + (bflo(w.w) * bflo(w.w) + bfhi(w.w) * bfhi(w.w)); }
    { auto rr = __builtin_amdgcn_permlane32_swap(__float_as_uint(ss), __float_as_uint(ss), false, false); ss = __uint_as_float(rr[0]) + __uint_as_float(rr[1]); }
    const float rstd = 1.0f / sqrtf(ss * (1.0f / 128.0f) + EPS);
    const int t = t0 + wid * QBLK + r32, pr = t >> 6, pc = t & 63;
#pragma unroll
    for (int d0 = 0; d0 < 8; ++d0) {
      const f32x4 g0 = *(const f32x4*)(qgain + d0 * 16 + hi * 8) * rstd, g1 = *(const f32x4*)(qgain + d0 * 16 + hi * 8 + 4) * rstd;
      const f32x4* cp = (const f32x4*)(cs + ((d0 < 4) ? pr : pc) * 32 + (d0 & 3) * 8 + hi * 4); const f32x4 ca = cp[0], cb = cp[1];
      const u32x4 w = *reinterpret_cast<const u32x4*>(&qr[d0]); u32x4 o;
      { const float n1 = bflo(w.x) * g0[0], n2 = bfhi(w.x) * g0[1]; o.x = cvt_pk_bf16(n1 * ca[0] - n2 * ca[1], n1 * ca[1] + n2 * ca[0]); }
      { const float n1 = bflo(w.y) * g0[2], n2 = bfhi(w.y) * g0[3]; o.y = cvt_pk_bf16(n1 * ca[2] - n2 * ca[3], n1 * ca[3] + n2 * ca[2]); }
      { const float n1 = bflo(w.z) * g1[0], n2 = bfhi(w.z) * g1[1]; o.z = cvt_pk_bf16(n1 * cb[0] - n2 * cb[1], n1 * cb[1] + n2 * cb[0]); }
      { const float n1 = bflo(w.w) * g1[2], n2 = bfhi(w.w) * g1[3]; o.w = cvt_pk_bf16(n1 * cb[2] - n2 * cb[3], n1 * cb[3] + n2 * cb[2]); }
      qr[d0] = *reinterpret_cast<const bf16x8*>(&o);
    }
  }
  const int sr = tid >> 4, sc = (tid & 15) * 8, vst0 = v_st(sr, sc), vst1 = v_st(32 + sr, sc);
  const int vb0 = (int)(uintptr_t)V_lds + v_rd_base(lane);
  struct { bf16x8 vs0, vs1, ks0, ks1; } sr_[1];
#define SLOAD(i, k0) do { sr_[i].vs0 = *reinterpret_cast<const bf16x8*>(&Vh[(long)((k0) + sr) * LD + sc]); sr_[i].vs1 = *reinterpret_cast<const bf16x8*>(&Vh[(long)((k0) + 32 + sr) * LD + sc]); \
    sr_[i].ks0 = *reinterpret_cast<const bf16x8*>(&Kh[(long)((k0) + sr) * LD + sc]); sr_[i].ks1 = *reinterpret_cast<const bf16x8*>(&Kh[(long)((k0) + 32 + sr) * LD + sc]); } while (0)
#define SWRITE(b, i) do { *(bf16x8*)((char*)V_lds + (b) * SHM_V + vst0) = sr_[i].vs0;          \
    *(bf16x8*)((char*)V_lds + (b) * SHM_V + vst1) = sr_[i].vs1; int kc = sc * 2;               \
    *(bf16x8*)((char*)K_lds + (b) * SHM_K + KSWZ(sr, kc)) = sr_[i].ks0;                       \
    *(bf16x8*)((char*)K_lds + (b) * SHM_K + KSWZ(32 + sr, kc)) = sr_[i].ks1; } while (0)
#define SWAIT() asm volatile("s_waitcnt vmcnt(0)" ::: "memory")
#define RESC(a) do { if (__any((a) < 1.f)) { if (hi == 0) al_l[r32] = (a); asm volatile("s_waitcnt lgkmcnt(0)" ::: "memory"); \
    _Pragma("unroll") for (int d = 0; d < 4; ++d) _Pragma("unroll") for (int r = 0; r < 16; ++r) o[d][r] *= al_l[crow(r, hi)]; } } while (0)
  f32x16 pA0, pA1, pB0, pB1; float mnA, mnB, alA, alB; bf16x8 pa0, pa1, pa2, pa3; const int NT = seq / KVBLK;
  constexpr int SE = 0, SO = 0;
  SLOAD(SE, 0); asm volatile("s_waitcnt vmcnt(0)" ::: "memory"); SWRITE(0, SE); __syncthreads();
  qkt(pA0, pA1, K_lds, qr, r32, hi); partialSM(pA0, pA1, m_reg, mnA, alA);
  SLOAD(SO, KVBLK);
  SWAIT(); SWRITE(1, SO); __syncthreads();
  for (int j = 1; j + 1 < NT; j += 2) {
    SBAR(); qkt(pB0, pB1, (bf16_t*)((char*)K_lds + SHM_K), qr, r32, hi);
    finishSM(pA0, pA1, alA, l_reg, pa0, pa1, pa2, pa3); SBAR();
    SLOAD(SO, (j + 1) * KVBLK); SBAR();
    pv_d0(o, vb0, pa0, pa1, pa2, pa3); partialSM(pB0, pB1, m_reg, mnB, alB);
    __syncthreads(); SWAIT(); SWRITE(0, SE);
    RESC(alB); __syncthreads();
    SBAR(); qkt(pA0, pA1, K_lds, qr, r32, hi);
    finishSM(pB0, pB1, alB, l_reg, pa0, pa1, pa2, pa3); SBAR();
    SLOAD(SE, (j + 2) * KVBLK); SBAR();
    pv_d0(o, vb0 + (int)SHM_V, pa0, pa1, pa2, pa3); partialSM(pA0, pA1, m_reg, mnA, alA);
    __syncthreads(); SWAIT(); SWRITE(1, SO);
    RESC(alA); __syncthreads();
  }
  SBAR(); qkt(pB0, pB1, (bf16_t*)((char*)K_lds + SHM_K), qr, r32, hi);
  finishSM(pA0, pA1, alA, l_reg, pa0, pa1, pa2, pa3); SBAR();
  pv_d0(o, vb0, pa0, pa1, pa2, pa3); partialSM(pB0, pB1, m_reg, mnB, alB);
  __syncthreads(); RESC(alB);
  finishSM(pB0, pB1, alB, l_reg, pa0, pa1, pa2, pa3); SBAR();
  pv_d0(o, vb0 + (int)SHM_V, pa0, pa1, pa2, pa3);
  if (hi == 0) li_l[r32] = l_reg; asm volatile("s_waitcnt lgkmcnt(0)" ::: "memory");
  float rli[16];
#pragma unroll
  for (int r = 0; r < 16; ++r) rli[r] = __builtin_amdgcn_rcpf(li_l[crow(r, hi)]);
  bf16_t* Ow = Ob + (long)(wid * QBLK) * LDO;
#pragma unroll
  for (int r = 0; r < 16; ++r) { int orow = crow(r, hi);
#pragma unroll
    for (int d0 = 0; d0 < 4; ++d0) Ow[(long)orow * LDO + d0 * 32 + r32] = f2bf(o[d0][r] * rli[r]); }
  __syncthreads();
#undef SLOAD
#undef SWRITE
#undef SWAIT
#undef RESC
}
}

constexpr int RING_BYTES = 131072;
constexpr int LDSCTL_OFF = RING_BYTES, MISC_OFF = LDSCTL_OFF + 320, PTAB_OFF = LDSCTL_OFF + 1024;
constexpr int LDS_BYTES = 147456;

#define XB_TMO      128
#define XB_XCNT(j)  (256  + 64 * (j))
#define XB_XSUB(j)  (1280 + 64 * (j))
#define XB_XGEN(j)  (2304 + 64 * (j))
#define XB_TOP      3328
#define XB_TOPGEN   3392
#define XCD_BAR_WORDS 3456
#define XB_SPIN_CAP (1u << 22)
__device__ __forceinline__ unsigned xb_ld(unsigned* p)              { return __hip_atomic_load(p, __ATOMIC_RELAXED, __HIP_MEMORY_SCOPE_AGENT); }
__device__ __forceinline__ unsigned xb_add(unsigned* p, unsigned v) { return __hip_atomic_fetch_add(p, v, __ATOMIC_RELAXED, __HIP_MEMORY_SCOPE_AGENT); }
__device__ __forceinline__ unsigned xb_xcc_id() { return (unsigned)__builtin_amdgcn_s_getreg((3 << 11) | 20) & 0xFu; }
#define XB_SPIN(cond, bar) do { unsigned _sp = 0; while (cond) { __builtin_amdgcn_s_sleep(1); \
    if ((++_sp & 255u) == 0u) { if (xb_ld(&(bar)[XB_TMO])) break; if (_sp > XB_SPIN_CAP) { atomicAdd(&(bar)[XB_TMO], 1u); break; } } } } while (0)
struct XcdBarrier { unsigned* bar; unsigned x; volatile LAS unsigned* st; };
__device__ __forceinline__ XcdBarrier xcd_barrier_post(unsigned* bar, volatile LAS unsigned* st) {
    XcdBarrier b; b.bar = bar; b.x = xb_xcc_id(); b.st = st;
    if (threadIdx.x == 0) (void)xb_add(&bar[XB_XCNT(b.x)], 1u);
    return b;
}
__device__ __forceinline__ void xcd_barrier_complete(unsigned* bar, unsigned x, unsigned& nloc, unsigned& nx) {
    const unsigned G = gridDim.x * gridDim.y * gridDim.z;
    unsigned sum, cnt, mine, sp = 0u;
    for (;;) {
        sum = 0u; cnt = 0u;
        for (unsigned j = 0; j < 16; ++j) { const unsigned c = xb_ld(&bar[XB_XCNT(j)]); sum += c; cnt += (c > 0u) ? 1u : 0u; }
        mine = xb_ld(&bar[XB_XCNT(x)]);
        if (sum == G) break;
        __builtin_amdgcn_s_sleep(1);
        if ((++sp & 255u) == 0u) { if (xb_ld(&bar[XB_TMO])) break; if (sp > XB_SPIN_CAP) { atomicAdd(&bar[XB_TMO], 1u); break; } }
    }
    nloc = mine > 0u ? mine : 1u; nx = cnt > 0u ? cnt : 1u;
}
__device__ __forceinline__ XcdBarrier xcd_barrier_setup(unsigned* bar, volatile LAS unsigned* st) {
    XcdBarrier b = xcd_barrier_post(bar, st);
    if (threadIdx.x == 0) { unsigned nloc, nx; xcd_barrier_complete(bar, b.x, nloc, nx); st[0] = nloc; st[1] = nx; }
    __syncthreads();
    return b;
}
__device__ __forceinline__ void xcd_barrier(const XcdBarrier& b) {
    asm volatile("s_waitcnt vmcnt(0)" ::: "memory");
    __syncthreads();
    if (threadIdx.x == 0) {
        unsigned* bar = b.bar; unsigned bx = b.x;
        asm volatile("" : "+s"(bar), "+s"(bx));
        __builtin_amdgcn_s_waitcnt(0);
        const unsigned nloc = b.st[0], nx = b.st[1];
        const unsigned old = xb_add(&bar[XB_XSUB(bx)], 1u);
        const unsigned gen = old / nloc;
        if (old + 1u == (gen + 1u) * nloc) {
            __builtin_amdgcn_fence(__ATOMIC_RELEASE, "agent");
            asm volatile("s_waitcnt vmcnt(0)" ::: "memory");
            const unsigned og = xb_add(&bar[XB_TOP], 1u);
            const unsigned tg = og / nx;
            if (og + 1u == (tg + 1u) * nx) xb_add(&bar[XB_TOPGEN], 1u);
            else XB_SPIN(xb_ld(&bar[XB_TOPGEN]) == tg, bar);
            __builtin_amdgcn_fence(__ATOMIC_ACQUIRE, "agent");
            xb_add(&bar[XB_XGEN(bx)], 1u);
            asm volatile("s_waitcnt vmcnt(0)" ::: "memory");
        } else {
            XB_SPIN(xb_ld(&bar[XB_XGEN(bx)]) == gen, bar);
            __builtin_amdgcn_fence(__ATOMIC_ACQUIRE, "agent");
            asm volatile("s_waitcnt vmcnt(0)" ::: "memory");
        }
    }
    __syncthreads();
}

__device__ __forceinline__ void transpose_item(const float* W, int ldw, int K, int k0, int srccol0, bf16_t* WT, int dstrow0, LAS float* scr, int lane, const float* kgain = nullptr, int ldt = 0) {
    const int KT = ldt ? ldt : K;
    constexpr int P = 36;
    const int n4 = (lane & 7) * 4, kr = lane >> 3;
    f32x4 v[8];
    if (srccol0 >= 0) {
#pragma unroll
        for (int i = 0; i < 8; ++i) v[i] = *(const f32x4*)(W + (size_t)(k0 + 8 * i + kr) * ldw + srccol0 + n4);
        if (kgain) {
#pragma unroll
            for (int i = 0; i < 8; ++i) v[i] = v[i] * kgain[k0 + 8 * i + kr];
        }
    } else {
#pragma unroll
        for (int i = 0; i < 8; ++i) v[i] = (f32x4){0.f, 0.f, 0.f, 0.f};
    }
#pragma unroll
    for (int i = 0; i < 8; ++i) *(LAS f32x4*)(scr + (8 * i + kr) * P + n4) = v[i];
    LDS_WAIT(); asm volatile("" ::: "memory");
    const int c = lane & 7;
#pragma unroll
    for (int j = 0; j < 4; ++j) { const int n = (lane >> 3) + 8 * j; const LAS float* s = scr + (8 * c) * P + n;
        u32x4 o; o.x = cvt_pk_bf16(s[0 * P], s[1 * P]); o.y = cvt_pk_bf16(s[2 * P], s[3 * P]); o.z = cvt_pk_bf16(s[4 * P], s[5 * P]); o.w = cvt_pk_bf16(s[6 * P], s[7 * P]);
        *(u32x4*)(WT + (size_t)(dstrow0 + n) * KT + k0 + 8 * c) = o; }
    LDS_WAIT(); asm volatile("" ::: "memory");
}
struct LayerW { const float *w_in, *w_bra, *w_brb, *w_brc, *w_out, *f1i, *f1o, *f2i, *f2o, *ng; };
__device__ __forceinline__ void phase_weights(const LayerW& w, unsigned char* ws, LAS unsigned char* lds, int gw, int NGW, int wave, int lane) {
    LAS float* scr = (LAS float*)(lds + wave * 16384);
    constexpr int I_IN = (NIN_PAD / 32) * (D / 64);
    constexpr int I_FI = (2 * FF / 32) * (D / 64);
    constexpr int I_FO = (D / 32) * (FF / 64);
    constexpr int I_BA = (D / 32) * (1024 / 64);
    constexpr int I_BB = (D / 32) * (512 / 64);
    constexpr int I_WO = (D / 32) * (D / 64);
    constexpr int NITEMS = I_IN + 2 * I_FI + 2 * I_FO + I_BA + 2 * I_BB + I_WO;
    for (int it = gw; it < NITEMS; it += NGW) {
        int r = it;
        if (r < I_IN) { const int nb = r % (NIN_PAD / 32), kb = r / (NIN_PAD / 32); const int d0 = nb * 32;
            const int src = d0 < 4608 ? d0 : (d0 < 10752 ? d0 + 32 : (d0 < 10784 ? 4608 + (d0 - 10752) : -1));
            transpose_item(w.w_in, NIN, D, kb * 64, src, (bf16_t*)(ws + WS_WIN), d0, scr, lane, w.ng + 2 * D); continue; } r -= I_IN;
        if (r < 2 * I_FI) { const int which = r / I_FI; r -= which * I_FI; const int nb = r % (2 * FF / 32), kb = r / (2 * FF / 32); const int d0 = nb * 32;
            const int t = d0 >> 8, within = d0 & 255; const int src = within < 128 ? 128 * t + within : FF + 128 * t + (within - 128);
            transpose_item(which ? w.f2i : w.f1i, 2 * FF, D, kb * 64, src, (bf16_t*)(ws + (which ? WS_WF2I : WS_WF1I)), d0, scr, lane, w.ng + (which ? 4 * D : 0)); continue; } r -= 2 * I_FI;
        if (r < 2 * I_FO) { const int which = r / I_FO; r -= which * I_FO; const int nb = r % (D / 32), kb = r / (D / 32);
            transpose_item(which ? w.f2o : w.f1o, D, FF, kb * 64, nb * 32, (bf16_t*)(ws + (which ? WS_WF2O : WS_WF1O)), nb * 32, scr, lane); continue; } r -= 2 * I_FO;
        if (r < I_BA) { const int nb = r % (D / 32), kb = r / (D / 32);
            transpose_item(w.w_bra, D, 1024, kb * 64, nb * 32, (bf16_t*)(ws + WS_WBRA), nb * 32, scr, lane, nullptr, LDOM); continue; } r -= I_BA;
        if (r < 2 * I_BB) { const int which = r / I_BB; r -= which * I_BB; const int nb = r % (D / 32), kb = r / (D / 32);
            transpose_item(which ? w.w_brc : w.w_brb, D, 512, kb * 64, nb * 32, (bf16_t*)(ws + WS_WBRA) + (which ? OM_C : OM_B), nb * 32, scr, lane, nullptr, LDOM); continue; } r -= 2 * I_BB;
        { const int nb = r % (D / 32), kb = r / (D / 32);
            transpose_item(w.w_out, D, D, kb * 64, nb * 32, (bf16_t*)(ws + WS_WOUT), nb * 32, scr, lane); }
    }
}
__device__ __forceinline__ void phase_norm(bf16_t* XB, const bf16_t* Y, float* RSTD, float* OUT, const float* gpost, float coef, int gw, int NGW, int lane) {
    for (int m = gw; m < M; m += NGW) {
        const u32x2* xr = (const u32x2*)(XB + (size_t)m * D) + lane; const u32x2* yr = (const u32x2*)(Y + (size_t)m * D) + lane;
        f32x4 x[8], y[8]; float s = 0.f;
#pragma unroll
        for (int j = 0; j < 8; ++j) { const u32x2 t = yr[64 * j], q = xr[64 * j]; y[j] = (f32x4){bflo(t.x), bfhi(t.x), bflo(t.y), bfhi(t.y)}; x[j] = (f32x4){bflo(q.x), bfhi(q.x), bflo(q.y), bfhi(q.y)};
            s += (y[j].x * y[j].x + y[j].y * y[j].y) + (y[j].z * y[j].z + y[j].w * y[j].w); }
        const float rstd = coef * (1.0f / sqrtf(wave_sum(s) * (1.0f / D) + EPS));
        float s2 = 0.f;
#pragma unroll
        for (int j = 0; j < 8; ++j) { const f32x4 g = ((const f32x4*)gpost)[lane + 64 * j]; x[j] = x[j] + y[j] * g * rstd; s2 += (x[j].x * x[j].x + x[j].y * x[j].y) + (x[j].z * x[j].z + x[j].w * x[j].w); }
        if (OUT) { f32x4* xo = (f32x4*)(OUT + (size_t)m * D) + lane;
#pragma unroll
            for (int j = 0; j < 8; ++j) xo[64 * j] = x[j];
        } else {
            u32x2* o8 = (u32x2*)(XB + (size_t)m * D) + lane;
#pragma unroll
            for (int j = 0; j < 8; ++j) { u32x2 w; w.x = cvt_pk_bf16(x[j].x, x[j].y); w.y = cvt_pk_bf16(x[j].z, x[j].w); o8[64 * j] = w; }
            const float r2 = 1.0f / sqrtf(wave_sum(s2) * (1.0f / D) + EPS);
            if (lane == 0) RSTD[m] = r2;
        }
    }
}
__device__ __forceinline__ void prep_k(bf16_t* PROJ, const float* qk_gain  , const f32x2* cs  , int gw, int NGW, int lane) {
    const float gk0 = qk_gain[128 + 2 * lane], gk1 = qk_gain[128 + 2 * lane + 1];
    for (int m0 = gw; m0 < M; m0 += 4 * NGW) {
        unsigned v[4][2]; f32x2 c_s[4];
#pragma unroll
        for (int i = 0; i < 4; ++i) { const int m = m0 + i * NGW; if (m < M) { const int t = m & (SEQ - 1), pr = t >> 6, pc = t & 63;
            const unsigned* row = (const unsigned*)(PROJ + (size_t)m * NPROJ + C_AK); v[i][0] = row[lane]; v[i][1] = row[64 + lane]; c_s[i] = cs[((lane < 32) ? pr : pc) * 32 + (lane & 31)]; } }
#pragma unroll
        for (int i = 0; i < 4; ++i) { const int m = m0 + i * NGW; if (m < M) { unsigned* row = (unsigned*)(PROJ + (size_t)m * NPROJ + C_AK);
#pragma unroll
            for (int h = 0; h < 2; ++h) { const float x1 = bflo(v[i][h]), x2 = bfhi(v[i][h]);
                const float rstd = 1.0f / sqrtf(wave_sum(x1 * x1 + x2 * x2) * (1.0f / 128.0f) + EPS);
                const float n1 = x1 * rstd * gk0, n2 = x2 * rstd * gk1;
                row[h * 64 + lane] = cvt_pk_bf16(n1 * c_s[i].x - n2 * c_s[i].y, n1 * c_s[i].y + n2 * c_s[i].x); } } }
    }
}
__device__ __forceinline__ void tr_pair(unsigned base, int pitch, int row0, int col0, int lane, s16x4& lo, s16x4& hi) {
    const int g = lane >> 4, i = lane & 15;
    const unsigned addr = base + (unsigned)((row0 + 4 * g + (i >> 2)) * pitch + (col0 + 4 * (i & 3)) * 2);
    asm volatile("ds_read_b64_tr_b16 %0, %1" : "=&v"(lo) : "v"(addr) : "memory");
    asm volatile("ds_read_b64_tr_b16 %0, %1" : "=&v"(hi) : "v"(addr + (unsigned)(16 * pitch)) : "memory");
}
#define TR_JOIN(L, H) ((bf16x8){L[0], L[1], L[2], L[3], H[0], H[1], H[2], H[3]})
__device__ __forceinline__ bf16x8 pack8(const float* x) { u32x4 w; w.x = cvt_pk_bf16(x[0], x[1]); w.y = cvt_pk_bf16(x[2], x[3]); w.z = cvt_pk_bf16(x[4], x[5]); w.w = cvt_pk_bf16(x[6], x[7]); return *reinterpret_cast<bf16x8*>(&w); }
__device__ __forceinline__ void na_unit(const bf16_t* PROJ, bf16_t* OB  , LAS unsigned char* lds, int u) {
    const int tid = opaque_tid(), lane = tid & 63, w = __builtin_amdgcn_readfirstlane(tid >> 6);
    constexpr int PV = 272, O_V = 0, O_RPB = 2 * 64 * PV;
    LAS float* rpbs = (LAS float*)(lds + O_RPB);
    const unsigned lbase = (unsigned)(uintptr_t)lds;
    const int ib = w & 3, vh = w >> 2;
    {
        int lane_o = lane; asm volatile("" : "+v"(lane_o));
        const int g = lane_o >> 4, li = lane_o & 15;
        const int r = u & 31, h = (u >> 5) & 3, b = u >> 7;
        const int rs = min(max(r - 4, 0), 24);
        const int c = 16 * ib + li, cs0 = min(max(c - 8, 0), 48);
        const size_t tq = (size_t)b * SEQ + r * 64 + c;
        bf16x8 qf[4];
#pragma unroll
        for (int ks = 0; ks < 4; ++ks) qf[ks] = *(const bf16x8*)(PROJ + tq * NPROJ + C_BQ + h * 128 + 32 * ks + 8 * g);
        int jbv[4], dcv[4];
#pragma unroll
        for (int rr = 0; rr < 4; ++rr) { const int km = 4 * g + rr; jbv[rr] = (cs0 + 15 - km) >> 4; dcv[rr] = 16 * jbv[rr] + km - c + 15; }
        f32x4 o[4];
#pragma unroll
        for (int vt = 0; vt < 4; ++vt) o[vt] = (f32x4){0.f, 0.f, 0.f, 0.f};
        float m_run = -1e30f, l_run = 0.f;
        const int sr = tid >> 4, sc = (tid & 15) * 8;
        const int jlo = ib > 1 ? ib - 1 : 0, jhi = ib < 2 ? ib + 1 : 3;
        bf16x8 kf[4][4], vr0, vr1;
#define NA_LOADK(kr_) do { const size_t kt_ = (size_t)b * SEQ + (size_t)(rs + (kr_)) * 64; \
            _Pragma("unroll") for (int jb = 0; jb < 4; ++jb) if (jb >= jlo && jb <= jhi) { const bf16_t* kp = PROJ + (kt_ + 16 * jb + li) * NPROJ + C_BK + h * 128 + 8 * g; \
                _Pragma("unroll") for (int ks = 0; ks < 4; ++ks) kf[jb][ks] = *(const bf16x8*)(kp + 32 * ks); } } while (0)
#define NA_LOADV(kr_) do { const size_t kt_ = (size_t)b * SEQ + (size_t)(rs + (kr_)) * 64; \
            vr0 = *(const bf16x8*)(PROJ + (kt_ + sr) * NPROJ + C_BV + h * 128 + sc); vr1 = *(const bf16x8*)(PROJ + (kt_ + sr + 32) * NPROJ + C_BV + h * 128 + sc); } while (0)
        NA_LOADV(0); NA_LOADK(0);
        for (int kr = 0; kr < 8; ++kr) {
            *(LAS bf16x8*)(lds + O_V + (kr & 1) * 64 * PV + sr * PV + sc * 2) = vr0; *(LAS bf16x8*)(lds + O_V + (kr & 1) * 64 * PV + (sr + 32) * PV + sc * 2) = vr1;
            if (kr + 1 < 8) NA_LOADV(kr + 1);
            f32x4 s[4];
#pragma unroll
            for (int jb = 0; jb < 4; ++jb) { s[jb] = (f32x4){0.f, 0.f, 0.f, 0.f};
                if (jb >= jlo && jb <= jhi) {
#pragma unroll
                    for (int ks = 0; ks < 4; ++ks) s[jb] = __builtin_amdgcn_mfma_f32_16x16x32_bf16(kf[jb][ks], qf[ks], s[jb], 0, 0, 0); } }
            if (kr + 1 < 8) NA_LOADK(kr + 1);
            const int dr = rs + kr - r + 7;
            float mx = -1e30f;
#pragma unroll
            for (int rr = 0; rr < 4; ++rr) { const float bias = rpbs[(h * 15 + dr) * 31 + dcv[rr]];
#pragma unroll
                for (int jb = 0; jb < 4; ++jb) { const float v = (jb == jbv[rr]) ? s[jb][rr] * 0.088388347648318440f + bias : -1e30f; s[jb][rr] = v; mx = fmaxf(mx, v); } }
            mx = fmaxf(mx, __shfl_xor(mx, 16)); mx = fmaxf(mx, __shfl_xor(mx, 32));
            const float m_new = fmaxf(m_run, mx), alpha = __expf(m_run - m_new);
            m_run = m_new;
            float ps = 0.f;
#pragma unroll
            for (int jb = 0; jb < 4; ++jb)
#pragma unroll
                for (int rr = 0; rr < 4; ++rr) { const float p = (jb == jbv[rr]) ? __expf(s[jb][rr] - m_new) : 0.f; s[jb][rr] = p; ps += p; }
            l_run = l_run * alpha + ps;
            bf16x8 pfr[2];
#pragma unroll
            for (int ss = 0; ss < 2; ++ss) { const float t[8] = {s[2 * ss][0], s[2 * ss][1], s[2 * ss][2], s[2 * ss][3], s[2 * ss + 1][0], s[2 * ss + 1][1], s[2 * ss + 1][2], s[2 * ss + 1][3]}; pfr[ss] = pack8(t); }
            __syncthreads();
            s16x4 vl[4][2], vhh[4][2];
            {
                const unsigned vbase = lbase + O_V + (unsigned)((kr & 1) * 64 * PV + (4 * g + (li >> 2)) * PV + (64 * vh + 4 * (li & 3)) * 2);
                asm volatile("ds_read_b64_tr_b16 %0, %16 offset:0\n\t"
                         "ds_read_b64_tr_b16 %1, %16 offset:4352\n\t"
                         "ds_read_b64_tr_b16 %2, %16 offset:8704\n\t"
                         "ds_read_b64_tr_b16 %3, %16 offset:13056\n\t"
                         "ds_read_b64_tr_b16 %4, %16 offset:32\n\t"
                         "ds_read_b64_tr_b16 %5, %16 offset:4384\n\t"
                         "ds_read_b64_tr_b16 %6, %16 offset:8736\n\t"
                         "ds_read_b64_tr_b16 %7, %16 offset:13088\n\t"
                         "ds_read_b64_tr_b16 %8, %16 offset:64\n\t"
                         "ds_read_b64_tr_b16 %9, %16 offset:4416\n\t"
                         "ds_read_b64_tr_b16 %10, %16 offset:8768\n\t"
                         "ds_read_b64_tr_b16 %11, %16 offset:13120\n\t"
                         "ds_read_b64_tr_b16 %12, %16 offset:96\n\t"
                         "ds_read_b64_tr_b16 %13, %16 offset:4448\n\t"
                         "ds_read_b64_tr_b16 %14, %16 offset:8800\n\t"
                         "ds_read_b64_tr_b16 %15, %16 offset:13152\n\t"
                         "s_waitcnt lgkmcnt(0)"
                         : "=&v"(vl[0][0]), "=&v"(vhh[0][0]), "=&v"(vl[0][1]), "=&v"(vhh[0][1]), "=&v"(vl[1][0]), "=&v"(vhh[1][0]), "=&v"(vl[1][1]), "=&v"(vhh[1][1]), "=&v"(vl[2][0]), "=&v"(vhh[2][0]), "=&v"(vl[2][1]), "=&v"(vhh[2][1]), "=&v"(vl[3][0]), "=&v"(vhh[3][0]), "=&v"(vl[3][1]), "=&v"(vhh[3][1])
                         : "v"(vbase) : "memory");
            }
            __builtin_amdgcn_sched_barrier(0);
#pragma unroll
            for (int vt = 0; vt < 4; ++vt) { o[vt] = o[vt] * alpha;
#pragma unroll
                for (int ss = 0; ss < 2; ++ss) o[vt] = __builtin_amdgcn_mfma_f32_16x16x32_bf16(TR_JOIN(vl[vt][ss], vhh[vt][ss]), pfr[ss], o[vt], 0, 0, 0); }
        }
#undef NA_LOADK
#undef NA_LOADV
        l_run += __shfl_xor(l_run, 16); l_run += __shfl_xor(l_run, 32);
        const float inv = 1.0f / l_run;
#pragma unroll
        for (int vt = 0; vt < 4; ++vt) { u32x2 ov; ov.x = cvt_pk_bf16(o[vt].x * inv, o[vt].y * inv); ov.y = cvt_pk_bf16(o[vt].z * inv, o[vt].w * inv);
            *(u32x2*)(OB + tq * LDOM + h * 128 + 64 * vh + 16 * vt + 4 * g) = ov; }
        __syncthreads();
    }
}
__device__ __forceinline__ void na_load_bias(const float* rpb, LAS unsigned char* lds) {
    const int tid = opaque_tid(); LAS float* rpbs = (LAS float*)(lds + 2 * 64 * 272);
    __syncthreads();
    for (int i = tid; i < 4 * 15 * 31; i += 512) rpbs[i] = rpb[i];
    __syncthreads();
}
__device__ __forceinline__ float logsig16(float z) { return (fminf(z, 0.f) - __logf(1.0f + __expf(-fabsf(z)))) * (1.0f / 16.0f); }
__device__ __forceinline__ void gla_seq_unit(const bf16_t* PROJ, const float* LR, const float* w_decay  , const float* b_decay  , bf16_t* OFB, bf16_t* OC, const float* onorm,
                                             LAS unsigned char* lds, int b, int h) {
    const int tid = opaque_tid(), lane = tid & 63, w = __builtin_amdgcn_readfirstlane(tid >> 6);
    constexpr int P64 = 144, PV = 272;
    constexpr int O_Q = 0, O_K = 9216, O_KH = 18432, O_V = 27648, O_S = 45056, O_DEC = 63488, O_W2 = 63744;
    const unsigned lbase = (unsigned)(uintptr_t)lds;
    const int ib = w & 3, vh = w >> 2, g = lane >> 4, li = lane & 15;
    LAS float* w2s = (LAS float*)(lds + O_W2);
    LAS float* gns = (LAS float*)(lds + 68608);
    __syncthreads(); if (tid < 128) gns[tid] = onorm[tid];
    LAS float* red = (LAS float*)(lds + 68096);
  for (int dir = 0; dir < 2; ++dir) {
    __syncthreads();
    for (int i = tid; i < 16 * 64; i += 512) w2s[i] = w_decay[dir * 4096 + (i >> 6) * 256 + h * 64 + (i & 63)];
    if (tid < 64) w2s[1024 + tid] = b_decay[dir * 256 + h * 64 + tid];
    for (int i = tid; i < 128 * 72 / 2; i += 512) ((LAS unsigned*)(lds + O_S))[i] = 0u;
    f32x4 S[4];
#pragma unroll
    for (int vt = 0; vt < 4; ++vt) S[vt] = (f32x4){0.f, 0.f, 0.f, 0.f};
    const int dcol = 8 * w;
    const int sr = tid >> 4, sc = (tid & 15) * 8;
    f32x4 lr4[4]; u32x4 qraw, kraw; bf16x8 vst0, vst1;
    u32x2 ofr[4], ogr[4];
#define GLA_LOAD_O(cc_) do { const int c_ = 31 - (cc_); const size_t mi_ = (size_t)b * SEQ + c_ * 64 + 16 * ib + li; \
        _Pragma("unroll") for (int vt = 0; vt < 4; ++vt) { ofr[vt] = *(const u32x2*)(OFB + mi_ * 512 + h * 128 + 64 * vh + 16 * vt + 4 * g); ogr[vt] = *(const u32x2*)(PROJ + mi_ * NPROJ + C_OG + h * 128 + 64 * vh + 16 * vt + 4 * g); } } while (0)
#define GLA_LOAD(cc_) do { const int c_ = dir ? 31 - (cc_) : (cc_); const size_t m0_ = (size_t)b * SEQ + c_ * 64, m_ = m0_ + lane; \
        _Pragma("unroll") for (int j = 0; j < 4; ++j) lr4[j] = ((const f32x4*)(LR + m_ * 32 + dir * 16))[j]; \
        qraw = *(const u32x4*)(PROJ + m_ * NPROJ + C_CQ + h * 64 + dcol); kraw = *(const u32x4*)(PROJ + m_ * NPROJ + C_CK + h * 64 + dcol); \
        vst0 = *(const bf16x8*)(PROJ + (m0_ + sr) * NPROJ + C_CV + h * 128 + sc); vst1 = *(const bf16x8*)(PROJ + (m0_ + sr + 32) * NPROJ + C_CV + h * 128 + sc); } while (0)
#pragma unroll
    for (int vt = 0; vt < 4; ++vt) { ofr[vt] = (u32x2){0u, 0u}; ogr[vt] = (u32x2){0u, 0u}; }
    GLA_LOAD(0);
    if (dir) GLA_LOAD_O(0);
    __syncthreads();
    for (int cc = 0; cc < 32; ++cc) {
        const int c = dir ? 31 - cc : cc; const size_t m0 = (size_t)b * SEQ + c * 64;
        {
            f32x4 z0 = *(const LAS f32x4*)(w2s + 1024 + dcol), z1 = *(const LAS f32x4*)(w2s + 1024 + dcol + 4);
#pragma unroll
            for (int j = 0; j < 4; ++j)
#pragma unroll
                for (int rr = 0; rr < 4; ++rr) { const int r = 4 * j + rr; z0 = z0 + *(const LAS f32x4*)(w2s + r * 64 + dcol) * lr4[j][rr]; z1 = z1 + *(const LAS f32x4*)(w2s + r * 64 + dcol + 4) * lr4[j][rr]; }
            float bs[8];
#pragma unroll
            for (int e = 0; e < 4; ++e) { bs[e] = logsig16(z0[e]); bs[4 + e] = logsig16(z1[e]); }
            if (dir == 0) {
#pragma unroll
                for (int off = 1; off < 64; off <<= 1)
#pragma unroll
                    for (int e = 0; e < 8; ++e) { const float t = __shfl_up(bs[e], off); if (lane >= off) bs[e] += t; }
            } else {
#pragma unroll
                for (int off = 1; off < 64; off <<= 1)
#pragma unroll
                    for (int e = 0; e < 8; ++e) { const float t = __shfl_down(bs[e], off); if (lane + off < 64) bs[e] += t; }
            }
            const float q[8] = {bflo(qraw.x), bfhi(qraw.x), bflo(qraw.y), bfhi(qraw.y), bflo(qraw.z), bfhi(qraw.z), bflo(qraw.w), bfhi(qraw.w)};
            const float k[8] = {bflo(kraw.x), bfhi(kraw.x), bflo(kraw.y), bfhi(kraw.y), bflo(kraw.z), bfhi(kraw.z), bflo(kraw.w), bfhi(kraw.w)};
            float qt[8], kt[8], kh[8], dc[8];
#pragma unroll
            for (int e = 0; e < 8; ++e) { const float be = __shfl(bs[e], dir ? 0 : 63);
                qt[e] = q[e] * 0.125f * __expf(bs[e]); kt[e] = k[e] * __expf(-bs[e]); kh[e] = k[e] * __expf(be - bs[e]); dc[e] = __expf(be); }
            *(LAS bf16x8*)(lds + O_Q + lane * P64 + 16 * w) = pack8(qt); *(LAS bf16x8*)(lds + O_K + lane * P64 + 16 * w) = pack8(kt); *(LAS bf16x8*)(lds + O_KH + lane * P64 + 16 * w) = pack8(kh);
            if (lane == 0) { *(LAS f32x4*)(lds + O_DEC + 4 * dcol) = (f32x4){dc[0], dc[1], dc[2], dc[3]}; *(LAS f32x4*)(lds + O_DEC + 4 * dcol + 16) = (f32x4){dc[4], dc[5], dc[6], dc[7]}; }
            *(LAS bf16x8*)(lds + O_V + sr * PV + sc * 2) = vst0; *(LAS bf16x8*)(lds + O_V + (sr + 32) * PV + sc * 2) = vst1;
        }
        __syncthreads();
        if (cc + 1 < 32) GLA_LOAD(cc + 1);
        const size_t mi = m0 + 16 * ib + li; f32x4 oo[4]; float ss = 0.f;
        {
            bf16x8 qF[2];
#pragma unroll
            for (int ks = 0; ks < 2; ++ks) qF[ks] = *(const LAS bf16x8*)(lds + O_Q + (16 * ib + li) * P64 + (32 * ks + 8 * g) * 2);
            f32x4 P[4];
#pragma unroll
            for (int jb = 0; jb < 4; ++jb) {
                f32x4 a = {0.f, 0.f, 0.f, 0.f};
                const bool need = dir ? (jb >= ib) : (jb <= ib);
                if (need) {
#pragma unroll
                    for (int ks = 0; ks < 2; ++ks) a = __builtin_amdgcn_mfma_f32_16x16x32_bf16(*(const LAS bf16x8*)(lds + O_K + (16 * jb + li) * P64 + (32 * ks + 8 * g) * 2), qF[ks], a, 0, 0, 0); }
#pragma unroll
                for (int r = 0; r < 4; ++r) { const int jl = 4 * g + r;
                    const bool keep = (jb == ib) ? (dir ? (jl >= li) : (jl <= li)) : need;
                    P[jb][r] = keep ? a[r] : 0.f; }
            }
            bf16x8 pfr[2];
#pragma unroll
            for (int s = 0; s < 2; ++s) { const float t[8] = {P[2 * s][0], P[2 * s][1], P[2 * s][2], P[2 * s][3], P[2 * s + 1][0], P[2 * s + 1][1], P[2 * s + 1][2], P[2 * s + 1][3]}; pfr[s] = pack8(t); }
            s16x4 vl[4][2], vhh[4][2], kl[2], kh2[2];
            {
                const unsigned vbase = lbase + O_V + (unsigned)((4 * g + (li >> 2)) * PV + (64 * vh + 4 * (li & 3)) * 2);
                const unsigned kbase = lbase + O_KH + (unsigned)((4 * g + (li >> 2)) * P64 + (16 * ib + 4 * (li & 3)) * 2);
                asm volatile("ds_read_b64_tr_b16 %0, %20 offset:0\n\t"
                         "ds_read_b64_tr_b16 %1, %20 offset:4352\n\t"
                         "ds_read_b64_tr_b16 %2, %20 offset:8704\n\t"
                         "ds_read_b64_tr_b16 %3, %20 offset:13056\n\t"
                         "ds_read_b64_tr_b16 %4, %20 offset:32\n\t"
                         "ds_read_b64_tr_b16 %5, %20 offset:4384\n\t"
                         "ds_read_b64_tr_b16 %6, %20 offset:8736\n\t"
                         "ds_read_b64_tr_b16 %7, %20 offset:13088\n\t"
                         "ds_read_b64_tr_b16 %8, %20 offset:64\n\t"
                         "ds_read_b64_tr_b16 %9, %20 offset:4416\n\t"
                         "ds_read_b64_tr_b16 %10, %20 offset:8768\n\t"
                         "ds_read_b64_tr_b16 %11, %20 offset:13120\n\t"
                         "ds_read_b64_tr_b16 %12, %20 offset:96\n\t"
                         "ds_read_b64_tr_b16 %13, %20 offset:4448\n\t"
                         "ds_read_b64_tr_b16 %14, %20 offset:8800\n\t"
                         "ds_read_b64_tr_b16 %15, %20 offset:13152\n\t"
                         "ds_read_b64_tr_b16 %16, %21 offset:0\n\t"
                         "ds_read_b64_tr_b16 %17, %21 offset:2304\n\t"
                         "ds_read_b64_tr_b16 %18, %21 offset:4608\n\t"
                         "ds_read_b64_tr_b16 %19, %21 offset:6912\n\t"
                         "s_waitcnt lgkmcnt(0)"
                         : "=&v"(vl[0][0]), "=&v"(vhh[0][0]), "=&v"(vl[0][1]), "=&v"(vhh[0][1]), "=&v"(vl[1][0]), "=&v"(vhh[1][0]), "=&v"(vl[1][1]), "=&v"(vhh[1][1]), "=&v"(vl[2][0]), "=&v"(vhh[2][0]), "=&v"(vl[2][1]), "=&v"(vhh[2][1]), "=&v"(vl[3][0]), "=&v"(vhh[3][0]), "=&v"(vl[3][1]), "=&v"(vhh[3][1]), "=&v"(kl[0]), "=&v"(kh2[0]), "=&v"(kl[1]), "=&v"(kh2[1])
                         : "v"(vbase), "v"(kbase) : "memory");
            }
            bf16x8 sfr[4][2];
#pragma unroll
            for (int vt = 0; vt < 4; ++vt)
#pragma unroll
                for (int ks = 0; ks < 2; ++ks) sfr[vt][ks] = *(const LAS bf16x8*)(lds + O_S + (64 * vh + 16 * vt + li) * P64 + (32 * ks + 8 * g) * 2);
            const float dec = *(const LAS float*)(lds + O_DEC + 4 * (16 * ib + li));
            __builtin_amdgcn_sched_barrier(0);
#pragma unroll
            for (int vt = 0; vt < 4; ++vt) {
                const int v0 = 64 * vh + 16 * vt;
                f32x4 o = {0.f, 0.f, 0.f, 0.f};
#pragma unroll
                for (int s = 0; s < 2; ++s) o = __builtin_amdgcn_mfma_f32_16x16x32_bf16(TR_JOIN(vl[vt][s], vhh[vt][s]), pfr[s], o, 0, 0, 0);
#pragma unroll
                for (int ks = 0; ks < 2; ++ks) o = __builtin_amdgcn_mfma_f32_16x16x32_bf16(sfr[vt][ks], qF[ks], o, 0, 0, 0);
                if (dir == 0) { u32x2 ov; ov.x = (unsigned)f2bf(o.x) | ((unsigned)f2bf(o.y) << 16); ov.y = (unsigned)f2bf(o.z) | ((unsigned)f2bf(o.w) << 16);
                    *(u32x2*)(OFB + mi * 512 + h * 128 + v0 + 4 * g) = ov; }
                else { const u32x2 f = ofr[vt];
                    o.x += bflo(f.x); o.y += bfhi(f.x); o.z += bflo(f.y); o.w += bfhi(f.y); oo[vt] = o; ss += (o.x * o.x + o.y * o.y) + (o.z * o.z + o.w * o.w); }
                f32x4 sn = S[vt] * dec;
#pragma unroll
                for (int s = 0; s < 2; ++s) sn = __builtin_amdgcn_mfma_f32_16x16x32_bf16(TR_JOIN(vl[vt][s], vhh[vt][s]), TR_JOIN(kl[s], kh2[s]), sn, 0, 0, 0);
                S[vt] = sn;
            }
        }
        if (dir) { ss += __shfl_xor(ss, 16); ss += __shfl_xor(ss, 32); if (g == 0) red[vh * 64 + 16 * ib + li] = ss; }
        __syncthreads();
        if (dir) {
            const float rstd = 1.0f / sqrtf((red[16 * ib + li] + red[64 + 16 * ib + li]) * (1.0f / 128.0f) + EPS);
#pragma unroll
            for (int vt = 0; vt < 4; ++vt) { const int v0 = 64 * vh + 16 * vt;
                const u32x2 og = ogr[vt]; const f32x4 gn = *(const LAS f32x4*)(gns + v0 + 4 * g);
                u32x2 ov; ov.x = cvt_pk_bf16(oo[vt].x * rstd * gn.x * pg8::silu_f(bflo(og.x)), oo[vt].y * rstd * gn.y * pg8::silu_f(bfhi(og.x)));
                ov.y = cvt_pk_bf16(oo[vt].z * rstd * gn.z * pg8::silu_f(bflo(og.y)), oo[vt].w * rstd * gn.w * pg8::silu_f(bfhi(og.y)));
                *(u32x2*)(OC + mi * LDOM + h * 128 + v0 + 4 * g) = ov; }
            if (cc + 1 < 32) GLA_LOAD_O(cc + 1);
        }
#pragma unroll
        for (int vt = 0; vt < 4; ++vt)
#pragma unroll
            for (int r = 0; r < 4; ++r) *(LAS bf16_t*)(lds + O_S + (64 * vh + 16 * vt + 4 * g + r) * P64 + (16 * ib + li) * 2) = f2bf(S[vt][r]);
    }
    __syncthreads();
  }
#undef GLA_LOAD
#undef GLA_LOAD_O
}
constexpr int NPH = 15;
enum { P_F1A = 0, P_F1B, P_N1, P_M1, P_PREP, P_ATT, P_NA, P_GLA, P_GLC, P_M4, P_M5, P_N2, P_F2A, P_F2B, P_N3 };
constexpr int NGP = 1 + DEPTH * NPH;
struct Args { const float* in[18]; float* out; unsigned char* ws; int gp_lo, gp_hi; };

typedef decltype(__builtin_amdgcn_kernarg_segment_ptr()) kargp_t;
__device__ __forceinline__ unsigned long long karg_q(int byte_off) { kargp_t p_ = __builtin_amdgcn_kernarg_segment_ptr(); asm volatile("" : "+s"(p_));
    return *(const unsigned long long __attribute__((address_space(4)))*)((const char __attribute__((address_space(4)))*)p_ + byte_off); }
__global__ void __launch_bounds__(512, 2) __attribute__((target("no-packed-fp32-ops"))) fwd(Args args) {
    extern __shared__ __attribute__((aligned(16))) unsigned char lds_raw[];
    LAS unsigned char* const lds0 = (LAS unsigned char*)lds_raw;
    const int G0 = gridDim.x, wg0 = blockIdx.x;
#define PENV LAS unsigned char* lds = lds0; int G = G0, wg = wg0; asm volatile("" : "+s"(lds), "+s"(G), "+s"(wg)); const int NGW = G * 8; (void)NGW; (void)lds; (void)wg
    volatile LAS unsigned* MISC = (volatile LAS unsigned*)(lds0 + MISC_OFF);
    volatile LAS unsigned long long* PT = (volatile LAS unsigned long long*)(lds0 + PTAB_OFF);
    { const int t0 = threadIdx.x;
      for (int u = t0; u < (LDS_BYTES - LDSCTL_OFF) / 4; u += 512) ((LAS unsigned*)(lds0 + LDSCTL_OFF))[u] = 0u;
      __syncthreads();
      __syncthreads(); }
#if ONE_LAUNCH
    constexpr int lo = 0, hi = NGP;
#else
    const int lo = args.gp_lo, hi = args.gp_hi;
#endif
    XcdBarrier bar; bar.bar = (unsigned*)(args.ws + WS_CTL) + CW_BAR; bar.x = 0; bar.st = nullptr;
    if (hi - lo > 1) bar = xcd_barrier_setup((unsigned*)(args.ws + WS_CTL) + CW_BAR, MISC + 8);
#define SEAM(gp) do { if ((gp) + 1 < hi) xcd_barrier(bar); } while (0)
#define INP(i) ((const float*)(const GAS float*)karg_q(8 * (i)))
#define WSP() ((unsigned char*)(GAS unsigned char*)karg_q(8 * 19))
#define XP() ((float*)(GAS float*)karg_q(8 * 18))
#define TIDS() PENV; const int tid = opaque_tid(), lane = tid & 63, wave = __builtin_amdgcn_readfirstlane(tid >> 6), gw = wg * 8 + wave; (void)tid; (void)lane; (void)wave; (void)gw

    if (((PHASE_MASK >> 31) & 1u) && lo <= 0 && 0 < hi) {
        TIDS(); unsigned char* ws = WSP(); bf16_t* XB = (bf16_t*)(ws + WS_XN); float* RSTD = (float*)(ws + WS_RSTD);
        LayerW w; w.w_in = INP(3); w.w_bra = INP(10); w.w_brb = INP(11); w.w_brc = INP(12); w.w_out = INP(13); w.f1i = INP(14); w.f1o = INP(15); w.f2i = INP(16); w.f2o = INP(17); w.ng = INP(2);
        if (wg == 0) { f32x2* cs = (f32x2*)(ws + WS_CTL + ROPE_OFF);
            for (int i = tid; i < 2048; i += 512) { const int pos = i >> 5, mi = i & 31; const float inv = powf(10000.0f, -(float)mi / 32.0f); float s, c; sincosf((float)pos * inv, &s, &c); cs[i] = (f32x2){c, s}; } }
        phase_weights(w, ws, lds, gw, NGW, wave, lane);
        const float* xp = INP(0); const float* xs = INP(1);
        for (int m = gw; m < M; m += NGW) {
            const float* src = m < 16 * SEQ ? xp + (size_t)m * D : xs + (size_t)(m - 16 * SEQ) * D;
            const f32x4* xr = (const f32x4*)src + lane; f32x4 x[8]; float s = 0.f;
#pragma unroll
            for (int j = 0; j < 8; ++j) { x[j] = xr[64 * j]; s += (x[j].x * x[j].x + x[j].y * x[j].y) + (x[j].z * x[j].z + x[j].w * x[j].w); }
            u32x2* o8 = (u32x2*)(XB + (size_t)m * D) + lane;
#pragma unroll
            for (int j = 0; j < 8; ++j) { u32x2 wv; wv.x = cvt_pk_bf16(x[j].x, x[j].y); wv.y = cvt_pk_bf16(x[j].z, x[j].w); o8[64 * j] = wv; }
            const float rstd = 1.0f / sqrtf(wave_sum(s) * (1.0f / D) + EPS);
            if (lane == 0) RSTD[m] = rstd;
        }
        SEAM(0);
    }
    for (int l = 0; l < DEPTH; ++l) {
        const int gp0 = 1 + l * NPH;
        if (gp0 + NPH <= lo || gp0 >= hi) continue;
#define IN(p) (((PHASE_MASK >> (p)) & 1u) && lo <= gp0 + (p) && gp0 + (p) < hi)
#define FFN_PAIR(ff, pa, pb) do { \
        if (IN(pa)) { PENV; unsigned char* ws = WSP(); pg8::Gemm g{(const bf16_t*)(ws + WS_XN), (const bf16_t*)(ws + ((ff) ? WS_WF2I : WS_WF1I)), M, 2 * FF, D, D}; pg8::StaticOrder S; S.init(M, 2 * FF, G, wg, WGM_FI); \
            pg8::EpiSwiGLU E{(bf16_t*)(ws + WS_H), (const float*)(ws + WS_RSTD)}; pg8::gemm_phase<pg8::EpiSwiGLU, pg8::StaticOrder, true, true>(lds, g, S, E); if ((DUP_MASK >> (pa)) & 1u) pg8::gemm_phase<pg8::EpiSwiGLU, pg8::StaticOrder, true, true>(lds, g, S, E); SEAM(gp0 + (pa)); } \
        if (IN(pb)) { PENV; unsigned char* ws = WSP(); pg8::Gemm g{(const bf16_t*)(ws + WS_H), (const bf16_t*)(ws + ((ff) ? WS_WF2O : WS_WF1O)), M, D, FF, FF}; pg8::StaticOrder S; S.init(M, D, G, wg, WGM_FO); \
            pg8::EpiBf16Plain E{(bf16_t*)(ws + WS_Y), D}; pg8::gemm_phase<pg8::EpiBf16Plain, pg8::StaticOrder, true, true>(lds, g, S, E); if ((DUP_MASK >> (pb)) & 1u) pg8::gemm_phase<pg8::EpiBf16Plain, pg8::StaticOrder, true, true>(lds, g, S, E); SEAM(gp0 + (pb)); } } while (0)
#define NORM_PHASE(p, ipost, coef, last) do { if (IN(p)) { TIDS(); unsigned char* ws = WSP(); const float* ng = INP(2) + (size_t)l * 6 * D; \
            phase_norm((bf16_t*)(ws + WS_XN), (const bf16_t*)(ws + WS_Y), (float*)(ws + WS_RSTD), (last) ? XP() : nullptr, ng + (ipost) * D, (coef), gw, NGW, lane);

        FFN_PAIR(0, P_F1A, P_F1B);
        NORM_PHASE(P_N1, 1, 0.5f, false) SEAM(gp0 + P_N1); } } while (0);
        if (IN(P_M1)) { PENV;
            unsigned char* ws = WSP();
            pg8::Gemm g{(const bf16_t*)(ws + WS_XN), (const bf16_t*)(ws + WS_WIN), M, NIN_PAD, D, D}; pg8::StaticOrder S; S.init(M, NIN_PAD, G, wg, WGM_M1);
            pg8::EpiProj E{(bf16_t*)(ws + WS_PROJ), (u32x4*)(ws + WS_GATES), (float*)(ws + WS_LR), INP(4) + (size_t)l * 3 * D, (const float*)(ws + WS_RSTD)};
            pg8::gemm_phase<pg8::EpiProj, pg8::StaticOrder, true, true>(lds, g, S, E);
            if ((DUP_MASK >> P_M1) & 1u) pg8::gemm_phase<pg8::EpiProj, pg8::StaticOrder, true, true>(lds, g, S, E);
            SEAM(gp0 + P_M1);
        }
        if (IN(P_ATT)) { PENV;
            unsigned char* ws = WSP(); bf16_t* PROJ = (bf16_t*)(ws + WS_PROJ);
            {
                const int tid_k = opaque_tid(), lane_k = tid_k & 63, gw_k = wg * 8 + __builtin_amdgcn_readfirstlane(tid_k >> 6);
                prep_k(PROJ, INP(5) + (size_t)l * 256, (const f32x2*)(ws + WS_CTL + ROPE_OFF), gw_k, G * 8, lane_k);
                asm volatile("s_waitcnt vmcnt(0)" ::: "memory"); __syncthreads();
                if (threadIdx.x == 0) { __builtin_amdgcn_fence(__ATOMIC_RELEASE, "agent"); asm volatile("s_waitcnt vmcnt(0)" ::: "memory");
                    __hip_atomic_fetch_add((unsigned*)(ws + WS_CTL) + CW_KRDY + 64 * l, 1u, __ATOMIC_RELAXED, __HIP_MEMORY_SCOPE_AGENT); }
            }
            bool k_ready = false;
            const int ngrp = (G % 8 == 0) ? 8 : 1, xg = wg % ngrp, slot = wg / ngrp, per = G / ngrp;
            for (int gu = slot; gu < 96 / ngrp; gu += per) { const int U = xg * (96 / ngrp) + gu;
                gla_seq_unit(PROJ, (const float*)(ws + WS_LR), INP(7) + (size_t)l * 2 * 16 * 256, INP(8) + (size_t)l * 512, (bf16_t*)(ws + WS_OFB), (bf16_t*)(ws + WS_OA) + OM_C, INP(9) + (size_t)l * 128, lds, U >> 2, U & 3); }
            na_load_bias(INP(6) + (size_t)l * 4 * 15 * 31, lds);
            unsigned* head = (unsigned*)(ws + WS_CTL) + CW_Q + (l * 8 + xg) * 64;
            const int n_att = 1536 / ngrp, n_na = 3072 / ngrp;
            LAS unsigned* qslot = (LAS unsigned*)(lds + MISC_OFF + 64);
            for (;;) {
                __syncthreads();
                if (threadIdx.x == 0) *qslot = __hip_atomic_fetch_add(head, 1u, __ATOMIC_RELAXED, __HIP_MEMORY_SCOPE_AGENT);
                __syncthreads();
                const int idx = __builtin_amdgcn_readfirstlane((int)*(volatile LAS unsigned*)qslot);
                if (idx >= n_att * (1 + ATT_DUP) + n_na) break;
                if (idx < n_att * (1 + ATT_DUP)) { const int idx0 = idx; const int idx = idx0 % n_att;
                    const int rnd = idx >> 5, mem = idx & 31, grp = (ngrp == 8) ? rnd * 8 + xg : rnd;
                    const int b = grp >> 1, kvh = grp & 1, h = kvh * 4 + (mem >> 3), qb = mem & 7;
                    const size_t rowq = (size_t)b * SEQ + qb * 256, rowk = (size_t)b * SEQ;
                    bf16_t* Qp = PROJ + rowq * NPROJ + C_AQ + h * 128;
                    if (!k_ready) {
                        if (threadIdx.x == 0) { unsigned* kc = (unsigned*)(ws + WS_CTL) + CW_KRDY + 64 * l; unsigned sp = 0u;
                            while (__hip_atomic_load(kc, __ATOMIC_RELAXED, __HIP_MEMORY_SCOPE_AGENT) < (unsigned)G && ++sp < XB_SPIN_CAP) __builtin_amdgcn_s_sleep(1);
                            __builtin_amdgcn_fence(__ATOMIC_ACQUIRE, "agent"); asm volatile("s_waitcnt vmcnt(0)" ::: "memory"); }
                        __syncthreads(); k_ready = true; }
                    att::attn_dense_body(Qp, PROJ + rowk * NPROJ + C_AK + kvh * 128, PROJ + rowk * NPROJ + C_AV + kvh * 128, (bf16_t*)(ws + WS_OA) + rowq * LDOM + h * 128, SEQ, (char*)lds_raw + 49152, INP(5) + (size_t)l * 256, (const f32x2*)(ws + WS_CTL + ROPE_OFF), qb * 256);
                } else {
                    na_unit(PROJ, (bf16_t*)(ws + WS_OA) + OM_B, lds, xg * n_na + (idx - n_att * (1 + ATT_DUP)));
                }
            }
            SEAM(gp0 + P_GLA);
        }
        if (IN(P_M4)) { PENV;
            unsigned char* ws = WSP();
            pg8::Gemm g{(const bf16_t*)(ws + WS_OA), (const bf16_t*)(ws + WS_WBRA), M, D, LDOM, LDOM}; pg8::StaticOrder S; S.init(M, D, G, wg, WGM_M45);
            pg8::EpiMerge3 E{(const u32x4*)(ws + WS_GATES), (bf16_t*)(ws + WS_MG)};
            pg8::gemm_phase<pg8::EpiMerge3, pg8::StaticOrder, true, true>(lds, g, S, E);
            if ((DUP_MASK >> P_M4) & 1u) pg8::gemm_phase<pg8::EpiMerge3, pg8::StaticOrder, true, true>(lds, g, S, E);
            SEAM(gp0 + P_M4);
        }
        if (IN(P_M5)) { PENV;
            unsigned char* ws = WSP();
            pg8::Gemm g{(const bf16_t*)(ws + WS_MG), (const bf16_t*)(ws + WS_WOUT), M, D, D, D}; pg8::StaticOrder S; S.init(M, D, G, wg, WGM_M45);
            pg8::EpiBf16Plain E{(bf16_t*)(ws + WS_Y), D};
            pg8::gemm_phase<pg8::EpiBf16Plain, pg8::StaticOrder, true, true>(lds, g, S, E);
            if ((DUP_MASK >> P_M5) & 1u) pg8::gemm_phase<pg8::EpiBf16Plain, pg8::StaticOrder, true, true>(lds, g, S, E);
            SEAM(gp0 + P_M5);
        }
        NORM_PHASE(P_N2, 3, 1.0f, false) SEAM(gp0 + P_N2); } } while (0);
        FFN_PAIR(1, P_F2A, P_F2B);
        NORM_PHASE(P_N3, 5, 0.5f, (l + 1 == DEPTH))
            if (l + 1 < DEPTH) { LayerW w; w.w_in = INP(3) + (size_t)(l + 1) * D * NIN; w.w_bra = INP(10) + (size_t)(l + 1) * 1024 * D; w.w_brb = INP(11) + (size_t)(l + 1) * 512 * D; w.w_brc = INP(12) + (size_t)(l + 1) * 512 * D;
                w.w_out = INP(13) + (size_t)(l + 1) * D * D; w.f1i = INP(14) + (size_t)(l + 1) * D * 2 * FF; w.f1o = INP(15) + (size_t)(l + 1) * FF * D; w.f2i = INP(16) + (size_t)(l + 1) * D * 2 * FF; w.f2o = INP(17) + (size_t)(l + 1) * FF * D; w.ng = INP(2) + (size_t)(l + 1) * 6 * D;
                phase_weights(w, ws, lds, gw, NGW, wave, lane); if ((DUP_MASK >> 20) & 1u) phase_weights(w, ws, lds, gw, NGW, wave, lane); }
            SEAM(gp0 + P_N3); } } while (0);
#undef FFN_PAIR
#undef NORM_PHASE
#undef IN
    }
#undef SEAM
}

extern "C" void kernel_launch(void* const* d_in, const int* in_sizes, int n_in, void* d_out, int out_size, void* d_ws, size_t ws_size, hipStream_t stream) {
    static int grid = 0;
    if (grid == 0) {
        if (n_in != 18 || out_size != M * D || ws_size < WS_END) { fprintf(stderr, "kernel_launch: unexpected shapes: n_in %d out %d ws %zu (need %zu)\n", n_in, out_size, ws_size, (size_t)WS_END); grid = -1; return; }
        int dev = 0, cus = 0, per_cu = 0;
        if (hipGetDevice(&dev) != hipSuccess || hipDeviceGetAttribute(&cus, hipDeviceAttributeMultiprocessorCount, dev) != hipSuccess) { grid = -1; return; }
        if (hipFuncSetAttribute((const void*)fwd, hipFuncAttributeMaxDynamicSharedMemorySize, LDS_BYTES) != hipSuccess) { fprintf(stderr, "kernel_launch: hipFuncSetAttribute failed\n"); grid = -1; return; }
        if (hipOccupancyMaxActiveBlocksPerMultiprocessor(&per_cu, (const void*)fwd, 512, LDS_BYTES) != hipSuccess || per_cu < 1) fprintf(stderr, "kernel_launch: occupancy query says %d\n", per_cu);
        (void)hipGetLastError();
        grid = cus;
    }
    if (grid < 0) return;
    (void)hipMemsetAsync((char*)d_ws + WS_CTL, 0, CTL_BYTES, stream);
    Args a{};
    for (int i = 0; i < 18; ++i) a.in[i] = (const float*)d_in[i];
    a.out = (float*)d_out; a.ws = (unsigned char*)d_ws;
#if ONE_LAUNCH
    a.gp_lo = 0; a.gp_hi = NGP;
    hipLaunchKernelGGL(fwd, dim3(grid), dim3(512), LDS_BYTES, stream, a);
#else
    for (int gp = 0; gp < NGP; ++gp) { a.gp_lo = gp; a.gp_hi = gp + 1; hipLaunchKernelGGL(fwd, dim3(grid), dim3(512), LDS_BYTES, stream, a); }
#endif
    const hipError_t le = hipPeekAtLastError();
    if (le != hipSuccess) fprintf(stderr, "kernel_launch: launch failed: %s\n", hipGetErrorName(le));
}
```

```cpp
#include <hip/hip_runtime.h>
#include <cstdio>
#include <cstdint>
__device__ __forceinline__ void wg_sync() { __builtin_amdgcn_fence(__ATOMIC_RELEASE, "workgroup"); __builtin_amdgcn_s_barrier(); __builtin_amdgcn_fence(__ATOMIC_ACQUIRE, "workgroup"); }
#define __syncthreads() wg_sync()

#ifndef ONE_LAUNCH
#define ONE_LAUNCH 1
#endif
#ifndef WGM_FI
#define WGM_FI 4
#endif
#ifndef WGM_FO
#define WGM_FO 2
#endif
#ifndef WGM_M1
#define WGM_M1 4
#endif
#ifndef WGM_M45
#define WGM_M45 4
#endif
#ifndef ATT_DUP
#define ATT_DUP 0
#endif
#ifndef DUP_MASK
#define DUP_MASK 0u
#endif
#ifndef PHASE_MASK
#define PHASE_MASK 0xFFFFFFFFu
#endif

#define GAS __attribute__((address_space(1)))
#define LAS __attribute__((address_space(3)))
typedef unsigned short bf16_t;
typedef short bf16x8 __attribute__((ext_vector_type(8)));
typedef short s16x4 __attribute__((ext_vector_type(4)));
typedef float f32x4 __attribute__((ext_vector_type(4)));
typedef float f32x2 __attribute__((ext_vector_type(2)));
typedef float f32x16 __attribute__((ext_vector_type(16)));
typedef unsigned u32x4 __attribute__((ext_vector_type(4)));
typedef unsigned u32x2 __attribute__((ext_vector_type(2)));

constexpr int M = 49152;
constexpr int SEQ = 2048, NSEQ = 24;
constexpr int D = 2048, FF = 5632, DEPTH = 4;
constexpr int NPROJ = 4608;
constexpr int NGATE = 6144;
constexpr int NIN = 10784, NIN_PAD = 11008;
constexpr int C_AQ = 0, C_AK = 1024, C_AV = 1280, C_BQ = 1536, C_BK = 2048, C_BV = 2560, C_CQ = 3072, C_CK = 3328, C_CV = 3584, C_OG = 4096;
constexpr int C_OC = 3072;
constexpr float EPS = 1e-6f;

constexpr size_t MiB = 1u << 20;
constexpr size_t WS_CTL = 0, CTL_BYTES = 1 * MiB;
constexpr size_t WS_WIN = 2 * MiB;
constexpr size_t WS_WF1I = 45 * MiB;
constexpr size_t WS_WF1O = 89 * MiB;
constexpr size_t WS_WF2I = 111 * MiB;
constexpr size_t WS_WF2O = 155 * MiB;
constexpr size_t WS_WBRA = 177 * MiB;
constexpr size_t WS_WBRB = 181 * MiB;
constexpr size_t WS_WBRC = 183 * MiB;
constexpr size_t WS_WOUT = 185 * MiB;
constexpr size_t WS_XN = 193 * MiB;
constexpr size_t WS_BIG = 385 * MiB;
constexpr size_t WS_PROJ = WS_BIG;
constexpr size_t WS_GATES = WS_BIG + 432 * MiB;
constexpr size_t WS_LR = WS_BIG + 1008 * MiB;
constexpr size_t WS_H = WS_BIG;
constexpr size_t WS_Y = WS_BIG + 528 * MiB;
constexpr size_t WS_OFB = WS_BIG + 1014 * MiB;
constexpr size_t WS_MG = WS_OFB + 48 * MiB;
constexpr size_t WS_RSTD = WS_MG + 192 * MiB;
constexpr size_t WS_OA = WS_RSTD + 1 * MiB;
constexpr int LDOM = 2048, OM_B = 1024, OM_C = 1536;
constexpr size_t WS_END = WS_OA + 192 * MiB;
constexpr int CW_Q = 32768;
static_assert(WS_Y + (size_t)M * D * 4 <= WS_LR, "Y inside GATES region");
constexpr int CW_BAR = 4096;
constexpr int CW_KRDY = 49152;
constexpr size_t ROPE_OFF = 524288;

__device__ __forceinline__ unsigned cvt_pk_bf16(float lo, float hi) { unsigned r; asm volatile("v_cvt_pk_bf16_f32 %0, %1, %2" : "=v"(r) : "v"(lo), "v"(hi)); return r; }
__device__ __forceinline__ float bflo(unsigned w) { return __uint_as_float(w << 16); }
__device__ __forceinline__ float bfhi(unsigned w) { return __uint_as_float(w & 0xffff0000u); }
__device__ __forceinline__ float bf2f(bf16_t v) { return __uint_as_float(((unsigned)v) << 16); }
__device__ __forceinline__ bf16_t f2bf(float f) { unsigned u = __float_as_uint(f); return (bf16_t)((u + 0x7fffu + ((u >> 16) & 1u)) >> 16); }
template <int CTRL> __device__ __forceinline__ float dpp_f(float v) { return __int_as_float(__builtin_amdgcn_update_dpp(0, __float_as_int(v), CTRL, 0xF, 0xF, true)); }
__device__ __forceinline__ float wave_sum(float v) {
    v += dpp_f<0xB1>(v); v += dpp_f<0x4E>(v); v += dpp_f<0x141>(v); v += dpp_f<0x140>(v);
    const int b = __float_as_int(v);
    return (__int_as_float(__builtin_amdgcn_readlane(b, 0)) + __int_as_float(__builtin_amdgcn_readlane(b, 16))) + (__int_as_float(__builtin_amdgcn_readlane(b, 32)) + __int_as_float(__builtin_amdgcn_readlane(b, 48)));
}
__device__ __forceinline__ float wave_max(float v) {
#pragma unroll
    for (int o = 1; o < 64; o <<= 1) v = fmaxf(v, __shfl_xor(v, o));
    return v;
}
__device__ __forceinline__ int opaque_tid() { int t = threadIdx.x; asm volatile("" : "+v"(t)); return t; }
__device__ __forceinline__ unsigned char* opq(unsigned char* p) { asm volatile("" : "+s"(p)); return p; }
__device__ __forceinline__ const float* lds_ptr(volatile LAS unsigned long long* tab, int i) { const unsigned long long v = tab[i];
    const unsigned lo = __builtin_amdgcn_readfirstlane((unsigned)v), hi = __builtin_amdgcn_readfirstlane((unsigned)(v >> 32)); return (const float*)(((unsigned long long)hi << 32) | lo); }
#define LDS_WAIT() asm volatile("s_waitcnt lgkmcnt(0)" ::: "memory")
#define VM_WAIT() asm volatile("s_waitcnt vmcnt(0)" ::: "memory")

namespace pg8 {
constexpr int BM = 256, BK = 64, HALF = 128, HTB = HALF * BK * 2, STAGE_BYTES = 8 * HTB, NXCD = 8;
__host__ __device__ __forceinline__ int lds_byte(int r, int c) { const int st = (r >> 4) * 2 + (c >> 5), rr = r & 15, cc = c & 31, ob = rr * 64 + cc * 2; return st * 1024 + (ob ^ (((ob >> 9) & 1) << 5)); }
__host__ __device__ __forceinline__ void stage_rc(int b, int& R, int& C) { const int st = b / 1024, sb = b % 1024, swz = sb ^ (((sb >> 9) & 1) << 5); R = (st >> 1) * 16 + swz / 64; C = (st & 1) * 32 + (swz % 64) / 2; }
__host__ __device__ __forceinline__ int perm32(int rho) { const int n = rho >> 4, i = rho & 15; return 8 * (i >> 2) + 4 * n + (i & 3); }

struct Unit { int pm, pn; };
struct Gemm { const bf16_t* A; const bf16_t* Bt; int M, N, K, lda; };

struct StaticOrder {
    int nM, nN, nwg, G, c, WGM;
    __host__ __device__ __forceinline__ void init(int M_, int N_, int G_, int c_, int wgm_ = 4) { nM = M_ / BM; nN = N_ / BM; nwg = nM * nN; G = G_; c = c_; WGM = wgm_; }
    __host__ __device__ bool next(int i, Unit& u) const {
        const long L = (long)i * G + c; if (L >= nwg) return false;
        int wgid = (int)L; { const int q = nwg / NXCD, r = nwg % NXCD, xcd = wgid % NXCD, off = wgid / NXCD; wgid = (xcd < r ? xcd * (q + 1) : r * (q + 1) + (xcd - r) * q) + off; }
        const int nig = WGM * nN, gid = wgid / nig, fm = gid * WGM, gsz = (nM - fm) < WGM ? (nM - fm) : WGM;
        u.pm = fm + ((wgid % nig) % gsz); u.pn = (wgid % nig) / gsz; return true;
    }
    __device__ __forceinline__ void a_ready(const Unit&) const {}
    __device__ __forceinline__ void done(const Unit&) const {}
};

struct EpiF32 {
    static constexpr bool PERM = false, AFTER_DRAIN = false, HAS_MID = false, USES_RSTD = false;
    float* C; int ldc;
    __device__ __forceinline__ void operator()(const f32x4 (&acc)[2][2][4][2], const Unit& u, int wr, int wc, int fr, int fq, const LAS float* rsl) const {
        const int row0 = u.pm * BM + wr * 64 + fr, col0 = u.pn * BM + wc * 32 + 4 * fq;
#pragma unroll
        for (int ai = 0; ai < 2; ++ai)
#pragma unroll
            for (int m = 0; m < 4; ++m) { float* rowp = C + (size_t)(row0 + ai * HALF + m * 16) * ldc + col0;
#pragma unroll
                for (int bj = 0; bj < 2; ++bj)
#pragma unroll
                    for (int n = 0; n < 2; ++n) *(f32x4*)(rowp + bj * HALF + n * 16) = acc[ai][bj][m][n]; }
    }
};
struct EpiBf16Plain {
    static constexpr bool PERM = true, AFTER_DRAIN = false, HAS_MID = false, USES_RSTD = false;
    bf16_t* C; int ldc;
    __device__ __forceinline__ void operator()(const f32x4 (&acc)[2][2][4][2], const Unit& u, int wr, int wc, int fr, int fq, const LAS float* rsl) const {
        const int row0 = u.pm * BM + wr * 64 + fr, col0 = u.pn * BM + wc * 32 + 8 * fq;
#pragma unroll
        for (int ai = 0; ai < 2; ++ai)
#pragma unroll
            for (int m = 0; m < 4; ++m) { bf16_t* p = C + (size_t)(row0 + ai * HALF + m * 16) * ldc + col0;
#pragma unroll
                for (int bj = 0; bj < 2; ++bj) { const f32x4 v0 = acc[ai][bj][m][0], v1 = acc[ai][bj][m][1];
                    u32x4 w; w.x = cvt_pk_bf16(v0[0], v0[1]); w.y = cvt_pk_bf16(v0[2], v0[3]); w.z = cvt_pk_bf16(v1[0], v1[1]); w.w = cvt_pk_bf16(v1[2], v1[3]);
                    *(u32x4*)(p + bj * HALF) = w; } }
    }
};
__device__ __forceinline__ float silu_f(float g) { return g * __builtin_amdgcn_rcpf(1.0f + __builtin_amdgcn_exp2f(-1.4426950408889634f * g)); }
__device__ __forceinline__ float sigmoid_f(float g) { return __builtin_amdgcn_rcpf(1.0f + __builtin_amdgcn_exp2f(-1.4426950408889634f * g)); }
__device__ __forceinline__ float swiglu1(float a, float b, float nrs, float irs2) { const float e = __builtin_amdgcn_exp2f(a * nrs); return (a * b) * __builtin_amdgcn_rcpf(__builtin_fmaf(e, irs2, irs2)); }
struct EpiSwiGLU {
    static constexpr bool PERM = true, AFTER_DRAIN = false, HAS_MID = false, USES_RSTD = true;
    bf16_t* H; const float* rstd;
    __device__ __forceinline__ void operator()(const f32x4 (&acc)[2][2][4][2], const Unit& u, int wr, int wc, int fr, int fq, const LAS float* rsl) const {
        const int row0 = u.pm * BM + wr * 64 + fr, col0 = u.pn * HALF + wc * 32 + 8 * fq;
#pragma unroll
        for (int ai = 0; ai < 2; ++ai)
#pragma unroll
            for (int m = 0; m < 4; ++m) { bf16_t* p = H + (size_t)(row0 + ai * HALF + m * 16) * FF + col0; const float rs = rsl[wr * 64 + fr + ai * HALF + m * 16];
                const float nrs = -1.4426950408889634f * rs, irs2 = __builtin_amdgcn_rcpf(rs * rs);
                const f32x4 a0 = acc[ai][0][m][0], a1 = acc[ai][0][m][1], b0 = acc[ai][1][m][0], b1 = acc[ai][1][m][1];
                float e[8], pr[8];
#pragma unroll
                for (int i = 0; i < 4; ++i) { e[i] = a0[i] * nrs; e[4 + i] = a1[i] * nrs; }
#pragma unroll
                for (int i = 0; i < 8; ++i) e[i] = __builtin_amdgcn_exp2f(e[i]);
#pragma unroll
                for (int i = 0; i < 4; ++i) { pr[i] = a0[i] * b0[i]; pr[4 + i] = a1[i] * b1[i]; }
#pragma unroll
                for (int i = 0; i < 8; ++i) e[i] = __builtin_fmaf(e[i], irs2, irs2);
#pragma unroll
                for (int i = 0; i < 8; ++i) e[i] = __builtin_amdgcn_rcpf(e[i]);
#pragma unroll
                for (int i = 0; i < 8; ++i) pr[i] *= e[i];
                u32x4 w; w.x = cvt_pk_bf16(pr[0], pr[1]); w.y = cvt_pk_bf16(pr[2], pr[3]); w.z = cvt_pk_bf16(pr[4], pr[5]); w.w = cvt_pk_bf16(pr[6], pr[7]);
                *(u32x4*)p = w; }
    }
};
__device__ __forceinline__ float gate_k(float a, float nrs, float nb) { const float e = __builtin_amdgcn_exp2f(__builtin_fmaf(a, nrs, nb));
    return fmaxf(__builtin_rintf(__builtin_amdgcn_rcpf(__builtin_fmaf(e, 1.0f / 255.0f, 1.0f / 255.0f))), 1.0f); }
__device__ __forceinline__ unsigned gate_q4(const f32x4 a, float nrs, const f32x4 nb) { unsigned w = __builtin_amdgcn_cvt_pk_u8_f32(gate_k(a[0], nrs, nb[0]), 0u, 0u); w = __builtin_amdgcn_cvt_pk_u8_f32(gate_k(a[1], nrs, nb[1]), 1u, w);
    w = __builtin_amdgcn_cvt_pk_u8_f32(gate_k(a[2], nrs, nb[2]), 2u, w); return __builtin_amdgcn_cvt_pk_u8_f32(gate_k(a[3], nrs, nb[3]), 3u, w); }
__device__ __forceinline__ f32x4 ub4(unsigned w) { return (f32x4){(float)(w & 0xffu), (float)((w >> 8) & 0xffu), (float)((w >> 16) & 0xffu), (float)(w >> 24)}; }
__device__ __forceinline__ f32x4 rcp4(const f32x4 v) { return (f32x4){__builtin_amdgcn_rcpf(v[0]), __builtin_amdgcn_rcpf(v[1]), __builtin_amdgcn_rcpf(v[2]), __builtin_amdgcn_rcpf(v[3])}; }
struct EpiProj {
    static constexpr bool PERM = true, AFTER_DRAIN = false, HAS_MID = false, USES_RSTD = true;
    bf16_t* PROJ; u32x4* GQ; float* LR; const float* gbias; const float* rstd;
    __device__ __forceinline__ void operator()(const f32x4 (&acc)[2][2][4][2], const Unit& u, int wr, int wc, int fr, int fq, const LAS float* rsl) const {
        const int row0 = u.pm * BM + wr * 64 + fr;
        if (u.pn < 18) {
            const int col0 = u.pn * BM + wc * 32 + 8 * fq;
#pragma unroll
            for (int ai = 0; ai < 2; ++ai)
#pragma unroll
                for (int m = 0; m < 4; ++m) { bf16_t* p = PROJ + (size_t)(row0 + ai * HALF + m * 16) * NPROJ + col0; const float rs = rsl[wr * 64 + fr + ai * HALF + m * 16];
#pragma unroll
                    for (int bj = 0; bj < 2; ++bj) { const f32x4 v0 = acc[ai][bj][m][0] * rs, v1 = acc[ai][bj][m][1] * rs;
                        u32x4 w; w.x = cvt_pk_bf16(v0[0], v0[1]); w.y = cvt_pk_bf16(v0[2], v0[3]); w.z = cvt_pk_bf16(v1[0], v1[1]); w.w = cvt_pk_bf16(v1[2], v1[3]);
                        *(u32x4*)(p + bj * HALF) = w; } }
        } else if (u.pn < 42) {
            const int gt = u.pn - 18, col0 = gt * BM + wc * 32 + 8 * fq;
            constexpr float NL2E = -1.4426950408889634f;
            const f32x4 b00 = *(const f32x4*)(gbias + col0) * NL2E, b01 = *(const f32x4*)(gbias + col0 + 4) * NL2E, b10 = *(const f32x4*)(gbias + col0 + HALF) * NL2E, b11 = *(const f32x4*)(gbias + col0 + HALF + 4) * NL2E;
            u32x4* gq = GQ + ((size_t)((gt >> 3) * (M / BM) + u.pm) * 8 + (gt & 7)) * 4096 + (wr * 4 + wc) * 512 + (fq * 16 + fr);
#pragma unroll
            for (int ai = 0; ai < 2; ++ai)
#pragma unroll
                for (int m = 0; m < 4; ++m) { const float nrs = NL2E * rsl[wr * 64 + fr + ai * HALF + m * 16];
                    float k[16];
#pragma unroll
                    for (int i = 0; i < 4; ++i) { k[i] = __builtin_fmaf(acc[ai][0][m][0][i], nrs, b00[i]); k[4 + i] = __builtin_fmaf(acc[ai][0][m][1][i], nrs, b01[i]);
                        k[8 + i] = __builtin_fmaf(acc[ai][1][m][0][i], nrs, b10[i]); k[12 + i] = __builtin_fmaf(acc[ai][1][m][1][i], nrs, b11[i]); }
#pragma unroll
                    for (int i = 0; i < 16; ++i) k[i] = __builtin_amdgcn_exp2f(k[i]);
#pragma unroll
                    for (int i = 0; i < 16; ++i) k[i] = __builtin_fmaf(k[i], 1.0f / 255.0f, 1.0f / 255.0f);
#pragma unroll
                    for (int i = 0; i < 16; ++i) k[i] = __builtin_amdgcn_rcpf(k[i]);
#pragma unroll
                    for (int i = 0; i < 16; ++i) k[i] = fmaxf(__builtin_rintf(k[i]), 1.0f);
                    u32x4 w;
                    w.x = __builtin_amdgcn_cvt_pk_u8_f32(k[3], 3u, __builtin_amdgcn_cvt_pk_u8_f32(k[2], 2u, __builtin_amdgcn_cvt_pk_u8_f32(k[1], 1u, __builtin_amdgcn_cvt_pk_u8_f32(k[0], 0u, 0u))));
                    w.y = __builtin_amdgcn_cvt_pk_u8_f32(k[7], 3u, __builtin_amdgcn_cvt_pk_u8_f32(k[6], 2u, __builtin_amdgcn_cvt_pk_u8_f32(k[5], 1u, __builtin_amdgcn_cvt_pk_u8_f32(k[4], 0u, 0u))));
                    w.z = __builtin_amdgcn_cvt_pk_u8_f32(k[11], 3u, __builtin_amdgcn_cvt_pk_u8_f32(k[10], 2u, __builtin_amdgcn_cvt_pk_u8_f32(k[9], 1u, __builtin_amdgcn_cvt_pk_u8_f32(k[8], 0u, 0u))));
                    w.w = __builtin_amdgcn_cvt_pk_u8_f32(k[15], 3u, __builtin_amdgcn_cvt_pk_u8_f32(k[14], 2u, __builtin_amdgcn_cvt_pk_u8_f32(k[13], 1u, __builtin_amdgcn_cvt_pk_u8_f32(k[12], 0u, 0u))));
                    gq[(ai * 4 + m) * 64] = w; }
        } else {
            if (wc == 0) {
#pragma unroll
                for (int ai = 0; ai < 2; ++ai)
#pragma unroll
                    for (int m = 0; m < 4; ++m) { float* p = LR + (size_t)(row0 + ai * HALF + m * 16) * 32 + 8 * fq; const float rs = rsl[wr * 64 + fr + ai * HALF + m * 16];
                        *(f32x4*)p = acc[ai][0][m][0] * rs; *(f32x4*)(p + 4) = acc[ai][0][m][1] * rs; }
            }
        }
    }
};
struct EpiMerge3 {
    static constexpr bool PERM = true, AFTER_DRAIN = false, HAS_MID = true, USES_RSTD = false;
    static constexpr int MID0 = 1024 / BK, MID1 = 1536 / BK;
    static constexpr size_t GSTRIDE = (size_t)(M / BM) * 8 * 4096;
    const u32x4* GQ; bf16_t* MG;
    __device__ __forceinline__ void mid(f32x4 (&acc)[2][2][4][2], const Unit& u, int seg, int wr, int wc, int fr, int fq) const {
        const u32x4* gp = GQ + (size_t)seg * GSTRIDE + ((size_t)u.pm * 8 + u.pn) * 4096 + (wr * 4 + wc) * 512 + (fq * 16 + fr);
        u32x4 gn[8], gd[8];
#pragma unroll
        for (int j = 0; j < 8; ++j) { gn[j] = gp[j * 64]; gd[j] = gp[GSTRIDE + j * 64]; }
#pragma unroll
        for (int j = 0; j < 8; ++j) { const int ai = j >> 2, m = j & 3;
            acc[ai][0][m][0] = acc[ai][0][m][0] * (ub4(gn[j].x) * rcp4(ub4(gd[j].x))); acc[ai][0][m][1] = acc[ai][0][m][1] * (ub4(gn[j].y) * rcp4(ub4(gd[j].y)));
            acc[ai][1][m][0] = acc[ai][1][m][0] * (ub4(gn[j].z) * rcp4(ub4(gd[j].z))); acc[ai][1][m][1] = acc[ai][1][m][1] * (ub4(gn[j].w) * rcp4(ub4(gd[j].w))); }
    }
    __device__ __forceinline__ void operator()(const f32x4 (&acc)[2][2][4][2], const Unit& u, int wr, int wc, int fr, int fq, const LAS float* rsl) const {
        const int row0 = u.pm * BM + wr * 64 + fr, col0 = u.pn * BM + wc * 32 + 8 * fq;
        const u32x4* gp = GQ + 2 * GSTRIDE + ((size_t)u.pm * 8 + u.pn) * 4096 + (wr * 4 + wc) * 512 + (fq * 16 + fr);
        u32x4 gc[8];
#pragma unroll
        for (int j = 0; j < 8; ++j) gc[j] = gp[j * 64];
        constexpr float S = 1.0f / 255.0f;
#pragma unroll
        for (int j = 0; j < 8; ++j) { const int ai = j >> 2, m = j & 3; bf16_t* p = MG + (size_t)(row0 + ai * HALF + m * 16) * D + col0;
            const f32x4 v0 = acc[ai][0][m][0] * (ub4(gc[j].x) * S), v1 = acc[ai][0][m][1] * (ub4(gc[j].y) * S), v2 = acc[ai][1][m][0] * (ub4(gc[j].z) * S), v3 = acc[ai][1][m][1] * (ub4(gc[j].w) * S);
            u32x4 w; w.x = cvt_pk_bf16(v0[0], v0[1]); w.y = cvt_pk_bf16(v0[2], v0[3]); w.z = cvt_pk_bf16(v1[0], v1[1]); w.w = cvt_pk_bf16(v1[2], v1[3]); *(u32x4*)p = w;
            w.x = cvt_pk_bf16(v2[0], v2[1]); w.y = cvt_pk_bf16(v2[2], v2[3]); w.z = cvt_pk_bf16(v3[0], v3[1]); w.w = cvt_pk_bf16(v3[2], v3[3]); *(u32x4*)(p + HALF) = w; }
    }
};

template <class Epi, class Sched, bool ALIGN_EPI = false, bool SP2 = false>
__device__ __forceinline__ void gemm_phase(LAS unsigned char* lds, const Gemm g, const Sched& S, const Epi& E) {
    const int tid = opaque_tid(), wid = __builtin_amdgcn_readfirstlane(tid >> 6), lane = tid & 63, wr = wid >> 2, wc = wid & 3, fr = lane & 15, fq = lane >> 4;
    const int K = g.K, nt = K / BK, lda = g.lda;
    unsigned voffA[2], voffB[2];
#pragma unroll
    for (int i = 0; i < 2; ++i) { int R, C; stage_rc(tid * 16 + i * 8192, R, C); const int Rb = Epi::PERM ? ((R & ~31) + perm32(R & 31)) : R;
        voffA[i] = (unsigned)(R * lda + C) * 2u; voffB[i] = (unsigned)(Rb * K + C) * 2u; }
    const unsigned kstep = (unsigned)(BK * 2);
    const unsigned hstepA = (unsigned)HALF * (unsigned)lda * 2u, hstepB = (unsigned)HALF * (unsigned)K * 2u;
    const unsigned tstepA = 2u * hstepA, tstepB = 2u * hstepB;
    const unsigned ldsw = (unsigned)wid * 1024u;
    const int aoff = lds_byte(wr * 64 + fr, fq * 8), boff = lds_byte(wc * 32 + fr, fq * 8);
    const char* const baseA = (const char*)g.A; const char* const baseB = (const char*)g.Bt;
#define PG8_SA(b, h) (((b) * 2 + (h)) * HTB)
#define PG8_SB(b, h) ((4 + (b) * 2 + (h)) * HTB)
#define PG8_STAGE(bufoff, gbase, goff, voff) do { _Pragma("unroll") for (int _i = 0; _i < 2; ++_i) \
        __builtin_amdgcn_global_load_lds((const unsigned*)((gbase) + (size_t)(unsigned)((goff) + (voff)[_i])), (LAS unsigned*)(lds + (bufoff) + ldsw + _i * 8192), 16, 0, 0); } while (0)
#define PG8_LDA(dst, b, h) do { _Pragma("unroll") for (int m = 0; m < 4; ++m) _Pragma("unroll") for (int k = 0; k < 2; ++k) dst[m][k] = *(const LAS bf16x8*)(lds + PG8_SA(b, h) + aoff + m * 2048 + k * 1024); } while (0)
#define PG8_LDB(dst, b, h) do { _Pragma("unroll") for (int n = 0; n < 2; ++n) _Pragma("unroll") for (int k = 0; k < 2; ++k) dst[n][k] = *(const LAS bf16x8*)(lds + PG8_SB(b, h) + boff + n * 2048 + k * 1024); } while (0)
#define PG8_MMA(ai, bj, At, Bt) do { __builtin_amdgcn_s_setprio(1); _Pragma("unroll") for (int m = 0; m < 4; ++m) _Pragma("unroll") for (int n = 0; n < 2; ++n) _Pragma("unroll") for (int k = 0; k < 2; ++k) \
        acc[ai][bj][m][n] = __builtin_amdgcn_mfma_f32_16x16x32_bf16(Bt[n][k], At[m][k], acc[ai][bj][m][n], 0, 0, 0); __builtin_amdgcn_s_setprio(0); } while (0)
#define PG8_WAIT_V(n) asm volatile("s_waitcnt vmcnt(" #n ")" ::: "memory")
#define PG8_WAIT_L(n) asm volatile("s_waitcnt lgkmcnt(" #n ")" ::: "memory")
#define PG8_BAR __builtin_amdgcn_s_barrier()
#define PG8_SCHED __builtin_amdgcn_sched_barrier(0)
    Unit cur, nxt; int ui = 0;
    if (!S.next(0, cur)) return;
    constexpr int RS_OFF = 131072 + 8192;
#define PG8_RSTD(u_, slot_) do { if constexpr (Epi::USES_RSTD) { if (wid == 0) __builtin_amdgcn_global_load_lds((const unsigned*)(E.rstd + (size_t)(u_).pm * BM + lane * 4), (LAS unsigned*)(lds + RS_OFF + (slot_) * 1024), 16, 0, 0); } } while (0)
    PG8_RSTD(cur, 0);
    f32x4 acc[2][2][4][2];
#pragma unroll
    for (int a = 0; a < 2; ++a)
#pragma unroll
        for (int b = 0; b < 2; ++b)
#pragma unroll
            for (int m = 0; m < 4; ++m)
#pragma unroll
                for (int n = 0; n < 2; ++n) acc[a][b][m][n] = (f32x4){0.f, 0.f, 0.f, 0.f};
    bf16x8 At[4][2], B0[2][2], B1[2][2];
    unsigned cA = (unsigned)cur.pm * tstepA, cB = (unsigned)cur.pn * tstepB;
    S.a_ready(cur);
    if constexpr (SP2) {
        PG8_STAGE(PG8_SB(0, 0), baseB, cB, voffB); PG8_STAGE(PG8_SB(0, 1), baseB, cB + hstepB, voffB); PG8_STAGE(PG8_SA(0, 0), baseA, cA, voffA); PG8_STAGE(PG8_SA(0, 1), baseA, cA + hstepA, voffA);
        if (wr == 1) PG8_BAR;
        PG8_WAIT_V(2); PG8_BAR;
        PG8_STAGE(PG8_SB(1, 0), baseB, cB + kstep, voffB); PG8_STAGE(PG8_SA(1, 0), baseA, cA + kstep, voffA); PG8_STAGE(PG8_SB(1, 1), baseB, cB + hstepB + kstep, voffB);
        PG8_WAIT_V(6); PG8_BAR;
    } else {
        PG8_STAGE(PG8_SB(0, 0), baseB, cB, voffB); PG8_STAGE(PG8_SA(0, 0), baseA, cA, voffA); PG8_STAGE(PG8_SB(0, 1), baseB, cB + hstepB, voffB); PG8_STAGE(PG8_SA(0, 1), baseA, cA + hstepA, voffA);
        if (wr == 1) PG8_BAR;
        PG8_WAIT_V(4); PG8_BAR;
        PG8_STAGE(PG8_SB(1, 0), baseB, cB + kstep, voffB); PG8_STAGE(PG8_SA(1, 0), baseA, cA + kstep, voffA); PG8_STAGE(PG8_SB(1, 1), baseB, cB + hstepB + kstep, voffB);
        PG8_WAIT_V(6); PG8_BAR;
    }
    for (;;) {
        const bool has_next = S.next(ui + 1, nxt);
        const unsigned nA = has_next ? (unsigned)nxt.pm * tstepA : cA, nB = has_next ? (unsigned)nxt.pn * tstepB : cB;
        for (int t = 0; t < nt; t += 2) {
            const bool last = (t == nt - 2);
            if constexpr (Epi::HAS_MID) { if (t == Epi::MID0 || t == Epi::MID1) E.mid(acc, cur, t == Epi::MID0 ? 0 : 1, wr, wc, fr, fq); }
            const unsigned a1 = cA + (unsigned)(t + 1) * kstep;
            const unsigned a2 = last ? nA : cA + (unsigned)(t + 2) * kstep, b2 = last ? nB : cB + (unsigned)(t + 2) * kstep;
            const unsigned a3 = a2 + kstep, b3 = b2 + kstep;
            if (last && has_next) S.a_ready(nxt);
            if constexpr (SP2) {
            PG8_LDB(B0, 0, 0); PG8_LDB(B1, 0, 1); PG8_SCHED; PG8_LDA(At, 0, 0); PG8_STAGE(PG8_SA(1, 1), baseA, a1 + hstepA, voffA);
            PG8_WAIT_V(8); PG8_WAIT_L(0); PG8_BAR; PG8_MMA(0, 0, At, B0); PG8_MMA(0, 1, At, B1); PG8_BAR; PG8_SCHED;
            PG8_LDA(At, 0, 1); PG8_STAGE(PG8_SB(0, 0), baseB, b2, voffB); PG8_STAGE(PG8_SB(0, 1), baseB, b2 + hstepB, voffB); PG8_STAGE(PG8_SA(0, 0), baseA, a2, voffA);
            PG8_WAIT_V(8); PG8_WAIT_L(0); PG8_BAR; PG8_MMA(1, 0, At, B0); PG8_MMA(1, 1, At, B1); PG8_BAR; PG8_SCHED;
            PG8_LDB(B0, 1, 0); PG8_LDB(B1, 1, 1); PG8_SCHED; PG8_LDA(At, 1, 0); PG8_STAGE(PG8_SA(0, 1), baseA, a2 + hstepA, voffA);
            PG8_WAIT_V(8); PG8_WAIT_L(0); PG8_BAR; PG8_MMA(0, 0, At, B0); PG8_MMA(0, 1, At, B1); PG8_BAR; PG8_SCHED;
            PG8_LDA(At, 1, 1); PG8_STAGE(PG8_SB(1, 0), baseB, b3, voffB); PG8_STAGE(PG8_SB(1, 1), baseB, b3 + hstepB, voffB); PG8_STAGE(PG8_SA(1, 0), baseA, a3, voffA);
            PG8_WAIT_V(8); PG8_WAIT_L(0); PG8_BAR; PG8_MMA(1, 0, At, B0); PG8_MMA(1, 1, At, B1); PG8_BAR; PG8_SCHED;
            } else {
            PG8_LDB(B0, 0, 0); PG8_SCHED; PG8_LDA(At, 0, 0); PG8_STAGE(PG8_SA(1, 1), baseA, a1 + hstepA, voffA);
            PG8_WAIT_L(8); PG8_BAR; PG8_WAIT_L(0); PG8_MMA(0, 0, At, B0); PG8_BAR; PG8_SCHED;
            PG8_LDB(B1, 0, 1); PG8_STAGE(PG8_SB(0, 0), baseB, b2, voffB);
            PG8_BAR; PG8_WAIT_L(0); PG8_MMA(0, 1, At, B1); PG8_BAR;
            PG8_LDA(At, 0, 1); PG8_STAGE(PG8_SA(0, 0), baseA, a2, voffA);
            PG8_BAR; PG8_WAIT_L(0); PG8_MMA(1, 0, At, B0); PG8_BAR; PG8_SCHED;
            PG8_STAGE(PG8_SB(0, 1), baseB, b2 + hstepB, voffB);
            PG8_WAIT_V(6); PG8_BAR; PG8_MMA(1, 1, At, B1); PG8_BAR;
            PG8_LDB(B0, 1, 0); PG8_SCHED; PG8_LDA(At, 1, 0); PG8_STAGE(PG8_SA(0, 1), baseA, a2 + hstepA, voffA);
            PG8_WAIT_L(8); PG8_BAR; PG8_WAIT_L(0); PG8_MMA(0, 0, At, B0); PG8_BAR; PG8_SCHED;
            PG8_LDB(B1, 1, 1); PG8_STAGE(PG8_SB(1, 0), baseB, b3, voffB);
            PG8_BAR; PG8_WAIT_L(0); PG8_MMA(0, 1, At, B1); PG8_BAR;
            PG8_LDA(At, 1, 1); PG8_STAGE(PG8_SA(1, 0), baseA, a3, voffA);
            PG8_BAR; PG8_WAIT_L(0); PG8_MMA(1, 0, At, B0); PG8_BAR; PG8_SCHED;
            PG8_STAGE(PG8_SB(1, 1), baseB, b3 + hstepB, voffB);
            PG8_WAIT_V(6); PG8_BAR; PG8_MMA(1, 1, At, B1); PG8_BAR;
            }
        }
        if constexpr (ALIGN_EPI) { if (wr == 0) PG8_BAR; }
        if constexpr (!Epi::AFTER_DRAIN) { E(acc, cur, wr, wc, fr, fq, (const LAS float*)(lds + RS_OFF + (ui & 1) * 1024)); S.done(cur); }
        if (!has_next) break;
#pragma unroll
        for (int a = 0; a < 2; ++a)
#pragma unroll
            for (int b = 0; b < 2; ++b)
#pragma unroll
                for (int m = 0; m < 4; ++m)
#pragma unroll
                    for (int n = 0; n < 2; ++n) acc[a][b][m][n] = (f32x4){0.f, 0.f, 0.f, 0.f};
        cur = nxt; cA = nA; cB = nB; ++ui;
        PG8_RSTD(cur, ui & 1);
        if constexpr (ALIGN_EPI) { if (wr == 1) PG8_BAR; }
    }
    PG8_WAIT_V(0);
    if constexpr (!ALIGN_EPI) { if (wr == 0) PG8_BAR; }
    PG8_BAR;
#undef PG8_SA
#undef PG8_SB
#undef PG8_STAGE
#undef PG8_LDA
#undef PG8_LDB
#undef PG8_MMA
#undef PG8_WAIT_V
#undef PG8_WAIT_L
#undef PG8_BAR
#undef PG8_SCHED
}
}

namespace att {
constexpr int DH = 128, NW = 8, QBLK = 32, KVBLK = 64;
constexpr float SCALE = 0.088388347648318440f;
constexpr float THR = 8.f;
constexpr int LD = NPROJ, LDO = 2048;
constexpr size_t SHM_V = KVBLK * DH * 2, SHM_K = KVBLK * DH * 2, SHM_ATTN = 2 * SHM_V + 2 * SHM_K + NW * 64 * 4;
#define KSWZ(row, colB) ((row) * 256 + ((colB) ^ (((row) & 7) << 4)))
#define SBAR() __builtin_amdgcn_sched_barrier(0)
__device__ __forceinline__ int crow(int r, int hi) { return (r & 3) + 8 * (r >> 2) + 4 * hi; }
__device__ __forceinline__ void partialSM(f32x16& p0, f32x16& p1, float& m_reg, float& mn, float& alpha) {
  constexpr float C = SCALE * 1.4426950408889634f;
  float pmax = p0[0];
#pragma unroll
  for (int r = 1; r < 16; ++r) pmax = fmaxf(pmax, p0[r]);
#pragma unroll
  for (int r = 0; r < 16; ++r) pmax = fmaxf(pmax, p1[r]);
  { auto rr = __builtin_amdgcn_permlane32_swap(__float_as_uint(pmax), __float_as_uint(pmax), false, false);
    pmax = fmaxf(__uint_as_float(rr[0]), __uint_as_float(rr[1])); }
  if (__builtin_expect(__all(pmax - m_reg <= THR / SCALE), 1)) { mn = m_reg; alpha = 1.f; }
  else { mn = fmaxf(m_reg, pmax); alpha = __builtin_amdgcn_exp2f((m_reg - mn) * C); m_reg = mn; }
  float mnC = -mn * C;
#pragma unroll
  for (int r = 0; r < 16; ++r) p0[r] = fmaf(p0[r], C, mnC);
#pragma unroll
  for (int r = 0; r < 16; ++r) p1[r] = fmaf(p1[r], C, mnC);
#pragma unroll
  for (int r = 0; r < 16; ++r) p0[r] = __builtin_amdgcn_exp2f(p0[r]);
}
__device__ __forceinline__ void finishSM(f32x16& p0, f32x16& p1, float alpha, float& l_reg, bf16x8& pa0, bf16x8& pa1, bf16x8& pa2, bf16x8& pa3) {
#pragma unroll
  for (int r = 0; r < 16; ++r) p1[r] = __builtin_amdgcn_exp2f(p1[r]);
  float ps = 0;
#pragma unroll
  for (int r = 0; r < 16; ++r) ps += p0[r];
#pragma unroll
  for (int r = 0; r < 16; ++r) ps += p1[r];
  { auto rr = __builtin_amdgcn_permlane32_swap(__float_as_uint(ps), __float_as_uint(ps), false, false);
    ps = __uint_as_float(rr[0]) + __uint_as_float(rr[1]); }
  l_reg = l_reg * alpha + ps;
#define PK4(P, BASE, OUT) do { unsigned a0 = cvt_pk_bf16(P[BASE + 0], P[BASE + 1]), a1 = cvt_pk_bf16(P[BASE + 2], P[BASE + 3]);   \
    unsigned b0 = cvt_pk_bf16(P[BASE + 4], P[BASE + 5]), b1 = cvt_pk_bf16(P[BASE + 6], P[BASE + 7]);                              \
    auto r0 = __builtin_amdgcn_permlane32_swap(a0, b0, false, false); auto r1 = __builtin_amdgcn_permlane32_swap(a1, b1, false, false); \
    u32x4 w = {r0[0], r1[0], r0[1], r1[1]}; OUT = *reinterpret_cast<bf16x8*>(&w); } while (0)
  PK4(p0, 0, pa0); PK4(p0, 8, pa1); PK4(p1, 0, pa2); PK4(p1, 8, pa3);
#undef PK4
}
__device__ __forceinline__ void qkt(f32x16& p0, f32x16& p1, const bf16_t* Ks, const bf16x8* qr, int r32, int hi) {
  p0 = f32x16{}; p1 = f32x16{};
#pragma unroll
  for (int d0 = 0; d0 < 8; ++d0) { int cb = (d0 * 16 + hi * 8) * 2;
    bf16x8 b0 = *reinterpret_cast<const bf16x8*>((const char*)Ks + KSWZ(r32, cb));
    bf16x8 b1 = *reinterpret_cast<const bf16x8*>((const char*)Ks + KSWZ(32 + r32, cb));
    p0 = __builtin_amdgcn_mfma_f32_32x32x16_bf16(b0, qr[d0], p0, 0, 0, 0);
    p1 = __builtin_amdgcn_mfma_f32_32x32x16_bf16(b1, qr[d0], p1, 0, 0, 0); }
}
__device__ __forceinline__ int v_st(int k, int c) { const int kk = (k & ~0xC) | ((k & 4) << 1) | ((k & 8) >> 1); return ((kk >> 3) * 4 + (c >> 5)) * 512 + ((kk & 7) * 32 + (c & 31)) * 2; }
__device__ __forceinline__ int v_rd_base(int lane) { return ((lane & 3) << 3) | (((lane >> 2) & 3) << 6) | (((lane >> 4) & 1) << 5) | (((lane >> 5) & 1) << 8); }
constexpr int v_rd_off(int d0, int ks, int half) { return d0 * 512 + ks * 4096 + half * 2048; }
template <int OFF> __device__ __forceinline__ s16x4 tr_read(int vb) {
  s16x4 r; asm volatile("ds_read_b64_tr_b16 %0, %1 offset:%2" : "=&v"(r) : "v"(vb), "i"(OFF) : "memory"); return r;
}
template <int D0> __device__ __forceinline__ void pv_one(f32x16& od, int vb, bf16x8 pa0, bf16x8 pa1, bf16x8 pa2, bf16x8 pa3) {
  const s16x4 l0 = tr_read<v_rd_off(D0, 0, 0)>(vb), h0 = tr_read<v_rd_off(D0, 0, 1)>(vb), l1 = tr_read<v_rd_off(D0, 1, 0)>(vb), h1 = tr_read<v_rd_off(D0, 1, 1)>(vb);
  const s16x4 l2 = tr_read<v_rd_off(D0, 2, 0)>(vb), h2 = tr_read<v_rd_off(D0, 2, 1)>(vb), l3 = tr_read<v_rd_off(D0, 3, 0)>(vb), h3 = tr_read<v_rd_off(D0, 3, 1)>(vb);
  asm volatile("s_waitcnt lgkmcnt(0)" ::: "memory"); SBAR();
#define PK(L, H) (bf16x8){L[0], L[1], L[2], L[3], H[0], H[1], H[2], H[3]}
  od = __builtin_amdgcn_mfma_f32_32x32x16_bf16(pa0, PK(l0, h0), od, 0, 0, 0);
  od = __builtin_amdgcn_mfma_f32_32x32x16_bf16(pa1, PK(l1, h1), od, 0, 0, 0);
  od = __builtin_amdgcn_mfma_f32_32x32x16_bf16(pa2, PK(l2, h2), od, 0, 0, 0);
  od = __builtin_amdgcn_mfma_f32_32x32x16_bf16(pa3, PK(l3, h3), od, 0, 0, 0);
#undef PK
}
__device__ __forceinline__ void pv_d0(f32x16* o, int vb, bf16x8 pa0, bf16x8 pa1, bf16x8 pa2, bf16x8 pa3) {
  pv_one<0>(o[0], vb, pa0, pa1, pa2, pa3); pv_one<1>(o[1], vb, pa0, pa1, pa2, pa3); pv_one<2>(o[2], vb, pa0, pa1, pa2, pa3); pv_one<3>(o[3], vb, pa0, pa1, pa2, pa3);
}
__device__ __forceinline__ void attn_dense_body(const bf16_t* Qb, const bf16_t* __restrict__ Kh, const bf16_t* __restrict__ Vh, bf16_t* Ob, int seq, char* lds, const float* qgain  , const f32x2* cs  , int t0  ) {
  const int tid = opaque_tid(), wid = tid >> 6, lane = tid & 63, r32 = lane & 31, hi = lane >> 5;
  bf16_t* V_lds = (bf16_t*)lds; bf16_t* K_lds = (bf16_t*)(lds + 2 * SHM_V);
  float* ws = (float*)(lds + 2 * SHM_V + 2 * SHM_K) + wid * 64; float* li_l = ws; float* al_l = ws + 32;
  float m_reg = -1e30f, l_reg = 0; f32x16 o[4] = {}; bf16x8 qr[8];
  const bf16_t* Qw = Qb + (long)(wid * QBLK + r32) * LD + hi * 8;
#pragma unroll
  for (int d0 = 0; d0 < 8; ++d0) qr[d0] = *reinterpret_cast<const bf16x8*>(Qw + d0 * 16);
  {
    float ss = 0.f;
#pragma unroll
    for (int d0 = 0; d0 < 8; ++d0) { const u32x4 w = *reinterpret_cast<const u32x4*>(&qr[d0]);
      ss += (bflo(w.x) * bflo(w.x) + bfhi(w.x) * bfhi(w.x)) + (bflo(w.y) * bflo(w.y) + bfhi(w.y) * bfhi(w.y)) + (bflo(w.z) * bflo(w.z) + bfhi(w.z) * bfhi(w.z)) + (bflo(w.w) * bflo(w.w) + bfhi(w.w) * bfhi(w.w)); }
    { auto rr = __builtin_amdgcn_permlane32_swap(__float_as_uint(ss), __float_as_uint(ss), false, false); ss = __uint_as_float(rr[0]) + __uint_as_float(rr[1]); }
    const float rstd = 1.0f / sqrtf(ss * (1.0f / 128.0f) + EPS);
    const int t = t0 + wid * QBLK + r32, pr = t >> 6, pc = t & 63;
#pragma unroll
    for (int d0 = 0; d0 < 8; ++d0) {
      const f32x4 g0 = *(const f32x4*)(qgain + d0 * 16 + hi * 8) * rstd, g1 = *(const f32x4*)(qgain + d0 * 16 + hi * 8 + 4) * rstd;
      const f32x4* cp = (const f32x4*)(cs + ((d0 < 4) ? pr : pc) * 32 + (d0 & 3) * 8 + hi * 4); const f32x4 ca = cp[0], cb = cp[1];
      const u32x4 w = *reinterpret_cast<const u32x4*>(&qr[d0]); u32x4 o;
      { const float n1 = bflo(w.x) * g0[0], n2 = bfhi(w.x) * g0[1]; o.x = cvt_pk_bf16(n1 * ca[0] - n2 * ca[1], n1 * ca[1] + n2 * ca[0]); }
      { const float n1 = bflo(w.y) * g0[2], n2 = bfhi(w.y) * g0[3]; o.y = cvt_pk_bf16(n1 * ca[2] - n2 * ca[3], n1 * ca[3] + n2 * ca[2]); }
      { const float n1 = bflo(w.z) * g1[0], n2 = bfhi(w.z) * g1[1]; o.z = cvt_pk_bf16(n1 * cb[0] - n2 * cb[1], n1 * cb[1] + n2 * cb[0]); }
      { const float n1 = bflo(w.w) * g1[2], n2 = bfhi(w.w) * g1[3]; o.w = cvt_pk_bf16(n1 * cb[2] - n2 * cb[3], n1 * cb[3] + n2 * cb[2]); }
      qr[d0] = *reinterpret_cast<const bf16x8*>(&o);
    }
  }
  const int sr = tid >> 4, sc = (tid & 15) * 8, vst0 = v_st(sr, sc), vst1 = v_st(32 + sr, sc);
  const int vb0 = (int)(uintptr_t)V_lds + v_rd_base(lane);
  struct { bf16x8 vs0, vs1, ks0, ks1; } sr_[1];
#define SLOAD(i, k0) do { sr_[i].vs0 = *reinterpret_cast<const bf16x8*>(&Vh[(long)((k0) + sr) * LD + sc]); sr_[i].vs1 = *reinterpret_cast<const bf16x8*>(&Vh[(long)((k0) + 32 + sr) * LD + sc]); \
    sr_[i].ks0 = *reinterpret_cast<const bf16x8*>(&Kh[(long)((k0) + sr) * LD + sc]); sr_[i].ks1 = *reinterpret_cast<const bf16x8*>(&Kh[(long)((k0) + 32 + sr) * LD + sc]); } while (0)
#define SWRITE(b, i) do { *(bf16x8*)((char*)V_lds + (b) * SHM_V + vst0) = sr_[i].vs0;          \
    *(bf16x8*)((char*)V_lds + (b) * SHM_V + vst1) = sr_[i].vs1; int kc = sc * 2;               \
    *(bf16x8*)((char*)K_lds + (b) * SHM_K + KSWZ(sr, kc)) = sr_[i].ks0;                       \
    *(bf16x8*)((char*)K_lds + (b) * SHM_K + KSWZ(32 + sr, kc)) = sr_[i].ks1; } while (0)
#define SWAIT() asm volatile("s_waitcnt vmcnt(0)" ::: "memory")
#define RESC(a) do { if (__any((a) < 1.f)) { if (hi == 0) al_l[r32] = (a); asm volatile("s_waitcnt lgkmcnt(0)" ::: "memory"); \
    _Pragma("unroll") for (int d = 0; d < 4; ++d) _Pragma("unroll") for (int r = 0; r < 16; ++r) o[d][r] *= al_l[crow(r, hi)]; } } while (0)
  f32x16 pA0, pA1, pB0, pB1; float mnA, mnB, alA, alB; bf16x8 pa0, pa1, pa2, pa3; const int NT = seq / KVBLK;
  constexpr int SE = 0, SO = 0;
  SLOAD(SE, 0); asm volatile("s_waitcnt vmcnt(0)" ::: "memory"); SWRITE(0, SE); __syncthreads();
  qkt(pA0, pA1, K_lds, qr, r32, hi); partialSM(pA0, pA1, m_reg, mnA, alA);
  SLOAD(SO, KVBLK);
  SWAIT(); SWRITE(1, SO); __syncthreads();
  for (int j = 1; j + 1 < NT; j += 2) {
    SBAR(); qkt(pB0, pB1, (bf16_t*)((char*)K_lds + SHM_K), qr, r32, hi);
    finishSM(pA0, pA1, alA, l_reg, pa0, pa1, pa2, pa3); SBAR();
    SLOAD(SO, (j + 1) * KVBLK); SBAR();
    pv_d0(o, vb0, pa0, pa1, pa2, pa3); partialSM(pB0, pB1, m_reg, mnB, alB);
    __syncthreads(); SWAIT(); SWRITE(0, SE);
    RESC(alB); __syncthreads();
    SBAR(); qkt(pA0, pA1, K_lds, qr, r32, hi);
    finishSM(pB0, pB1, alB, l_reg, pa0, pa1, pa2, pa3); SBAR();
    SLOAD(SE, (j + 2) * KVBLK); SBAR();
    pv_d0(o, vb0 + (int)SHM_V, pa0, pa1, pa2, pa3); partialSM(pA0, pA1, m_reg, mnA, alA);
    __syncthreads(); SWAIT(); SWRITE(1, SO);
    RESC(alA); __syncthreads();
  }
  SBAR(); qkt(pB0, pB1, (bf16_t*)((char*)K_lds + SHM_K), qr, r32, hi);
  finishSM(pA0, pA1, alA, l_reg, pa0, pa1, pa2, pa3); SBAR();
  pv_d0(o, vb0, pa0, pa1, pa2, pa3); partialSM(pB0, pB1, m_reg, mnB, alB);
  __syncthreads(); RESC(alB);
  finishSM(pB0, pB1, alB, l_reg, pa0, pa1, pa2, pa3); SBAR();
  pv_d0(o, vb0 + (int)SHM_V, pa0, pa1, pa2, pa3);
  if (hi == 0) li_l[r32] = l_reg; asm volatile("s_waitcnt lgkmcnt(0)" ::: "memory");
  float rli[16];
#pragma unroll
  for (int r = 0; r < 16; ++r) rli[r] = __builtin_amdgcn_rcpf(li_l[crow(r, hi)]);
  bf16_t* Ow = Ob + (long)(wid * QBLK) * LDO;
#pragma unroll
  for (int r = 0; r < 16; ++r) { int orow = crow(r, hi);
#pragma unroll
    for (int d0 = 0; d0 < 4; ++d0) Ow[(long)orow * LDO + d0 * 32 + r32] = f2bf(o[d0][r] * rli[r]); }
  __syncthreads();
#undef SLOAD
#undef SWRITE
#undef SWAIT
#undef RESC
}
}

constexpr int RING_BYTES = 131072;
constexpr int LDSCTL_OFF = RING_BYTES, MISC_OFF = LDSCTL_OFF + 320, PTAB_OFF = LDSCTL_OFF + 1024;
constexpr int LDS_BYTES = 147456;

#define XB_TMO      128
#define XB_XCNT(j)  (256  + 64 * (j))
#define XB_XSUB(j)  (1280 + 64 * (j))
#define XB_XGEN(j)  (2304 + 64 * (j))
#define XB_TOP      3328
#define XB_TOPGEN   3392
#define XCD_BAR_WORDS 3456
#define XB_SPIN_CAP (1u << 22)
__device__ __forceinline__ unsigned xb_ld(unsigned* p)              { return __hip_atomic_load(p, __ATOMIC_RELAXED, __HIP_MEMORY_SCOPE_AGENT); }
__device__ __forceinline__ unsigned xb_add(unsigned* p, unsigned v) { return __hip_atomic_fetch_add(p, v, __ATOMIC_RELAXED, __HIP_MEMORY_SCOPE_AGENT); }
__device__ __forceinline__ unsigned xb_xcc_id() { return (unsigned)__builtin_amdgcn_s_getreg((3 << 11) | 20) & 0xFu; }
#define XB_SPIN(cond, bar) do { unsigned _sp = 0; while (cond) { __builtin_amdgcn_s_sleep(1); \
    if ((++_sp & 255u) == 0u) { if (xb_ld(&(bar)[XB_TMO])) break; if (_sp > XB_SPIN_CAP) { atomicAdd(&(bar)[XB_TMO], 1u); break; } } } } while (0)
struct XcdBarrier { unsigned* bar; unsigned x; volatile LAS unsigned* st; };
__device__ __forceinline__ XcdBarrier xcd_barrier_post(unsigned* bar, volatile LAS unsigned* st) {
    XcdBarrier b; b.bar = bar; b.x = xb_xcc_id(); b.st = st;
    if (threadIdx.x == 0) (void)xb_add(&bar[XB_XCNT(b.x)], 1u);
    return b;
}
__device__ __forceinline__ void xcd_barrier_complete(unsigned* bar, unsigned x, unsigned& nloc, unsigned& nx) {
    const unsigned G = gridDim.x * gridDim.y * gridDim.z;
    unsigned sum, cnt, mine, sp = 0u;
    for (;;) {
        sum = 0u; cnt = 0u;
        for (unsigned j = 0; j < 16; ++j) { const unsigned c = xb_ld(&bar[XB_XCNT(j)]); sum += c; cnt += (c > 0u) ? 1u : 0u; }
        mine = xb_ld(&bar[XB_XCNT(x)]);
        if (sum == G) break;
        __builtin_amdgcn_s_sleep(1);
        if ((++sp & 255u) == 0u) { if (xb_ld(&bar[XB_TMO])) break; if (sp > XB_SPIN_CAP) { atomicAdd(&bar[XB_TMO], 1u); break; } }
    }
    nloc = mine > 0u ? mine : 1u; nx = cnt > 0u ? cnt : 1u;
}
__device__ __forceinline__ XcdBarrier xcd_barrier_setup(unsigned* bar, volatile LAS unsigned* st) {
    XcdBarrier b = xcd_barrier_post(bar, st);
    if (threadIdx.x == 0) { unsigned nloc, nx; xcd_barrier_complete(bar, b.x, nloc, nx); st[0] = nloc; st[1] = nx; }
    __syncthreads();
    return b;
}
__device__ __forceinline__ void xcd_barrier(const XcdBarrier& b) {
    asm volatile("s_waitcnt vmcnt(0)" ::: "memory");
    __syncthreads();
    if (threadIdx.x == 0) {
        unsigned* bar = b.bar; unsigned bx = b.x;
        asm volatile("" : "+s"(bar), "+s"(bx));
        __builtin_amdgcn_s_waitcnt(0);
        const unsigned nloc = b.st[0], nx = b.st[1];
        const unsigned old = xb_add(&bar[XB_XSUB(bx)], 1u);
        const unsigned gen = old / nloc;
        if (old + 1u == (gen + 1u) * nloc) {
            __builtin_amdgcn_fence(__ATOMIC_RELEASE, "agent");
            asm volatile("s_waitcnt vmcnt(0)" ::: "memory");
            const unsigned og = xb_add(&bar[XB_TOP], 1u);
            const unsigned tg = og / nx;
            if (og + 1u == (tg + 1u) * nx) xb_add(&bar[XB_TOPGEN], 1u);
            else XB_SPIN(xb_ld(&bar[XB_TOPGEN]) == tg, bar);
            __builtin_amdgcn_fence(__ATOMIC_ACQUIRE, "agent");
            xb_add(&bar[XB_XGEN(bx)], 1u);
            asm volatile("s_waitcnt vmcnt(0)" ::: "memory");
        } else {
            XB_SPIN(xb_ld(&bar[XB_XGEN(bx)]) == gen, bar);
            __builtin_amdgcn_fence(__ATOMIC_ACQUIRE, "agent");
            asm volatile("s_waitcnt vmcnt(0)" ::: "memory");
        }
    }
    __syncthreads();
}

__device__ __forceinline__ void transpose_item(const float* W, int ldw, int K, int k0, int srccol0, bf16_t* WT, int dstrow0, LAS float* scr, int lane, const float* kgain = nullptr, int ldt = 0) {
    const int KT = ldt ? ldt : K;
    constexpr int P = 36;
    const int n4 = (lane & 7) * 4, kr = lane >> 3;
    f32x4 v[8];
    if (srccol0 >= 0) {
#pragma unroll
        for (int i = 0; i < 8; ++i) v[i] = *(const f32x4*)(W + (size_t)(k0 + 8 * i + kr) * ldw + srccol0 + n4);
        if (kgain) {
#pragma unroll
            for (int i = 0; i < 8; ++i) v[i] = v[i] * kgain[k0 + 8 * i + kr];
        }
    } else {
#pragma unroll
        for (int i = 0; i < 8; ++i) v[i] = (f32x4){0.f, 0.f, 0.f, 0.f};
    }
#pragma unroll
    for (int i = 0; i < 8; ++i) *(LAS f32x4*)(scr + (8 * i + kr) * P + n4) = v[i];
    LDS_WAIT(); asm volatile("" ::: "memory");
    const int c = lane & 7;
#pragma unroll
    for (int j = 0; j < 4; ++j) { const int n = (lane >> 3) + 8 * j; const LAS float* s = scr + (8 * c) * P + n;
        u32x4 o; o.x = cvt_pk_bf16(s[0 * P], s[1 * P]); o.y = cvt_pk_bf16(s[2 * P], s[3 * P]); o.z = cvt_pk_bf16(s[4 * P], s[5 * P]); o.w = cvt_pk_bf16(s[6 * P], s[7 * P]);
        *(u32x4*)(WT + (size_t)(dstrow0 + n) * KT + k0 + 8 * c) = o; }
    LDS_WAIT(); asm volatile("" ::: "memory");
}
struct LayerW { const float *w_in, *w_bra, *w_brb, *w_brc, *w_out, *f1i, *f1o, *f2i, *f2o, *ng; };
__device__ __forceinline__ void phase_weights(const LayerW& w, unsigned char* ws, LAS unsigned char* lds, int gw, int NGW, int wave, int lane) {
    LAS float* scr = (LAS float*)(lds + wave * 16384);
    constexpr int I_IN = (NIN_PAD / 32) * (D / 64);
    constexpr int I_FI = (2 * FF / 32) * (D / 64);
    constexpr int I_FO = (D / 32) * (FF / 64);
    constexpr int I_BA = (D / 32) * (1024 / 64);
    constexpr int I_BB = (D / 32) * (512 / 64);
    constexpr int I_WO = (D / 32) * (D / 64);
    constexpr int NITEMS = I_IN + 2 * I_FI + 2 * I_FO + I_BA + 2 * I_BB + I_WO;
    for (int it = gw; it < NITEMS; it += NGW) {
        int r = it;
        if (r < I_IN) { const int nb = r % (NIN_PAD / 32), kb = r / (NIN_PAD / 32); const int d0 = nb * 32;
            const int src = d0 < 4608 ? d0 : (d0 < 10752 ? d0 + 32 : (d0 < 10784 ? 4608 + (d0 - 10752) : -1));
            transpose_item(w.w_in, NIN, D, kb * 64, src, (bf16_t*)(ws + WS_WIN), d0, scr, lane, w.ng + 2 * D); continue; } r -= I_IN;
        if (r < 2 * I_FI) { const int which = r / I_FI; r -= which * I_FI; const int nb = r % (2 * FF / 32), kb = r / (2 * FF / 32); const int d0 = nb * 32;
            const int t = d0 >> 8, within = d0 & 255; const int src = within < 128 ? 128 * t + within : FF + 128 * t + (within - 128);
            transpose_item(which ? w.f2i : w.f1i, 2 * FF, D, kb * 64, src, (bf16_t*)(ws + (which ? WS_WF2I : WS_WF1I)), d0, scr, lane, w.ng + (which ? 4 * D : 0)); continue; } r -= 2 * I_FI;
        if (r < 2 * I_FO) { const int which = r / I_FO; r -= which * I_FO; const int nb = r % (D / 32), kb = r / (D / 32);
            transpose_item(which ? w.f2o : w.f1o, D, FF, kb * 64, nb * 32, (bf16_t*)(ws + (which ? WS_WF2O : WS_WF1O)), nb * 32, scr, lane); continue; } r -= 2 * I_FO;
        if (r < I_BA) { const int nb = r % (D / 32), kb = r / (D / 32);
            transpose_item(w.w_bra, D, 1024, kb * 64, nb * 32, (bf16_t*)(ws + WS_WBRA), nb * 32, scr, lane, nullptr, LDOM); continue; } r -= I_BA;
        if (r < 2 * I_BB) { const int which = r / I_BB; r -= which * I_BB; const int nb = r % (D / 32), kb = r / (D / 32);
            transpose_item(which ? w.w_brc : w.w_brb, D, 512, kb * 64, nb * 32, (bf16_t*)(ws + WS_WBRA) + (which ? OM_C : OM_B), nb * 32, scr, lane, nullptr, LDOM); continue; } r -= 2 * I_BB;
        { const int nb = r % (D / 32), kb = r / (D / 32);
            transpose_item(w.w_out, D, D, kb * 64, nb * 32, (bf16_t*)(ws + WS_WOUT), nb * 32, scr, lane); }
    }
}
__device__ __forceinline__ void phase_norm(bf16_t* XB, const bf16_t* Y, float* RSTD, float* OUT, const float* gpost, float coef, int gw, int NGW, int lane) {
    f32x4 g[8];
#pragma unroll
    for (int j = 0; j < 4; ++j) { g[2 * j] = *(const f32x4*)(gpost + 512 * j + 8 * lane); g[2 * j + 1] = *(const f32x4*)(gpost + 512 * j + 8 * lane + 4); }
#define NRM_LOAD(X, Yq, m_) do { const u32x4* xr_ = (const u32x4*)(XB + (size_t)(m_) * D) + lane; const u32x4* yr_ = (const u32x4*)(Y + (size_t)(m_) * D) + lane; \
        _Pragma("unroll") for (int j = 0; j < 4; ++j) { Yq[j] = yr_[64 * j]; X[j] = xr_[64 * j]; } } while (0)
#define NRM_UNP(q_, lo, hi) do { lo = (f32x4){bflo((q_).x), bfhi((q_).x), bflo((q_).y), bfhi((q_).y)}; hi = (f32x4){bflo((q_).z), bfhi((q_).z), bflo((q_).w), bfhi((q_).w)}; } while (0)
#define NRM_PROC(X, Yq, m_) do { f32x4 x[8], y[8]; float s = 0.f; \
        _Pragma("unroll") for (int j = 0; j < 4; ++j) { NRM_UNP(Yq[j], y[2 * j], y[2 * j + 1]); NRM_UNP(X[j], x[2 * j], x[2 * j + 1]); } \
        _Pragma("unroll") for (int j = 0; j < 8; ++j) s += (y[j].x * y[j].x + y[j].y * y[j].y) + (y[j].z * y[j].z + y[j].w * y[j].w); \
        const float rstd = coef * (1.0f / sqrtf(wave_sum(s) * (1.0f / D) + EPS)); float s2 = 0.f; \
        _Pragma("unroll") for (int j = 0; j < 8; ++j) { x[j] = x[j] + y[j] * g[j] * rstd; s2 += (x[j].x * x[j].x + x[j].y * x[j].y) + (x[j].z * x[j].z + x[j].w * x[j].w); } \
        if (OUT) { f32x4* xo = (f32x4*)(OUT + (size_t)(m_) * D + 8 * lane); \
            _Pragma("unroll") for (int j = 0; j < 4; ++j) { xo[128 * j] = x[2 * j]; xo[128 * j + 1] = x[2 * j + 1]; } \
        } else { u32x4* o16 = (u32x4*)(XB + (size_t)(m_) * D) + lane; \
            _Pragma("unroll") for (int j = 0; j < 4; ++j) { u32x4 w; w.x = cvt_pk_bf16(x[2 * j].x, x[2 * j].y); w.y = cvt_pk_bf16(x[2 * j].z, x[2 * j].w); w.z = cvt_pk_bf16(x[2 * j + 1].x, x[2 * j + 1].y); w.w = cvt_pk_bf16(x[2 * j + 1].z, x[2 * j + 1].w); o16[64 * j] = w; } \
            const float r2 = 1.0f / sqrtf(wave_sum(s2) * (1.0f / D) + EPS); if (lane == 0) RSTD[m_] = r2; } } while (0)
    u32x4 xa[4], ya[4], xb[4], yb[4];
    int m = gw;
    if (m < M) NRM_LOAD(xa, ya, m);
    while (m < M) {
        const int mb = m + NGW, mbl = mb < M ? mb : m;
        NRM_LOAD(xb, yb, mbl);
        NRM_PROC(xa, ya, m);
        if (mb >= M) break;
        const int ma = mb + NGW, mal = ma < M ? ma : mb;
        NRM_LOAD(xa, ya, mal);
        NRM_PROC(xb, yb, mb);
        m = ma;
    }
#undef NRM_LOAD
#undef NRM_UNP
#undef NRM_PROC
}
__device__ __forceinline__ void prep_k(bf16_t* PROJ, const float* qk_gain  , const f32x2* cs  , int gw, int NGW, int lane) {
    const float gk0 = qk_gain[128 + 2 * lane], gk1 = qk_gain[128 + 2 * lane + 1];
    for (int m0 = gw; m0 < M; m0 += 4 * NGW) {
        unsigned v[4][2]; f32x2 c_s[4];
#pragma unroll
        for (int i = 0; i < 4; ++i) { const int m = m0 + i * NGW; if (m < M) { const int t = m & (SEQ - 1), pr = t >> 6, pc = t & 63;
            const unsigned* row = (const unsigned*)(PROJ + (size_t)m * NPROJ + C_AK); v[i][0] = row[lane]; v[i][1] = row[64 + lane]; c_s[i] = cs[((lane < 32) ? pr : pc) * 32 + (lane & 31)]; } }
#pragma unroll
        for (int i = 0; i < 4; ++i) { const int m = m0 + i * NGW; if (m < M) { unsigned* row = (unsigned*)(PROJ + (size_t)m * NPROJ + C_AK);
#pragma unroll
            for (int h = 0; h < 2; ++h) { const float x1 = bflo(v[i][h]), x2 = bfhi(v[i][h]);
                const float rstd = 1.0f / sqrtf(wave_sum(x1 * x1 + x2 * x2) * (1.0f / 128.0f) + EPS);
                const float n1 = x1 * rstd * gk0, n2 = x2 * rstd * gk1;
                row[h * 64 + lane] = cvt_pk_bf16(n1 * c_s[i].x - n2 * c_s[i].y, n1 * c_s[i].y + n2 * c_s[i].x); } } }
    }
}
__device__ __forceinline__ void tr_pair(unsigned base, int pitch, int row0, int col0, int lane, s16x4& lo, s16x4& hi) {
    const int g = lane >> 4, i = lane & 15;
    const unsigned addr = base + (unsigned)((row0 + 4 * g + (i >> 2)) * pitch + (col0 + 4 * (i & 3)) * 2);
    asm volatile("ds_read_b64_tr_b16 %0, %1" : "=&v"(lo) : "v"(addr) : "memory");
    asm volatile("ds_read_b64_tr_b16 %0, %1" : "=&v"(hi) : "v"(addr + (unsigned)(16 * pitch)) : "memory");
}
#define TR_JOIN(L, H) ((bf16x8){L[0], L[1], L[2], L[3], H[0], H[1], H[2], H[3]})
__device__ __forceinline__ bf16x8 pack8(const float* x) { u32x4 w; w.x = cvt_pk_bf16(x[0], x[1]); w.y = cvt_pk_bf16(x[2], x[3]); w.z = cvt_pk_bf16(x[4], x[5]); w.w = cvt_pk_bf16(x[6], x[7]); return *reinterpret_cast<bf16x8*>(&w); }
constexpr int NAR = 4;
__device__ __forceinline__ void na_unit(const bf16_t* PROJ, bf16_t* OB  , LAS unsigned char* lds, int u) {
    const int tid = opaque_tid(), lane = tid & 63, w = __builtin_amdgcn_readfirstlane(tid >> 6);
    constexpr int PV = 272, O_V = 0, O_RPB = 2 * 64 * PV;
    LAS float* rpbs = (LAS float*)(lds + O_RPB);
    const unsigned lbase = (unsigned)(uintptr_t)lds;
    const int ib = w & 3, qh = w >> 2;
    {
        int lane_o = lane; asm volatile("" : "+v"(lane_o));
        const int g = lane_o >> 4, li = lane_o & 15;
        const int r0 = (u & 7) * NAR, h = (u >> 3) & 3, b = u >> 5;
        const int klo = min(max(r0 - 4, 0), 24), khi = min(max(r0 + NAR - 1 - 4, 0), 24) + 7, nk = khi - klo + 1;
        const int c = 16 * ib + li, cs0 = min(max(c - 8, 0), 48);
        const int rw = r0 + 2 * qh;
        const size_t tq = (size_t)b * SEQ + rw * 64 + c;
        bf16x8 qf[2][4];
#pragma unroll
        for (int q = 0; q < 2; ++q)
#pragma unroll
            for (int ks = 0; ks < 4; ++ks) qf[q][ks] = *(const bf16x8*)(PROJ + (tq + 64 * q) * NPROJ + C_BQ + h * 128 + 32 * ks + 8 * g);
        int jbv[4], dcv[4];
#pragma unroll
        for (int rr = 0; rr < 4; ++rr) { const int km = 4 * g + rr; jbv[rr] = (cs0 + 15 - km) >> 4; dcv[rr] = 16 * jbv[rr] + km - c + 15; }
        f32x4 o[2][8]; float m_run[2], l_run[2];
#pragma unroll
        for (int q = 0; q < 2; ++q) { m_run[q] = -1e30f; l_run[q] = 0.f;
#pragma unroll
            for (int vt = 0; vt < 8; ++vt) o[q][vt] = (f32x4){0.f, 0.f, 0.f, 0.f}; }
        const int sr = tid >> 4, sc = (tid & 15) * 8;
        const int jlo = ib > 1 ? ib - 1 : 0, jn = (ib == 0 || ib == 3) ? 2 : 3;
        bf16x8 kf[3][4], vr0, vr1;
#define NA_LOADK(kr_) do { const size_t kt_ = (size_t)b * SEQ + (size_t)(klo + (kr_)) * 64; \
            _Pragma("unroll") for (int jj = 0; jj < 3; ++jj) if (jj < jn) { const bf16_t* kp = PROJ + (kt_ + 16 * (jlo + jj) + li) * NPROJ + C_BK + h * 128 + 8 * g; \
                _Pragma("unroll") for (int ks = 0; ks < 4; ++ks) kf[jj][ks] = *(const bf16x8*)(kp + 32 * ks); } } while (0)
#define NA_LOADV(kr_) do { const size_t kt_ = (size_t)b * SEQ + (size_t)(klo + (kr_)) * 64; \
            vr0 = *(const bf16x8*)(PROJ + (kt_ + sr) * NPROJ + C_BV + h * 128 + sc); vr1 = *(const bf16x8*)(PROJ + (kt_ + sr + 32) * NPROJ + C_BV + h * 128 + sc); } while (0)
        NA_LOADV(0); NA_LOADK(0);
        for (int kr = 0; kr < nk; ++kr) {
            const int kabs = klo + kr;
            *(LAS bf16x8*)(lds + O_V + (kr & 1) * 64 * PV + sr * PV + sc * 2) = vr0; *(LAS bf16x8*)(lds + O_V + (kr & 1) * 64 * PV + (sr + 32) * PV + sc * 2) = vr1;
            if (kr + 1 < nk) NA_LOADV(kr + 1);
            bf16x8 pfr[2][2]; float alpha[2]; bool act[2];
#pragma unroll
            for (int q = 0; q < 2; ++q) {
                const int rq = rw + q, rsq = min(max(rq - 4, 0), 24);
                act[q] = (kabs >= rsq) && (kabs <= rsq + 7);
                alpha[q] = 1.0f;
                if (act[q]) {
                    f32x4 s[3];
#pragma unroll
                    for (int jj = 0; jj < 3; ++jj) { s[jj] = (f32x4){0.f, 0.f, 0.f, 0.f};
                        if (jj < jn) {
#pragma unroll
                            for (int ks = 0; ks < 4; ++ks) s[jj] = __builtin_amdgcn_mfma_f32_16x16x32_bf16(kf[jj][ks], qf[q][ks], s[jj], 0, 0, 0); } }
                    const int dr = kabs - rq + 7;
                    float mx = -1e30f;
#pragma unroll
                    for (int rr = 0; rr < 4; ++rr) { const float bias = rpbs[(h * 15 + dr) * 31 + dcv[rr]];
#pragma unroll
                        for (int jj = 0; jj < 3; ++jj) { const float v = (jlo + jj == jbv[rr]) ? s[jj][rr] * 0.088388347648318440f + bias : -1e30f; s[jj][rr] = v; mx = fmaxf(mx, v); } }
                    mx = fmaxf(mx, __shfl_xor(mx, 16)); mx = fmaxf(mx, __shfl_xor(mx, 32));
                    const float m_new = fmaxf(m_run[q], mx); alpha[q] = __expf(m_run[q] - m_new);
                    m_run[q] = m_new;
                    float ps = 0.f;
#pragma unroll
                    for (int jj = 0; jj < 3; ++jj)
#pragma unroll
                        for (int rr = 0; rr < 4; ++rr) { const float p = (jlo + jj == jbv[rr]) ? __expf(s[jj][rr] - m_new) : 0.f; s[jj][rr] = p; ps += p; }
                    l_run[q] = l_run[q] * alpha[q] + ps;
                    float t[16];
#pragma unroll
                    for (int jb = 0; jb < 4; ++jb)
#pragma unroll
                        for (int rr = 0; rr < 4; ++rr) { float v = 0.f;
#pragma unroll
                            for (int jj = 0; jj < 3; ++jj) v = (jlo + jj == jb) ? s[jj][rr] : v;
                            t[4 * jb + rr] = v; }
                    pfr[q][0] = pack8(t); pfr[q][1] = pack8(t + 8);
                } else { pfr[q][0] = pfr[q][1] = (bf16x8){0, 0, 0, 0, 0, 0, 0, 0}; }
            }
            if (kr + 1 < nk) NA_LOADK(kr + 1);
            __syncthreads();
#pragma unroll
            for (int vh = 0; vh < 2; ++vh) {
                s16x4 vl[4][2], vhh[4][2];
                {
                    const unsigned vbase = lbase + O_V + (unsigned)((kr & 1) * 64 * PV + (4 * g + (li >> 2)) * PV + (64 * vh + 4 * (li & 3)) * 2);
                    asm volatile("ds_read_b64_tr_b16 %0, %16 offset:0\n\t"
                             "ds_read_b64_tr_b16 %1, %16 offset:4352\n\t"
                             "ds_read_b64_tr_b16 %2, %16 offset:8704\n\t"
                             "ds_read_b64_tr_b16 %3, %16 offset:13056\n\t"
                             "ds_read_b64_tr_b16 %4, %16 offset:32\n\t"
                             "ds_read_b64_tr_b16 %5, %16 offset:4384\n\t"
                             "ds_read_b64_tr_b16 %6, %16 offset:8736\n\t"
                             "ds_read_b64_tr_b16 %7, %16 offset:13088\n\t"
                             "ds_read_b64_tr_b16 %8, %16 offset:64\n\t"
                             "ds_read_b64_tr_b16 %9, %16 offset:4416\n\t"
                             "ds_read_b64_tr_b16 %10, %16 offset:8768\n\t"
                             "ds_read_b64_tr_b16 %11, %16 offset:13120\n\t"
                             "ds_read_b64_tr_b16 %12, %16 offset:96\n\t"
                             "ds_read_b64_tr_b16 %13, %16 offset:4448\n\t"
                             "ds_read_b64_tr_b16 %14, %16 offset:8800\n\t"
                             "ds_read_b64_tr_b16 %15, %16 offset:13152\n\t"
                             "s_waitcnt lgkmcnt(0)"
                             : "=&v"(vl[0][0]), "=&v"(vhh[0][0]), "=&v"(vl[0][1]), "=&v"(vhh[0][1]), "=&v"(vl[1][0]), "=&v"(vhh[1][0]), "=&v"(vl[1][1]), "=&v"(vhh[1][1]), "=&v"(vl[2][0]), "=&v"(vhh[2][0]), "=&v"(vl[2][1]), "=&v"(vhh[2][1]), "=&v"(vl[3][0]), "=&v"(vhh[3][0]), "=&v"(vl[3][1]), "=&v"(vhh[3][1])
                             : "v"(vbase) : "memory");
                }
                __builtin_amdgcn_sched_barrier(0);
#pragma unroll
                for (int q = 0; q < 2; ++q) if (act[q]) {
#pragma unroll
                    for (int vt = 0; vt < 4; ++vt) { f32x4 acc = o[q][4 * vh + vt] * alpha[q];
#pragma unroll
                        for (int ss = 0; ss < 2; ++ss) acc = __builtin_amdgcn_mfma_f32_16x16x32_bf16(TR_JOIN(vl[vt][ss], vhh[vt][ss]), pfr[q][ss], acc, 0, 0, 0);
                        o[q][4 * vh + vt] = acc; } }
            }
        }
#undef NA_LOADK
#undef NA_LOADV
#pragma unroll
        for (int q = 0; q < 2; ++q) {
            float lr = l_run[q]; lr += __shfl_xor(lr, 16); lr += __shfl_xor(lr, 32);
            const float inv = 1.0f / lr;
#pragma unroll
            for (int vt = 0; vt < 8; ++vt) { u32x2 ov; ov.x = cvt_pk_bf16(o[q][vt].x * inv, o[q][vt].y * inv); ov.y = cvt_pk_bf16(o[q][vt].z * inv, o[q][vt].w * inv);
                *(u32x2*)(OB + (tq + 64 * q) * LDOM + h * 128 + 16 * vt + 4 * g) = ov; } }
        __syncthreads();
    }
}
__device__ __forceinline__ void na_load_bias(const float* rpb, LAS unsigned char* lds) {
    const int tid = opaque_tid(); LAS float* rpbs = (LAS float*)(lds + 2 * 64 * 272);
    __syncthreads();
    for (int i = tid; i < 4 * 15 * 31; i += 512) rpbs[i] = rpb[i];
    __syncthreads();
}
__device__ __forceinline__ float logsig16(float z) { return (fminf(z, 0.f) - __logf(1.0f + __expf(-fabsf(z)))) * (1.0f / 16.0f); }
__device__ __forceinline__ void gla_seq_unit(const bf16_t* PROJ, const float* LR, const float* w_decay  , const float* b_decay  , bf16_t* OFB, bf16_t* OC, const float* onorm,
                                             LAS unsigned char* lds, int b, int h) {
    const int tid = opaque_tid(), lane = tid & 63, w = __builtin_amdgcn_readfirstlane(tid >> 6);
    constexpr int P64 = 144, PV = 272;
    constexpr int O_Q = 0, O_K = 9216, O_KH = 18432, O_V = 27648, O_S = 45056, O_DEC = 63488, O_W2 = 63744;
    const unsigned lbase = (unsigned)(uintptr_t)lds;
    const int ib = w & 3, vh = w >> 2, g = lane >> 4, li = lane & 15;
    LAS float* w2s = (LAS float*)(lds + O_W2);
    LAS float* gns = (LAS float*)(lds + 68608);
    __syncthreads(); if (tid < 128) gns[tid] = onorm[tid];
    LAS float* red = (LAS float*)(lds + 68096);
  for (int dir = 0; dir < 2; ++dir) {
    __syncthreads();
    for (int i = tid; i < 16 * 64; i += 512) w2s[i] = w_decay[dir * 4096 + (i >> 6) * 256 + h * 64 + (i & 63)];
    if (tid < 64) w2s[1024 + tid] = b_decay[dir * 256 + h * 64 + tid];
    for (int i = tid; i < 128 * 72 / 2; i += 512) ((LAS unsigned*)(lds + O_S))[i] = 0u;
    f32x4 S[4];
#pragma unroll
    for (int vt = 0; vt < 4; ++vt) S[vt] = (f32x4){0.f, 0.f, 0.f, 0.f};
    const int dcol = 8 * w;
    const int sr = tid >> 4, sc = (tid & 15) * 8;
    f32x4 lr4[4]; u32x4 qraw, kraw; bf16x8 vst0, vst1;
    u32x2 ofr[4], ogr[4];
#define GLA_LOAD_O(cc_) do { const int c_ = 31 - (cc_); const size_t mi_ = (size_t)b * SEQ + c_ * 64 + 16 * ib + li; \
        _Pragma("unroll") for (int vt = 0; vt < 4; ++vt) { ofr[vt] = *(const u32x2*)(OFB + mi_ * 512 + h * 128 + 64 * vh + 16 * vt + 4 * g); ogr[vt] = *(const u32x2*)(PROJ + mi_ * NPROJ + C_OG + h * 128 + 64 * vh + 16 * vt + 4 * g); } } while (0)
#define GLA_LOAD(cc_) do { const int c_ = dir ? 31 - (cc_) : (cc_); const size_t m0_ = (size_t)b * SEQ + c_ * 64, m_ = m0_ + lane; \
        _Pragma("unroll") for (int j = 0; j < 4; ++j) lr4[j] = ((const f32x4*)(LR + m_ * 32 + dir * 16))[j]; \
        qraw = *(const u32x4*)(PROJ + m_ * NPROJ + C_CQ + h * 64 + dcol); kraw = *(const u32x4*)(PROJ + m_ * NPROJ + C_CK + h * 64 + dcol); \
        vst0 = *(const bf16x8*)(PROJ + (m0_ + sr) * NPROJ + C_CV + h * 128 + sc); vst1 = *(const bf16x8*)(PROJ + (m0_ + sr + 32) * NPROJ + C_CV + h * 128 + sc); } while (0)
#pragma unroll
    for (int vt = 0; vt < 4; ++vt) { ofr[vt] = (u32x2){0u, 0u}; ogr[vt] = (u32x2){0u, 0u}; }
    GLA_LOAD(0);
    if (dir) GLA_LOAD_O(0);
    __syncthreads();
    for (int cc = 0; cc < 32; ++cc) {
        const int c = dir ? 31 - cc : cc; const size_t m0 = (size_t)b * SEQ + c * 64;
        {
            f32x4 z0 = *(const LAS f32x4*)(w2s + 1024 + dcol), z1 = *(const LAS f32x4*)(w2s + 1024 + dcol + 4);
#pragma unroll
            for (int j = 0; j < 4; ++j)
#pragma unroll
                for (int rr = 0; rr < 4; ++rr) { const int r = 4 * j + rr; z0 = z0 + *(const LAS f32x4*)(w2s + r * 64 + dcol) * lr4[j][rr]; z1 = z1 + *(const LAS f32x4*)(w2s + r * 64 + dcol + 4) * lr4[j][rr]; }
            float bs[8];
#pragma unroll
            for (int e = 0; e < 4; ++e) { bs[e] = logsig16(z0[e]); bs[4 + e] = logsig16(z1[e]); }
            if (dir == 0) {
#pragma unroll
                for (int off = 1; off < 64; off <<= 1)
#pragma unroll
                    for (int e = 0; e < 8; ++e) { const float t = __shfl_up(bs[e], off); if (lane >= off) bs[e] += t; }
            } else {
#pragma unroll
                for (int off = 1; off < 64; off <<= 1)
#pragma unroll
                    for (int e = 0; e < 8; ++e) { const float t = __shfl_down(bs[e], off); if (lane + off < 64) bs[e] += t; }
            }
            const float q[8] = {bflo(qraw.x), bfhi(qraw.x), bflo(qraw.y), bfhi(qraw.y), bflo(qraw.z), bfhi(qraw.z), bflo(qraw.w), bfhi(qraw.w)};
            const float k[8] = {bflo(kraw.x), bfhi(kraw.x), bflo(kraw.y), bfhi(kraw.y), bflo(kraw.z), bfhi(kraw.z), bflo(kraw.w), bfhi(kraw.w)};
            float qt[8], kt[8], kh[8], dc[8];
#pragma unroll
            for (int e = 0; e < 8; ++e) { const float be = __shfl(bs[e], dir ? 0 : 63);
                qt[e] = q[e] * 0.125f * __expf(bs[e]); kt[e] = k[e] * __expf(-bs[e]); kh[e] = k[e] * __expf(be - bs[e]); dc[e] = __expf(be); }
            *(LAS bf16x8*)(lds + O_Q + lane * P64 + 16 * w) = pack8(qt); *(LAS bf16x8*)(lds + O_K + lane * P64 + 16 * w) = pack8(kt); *(LAS bf16x8*)(lds + O_KH + lane * P64 + 16 * w) = pack8(kh);
            if (lane == 0) { *(LAS f32x4*)(lds + O_DEC + 4 * dcol) = (f32x4){dc[0], dc[1], dc[2], dc[3]}; *(LAS f32x4*)(lds + O_DEC + 4 * dcol + 16) = (f32x4){dc[4], dc[5], dc[6], dc[7]}; }
            *(LAS bf16x8*)(lds + O_V + sr * PV + sc * 2) = vst0; *(LAS bf16x8*)(lds + O_V + (sr + 32) * PV + sc * 2) = vst1;
        }
        __syncthreads();
        if (cc + 1 < 32) GLA_LOAD(cc + 1);
        const size_t mi = m0 + 16 * ib + li; f32x4 oo[4]; float ss = 0.f;
        {
            bf16x8 qF[2];
#pragma unroll
            for (int ks = 0; ks < 2; ++ks) qF[ks] = *(const LAS bf16x8*)(lds + O_Q + (16 * ib + li) * P64 + (32 * ks + 8 * g) * 2);
            f32x4 P[4];
#pragma unroll
            for (int jb = 0; jb < 4; ++jb) {
                f32x4 a = {0.f, 0.f, 0.f, 0.f};
                const bool need = dir ? (jb >= ib) : (jb <= ib);
                if (need) {
#pragma unroll
                    for (int ks = 0; ks < 2; ++ks) a = __builtin_amdgcn_mfma_f32_16x16x32_bf16(*(const LAS bf16x8*)(lds + O_K + (16 * jb + li) * P64 + (32 * ks + 8 * g) * 2), qF[ks], a, 0, 0, 0); }
#pragma unroll
                for (int r = 0; r < 4; ++r) { const int jl = 4 * g + r;
                    const bool keep = (jb == ib) ? (dir ? (jl >= li) : (jl <= li)) : need;
                    P[jb][r] = keep ? a[r] : 0.f; }
            }
            bf16x8 pfr[2];
#pragma unroll
            for (int s = 0; s < 2; ++s) { const float t[8] = {P[2 * s][0], P[2 * s][1], P[2 * s][2], P[2 * s][3], P[2 * s + 1][0], P[2 * s + 1][1], P[2 * s + 1][2], P[2 * s + 1][3]}; pfr[s] = pack8(t); }
            s16x4 vl[4][2], vhh[4][2], kl[2], kh2[2];
            {
                const unsigned vbase = lbase + O_V + (unsigned)((4 * g + (li >> 2)) * PV + (64 * vh + 4 * (li & 3)) * 2);
                const unsigned kbase = lbase + O_KH + (unsigned)((4 * g + (li >> 2)) * P64 + (16 * ib + 4 * (li & 3)) * 2);
                asm volatile("ds_read_b64_tr_b16 %0, %20 offset:0\n\t"
                         "ds_read_b64_tr_b16 %1, %20 offset:4352\n\t"
                         "ds_read_b64_tr_b16 %2, %20 offset:8704\n\t"
                         "ds_read_b64_tr_b16 %3, %20 offset:13056\n\t"
                         "ds_read_b64_tr_b16 %4, %20 offset:32\n\t"
                         "ds_read_b64_tr_b16 %5, %20 offset:4384\n\t"
                         "ds_read_b64_tr_b16 %6, %20 offset:8736\n\t"
                         "ds_read_b64_tr_b16 %7, %20 offset:13088\n\t"
                         "ds_read_b64_tr_b16 %8, %20 offset:64\n\t"
                         "ds_read_b64_tr_b16 %9, %20 offset:4416\n\t"
                         "ds_read_b64_tr_b16 %10, %20 offset:8768\n\t"
                         "ds_read_b64_tr_b16 %11, %20 offset:13120\n\t"
                         "ds_read_b64_tr_b16 %12, %20 offset:96\n\t"
                         "ds_read_b64_tr_b16 %13, %20 offset:4448\n\t"
                         "ds_read_b64_tr_b16 %14, %20 offset:8800\n\t"
                         "ds_read_b64_tr_b16 %15, %20 offset:13152\n\t"
                         "ds_read_b64_tr_b16 %16, %21 offset:0\n\t"
                         "ds_read_b64_tr_b16 %17, %21 offset:2304\n\t"
                         "ds_read_b64_tr_b16 %18, %21 offset:4608\n\t"
                         "ds_read_b64_tr_b16 %19, %21 offset:6912\n\t"
                         "s_waitcnt lgkmcnt(0)"
                         : "=&v"(vl[0][0]), "=&v"(vhh[0][0]), "=&v"(vl[0][1]), "=&v"(vhh[0][1]), "=&v"(vl[1][0]), "=&v"(vhh[1][0]), "=&v"(vl[1][1]), "=&v"(vhh[1][1]), "=&v"(vl[2][0]), "=&v"(vhh[2][0]), "=&v"(vl[2][1]), "=&v"(vhh[2][1]), "=&v"(vl[3][0]), "=&v"(vhh[3][0]), "=&v"(vl[3][1]), "=&v"(vhh[3][1]), "=&v"(kl[0]), "=&v"(kh2[0]), "=&v"(kl[1]), "=&v"(kh2[1])
                         : "v"(vbase), "v"(kbase) : "memory");
            }
            bf16x8 sfr[4][2];
#pragma unroll
            for (int vt = 0; vt < 4; ++vt)
#pragma unroll
                for (int ks = 0; ks < 2; ++ks) sfr[vt][ks] = *(const LAS bf16x8*)(lds + O_S + (64 * vh + 16 * vt + li) * P64 + (32 * ks + 8 * g) * 2);
            const float dec = *(const LAS float*)(lds + O_DEC + 4 * (16 * ib + li));
            __builtin_amdgcn_sched_barrier(0);
#pragma unroll
            for (int vt = 0; vt < 4; ++vt) {
                const int v0 = 64 * vh + 16 * vt;
                f32x4 o = {0.f, 0.f, 0.f, 0.f};
#pragma unroll
                for (int s = 0; s < 2; ++s) o = __builtin_amdgcn_mfma_f32_16x16x32_bf16(TR_JOIN(vl[vt][s], vhh[vt][s]), pfr[s], o, 0, 0, 0);
#pragma unroll
                for (int ks = 0; ks < 2; ++ks) o = __builtin_amdgcn_mfma_f32_16x16x32_bf16(sfr[vt][ks], qF[ks], o, 0, 0, 0);
                if (dir == 0) { u32x2 ov; ov.x = (unsigned)f2bf(o.x) | ((unsigned)f2bf(o.y) << 16); ov.y = (unsigned)f2bf(o.z) | ((unsigned)f2bf(o.w) << 16);
                    *(u32x2*)(OFB + mi * 512 + h * 128 + v0 + 4 * g) = ov; }
                else { const u32x2 f = ofr[vt];
                    o.x += bflo(f.x); o.y += bfhi(f.x); o.z += bflo(f.y); o.w += bfhi(f.y); oo[vt] = o; ss += (o.x * o.x + o.y * o.y) + (o.z * o.z + o.w * o.w); }
                f32x4 sn = S[vt] * dec;
#pragma unroll
                for (int s = 0; s < 2; ++s) sn = __builtin_amdgcn_mfma_f32_16x16x32_bf16(TR_JOIN(vl[vt][s], vhh[vt][s]), TR_JOIN(kl[s], kh2[s]), sn, 0, 0, 0);
                S[vt] = sn;
            }
        }
        if (dir) { ss += __shfl_xor(ss, 16); ss += __shfl_xor(ss, 32); if (g == 0) red[vh * 64 + 16 * ib + li] = ss; }
        __syncthreads();
        if (dir) {
            const float rstd = 1.0f / sqrtf((red[16 * ib + li] + red[64 + 16 * ib + li]) * (1.0f / 128.0f) + EPS);
#pragma unroll
            for (int vt = 0; vt < 4; ++vt) { const int v0 = 64 * vh + 16 * vt;
                const u32x2 og = ogr[vt]; const f32x4 gn = *(const LAS f32x4*)(gns + v0 + 4 * g);
                u32x2 ov; ov.x = cvt_pk_bf16(oo[vt].x * rstd * gn.x * pg8::silu_f(bflo(og.x)), oo[vt].y * rstd * gn.y * pg8::silu_f(bfhi(og.x)));
                ov.y = cvt_pk_bf16(oo[vt].z * rstd * gn.z * pg8::silu_f(bflo(og.y)), oo[vt].w * rstd * gn.w * pg8::silu_f(bfhi(og.y)));
                *(u32x2*)(OC + mi * LDOM + h * 128 + v0 + 4 * g) = ov; }
            if (cc + 1 < 32) GLA_LOAD_O(cc + 1);
        }
#pragma unroll
        for (int vt = 0; vt < 4; ++vt)
#pragma unroll
            for (int r = 0; r < 4; ++r) *(LAS bf16_t*)(lds + O_S + (64 * vh + 16 * vt + 4 * g + r) * P64 + (16 * ib + li) * 2) = f2bf(S[vt][r]);
    }
    __syncthreads();
  }
#undef GLA_LOAD
#undef GLA_LOAD_O
}
constexpr int NPH = 15;
enum { P_F1A = 0, P_F1B, P_N1, P_M1, P_PREP, P_ATT, P_NA, P_GLA, P_GLC, P_M4, P_M5, P_N2, P_F2A, P_F2B, P_N3 };
constexpr int NGP = 1 + DEPTH * NPH;
struct Args { const float* in[18]; float* out; unsigned char* ws; int gp_lo, gp_hi; };

typedef decltype(__builtin_amdgcn_kernarg_segment_ptr()) kargp_t;
__device__ __forceinline__ unsigned long long karg_q(int byte_off) { kargp_t p_ = __builtin_amdgcn_kernarg_segment_ptr(); asm volatile("" : "+s"(p_));
    return *(const unsigned long long __attribute__((address_space(4)))*)((const char __attribute__((address_space(4)))*)p_ + byte_off); }
__global__ void __launch_bounds__(512, 2) __attribute__((target("no-packed-fp32-ops"))) fwd(Args args) {
    extern __shared__ __attribute__((aligned(16))) unsigned char lds_raw[];
    LAS unsigned char* const lds0 = (LAS unsigned char*)lds_raw;
    const int G0 = gridDim.x, wg0 = blockIdx.x;
#define PENV LAS unsigned char* lds = lds0; int G = G0, wg = wg0; asm volatile("" : "+s"(lds), "+s"(G), "+s"(wg)); const int NGW = G * 8; (void)NGW; (void)lds; (void)wg
    volatile LAS unsigned* MISC = (volatile LAS unsigned*)(lds0 + MISC_OFF);
    volatile LAS unsigned long long* PT = (volatile LAS unsigned long long*)(lds0 + PTAB_OFF);
    { const int t0 = threadIdx.x;
      for (int u = t0; u < (LDS_BYTES - LDSCTL_OFF) / 4; u += 512) ((LAS unsigned*)(lds0 + LDSCTL_OFF))[u] = 0u;
      __syncthreads();
      __syncthreads(); }
#if ONE_LAUNCH
    constexpr int lo = 0, hi = NGP;
#else
    const int lo = args.gp_lo, hi = args.gp_hi;
#endif
    XcdBarrier bar; bar.bar = (unsigned*)(args.ws + WS_CTL) + CW_BAR; bar.x = 0; bar.st = nullptr;
    if (hi - lo > 1) bar = xcd_barrier_setup((unsigned*)(args.ws + WS_CTL) + CW_BAR, MISC + 8);
#define SEAM(gp) do { if ((gp) + 1 < hi) xcd_barrier(bar); } while (0)
#define INP(i) ((const float*)(const GAS float*)karg_q(8 * (i)))
#define WSP() ((unsigned char*)(GAS unsigned char*)karg_q(8 * 19))
#define XP() ((float*)(GAS float*)karg_q(8 * 18))
#define TIDS() PENV; const int tid = opaque_tid(), lane = tid & 63, wave = __builtin_amdgcn_readfirstlane(tid >> 6), gw = wg * 8 + wave; (void)tid; (void)lane; (void)wave; (void)gw

    if (((PHASE_MASK >> 31) & 1u) && lo <= 0 && 0 < hi) {
        TIDS(); unsigned char* ws = WSP(); bf16_t* XB = (bf16_t*)(ws + WS_XN); float* RSTD = (float*)(ws + WS_RSTD);
        LayerW w; w.w_in = INP(3); w.w_bra = INP(10); w.w_brb = INP(11); w.w_brc = INP(12); w.w_out = INP(13); w.f1i = INP(14); w.f1o = INP(15); w.f2i = INP(16); w.f2o = INP(17); w.ng = INP(2);
        if (wg == 0) { f32x2* cs = (f32x2*)(ws + WS_CTL + ROPE_OFF);
            for (int i = tid; i < 2048; i += 512) { const int pos = i >> 5, mi = i & 31; const float inv = powf(10000.0f, -(float)mi / 32.0f); float s, c; sincosf((float)pos * inv, &s, &c); cs[i] = (f32x2){c, s}; } }
        phase_weights(w, ws, lds, gw, NGW, wave, lane);
        const float* xp = INP(0); const float* xs = INP(1);
        for (int m = gw; m < M; m += NGW) {
            const float* src = m < 16 * SEQ ? xp + (size_t)m * D : xs + (size_t)(m - 16 * SEQ) * D;
            const f32x4* xr = (const f32x4*)src + lane; f32x4 x[8]; float s = 0.f;
#pragma unroll
            for (int j = 0; j < 8; ++j) { x[j] = xr[64 * j]; s += (x[j].x * x[j].x + x[j].y * x[j].y) + (x[j].z * x[j].z + x[j].w * x[j].w); }
            u32x2* o8 = (u32x2*)(XB + (size_t)m * D) + lane;
#pragma unroll
            for (int j = 0; j < 8; ++j) { u32x2 wv; wv.x = cvt_pk_bf16(x[j].x, x[j].y); wv.y = cvt_pk_bf16(x[j].z, x[j].w); o8[64 * j] = wv; }
            const float rstd = 1.0f / sqrtf(wave_sum(s) * (1.0f / D) + EPS);
            if (lane == 0) RSTD[m] = rstd;
        }
        SEAM(0);
    }
    for (int l = 0; l < DEPTH; ++l) {
        const int gp0 = 1 + l * NPH;
        if (gp0 + NPH <= lo || gp0 >= hi) continue;
#define IN(p) (((PHASE_MASK >> (p)) & 1u) && lo <= gp0 + (p) && gp0 + (p) < hi)
#define FFN_PAIR(ff, pa, pb) do { \
        if (IN(pa)) { PENV; unsigned char* ws = WSP(); pg8::Gemm g{(const bf16_t*)(ws + WS_XN), (const bf16_t*)(ws + ((ff) ? WS_WF2I : WS_WF1I)), M, 2 * FF, D, D}; pg8::StaticOrder S; S.init(M, 2 * FF, G, wg, WGM_FI); \
            pg8::EpiSwiGLU E{(bf16_t*)(ws + WS_H), (const float*)(ws + WS_RSTD)}; pg8::gemm_phase<pg8::EpiSwiGLU, pg8::StaticOrder, true, true>(lds, g, S, E); if ((DUP_MASK >> (pa)) & 1u) pg8::gemm_phase<pg8::EpiSwiGLU, pg8::StaticOrder, true, true>(lds, g, S, E); SEAM(gp0 + (pa)); } \
        if (IN(pb)) { PENV; unsigned char* ws = WSP(); pg8::Gemm g{(const bf16_t*)(ws + WS_H), (const bf16_t*)(ws + ((ff) ? WS_WF2O : WS_WF1O)), M, D, FF, FF}; pg8::StaticOrder S; S.init(M, D, G, wg, WGM_FO); \
            pg8::EpiBf16Plain E{(bf16_t*)(ws + WS_Y), D}; pg8::gemm_phase<pg8::EpiBf16Plain, pg8::StaticOrder, true, true>(lds, g, S, E); if ((DUP_MASK >> (pb)) & 1u) pg8::gemm_phase<pg8::EpiBf16Plain, pg8::StaticOrder, true, true>(lds, g, S, E); SEAM(gp0 + (pb)); } } while (0)
#define NORM_PHASE(p, ipost, coef, last) do { if (IN(p)) { TIDS(); unsigned char* ws = WSP(); const float* ng = INP(2) + (size_t)l * 6 * D; \
            phase_norm((bf16_t*)(ws + WS_XN), (const bf16_t*)(ws + WS_Y), (float*)(ws + WS_RSTD), (last) ? XP() : nullptr, ng + (ipost) * D, (coef), gw, NGW, lane);

        FFN_PAIR(0, P_F1A, P_F1B);
        NORM_PHASE(P_N1, 1, 0.5f, false) SEAM(gp0 + P_N1); } } while (0);
        if (IN(P_M1)) { PENV;
            unsigned char* ws = WSP();
            pg8::Gemm g{(const bf16_t*)(ws + WS_XN), (const bf16_t*)(ws + WS_WIN), M, NIN_PAD, D, D}; pg8::StaticOrder S; S.init(M, NIN_PAD, G, wg, WGM_M1);
            pg8::EpiProj E{(bf16_t*)(ws + WS_PROJ), (u32x4*)(ws + WS_GATES), (float*)(ws + WS_LR), INP(4) + (size_t)l * 3 * D, (const float*)(ws + WS_RSTD)};
            pg8::gemm_phase<pg8::EpiProj, pg8::StaticOrder, true, true>(lds, g, S, E);
            if ((DUP_MASK >> P_M1) & 1u) pg8::gemm_phase<pg8::EpiProj, pg8::StaticOrder, true, true>(lds, g, S, E);
            SEAM(gp0 + P_M1);
        }
        if (IN(P_ATT)) { PENV;
            unsigned char* ws = WSP(); bf16_t* PROJ = (bf16_t*)(ws + WS_PROJ);
            {
                const int tid_k = opaque_tid(), lane_k = tid_k & 63, gw_k = wg * 8 + __builtin_amdgcn_readfirstlane(tid_k >> 6);
                prep_k(PROJ, INP(5) + (size_t)l * 256, (const f32x2*)(ws + WS_CTL + ROPE_OFF), gw_k, G * 8, lane_k);
                asm volatile("s_waitcnt vmcnt(0)" ::: "memory"); __syncthreads();
                if (threadIdx.x == 0) { __builtin_amdgcn_fence(__ATOMIC_RELEASE, "agent"); asm volatile("s_waitcnt vmcnt(0)" ::: "memory");
                    __hip_atomic_fetch_add((unsigned*)(ws + WS_CTL) + CW_KRDY + 64 * l, 1u, __ATOMIC_RELAXED, __HIP_MEMORY_SCOPE_AGENT); }
            }
            bool k_ready = false;
            const int ngrp = (G % 8 == 0) ? 8 : 1, xg = wg % ngrp, slot = wg / ngrp, per = G / ngrp;
            for (int gu = slot; gu < 96 / ngrp; gu += per) { const int U = xg * (96 / ngrp) + gu;
                gla_seq_unit(PROJ, (const float*)(ws + WS_LR), INP(7) + (size_t)l * 2 * 16 * 256, INP(8) + (size_t)l * 512, (bf16_t*)(ws + WS_OFB), (bf16_t*)(ws + WS_OA) + OM_C, INP(9) + (size_t)l * 128, lds, U >> 2, U & 3); }
            na_load_bias(INP(6) + (size_t)l * 4 * 15 * 31, lds);
            unsigned* head = (unsigned*)(ws + WS_CTL) + CW_Q + (l * 8 + xg) * 64;
            const int n_att = 1536 / ngrp, n_na = (3072 / NAR) / ngrp;
            LAS unsigned* qslot = (LAS unsigned*)(lds + MISC_OFF + 64);
            for (;;) {
                __syncthreads();
                if (threadIdx.x == 0) *qslot = __hip_atomic_fetch_add(head, 1u, __ATOMIC_RELAXED, __HIP_MEMORY_SCOPE_AGENT);
                __syncthreads();
                const int idx = __builtin_amdgcn_readfirstlane((int)*(volatile LAS unsigned*)qslot);
                if (idx >= n_att * (1 + ATT_DUP) + n_na) break;
                if (idx < n_att * (1 + ATT_DUP)) { const int idx0 = idx; const int idx = idx0 % n_att;
                    const int rnd = idx >> 5, mem = idx & 31, grp = (ngrp == 8) ? rnd * 8 + xg : rnd;
                    const int b = grp >> 1, kvh = grp & 1, h = kvh * 4 + (mem >> 3), qb = mem & 7;
                    const size_t rowq = (size_t)b * SEQ + qb * 256, rowk = (size_t)b * SEQ;
                    bf16_t* Qp = PROJ + rowq * NPROJ + C_AQ + h * 128;
                    if (!k_ready) {
                        if (threadIdx.x == 0) { unsigned* kc = (unsigned*)(ws + WS_CTL) + CW_KRDY + 64 * l; unsigned sp = 0u;
                            while (__hip_atomic_load(kc, __ATOMIC_RELAXED, __HIP_MEMORY_SCOPE_AGENT) < (unsigned)G && ++sp < XB_SPIN_CAP) __builtin_amdgcn_s_sleep(1);
                            __builtin_amdgcn_fence(__ATOMIC_ACQUIRE, "agent"); asm volatile("s_waitcnt vmcnt(0)" ::: "memory"); }
                        __syncthreads(); k_ready = true; }
                    att::attn_dense_body(Qp, PROJ + rowk * NPROJ + C_AK + kvh * 128, PROJ + rowk * NPROJ + C_AV + kvh * 128, (bf16_t*)(ws + WS_OA) + rowq * LDOM + h * 128, SEQ, (char*)lds_raw + 49152, INP(5) + (size_t)l * 256, (const f32x2*)(ws + WS_CTL + ROPE_OFF), qb * 256);
                } else {
                    na_unit(PROJ, (bf16_t*)(ws + WS_OA) + OM_B, lds, xg * n_na + (idx - n_att * (1 + ATT_DUP)));
                }
            }
            SEAM(gp0 + P_GLA);
        }
        if (IN(P_M4)) { PENV;
            unsigned char* ws = WSP();
            pg8::Gemm g{(const bf16_t*)(ws + WS_OA), (const bf16_t*)(ws + WS_WBRA), M, D, LDOM, LDOM}; pg8::StaticOrder S; S.init(M, D, G, wg, WGM_M45);
            pg8::EpiMerge3 E{(const u32x4*)(ws + WS_GATES), (bf16_t*)(ws + WS_MG)};
            pg8::gemm_phase<pg8::EpiMerge3, pg8::StaticOrder, true, true>(lds, g, S, E);
            if ((DUP_MASK >> P_M4) & 1u) pg8::gemm_phase<pg8::EpiMerge3, pg8::StaticOrder, true, true>(lds, g, S, E);
            SEAM(gp0 + P_M4);
        }
        if (IN(P_M5)) { PENV;
            unsigned char* ws = WSP();
            pg8::Gemm g{(const bf16_t*)(ws + WS_MG), (const bf16_t*)(ws + WS_WOUT), M, D, D, D}; pg8::StaticOrder S; S.init(M, D, G, wg, WGM_M45);
            pg8::EpiBf16Plain E{(bf16_t*)(ws + WS_Y), D};
            pg8::gemm_phase<pg8::EpiBf16Plain, pg8::StaticOrder, true, true>(lds, g, S, E);
            if ((DUP_MASK >> P_M5) & 1u) pg8::gemm_phase<pg8::EpiBf16Plain, pg8::StaticOrder, true, true>(lds, g, S, E);
            SEAM(gp0 + P_M5);
        }
        NORM_PHASE(P_N2, 3, 1.0f, false) SEAM(gp0 + P_N2); } } while (0);
        FFN_PAIR(1, P_F2A, P_F2B);
        NORM_PHASE(P_N3, 5, 0.5f, (l + 1 == DEPTH))
            if (l + 1 < DEPTH) { LayerW w; w.w_in = INP(3) + (size_t)(l + 1) * D * NIN; w.w_bra = INP(10) + (size_t)(l + 1) * 1024 * D; w.w_brb = INP(11) + (size_t)(l + 1) * 512 * D; w.w_brc = INP(12) + (size_t)(l + 1) * 512 * D;
                w.w_out = INP(13) + (size_t)(l + 1) * D * D; w.f1i = INP(14) + (size_t)(l + 1) * D * 2 * FF; w.f1o = INP(15) + (size_t)(l + 1) * FF * D; w.f2i = INP(16) + (size_t)(l + 1) * D * 2 * FF; w.f2o = INP(17) + (size_t)(l + 1) * FF * D; w.ng = INP(2) + (size_t)(l + 1) * 6 * D;
                phase_weights(w, ws, lds, gw, NGW, wave, lane); if ((DUP_MASK >> 20) & 1u) phase_weights(w, ws, lds, gw, NGW, wave, lane); }
            SEAM(gp0 + P_N3); } } while (0);
#undef FFN_PAIR
#undef NORM_PHASE
#undef IN
    }
#undef SEAM
}

extern "C" void kernel_launch(void* const* d_in, const int* in_sizes, int n_in, void* d_out, int out_size, void* d_ws, size_t ws_size, hipStream_t stream) {
    static int grid = 0;
    if (grid == 0) {
        if (n_in != 18 || out_size != M * D || ws_size < WS_END) { fprintf(stderr, "kernel_launch: unexpected shapes: n_in %d out %d ws %zu (need %zu)\n", n_in, out_size, ws_size, (size_t)WS_END); grid = -1; return; }
        int dev = 0, cus = 0, per_cu = 0;
        if (hipGetDevice(&dev) != hipSuccess || hipDeviceGetAttribute(&cus, hipDeviceAttributeMultiprocessorCount, dev) != hipSuccess) { grid = -1; return; }
        if (hipFuncSetAttribute((const void*)fwd, hipFuncAttributeMaxDynamicSharedMemorySize, LDS_BYTES) != hipSuccess) { fprintf(stderr, "kernel_launch: hipFuncSetAttribute failed\n"); grid = -1; return; }
        if (hipOccupancyMaxActiveBlocksPerMultiprocessor(&per_cu, (const void*)fwd, 512, LDS_BYTES) != hipSuccess || per_cu < 1) fprintf(stderr, "kernel_launch: occupancy query says %d\n", per_cu);
        (void)hipGetLastError();
        grid = cus;
    }
    if (grid < 0) return;
    (void)hipMemsetAsync((char*)d_ws + WS_CTL, 0, CTL_BYTES, stream);
    Args a{};
    for (int i = 0; i < 18; ++i) a.in[i] = (const float*)d_in[i];
    a.out = (float*)d_out; a.ws = (unsigned char*)d_ws;
#if ONE_LAUNCH
    a.gp_lo = 0; a.gp_hi = NGP;
    hipLaunchKernelGGL(fwd, dim3(grid), dim3(512), LDS_BYTES, stream, a);
#else
    for (int gp = 0; gp < NGP; ++gp) { a.gp_lo = gp; a.gp_hi = gp + 1; hipLaunchKernelGGL(fwd, dim3(grid), dim3(512), LDS_BYTES, stream, a); }
#endif
    const hipError_t le = hipPeekAtLastError();
    if (le != hipSuccess) fprintf(stderr, "kernel_launch: launch failed: %s\n", hipGetErrorName(le));
}
```

```cpp
#include <hip/hip_runtime.h>
#include <cstdio>
#include <cstdint>
__device__ __forceinline__ void wg_sync() { __builtin_amdgcn_fence(__ATOMIC_RELEASE, "workgroup"); __builtin_amdgcn_s_barrier(); __builtin_amdgcn_fence(__ATOMIC_ACQUIRE, "workgroup"); }
#define __syncthreads() wg_sync()

#ifndef ONE_LAUNCH
#define ONE_LAUNCH 1
#endif
#ifndef WGM_FI
#define WGM_FI 4
#endif
#ifndef WGM_FO
#define WGM_FO 2
#endif
#ifndef WGM_M1
#define WGM_M1 4
#endif
#ifndef WGM_M45
#define WGM_M45 4
#endif
#ifndef ATT_DUP
#define ATT_DUP 0
#endif
#ifndef DUP_MASK
#define DUP_MASK 0u
#endif
#ifndef PHASE_MASK
#define PHASE_MASK 0xFFFFFFFFu
#endif

#define GAS __attribute__((address_space(1)))
#define LAS __attribute__((address_space(3)))
typedef unsigned short bf16_t;
typedef short bf16x8 __attribute__((ext_vector_type(8)));
typedef short s16x4 __attribute__((ext_vector_type(4)));
typedef float f32x4 __attribute__((ext_vector_type(4)));
typedef float f32x2 __attribute__((ext_vector_type(2)));
typedef float f32x16 __attribute__((ext_vector_type(16)));
typedef unsigned u32x4 __attribute__((ext_vector_type(4)));
typedef unsigned u32x2 __attribute__((ext_vector_type(2)));

constexpr int M = 49152;
constexpr int SEQ = 2048, NSEQ = 24;
constexpr int D = 2048, FF = 5632, DEPTH = 4;
constexpr int NPROJ = 4608;
constexpr int NGATE = 6144;
constexpr int NIN = 10784, NIN_PAD = 11008;
constexpr int C_AQ = 0, C_AK = 1024, C_AV = 1280, C_BQ = 1536, C_BK = 2048, C_BV = 2560, C_CQ = 3072, C_CK = 3328, C_CV = 3584, C_OG = 4096;
constexpr int C_OC = 3072;
constexpr float EPS = 1e-6f;

constexpr size_t MiB = 1u << 20;
constexpr size_t WS_CTL = 0, CTL_BYTES = 1 * MiB;
constexpr size_t WS_WIN = 2 * MiB;
constexpr size_t WS_WF1I = 45 * MiB;
constexpr size_t WS_WF1O = 89 * MiB;
constexpr size_t WS_WF2I = 111 * MiB;
constexpr size_t WS_WF2O = 155 * MiB;
constexpr size_t WS_WBRA = 177 * MiB;
constexpr size_t WS_WBRB = 181 * MiB;
constexpr size_t WS_WBRC = 183 * MiB;
constexpr size_t WS_WOUT = 185 * MiB;
constexpr size_t WS_XN = 193 * MiB;
constexpr size_t WS_BIG = 385 * MiB;
constexpr size_t WS_PROJ = WS_BIG;
constexpr size_t WS_GATES = WS_BIG + 432 * MiB;
constexpr size_t WS_LR = WS_BIG + 1008 * MiB;
constexpr size_t WS_H = WS_BIG;
constexpr size_t WS_Y = WS_BIG + 528 * MiB;
constexpr size_t WS_OFB = WS_BIG + 1014 * MiB;
constexpr size_t WS_MG = WS_OFB + 48 * MiB;
constexpr size_t WS_RSTD = WS_MG + 192 * MiB;
constexpr size_t WS_OA = WS_RSTD + 1 * MiB;
constexpr int LDOM = 2048, OM_B = 1024, OM_C = 1536;
constexpr size_t WS_END = WS_OA + 192 * MiB;
constexpr int CW_Q = 32768;
static_assert(WS_Y + (size_t)M * D * 4 <= WS_LR, "Y inside GATES region");
constexpr int CW_BAR = 4096;
constexpr int CW_POOL = 57344;
constexpr int CW_KRDY = 49152;
constexpr size_t ROPE_OFF = 524288;

__device__ __forceinline__ unsigned cvt_pk_bf16(float lo, float hi) { unsigned r; asm volatile("v_cvt_pk_bf16_f32 %0, %1, %2" : "=v"(r) : "v"(lo), "v"(hi)); return r; }
__device__ __forceinline__ float bflo(unsigned w) { return __uint_as_float(w << 16); }
__device__ __forceinline__ float bfhi(unsigned w) { return __uint_as_float(w & 0xffff0000u); }
__device__ __forceinline__ float bf2f(bf16_t v) { return __uint_as_float(((unsigned)v) << 16); }
__device__ __forceinline__ bf16_t f2bf(float f) { unsigned u = __float_as_uint(f); return (bf16_t)((u + 0x7fffu + ((u >> 16) & 1u)) >> 16); }
template <int CTRL> __device__ __forceinline__ float dpp_f(float v) { return __int_as_float(__builtin_amdgcn_update_dpp(0, __float_as_int(v), CTRL, 0xF, 0xF, true)); }
__device__ __forceinline__ float wave_sum(float v) {
    v += dpp_f<0xB1>(v); v += dpp_f<0x4E>(v); v += dpp_f<0x141>(v); v += dpp_f<0x140>(v);
    const int b = __float_as_int(v);
    return (__int_as_float(__builtin_amdgcn_readlane(b, 0)) + __int_as_float(__builtin_amdgcn_readlane(b, 16))) + (__int_as_float(__builtin_amdgcn_readlane(b, 32)) + __int_as_float(__builtin_amdgcn_readlane(b, 48)));
}
__device__ __forceinline__ float wave_max(float v) {
#pragma unroll
    for (int o = 1; o < 64; o <<= 1) v = fmaxf(v, __shfl_xor(v, o));
    return v;
}
__device__ __forceinline__ int opaque_tid() { int t = threadIdx.x; asm volatile("" : "+v"(t)); return t; }
__device__ __forceinline__ unsigned char* opq(unsigned char* p) { asm volatile("" : "+s"(p)); return p; }
__device__ __forceinline__ const float* lds_ptr(volatile LAS unsigned long long* tab, int i) { const unsigned long long v = tab[i];
    const unsigned lo = __builtin_amdgcn_readfirstlane((unsigned)v), hi = __builtin_amdgcn_readfirstlane((unsigned)(v >> 32)); return (const float*)(((unsigned long long)hi << 32) | lo); }
#define LDS_WAIT() asm volatile("s_waitcnt lgkmcnt(0)" ::: "memory")
#define VM_WAIT() asm volatile("s_waitcnt vmcnt(0)" ::: "memory")

namespace pg8 {
constexpr int BM = 256, BK = 64, HALF = 128, HTB = HALF * BK * 2, STAGE_BYTES = 8 * HTB, NXCD = 8;
__host__ __device__ __forceinline__ int lds_byte(int r, int c) { const int st = (r >> 4) * 2 + (c >> 5), rr = r & 15, cc = c & 31, ob = rr * 64 + cc * 2; return st * 1024 + (ob ^ (((ob >> 9) & 1) << 5)); }
__host__ __device__ __forceinline__ void stage_rc(int b, int& R, int& C) { const int st = b / 1024, sb = b % 1024, swz = sb ^ (((sb >> 9) & 1) << 5); R = (st >> 1) * 16 + swz / 64; C = (st & 1) * 32 + (swz % 64) / 2; }
__host__ __device__ __forceinline__ int perm32(int rho) { const int n = rho >> 4, i = rho & 15; return 8 * (i >> 2) + 4 * n + (i & 3); }

struct Unit { int pm, pn; };
struct Gemm { const bf16_t* A; const bf16_t* Bt; int M, N, K, lda; };

struct StaticOrder {
    int nM, nN, nwg, G, c, WGM;
    __host__ __device__ __forceinline__ void init(int M_, int N_, int G_, int c_, int wgm_ = 4) { nM = M_ / BM; nN = N_ / BM; nwg = nM * nN; G = G_; c = c_; WGM = wgm_; }
    __host__ __device__ bool next(int i, Unit& u) const {
        const long L = (long)i * G + c; if (L >= nwg) return false;
        int wgid = (int)L; { const int q = nwg / NXCD, r = nwg % NXCD, xcd = wgid % NXCD, off = wgid / NXCD; wgid = (xcd < r ? xcd * (q + 1) : r * (q + 1) + (xcd - r) * q) + off; }
        const int nig = WGM * nN, gid = wgid / nig, fm = gid * WGM, gsz = (nM - fm) < WGM ? (nM - fm) : WGM;
        u.pm = fm + ((wgid % nig) % gsz); u.pn = (wgid % nig) / gsz; return true;
    }
    __device__ __forceinline__ void a_ready(const Unit&) const {}
    __device__ __forceinline__ void done(const Unit&) const {}
};
template <int ROUNDS> struct StaticOrderCut : StaticOrder {
    __device__ __forceinline__ bool next(int i, Unit& u) const { if (i >= ROUNDS) return false; return StaticOrder::next(i, u); }
    __device__ __forceinline__ int pool_size() const { const int n = nwg - ROUNDS * G; return n > 0 ? n : 0; }
    __device__ __forceinline__ void pool_unit(int p, Unit& u) const { StaticOrder t = *this; t.c = p; t.next(ROUNDS, u); }
};
struct OneUnit {
    Unit u;
    __device__ __forceinline__ bool next(int i, Unit& o) const { if (i) return false; o = u; return true; }
    __device__ __forceinline__ void a_ready(const Unit&) const {}
    __device__ __forceinline__ void done(const Unit&) const {}
};

struct EpiF32 {
    static constexpr bool PERM = false, AFTER_DRAIN = false, HAS_MID = false, USES_RSTD = false;
    float* C; int ldc;
    __device__ __forceinline__ void operator()(const f32x4 (&acc)[2][2][4][2], const Unit& u, int wr, int wc, int fr, int fq, const LAS float* rsl) const {
        const int row0 = u.pm * BM + wr * 64 + fr, col0 = u.pn * BM + wc * 32 + 4 * fq;
#pragma unroll
        for (int ai = 0; ai < 2; ++ai)
#pragma unroll
            for (int m = 0; m < 4; ++m) { float* rowp = C + (size_t)(row0 + ai * HALF + m * 16) * ldc + col0;
#pragma unroll
                for (int bj = 0; bj < 2; ++bj)
#pragma unroll
                    for (int n = 0; n < 2; ++n) *(f32x4*)(rowp + bj * HALF + n * 16) = acc[ai][bj][m][n]; }
    }
};
struct EpiBf16Plain {
    static constexpr bool PERM = true, AFTER_DRAIN = false, HAS_MID = false, USES_RSTD = false;
    bf16_t* C; int ldc;
    __device__ __forceinline__ void operator()(const f32x4 (&acc)[2][2][4][2], const Unit& u, int wr, int wc, int fr, int fq, const LAS float* rsl) const {
        const int row0 = u.pm * BM + wr * 64 + fr, col0 = u.pn * BM + wc * 32 + 8 * fq;
#pragma unroll
        for (int ai = 0; ai < 2; ++ai)
#pragma unroll
            for (int m = 0; m < 4; ++m) { bf16_t* p = C + (size_t)(row0 + ai * HALF + m * 16) * ldc + col0;
#pragma unroll
                for (int bj = 0; bj < 2; ++bj) { const f32x4 v0 = acc[ai][bj][m][0], v1 = acc[ai][bj][m][1];
                    u32x4 w; w.x = cvt_pk_bf16(v0[0], v0[1]); w.y = cvt_pk_bf16(v0[2], v0[3]); w.z = cvt_pk_bf16(v1[0], v1[1]); w.w = cvt_pk_bf16(v1[2], v1[3]);
                    *(u32x4*)(p + bj * HALF) = w; } }
    }
};
__device__ __forceinline__ float silu_f(float g) { return g * __builtin_amdgcn_rcpf(1.0f + __builtin_amdgcn_exp2f(-1.4426950408889634f * g)); }
__device__ __forceinline__ float sigmoid_f(float g) { return __builtin_amdgcn_rcpf(1.0f + __builtin_amdgcn_exp2f(-1.4426950408889634f * g)); }
__device__ __forceinline__ float swiglu1(float a, float b, float nrs, float irs2) { const float e = __builtin_amdgcn_exp2f(a * nrs); return (a * b) * __builtin_amdgcn_rcpf(__builtin_fmaf(e, irs2, irs2)); }
struct EpiSwiGLU {
    static constexpr bool PERM = true, AFTER_DRAIN = false, HAS_MID = false, USES_RSTD = true;
    bf16_t* H; const float* rstd;
    __device__ __forceinline__ void operator()(const f32x4 (&acc)[2][2][4][2], const Unit& u, int wr, int wc, int fr, int fq, const LAS float* rsl) const {
        const int row0 = u.pm * BM + wr * 64 + fr, col0 = u.pn * HALF + wc * 32 + 8 * fq;
#pragma unroll
        for (int ai = 0; ai < 2; ++ai)
#pragma unroll
            for (int m = 0; m < 4; ++m) { bf16_t* p = H + (size_t)(row0 + ai * HALF + m * 16) * FF + col0; const float rs = rsl[wr * 64 + fr + ai * HALF + m * 16];
                const float nrs = -1.4426950408889634f * rs, irs2 = __builtin_amdgcn_rcpf(rs * rs);
                const f32x4 a0 = acc[ai][0][m][0], a1 = acc[ai][0][m][1], b0 = acc[ai][1][m][0], b1 = acc[ai][1][m][1];
                float e[8], pr[8];
#pragma unroll
                for (int i = 0; i < 4; ++i) { e[i] = a0[i] * nrs; e[4 + i] = a1[i] * nrs; }
#pragma unroll
                for (int i = 0; i < 8; ++i) e[i] = __builtin_amdgcn_exp2f(e[i]);
#pragma unroll
                for (int i = 0; i < 4; ++i) { pr[i] = a0[i] * b0[i]; pr[4 + i] = a1[i] * b1[i]; }
#pragma unroll
                for (int i = 0; i < 8; ++i) e[i] = __builtin_fmaf(e[i], irs2, irs2);
#pragma unroll
                for (int i = 0; i < 8; ++i) e[i] = __builtin_amdgcn_rcpf(e[i]);
#pragma unroll
                for (int i = 0; i < 8; ++i) pr[i] *= e[i];
                u32x4 w; w.x = cvt_pk_bf16(pr[0], pr[1]); w.y = cvt_pk_bf16(pr[2], pr[3]); w.z = cvt_pk_bf16(pr[4], pr[5]); w.w = cvt_pk_bf16(pr[6], pr[7]);
                *(u32x4*)p = w; }
    }
};
__device__ __forceinline__ float gate_k(float a, float nrs, float nb) { const float e = __builtin_amdgcn_exp2f(__builtin_fmaf(a, nrs, nb));
    return fmaxf(__builtin_rintf(__builtin_amdgcn_rcpf(__builtin_fmaf(e, 1.0f / 255.0f, 1.0f / 255.0f))), 1.0f); }
__device__ __forceinline__ unsigned gate_q4(const f32x4 a, float nrs, const f32x4 nb) { unsigned w = __builtin_amdgcn_cvt_pk_u8_f32(gate_k(a[0], nrs, nb[0]), 0u, 0u); w = __builtin_amdgcn_cvt_pk_u8_f32(gate_k(a[1], nrs, nb[1]), 1u, w);
    w = __builtin_amdgcn_cvt_pk_u8_f32(gate_k(a[2], nrs, nb[2]), 2u, w); return __builtin_amdgcn_cvt_pk_u8_f32(gate_k(a[3], nrs, nb[3]), 3u, w); }
__device__ __forceinline__ f32x4 ub4(unsigned w) { return (f32x4){(float)(w & 0xffu), (float)((w >> 8) & 0xffu), (float)((w >> 16) & 0xffu), (float)(w >> 24)}; }
__device__ __forceinline__ f32x4 rcp4(const f32x4 v) { return (f32x4){__builtin_amdgcn_rcpf(v[0]), __builtin_amdgcn_rcpf(v[1]), __builtin_amdgcn_rcpf(v[2]), __builtin_amdgcn_rcpf(v[3])}; }
struct EpiProj {
    static constexpr bool PERM = true, AFTER_DRAIN = false, HAS_MID = false, USES_RSTD = true;
    bf16_t* PROJ; u32x4* GQ; float* LR; const float* gbias; const float* rstd;
    __device__ __forceinline__ void operator()(const f32x4 (&acc)[2][2][4][2], const Unit& u, int wr, int wc, int fr, int fq, const LAS float* rsl) const {
        const int row0 = u.pm * BM + wr * 64 + fr;
        if (u.pn < 18) {
            const int col0 = u.pn * BM + wc * 32 + 8 * fq;
#pragma unroll
            for (int ai = 0; ai < 2; ++ai)
#pragma unroll
                for (int m = 0; m < 4; ++m) { bf16_t* p = PROJ + (size_t)(row0 + ai * HALF + m * 16) * NPROJ + col0; const float rs = rsl[wr * 64 + fr + ai * HALF + m * 16];
#pragma unroll
                    for (int bj = 0; bj < 2; ++bj) { const f32x4 v0 = acc[ai][bj][m][0] * rs, v1 = acc[ai][bj][m][1] * rs;
                        u32x4 w; w.x = cvt_pk_bf16(v0[0], v0[1]); w.y = cvt_pk_bf16(v0[2], v0[3]); w.z = cvt_pk_bf16(v1[0], v1[1]); w.w = cvt_pk_bf16(v1[2], v1[3]);
                        *(u32x4*)(p + bj * HALF) = w; } }
        } else if (u.pn < 42) {
            const int gt = u.pn - 18, col0 = gt * BM + wc * 32 + 8 * fq;
            constexpr float NL2E = -1.4426950408889634f;
            const f32x4 b00 = *(const f32x4*)(gbias + col0) * NL2E, b01 = *(const f32x4*)(gbias + col0 + 4) * NL2E, b10 = *(const f32x4*)(gbias + col0 + HALF) * NL2E, b11 = *(const f32x4*)(gbias + col0 + HALF + 4) * NL2E;
            u32x4* gq = GQ + ((size_t)((gt >> 3) * (M / BM) + u.pm) * 8 + (gt & 7)) * 4096 + (wr * 4 + wc) * 512 + (fq * 16 + fr);
#pragma unroll
            for (int ai = 0; ai < 2; ++ai)
#pragma unroll
                for (int m = 0; m < 4; ++m) { const float nrs = NL2E * rsl[wr * 64 + fr + ai * HALF + m * 16];
                    float k[16];
#pragma unroll
                    for (int i = 0; i < 4; ++i) { k[i] = __builtin_fmaf(acc[ai][0][m][0][i], nrs, b00[i]); k[4 + i] = __builtin_fmaf(acc[ai][0][m][1][i], nrs, b01[i]);
                        k[8 + i] = __builtin_fmaf(acc[ai][1][m][0][i], nrs, b10[i]); k[12 + i] = __builtin_fmaf(acc[ai][1][m][1][i], nrs, b11[i]); }
#pragma unroll
                    for (int i = 0; i < 16; ++i) k[i] = __builtin_amdgcn_exp2f(k[i]);
#pragma unroll
                    for (int i = 0; i < 16; ++i) k[i] = __builtin_fmaf(k[i], 1.0f / 255.0f, 1.0f / 255.0f);
#pragma unroll
                    for (int i = 0; i < 16; ++i) k[i] = __builtin_amdgcn_rcpf(k[i]);
#pragma unroll
                    for (int i = 0; i < 16; ++i) k[i] = fmaxf(__builtin_rintf(k[i]), 1.0f);
                    u32x4 w;
                    w.x = __builtin_amdgcn_cvt_pk_u8_f32(k[3], 3u, __builtin_amdgcn_cvt_pk_u8_f32(k[2], 2u, __builtin_amdgcn_cvt_pk_u8_f32(k[1], 1u, __builtin_amdgcn_cvt_pk_u8_f32(k[0], 0u, 0u))));
                    w.y = __builtin_amdgcn_cvt_pk_u8_f32(k[7], 3u, __builtin_amdgcn_cvt_pk_u8_f32(k[6], 2u, __builtin_amdgcn_cvt_pk_u8_f32(k[5], 1u, __builtin_amdgcn_cvt_pk_u8_f32(k[4], 0u, 0u))));
                    w.z = __builtin_amdgcn_cvt_pk_u8_f32(k[11], 3u, __builtin_amdgcn_cvt_pk_u8_f32(k[10], 2u, __builtin_amdgcn_cvt_pk_u8_f32(k[9], 1u, __builtin_amdgcn_cvt_pk_u8_f32(k[8], 0u, 0u))));
                    w.w = __builtin_amdgcn_cvt_pk_u8_f32(k[15], 3u, __builtin_amdgcn_cvt_pk_u8_f32(k[14], 2u, __builtin_amdgcn_cvt_pk_u8_f32(k[13], 1u, __builtin_amdgcn_cvt_pk_u8_f32(k[12], 0u, 0u))));
                    gq[(ai * 4 + m) * 64] = w; }
        } else {
            if (wc == 0) {
#pragma unroll
                for (int ai = 0; ai < 2; ++ai)
#pragma unroll
                    for (int m = 0; m < 4; ++m) { float* p = LR + (size_t)(row0 + ai * HALF + m * 16) * 32 + 8 * fq; const float rs = rsl[wr * 64 + fr + ai * HALF + m * 16];
                        *(f32x4*)p = acc[ai][0][m][0] * rs; *(f32x4*)(p + 4) = acc[ai][0][m][1] * rs; }
            }
        }
    }
};
struct EpiMerge3 {
    static constexpr bool PERM = true, AFTER_DRAIN = false, HAS_MID = true, USES_RSTD = false;
    static constexpr int MID0 = 1024 / BK, MID1 = 1536 / BK;
    static constexpr size_t GSTRIDE = (size_t)(M / BM) * 8 * 4096;
    const u32x4* GQ; bf16_t* MG;
    __device__ __forceinline__ void mid(f32x4 (&acc)[2][2][4][2], const Unit& u, int seg, int wr, int wc, int fr, int fq) const {
        const u32x4* gp = GQ + (size_t)seg * GSTRIDE + ((size_t)u.pm * 8 + u.pn) * 4096 + (wr * 4 + wc) * 512 + (fq * 16 + fr);
        u32x4 gn[8], gd[8];
#pragma unroll
        for (int j = 0; j < 8; ++j) { gn[j] = gp[j * 64]; gd[j] = gp[GSTRIDE + j * 64]; }
#pragma unroll
        for (int j = 0; j < 8; ++j) { const int ai = j >> 2, m = j & 3;
            acc[ai][0][m][0] = acc[ai][0][m][0] * (ub4(gn[j].x) * rcp4(ub4(gd[j].x))); acc[ai][0][m][1] = acc[ai][0][m][1] * (ub4(gn[j].y) * rcp4(ub4(gd[j].y)));
            acc[ai][1][m][0] = acc[ai][1][m][0] * (ub4(gn[j].z) * rcp4(ub4(gd[j].z))); acc[ai][1][m][1] = acc[ai][1][m][1] * (ub4(gn[j].w) * rcp4(ub4(gd[j].w))); }
    }
    __device__ __forceinline__ void operator()(const f32x4 (&acc)[2][2][4][2], const Unit& u, int wr, int wc, int fr, int fq, const LAS float* rsl) const {
        const int row0 = u.pm * BM + wr * 64 + fr, col0 = u.pn * BM + wc * 32 + 8 * fq;
        const u32x4* gp = GQ + 2 * GSTRIDE + ((size_t)u.pm * 8 + u.pn) * 4096 + (wr * 4 + wc) * 512 + (fq * 16 + fr);
        u32x4 gc[8];
#pragma unroll
        for (int j = 0; j < 8; ++j) gc[j] = gp[j * 64];
        constexpr float S = 1.0f / 255.0f;
#pragma unroll
        for (int j = 0; j < 8; ++j) { const int ai = j >> 2, m = j & 3; bf16_t* p = MG + (size_t)(row0 + ai * HALF + m * 16) * D + col0;
            const f32x4 v0 = acc[ai][0][m][0] * (ub4(gc[j].x) * S), v1 = acc[ai][0][m][1] * (ub4(gc[j].y) * S), v2 = acc[ai][1][m][0] * (ub4(gc[j].z) * S), v3 = acc[ai][1][m][1] * (ub4(gc[j].w) * S);
            u32x4 w; w.x = cvt_pk_bf16(v0[0], v0[1]); w.y = cvt_pk_bf16(v0[2], v0[3]); w.z = cvt_pk_bf16(v1[0], v1[1]); w.w = cvt_pk_bf16(v1[2], v1[3]); *(u32x4*)p = w;
            w.x = cvt_pk_bf16(v2[0], v2[1]); w.y = cvt_pk_bf16(v2[2], v2[3]); w.z = cvt_pk_bf16(v3[0], v3[1]); w.w = cvt_pk_bf16(v3[2], v3[3]); *(u32x4*)(p + HALF) = w; }
    }
};

template <class Epi, class Sched, bool ALIGN_EPI = false, bool SP2 = false>
__device__ __forceinline__ void gemm_phase(LAS unsigned char* lds, const Gemm g, const Sched& S, const Epi& E) {
    const int tid = opaque_tid(), wid = __builtin_amdgcn_readfirstlane(tid >> 6), lane = tid & 63, wr = wid >> 2, wc = wid & 3, fr = lane & 15, fq = lane >> 4;
    const int K = g.K, nt = K / BK, lda = g.lda;
    unsigned voffA[2], voffB[2];
#pragma unroll
    for (int i = 0; i < 2; ++i) { int R, C; stage_rc(tid * 16 + i * 8192, R, C); const int Rb = Epi::PERM ? ((R & ~31) + perm32(R & 31)) : R;
        voffA[i] = (unsigned)(R * lda + C) * 2u; voffB[i] = (unsigned)(Rb * K + C) * 2u; }
    const unsigned kstep = (unsigned)(BK * 2);
    const unsigned hstepA = (unsigned)HALF * (unsigned)lda * 2u, hstepB = (unsigned)HALF * (unsigned)K * 2u;
    const unsigned tstepA = 2u * hstepA, tstepB = 2u * hstepB;
    const unsigned ldsw = (unsigned)wid * 1024u;
    const int aoff = lds_byte(wr * 64 + fr, fq * 8), boff = lds_byte(wc * 32 + fr, fq * 8);
    const char* const baseA = (const char*)g.A; const char* const baseB = (const char*)g.Bt;
#define PG8_SA(b, h) (((b) * 2 + (h)) * HTB)
#define PG8_SB(b, h) ((4 + (b) * 2 + (h)) * HTB)
#define PG8_STAGE(bufoff, gbase, goff, voff) do { _Pragma("unroll") for (int _i = 0; _i < 2; ++_i) \
        __builtin_amdgcn_global_load_lds((const unsigned*)((gbase) + (size_t)(unsigned)((goff) + (voff)[_i])), (LAS unsigned*)(lds + (bufoff) + ldsw + _i * 8192), 16, 0, 0); } while (0)
#define PG8_LDA(dst, b, h) do { _Pragma("unroll") for (int m = 0; m < 4; ++m) _Pragma("unroll") for (int k = 0; k < 2; ++k) dst[m][k] = *(const LAS bf16x8*)(lds + PG8_SA(b, h) + aoff + m * 2048 + k * 1024); } while (0)
#define PG8_LDB(dst, b, h) do { _Pragma("unroll") for (int n = 0; n < 2; ++n) _Pragma("unroll") for (int k = 0; k < 2; ++k) dst[n][k] = *(const LAS bf16x8*)(lds + PG8_SB(b, h) + boff + n * 2048 + k * 1024); } while (0)
#define PG8_MMA(ai, bj, At, Bt) do { __builtin_amdgcn_s_setprio(1); _Pragma("unroll") for (int m = 0; m < 4; ++m) _Pragma("unroll") for (int n = 0; n < 2; ++n) _Pragma("unroll") for (int k = 0; k < 2; ++k) \
        acc[ai][bj][m][n] = __builtin_amdgcn_mfma_f32_16x16x32_bf16(Bt[n][k], At[m][k], acc[ai][bj][m][n], 0, 0, 0); __builtin_amdgcn_s_setprio(0); } while (0)
#define PG8_WAIT_V(n) asm volatile("s_waitcnt vmcnt(" #n ")" ::: "memory")
#define PG8_WAIT_L(n) asm volatile("s_waitcnt lgkmcnt(" #n ")" ::: "memory")
#define PG8_BAR __builtin_amdgcn_s_barrier()
#define PG8_SCHED __builtin_amdgcn_sched_barrier(0)
    Unit cur, nxt; int ui = 0;
    if (!S.next(0, cur)) return;
    constexpr int RS_OFF = 131072 + 8192;
#define PG8_RSTD(u_, slot_) do { if constexpr (Epi::USES_RSTD) { if (wid == 0) __builtin_amdgcn_global_load_lds((const unsigned*)(E.rstd + (size_t)(u_).pm * BM + lane * 4), (LAS unsigned*)(lds + RS_OFF + (slot_) * 1024), 16, 0, 0); } } while (0)
    PG8_RSTD(cur, 0);
    f32x4 acc[2][2][4][2];
#pragma unroll
    for (int a = 0; a < 2; ++a)
#pragma unroll
        for (int b = 0; b < 2; ++b)
#pragma unroll
            for (int m = 0; m < 4; ++m)
#pragma unroll
                for (int n = 0; n < 2; ++n) acc[a][b][m][n] = (f32x4){0.f, 0.f, 0.f, 0.f};
    bf16x8 At[4][2], B0[2][2], B1[2][2];
    unsigned cA = (unsigned)cur.pm * tstepA, cB = (unsigned)cur.pn * tstepB;
    S.a_ready(cur);
    if constexpr (SP2) {
        PG8_STAGE(PG8_SB(0, 0), baseB, cB, voffB); PG8_STAGE(PG8_SB(0, 1), baseB, cB + hstepB, voffB); PG8_STAGE(PG8_SA(0, 0), baseA, cA, voffA); PG8_STAGE(PG8_SA(0, 1), baseA, cA + hstepA, voffA);
        if (wr == 1) PG8_BAR;
        PG8_WAIT_V(2); PG8_BAR;
        PG8_STAGE(PG8_SB(1, 0), baseB, cB + kstep, voffB); PG8_STAGE(PG8_SA(1, 0), baseA, cA + kstep, voffA); PG8_STAGE(PG8_SB(1, 1), baseB, cB + hstepB + kstep, voffB);
        PG8_WAIT_V(6); PG8_BAR;
    } else {
        PG8_STAGE(PG8_SB(0, 0), baseB, cB, voffB); PG8_STAGE(PG8_SA(0, 0), baseA, cA, voffA); PG8_STAGE(PG8_SB(0, 1), baseB, cB + hstepB, voffB); PG8_STAGE(PG8_SA(0, 1), baseA, cA + hstepA, voffA);
        if (wr == 1) PG8_BAR;
        PG8_WAIT_V(4); PG8_BAR;
        PG8_STAGE(PG8_SB(1, 0), baseB, cB + kstep, voffB); PG8_STAGE(PG8_SA(1, 0), baseA, cA + kstep, voffA); PG8_STAGE(PG8_SB(1, 1), baseB, cB + hstepB + kstep, voffB);
        PG8_WAIT_V(6); PG8_BAR;
    }
    for (;;) {
        const bool has_next = S.next(ui + 1, nxt);
        const unsigned nA = has_next ? (unsigned)nxt.pm * tstepA : cA, nB = has_next ? (unsigned)nxt.pn * tstepB : cB;
        for (int t = 0; t < nt; t += 2) {
            const bool last = (t == nt - 2);
            if constexpr (Epi::HAS_MID) { if (t == Epi::MID0 || t == Epi::MID1) E.mid(acc, cur, t == Epi::MID0 ? 0 : 1, wr, wc, fr, fq); }
            const unsigned a1 = cA + (unsigned)(t + 1) * kstep;
            const unsigned a2 = last ? nA : cA + (unsigned)(t + 2) * kstep, b2 = last ? nB : cB + (unsigned)(t + 2) * kstep;
            const unsigned a3 = a2 + kstep, b3 = b2 + kstep;
            if (last && has_next) S.a_ready(nxt);
            if constexpr (SP2) {
            PG8_LDB(B0, 0, 0); PG8_LDB(B1, 0, 1); PG8_SCHED; PG8_LDA(At, 0, 0); PG8_STAGE(PG8_SA(1, 1), baseA, a1 + hstepA, voffA);
            PG8_WAIT_V(8); PG8_WAIT_L(0); PG8_BAR; PG8_MMA(0, 0, At, B0); PG8_MMA(0, 1, At, B1); PG8_BAR; PG8_SCHED;
            PG8_LDA(At, 0, 1); PG8_STAGE(PG8_SB(0, 0), baseB, b2, voffB); PG8_STAGE(PG8_SB(0, 1), baseB, b2 + hstepB, voffB); PG8_STAGE(PG8_SA(0, 0), baseA, a2, voffA);
            PG8_WAIT_V(8); PG8_WAIT_L(0); PG8_BAR; PG8_MMA(1, 0, At, B0); PG8_MMA(1, 1, At, B1); PG8_BAR; PG8_SCHED;
            PG8_LDB(B0, 1, 0); PG8_LDB(B1, 1, 1); PG8_SCHED; PG8_LDA(At, 1, 0); PG8_STAGE(PG8_SA(0, 1), baseA, a2 + hstepA, voffA);
            PG8_WAIT_V(8); PG8_WAIT_L(0); PG8_BAR; PG8_MMA(0, 0, At, B0); PG8_MMA(0, 1, At, B1); PG8_BAR; PG8_SCHED;
            PG8_LDA(At, 1, 1); PG8_STAGE(PG8_SB(1, 0), baseB, b3, voffB); PG8_STAGE(PG8_SB(1, 1), baseB, b3 + hstepB, voffB); PG8_STAGE(PG8_SA(1, 0), baseA, a3, voffA);
            PG8_WAIT_V(8); PG8_WAIT_L(0); PG8_BAR; PG8_MMA(1, 0, At, B0); PG8_MMA(1, 1, At, B1); PG8_BAR; PG8_SCHED;
            } else {
            PG8_LDB(B0, 0, 0); PG8_SCHED; PG8_LDA(At, 0, 0); PG8_STAGE(PG8_SA(1, 1), baseA, a1 + hstepA, voffA);
            PG8_WAIT_L(8); PG8_BAR; PG8_WAIT_L(0); PG8_MMA(0, 0, At, B0); PG8_BAR; PG8_SCHED;
            PG8_LDB(B1, 0, 1); PG8_STAGE(PG8_SB(0, 0), baseB, b2, voffB);
            PG8_BAR; PG8_WAIT_L(0); PG8_MMA(0, 1, At, B1); PG8_BAR;
            PG8_LDA(At, 0, 1); PG8_STAGE(PG8_SA(0, 0), baseA, a2, voffA);
            PG8_BAR; PG8_WAIT_L(0); PG8_MMA(1, 0, At, B0); PG8_BAR; PG8_SCHED;
            PG8_STAGE(PG8_SB(0, 1), baseB, b2 + hstepB, voffB);
            PG8_WAIT_V(6); PG8_BAR; PG8_MMA(1, 1, At, B1); PG8_BAR;
            PG8_LDB(B0, 1, 0); PG8_SCHED; PG8_LDA(At, 1, 0); PG8_STAGE(PG8_SA(0, 1), baseA, a2 + hstepA, voffA);
            PG8_WAIT_L(8); PG8_BAR; PG8_WAIT_L(0); PG8_MMA(0, 0, At, B0); PG8_BAR; PG8_SCHED;
            PG8_LDB(B1, 1, 1); PG8_STAGE(PG8_SB(1, 0), baseB, b3, voffB);
            PG8_BAR; PG8_WAIT_L(0); PG8_MMA(0, 1, At, B1); PG8_BAR;
            PG8_LDA(At, 1, 1); PG8_STAGE(PG8_SA(1, 0), baseA, a3, voffA);
            PG8_BAR; PG8_WAIT_L(0); PG8_MMA(1, 0, At, B0); PG8_BAR; PG8_SCHED;
            PG8_STAGE(PG8_SB(1, 1), baseB, b3 + hstepB, voffB);
            PG8_WAIT_V(6); PG8_BAR; PG8_MMA(1, 1, At, B1); PG8_BAR;
            }
        }
        if constexpr (ALIGN_EPI) { if (wr == 0) PG8_BAR; }
        if constexpr (!Epi::AFTER_DRAIN) { E(acc, cur, wr, wc, fr, fq, (const LAS float*)(lds + RS_OFF + (ui & 1) * 1024)); S.done(cur); }
        if (!has_next) break;
#pragma unroll
        for (int a = 0; a < 2; ++a)
#pragma unroll
            for (int b = 0; b < 2; ++b)
#pragma unroll
                for (int m = 0; m < 4; ++m)
#pragma unroll
                    for (int n = 0; n < 2; ++n) acc[a][b][m][n] = (f32x4){0.f, 0.f, 0.f, 0.f};
        cur = nxt; cA = nA; cB = nB; ++ui;
        PG8_RSTD(cur, ui & 1);
        if constexpr (ALIGN_EPI) { if (wr == 1) PG8_BAR; }
    }
    PG8_WAIT_V(0);
    if constexpr (!ALIGN_EPI) { if (wr == 0) PG8_BAR; }
    PG8_BAR;
#undef PG8_SA
#undef PG8_SB
#undef PG8_STAGE
#undef PG8_LDA
#undef PG8_LDB
#undef PG8_MMA
#undef PG8_WAIT_V
#undef PG8_WAIT_L
#undef PG8_BAR
#undef PG8_SCHED
}
}

namespace att {
constexpr int DH = 128, NW = 8, QBLK = 32, KVBLK = 64;
constexpr float SCALE = 0.088388347648318440f;
constexpr float THR = 8.f;
constexpr int LD = NPROJ, LDO = 2048;
constexpr size_t SHM_V = KVBLK * DH * 2, SHM_K = KVBLK * DH * 2, SHM_ATTN = 2 * SHM_V + 2 * SHM_K + NW * 64 * 4;
#define KSWZ(row, colB) ((row) * 256 + ((colB) ^ (((row) & 7) << 4)))
#define SBAR() __builtin_amdgcn_sched_barrier(0)
__device__ __forceinline__ int crow(int r, int hi) { return (r & 3) + 8 * (r >> 2) + 4 * hi; }
__device__ __forceinline__ void partialSM(f32x16& p0, f32x16& p1, float& m_reg, float& mn, float& alpha) {
  constexpr float C = SCALE * 1.4426950408889634f;
  float pmax = p0[0];
#pragma unroll
  for (int r = 1; r < 16; ++r) pmax = fmaxf(pmax, p0[r]);
#pragma unroll
  for (int r = 0; r < 16; ++r) pmax = fmaxf(pmax, p1[r]);
  { auto rr = __builtin_amdgcn_permlane32_swap(__float_as_uint(pmax), __float_as_uint(pmax), false, false);
    pmax = fmaxf(__uint_as_float(rr[0]), __uint_as_float(rr[1])); }
  if (__builtin_expect(__all(pmax - m_reg <= THR / SCALE), 1)) { mn = m_reg; alpha = 1.f; }
  else { mn = fmaxf(m_reg, pmax); alpha = __builtin_amdgcn_exp2f((m_reg - mn) * C); m_reg = mn; }
  float mnC = -mn * C;
#pragma unroll
  for (int r = 0; r < 16; ++r) p0[r] = fmaf(p0[r], C, mnC);
#pragma unroll
  for (int r = 0; r < 16; ++r) p1[r] = fmaf(p1[r], C, mnC);
#pragma unroll
  for (int r = 0; r < 16; ++r) p0[r] = __builtin_amdgcn_exp2f(p0[r]);
}
__device__ __forceinline__ void finishSM(f32x16& p0, f32x16& p1, float alpha, float& l_reg, bf16x8& pa0, bf16x8& pa1, bf16x8& pa2, bf16x8& pa3) {
#pragma unroll
  for (int r = 0; r < 16; ++r) p1[r] = __builtin_amdgcn_exp2f(p1[r]);
  float ps = 0;
#pragma unroll
  for (int r = 0; r < 16; ++r) ps += p0[r];
#pragma unroll
  for (int r = 0; r < 16; ++r) ps += p1[r];
  { auto rr = __builtin_amdgcn_permlane32_swap(__float_as_uint(ps), __float_as_uint(ps), false, false);
    ps = __uint_as_float(rr[0]) + __uint_as_float(rr[1]); }
  l_reg = l_reg * alpha + ps;
#define PK4(P, BASE, OUT) do { unsigned a0 = cvt_pk_bf16(P[BASE + 0], P[BASE + 1]), a1 = cvt_pk_bf16(P[BASE + 2], P[BASE + 3]);   \
    unsigned b0 = cvt_pk_bf16(P[BASE + 4], P[BASE + 5]), b1 = cvt_pk_bf16(P[BASE + 6], P[BASE + 7]);                              \
    auto r0 = __builtin_amdgcn_permlane32_swap(a0, b0, false, false); auto r1 = __builtin_amdgcn_permlane32_swap(a1, b1, false, false); \
    u32x4 w = {r0[0], r1[0], r0[1], r1[1]}; OUT = *reinterpret_cast<bf16x8*>(&w); } while (0)
  PK4(p0, 0, pa0); PK4(p0, 8, pa1); PK4(p1, 0, pa2); PK4(p1, 8, pa3);
#undef PK4
}
__device__ __forceinline__ void qkt(f32x16& p0, f32x16& p1, const bf16_t* Ks, const bf16x8* qr, int r32, int hi) {
  p0 = f32x16{}; p1 = f32x16{};
#pragma unroll
  for (int d0 = 0; d0 < 8; ++d0) { int cb = (d0 * 16 + hi * 8) * 2;
    bf16x8 b0 = *reinterpret_cast<const bf16x8*>((const char*)Ks + KSWZ(r32, cb));
    bf16x8 b1 = *reinterpret_cast<const bf16x8*>((const char*)Ks + KSWZ(32 + r32, cb));
    p0 = __builtin_amdgcn_mfma_f32_32x32x16_bf16(b0, qr[d0], p0, 0, 0, 0);
    p1 = __builtin_amdgcn_mfma_f32_32x32x16_bf16(b1, qr[d0], p1, 0, 0, 0); }
}
__device__ __forceinline__ int v_st(int k, int c) { const int kk = (k & ~0xC) | ((k & 4) << 1) | ((k & 8) >> 1); return ((kk >> 3) * 4 + (c >> 5)) * 512 + ((kk & 7) * 32 + (c & 31)) * 2; }
__device__ __forceinline__ int v_rd_base(int lane) { return ((lane & 3) << 3) | (((lane >> 2) & 3) << 6) | (((lane >> 4) & 1) << 5) | (((lane >> 5) & 1) << 8); }
constexpr int v_rd_off(int d0, int ks, int half) { return d0 * 512 + ks * 4096 + half * 2048; }
template <int OFF> __device__ __forceinline__ s16x4 tr_read(int vb) {
  s16x4 r; asm volatile("ds_read_b64_tr_b16 %0, %1 offset:%2" : "=&v"(r) : "v"(vb), "i"(OFF) : "memory"); return r;
}
template <int D0> __device__ __forceinline__ void pv_one(f32x16& od, int vb, bf16x8 pa0, bf16x8 pa1, bf16x8 pa2, bf16x8 pa3) {
  const s16x4 l0 = tr_read<v_rd_off(D0, 0, 0)>(vb), h0 = tr_read<v_rd_off(D0, 0, 1)>(vb), l1 = tr_read<v_rd_off(D0, 1, 0)>(vb), h1 = tr_read<v_rd_off(D0, 1, 1)>(vb);
  const s16x4 l2 = tr_read<v_rd_off(D0, 2, 0)>(vb), h2 = tr_read<v_rd_off(D0, 2, 1)>(vb), l3 = tr_read<v_rd_off(D0, 3, 0)>(vb), h3 = tr_read<v_rd_off(D0, 3, 1)>(vb);
  asm volatile("s_waitcnt lgkmcnt(0)" ::: "memory"); SBAR();
#define PK(L, H) (bf16x8){L[0], L[1], L[2], L[3], H[0], H[1], H[2], H[3]}
  od = __builtin_amdgcn_mfma_f32_32x32x16_bf16(pa0, PK(l0, h0), od, 0, 0, 0);
  od = __builtin_amdgcn_mfma_f32_32x32x16_bf16(pa1, PK(l1, h1), od, 0, 0, 0);
  od = __builtin_amdgcn_mfma_f32_32x32x16_bf16(pa2, PK(l2, h2), od, 0, 0, 0);
  od = __builtin_amdgcn_mfma_f32_32x32x16_bf16(pa3, PK(l3, h3), od, 0, 0, 0);
#undef PK
}
__device__ __forceinline__ void pv_d0(f32x16* o, int vb, bf16x8 pa0, bf16x8 pa1, bf16x8 pa2, bf16x8 pa3) {
  pv_one<0>(o[0], vb, pa0, pa1, pa2, pa3); pv_one<1>(o[1], vb, pa0, pa1, pa2, pa3); pv_one<2>(o[2], vb, pa0, pa1, pa2, pa3); pv_one<3>(o[3], vb, pa0, pa1, pa2, pa3);
}
__device__ __forceinline__ void attn_dense_body(const bf16_t* Qb, const bf16_t* __restrict__ Kh, const bf16_t* __restrict__ Vh, bf16_t* Ob, int seq, char* lds, const float* qgain  , const f32x2* cs  , int t0  ) {
  const int tid = opaque_tid(), wid = tid >> 6, lane = tid & 63, r32 = lane & 31, hi = lane >> 5;
  bf16_t* V_lds = (bf16_t*)lds; bf16_t* K_lds = (bf16_t*)(lds + 2 * SHM_V);
  float* ws = (float*)(lds + 2 * SHM_V + 2 * SHM_K) + wid * 64; float* li_l = ws; float* al_l = ws + 32;
  float m_reg = -1e30f, l_reg = 0; f32x16 o[4] = {}; bf16x8 qr[8];
  const bf16_t* Qw = Qb + (long)(wid * QBLK + r32) * LD + hi * 8;
#pragma unroll
  for (int d0 = 0; d0 < 8; ++d0) qr[d0] = *reinterpret_cast<const bf16x8*>(Qw + d0 * 16);
  {
    float ss = 0.f;
#pragma unroll
    for (int d0 = 0; d0 < 8; ++d0) { const u32x4 w = *reinterpret_cast<const u32x4*>(&qr[d0]);
      ss += (bflo(w.x) * bflo(w.x) + bfhi(w.x) * bfhi(w.x)) + (bflo(w.y) * bflo(w.y) + bfhi(w.y) * bfhi(w.y)) + (bflo(w.z) * bflo(w.z) + bfhi(w.z) * bfhi(w.z)) + (bflo(w.w) * bflo(w.w) + bfhi(w.w) * bfhi(w.w)); }
    { auto rr = __builtin_amdgcn_permlane32_swap(__float_as_uint(ss), __float_as_uint(ss), false, false); ss = __uint_as_float(rr[0]) + __uint_as_float(rr[1]); }
    const float rstd = 1.0f / sqrtf(ss * (1.0f / 128.0f) + EPS);
    const int t = t0 + wid * QBLK + r32, pr = t >> 6, pc = t & 63;
#pragma unroll
    for (int d0 = 0; d0 < 8; ++d0) {
      const f32x4 g0 = *(const f32x4*)(qgain + d0 * 16 + hi * 8) * rstd, g1 = *(const f32x4*)(qgain + d0 * 16 + hi * 8 + 4) * rstd;
      const f32x4* cp = (const f32x4*)(cs + ((d0 < 4) ? pr : pc) * 32 + (d0 & 3) * 8 + hi * 4); const f32x4 ca = cp[0], cb = cp[1];
      const u32x4 w = *reinterpret_cast<const u32x4*>(&qr[d0]); u32x4 o;
      { const float n1 = bflo(w.x) * g0[0], n2 = bfhi(w.x) * g0[1]; o.x = cvt_pk_bf16(n1 * ca[0] - n2 * ca[1], n1 * ca[1] + n2 * ca[0]); }
      { const float n1 = bflo(w.y) * g0[2], n2 = bfhi(w.y) * g0[3]; o.y = cvt_pk_bf16(n1 * ca[2] - n2 * ca[3], n1 * ca[3] + n2 * ca[2]); }
      { const float n1 = bflo(w.z) * g1[0], n2 = bfhi(w.z) * g1[1]; o.z = cvt_pk_bf16(n1 * cb[0] - n2 * cb[1], n1 * cb[1] + n2 * cb[0]); }
      { const float n1 = bflo(w.w) * g1[2], n2 = bfhi(w.w) * g1[3]; o.w = cvt_pk_bf16(n1 * cb[2] - n2 * cb[3], n1 * cb[3] + n2 * cb[2]); }
      qr[d0] = *reinterpret_cast<const bf16x8*>(&o);
    }
  }
  const int sr = tid >> 4, sc = (tid & 15) * 8, vst0 = v_st(sr, sc), vst1 = v_st(32 + sr, sc);
  const int vb0 = (int)(uintptr_t)V_lds + v_rd_base(lane);
  struct { bf16x8 vs0, vs1, ks0, ks1; } sr_[1];
#define SLOAD(i, k0) do { sr_[i].vs0 = *reinterpret_cast<const bf16x8*>(&Vh[(long)((k0) + sr) * LD + sc]); sr_[i].vs1 = *reinterpret_cast<const bf16x8*>(&Vh[(long)((k0) + 32 + sr) * LD + sc]); \
    sr_[i].ks0 = *reinterpret_cast<const bf16x8*>(&Kh[(long)((k0) + sr) * LD + sc]); sr_[i].ks1 = *reinterpret_cast<const bf16x8*>(&Kh[(long)((k0) + 32 + sr) * LD + sc]); } while (0)
#define SWRITE(b, i) do { *(bf16x8*)((char*)V_lds + (b) * SHM_V + vst0) = sr_[i].vs0;          \
    *(bf16x8*)((char*)V_lds + (b) * SHM_V + vst1) = sr_[i].vs1; int kc = sc * 2;               \
    *(bf16x8*)((char*)K_lds + (b) * SHM_K + KSWZ(sr, kc)) = sr_[i].ks0;                       \
    *(bf16x8*)((char*)K_lds + (b) * SHM_K + KSWZ(32 + sr, kc)) = sr_[i].ks1; } while (0)
#define SWAIT() asm volatile("s_waitcnt vmcnt(0)" ::: "memory")
#define RESC(a) do { if (__any((a) < 1.f)) { if (hi == 0) al_l[r32] = (a); asm volatile("s_waitcnt lgkmcnt(0)" ::: "memory"); \
    _Pragma("unroll") for (int d = 0; d < 4; ++d) _Pragma("unroll") for (int r = 0; r < 16; ++r) o[d][r] *= al_l[crow(r, hi)]; } } while (0)
  f32x16 pA0, pA1, pB0, pB1; float mnA, mnB, alA, alB; bf16x8 pa0, pa1, pa2, pa3; const int NT = seq / KVBLK;
  constexpr int SE = 0, SO = 0;
  SLOAD(SE, 0); asm volatile("s_waitcnt vmcnt(0)" ::: "memory"); SWRITE(0, SE); __syncthreads();
  qkt(pA0, pA1, K_lds, qr, r32, hi); partialSM(pA0, pA1, m_reg, mnA, alA);
  SLOAD(SO, KVBLK);
  SWAIT(); SWRITE(1, SO); __syncthreads();
  for (int j = 1; j + 1 < NT; j += 2) {
    SBAR(); qkt(pB0, pB1, (bf16_t*)((char*)K_lds + SHM_K), qr, r32, hi);
    finishSM(pA0, pA1, alA, l_reg, pa0, pa1, pa2, pa3); SBAR();
    SLOAD(SO, (j + 1) * KVBLK); SBAR();
    pv_d0(o, vb0, pa0, pa1, pa2, pa3); partialSM(pB0, pB1, m_reg, mnB, alB);
    __syncthreads(); SWAIT(); SWRITE(0, SE);
    RESC(alB); __syncthreads();
    SBAR(); qkt(pA0, pA1, K_lds, qr, r32, hi);
    finishSM(pB0, pB1, alB, l_reg, pa0, pa1, pa2, pa3); SBAR();
    SLOAD(SE, (j + 2) * KVBLK); SBAR();
    pv_d0(o, vb0 + (int)SHM_V, pa0, pa1, pa2, pa3); partialSM(pA0, pA1, m_reg, mnA, alA);
    __syncthreads(); SWAIT(); SWRITE(1, SO);
    RESC(alA); __syncthreads();
  }
  SBAR(); qkt(pB0, pB1, (bf16_t*)((char*)K_lds + SHM_K), qr, r32, hi);
  finishSM(pA0, pA1, alA, l_reg, pa0, pa1, pa2, pa3); SBAR();
  pv_d0(o, vb0, pa0, pa1, pa2, pa3); partialSM(pB0, pB1, m_reg, mnB, alB);
  __syncthreads(); RESC(alB);
  finishSM(pB0, pB1, alB, l_reg, pa0, pa1, pa2, pa3); SBAR();
  pv_d0(o, vb0 + (int)SHM_V, pa0, pa1, pa2, pa3);
  if (hi == 0) li_l[r32] = l_reg; asm volatile("s_waitcnt lgkmcnt(0)" ::: "memory");
  float rli[16];
#pragma unroll
  for (int r = 0; r < 16; ++r) rli[r] = __builtin_amdgcn_rcpf(li_l[crow(r, hi)]);
  bf16_t* Ow = Ob + (long)(wid * QBLK) * LDO;
#pragma unroll
  for (int r = 0; r < 16; ++r) { int orow = crow(r, hi);
#pragma unroll
    for (int d0 = 0; d0 < 4; ++d0) Ow[(long)orow * LDO + d0 * 32 + r32] = f2bf(o[d0][r] * rli[r]); }
  __syncthreads();
#undef SLOAD
#undef SWRITE
#undef SWAIT
#undef RESC
}
}

constexpr int RING_BYTES = 131072;
constexpr int LDSCTL_OFF = RING_BYTES, MISC_OFF = LDSCTL_OFF + 320, PTAB_OFF = LDSCTL_OFF + 1024;
constexpr int LDS_BYTES = 147456;

#define XB_TMO      128
#define XB_XCNT(j)  (256  + 64 * (j))
#define XB_XSUB(j)  (1280 + 64 * (j))
#define XB_XGEN(j)  (2304 + 64 * (j))
#define XB_TOP      3328
#define XB_TOPGEN   3392
#define XCD_BAR_WORDS 3456
#define XB_SPIN_CAP (1u << 22)
__device__ __forceinline__ unsigned xb_ld(unsigned* p)              { return __hip_atomic_load(p, __ATOMIC_RELAXED, __HIP_MEMORY_SCOPE_AGENT); }
__device__ __forceinline__ unsigned xb_add(unsigned* p, unsigned v) { return __hip_atomic_fetch_add(p, v, __ATOMIC_RELAXED, __HIP_MEMORY_SCOPE_AGENT); }
__device__ __forceinline__ unsigned xb_xcc_id() { return (unsigned)__builtin_amdgcn_s_getreg((3 << 11) | 20) & 0xFu; }
#define XB_SPIN(cond, bar) do { unsigned _sp = 0; while (cond) { __builtin_amdgcn_s_sleep(1); \
    if ((++_sp & 255u) == 0u) { if (xb_ld(&(bar)[XB_TMO])) break; if (_sp > XB_SPIN_CAP) { atomicAdd(&(bar)[XB_TMO], 1u); break; } } } } while (0)
struct XcdBarrier { unsigned* bar; unsigned x; volatile LAS unsigned* st; };
__device__ __forceinline__ XcdBarrier xcd_barrier_post(unsigned* bar, volatile LAS unsigned* st) {
    XcdBarrier b; b.bar = bar; b.x = xb_xcc_id(); b.st = st;
    if (threadIdx.x == 0) (void)xb_add(&bar[XB_XCNT(b.x)], 1u);
    return b;
}
__device__ __forceinline__ void xcd_barrier_complete(unsigned* bar, unsigned x, unsigned& nloc, unsigned& nx) {
    const unsigned G = gridDim.x * gridDim.y * gridDim.z;
    unsigned sum, cnt, mine, sp = 0u;
    for (;;) {
        sum = 0u; cnt = 0u;
        for (unsigned j = 0; j < 16; ++j) { const unsigned c = xb_ld(&bar[XB_XCNT(j)]); sum += c; cnt += (c > 0u) ? 1u : 0u; }
        mine = xb_ld(&bar[XB_XCNT(x)]);
        if (sum == G) break;
        __builtin_amdgcn_s_sleep(1);
        if ((++sp & 255u) == 0u) { if (xb_ld(&bar[XB_TMO])) break; if (sp > XB_SPIN_CAP) { atomicAdd(&bar[XB_TMO], 1u); break; } }
    }
    nloc = mine > 0u ? mine : 1u; nx = cnt > 0u ? cnt : 1u;
}
__device__ __forceinline__ XcdBarrier xcd_barrier_setup(unsigned* bar, volatile LAS unsigned* st) {
    XcdBarrier b = xcd_barrier_post(bar, st);
    if (threadIdx.x == 0) { unsigned nloc, nx; xcd_barrier_complete(bar, b.x, nloc, nx); st[0] = nloc; st[1] = nx; }
    __syncthreads();
    return b;
}
__device__ __forceinline__ void xcd_barrier(const XcdBarrier& b) {
    asm volatile("s_waitcnt vmcnt(0)" ::: "memory");
    __syncthreads();
    if (threadIdx.x == 0) {
        unsigned* bar = b.bar; unsigned bx = b.x;
        asm volatile("" : "+s"(bar), "+s"(bx));
        __builtin_amdgcn_s_waitcnt(0);
        const unsigned nloc = b.st[0], nx = b.st[1];
        const unsigned old = xb_add(&bar[XB_XSUB(bx)], 1u);
        const unsigned gen = old / nloc;
        if (old + 1u == (gen + 1u) * nloc) {
            __builtin_amdgcn_fence(__ATOMIC_RELEASE, "agent");
            asm volatile("s_waitcnt vmcnt(0)" ::: "memory");
            const unsigned og = xb_add(&bar[XB_TOP], 1u);
            const unsigned tg = og / nx;
            if (og + 1u == (tg + 1u) * nx) xb_add(&bar[XB_TOPGEN], 1u);
            else XB_SPIN(xb_ld(&bar[XB_TOPGEN]) == tg, bar);
            __builtin_amdgcn_fence(__ATOMIC_ACQUIRE, "agent");
            xb_add(&bar[XB_XGEN(bx)], 1u);
            asm volatile("s_waitcnt vmcnt(0)" ::: "memory");
        } else {
            XB_SPIN(xb_ld(&bar[XB_XGEN(bx)]) == gen, bar);
            __builtin_amdgcn_fence(__ATOMIC_ACQUIRE, "agent");
            asm volatile("s_waitcnt vmcnt(0)" ::: "memory");
        }
    }
    __syncthreads();
}

__device__ __forceinline__ void transpose_item(const float* W, int ldw, int K, int k0, int srccol0, bf16_t* WT, int dstrow0, LAS float* scr, int lane, const float* kgain = nullptr, int ldt = 0) {
    const int KT = ldt ? ldt : K;
    constexpr int P = 36;
    const int n4 = (lane & 7) * 4, kr = lane >> 3;
    f32x4 v[8];
    if (srccol0 >= 0) {
#pragma unroll
        for (int i = 0; i < 8; ++i) v[i] = *(const f32x4*)(W + (size_t)(k0 + 8 * i + kr) * ldw + srccol0 + n4);
        if (kgain) {
#pragma unroll
            for (int i = 0; i < 8; ++i) v[i] = v[i] * kgain[k0 + 8 * i + kr];
        }
    } else {
#pragma unroll
        for (int i = 0; i < 8; ++i) v[i] = (f32x4){0.f, 0.f, 0.f, 0.f};
    }
#pragma unroll
    for (int i = 0; i < 8; ++i) *(LAS f32x4*)(scr + (8 * i + kr) * P + n4) = v[i];
    LDS_WAIT(); asm volatile("" ::: "memory");
    const int c = lane & 7;
#pragma unroll
    for (int j = 0; j < 4; ++j) { const int n = (lane >> 3) + 8 * j; const LAS float* s = scr + (8 * c) * P + n;
        u32x4 o; o.x = cvt_pk_bf16(s[0 * P], s[1 * P]); o.y = cvt_pk_bf16(s[2 * P], s[3 * P]); o.z = cvt_pk_bf16(s[4 * P], s[5 * P]); o.w = cvt_pk_bf16(s[6 * P], s[7 * P]);
        *(u32x4*)(WT + (size_t)(dstrow0 + n) * KT + k0 + 8 * c) = o; }
    LDS_WAIT(); asm volatile("" ::: "memory");
}
struct LayerW { const float *w_in, *w_bra, *w_brb, *w_brc, *w_out, *f1i, *f1o, *f2i, *f2o, *ng; };
__device__ __forceinline__ void phase_weights(const LayerW& w, unsigned char* ws, LAS unsigned char* lds, int gw, int NGW, int wave, int lane) {
    LAS float* scr = (LAS float*)(lds + wave * 16384);
    constexpr int I_IN = (NIN_PAD / 32) * (D / 64);
    constexpr int I_FI = (2 * FF / 32) * (D / 64);
    constexpr int I_FO = (D / 32) * (FF / 64);
    constexpr int I_BA = (D / 32) * (1024 / 64);
    constexpr int I_BB = (D / 32) * (512 / 64);
    constexpr int I_WO = (D / 32) * (D / 64);
    constexpr int NITEMS = I_IN + 2 * I_FI + 2 * I_FO + I_BA + 2 * I_BB + I_WO;
    for (int it = gw; it < NITEMS; it += NGW) {
        int r = it;
        if (r < I_IN) { const int nb = r % (NIN_PAD / 32), kb = r / (NIN_PAD / 32); const int d0 = nb * 32;
            const int src = d0 < 4608 ? d0 : (d0 < 10752 ? d0 + 32 : (d0 < 10784 ? 4608 + (d0 - 10752) : -1));
            transpose_item(w.w_in, NIN, D, kb * 64, src, (bf16_t*)(ws + WS_WIN), d0, scr, lane, w.ng + 2 * D); continue; } r -= I_IN;
        if (r < 2 * I_FI) { const int which = r / I_FI; r -= which * I_FI; const int nb = r % (2 * FF / 32), kb = r / (2 * FF / 32); const int d0 = nb * 32;
            const int t = d0 >> 8, within = d0 & 255; const int src = within < 128 ? 128 * t + within : FF + 128 * t + (within - 128);
            transpose_item(which ? w.f2i : w.f1i, 2 * FF, D, kb * 64, src, (bf16_t*)(ws + (which ? WS_WF2I : WS_WF1I)), d0, scr, lane, w.ng + (which ? 4 * D : 0)); continue; } r -= 2 * I_FI;
        if (r < 2 * I_FO) { const int which = r / I_FO; r -= which * I_FO; const int nb = r % (D / 32), kb = r / (D / 32);
            transpose_item(which ? w.f2o : w.f1o, D, FF, kb * 64, nb * 32, (bf16_t*)(ws + (which ? WS_WF2O : WS_WF1O)), nb * 32, scr, lane); continue; } r -= 2 * I_FO;
        if (r < I_BA) { const int nb = r % (D / 32), kb = r / (D / 32);
            transpose_item(w.w_bra, D, 1024, kb * 64, nb * 32, (bf16_t*)(ws + WS_WBRA), nb * 32, scr, lane, nullptr, LDOM); continue; } r -= I_BA;
        if (r < 2 * I_BB) { const int which = r / I_BB; r -= which * I_BB; const int nb = r % (D / 32), kb = r / (D / 32);
            transpose_item(which ? w.w_brc : w.w_brb, D, 512, kb * 64, nb * 32, (bf16_t*)(ws + WS_WBRA) + (which ? OM_C : OM_B), nb * 32, scr, lane, nullptr, LDOM); continue; } r -= 2 * I_BB;
        { const int nb = r % (D / 32), kb = r / (D / 32);
            transpose_item(w.w_out, D, D, kb * 64, nb * 32, (bf16_t*)(ws + WS_WOUT), nb * 32, scr, lane); }
    }
}
__device__ __forceinline__ void phase_norm(bf16_t* XB, const bf16_t* Y, float* RSTD, float* OUT, const float* gpost, float coef, int gw, int NGW, int lane) {
    f32x4 g[8];
#pragma unroll
    for (int j = 0; j < 4; ++j) { g[2 * j] = *(const f32x4*)(gpost + 512 * j + 8 * lane); g[2 * j + 1] = *(const f32x4*)(gpost + 512 * j + 8 * lane + 4); }
#define NRM_LOAD(X, Yq, m_) do { const u32x4* xr_ = (const u32x4*)(XB + (size_t)(m_) * D) + lane; const u32x4* yr_ = (const u32x4*)(Y + (size_t)(m_) * D) + lane; \
        _Pragma("unroll") for (int j = 0; j < 4; ++j) { Yq[j] = yr_[64 * j]; X[j] = xr_[64 * j]; } } while (0)
#define NRM_UNP(q_, lo, hi) do { lo = (f32x4){bflo((q_).x), bfhi((q_).x), bflo((q_).y), bfhi((q_).y)}; hi = (f32x4){bflo((q_).z), bfhi((q_).z), bflo((q_).w), bfhi((q_).w)}; } while (0)
#define NRM_PROC(X, Yq, m_) do { f32x4 x[8], y[8]; float s = 0.f; \
        _Pragma("unroll") for (int j = 0; j < 4; ++j) { NRM_UNP(Yq[j], y[2 * j], y[2 * j + 1]); NRM_UNP(X[j], x[2 * j], x[2 * j + 1]); } \
        _Pragma("unroll") for (int j = 0; j < 8; ++j) s += (y[j].x * y[j].x + y[j].y * y[j].y) + (y[j].z * y[j].z + y[j].w * y[j].w); \
        const float rstd = coef * (1.0f / sqrtf(wave_sum(s) * (1.0f / D) + EPS)); float s2 = 0.f; \
        _Pragma("unroll") for (int j = 0; j < 8; ++j) { x[j] = x[j] + y[j] * g[j] * rstd; s2 += (x[j].x * x[j].x + x[j].y * x[j].y) + (x[j].z * x[j].z + x[j].w * x[j].w); } \
        if (OUT) { f32x4* xo = (f32x4*)(OUT + (size_t)(m_) * D + 8 * lane); \
            _Pragma("unroll") for (int j = 0; j < 4; ++j) { xo[128 * j] = x[2 * j]; xo[128 * j + 1] = x[2 * j + 1]; } \
        } else { u32x4* o16 = (u32x4*)(XB + (size_t)(m_) * D) + lane; \
            _Pragma("unroll") for (int j = 0; j < 4; ++j) { u32x4 w; w.x = cvt_pk_bf16(x[2 * j].x, x[2 * j].y); w.y = cvt_pk_bf16(x[2 * j].z, x[2 * j].w); w.z = cvt_pk_bf16(x[2 * j + 1].x, x[2 * j + 1].y); w.w = cvt_pk_bf16(x[2 * j + 1].z, x[2 * j + 1].w); o16[64 * j] = w; } \
            const float r2 = 1.0f / sqrtf(wave_sum(s2) * (1.0f / D) + EPS); if (lane == 0) RSTD[m_] = r2; } } while (0)
    u32x4 xa[4], ya[4], xb[4], yb[4];
    int m = gw;
    if (m < M) NRM_LOAD(xa, ya, m);
    while (m < M) {
        const int mb = m + NGW, mbl = mb < M ? mb : m;
        NRM_LOAD(xb, yb, mbl);
        NRM_PROC(xa, ya, m);
        if (mb >= M) break;
        const int ma = mb + NGW, mal = ma < M ? ma : mb;
        NRM_LOAD(xa, ya, mal);
        NRM_PROC(xb, yb, mb);
        m = ma;
    }
#undef NRM_LOAD
#undef NRM_UNP
#undef NRM_PROC
}
__device__ __forceinline__ void prep_k(bf16_t* PROJ, const float* qk_gain  , const f32x2* cs  , int gw, int NGW, int lane) {
    const float gk0 = qk_gain[128 + 2 * lane], gk1 = qk_gain[128 + 2 * lane + 1];
    for (int m0 = gw; m0 < M; m0 += 4 * NGW) {
        unsigned v[4][2]; f32x2 c_s[4];
#pragma unroll
        for (int i = 0; i < 4; ++i) { const int m = m0 + i * NGW; if (m < M) { const int t = m & (SEQ - 1), pr = t >> 6, pc = t & 63;
            const unsigned* row = (const unsigned*)(PROJ + (size_t)m * NPROJ + C_AK); v[i][0] = row[lane]; v[i][1] = row[64 + lane]; c_s[i] = cs[((lane < 32) ? pr : pc) * 32 + (lane & 31)]; } }
#pragma unroll
        for (int i = 0; i < 4; ++i) { const int m = m0 + i * NGW; if (m < M) { unsigned* row = (unsigned*)(PROJ + (size_t)m * NPROJ + C_AK);
#pragma unroll
            for (int h = 0; h < 2; ++h) { const float x1 = bflo(v[i][h]), x2 = bfhi(v[i][h]);
                const float rstd = 1.0f / sqrtf(wave_sum(x1 * x1 + x2 * x2) * (1.0f / 128.0f) + EPS);
                const float n1 = x1 * rstd * gk0, n2 = x2 * rstd * gk1;
                row[h * 64 + lane] = cvt_pk_bf16(n1 * c_s[i].x - n2 * c_s[i].y, n1 * c_s[i].y + n2 * c_s[i].x); } } }
    }
}
__device__ __forceinline__ void tr_pair(unsigned base, int pitch, int row0, int col0, int lane, s16x4& lo, s16x4& hi) {
    const int g = lane >> 4, i = lane & 15;
    const unsigned addr = base + (unsigned)((row0 + 4 * g + (i >> 2)) * pitch + (col0 + 4 * (i & 3)) * 2);
    asm volatile("ds_read_b64_tr_b16 %0, %1" : "=&v"(lo) : "v"(addr) : "memory");
    asm volatile("ds_read_b64_tr_b16 %0, %1" : "=&v"(hi) : "v"(addr + (unsigned)(16 * pitch)) : "memory");
}
#define TR_JOIN(L, H) ((bf16x8){L[0], L[1], L[2], L[3], H[0], H[1], H[2], H[3]})
__device__ __forceinline__ bf16x8 pack8(const float* x) { u32x4 w; w.x = cvt_pk_bf16(x[0], x[1]); w.y = cvt_pk_bf16(x[2], x[3]); w.z = cvt_pk_bf16(x[4], x[5]); w.w = cvt_pk_bf16(x[6], x[7]); return *reinterpret_cast<bf16x8*>(&w); }
constexpr int NAR = 4;
__device__ __forceinline__ void na_unit(const bf16_t* PROJ, bf16_t* OB  , LAS unsigned char* lds, int u) {
    const int tid = opaque_tid(), lane = tid & 63, w = __builtin_amdgcn_readfirstlane(tid >> 6);
    constexpr int PV = 272, O_V = 0, O_RPB = 2 * 64 * PV;
    LAS float* rpbs = (LAS float*)(lds + O_RPB);
    const unsigned lbase = (unsigned)(uintptr_t)lds;
    const int ib = w & 3, qh = w >> 2;
    {
        int lane_o = lane; asm volatile("" : "+v"(lane_o));
        const int g = lane_o >> 4, li = lane_o & 15;
        const int r0 = (u & 7) * NAR, h = (u >> 3) & 3, b = u >> 5;
        const int klo = min(max(r0 - 4, 0), 24), khi = min(max(r0 + NAR - 1 - 4, 0), 24) + 7, nk = khi - klo + 1;
        const int c = 16 * ib + li, cs0 = min(max(c - 8, 0), 48);
        const int rw = r0 + 2 * qh;
        const size_t tq = (size_t)b * SEQ + rw * 64 + c;
        bf16x8 qf[2][4];
#pragma unroll
        for (int q = 0; q < 2; ++q)
#pragma unroll
            for (int ks = 0; ks < 4; ++ks) qf[q][ks] = *(const bf16x8*)(PROJ + (tq + 64 * q) * NPROJ + C_BQ + h * 128 + 32 * ks + 8 * g);
        int jbv[4], dcv[4];
#pragma unroll
        for (int rr = 0; rr < 4; ++rr) { const int km = 4 * g + rr; jbv[rr] = (cs0 + 15 - km) >> 4; dcv[rr] = 16 * jbv[rr] + km - c + 15; }
        f32x4 o[2][8]; float m_run[2], l_run[2];
#pragma unroll
        for (int q = 0; q < 2; ++q) { m_run[q] = -1e30f; l_run[q] = 0.f;
#pragma unroll
            for (int vt = 0; vt < 8; ++vt) o[q][vt] = (f32x4){0.f, 0.f, 0.f, 0.f}; }
        const int sr = tid >> 4, sc = (tid & 15) * 8;
        const int jlo = ib > 1 ? ib - 1 : 0, jn = (ib == 0 || ib == 3) ? 2 : 3;
        bf16x8 kf[3][4], vr0, vr1;
#define NA_LOADK(kr_) do { const size_t kt_ = (size_t)b * SEQ + (size_t)(klo + (kr_)) * 64; \
            _Pragma("unroll") for (int jj = 0; jj < 3; ++jj) if (jj < jn) { const bf16_t* kp = PROJ + (kt_ + 16 * (jlo + jj) + li) * NPROJ + C_BK + h * 128 + 8 * g; \
                _Pragma("unroll") for (int ks = 0; ks < 4; ++ks) kf[jj][ks] = *(const bf16x8*)(kp + 32 * ks); } } while (0)
#define NA_LOADV(kr_) do { const size_t kt_ = (size_t)b * SEQ + (size_t)(klo + (kr_)) * 64; \
            vr0 = *(const bf16x8*)(PROJ + (kt_ + sr) * NPROJ + C_BV + h * 128 + sc); vr1 = *(const bf16x8*)(PROJ + (kt_ + sr + 32) * NPROJ + C_BV + h * 128 + sc); } while (0)
        NA_LOADV(0); NA_LOADK(0);
        for (int kr = 0; kr < nk; ++kr) {
            const int kabs = klo + kr;
            *(LAS bf16x8*)(lds + O_V + (kr & 1) * 64 * PV + sr * PV + sc * 2) = vr0; *(LAS bf16x8*)(lds + O_V + (kr & 1) * 64 * PV + (sr + 32) * PV + sc * 2) = vr1;
            if (kr + 1 < nk) NA_LOADV(kr + 1);
            bf16x8 pfr[2][2]; float alpha[2]; bool act[2];
#pragma unroll
            for (int q = 0; q < 2; ++q) {
                const int rq = rw + q, rsq = min(max(rq - 4, 0), 24);
                act[q] = (kabs >= rsq) && (kabs <= rsq + 7);
                alpha[q] = 1.0f;
                if (act[q]) {
                    f32x4 s[3];
#pragma unroll
                    for (int jj = 0; jj < 3; ++jj) { s[jj] = (f32x4){0.f, 0.f, 0.f, 0.f};
                        if (jj < jn) {
#pragma unroll
                            for (int ks = 0; ks < 4; ++ks) s[jj] = __builtin_amdgcn_mfma_f32_16x16x32_bf16(kf[jj][ks], qf[q][ks], s[jj], 0, 0, 0); } }
                    const int dr = kabs - rq + 7;
                    float mx = -1e30f;
#pragma unroll
                    for (int rr = 0; rr < 4; ++rr) { const float bias = rpbs[(h * 15 + dr) * 31 + dcv[rr]];
#pragma unroll
                        for (int jj = 0; jj < 3; ++jj) { const float v = (jlo + jj == jbv[rr]) ? s[jj][rr] * 0.088388347648318440f + bias : -1e30f; s[jj][rr] = v; mx = fmaxf(mx, v); } }
                    mx = fmaxf(mx, __shfl_xor(mx, 16)); mx = fmaxf(mx, __shfl_xor(mx, 32));
                    const float m_new = fmaxf(m_run[q], mx); alpha[q] = __expf(m_run[q] - m_new);
                    m_run[q] = m_new;
                    float ps = 0.f;
#pragma unroll
                    for (int jj = 0; jj < 3; ++jj)
#pragma unroll
                        for (int rr = 0; rr < 4; ++rr) { const float p = (jlo + jj == jbv[rr]) ? __expf(s[jj][rr] - m_new) : 0.f; s[jj][rr] = p; ps += p; }
                    l_run[q] = l_run[q] * alpha[q] + ps;
                    float t[16];
#pragma unroll
                    for (int jb = 0; jb < 4; ++jb)
#pragma unroll
                        for (int rr = 0; rr < 4; ++rr) { float v = 0.f;
#pragma unroll
                            for (int jj = 0; jj < 3; ++jj) v = (jlo + jj == jb) ? s[jj][rr] : v;
                            t[4 * jb + rr] = v; }
                    pfr[q][0] = pack8(t); pfr[q][1] = pack8(t + 8);
                } else { pfr[q][0] = pfr[q][1] = (bf16x8){0, 0, 0, 0, 0, 0, 0, 0}; }
            }
            if (kr + 1 < nk) NA_LOADK(kr + 1);
            __syncthreads();
#pragma unroll
            for (int vh = 0; vh < 2; ++vh) {
                s16x4 vl[4][2], vhh[4][2];
                {
                    const unsigned vbase = lbase + O_V + (unsigned)((kr & 1) * 64 * PV + (4 * g + (li >> 2)) * PV + (64 * vh + 4 * (li & 3)) * 2);
                    asm volatile("ds_read_b64_tr_b16 %0, %16 offset:0\n\t"
                             "ds_read_b64_tr_b16 %1, %16 offset:4352\n\t"
                             "ds_read_b64_tr_b16 %2, %16 offset:8704\n\t"
                             "ds_read_b64_tr_b16 %3, %16 offset:13056\n\t"
                             "ds_read_b64_tr_b16 %4, %16 offset:32\n\t"
                             "ds_read_b64_tr_b16 %5, %16 offset:4384\n\t"
                             "ds_read_b64_tr_b16 %6, %16 offset:8736\n\t"
                             "ds_read_b64_tr_b16 %7, %16 offset:13088\n\t"
                             "ds_read_b64_tr_b16 %8, %16 offset:64\n\t"
                             "ds_read_b64_tr_b16 %9, %16 offset:4416\n\t"
                             "ds_read_b64_tr_b16 %10, %16 offset:8768\n\t"
                             "ds_read_b64_tr_b16 %11, %16 offset:13120\n\t"
                             "ds_read_b64_tr_b16 %12, %16 offset:96\n\t"
                             "ds_read_b64_tr_b16 %13, %16 offset:4448\n\t"
                             "ds_read_b64_tr_b16 %14, %16 offset:8800\n\t"
                             "ds_read_b64_tr_b16 %15, %16 offset:13152\n\t"
                             "s_waitcnt lgkmcnt(0)"
                             : "=&v"(vl[0][0]), "=&v"(vhh[0][0]), "=&v"(vl[0][1]), "=&v"(vhh[0][1]), "=&v"(vl[1][0]), "=&v"(vhh[1][0]), "=&v"(vl[1][1]), "=&v"(vhh[1][1]), "=&v"(vl[2][0]), "=&v"(vhh[2][0]), "=&v"(vl[2][1]), "=&v"(vhh[2][1]), "=&v"(vl[3][0]), "=&v"(vhh[3][0]), "=&v"(vl[3][1]), "=&v"(vhh[3][1])
                             : "v"(vbase) : "memory");
                }
                __builtin_amdgcn_sched_barrier(0);
#pragma unroll
                for (int q = 0; q < 2; ++q) if (act[q]) {
#pragma unroll
                    for (int vt = 0; vt < 4; ++vt) { f32x4 acc = o[q][4 * vh + vt] * alpha[q];
#pragma unroll
                        for (int ss = 0; ss < 2; ++ss) acc = __builtin_amdgcn_mfma_f32_16x16x32_bf16(TR_JOIN(vl[vt][ss], vhh[vt][ss]), pfr[q][ss], acc, 0, 0, 0);
                        o[q][4 * vh + vt] = acc; } }
            }
        }
#undef NA_LOADK
#undef NA_LOADV
#pragma unroll
        for (int q = 0; q < 2; ++q) {
            float lr = l_run[q]; lr += __shfl_xor(lr, 16); lr += __shfl_xor(lr, 32);
            const float inv = 1.0f / lr;
#pragma unroll
            for (int vt = 0; vt < 8; ++vt) { u32x2 ov; ov.x = cvt_pk_bf16(o[q][vt].x * inv, o[q][vt].y * inv); ov.y = cvt_pk_bf16(o[q][vt].z * inv, o[q][vt].w * inv);
                *(u32x2*)(OB + (tq + 64 * q) * LDOM + h * 128 + 16 * vt + 4 * g) = ov; } }
        __syncthreads();
    }
}
__device__ __forceinline__ void na_load_bias(const float* rpb, LAS unsigned char* lds) {
    const int tid = opaque_tid(); LAS float* rpbs = (LAS float*)(lds + 2 * 64 * 272);
    __syncthreads();
    for (int i = tid; i < 4 * 15 * 31; i += 512) rpbs[i] = rpb[i];
    __syncthreads();
}
__device__ __forceinline__ float logsig16(float z) { return (fminf(z, 0.f) - __logf(1.0f + __expf(-fabsf(z)))) * (1.0f / 16.0f); }
__device__ __forceinline__ void gla_seq_unit(const bf16_t* PROJ, const float* LR, const float* w_decay  , const float* b_decay  , bf16_t* OFB, bf16_t* OC, const float* onorm,
                                             LAS unsigned char* lds, int b, int h) {
    const int tid = opaque_tid(), lane = tid & 63, w = __builtin_amdgcn_readfirstlane(tid >> 6);
    constexpr int P64 = 144, PV = 272;
    constexpr int O_Q = 0, O_K = 9216, O_KH = 18432, O_V = 27648, O_S = 45056, O_DEC = 63488, O_W2 = 63744;
    const unsigned lbase = (unsigned)(uintptr_t)lds;
    const int ib = w & 3, vh = w >> 2, g = lane >> 4, li = lane & 15;
    LAS float* w2s = (LAS float*)(lds + O_W2);
    LAS float* gns = (LAS float*)(lds + 68608);
    __syncthreads(); if (tid < 128) gns[tid] = onorm[tid];
    LAS float* red = (LAS float*)(lds + 68096);
  for (int dir = 0; dir < 2; ++dir) {
    __syncthreads();
    for (int i = tid; i < 16 * 64; i += 512) w2s[i] = w_decay[dir * 4096 + (i >> 6) * 256 + h * 64 + (i & 63)];
    if (tid < 64) w2s[1024 + tid] = b_decay[dir * 256 + h * 64 + tid];
    for (int i = tid; i < 128 * 72 / 2; i += 512) ((LAS unsigned*)(lds + O_S))[i] = 0u;
    f32x4 S[4];
#pragma unroll
    for (int vt = 0; vt < 4; ++vt) S[vt] = (f32x4){0.f, 0.f, 0.f, 0.f};
    const int dcol = 8 * w;
    const int sr = tid >> 4, sc = (tid & 15) * 8;
    f32x4 lr4[4]; u32x4 qraw, kraw; bf16x8 vst0, vst1;
    u32x2 ofr[4], ogr[4];
#define GLA_LOAD_O(cc_) do { const int c_ = 31 - (cc_); const size_t mi_ = (size_t)b * SEQ + c_ * 64 + 16 * ib + li; \
        _Pragma("unroll") for (int vt = 0; vt < 4; ++vt) { ofr[vt] = *(const u32x2*)(OFB + mi_ * 512 + h * 128 + 64 * vh + 16 * vt + 4 * g); ogr[vt] = *(const u32x2*)(PROJ + mi_ * NPROJ + C_OG + h * 128 + 64 * vh + 16 * vt + 4 * g); } } while (0)
#define GLA_LOAD(cc_) do { const int c_ = dir ? 31 - (cc_) : (cc_); const size_t m0_ = (size_t)b * SEQ + c_ * 64, m_ = m0_ + lane; \
        _Pragma("unroll") for (int j = 0; j < 4; ++j) lr4[j] = ((const f32x4*)(LR + m_ * 32 + dir * 16))[j]; \
        qraw = *(const u32x4*)(PROJ + m_ * NPROJ + C_CQ + h * 64 + dcol); kraw = *(const u32x4*)(PROJ + m_ * NPROJ + C_CK + h * 64 + dcol); \
        vst0 = *(const bf16x8*)(PROJ + (m0_ + sr) * NPROJ + C_CV + h * 128 + sc); vst1 = *(const bf16x8*)(PROJ + (m0_ + sr + 32) * NPROJ + C_CV + h * 128 + sc); } while (0)
#pragma unroll
    for (int vt = 0; vt < 4; ++vt) { ofr[vt] = (u32x2){0u, 0u}; ogr[vt] = (u32x2){0u, 0u}; }
    GLA_LOAD(0);
    if (dir) GLA_LOAD_O(0);
    __syncthreads();
    for (int cc = 0; cc < 32; ++cc) {
        const int c = dir ? 31 - cc : cc; const size_t m0 = (size_t)b * SEQ + c * 64;
        {
            f32x4 z0 = *(const LAS f32x4*)(w2s + 1024 + dcol), z1 = *(const LAS f32x4*)(w2s + 1024 + dcol + 4);
#pragma unroll
            for (int j = 0; j < 4; ++j)
#pragma unroll
                for (int rr = 0; rr < 4; ++rr) { const int r = 4 * j + rr; z0 = z0 + *(const LAS f32x4*)(w2s + r * 64 + dcol) * lr4[j][rr]; z1 = z1 + *(const LAS f32x4*)(w2s + r * 64 + dcol + 4) * lr4[j][rr]; }
            float bs[8];
#pragma unroll
            for (int e = 0; e < 4; ++e) { bs[e] = logsig16(z0[e]); bs[4 + e] = logsig16(z1[e]); }
            if (dir == 0) {
#pragma unroll
                for (int off = 1; off < 64; off <<= 1)
#pragma unroll
                    for (int e = 0; e < 8; ++e) { const float t = __shfl_up(bs[e], off); if (lane >= off) bs[e] += t; }
            } else {
#pragma unroll
                for (int off = 1; off < 64; off <<= 1)
#pragma unroll
                    for (int e = 0; e < 8; ++e) { const float t = __shfl_down(bs[e], off); if (lane + off < 64) bs[e] += t; }
            }
            const float q[8] = {bflo(qraw.x), bfhi(qraw.x), bflo(qraw.y), bfhi(qraw.y), bflo(qraw.z), bfhi(qraw.z), bflo(qraw.w), bfhi(qraw.w)};
            const float k[8] = {bflo(kraw.x), bfhi(kraw.x), bflo(kraw.y), bfhi(kraw.y), bflo(kraw.z), bfhi(kraw.z), bflo(kraw.w), bfhi(kraw.w)};
            float qt[8], kt[8], kh[8], dc[8];
#pragma unroll
            for (int e = 0; e < 8; ++e) { const float be = __shfl(bs[e], dir ? 0 : 63);
                qt[e] = q[e] * 0.125f * __expf(bs[e]); kt[e] = k[e] * __expf(-bs[e]); kh[e] = k[e] * __expf(be - bs[e]); dc[e] = __expf(be); }
            *(LAS bf16x8*)(lds + O_Q + lane * P64 + 16 * w) = pack8(qt); *(LAS bf16x8*)(lds + O_K + lane * P64 + 16 * w) = pack8(kt); *(LAS bf16x8*)(lds + O_KH + lane * P64 + 16 * w) = pack8(kh);
            if (lane == 0) { *(LAS f32x4*)(lds + O_DEC + 4 * dcol) = (f32x4){dc[0], dc[1], dc[2], dc[3]}; *(LAS f32x4*)(lds + O_DEC + 4 * dcol + 16) = (f32x4){dc[4], dc[5], dc[6], dc[7]}; }
            *(LAS bf16x8*)(lds + O_V + sr * PV + sc * 2) = vst0; *(LAS bf16x8*)(lds + O_V + (sr + 32) * PV + sc * 2) = vst1;
        }
        __syncthreads();
        if (cc + 1 < 32) GLA_LOAD(cc + 1);
        const size_t mi = m0 + 16 * ib + li; f32x4 oo[4]; float ss = 0.f;
        {
            bf16x8 qF[2];
#pragma unroll
            for (int ks = 0; ks < 2; ++ks) qF[ks] = *(const LAS bf16x8*)(lds + O_Q + (16 * ib + li) * P64 + (32 * ks + 8 * g) * 2);
            f32x4 P[4];
#pragma unroll
            for (int jb = 0; jb < 4; ++jb) {
                f32x4 a = {0.f, 0.f, 0.f, 0.f};
                const bool need = dir ? (jb >= ib) : (jb <= ib);
                if (need) {
#pragma unroll
                    for (int ks = 0; ks < 2; ++ks) a = __builtin_amdgcn_mfma_f32_16x16x32_bf16(*(const LAS bf16x8*)(lds + O_K + (16 * jb + li) * P64 + (32 * ks + 8 * g) * 2), qF[ks], a, 0, 0, 0); }
#pragma unroll
                for (int r = 0; r < 4; ++r) { const int jl = 4 * g + r;
                    const bool keep = (jb == ib) ? (dir ? (jl >= li) : (jl <= li)) : need;
                    P[jb][r] = keep ? a[r] : 0.f; }
            }
            bf16x8 pfr[2];
#pragma unroll
            for (int s = 0; s < 2; ++s) { const float t[8] = {P[2 * s][0], P[2 * s][1], P[2 * s][2], P[2 * s][3], P[2 * s + 1][0], P[2 * s + 1][1], P[2 * s + 1][2], P[2 * s + 1][3]}; pfr[s] = pack8(t); }
            s16x4 vl[4][2], vhh[4][2], kl[2], kh2[2];
            {
                const unsigned vbase = lbase + O_V + (unsigned)((4 * g + (li >> 2)) * PV + (64 * vh + 4 * (li & 3)) * 2);
                const unsigned kbase = lbase + O_KH + (unsigned)((4 * g + (li >> 2)) * P64 + (16 * ib + 4 * (li & 3)) * 2);
                asm volatile("ds_read_b64_tr_b16 %0, %20 offset:0\n\t"
                         "ds_read_b64_tr_b16 %1, %20 offset:4352\n\t"
                         "ds_read_b64_tr_b16 %2, %20 offset:8704\n\t"
                         "ds_read_b64_tr_b16 %3, %20 offset:13056\n\t"
                         "ds_read_b64_tr_b16 %4, %20 offset:32\n\t"
                         "ds_read_b64_tr_b16 %5, %20 offset:4384\n\t"
                         "ds_read_b64_tr_b16 %6, %20 offset:8736\n\t"
                         "ds_read_b64_tr_b16 %7, %20 offset:13088\n\t"
                         "ds_read_b64_tr_b16 %8, %20 offset:64\n\t"
                         "ds_read_b64_tr_b16 %9, %20 offset:4416\n\t"
                         "ds_read_b64_tr_b16 %10, %20 offset:8768\n\t"
                         "ds_read_b64_tr_b16 %11, %20 offset:13120\n\t"
                         "ds_read_b64_tr_b16 %12, %20 offset:96\n\t"
                         "ds_read_b64_tr_b16 %13, %20 offset:4448\n\t"
                         "ds_read_b64_tr_b16 %14, %20 offset:8800\n\t"
                         "ds_read_b64_tr_b16 %15, %20 offset:13152\n\t"
                         "ds_read_b64_tr_b16 %16, %21 offset:0\n\t"
                         "ds_read_b64_tr_b16 %17, %21 offset:2304\n\t"
                         "ds_read_b64_tr_b16 %18, %21 offset:4608\n\t"
                         "ds_read_b64_tr_b16 %19, %21 offset:6912\n\t"
                         "s_waitcnt lgkmcnt(0)"
                         : "=&v"(vl[0][0]), "=&v"(vhh[0][0]), "=&v"(vl[0][1]), "=&v"(vhh[0][1]), "=&v"(vl[1][0]), "=&v"(vhh[1][0]), "=&v"(vl[1][1]), "=&v"(vhh[1][1]), "=&v"(vl[2][0]), "=&v"(vhh[2][0]), "=&v"(vl[2][1]), "=&v"(vhh[2][1]), "=&v"(vl[3][0]), "=&v"(vhh[3][0]), "=&v"(vl[3][1]), "=&v"(vhh[3][1]), "=&v"(kl[0]), "=&v"(kh2[0]), "=&v"(kl[1]), "=&v"(kh2[1])
                         : "v"(vbase), "v"(kbase) : "memory");
            }
            bf16x8 sfr[4][2];
#pragma unroll
            for (int vt = 0; vt < 4; ++vt)
#pragma unroll
                for (int ks = 0; ks < 2; ++ks) sfr[vt][ks] = *(const LAS bf16x8*)(lds + O_S + (64 * vh + 16 * vt + li) * P64 + (32 * ks + 8 * g) * 2);
            const float dec = *(const LAS float*)(lds + O_DEC + 4 * (16 * ib + li));
            __builtin_amdgcn_sched_barrier(0);
#pragma unroll
            for (int vt = 0; vt < 4; ++vt) {
                const int v0 = 64 * vh + 16 * vt;
                f32x4 o = {0.f, 0.f, 0.f, 0.f};
#pragma unroll
                for (int s = 0; s < 2; ++s) o = __builtin_amdgcn_mfma_f32_16x16x32_bf16(TR_JOIN(vl[vt][s], vhh[vt][s]), pfr[s], o, 0, 0, 0);
#pragma unroll
                for (int ks = 0; ks < 2; ++ks) o = __builtin_amdgcn_mfma_f32_16x16x32_bf16(sfr[vt][ks], qF[ks], o, 0, 0, 0);
                if (dir == 0) { u32x2 ov; ov.x = (unsigned)f2bf(o.x) | ((unsigned)f2bf(o.y) << 16); ov.y = (unsigned)f2bf(o.z) | ((unsigned)f2bf(o.w) << 16);
                    *(u32x2*)(OFB + mi * 512 + h * 128 + v0 + 4 * g) = ov; }
                else { const u32x2 f = ofr[vt];
                    o.x += bflo(f.x); o.y += bfhi(f.x); o.z += bflo(f.y); o.w += bfhi(f.y); oo[vt] = o; ss += (o.x * o.x + o.y * o.y) + (o.z * o.z + o.w * o.w); }
                f32x4 sn = S[vt] * dec;
#pragma unroll
                for (int s = 0; s < 2; ++s) sn = __builtin_amdgcn_mfma_f32_16x16x32_bf16(TR_JOIN(vl[vt][s], vhh[vt][s]), TR_JOIN(kl[s], kh2[s]), sn, 0, 0, 0);
                S[vt] = sn;
            }
        }
        if (dir) { ss += __shfl_xor(ss, 16); ss += __shfl_xor(ss, 32); if (g == 0) red[vh * 64 + 16 * ib + li] = ss; }
        __syncthreads();
        if (dir) {
            const float rstd = 1.0f / sqrtf((red[16 * ib + li] + red[64 + 16 * ib + li]) * (1.0f / 128.0f) + EPS);
#pragma unroll
            for (int vt = 0; vt < 4; ++vt) { const int v0 = 64 * vh + 16 * vt;
                const u32x2 og = ogr[vt]; const f32x4 gn = *(const LAS f32x4*)(gns + v0 + 4 * g);
                u32x2 ov; ov.x = cvt_pk_bf16(oo[vt].x * rstd * gn.x * pg8::silu_f(bflo(og.x)), oo[vt].y * rstd * gn.y * pg8::silu_f(bfhi(og.x)));
                ov.y = cvt_pk_bf16(oo[vt].z * rstd * gn.z * pg8::silu_f(bflo(og.y)), oo[vt].w * rstd * gn.w * pg8::silu_f(bfhi(og.y)));
                *(u32x2*)(OC + mi * LDOM + h * 128 + v0 + 4 * g) = ov; }
            if (cc + 1 < 32) GLA_LOAD_O(cc + 1);
        }
#pragma unroll
        for (int vt = 0; vt < 4; ++vt)
#pragma unroll
            for (int r = 0; r < 4; ++r) *(LAS bf16_t*)(lds + O_S + (64 * vh + 16 * vt + 4 * g + r) * P64 + (16 * ib + li) * 2) = f2bf(S[vt][r]);
    }
    __syncthreads();
  }
#undef GLA_LOAD
#undef GLA_LOAD_O
}
constexpr int NPH = 15;
enum { P_F1A = 0, P_F1B, P_N1, P_M1, P_PREP, P_ATT, P_NA, P_GLA, P_GLC, P_M4, P_M5, P_N2, P_F2A, P_F2B, P_N3 };
constexpr int NGP = 1 + DEPTH * NPH;
struct Args { const float* in[18]; float* out; unsigned char* ws; int gp_lo, gp_hi; };

typedef decltype(__builtin_amdgcn_kernarg_segment_ptr()) kargp_t;
__device__ __forceinline__ unsigned long long karg_q(int byte_off) { kargp_t p_ = __builtin_amdgcn_kernarg_segment_ptr(); asm volatile("" : "+s"(p_));
    return *(const unsigned long long __attribute__((address_space(4)))*)((const char __attribute__((address_space(4)))*)p_ + byte_off); }
__global__ void __launch_bounds__(512, 2) __attribute__((target("no-packed-fp32-ops"))) fwd(Args args) {
    extern __shared__ __attribute__((aligned(16))) unsigned char lds_raw[];
    LAS unsigned char* const lds0 = (LAS unsigned char*)lds_raw;
    const int G0 = gridDim.x, wg0 = blockIdx.x;
#define PENV LAS unsigned char* lds = lds0; int G = G0, wg = wg0; asm volatile("" : "+s"(lds), "+s"(G), "+s"(wg)); const int NGW = G * 8; (void)NGW; (void)lds; (void)wg
    volatile LAS unsigned* MISC = (volatile LAS unsigned*)(lds0 + MISC_OFF);
    volatile LAS unsigned long long* PT = (volatile LAS unsigned long long*)(lds0 + PTAB_OFF);
    { const int t0 = threadIdx.x;
      for (int u = t0; u < (LDS_BYTES - LDSCTL_OFF) / 4; u += 512) ((LAS unsigned*)(lds0 + LDSCTL_OFF))[u] = 0u;
      __syncthreads();
      __syncthreads(); }
#if ONE_LAUNCH
    constexpr int lo = 0, hi = NGP;
#else
    const int lo = args.gp_lo, hi = args.gp_hi;
#endif
    XcdBarrier bar; bar.bar = (unsigned*)(args.ws + WS_CTL) + CW_BAR; bar.x = 0; bar.st = nullptr;
    if (hi - lo > 1) bar = xcd_barrier_setup((unsigned*)(args.ws + WS_CTL) + CW_BAR, MISC + 8);
#define SEAM(gp) do { if ((gp) + 1 < hi) xcd_barrier(bar); } while (0)
#define INP(i) ((const float*)(const GAS float*)karg_q(8 * (i)))
#define WSP() ((unsigned char*)(GAS unsigned char*)karg_q(8 * 19))
#define XP() ((float*)(GAS float*)karg_q(8 * 18))
#define TIDS() PENV; const int tid = opaque_tid(), lane = tid & 63, wave = __builtin_amdgcn_readfirstlane(tid >> 6), gw = wg * 8 + wave; (void)tid; (void)lane; (void)wave; (void)gw

    if (((PHASE_MASK >> 31) & 1u) && lo <= 0 && 0 < hi) {
        TIDS(); unsigned char* ws = WSP(); bf16_t* XB = (bf16_t*)(ws + WS_XN); float* RSTD = (float*)(ws + WS_RSTD);
        LayerW w; w.w_in = INP(3); w.w_bra = INP(10); w.w_brb = INP(11); w.w_brc = INP(12); w.w_out = INP(13); w.f1i = INP(14); w.f1o = INP(15); w.f2i = INP(16); w.f2o = INP(17); w.ng = INP(2);
        if (wg == 0) { f32x2* cs = (f32x2*)(ws + WS_CTL + ROPE_OFF);
            for (int i = tid; i < 2048; i += 512) { const int pos = i >> 5, mi = i & 31; const float inv = powf(10000.0f, -(float)mi / 32.0f); float s, c; sincosf((float)pos * inv, &s, &c); cs[i] = (f32x2){c, s}; } }
        phase_weights(w, ws, lds, gw, NGW, wave, lane);
        const float* xp = INP(0); const float* xs = INP(1);
        for (int m = gw; m < M; m += NGW) {
            const float* src = m < 16 * SEQ ? xp + (size_t)m * D : xs + (size_t)(m - 16 * SEQ) * D;
            const f32x4* xr = (const f32x4*)src + lane; f32x4 x[8]; float s = 0.f;
#pragma unroll
            for (int j = 0; j < 8; ++j) { x[j] = xr[64 * j]; s += (x[j].x * x[j].x + x[j].y * x[j].y) + (x[j].z * x[j].z + x[j].w * x[j].w); }
            u32x2* o8 = (u32x2*)(XB + (size_t)m * D) + lane;
#pragma unroll
            for (int j = 0; j < 8; ++j) { u32x2 wv; wv.x = cvt_pk_bf16(x[j].x, x[j].y); wv.y = cvt_pk_bf16(x[j].z, x[j].w); o8[64 * j] = wv; }
            const float rstd = 1.0f / sqrtf(wave_sum(s) * (1.0f / D) + EPS);
            if (lane == 0) RSTD[m] = rstd;
        }
        SEAM(0);
    }
    for (int l = 0; l < DEPTH; ++l) {
        const int gp0 = 1 + l * NPH;
        if (gp0 + NPH <= lo || gp0 >= hi) continue;
#define IN(p) (((PHASE_MASK >> (p)) & 1u) && lo <= gp0 + (p) && gp0 + (p) < hi)
#define POOL_CLAIM_RUN(EPI) do { __syncthreads(); if (threadIdx.x == 0) *qs = __hip_atomic_fetch_add(head, 1u, __ATOMIC_RELAXED, __HIP_MEMORY_SCOPE_AGENT); __syncthreads(); \
            const int pi_ = __builtin_amdgcn_readfirstlane((int)*(volatile LAS unsigned*)qs); \
            if (pi_ < npool) { pg8::OneUnit S1; S.pool_unit(pi_, S1.u); pg8::gemm_phase<EPI, pg8::OneUnit, true, true>(lds, g, S1, E); } } while (0)
#define FFN_PAIR(ff, pa, pb) do { \
        if (IN(pa)) { PENV; unsigned char* ws = WSP(); pg8::Gemm g{(const bf16_t*)(ws + WS_XN), (const bf16_t*)(ws + ((ff) ? WS_WF2I : WS_WF1I)), M, 2 * FF, D, D}; pg8::StaticOrderCut<32> S; S.init(M, 2 * FF, G, wg, WGM_FI); \
            pg8::EpiSwiGLU E{(bf16_t*)(ws + WS_H), (const float*)(ws + WS_RSTD)}; pg8::gemm_phase<pg8::EpiSwiGLU, pg8::StaticOrderCut<32>, true, true>(lds, g, S, E); \
            { unsigned* head = (unsigned*)(ws + WS_CTL) + CW_POOL + 64 * (4 + l * 2 + (ff)); LAS unsigned* qs = (LAS unsigned*)(lds + MISC_OFF + 64); const int npool = S.pool_size(); \
              POOL_CLAIM_RUN(pg8::EpiSwiGLU); POOL_CLAIM_RUN(pg8::EpiSwiGLU); } \
            SEAM(gp0 + (pa)); } \
        if (IN(pb)) { PENV; unsigned char* ws = WSP(); pg8::Gemm g{(const bf16_t*)(ws + WS_H), (const bf16_t*)(ws + ((ff) ? WS_WF2O : WS_WF1O)), M, D, FF, FF}; pg8::StaticOrder S; S.init(M, D, G, wg, WGM_FO); \
            pg8::EpiBf16Plain E{(bf16_t*)(ws + WS_Y), D}; pg8::gemm_phase<pg8::EpiBf16Plain, pg8::StaticOrder, true, true>(lds, g, S, E); if ((DUP_MASK >> (pb)) & 1u) pg8::gemm_phase<pg8::EpiBf16Plain, pg8::StaticOrder, true, true>(lds, g, S, E); SEAM(gp0 + (pb)); } } while (0)
#define NORM_PHASE(p, ipost, coef, last) do { if (IN(p)) { TIDS(); unsigned char* ws = WSP(); const float* ng = INP(2) + (size_t)l * 6 * D; \
            phase_norm((bf16_t*)(ws + WS_XN), (const bf16_t*)(ws + WS_Y), (float*)(ws + WS_RSTD), (last) ? XP() : nullptr, ng + (ipost) * D, (coef), gw, NGW, lane);

        FFN_PAIR(0, P_F1A, P_F1B);
        NORM_PHASE(P_N1, 1, 0.5f, false) SEAM(gp0 + P_N1); } } while (0);
        if (IN(P_M1)) { PENV;
            unsigned char* ws = WSP();
            pg8::Gemm g{(const bf16_t*)(ws + WS_XN), (const bf16_t*)(ws + WS_WIN), M, NIN_PAD, D, D}; pg8::StaticOrderCut<32> S; S.init(M, NIN_PAD, G, wg, WGM_M1);
            pg8::EpiProj E{(bf16_t*)(ws + WS_PROJ), (u32x4*)(ws + WS_GATES), (float*)(ws + WS_LR), INP(4) + (size_t)l * 3 * D, (const float*)(ws + WS_RSTD)};
            pg8::gemm_phase<pg8::EpiProj, pg8::StaticOrderCut<32>, true, true>(lds, g, S, E);
            {
                unsigned* head = (unsigned*)(ws + WS_CTL) + CW_POOL + 64 * l; LAS unsigned* qs = (LAS unsigned*)(lds + MISC_OFF + 64);
                __syncthreads(); if (threadIdx.x == 0) *qs = __hip_atomic_fetch_add(head, 1u, __ATOMIC_RELAXED, __HIP_MEMORY_SCOPE_AGENT); __syncthreads();
                const int pi = __builtin_amdgcn_readfirstlane((int)*(volatile LAS unsigned*)qs);
                if (pi < S.pool_size()) { pg8::OneUnit S1; S.pool_unit(pi, S1.u); pg8::gemm_phase<pg8::EpiProj, pg8::OneUnit, true, true>(lds, g, S1, E); }
            }
            SEAM(gp0 + P_M1);
        }
        if (IN(P_ATT)) { PENV;
            unsigned char* ws = WSP(); bf16_t* PROJ = (bf16_t*)(ws + WS_PROJ);
            {
                const int tid_k = opaque_tid(), lane_k = tid_k & 63, gw_k = wg * 8 + __builtin_amdgcn_readfirstlane(tid_k >> 6);
                prep_k(PROJ, INP(5) + (size_t)l * 256, (const f32x2*)(ws + WS_CTL + ROPE_OFF), gw_k, G * 8, lane_k);
                asm volatile("s_waitcnt vmcnt(0)" ::: "memory"); __syncthreads();
                if (threadIdx.x == 0) { __builtin_amdgcn_fence(__ATOMIC_RELEASE, "agent"); asm volatile("s_waitcnt vmcnt(0)" ::: "memory");
                    __hip_atomic_fetch_add((unsigned*)(ws + WS_CTL) + CW_KRDY + 64 * l, 1u, __ATOMIC_RELAXED, __HIP_MEMORY_SCOPE_AGENT); }
            }
            bool k_ready = false;
            const int ngrp = (G % 8 == 0) ? 8 : 1, xg = wg % ngrp, slot = wg / ngrp, per = G / ngrp;
            for (int gu = slot; gu < 96 / ngrp; gu += per) { const int U = xg * (96 / ngrp) + gu;
                gla_seq_unit(PROJ, (const float*)(ws + WS_LR), INP(7) + (size_t)l * 2 * 16 * 256, INP(8) + (size_t)l * 512, (bf16_t*)(ws + WS_OFB), (bf16_t*)(ws + WS_OA) + OM_C, INP(9) + (size_t)l * 128, lds, U >> 2, U & 3); }
            na_load_bias(INP(6) + (size_t)l * 4 * 15 * 31, lds);
            unsigned* head = (unsigned*)(ws + WS_CTL) + CW_Q + (l * 8 + xg) * 64;
            const int n_att = 1536 / ngrp, n_na = (3072 / NAR) / ngrp;
            LAS unsigned* qslot = (LAS unsigned*)(lds + MISC_OFF + 64);
            for (;;) {
                __syncthreads();
                if (threadIdx.x == 0) *qslot = __hip_atomic_fetch_add(head, 1u, __ATOMIC_RELAXED, __HIP_MEMORY_SCOPE_AGENT);
                __syncthreads();
                const int idx = __builtin_amdgcn_readfirstlane((int)*(volatile LAS unsigned*)qslot);
                if (idx >= n_att * (1 + ATT_DUP) + n_na) break;
                if (idx < n_att * (1 + ATT_DUP)) { const int idx0 = idx; const int idx = idx0 % n_att;
                    const int rnd = idx >> 5, mem = idx & 31, grp = (ngrp == 8) ? rnd * 8 + xg : rnd;
                    const int b = grp >> 1, kvh = grp & 1, h = kvh * 4 + (mem >> 3), qb = mem & 7;
                    const size_t rowq = (size_t)b * SEQ + qb * 256, rowk = (size_t)b * SEQ;
                    bf16_t* Qp = PROJ + rowq * NPROJ + C_AQ + h * 128;
                    if (!k_ready) {
                        if (threadIdx.x == 0) { unsigned* kc = (unsigned*)(ws + WS_CTL) + CW_KRDY + 64 * l; unsigned sp = 0u;
                            while (__hip_atomic_load(kc, __ATOMIC_RELAXED, __HIP_MEMORY_SCOPE_AGENT) < (unsigned)G && ++sp < XB_SPIN_CAP) __builtin_amdgcn_s_sleep(1);
                            __builtin_amdgcn_fence(__ATOMIC_ACQUIRE, "agent"); asm volatile("s_waitcnt vmcnt(0)" ::: "memory"); }
                        __syncthreads(); k_ready = true; }
                    att::attn_dense_body(Qp, PROJ + rowk * NPROJ + C_AK + kvh * 128, PROJ + rowk * NPROJ + C_AV + kvh * 128, (bf16_t*)(ws + WS_OA) + rowq * LDOM + h * 128, SEQ, (char*)lds_raw + 49152, INP(5) + (size_t)l * 256, (const f32x2*)(ws + WS_CTL + ROPE_OFF), qb * 256);
                } else {
                    na_unit(PROJ, (bf16_t*)(ws + WS_OA) + OM_B, lds, xg * n_na + (idx - n_att * (1 + ATT_DUP)));
                }
            }
            SEAM(gp0 + P_GLA);
        }
        if (IN(P_M4)) { PENV;
            unsigned char* ws = WSP();
            pg8::Gemm g{(const bf16_t*)(ws + WS_OA), (const bf16_t*)(ws + WS_WBRA), M, D, LDOM, LDOM}; pg8::StaticOrder S; S.init(M, D, G, wg, WGM_M45);
            pg8::EpiMerge3 E{(const u32x4*)(ws + WS_GATES), (bf16_t*)(ws + WS_MG)};
            pg8::gemm_phase<pg8::EpiMerge3, pg8::StaticOrder, true, true>(lds, g, S, E);
            if ((DUP_MASK >> P_M4) & 1u) pg8::gemm_phase<pg8::EpiMerge3, pg8::StaticOrder, true, true>(lds, g, S, E);
            SEAM(gp0 + P_M4);
        }
        if (IN(P_M5)) { PENV;
            unsigned char* ws = WSP();
            pg8::Gemm g{(const bf16_t*)(ws + WS_MG), (const bf16_t*)(ws + WS_WOUT), M, D, D, D}; pg8::StaticOrder S; S.init(M, D, G, wg, WGM_M45);
            pg8::EpiBf16Plain E{(bf16_t*)(ws + WS_Y), D};
            pg8::gemm_phase<pg8::EpiBf16Plain, pg8::StaticOrder, true, true>(lds, g, S, E);
            if ((DUP_MASK >> P_M5) & 1u) pg8::gemm_phase<pg8::EpiBf16Plain, pg8::StaticOrder, true, true>(lds, g, S, E);
            SEAM(gp0 + P_M5);
        }
        NORM_PHASE(P_N2, 3, 1.0f, false) SEAM(gp0 + P_N2); } } while (0);
        FFN_PAIR(1, P_F2A, P_F2B);
        NORM_PHASE(P_N3, 5, 0.5f, (l + 1 == DEPTH))
            if (l + 1 < DEPTH) { LayerW w; w.w_in = INP(3) + (size_t)(l + 1) * D * NIN; w.w_bra = INP(10) + (size_t)(l + 1) * 1024 * D; w.w_brb = INP(11) + (size_t)(l + 1) * 512 * D; w.w_brc = INP(12) + (size_t)(l + 1) * 512 * D;
                w.w_out = INP(13) + (size_t)(l + 1) * D * D; w.f1i = INP(14) + (size_t)(l + 1) * D * 2 * FF; w.f1o = INP(15) + (size_t)(l + 1) * FF * D; w.f2i = INP(16) + (size_t)(l + 1) * D * 2 * FF; w.f2o = INP(17) + (size_t)(l + 1) * FF * D; w.ng = INP(2) + (size_t)(l + 1) * 6 * D;
                phase_weights(w, ws, lds, gw, NGW, wave, lane); if ((DUP_MASK >> 20) & 1u) phase_weights(w, ws, lds, gw, NGW, wave, lane); }
            SEAM(gp0 + P_N3); } } while (0);
#undef FFN_PAIR
#undef NORM_PHASE
#undef IN
    }
#undef SEAM
}

extern "C" void kernel_launch(void* const* d_in, const int* in_sizes, int n_in, void* d_out, int out_size, void* d_ws, size_t ws_size, hipStream_t stream) {
    static int grid = 0;
    if (grid == 0) {
        if (n_in != 18 || out_size != M * D || ws_size < WS_END) { fprintf(stderr, "kernel_launch: unexpected shapes: n_in %d out %d ws %zu (need %zu)\n", n_in, out_size, ws_size, (size_t)WS_END); grid = -1; return; }
        int dev = 0, cus = 0, per_cu = 0;
        if (hipGetDevice(&dev) != hipSuccess || hipDeviceGetAttribute(&cus, hipDeviceAttributeMultiprocessorCount, dev) != hipSuccess) { grid = -1; return; }
        if (hipFuncSetAttribute((const void*)fwd, hipFuncAttributeMaxDynamicSharedMemorySize, LDS_BYTES) != hipSuccess) { fprintf(stderr, "kernel_launch: hipFuncSetAttribute failed\n"); grid = -1; return; }
        if (hipOccupancyMaxActiveBlocksPerMultiprocessor(&per_cu, (const void*)fwd, 512, LDS_BYTES) != hipSuccess || per_cu < 1) fprintf(stderr, "kernel_launch: occupancy query says %d\n", per_cu);
        (void)hipGetLastError();
        grid = cus;
    }
    if (grid < 0) return;
    (void)hipMemsetAsync((char*)d_ws + WS_CTL, 0, CTL_BYTES, stream);
    Args a{};
    for (int i = 0; i < 18; ++i) a.in[i] = (const float*)d_in[i];
    a.out = (float*)d_out; a.ws = (unsigned char*)d_ws;
#if ONE_LAUNCH
    a.gp_lo = 0; a.gp_hi = NGP;
    hipLaunchKernelGGL(fwd, dim3(grid), dim3(512), LDS_BYTES, stream, a);
#else
    for (int gp = 0; gp < NGP; ++gp) { a.gp_lo = gp; a.gp_hi = gp + 1; hipLaunchKernelGGL(fwd, dim3(grid), dim3(512), LDS_BYTES, stream, a); }
#endif
    const hipError_t le = hipPeekAtLastError();
    if (le != hipSuccess) fprintf(stderr, "kernel_launch: launch failed: %s\n", hipGetErrorName(le));
}
```
